# Optimizing an MI355X kernel written in HIP

```python
import jax, jax.numpy as jnp
from jax import lax
import numpy as np

D_MODEL = 2048
BATCH = 4
SEQ = 4096
DEPTH = 1

MEM_LEN = 256
POOL_WIDTH = 1024
POOL_WINDOWS = (2, 4, 8, 16)
POOL_GROUPS = len(POOL_WINDOWS)
POOL_GROUP = POOL_WIDTH // POOL_GROUPS
ATTN_HEADS = 8
HEAD_DIM = 128
ATTN_WIDTH = ATTN_HEADS * HEAD_DIM
MIX_WIDTH = POOL_WIDTH + ATTN_WIDTH
IN_COLS = POOL_WIDTH + 3 * ATTN_WIDTH
DILATED_PAIRS = ((128, 1), (512, 4), (2048, 16))
BLOCK = 128
ROPE_THETA = 500000.0
ROPE_DIM = HEAD_DIM // 4
CROSS_HEADS = 4
CROSS_HEAD_DIM = 128
CROSS_WIDTH = CROSS_HEADS * CROSS_HEAD_DIM
PEER_KEYS = 128
PEER_EXPERTS = PEER_KEYS * PEER_KEYS
PEER_HEADS = 8
PEER_QUERY_DIM = 256
PEER_HALF = PEER_QUERY_DIM // 2
PEER_TOPK = 16
PEER_TOKEN_BLOCK = 128
EPS = 1e-6

kernel_name = "hybrid_pool_dilated_peer_block"


def rmsnorm(x, g):
    xf = x.astype(jnp.float32)
    y = xf * lax.rsqrt(jnp.mean(xf * xf, axis=-1, keepdims=True) + EPS)
    return (y * g.astype(jnp.float32)).astype(x.dtype)


def rope_partial(t, positions):
    half = ROPE_DIM // 2
    inv = ROPE_THETA ** (-jnp.arange(0, ROPE_DIM, 2, dtype=jnp.float32) / ROPE_DIM)
    ang = positions.astype(jnp.float32)[..., None] * inv
    cos = jnp.cos(ang)[:, :, None, :]
    sin = jnp.sin(ang)[:, :, None, :]
    tr = t[..., :ROPE_DIM].astype(jnp.float32)
    x1, x2 = tr[..., :half], tr[..., half:]
    rot = jnp.concatenate([x1 * cos - x2 * sin, x2 * cos + x1 * sin], axis=-1)
    return jnp.concatenate([rot.astype(t.dtype), t[..., ROPE_DIM:]], axis=-1)


def causal_pool_mixer(p, w_pool, pool_scale):
    B, S, _ = p.shape
    pg = p.reshape(B, S, POOL_GROUPS, POOL_GROUP)
    c = jnp.cumsum(pg.astype(jnp.float32), axis=1)
    t = jnp.arange(S)
    pooled = []
    for g, w in enumerate(POOL_WINDOWS):
        cg = c[:, :, g]
        prev = jnp.pad(cg, ((0, 0), (w, 0), (0, 0)))[:, :S]
        cnt = jnp.minimum(t + 1, w).astype(jnp.float32)[None, :, None]
        pooled.append((cg - prev) / cnt)
    mixed = (jnp.stack(pooled, axis=2) - pg.astype(jnp.float32)).astype(p.dtype)
    y = jnp.einsum('bsgc,gce->bsge', mixed, w_pool) * pool_scale
    return y.reshape(B, S, POOL_WIDTH)


def dilated_branch(q, k, v, window, dilation):
    B, S, H, Dh = q.shape
    L = S // dilation
    w_sub = window // dilation
    nb = -(-L // BLOCK)
    Lp = nb * BLOCK

    def to_sub(t):
        t = t.reshape(B, L, dilation, H, Dh).transpose(0, 2, 3, 1, 4).reshape(B * dilation, H, L, Dh)
        t = jnp.pad(t, ((0, 0), (0, 0), (0, Lp - L), (0, 0)))
        return t.reshape(B * dilation, H, nb, BLOCK, Dh)

    def with_prev(t):
        prev = jnp.pad(t, ((0, 0), (0, 0), (1, 0), (0, 0), (0, 0)))[:, :, :nb]
        return jnp.concatenate([prev, t], axis=3)

    qs = to_sub(q)
    kk = with_prev(to_sub(k))
    vv = with_prev(to_sub(v))
    s = jnp.einsum('ghnqd,ghnkd->ghnqk', qs, kk).astype(jnp.float32)
    ql = jnp.arange(BLOCK)[:, None]
    kl = jnp.arange(2 * BLOCK)[None, :]
    dist = ql + BLOCK - kl
    key_idx = jnp.arange(nb)[:, None, None] * BLOCK - BLOCK + kl[None]
    mask = (dist >= 0) & (dist <= w_sub) & (key_idx >= 0)
    s = jnp.where(mask, s, -jnp.inf)
    m = jnp.max(s, axis=-1, keepdims=True)
    pe = jnp.exp(s - m)
    l = jnp.sum(pe, axis=-1, keepdims=True)
    o = jnp.einsum('ghnqk,ghnkd->ghnqd', pe, vv.astype(jnp.float32)) / l
    lse = (m + jnp.log(l))[..., 0]
    o = o.reshape(B, dilation, H, Lp, Dh)[:, :, :, :L].transpose(0, 3, 1, 2, 4).reshape(B, S, H, Dh)
    lse = lse.reshape(B, dilation, H, Lp)[..., :L].transpose(0, 3, 1, 2).reshape(B, S, H)
    return o, lse


def dilated_attention(q, k, v):
    outs, lses = [], []
    for window, dilation in DILATED_PAIRS:
        o, lse = dilated_branch(q, k, v, window, dilation)
        outs.append(o)
        lses.append(lse)
    wts = jax.nn.softmax(jnp.stack(lses, axis=-1), axis=-1)
    o = sum(wts[..., i, None] * outs[i] for i in range(len(outs)))
    return o.astype(q.dtype)


def memory_cross_attention(h, memn, w_cq, w_ck, w_cv, w_co):
    B, S, _ = h.shape
    M = memn.shape[1]
    q = (h @ w_cq).reshape(B, S, CROSS_HEADS, CROSS_HEAD_DIM) * (CROSS_HEAD_DIM ** -0.5)
    k = (memn @ w_ck).reshape(B, M, CROSS_HEADS, CROSS_HEAD_DIM)
    v = (memn @ w_cv).reshape(B, M, CROSS_HEADS, CROSS_HEAD_DIM)
    s = jnp.einsum('bshd,bmhd->bhsm', q, k).astype(jnp.float32)
    p = jax.nn.softmax(s, axis=-1).astype(v.dtype)
    o = jnp.einsum('bhsm,bmhd->bshd', p, v).reshape(B, S, CROSS_WIDTH)
    return o @ w_co


def peer_ffn(h, w_pq, sub_keys_1, sub_keys_2, w_u, w_v):
    B, S, D = h.shape
    T = B * S
    hf = h.reshape(T, D)
    q = (hf @ w_pq).reshape(T, PEER_HEADS, 2, PEER_HALF)
    s1 = jnp.einsum('thd,kd->thk', q[:, :, 0], sub_keys_1).astype(jnp.float32)
    s2 = jnp.einsum('thd,kd->thk', q[:, :, 1], sub_keys_2).astype(jnp.float32)
    v1, i1 = lax.top_k(s1, PEER_TOPK)
    v2, i2 = lax.top_k(s2, PEER_TOPK)
    cand = (v1[..., :, None] + v2[..., None, :]).reshape(T, PEER_HEADS, PEER_TOPK * PEER_TOPK)
    sc, ci = lax.top_k(cand, PEER_TOPK)
    e1 = jnp.take_along_axis(i1, ci // PEER_TOPK, axis=-1)
    e2 = jnp.take_along_axis(i2, ci % PEER_TOPK, axis=-1)
    experts = e1 * PEER_KEYS + e2
    gates = jax.nn.softmax(sc, axis=-1).astype(h.dtype)
    nblk = T // PEER_TOKEN_BLOCK
    idx = experts.reshape(nblk, PEER_TOKEN_BLOCK, PEER_HEADS * PEER_TOPK)
    gts = gates.reshape(nblk, PEER_TOKEN_BLOCK, PEER_HEADS * PEER_TOPK)

    def expert_block(args):
        hb, ib, gb = args
        u = jnp.take(w_u, ib, axis=0)
        a = jnp.einsum('td,tkd->tk', hb, u)
        c = gb * jax.nn.gelu(a)
        vv = jnp.take(w_v, ib, axis=0)
        return jnp.einsum('tk,tkd->td', c, vv)

    y = lax.map(expert_block, (hf.reshape(nblk, PEER_TOKEN_BLOCK, D), idx, gts))
    return y.reshape(B, S, D)


def setup_inputs(seed: int = 0) -> dict:
    key = jax.random.key(seed)
    ks = jax.random.split(key, 24)
    f32 = jnp.float32

    def nrm(k, shape, scale):
        return jax.random.normal(k, shape, f32) * scale

    def gain(k, shape):
        return 1.0 + 0.02 * jax.random.normal(k, shape, f32)

    offset = jax.random.randint(ks[2], (BATCH, 1), 0, 1024, dtype=jnp.int32)
    positions = offset + jnp.arange(SEQ, dtype=jnp.int32)[None, :]
    return {
        "x": nrm(ks[0], (BATCH, SEQ, D_MODEL), 1.0),
        "mem": nrm(ks[1], (BATCH, MEM_LEN, D_MODEL), 1.0),
        "positions": positions,
        "g_mix": gain(ks[3], (DEPTH, D_MODEL)),
        "w_in": nrm(ks[4], (DEPTH, D_MODEL, IN_COLS), D_MODEL ** -0.5),
        "w_pool": nrm(ks[5], (DEPTH, POOL_GROUPS, POOL_GROUP, POOL_GROUP), POOL_GROUP ** -0.5),
        "pool_scale": 1.0 + 0.1 * jax.random.normal(ks[6], (DEPTH, POOL_GROUPS, POOL_GROUP), f32),
        "w_out": nrm(ks[7], (DEPTH, MIX_WIDTH, D_MODEL), MIX_WIDTH ** -0.5),
        "g_cross": gain(ks[8], (DEPTH, D_MODEL)),
        "g_mem": gain(ks[9], (DEPTH, D_MODEL)),
        "w_cq": nrm(ks[10], (DEPTH, D_MODEL, CROSS_WIDTH), D_MODEL ** -0.5),
        "w_ck": nrm(ks[11], (DEPTH, D_MODEL, CROSS_WIDTH), D_MODEL ** -0.5),
        "w_cv": nrm(ks[12], (DEPTH, D_MODEL, CROSS_WIDTH), D_MODEL ** -0.5),
        "w_co": nrm(ks[13], (DEPTH, CROSS_WIDTH, D_MODEL), CROSS_WIDTH ** -0.5),
        "g_ffn": gain(ks[14], (DEPTH, D_MODEL)),
        "w_pq": nrm(ks[15], (DEPTH, D_MODEL, PEER_HEADS * PEER_QUERY_DIM), D_MODEL ** -0.5),
        "sub_keys_1": nrm(ks[16], (DEPTH, PEER_KEYS, PEER_HALF), PEER_HALF ** -0.5),
        "sub_keys_2": nrm(ks[17], (DEPTH, PEER_KEYS, PEER_HALF), PEER_HALF ** -0.5),
        "w_u": nrm(ks[18], (DEPTH, PEER_EXPERTS, D_MODEL), D_MODEL ** -0.5),
        "w_v": nrm(ks[19], (DEPTH, PEER_EXPERTS, D_MODEL), (PEER_HEADS * PEER_TOPK) ** -0.5),
        "g_final": gain(ks[20], (D_MODEL,)),
    }


def reference(x, mem, positions, g_mix, w_in, w_pool, pool_scale, w_out, g_cross, g_mem,
              w_cq, w_ck, w_cv, w_co, g_ffn, w_pq, sub_keys_1, sub_keys_2, w_u, w_v, g_final):
    B, S, _ = x.shape
    for i in range(DEPTH):
        h = rmsnorm(x, g_mix[i])
        z = h @ w_in[i]
        p = z[..., :POOL_WIDTH]
        q = z[..., POOL_WIDTH:POOL_WIDTH + ATTN_WIDTH].reshape(B, S, ATTN_HEADS, HEAD_DIM)
        k = z[..., POOL_WIDTH + ATTN_WIDTH:POOL_WIDTH + 2 * ATTN_WIDTH].reshape(B, S, ATTN_HEADS, HEAD_DIM)
        v = z[..., POOL_WIDTH + 2 * ATTN_WIDTH:].reshape(B, S, ATTN_HEADS, HEAD_DIM)
        pool_out = causal_pool_mixer(p, w_pool[i], pool_scale[i])
        q = rope_partial(q, positions) * (HEAD_DIM ** -0.5)
        k = rope_partial(k, positions)
        attn_out = dilated_attention(q, k, v).reshape(B, S, ATTN_WIDTH)
        x = x + jnp.concatenate([pool_out, attn_out], axis=-1) @ w_out[i]
        memn = rmsnorm(mem, g_mem[i])
        x = x + memory_cross_attention(rmsnorm(x, g_cross[i]), memn, w_cq[i], w_ck[i], w_cv[i], w_co[i])
        x = x + peer_ffn(rmsnorm(x, g_ffn[i]), w_pq[i], sub_keys_1[i], sub_keys_2[i], w_u[i], w_v[i])
    return rmsnorm(x, g_final)
```

```cpp
#include <hip/hip_runtime.h>
#include <hip/hip_cooperative_groups.h>
#include <stdint.h>
#include <stdio.h>
namespace cg = cooperative_groups;

#ifndef ABL
#define ABL 0
#endif
#ifndef MULTI_LAUNCH
#define MULTI_LAUNCH 1
#endif

#define DI __device__ __forceinline__
typedef unsigned short bfr;
using bf16x8 = __attribute__((ext_vector_type(8))) short;
using s16x4  = __attribute__((ext_vector_type(4))) short;
using f32x4  = __attribute__((ext_vector_type(4))) float;
using u32x4  = __attribute__((ext_vector_type(4))) unsigned;
using u32x2  = __attribute__((ext_vector_type(2))) unsigned;
using bf2    = __attribute__((ext_vector_type(2))) __bf16;

constexpr int T_TOK = 16384;
constexpr int NTHREADS = 512;
constexpr int SMEM_BYTES = 151552;
constexpr int NPHASE = 13;

struct Params {
  const float *x, *mem; const int* pos;
  const float *g_mix, *w_in, *w_pool, *pool_scale, *w_out, *g_cross, *g_mem, *w_cq, *w_ck, *w_cv, *w_co, *g_ffn, *w_pq,
              *sk1f, *sk2f, *w_u, *w_v, *g_final;
  float* out;
  bfr *wInT, *wPoolT, *wOutT, *wCqT, *wCkT, *wCvT, *wCoT, *wPqT, *sk1, *sk2, *wU, *wV;
  bfr *hbuf, *memn, *kc, *vc;
  bfr *pbuf, *qbuf, *kbuf, *vbuf, *mixed, *ob; float* lse;
  float* xres; bfr *pq, *qc, *oc; int* idx; float* gates;
};

DI unsigned pack2(float a, float b) { bf2 p; p[0] = (__bf16)a; p[1] = (__bf16)b; return __builtin_bit_cast(unsigned, p); }
DI float bflo(unsigned u) { return __uint_as_float(u << 16); }
DI float bfhi(unsigned u) { return __uint_as_float(u & 0xffff0000u); }
DI float wave_sum(float v) {
#pragma unroll
  for (int o = 32; o >= 1; o >>= 1) v += __shfl_xor(v, o);
  return v;
}
DI f32x4 mfma16(bf16x8 a, bf16x8 b, f32x4 c) { return __builtin_amdgcn_mfma_f32_16x16x32_bf16(a, b, c, 0, 0, 0); }
DI s16x4 tr_read(const char* p) {
  return __builtin_amdgcn_ds_read_tr16_b64_v4i16((s16x4 __attribute__((address_space(3)))*)(p));
}

DI void gemm_main(const bfr* __restrict__ A, int lda, const bfr* __restrict__ Bt, int ldb, int K, char* smem,
                  f32x4 (&acc)[4][4]) {
  const int tid = threadIdx.x, lane = tid & 63, wid = tid >> 6, wm = wid >> 1, wn = wid & 1, fr = lane & 15, fq = lane >> 4;
  const int lrow = tid >> 3, lc = tid & 7;
  const int sw = ((lc ^ (lrow & 7)) << 4);
  u32x4 ra[4], rb[2];
  const bfr* ga = A + (size_t)lrow * lda + lc * 8;
  const bfr* gb = Bt + (size_t)lrow * ldb + lc * 8;
#pragma unroll
  for (int m = 0; m < 4; ++m)
#pragma unroll
    for (int n = 0; n < 4; ++n) acc[m][n] = f32x4{0.f, 0.f, 0.f, 0.f};
  const int nk = K >> 6;
#pragma unroll
  for (int i = 0; i < 4; ++i) ra[i] = *(const u32x4*)(ga + (size_t)(64 * i) * lda);
#pragma unroll
  for (int i = 0; i < 2; ++i) rb[i] = *(const u32x4*)(gb + (size_t)(64 * i) * ldb);
  __syncthreads();
#pragma unroll
  for (int i = 0; i < 4; ++i) *(u32x4*)(smem + (lrow + 64 * i) * 128 + sw) = ra[i];
#pragma unroll
  for (int i = 0; i < 2; ++i) *(u32x4*)(smem + 32768 + (lrow + 64 * i) * 128 + sw) = rb[i];
  __syncthreads();
  for (int kt = 0; kt < nk; ++kt) {
    const char* cur = smem + (kt & 1) * 49152;
    char* nxt = smem + ((kt + 1) & 1) * 49152;
    const bool more = (kt + 1 < nk);
    if (more) {
#pragma unroll
      for (int i = 0; i < 4; ++i) ra[i] = *(const u32x4*)(ga + (size_t)(64 * i) * lda + (kt + 1) * 64);
#pragma unroll
      for (int i = 0; i < 2; ++i) rb[i] = *(const u32x4*)(gb + (size_t)(64 * i) * ldb + (kt + 1) * 64);
    }
#pragma unroll
    for (int kk = 0; kk < 2; ++kk) {
      bf16x8 af[4], bf[4];
      const int co = (((kk * 4 + fq) ^ (fr & 7)) << 4);
#pragma unroll
      for (int m = 0; m < 4; ++m) af[m] = *(const bf16x8*)(cur + (wm * 64 + m * 16 + fr) * 128 + co);
#pragma unroll
      for (int n = 0; n < 4; ++n) bf[n] = *(const bf16x8*)(cur + 32768 + (wn * 64 + n * 16 + fr) * 128 + co);
#pragma unroll
      for (int m = 0; m < 4; ++m)
#pragma unroll
        for (int n = 0; n < 4; ++n) acc[m][n] = mfma16(bf[n], af[m], acc[m][n]);
    }
    if (more) {
#pragma unroll
      for (int i = 0; i < 4; ++i) *(u32x4*)(nxt + (lrow + 64 * i) * 128 + sw) = ra[i];
#pragma unroll
      for (int i = 0; i < 2; ++i) *(u32x4*)(nxt + 32768 + (lrow + 64 * i) * 128 + sw) = rb[i];
    }
    __syncthreads();
  }
}

DI void tile_map(int id, int MT, int NT, int& mt, int& nt) {
  if ((NT & 7) == 0 && (MT & 31) == 0) {
    const int round = id >> 8, local = id & 255, xcd = local & 7, j = local >> 3, mtl = j & 3, ntl = j >> 2;
    const int MR = MT >> 5;
    const int mr = round % MR, nr = round / MR;
    mt = mr * 32 + xcd * 4 + mtl;
    nt = nr * 8 + ntl;
  } else {
    mt = id % MT;
    nt = id / MT;
  }
}

template <bool BANDED, class StoreF>
DI void attn_core(const bfr* __restrict__ Qb, int qstride, int q0, const bfr* __restrict__ Kb, const bfr* __restrict__ Vb,
                  int kvstride, int key0, char* smem, StoreF store, float& m_out, float& l_out) {
  const int tid = threadIdx.x, lane = tid & 63, w = tid >> 6, fr = lane & 15, fq = lane >> 4;
  char* sK = smem;
  char* sV = smem + 65536;
  __syncthreads();
#pragma unroll 1
  for (int rr = 0; rr < 2; ++rr) {
    u32x4 kr[4], vr[4];
#pragma unroll
    for (int i = 0; i < 4; ++i) {
      const int id = tid + (rr * 4 + i) * 512, key = id >> 4, c = id & 15, lk = key0 + key;
      kr[i] = u32x4{0u, 0u, 0u, 0u};
      vr[i] = u32x4{0u, 0u, 0u, 0u};
      if (lk >= 0) {
        kr[i] = *(const u32x4*)(Kb + (long)lk * kvstride + c * 8);
        vr[i] = *(const u32x4*)(Vb + (long)lk * kvstride + c * 8);
      }
    }
#pragma unroll
    for (int i = 0; i < 4; ++i) {
      const int id = tid + (rr * 4 + i) * 512, key = id >> 4, c = id & 15;
      *(u32x4*)(sK + key * 256 + ((c ^ (key & 15)) << 4)) = kr[i];
      *(u32x4*)(sV + key * 288 + c * 16) = vr[i];
    }
  }
  bf16x8 qf[4];
  {
    const bfr* qrow = Qb + (long)(q0 + w * 16 + fr) * qstride;
#pragma unroll
    for (int kk = 0; kk < 4; ++kk) qf[kk] = *(const bf16x8*)(qrow + kk * 32 + fq * 8);
  }
  __syncthreads();
  constexpr int NT = BANDED ? 10 : 16;
  const int t0 = BANDED ? (w & ~1) : 0;
  f32x4 s[NT];
#pragma unroll
  for (int j = 0; j < NT; ++j) {
    f32x4 a = f32x4{0.f, 0.f, 0.f, 0.f};
    const int key = (t0 + j) * 16 + fr;
#pragma unroll
    for (int kk = 0; kk < 4; ++kk) {
      const bf16x8 kf = *(const bf16x8*)(sK + key * 256 + (((kk * 4 + fq) ^ fr) << 4));
      a = mfma16(kf, qf[kk], a);
    }
    s[j] = a;
  }
  const float L2E = 1.4426950408889634f;
  const float NINF = -__builtin_inff();
  float mx = NINF;
  const int lq = q0 + w * 16 + fr;
#pragma unroll
  for (int j = 0; j < NT; ++j)
#pragma unroll
    for (int i = 0; i < 4; ++i) {
      float v = s[j][i] * L2E;
      if (BANDED) {
        const int lk = key0 + (t0 + j) * 16 + fq * 4 + i;
        const int dist = lq - lk;
        const bool ok = (lk >= 0) && (dist >= 0) && (dist <= 128);
        v = ok ? v : NINF;
      }
      s[j][i] = v;
      mx = fmaxf(mx, v);
    }
  mx = fmaxf(mx, __shfl_xor(mx, 16));
  mx = fmaxf(mx, __shfl_xor(mx, 32));
  float l = 0.f;
#pragma unroll
  for (int j = 0; j < NT; ++j)
#pragma unroll
    for (int i = 0; i < 4; ++i) {
      const float p = __builtin_amdgcn_exp2f(s[j][i] - mx);
      s[j][i] = p;
      l += p;
    }
  l += __shfl_xor(l, 16);
  l += __shfl_xor(l, 32);
  bf16x8 pf[NT / 2];
#pragma unroll
  for (int c = 0; c < NT / 2; ++c) {
    u32x4 t;
    t[0] = pack2(s[2 * c][0], s[2 * c][1]);
    t[1] = pack2(s[2 * c][2], s[2 * c][3]);
    t[2] = pack2(s[2 * c + 1][0], s[2 * c + 1][1]);
    t[3] = pack2(s[2 * c + 1][2], s[2 * c + 1][3]);
    pf[c] = __builtin_bit_cast(bf16x8, t);
  }
  const int q4 = (lane & 15) >> 2, p4 = lane & 3;
  m_out = mx;
  l_out = l;
#pragma unroll 2
  for (int dt = 0; dt < 8; ++dt) {
    f32x4 a = f32x4{0.f, 0.f, 0.f, 0.f};
#pragma unroll
    for (int c = 0; c < NT / 2; ++c) {
      const int kb = (t0 + 2 * c) * 16;
      const s16x4 lo = tr_read(sV + (kb + fq * 4 + q4) * 288 + (dt * 16 + p4 * 4) * 2);
      const s16x4 hi = tr_read(sV + (kb + 16 + fq * 4 + q4) * 288 + (dt * 16 + p4 * 4) * 2);
      const bf16x8 vf = __builtin_shufflevector(lo, hi, 0, 1, 2, 3, 4, 5, 6, 7);
      a = mfma16(vf, pf[c], a);
    }
    store(dt, a, l);
  }
}

DI int f2sort(float f) { int b = __float_as_int(f); return b ^ ((b >> 31) & 0x7fffffff); }
DI float sort2f(int s) { int b = s ^ ((s >> 31) & 0x7fffffff); return __int_as_float(b); }
DI void topk_insert(int (&lst)[16], int key) {
#pragma unroll
  for (int j = 0; j < 16; ++j) {
    const int hi = max(lst[j], key);
    key = min(lst[j], key);
    lst[j] = hi;
  }
}

template <int O, int N>
DI void bfly(float (&p)[64], int lane) {
  const bool up = (lane & O) != 0;
#pragma unroll
  for (int i = 0; i < N / 2; ++i) {
    const float keep = up ? p[i + N / 2] : p[i];
    const float send = up ? p[i] : p[i + N / 2];
    p[i] = keep + __shfl_xor(send, O);
  }
  if constexpr (O > 1) bfly<O / 2, N / 2>(p, lane);
}

DI void rms_row_to_bf16(const float* __restrict__ x, const float* __restrict__ g, bfr* __restrict__ out, int lane) {
  float4 v[8];
  float ss = 0.f;
#pragma unroll
  for (int j = 0; j < 8; ++j) {
    v[j] = *(const float4*)(x + j * 256 + lane * 4);
    ss += v[j].x * v[j].x + v[j].y * v[j].y + v[j].z * v[j].z + v[j].w * v[j].w;
  }
  ss = wave_sum(ss);
  const float rs = rsqrtf(ss * (1.f / 2048.f) + 1e-6f);
#pragma unroll
  for (int j = 0; j < 8; ++j) {
    const float4 gg = *(const float4*)(g + j * 256 + lane * 4);
    u32x2 o;
    o[0] = pack2(v[j].x * rs * gg.x, v[j].y * rs * gg.y);
    o[1] = pack2(v[j].z * rs * gg.z, v[j].w * rs * gg.w);
    *(u32x2*)(out + j * 256 + lane * 4) = o;
  }
}

DI void transpose_tile(const float* __restrict__ W, int K, int N, int k0, int n0, bfr* __restrict__ Wt, float* tile) {
  __syncthreads();
  {
    const int r = threadIdx.x >> 4, c4 = threadIdx.x & 15;
#pragma unroll
    for (int i = 0; i < 2; ++i) {
      const int k = r + 32 * i;
      const float4 v = *(const float4*)(W + (size_t)(k0 + k) * N + n0 + c4 * 4);
      tile[k * 65 + c4 * 4 + 0] = v.x;
      tile[k * 65 + c4 * 4 + 1] = v.y;
      tile[k * 65 + c4 * 4 + 2] = v.z;
      tile[k * 65 + c4 * 4 + 3] = v.w;
    }
  }
  __syncthreads();
  {
    const int n = threadIdx.x >> 3, kc = threadIdx.x & 7;
    u32x4 o;
#pragma unroll
    for (int j = 0; j < 4; ++j) o[j] = pack2(tile[(kc * 8 + 2 * j) * 65 + n], tile[(kc * 8 + 2 * j + 1) * 65 + n]);
    *(u32x4*)(Wt + (size_t)(n0 + n) * K + k0 + kc * 8) = o;
  }
}

DI void convert_f32_bf16(const float* __restrict__ src, bfr* __restrict__ dst, long n8) {
  for (long i = (long)blockIdx.x * NTHREADS + threadIdx.x; i < n8; i += (long)gridDim.x * NTHREADS) {
    const float4 a = *(const float4*)(src + i * 8);
    const float4 b = *(const float4*)(src + i * 8 + 4);
    u32x4 o;
    o[0] = pack2(a.x, a.y); o[1] = pack2(a.z, a.w); o[2] = pack2(b.x, b.y); o[3] = pack2(b.z, b.w);
    *(u32x4*)(dst + i * 8) = o;
  }
}

DI void phase_prep(const Params& p, char* smem) {
  const int lane = threadIdx.x & 63, wid = threadIdx.x >> 6;
  for (int r = blockIdx.x * 8 + wid; r < T_TOK + 1024; r += gridDim.x * 8) {
    if (r < T_TOK) rms_row_to_bf16(p.x + (size_t)r * 2048, p.g_mix, p.hbuf + (size_t)r * 2048, lane);
    else rms_row_to_bf16(p.mem + (size_t)(r - T_TOK) * 2048, p.g_mem, p.memn + (size_t)(r - T_TOK) * 2048, lane);
  }
  float* tile = (float*)smem;
  for (int id0 = blockIdx.x; id0 < 5184; id0 += gridDim.x) {
    int id = id0;
    const float* W; bfr* Wt; int K, N;
    if (id < 2048) { W = p.w_in; Wt = p.wInT; K = 2048; N = 4096; }
    else if ((id -= 2048) < 1024) { W = p.w_out; Wt = p.wOutT; K = 2048; N = 2048; }
    else if ((id -= 1024) < 1024) { W = p.w_pq; Wt = p.wPqT; K = 2048; N = 2048; }
    else if ((id -= 1024) < 256) { W = p.w_cq; Wt = p.wCqT; K = 2048; N = 512; }
    else if ((id -= 256) < 256) { W = p.w_ck; Wt = p.wCkT; K = 2048; N = 512; }
    else if ((id -= 256) < 256) { W = p.w_cv; Wt = p.wCvT; K = 2048; N = 512; }
    else if ((id -= 256) < 256) { W = p.w_co; Wt = p.wCoT; K = 512; N = 2048; }
    else { id -= 256; const int g = id >> 4; id &= 15; W = p.w_pool + g * 65536; Wt = p.wPoolT + g * 65536; K = 256; N = 256; }
    const int ntn = N >> 6;
    const int kt = id / ntn, nt = id % ntn;
    transpose_tile(W, K, N, kt * 64, nt * 64, Wt, tile);
  }
  convert_f32_bf16(p.sk1f, p.sk1, 128 * 128 / 8);
  convert_f32_bf16(p.sk2f, p.sk2, 128 * 128 / 8);
  convert_f32_bf16(p.w_u, p.wU, (long)16384 * 2048 / 8);
  convert_f32_bf16(p.w_v, p.wV, (long)16384 * 2048 / 8);
}

DI void phase_inproj(const Params& p, char* smem) {
  const int tid = threadIdx.x, lane = tid & 63, wid = tid >> 6, wm = wid >> 1, wn = wid & 1, fr = lane & 15, fq = lane >> 4;
  f32x4 acc[4][4];
  for (int id = blockIdx.x; id < 2048 + 32; id += gridDim.x) {
    if (id < 2048) {
      int mt, nt;
      tile_map(id, 64, 32, mt, nt);
      gemm_main(p.hbuf + (size_t)mt * 256 * 2048, 2048, p.wInT + (size_t)nt * 128 * 2048, 2048, 2048, smem, acc);
      const int region = nt >> 3, h = nt & 7;
      if (region == 0) {
#pragma unroll
        for (int m = 0; m < 4; ++m) {
          const int row = mt * 256 + wm * 64 + m * 16 + fr;
#pragma unroll
          for (int n = 0; n < 4; ++n) {
            const int col = nt * 128 + wn * 64 + n * 16 + fq * 4;
            u32x2 o; o[0] = pack2(acc[m][n][0], acc[m][n][1]); o[1] = pack2(acc[m][n][2], acc[m][n][3]);
            *(u32x2*)(p.pbuf + (size_t)row * 1024 + col) = o;
          }
        }
      } else {
        bfr* dst = (region == 1) ? p.qbuf : (region == 2 ? p.kbuf : p.vbuf);
        const float scale = (region == 1) ? 0.08838834764831845f : 1.0f;
#pragma unroll
        for (int m = 0; m < 4; ++m) {
          const int row = mt * 256 + wm * 64 + m * 16 + fr;
          const int b = row >> 12, t = row & 4095;
          if (region != 3 && wn == 0) {
            const float posf = (float)p.pos[row];
#pragma unroll
            for (int i = 0; i < 4; ++i) {
              const int j = fq * 4 + i;
              const float inv = exp2f(-(float)j * (18.931568569324174f / 16.0f));
              float sn, cs;
              sincosf(posf * inv, &sn, &cs);
              const float x1 = acc[m][0][i], x2 = acc[m][1][i];
              acc[m][0][i] = x1 * cs - x2 * sn;
              acc[m][1][i] = x2 * cs + x1 * sn;
            }
          }
#pragma unroll
          for (int n = 0; n < 4; ++n) {
            const int d = wn * 64 + n * 16 + fq * 4;
            u32x2 o;
            o[0] = pack2(acc[m][n][0] * scale, acc[m][n][1] * scale);
            o[1] = pack2(acc[m][n][2] * scale, acc[m][n][3] * scale);
            *(u32x2*)(dst + ((size_t)((b * 8 + h) * 4096 + t)) * 128 + d) = o;
          }
        }
      }
    } else {
      const int id2 = id - 2048;
      const int which = id2 >> 4, mt = (id2 >> 2) & 3, nt = id2 & 3;
      const bfr* Bt = (which == 0 ? p.wCkT : p.wCvT) + (size_t)nt * 128 * 2048;
      bfr* dst = which == 0 ? p.kc : p.vc;
      gemm_main(p.memn + (size_t)mt * 256 * 2048, 2048, Bt, 2048, 2048, smem, acc);
#pragma unroll
      for (int m = 0; m < 4; ++m) {
        const int row = mt * 256 + wm * 64 + m * 16 + fr;
        const int b = row >> 8, mm = row & 255;
#pragma unroll
        for (int n = 0; n < 4; ++n) {
          const int d = wn * 64 + n * 16 + fq * 4;
          u32x2 o; o[0] = pack2(acc[m][n][0], acc[m][n][1]); o[1] = pack2(acc[m][n][2], acc[m][n][3]);
          *(u32x2*)(dst + ((size_t)((b * 4 + nt) * 256 + mm)) * 128 + d) = o;
        }
      }
    }
  }
}

DI void phase_mix_attn(const Params& p, char* smem) {
  const int tid = threadIdx.x, lane = tid & 63, w = tid >> 6, fr = lane & 15, fq = lane >> 4;
  for (int id = blockIdx.x; id < 3072 + 256; id += gridDim.x) {
    if (id < 3072) {
      const int br = id >> 10, rem = id & 1023;
      const int dl = (br == 0) ? 1 : (br == 1 ? 4 : 16);
      const int nblk = 32 / dl;
      const int bh = rem >> 5, rn = rem & 31;
      const int r = rn / nblk, nb = rn % nblk;
      const int l0 = nb * 128;
      const size_t base = (size_t)bh * 4096 * 128 + (size_t)r * 128;
      float mx, l;
      const int b = bh >> 3, h = bh & 7;
      const int tt = b * 4096 + (l0 + w * 16 + fr) * dl + r;
      bfr* dst = p.ob + (size_t)br * T_TOK * 1024 + (size_t)tt * 1024 + h * 128 + fq * 4;
      attn_core<true>(p.qbuf + base, dl * 128, l0, p.kbuf + base, p.vbuf + base, dl * 128, l0 - 128, smem,
                      [&](int dt, f32x4 a, float lsum) {
                        const float il = 1.f / lsum;
                        u32x2 v; v[0] = pack2(a[0] * il, a[1] * il); v[1] = pack2(a[2] * il, a[3] * il);
                        *(u32x2*)(dst + dt * 16) = v;
                      }, mx, l);
      if (fq == 0) p.lse[(size_t)br * T_TOK * 8 + (size_t)tt * 8 + h] = mx + __builtin_amdgcn_logf(l);
    } else {
      const int ci = id - 3072;
      const int sub = tid >> 7, cgp = tid & 127;
      const int wdw = 2 << (cgp >> 5);
      const int t0 = ci * 64 + sub * 16, tin0 = t0 & 4095;
      const bfr* pb = p.pbuf + cgp * 8;
      float sum[8];
#pragma unroll
      for (int e = 0; e < 8; ++e) sum[e] = 0.f;
      for (int j = 1; j < wdw; ++j) {
        if (tin0 - j >= 0) {
          const u32x4 v = *(const u32x4*)(pb + (size_t)(t0 - j) * 1024);
#pragma unroll
          for (int e = 0; e < 4; ++e) { sum[2 * e] += bflo(v[e]); sum[2 * e + 1] += bfhi(v[e]); }
        }
      }
      for (int s = 0; s < 16; ++s) {
        const int t = t0 + s, tin = tin0 + s;
        const u32x4 v = *(const u32x4*)(pb + (size_t)t * 1024);
        float cur[8];
#pragma unroll
        for (int e = 0; e < 4; ++e) { cur[2 * e] = bflo(v[e]); cur[2 * e + 1] = bfhi(v[e]); }
        const float ic = 1.f / (float)min(tin + 1, wdw);
        u32x4 ov;
#pragma unroll
        for (int e = 0; e < 8; ++e) sum[e] += cur[e];
#pragma unroll
        for (int e = 0; e < 4; ++e) ov[e] = pack2(sum[2 * e] * ic - cur[2 * e], sum[2 * e + 1] * ic - cur[2 * e + 1]);
        *(u32x4*)(p.mixed + (size_t)t * 1024 + cgp * 8) = ov;
        if (tin - wdw + 1 >= 0) {
          const u32x4 u = *(const u32x4*)(pb + (size_t)(t - wdw + 1) * 1024);
#pragma unroll
          for (int e = 0; e < 4; ++e) { sum[2 * e] -= bflo(u[e]); sum[2 * e + 1] -= bfhi(u[e]); }
        }
      }
    }
  }
}

DI void phase_pool_combine(const Params& p, char* smem) {
  const int tid = threadIdx.x, lane = tid & 63, wid = tid >> 6, wm = wid >> 1, wn = wid & 1, fr = lane & 15, fq = lane >> 4;
  f32x4 acc[4][4];
  for (int id = blockIdx.x; id < 512; id += gridDim.x) {
    const int g = id >> 7, mt = (id >> 1) & 63, nt = id & 1;
    gemm_main(p.mixed + (size_t)mt * 256 * 1024 + g * 256, 1024, p.wPoolT + (size_t)g * 65536 + (size_t)nt * 128 * 256, 256, 256,
              smem, acc);
#pragma unroll
    for (int m = 0; m < 4; ++m) {
      const int row = mt * 256 + wm * 64 + m * 16 + fr;
#pragma unroll
      for (int n = 0; n < 4; ++n) {
        const int e = nt * 128 + wn * 64 + n * 16 + fq * 4;
        const float4 sc = *(const float4*)(p.pool_scale + g * 256 + e);
        u32x2 o; o[0] = pack2(acc[m][n][0] * sc.x, acc[m][n][1] * sc.y); o[1] = pack2(acc[m][n][2] * sc.z, acc[m][n][3] * sc.w);
        *(u32x2*)(p.hbuf + (size_t)row * 2048 + g * 256 + e) = o;
      }
    }
  }
  for (long i = (long)blockIdx.x * NTHREADS + tid; i < (long)T_TOK * 8 * 16; i += (long)gridDim.x * NTHREADS) {
    const int dc = (int)(i & 15), h = (int)((i >> 4) & 7);
    const long tt = i >> 7;
    const float l0 = p.lse[tt * 8 + h], l1 = p.lse[(size_t)T_TOK * 8 + tt * 8 + h], l2 = p.lse[(size_t)2 * T_TOK * 8 + tt * 8 + h];
    const float mx = fmaxf(l0, fmaxf(l1, l2));
    float w0 = __builtin_amdgcn_exp2f(l0 - mx), w1 = __builtin_amdgcn_exp2f(l1 - mx), w2 = __builtin_amdgcn_exp2f(l2 - mx);
    const float inv = 1.f / (w0 + w1 + w2);
    w0 *= inv; w1 *= inv; w2 *= inv;
    if (ABL == 3) { w0 = 0.f; w1 = 0.f; w2 = 0.f; }
    const size_t off = (size_t)tt * 1024 + h * 128 + dc * 8;
    const u32x4 a = *(const u32x4*)(p.ob + off);
    const u32x4 b = *(const u32x4*)(p.ob + (size_t)T_TOK * 1024 + off);
    const u32x4 c = *(const u32x4*)(p.ob + (size_t)2 * T_TOK * 1024 + off);
    u32x4 o;
#pragma unroll
    for (int e = 0; e < 4; ++e)
      o[e] = pack2(w0 * bflo(a[e]) + w1 * bflo(b[e]) + w2 * bflo(c[e]), w0 * bfhi(a[e]) + w1 * bfhi(b[e]) + w2 * bfhi(c[e]));
    *(u32x4*)(p.hbuf + (size_t)tt * 2048 + 1024 + h * 128 + dc * 8) = o;
  }
}

DI void phase_gemm_resid(const bfr* A, int lda, const bfr* Bt, int K, const float* resid, float* xout, char* smem) {
  const int tid = threadIdx.x, lane = tid & 63, wid = tid >> 6, wm = wid >> 1, wn = wid & 1, fr = lane & 15, fq = lane >> 4;
  f32x4 acc[4][4];
  for (int id = blockIdx.x; id < 1024; id += gridDim.x) {
    int mt, nt;
    tile_map(id, 64, 16, mt, nt);
    gemm_main(A + (size_t)mt * 256 * lda, lda, Bt + (size_t)nt * 128 * K, K, K, smem, acc);
#pragma unroll
    for (int m = 0; m < 4; ++m) {
      const int row = mt * 256 + wm * 64 + m * 16 + fr;
#pragma unroll
      for (int n = 0; n < 4; ++n) {
        const int col = nt * 128 + wn * 64 + n * 16 + fq * 4;
        const float4 r = *(const float4*)(resid + (size_t)row * 2048 + col);
        float4 o; o.x = r.x + acc[m][n][0]; o.y = r.y + acc[m][n][1]; o.z = r.z + acc[m][n][2]; o.w = r.w + acc[m][n][3];
        *(float4*)(xout + (size_t)row * 2048 + col) = o;
      }
    }
  }
}

DI void phase_rms(const float* xin, const float* g, bfr* out) {
  const int lane = threadIdx.x & 63, wid = threadIdx.x >> 6;
  for (int r = blockIdx.x * 8 + wid; r < T_TOK; r += gridDim.x * 8)
    rms_row_to_bf16(xin + (size_t)r * 2048, g, out + (size_t)r * 2048, lane);
}

DI void phase_gemm_bf16(const bfr* A, int lda, const bfr* Bt, int K, int N, float scale, bfr* out, char* smem) {
  const int tid = threadIdx.x, lane = tid & 63, wid = tid >> 6, wm = wid >> 1, wn = wid & 1, fr = lane & 15, fq = lane >> 4;
  f32x4 acc[4][4];
  const int NT = N >> 7;
  for (int id = blockIdx.x; id < 64 * NT; id += gridDim.x) {
    int mt, nt;
    tile_map(id, 64, NT, mt, nt);
    gemm_main(A + (size_t)mt * 256 * lda, lda, Bt + (size_t)nt * 128 * K, K, K, smem, acc);
#pragma unroll
    for (int m = 0; m < 4; ++m) {
      const int row = mt * 256 + wm * 64 + m * 16 + fr;
#pragma unroll
      for (int n = 0; n < 4; ++n) {
        const int col = nt * 128 + wn * 64 + n * 16 + fq * 4;
        u32x2 o; o[0] = pack2(acc[m][n][0] * scale, acc[m][n][1] * scale); o[1] = pack2(acc[m][n][2] * scale, acc[m][n][3] * scale);
        *(u32x2*)(out + (size_t)row * N + col) = o;
      }
    }
  }
}

DI void phase_cross_attn(const Params& p, char* smem) {
  const int tid = threadIdx.x, lane = tid & 63, w = tid >> 6, fr = lane & 15, fq = lane >> 4;
  for (int id = blockIdx.x; id < 512; id += gridDim.x) {
    const int b = id >> 7, h = (id >> 5) & 3, qt = id & 31;
    float mx, l;
    const size_t kvb = (size_t)(b * 4 + h) * 256 * 128;
    bfr* dst = p.oc + (size_t)(b * 4096 + qt * 128 + w * 16 + fr) * 512 + h * 128 + fq * 4;
    attn_core<false>(p.qc + (size_t)b * 4096 * 512 + h * 128, 512, qt * 128, p.kc + kvb, p.vc + kvb, 128, 0, smem,
                     [&](int dt, f32x4 a, float lsum) {
                       const float il = 1.f / lsum;
                       u32x2 v; v[0] = pack2(a[0] * il, a[1] * il); v[1] = pack2(a[2] * il, a[3] * il);
                       *(u32x2*)(dst + dt * 16) = v;
                     }, mx, l);
  }
}

DI void phase_peer_route(const Params& p, char* smem) {
  const int tid = threadIdx.x, lane = tid & 63, w = tid >> 6, fr = lane & 15, fq = lane >> 4;
  float* scores = (float*)smem;
  int* lists = (int*)(smem + 135168);
  for (int id = blockIdx.x; id < 1024; id += gridDim.x) {
    const int tt = id >> 3, h = id & 7;
    const int tok0 = tt * 128;
    __syncthreads();
#pragma unroll
    for (int hf = 0; hf < 2; ++hf) {
      const bfr* arow = p.pq + (size_t)(tok0 + w * 16 + fr) * 2048 + h * 256 + hf * 128;
      bf16x8 af[4];
#pragma unroll
      for (int kk = 0; kk < 4; ++kk) af[kk] = *(const bf16x8*)(arow + kk * 32 + fq * 8);
      const bfr* sk = hf ? p.sk2 : p.sk1;
#pragma unroll
      for (int nt = 0; nt < 8; ++nt) {
        f32x4 a = f32x4{0.f, 0.f, 0.f, 0.f};
#pragma unroll
        for (int kk = 0; kk < 4; ++kk) {
          const bf16x8 bfg = *(const bf16x8*)(sk + (nt * 16 + fr) * 128 + kk * 32 + fq * 8);
          a = mfma16(af[kk], bfg, a);
        }
#pragma unroll
        for (int i = 0; i < 4; ++i) scores[(hf * 128 + w * 16 + fq * 4 + i) * 132 + nt * 16 + fr] = a[i];
      }
    }
    __syncthreads();
    if (tid < 256) {
      int lst[16];
#pragma unroll
      for (int j = 0; j < 16; ++j) lst[j] = (int)0x80000000;
      const float* srow = scores + tid * 132;
      for (int k4 = 0; k4 < 32; ++k4) {
        const float4 v = *(const float4*)(srow + k4 * 4);
        topk_insert(lst, (f2sort(v.x) & ~0x7F) | (k4 * 4 + 0));
        topk_insert(lst, (f2sort(v.y) & ~0x7F) | (k4 * 4 + 1));
        topk_insert(lst, (f2sort(v.z) & ~0x7F) | (k4 * 4 + 2));
        topk_insert(lst, (f2sort(v.w) & ~0x7F) | (k4 * 4 + 3));
      }
#pragma unroll
      for (int j = 0; j < 16; ++j) lists[tid * 16 + j] = lst[j];
    }
    __syncthreads();
    if (tid < 128) {
      float v1[16], v2[16];
#pragma unroll
      for (int j = 0; j < 16; ++j) {
        v1[j] = sort2f(lists[tid * 16 + j] & ~0x7F);
        v2[j] = sort2f(lists[(128 + tid) * 16 + j] & ~0x7F);
      }
      int top[16];
#pragma unroll
      for (int j = 0; j < 16; ++j) top[j] = (int)0x80000000;
#pragma unroll
      for (int a = 0; a < 16; ++a)
#pragma unroll
        for (int b = 0; b < 16; ++b)
          if ((a + 1) * (b + 1) <= 16) topk_insert(top, (f2sort(v1[a] + v2[b]) & ~0xFF) | (a * 16 + b));
      int ex[16];
      float sum = 0.f;
#pragma unroll
      for (int j = 0; j < 16; ++j) {
        const int code = top[j] & 0xFF;
        const int i1 = lists[tid * 16 + (code >> 4)] & 0x7F;
        const int i2 = lists[(128 + tid) * 16 + (code & 15)] & 0x7F;
        ex[j] = i1 * 128 + i2;
      }
      const float mxv = sort2f(top[0] & ~0xFF);
      float ev[16];
#pragma unroll
      for (int j = 0; j < 16; ++j) { ev[j] = __expf(sort2f(top[j] & ~0xFF) - mxv); sum += ev[j]; }
      const float inv = 1.f / sum;
      const size_t ob = (size_t)(tok0 + tid) * 128 + h * 16;
#pragma unroll
      for (int j4 = 0; j4 < 4; ++j4) {
        int4 iv; iv.x = ex[j4 * 4]; iv.y = ex[j4 * 4 + 1]; iv.z = ex[j4 * 4 + 2]; iv.w = ex[j4 * 4 + 3];
        float4 gv; gv.x = ev[j4 * 4] * inv; gv.y = ev[j4 * 4 + 1] * inv; gv.z = ev[j4 * 4 + 2] * inv; gv.w = ev[j4 * 4 + 3] * inv;
        *(int4*)(p.idx + ob + j4 * 4) = iv;
        *(float4*)(p.gates + ob + j4 * 4) = gv;
      }
    }
  }
}

DI float gelu_tanh(float a) {
  const float u = 0.7978845608028654f * (a + 0.044715f * a * a * a);
  return 0.5f * a * (1.f + tanhf(u));
}

DI void phase_peer_expert(const Params& p) {
  const int lane = threadIdx.x & 63, wid = threadIdx.x >> 6;
  for (int tok = blockIdx.x * 8 + wid; tok < T_TOK; tok += gridDim.x * 8) {
    u32x4 hreg[4];
#pragma unroll
    for (int j = 0; j < 4; ++j) hreg[j] = *(const u32x4*)(p.hbuf + (size_t)tok * 2048 + j * 512 + lane * 8);
    float y[32];
#pragma unroll
    for (int e = 0; e < 32; ++e) y[e] = 0.f;
    for (int half = 0; half < 2; ++half) {
      const int myidx = p.idx[(size_t)tok * 128 + half * 64 + lane];
      const float mygate = p.gates[(size_t)tok * 128 + half * 64 + lane];
      float amine = 0.f;
      for (int g = 0; g < 8; ++g) {
        float part[8];
#pragma unroll
        for (int k = 0; k < 8; ++k) {
          const int e = __builtin_amdgcn_readlane(myidx, g * 8 + k);
          const bfr* row = p.wU + (size_t)e * 2048 + lane * 8;
          float a = 0.f;
#pragma unroll
          for (int j = 0; j < 4; ++j) {
            const u32x4 u = *(const u32x4*)(row + j * 512);
#pragma unroll
            for (int c = 0; c < 4; ++c) {
              const unsigned uu = u[c], hh = hreg[j][c];
              a = __builtin_amdgcn_fdot2_f32_bf16(__builtin_bit_cast(bf2, uu), __builtin_bit_cast(bf2, hh), a, false);
            }
          }
          part[k] = a;
          if (k == 3) __builtin_amdgcn_sched_barrier(0);
        }
        {
          const bool up4 = (lane & 4) != 0, up2 = (lane & 2) != 0, up1 = (lane & 1) != 0;
          float q[4];
#pragma unroll
          for (int i = 0; i < 4; ++i) {
            const float keep = up4 ? part[i + 4] : part[i];
            const float send = up4 ? part[i] : part[i + 4];
            q[i] = keep + __shfl_xor(send, 4);
          }
          float r[2];
#pragma unroll
          for (int i = 0; i < 2; ++i) {
            const float keep = up2 ? q[i + 2] : q[i];
            const float send = up2 ? q[i] : q[i + 2];
            r[i] = keep + __shfl_xor(send, 2);
          }
          float v = (up1 ? r[1] : r[0]) + __shfl_xor(up1 ? r[0] : r[1], 1);
          v += __shfl_xor(v, 8);
          v += __shfl_xor(v, 16);
          v += __shfl_xor(v, 32);
          if ((lane >> 3) == g) amine = v;
        }
      }
      const float cval = (ABL == 1) ? 0.f : mygate * gelu_tanh(amine);
      for (int g = 0; g < 8; ++g) {
#pragma unroll
        for (int k = 0; k < 8; ++k) {
          const int e = __builtin_amdgcn_readlane(myidx, g * 8 + k);
          const float ck = __builtin_bit_cast(float, __builtin_amdgcn_readlane(__builtin_bit_cast(int, cval), g * 8 + k));
          const bfr* row = p.wV + (size_t)e * 2048 + lane * 8;
#pragma unroll
          for (int j = 0; j < 4; ++j) {
            const u32x4 u = *(const u32x4*)(row + j * 512);
#pragma unroll
            for (int c = 0; c < 4; ++c) {
              y[j * 8 + c * 2] += ck * bflo(u[c]);
              y[j * 8 + c * 2 + 1] += ck * bfhi(u[c]);
            }
          }
          if (k == 3) __builtin_amdgcn_sched_barrier(0);
        }
      }
    }
    float ss = 0.f;
#pragma unroll
    for (int j = 0; j < 4; ++j) {
      const float4 a = *(const float4*)(p.xres + (size_t)tok * 2048 + j * 512 + lane * 8);
      const float4 b = *(const float4*)(p.xres + (size_t)tok * 2048 + j * 512 + lane * 8 + 4);
      y[j * 8 + 0] += a.x; y[j * 8 + 1] += a.y; y[j * 8 + 2] += a.z; y[j * 8 + 3] += a.w;
      y[j * 8 + 4] += b.x; y[j * 8 + 5] += b.y; y[j * 8 + 6] += b.z; y[j * 8 + 7] += b.w;
#pragma unroll
      for (int e = 0; e < 8; ++e) ss += y[j * 8 + e] * y[j * 8 + e];
    }
    ss = wave_sum(ss);
    const float rs = rsqrtf(ss * (1.f / 2048.f) + 1e-6f);
#pragma unroll
    for (int j = 0; j < 4; ++j) {
      const float4 ga = *(const float4*)(p.g_final + j * 512 + lane * 8);
      const float4 gb = *(const float4*)(p.g_final + j * 512 + lane * 8 + 4);
      float4 oa, ob;
      oa.x = y[j * 8 + 0] * rs * ga.x; oa.y = y[j * 8 + 1] * rs * ga.y; oa.z = y[j * 8 + 2] * rs * ga.z; oa.w = y[j * 8 + 3] * rs * ga.w;
      ob.x = y[j * 8 + 4] * rs * gb.x; ob.y = y[j * 8 + 5] * rs * gb.y; ob.z = y[j * 8 + 6] * rs * gb.z; ob.w = y[j * 8 + 7] * rs * gb.w;
      *(float4*)(p.out + (size_t)tok * 2048 + j * 512 + lane * 8) = oa;
      *(float4*)(p.out + (size_t)tok * 2048 + j * 512 + lane * 8 + 4) = ob;
    }
  }
}

__global__ void __launch_bounds__(NTHREADS) mega(Params p, int phase_lo, int phase_hi) {
  __shared__ __attribute__((aligned(16))) char smem[SMEM_BYTES];
  cg::grid_group grid = cg::this_grid();
#define PHASE(k, call) if (phase_lo <= (k) && (k) < phase_hi) { if ((k) > phase_lo) grid.sync(); call; }
  PHASE(0, phase_prep(p, smem))
  PHASE(1, phase_inproj(p, smem))
  PHASE(2, phase_mix_attn(p, smem))
  PHASE(3, phase_pool_combine(p, smem))
  PHASE(4, phase_gemm_resid(p.hbuf, 2048, p.wOutT, 2048, p.x, p.xres, smem))
  PHASE(5, phase_rms(p.xres, p.g_cross, p.hbuf))
  PHASE(6, phase_gemm_bf16(p.hbuf, 2048, p.wCqT, 2048, 512, 0.08838834764831845f, p.qc, smem))
  PHASE(7, phase_cross_attn(p, smem))
  if (ABL != 2) PHASE(8, phase_gemm_resid(p.oc, 512, p.wCoT, 512, p.xres, p.xres, smem))
  PHASE(9, phase_rms(p.xres, p.g_ffn, p.hbuf))
  PHASE(10, phase_gemm_bf16(p.hbuf, 2048, p.wPqT, 2048, 2048, 1.0f, p.pq, smem))
  PHASE(11, phase_peer_route(p, smem))
  PHASE(12, phase_peer_expert(p))
}

extern "C" void kernel_launch(void* const* d_in, const int* in_sizes, int n_in, void* d_out, int out_size, void* d_ws,
                              size_t ws_size, hipStream_t stream) {
  Params p{};
  p.x = (const float*)d_in[0]; p.mem = (const float*)d_in[1]; p.pos = (const int*)d_in[2];
  p.g_mix = (const float*)d_in[3]; p.w_in = (const float*)d_in[4]; p.w_pool = (const float*)d_in[5];
  p.pool_scale = (const float*)d_in[6]; p.w_out = (const float*)d_in[7]; p.g_cross = (const float*)d_in[8];
  p.g_mem = (const float*)d_in[9]; p.w_cq = (const float*)d_in[10]; p.w_ck = (const float*)d_in[11];
  p.w_cv = (const float*)d_in[12]; p.w_co = (const float*)d_in[13]; p.g_ffn = (const float*)d_in[14];
  p.w_pq = (const float*)d_in[15]; p.sk1f = (const float*)d_in[16]; p.sk2f = (const float*)d_in[17];
  p.w_u = (const float*)d_in[18]; p.w_v = (const float*)d_in[19]; p.g_final = (const float*)d_in[20];
  p.out = (float*)d_out;
  char* ws = (char*)d_ws;
  size_t off = 0;
  auto take = [&](size_t bytes) { char* r = ws + off; off += (bytes + 255) & ~(size_t)255; return r; };
  const size_t MB = 1024 * 1024;
  p.wInT = (bfr*)take(16 * MB); p.wPoolT = (bfr*)take(512 * 1024); p.wOutT = (bfr*)take(8 * MB);
  p.wCqT = (bfr*)take(2 * MB); p.wCkT = (bfr*)take(2 * MB); p.wCvT = (bfr*)take(2 * MB); p.wCoT = (bfr*)take(2 * MB);
  p.wPqT = (bfr*)take(8 * MB); p.sk1 = (bfr*)take(32768); p.sk2 = (bfr*)take(32768);
  p.wU = (bfr*)take(64 * MB); p.wV = (bfr*)take(64 * MB);
  p.memn = (bfr*)take(4 * MB); p.kc = (bfr*)take(1 * MB); p.vc = (bfr*)take(1 * MB);
  p.hbuf = (bfr*)take(64 * MB);
  const size_t r2 = off;
  p.qbuf = (bfr*)take(32 * MB); p.kbuf = (bfr*)take(32 * MB); p.vbuf = (bfr*)take(32 * MB);
  p.pbuf = (bfr*)take(32 * MB); p.mixed = (bfr*)take(32 * MB); p.ob = (bfr*)take(96 * MB);
  p.lse = (float*)take((size_t)3 * T_TOK * 8 * 4);
  const size_t end1 = off;
  off = r2;
  p.xres = (float*)take(128 * MB); p.pq = (bfr*)take(64 * MB); p.qc = (bfr*)take(16 * MB); p.oc = (bfr*)take(16 * MB);
  p.idx = (int*)take(8 * MB); p.gates = (float*)take(8 * MB);
  const size_t end2 = off;
  const size_t need = end1 > end2 ? end1 : end2;
  if (need > ws_size) { fprintf(stderr, "workspace too small: need %zu have %zu\n", need, ws_size); return; }

  static int grid_blocks = 0;
  if (!grid_blocks) {
    int dev = 0, cus = 0, per_cu = 0;
    hipGetDevice(&dev);
    hipDeviceGetAttribute(&cus, hipDeviceAttributeMultiprocessorCount, dev);
    hipOccupancyMaxActiveBlocksPerMultiprocessor(&per_cu, mega, NTHREADS, 0);
    if (per_cu < 1) per_cu = 1;
    if (per_cu > 1) per_cu = 1;
    grid_blocks = cus * per_cu;
  }
#if MULTI_LAUNCH
  for (int ph = 0; ph < NPHASE; ++ph) hipLaunchKernelGGL(mega, dim3(grid_blocks), dim3(NTHREADS), 0, stream, p, ph, ph + 1);
#else
  int lo = 0, hi = NPHASE;
  void* args[] = {&p, &lo, &hi};
  hipError_t e = hipLaunchCooperativeKernel((void*)mega, dim3(grid_blocks), dim3(NTHREADS), args, 0, stream);
  if (e != hipSuccess) fprintf(stderr, "cooperative launch failed: %s (grid %d)\n", hipGetErrorString(e), grid_blocks);
#endif
}
```

```cpp
#include <hip/hip_runtime.h>
#include <hip/hip_cooperative_groups.h>
#include <stdint.h>
#include <stdio.h>
namespace cg = cooperative_groups;

#ifndef ABL
#define ABL 0
#endif
#ifndef MULTI_LAUNCH
#define MULTI_LAUNCH 0
#endif

#define DI __device__ __forceinline__
typedef unsigned short bfr;
using bf16x8 = __attribute__((ext_vector_type(8))) short;
using s16x4  = __attribute__((ext_vector_type(4))) short;
using f32x4  = __attribute__((ext_vector_type(4))) float;
using u32x4  = __attribute__((ext_vector_type(4))) unsigned;
using u32x2  = __attribute__((ext_vector_type(2))) unsigned;
using bf2    = __attribute__((ext_vector_type(2))) __bf16;

constexpr int T_TOK = 16384;
constexpr int NTHREADS = 512;
constexpr int SMEM_BYTES = 151552;
constexpr int NPHASE = 13;

struct Params {
  const float *x, *mem; const int* pos;
  const float *g_mix, *w_in, *w_pool, *pool_scale, *w_out, *g_cross, *g_mem, *w_cq, *w_ck, *w_cv, *w_co, *g_ffn, *w_pq,
              *sk1f, *sk2f, *w_u, *w_v, *g_final;
  float* out;
  bfr *wInT, *wPoolT, *wOutT, *wCqT, *wCkT, *wCvT, *wCoT, *wPqT, *sk1, *sk2, *wU, *wV;
  bfr *hbuf, *memn, *kc, *vc;
  bfr *pbuf, *qbuf, *kbuf, *vbuf, *mixed, *ob; float* lse;
  float* xres; bfr *pq, *qc, *oc; int* idx; float* gates;
};

DI unsigned pack2(float a, float b) { bf2 p; p[0] = (__bf16)a; p[1] = (__bf16)b; return __builtin_bit_cast(unsigned, p); }
DI float bflo(unsigned u) { return __uint_as_float(u << 16); }
DI float bfhi(unsigned u) { return __uint_as_float(u & 0xffff0000u); }
DI float wave_sum(float v) {
#pragma unroll
  for (int o = 32; o >= 1; o >>= 1) v += __shfl_xor(v, o);
  return v;
}
DI f32x4 mfma16(bf16x8 a, bf16x8 b, f32x4 c) { return __builtin_amdgcn_mfma_f32_16x16x32_bf16(a, b, c, 0, 0, 0); }
DI s16x4 tr_read(const char* p) {
  return __builtin_amdgcn_ds_read_tr16_b64_v4i16((s16x4 __attribute__((address_space(3)))*)(p));
}

DI void gemm_main(const bfr* __restrict__ A, int lda, const bfr* __restrict__ Bt, int ldb, int K, char* smem,
                  f32x4 (&acc)[4][4]) {
  const int tid = threadIdx.x, lane = tid & 63, wid = tid >> 6, wm = wid >> 1, wn = wid & 1, fr = lane & 15, fq = lane >> 4;
  const int lrow = tid >> 3, lc = tid & 7;
  const int sw = ((lc ^ (lrow & 7)) << 4);
  u32x4 ra[4], rb[2];
  const bfr* ga = A + (size_t)lrow * lda + lc * 8;
  const bfr* gb = Bt + (size_t)lrow * ldb + lc * 8;
#pragma unroll
  for (int m = 0; m < 4; ++m)
#pragma unroll
    for (int n = 0; n < 4; ++n) acc[m][n] = f32x4{0.f, 0.f, 0.f, 0.f};
  const int nk = K >> 6;
#pragma unroll
  for (int i = 0; i < 4; ++i) ra[i] = *(const u32x4*)(ga + (size_t)(64 * i) * lda);
#pragma unroll
  for (int i = 0; i < 2; ++i) rb[i] = *(const u32x4*)(gb + (size_t)(64 * i) * ldb);
  __syncthreads();
#pragma unroll
  for (int i = 0; i < 4; ++i) *(u32x4*)(smem + (lrow + 64 * i) * 128 + sw) = ra[i];
#pragma unroll
  for (int i = 0; i < 2; ++i) *(u32x4*)(smem + 32768 + (lrow + 64 * i) * 128 + sw) = rb[i];
  __syncthreads();
  for (int kt = 0; kt < nk; ++kt) {
    const char* cur = smem + (kt & 1) * 49152;
    char* nxt = smem + ((kt + 1) & 1) * 49152;
    const bool more = (kt + 1 < nk);
    if (more) {
#pragma unroll
      for (int i = 0; i < 4; ++i) ra[i] = *(const u32x4*)(ga + (size_t)(64 * i) * lda + (kt + 1) * 64);
#pragma unroll
      for (int i = 0; i < 2; ++i) rb[i] = *(const u32x4*)(gb + (size_t)(64 * i) * ldb + (kt + 1) * 64);
    }
#pragma unroll
    for (int kk = 0; kk < 2; ++kk) {
      bf16x8 af[4], bf[4];
      const int co = (((kk * 4 + fq) ^ (fr & 7)) << 4);
#pragma unroll
      for (int m = 0; m < 4; ++m) af[m] = *(const bf16x8*)(cur + (wm * 64 + m * 16 + fr) * 128 + co);
#pragma unroll
      for (int n = 0; n < 4; ++n) bf[n] = *(const bf16x8*)(cur + 32768 + (wn * 64 + n * 16 + fr) * 128 + co);
#pragma unroll
      for (int m = 0; m < 4; ++m)
#pragma unroll
        for (int n = 0; n < 4; ++n) acc[m][n] = mfma16(bf[n], af[m], acc[m][n]);
    }
    if (more) {
#pragma unroll
      for (int i = 0; i < 4; ++i) *(u32x4*)(nxt + (lrow + 64 * i) * 128 + sw) = ra[i];
#pragma unroll
      for (int i = 0; i < 2; ++i) *(u32x4*)(nxt + 32768 + (lrow + 64 * i) * 128 + sw) = rb[i];
    }
    __syncthreads();
  }
}

DI void tile_map(int id, int MT, int NT, int& mt, int& nt) {
  if ((NT & 7) == 0 && (MT & 31) == 0) {
    const int round = id >> 8, local = id & 255, xcd = local & 7, j = local >> 3, mtl = j & 3, ntl = j >> 2;
    const int MR = MT >> 5;
    const int mr = round % MR, nr = round / MR;
    mt = mr * 32 + xcd * 4 + mtl;
    nt = nr * 8 + ntl;
  } else {
    mt = id % MT;
    nt = id / MT;
  }
}

template <bool BANDED, class StoreF>
DI void attn_core(const bfr* __restrict__ Qb, int qstride, int q0, const bfr* __restrict__ Kb, const bfr* __restrict__ Vb,
                  int kvstride, int key0, char* smem, StoreF store, float& m_out, float& l_out) {
  const int tid = threadIdx.x, lane = tid & 63, w = tid >> 6, fr = lane & 15, fq = lane >> 4;
  char* sK = smem;
  char* sV = smem + 65536;
  __syncthreads();
#pragma unroll 1
  for (int rr = 0; rr < 2; ++rr) {
    u32x4 kr[4], vr[4];
#pragma unroll
    for (int i = 0; i < 4; ++i) {
      const int id = tid + (rr * 4 + i) * 512, key = id >> 4, c = id & 15, lk = key0 + key;
      kr[i] = u32x4{0u, 0u, 0u, 0u};
      vr[i] = u32x4{0u, 0u, 0u, 0u};
      if (lk >= 0) {
        kr[i] = *(const u32x4*)(Kb + (long)lk * kvstride + c * 8);
        vr[i] = *(const u32x4*)(Vb + (long)lk * kvstride + c * 8);
      }
    }
#pragma unroll
    for (int i = 0; i < 4; ++i) {
      const int id = tid + (rr * 4 + i) * 512, key = id >> 4, c = id & 15;
      *(u32x4*)(sK + key * 256 + ((c ^ (key & 15)) << 4)) = kr[i];
      *(u32x4*)(sV + key * 288 + c * 16) = vr[i];
    }
  }
  bf16x8 qf[4];
  {
    const bfr* qrow = Qb + (long)(q0 + w * 16 + fr) * qstride;
#pragma unroll
    for (int kk = 0; kk < 4; ++kk) qf[kk] = *(const bf16x8*)(qrow + kk * 32 + fq * 8);
  }
  __syncthreads();
  constexpr int NT = BANDED ? 10 : 16;
  const int t0 = BANDED ? (w & ~1) : 0;
  f32x4 s[NT];
#pragma unroll
  for (int j = 0; j < NT; ++j) {
    f32x4 a = f32x4{0.f, 0.f, 0.f, 0.f};
    const int key = (t0 + j) * 16 + fr;
#pragma unroll
    for (int kk = 0; kk < 4; ++kk) {
      const bf16x8 kf = *(const bf16x8*)(sK + key * 256 + (((kk * 4 + fq) ^ fr) << 4));
      a = mfma16(kf, qf[kk], a);
    }
    s[j] = a;
  }
  const float L2E = 1.4426950408889634f;
  const float NINF = -__builtin_inff();
  float mx = NINF;
  const int lq = q0 + w * 16 + fr;
#pragma unroll
  for (int j = 0; j < NT; ++j)
#pragma unroll
    for (int i = 0; i < 4; ++i) {
      float v = s[j][i] * L2E;
      if (BANDED) {
        const int lk = key0 + (t0 + j) * 16 + fq * 4 + i;
        const int dist = lq - lk;
        const bool ok = (lk >= 0) && (dist >= 0) && (dist <= 128);
        v = ok ? v : NINF;
      }
      s[j][i] = v;
      mx = fmaxf(mx, v);
    }
  mx = fmaxf(mx, __shfl_xor(mx, 16));
  mx = fmaxf(mx, __shfl_xor(mx, 32));
  float l = 0.f;
#pragma unroll
  for (int j = 0; j < NT; ++j)
#pragma unroll
    for (int i = 0; i < 4; ++i) {
      const float p = __builtin_amdgcn_exp2f(s[j][i] - mx);
      s[j][i] = p;
      l += p;
    }
  l += __shfl_xor(l, 16);
  l += __shfl_xor(l, 32);
  bf16x8 pf[NT / 2];
#pragma unroll
  for (int c = 0; c < NT / 2; ++c) {
    u32x4 t;
    t[0] = pack2(s[2 * c][0], s[2 * c][1]);
    t[1] = pack2(s[2 * c][2], s[2 * c][3]);
    t[2] = pack2(s[2 * c + 1][0], s[2 * c + 1][1]);
    t[3] = pack2(s[2 * c + 1][2], s[2 * c + 1][3]);
    pf[c] = __builtin_bit_cast(bf16x8, t);
  }
  const int q4 = (lane & 15) >> 2, p4 = lane & 3;
  m_out = mx;
  l_out = l;
#pragma unroll 2
  for (int dt = 0; dt < 8; ++dt) {
    f32x4 a = f32x4{0.f, 0.f, 0.f, 0.f};
#pragma unroll
    for (int c = 0; c < NT / 2; ++c) {
      const int kb = (t0 + 2 * c) * 16;
      const s16x4 lo = tr_read(sV + (kb + fq * 4 + q4) * 288 + (dt * 16 + p4 * 4) * 2);
      const s16x4 hi = tr_read(sV + (kb + 16 + fq * 4 + q4) * 288 + (dt * 16 + p4 * 4) * 2);
      const bf16x8 vf = __builtin_shufflevector(lo, hi, 0, 1, 2, 3, 4, 5, 6, 7);
      a = mfma16(vf, pf[c], a);
    }
    store(dt, a, l);
  }
}

DI int f2sort(float f) { int b = __float_as_int(f); return b ^ ((b >> 31) & 0x7fffffff); }
DI float sort2f(int s) { int b = s ^ ((s >> 31) & 0x7fffffff); return __int_as_float(b); }
DI void topk_insert(int (&lst)[16], int key) {
#pragma unroll
  for (int j = 0; j < 16; ++j) {
    const int hi = max(lst[j], key);
    key = min(lst[j], key);
    lst[j] = hi;
  }
}

template <int O, int N>
DI void bfly(float (&p)[64], int lane) {
  const bool up = (lane & O) != 0;
#pragma unroll
  for (int i = 0; i < N / 2; ++i) {
    const float keep = up ? p[i + N / 2] : p[i];
    const float send = up ? p[i] : p[i + N / 2];
    p[i] = keep + __shfl_xor(send, O);
  }
  if constexpr (O > 1) bfly<O / 2, N / 2>(p, lane);
}

DI void rms_row_to_bf16(const float* __restrict__ x, const float* __restrict__ g, bfr* __restrict__ out, int lane) {
  float4 v[8];
  float ss = 0.f;
#pragma unroll
  for (int j = 0; j < 8; ++j) {
    v[j] = *(const float4*)(x + j * 256 + lane * 4);
    ss += v[j].x * v[j].x + v[j].y * v[j].y + v[j].z * v[j].z + v[j].w * v[j].w;
  }
  ss = wave_sum(ss);
  const float rs = rsqrtf(ss * (1.f / 2048.f) + 1e-6f);
#pragma unroll
  for (int j = 0; j < 8; ++j) {
    const float4 gg = *(const float4*)(g + j * 256 + lane * 4);
    u32x2 o;
    o[0] = pack2(v[j].x * rs * gg.x, v[j].y * rs * gg.y);
    o[1] = pack2(v[j].z * rs * gg.z, v[j].w * rs * gg.w);
    *(u32x2*)(out + j * 256 + lane * 4) = o;
  }
}

DI void transpose_tile(const float* __restrict__ W, int K, int N, int k0, int n0, bfr* __restrict__ Wt, float* tile) {
  __syncthreads();
  {
    const int r = threadIdx.x >> 4, c4 = threadIdx.x & 15;
#pragma unroll
    for (int i = 0; i < 2; ++i) {
      const int k = r + 32 * i;
      const float4 v = *(const float4*)(W + (size_t)(k0 + k) * N + n0 + c4 * 4);
      tile[k * 65 + c4 * 4 + 0] = v.x;
      tile[k * 65 + c4 * 4 + 1] = v.y;
      tile[k * 65 + c4 * 4 + 2] = v.z;
      tile[k * 65 + c4 * 4 + 3] = v.w;
    }
  }
  __syncthreads();
  {
    const int n = threadIdx.x >> 3, kc = threadIdx.x & 7;
    u32x4 o;
#pragma unroll
    for (int j = 0; j < 4; ++j) o[j] = pack2(tile[(kc * 8 + 2 * j) * 65 + n], tile[(kc * 8 + 2 * j + 1) * 65 + n]);
    *(u32x4*)(Wt + (size_t)(n0 + n) * K + k0 + kc * 8) = o;
  }
}

DI void convert_f32_bf16(const float* __restrict__ src, bfr* __restrict__ dst, long n8) {
  for (long i = (long)blockIdx.x * NTHREADS + threadIdx.x; i < n8; i += (long)gridDim.x * NTHREADS) {
    const float4 a = *(const float4*)(src + i * 8);
    const float4 b = *(const float4*)(src + i * 8 + 4);
    u32x4 o;
    o[0] = pack2(a.x, a.y); o[1] = pack2(a.z, a.w); o[2] = pack2(b.x, b.y); o[3] = pack2(b.z, b.w);
    *(u32x4*)(dst + i * 8) = o;
  }
}

DI void phase_prep(const Params& p, char* smem) {
  const int lane = threadIdx.x & 63, wid = threadIdx.x >> 6;
  for (int r = blockIdx.x * 8 + wid; r < T_TOK + 1024; r += gridDim.x * 8) {
    if (r < T_TOK) rms_row_to_bf16(p.x + (size_t)r * 2048, p.g_mix, p.hbuf + (size_t)r * 2048, lane);
    else rms_row_to_bf16(p.mem + (size_t)(r - T_TOK) * 2048, p.g_mem, p.memn + (size_t)(r - T_TOK) * 2048, lane);
  }
  float* tile = (float*)smem;
  for (int id0 = blockIdx.x; id0 < 5184; id0 += gridDim.x) {
    int id = id0;
    const float* W; bfr* Wt; int K, N;
    if (id < 2048) { W = p.w_in; Wt = p.wInT; K = 2048; N = 4096; }
    else if ((id -= 2048) < 1024) { W = p.w_out; Wt = p.wOutT; K = 2048; N = 2048; }
    else if ((id -= 1024) < 1024) { W = p.w_pq; Wt = p.wPqT; K = 2048; N = 2048; }
    else if ((id -= 1024) < 256) { W = p.w_cq; Wt = p.wCqT; K = 2048; N = 512; }
    else if ((id -= 256) < 256) { W = p.w_ck; Wt = p.wCkT; K = 2048; N = 512; }
    else if ((id -= 256) < 256) { W = p.w_cv; Wt = p.wCvT; K = 2048; N = 512; }
    else if ((id -= 256) < 256) { W = p.w_co; Wt = p.wCoT; K = 512; N = 2048; }
    else { id -= 256; const int g = id >> 4; id &= 15; W = p.w_pool + g * 65536; Wt = p.wPoolT + g * 65536; K = 256; N = 256; }
    const int ntn = N >> 6;
    const int kt = id / ntn, nt = id % ntn;
    transpose_tile(W, K, N, kt * 64, nt * 64, Wt, tile);
  }
  convert_f32_bf16(p.sk1f, p.sk1, 128 * 128 / 8);
  convert_f32_bf16(p.sk2f, p.sk2, 128 * 128 / 8);
  convert_f32_bf16(p.w_u, p.wU, (long)16384 * 2048 / 8);
  convert_f32_bf16(p.w_v, p.wV, (long)16384 * 2048 / 8);
}

DI void phase_inproj(const Params& p, char* smem) {
  const int tid = threadIdx.x, lane = tid & 63, wid = tid >> 6, wm = wid >> 1, wn = wid & 1, fr = lane & 15, fq = lane >> 4;
  f32x4 acc[4][4];
  for (int id = blockIdx.x; id < 2048 + 32; id += gridDim.x) {
    if (id < 2048) {
      int mt, nt;
      tile_map(id, 64, 32, mt, nt);
      gemm_main(p.hbuf + (size_t)mt * 256 * 2048, 2048, p.wInT + (size_t)nt * 128 * 2048, 2048, 2048, smem, acc);
      const int region = nt >> 3, h = nt & 7;
      if (region == 0) {
#pragma unroll
        for (int m = 0; m < 4; ++m) {
          const int row = mt * 256 + wm * 64 + m * 16 + fr;
#pragma unroll
          for (int n = 0; n < 4; ++n) {
            const int col = nt * 128 + wn * 64 + n * 16 + fq * 4;
            u32x2 o; o[0] = pack2(acc[m][n][0], acc[m][n][1]); o[1] = pack2(acc[m][n][2], acc[m][n][3]);
            *(u32x2*)(p.pbuf + (size_t)row * 1024 + col) = o;
          }
        }
      } else {
        bfr* dst = (region == 1) ? p.qbuf : (region == 2 ? p.kbuf : p.vbuf);
        const float scale = (region == 1) ? 0.08838834764831845f : 1.0f;
#pragma unroll
        for (int m = 0; m < 4; ++m) {
          const int row = mt * 256 + wm * 64 + m * 16 + fr;
          const int b = row >> 12, t = row & 4095;
          if (region != 3 && wn == 0) {
            const float posf = (float)p.pos[row];
#pragma unroll
            for (int i = 0; i < 4; ++i) {
              const int j = fq * 4 + i;
              const float inv = exp2f(-(float)j * (18.931568569324174f / 16.0f));
              float sn, cs;
              sincosf(posf * inv, &sn, &cs);
              const float x1 = acc[m][0][i], x2 = acc[m][1][i];
              acc[m][0][i] = x1 * cs - x2 * sn;
              acc[m][1][i] = x2 * cs + x1 * sn;
            }
          }
#pragma unroll
          for (int n = 0; n < 4; ++n) {
            const int d = wn * 64 + n * 16 + fq * 4;
            u32x2 o;
            o[0] = pack2(acc[m][n][0] * scale, acc[m][n][1] * scale);
            o[1] = pack2(acc[m][n][2] * scale, acc[m][n][3] * scale);
            *(u32x2*)(dst + ((size_t)((b * 8 + h) * 4096 + t)) * 128 + d) = o;
          }
        }
      }
    } else {
      const int id2 = id - 2048;
      const int which = id2 >> 4, mt = (id2 >> 2) & 3, nt = id2 & 3;
      const bfr* Bt = (which == 0 ? p.wCkT : p.wCvT) + (size_t)nt * 128 * 2048;
      bfr* dst = which == 0 ? p.kc : p.vc;
      gemm_main(p.memn + (size_t)mt * 256 * 2048, 2048, Bt, 2048, 2048, smem, acc);
#pragma unroll
      for (int m = 0; m < 4; ++m) {
        const int row = mt * 256 + wm * 64 + m * 16 + fr;
        const int b = row >> 8, mm = row & 255;
#pragma unroll
        for (int n = 0; n < 4; ++n) {
          const int d = wn * 64 + n * 16 + fq * 4;
          u32x2 o; o[0] = pack2(acc[m][n][0], acc[m][n][1]); o[1] = pack2(acc[m][n][2], acc[m][n][3]);
          *(u32x2*)(dst + ((size_t)((b * 4 + nt) * 256 + mm)) * 128 + d) = o;
        }
      }
    }
  }
}

DI void phase_mix_attn(const Params& p, char* smem) {
  const int tid = threadIdx.x, lane = tid & 63, w = tid >> 6, fr = lane & 15, fq = lane >> 4;
  for (int id = blockIdx.x; id < 3072 + 256; id += gridDim.x) {
    if (id < 3072) {
      const int br = id >> 10, rem = id & 1023;
      const int dl = (br == 0) ? 1 : (br == 1 ? 4 : 16);
      const int nblk = 32 / dl;
      const int bh = rem >> 5, rn = rem & 31;
      const int r = rn / nblk, nb = rn % nblk;
      const int l0 = nb * 128;
      const size_t base = (size_t)bh * 4096 * 128 + (size_t)r * 128;
      float mx, l;
      const int b = bh >> 3, h = bh & 7;
      const int tt = b * 4096 + (l0 + w * 16 + fr) * dl + r;
      bfr* dst = p.ob + (size_t)br * T_TOK * 1024 + (size_t)tt * 1024 + h * 128 + fq * 4;
      attn_core<true>(p.qbuf + base, dl * 128, l0, p.kbuf + base, p.vbuf + base, dl * 128, l0 - 128, smem,
                      [&](int dt, f32x4 a, float lsum) {
                        const float il = 1.f / lsum;
                        u32x2 v; v[0] = pack2(a[0] * il, a[1] * il); v[1] = pack2(a[2] * il, a[3] * il);
                        *(u32x2*)(dst + dt * 16) = v;
                      }, mx, l);
      if (fq == 0) p.lse[(size_t)br * T_TOK * 8 + (size_t)tt * 8 + h] = mx + __builtin_amdgcn_logf(l);
    } else {
      const int ci = id - 3072;
      const int sub = tid >> 7, cgp = tid & 127;
      const int wdw = 2 << (cgp >> 5);
      const int t0 = ci * 64 + sub * 16, tin0 = t0 & 4095;
      const bfr* pb = p.pbuf + cgp * 8;
      float sum[8];
#pragma unroll
      for (int e = 0; e < 8; ++e) sum[e] = 0.f;
      for (int j = 1; j < wdw; ++j) {
        if (tin0 - j >= 0) {
          const u32x4 v = *(const u32x4*)(pb + (size_t)(t0 - j) * 1024);
#pragma unroll
          for (int e = 0; e < 4; ++e) { sum[2 * e] += bflo(v[e]); sum[2 * e + 1] += bfhi(v[e]); }
        }
      }
      for (int s = 0; s < 16; ++s) {
        const int t = t0 + s, tin = tin0 + s;
        const u32x4 v = *(const u32x4*)(pb + (size_t)t * 1024);
        float cur[8];
#pragma unroll
        for (int e = 0; e < 4; ++e) { cur[2 * e] = bflo(v[e]); cur[2 * e + 1] = bfhi(v[e]); }
        const float ic = 1.f / (float)min(tin + 1, wdw);
        u32x4 ov;
#pragma unroll
        for (int e = 0; e < 8; ++e) sum[e] += cur[e];
#pragma unroll
        for (int e = 0; e < 4; ++e) ov[e] = pack2(sum[2 * e] * ic - cur[2 * e], sum[2 * e + 1] * ic - cur[2 * e + 1]);
        *(u32x4*)(p.mixed + (size_t)t * 1024 + cgp * 8) = ov;
        if (tin - wdw + 1 >= 0) {
          const u32x4 u = *(const u32x4*)(pb + (size_t)(t - wdw + 1) * 1024);
#pragma unroll
          for (int e = 0; e < 4; ++e) { sum[2 * e] -= bflo(u[e]); sum[2 * e + 1] -= bfhi(u[e]); }
        }
      }
    }
  }
}

DI void phase_pool_combine(const Params& p, char* smem) {
  const int tid = threadIdx.x, lane = tid & 63, wid = tid >> 6, wm = wid >> 1, wn = wid & 1, fr = lane & 15, fq = lane >> 4;
  f32x4 acc[4][4];
  for (int id = blockIdx.x; id < 512; id += gridDim.x) {
    const int g = id >> 7, mt = (id >> 1) & 63, nt = id & 1;
    gemm_main(p.mixed + (size_t)mt * 256 * 1024 + g * 256, 1024, p.wPoolT + (size_t)g * 65536 + (size_t)nt * 128 * 256, 256, 256,
              smem, acc);
#pragma unroll
    for (int m = 0; m < 4; ++m) {
      const int row = mt * 256 + wm * 64 + m * 16 + fr;
#pragma unroll
      for (int n = 0; n < 4; ++n) {
        const int e = nt * 128 + wn * 64 + n * 16 + fq * 4;
        const float4 sc = *(const float4*)(p.pool_scale + g * 256 + e);
        u32x2 o; o[0] = pack2(acc[m][n][0] * sc.x, acc[m][n][1] * sc.y); o[1] = pack2(acc[m][n][2] * sc.z, acc[m][n][3] * sc.w);
        *(u32x2*)(p.hbuf + (size_t)row * 2048 + g * 256 + e) = o;
      }
    }
  }
  for (long i = (long)blockIdx.x * NTHREADS + tid; i < (long)T_TOK * 8 * 16; i += (long)gridDim.x * NTHREADS) {
    const int dc = (int)(i & 15), h = (int)((i >> 4) & 7);
    const long tt = i >> 7;
    const float l0 = p.lse[tt * 8 + h], l1 = p.lse[(size_t)T_TOK * 8 + tt * 8 + h], l2 = p.lse[(size_t)2 * T_TOK * 8 + tt * 8 + h];
    const float mx = fmaxf(l0, fmaxf(l1, l2));
    float w0 = __builtin_amdgcn_exp2f(l0 - mx), w1 = __builtin_amdgcn_exp2f(l1 - mx), w2 = __builtin_amdgcn_exp2f(l2 - mx);
    const float inv = 1.f / (w0 + w1 + w2);
    w0 *= inv; w1 *= inv; w2 *= inv;
    if (ABL == 3) { w0 = 0.f; w1 = 0.f; w2 = 0.f; }
    const size_t off = (size_t)tt * 1024 + h * 128 + dc * 8;
    const u32x4 a = *(const u32x4*)(p.ob + off);
    const u32x4 b = *(const u32x4*)(p.ob + (size_t)T_TOK * 1024 + off);
    const u32x4 c = *(const u32x4*)(p.ob + (size_t)2 * T_TOK * 1024 + off);
    u32x4 o;
#pragma unroll
    for (int e = 0; e < 4; ++e)
      o[e] = pack2(w0 * bflo(a[e]) + w1 * bflo(b[e]) + w2 * bflo(c[e]), w0 * bfhi(a[e]) + w1 * bfhi(b[e]) + w2 * bfhi(c[e]));
    *(u32x4*)(p.hbuf + (size_t)tt * 2048 + 1024 + h * 128 + dc * 8) = o;
  }
}

DI void phase_gemm_resid(const bfr* A, int lda, const bfr* Bt, int K, const float* resid, float* xout, char* smem) {
  const int tid = threadIdx.x, lane = tid & 63, wid = tid >> 6, wm = wid >> 1, wn = wid & 1, fr = lane & 15, fq = lane >> 4;
  f32x4 acc[4][4];
  for (int id = blockIdx.x; id < 1024; id += gridDim.x) {
    int mt, nt;
    tile_map(id, 64, 16, mt, nt);
    gemm_main(A + (size_t)mt * 256 * lda, lda, Bt + (size_t)nt * 128 * K, K, K, smem, acc);
#pragma unroll
    for (int m = 0; m < 4; ++m) {
      const int row = mt * 256 + wm * 64 + m * 16 + fr;
#pragma unroll
      for (int n = 0; n < 4; ++n) {
        const int col = nt * 128 + wn * 64 + n * 16 + fq * 4;
        const float4 r = *(const float4*)(resid + (size_t)row * 2048 + col);
        float4 o; o.x = r.x + acc[m][n][0]; o.y = r.y + acc[m][n][1]; o.z = r.z + acc[m][n][2]; o.w = r.w + acc[m][n][3];
        *(float4*)(xout + (size_t)row * 2048 + col) = o;
      }
    }
  }
}

DI void phase_rms(const float* xin, const float* g, bfr* out) {
  const int lane = threadIdx.x & 63, wid = threadIdx.x >> 6;
  for (int r = blockIdx.x * 8 + wid; r < T_TOK; r += gridDim.x * 8)
    rms_row_to_bf16(xin + (size_t)r * 2048, g, out + (size_t)r * 2048, lane);
}

DI void phase_gemm_bf16(const bfr* A, int lda, const bfr* Bt, int K, int N, float scale, bfr* out, char* smem) {
  const int tid = threadIdx.x, lane = tid & 63, wid = tid >> 6, wm = wid >> 1, wn = wid & 1, fr = lane & 15, fq = lane >> 4;
  f32x4 acc[4][4];
  const int NT = N >> 7;
  for (int id = blockIdx.x; id < 64 * NT; id += gridDim.x) {
    int mt, nt;
    tile_map(id, 64, NT, mt, nt);
    gemm_main(A + (size_t)mt * 256 * lda, lda, Bt + (size_t)nt * 128 * K, K, K, smem, acc);
#pragma unroll
    for (int m = 0; m < 4; ++m) {
      const int row = mt * 256 + wm * 64 + m * 16 + fr;
#pragma unroll
      for (int n = 0; n < 4; ++n) {
        const int col = nt * 128 + wn * 64 + n * 16 + fq * 4;
        u32x2 o; o[0] = pack2(acc[m][n][0] * scale, acc[m][n][1] * scale); o[1] = pack2(acc[m][n][2] * scale, acc[m][n][3] * scale);
        *(u32x2*)(out + (size_t)row * N + col) = o;
      }
    }
  }
}

DI void phase_cross_attn(const Params& p, char* smem) {
  const int tid = threadIdx.x, lane = tid & 63, w = tid >> 6, fr = lane & 15, fq = lane >> 4;
  for (int id = blockIdx.x; id < 512; id += gridDim.x) {
    const int b = id >> 7, h = (id >> 5) & 3, qt = id & 31;
    float mx, l;
    const size_t kvb = (size_t)(b * 4 + h) * 256 * 128;
    bfr* dst = p.oc + (size_t)(b * 4096 + qt * 128 + w * 16 + fr) * 512 + h * 128 + fq * 4;
    attn_core<false>(p.qc + (size_t)b * 4096 * 512 + h * 128, 512, qt * 128, p.kc + kvb, p.vc + kvb, 128, 0, smem,
                     [&](int dt, f32x4 a, float lsum) {
                       const float il = 1.f / lsum;
                       u32x2 v; v[0] = pack2(a[0] * il, a[1] * il); v[1] = pack2(a[2] * il, a[3] * il);
                       *(u32x2*)(dst + dt * 16) = v;
                     }, mx, l);
  }
}

DI void phase_peer_route(const Params& p, char* smem) {
  const int tid = threadIdx.x, lane = tid & 63, w = tid >> 6, fr = lane & 15, fq = lane >> 4;
  float* scores = (float*)smem;
  int* lists = (int*)(smem + 135168);
  for (int id = blockIdx.x; id < 1024; id += gridDim.x) {
    const int tt = id >> 3, h = id & 7;
    const int tok0 = tt * 128;
    __syncthreads();
#pragma unroll
    for (int hf = 0; hf < 2; ++hf) {
      const bfr* arow = p.pq + (size_t)(tok0 + w * 16 + fr) * 2048 + h * 256 + hf * 128;
      bf16x8 af[4];
#pragma unroll
      for (int kk = 0; kk < 4; ++kk) af[kk] = *(const bf16x8*)(arow + kk * 32 + fq * 8);
      const bfr* sk = hf ? p.sk2 : p.sk1;
#pragma unroll
      for (int nt = 0; nt < 8; ++nt) {
        f32x4 a = f32x4{0.f, 0.f, 0.f, 0.f};
#pragma unroll
        for (int kk = 0; kk < 4; ++kk) {
          const bf16x8 bfg = *(const bf16x8*)(sk + (nt * 16 + fr) * 128 + kk * 32 + fq * 8);
          a = mfma16(af[kk], bfg, a);
        }
#pragma unroll
        for (int i = 0; i < 4; ++i) scores[(hf * 128 + w * 16 + fq * 4 + i) * 132 + nt * 16 + fr] = a[i];
      }
    }
    __syncthreads();
    if (tid < 256) {
      int lst[16];
#pragma unroll
      for (int j = 0; j < 16; ++j) lst[j] = (int)0x80000000;
      const float* srow = scores + tid * 132;
      for (int k4 = 0; k4 < 32; ++k4) {
        const float4 v = *(const float4*)(srow + k4 * 4);
        topk_insert(lst, (f2sort(v.x) & ~0x7F) | (k4 * 4 + 0));
        topk_insert(lst, (f2sort(v.y) & ~0x7F) | (k4 * 4 + 1));
        topk_insert(lst, (f2sort(v.z) & ~0x7F) | (k4 * 4 + 2));
        topk_insert(lst, (f2sort(v.w) & ~0x7F) | (k4 * 4 + 3));
      }
#pragma unroll
      for (int j = 0; j < 16; ++j) lists[tid * 16 + j] = lst[j];
    }
    __syncthreads();
    if (tid < 128) {
      float v1[16], v2[16];
#pragma unroll
      for (int j = 0; j < 16; ++j) {
        v1[j] = sort2f(lists[tid * 16 + j] & ~0x7F);
        v2[j] = sort2f(lists[(128 + tid) * 16 + j] & ~0x7F);
      }
      int top[16];
#pragma unroll
      for (int j = 0; j < 16; ++j) top[j] = (int)0x80000000;
#pragma unroll
      for (int a = 0; a < 16; ++a)
#pragma unroll
        for (int b = 0; b < 16; ++b)
          if ((a + 1) * (b + 1) <= 16) topk_insert(top, (f2sort(v1[a] + v2[b]) & ~0xFF) | (a * 16 + b));
      int ex[16];
      float sum = 0.f;
#pragma unroll
      for (int j = 0; j < 16; ++j) {
        const int code = top[j] & 0xFF;
        const int i1 = lists[tid * 16 + (code >> 4)] & 0x7F;
        const int i2 = lists[(128 + tid) * 16 + (code & 15)] & 0x7F;
        ex[j] = i1 * 128 + i2;
      }
      const float mxv = sort2f(top[0] & ~0xFF);
      float ev[16];
#pragma unroll
      for (int j = 0; j < 16; ++j) { ev[j] = __expf(sort2f(top[j] & ~0xFF) - mxv); sum += ev[j]; }
      const float inv = 1.f / sum;
      const size_t ob = (size_t)(tok0 + tid) * 128 + h * 16;
#pragma unroll
      for (int j4 = 0; j4 < 4; ++j4) {
        int4 iv; iv.x = ex[j4 * 4]; iv.y = ex[j4 * 4 + 1]; iv.z = ex[j4 * 4 + 2]; iv.w = ex[j4 * 4 + 3];
        float4 gv; gv.x = ev[j4 * 4] * inv; gv.y = ev[j4 * 4 + 1] * inv; gv.z = ev[j4 * 4 + 2] * inv; gv.w = ev[j4 * 4 + 3] * inv;
        *(int4*)(p.idx + ob + j4 * 4) = iv;
        *(float4*)(p.gates + ob + j4 * 4) = gv;
      }
    }
  }
}

DI float gelu_tanh(float a) {
  const float u = 0.7978845608028654f * (a + 0.044715f * a * a * a);
  return 0.5f * a * (1.f + tanhf(u));
}

DI void phase_peer_expert(const Params& p) {
  const int lane = threadIdx.x & 63, wid = threadIdx.x >> 6;
  for (int tok = blockIdx.x * 8 + wid; tok < T_TOK; tok += gridDim.x * 8) {
    u32x4 hreg[4];
#pragma unroll
    for (int j = 0; j < 4; ++j) hreg[j] = *(const u32x4*)(p.hbuf + (size_t)tok * 2048 + j * 512 + lane * 8);
    float y[32];
#pragma unroll
    for (int e = 0; e < 32; ++e) y[e] = 0.f;
    for (int half = 0; half < 2; ++half) {
      const int myidx = p.idx[(size_t)tok * 128 + half * 64 + lane];
      const float mygate = p.gates[(size_t)tok * 128 + half * 64 + lane];
      float amine = 0.f;
      for (int g = 0; g < 8; ++g) {
        float part[8];
#pragma unroll
        for (int k = 0; k < 8; ++k) {
          const int e = __builtin_amdgcn_readlane(myidx, g * 8 + k);
          const bfr* row = p.wU + (size_t)e * 2048 + lane * 8;
          float a = 0.f;
#pragma unroll
          for (int j = 0; j < 4; ++j) {
            const u32x4 u = *(const u32x4*)(row + j * 512);
#pragma unroll
            for (int c = 0; c < 4; ++c) {
              const unsigned uu = u[c], hh = hreg[j][c];
              a = __builtin_amdgcn_fdot2_f32_bf16(__builtin_bit_cast(bf2, uu), __builtin_bit_cast(bf2, hh), a, false);
            }
          }
          part[k] = a;
          if (k == 3) __builtin_amdgcn_sched_barrier(0);
        }
        {
          const bool up4 = (lane & 4) != 0, up2 = (lane & 2) != 0, up1 = (lane & 1) != 0;
          float q[4];
#pragma unroll
          for (int i = 0; i < 4; ++i) {
            const float keep = up4 ? part[i + 4] : part[i];
            const float send = up4 ? part[i] : part[i + 4];
            q[i] = keep + __shfl_xor(send, 4);
          }
          float r[2];
#pragma unroll
          for (int i = 0; i < 2; ++i) {
            const float keep = up2 ? q[i + 2] : q[i];
            const float send = up2 ? q[i] : q[i + 2];
            r[i] = keep + __shfl_xor(send, 2);
          }
          float v = (up1 ? r[1] : r[0]) + __shfl_xor(up1 ? r[0] : r[1], 1);
          v += __shfl_xor(v, 8);
          v += __shfl_xor(v, 16);
          v += __shfl_xor(v, 32);
          if ((lane >> 3) == g) amine = v;
        }
      }
      const float cval = (ABL == 1) ? 0.f : mygate * gelu_tanh(amine);
      for (int g = 0; g < 8; ++g) {
#pragma unroll
        for (int k = 0; k < 8; ++k) {
          const int e = __builtin_amdgcn_readlane(myidx, g * 8 + k);
          const float ck = __builtin_bit_cast(float, __builtin_amdgcn_readlane(__builtin_bit_cast(int, cval), g * 8 + k));
          const bfr* row = p.wV + (size_t)e * 2048 + lane * 8;
#pragma unroll
          for (int j = 0; j < 4; ++j) {
            const u32x4 u = *(const u32x4*)(row + j * 512);
#pragma unroll
            for (int c = 0; c < 4; ++c) {
              y[j * 8 + c * 2] += ck * bflo(u[c]);
              y[j * 8 + c * 2 + 1] += ck * bfhi(u[c]);
            }
          }
          if (k == 3) __builtin_amdgcn_sched_barrier(0);
        }
      }
    }
    float ss = 0.f;
#pragma unroll
    for (int j = 0; j < 4; ++j) {
      const float4 a = *(const float4*)(p.xres + (size_t)tok * 2048 + j * 512 + lane * 8);
      const float4 b = *(const float4*)(p.xres + (size_t)tok * 2048 + j * 512 + lane * 8 + 4);
      y[j * 8 + 0] += a.x; y[j * 8 + 1] += a.y; y[j * 8 + 2] += a.z; y[j * 8 + 3] += a.w;
      y[j * 8 + 4] += b.x; y[j * 8 + 5] += b.y; y[j * 8 + 6] += b.z; y[j * 8 + 7] += b.w;
#pragma unroll
      for (int e = 0; e < 8; ++e) ss += y[j * 8 + e] * y[j * 8 + e];
    }
    ss = wave_sum(ss);
    const float rs = rsqrtf(ss * (1.f / 2048.f) + 1e-6f);
#pragma unroll
    for (int j = 0; j < 4; ++j) {
      const float4 ga = *(const float4*)(p.g_final + j * 512 + lane * 8);
      const float4 gb = *(const float4*)(p.g_final + j * 512 + lane * 8 + 4);
      float4 oa, ob;
      oa.x = y[j * 8 + 0] * rs * ga.x; oa.y = y[j * 8 + 1] * rs * ga.y; oa.z = y[j * 8 + 2] * rs * ga.z; oa.w = y[j * 8 + 3] * rs * ga.w;
      ob.x = y[j * 8 + 4] * rs * gb.x; ob.y = y[j * 8 + 5] * rs * gb.y; ob.z = y[j * 8 + 6] * rs * gb.z; ob.w = y[j * 8 + 7] * rs * gb.w;
      *(float4*)(p.out + (size_t)tok * 2048 + j * 512 + lane * 8) = oa;
      *(float4*)(p.out + (size_t)tok * 2048 + j * 512 + lane * 8 + 4) = ob;
    }
  }
}

__global__ void __launch_bounds__(NTHREADS) mega(Params p, int phase_lo, int phase_hi) {
  __shared__ __attribute__((aligned(16))) char smem[SMEM_BYTES];
  cg::grid_group grid = cg::this_grid();
#define PHASE(k, call) if (phase_lo <= (k) && (k) < phase_hi) { if ((k) > phase_lo) grid.sync(); call; }
  PHASE(0, phase_prep(p, smem))
  PHASE(1, phase_inproj(p, smem))
  PHASE(2, phase_mix_attn(p, smem))
  PHASE(3, phase_pool_combine(p, smem))
  PHASE(4, phase_gemm_resid(p.hbuf, 2048, p.wOutT, 2048, p.x, p.xres, smem))
  PHASE(5, phase_rms(p.xres, p.g_cross, p.hbuf))
  PHASE(6, phase_gemm_bf16(p.hbuf, 2048, p.wCqT, 2048, 512, 0.08838834764831845f, p.qc, smem))
  PHASE(7, phase_cross_attn(p, smem))
  if (ABL != 2) PHASE(8, phase_gemm_resid(p.oc, 512, p.wCoT, 512, p.xres, p.xres, smem))
  PHASE(9, phase_rms(p.xres, p.g_ffn, p.hbuf))
  PHASE(10, phase_gemm_bf16(p.hbuf, 2048, p.wPqT, 2048, 2048, 1.0f, p.pq, smem))
  PHASE(11, phase_peer_route(p, smem))
  PHASE(12, phase_peer_expert(p))
}

extern "C" void kernel_launch(void* const* d_in, const int* in_sizes, int n_in, void* d_out, int out_size, void* d_ws,
                              size_t ws_size, hipStream_t stream) {
  Params p{};
  p.x = (const float*)d_in[0]; p.mem = (const float*)d_in[1]; p.pos = (const int*)d_in[2];
  p.g_mix = (const float*)d_in[3]; p.w_in = (const float*)d_in[4]; p.w_pool = (const float*)d_in[5];
  p.pool_scale = (const float*)d_in[6]; p.w_out = (const float*)d_in[7]; p.g_cross = (const float*)d_in[8];
  p.g_mem = (const float*)d_in[9]; p.w_cq = (const float*)d_in[10]; p.w_ck = (const float*)d_in[11];
  p.w_cv = (const float*)d_in[12]; p.w_co = (const float*)d_in[13]; p.g_ffn = (const float*)d_in[14];
  p.w_pq = (const float*)d_in[15]; p.sk1f = (const float*)d_in[16]; p.sk2f = (const float*)d_in[17];
  p.w_u = (const float*)d_in[18]; p.w_v = (const float*)d_in[19]; p.g_final = (const float*)d_in[20];
  p.out = (float*)d_out;
  char* ws = (char*)d_ws;
  size_t off = 0;
  auto take = [&](size_t bytes) { char* r = ws + off; off += (bytes + 255) & ~(size_t)255; return r; };
  const size_t MB = 1024 * 1024;
  p.wInT = (bfr*)take(16 * MB); p.wPoolT = (bfr*)take(512 * 1024); p.wOutT = (bfr*)take(8 * MB);
  p.wCqT = (bfr*)take(2 * MB); p.wCkT = (bfr*)take(2 * MB); p.wCvT = (bfr*)take(2 * MB); p.wCoT = (bfr*)take(2 * MB);
  p.wPqT = (bfr*)take(8 * MB); p.sk1 = (bfr*)take(32768); p.sk2 = (bfr*)take(32768);
  p.wU = (bfr*)take(64 * MB); p.wV = (bfr*)take(64 * MB);
  p.memn = (bfr*)take(4 * MB); p.kc = (bfr*)take(1 * MB); p.vc = (bfr*)take(1 * MB);
  p.hbuf = (bfr*)take(64 * MB);
  const size_t r2 = off;
  p.qbuf = (bfr*)take(32 * MB); p.kbuf = (bfr*)take(32 * MB); p.vbuf = (bfr*)take(32 * MB);
  p.pbuf = (bfr*)take(32 * MB); p.mixed = (bfr*)take(32 * MB); p.ob = (bfr*)take(96 * MB);
  p.lse = (float*)take((size_t)3 * T_TOK * 8 * 4);
  const size_t end1 = off;
  off = r2;
  p.xres = (float*)take(128 * MB); p.pq = (bfr*)take(64 * MB); p.qc = (bfr*)take(16 * MB); p.oc = (bfr*)take(16 * MB);
  p.idx = (int*)take(8 * MB); p.gates = (float*)take(8 * MB);
  const size_t end2 = off;
  const size_t need = end1 > end2 ? end1 : end2;
  if (need > ws_size) { fprintf(stderr, "workspace too small: need %zu have %zu\n", need, ws_size); return; }

  static int grid_blocks = 0;
  if (!grid_blocks) {
    int dev = 0, cus = 0, per_cu = 0;
    hipGetDevice(&dev);
    hipDeviceGetAttribute(&cus, hipDeviceAttributeMultiprocessorCount, dev);
    hipOccupancyMaxActiveBlocksPerMultiprocessor(&per_cu, mega, NTHREADS, 0);
    if (per_cu < 1) per_cu = 1;
    if (per_cu > 1) per_cu = 1;
    grid_blocks = cus * per_cu;
  }
#if MULTI_LAUNCH
  for (int ph = 0; ph < NPHASE; ++ph) hipLaunchKernelGGL(mega, dim3(grid_blocks), dim3(NTHREADS), 0, stream, p, ph, ph + 1);
#else
  int lo = 0, hi = NPHASE;
  void* args[] = {&p, &lo, &hi};
  hipError_t e = hipLaunchCooperativeKernel((void*)mega, dim3(grid_blocks), dim3(NTHREADS), args, 0, stream);
  if (e != hipSuccess) fprintf(stderr, "cooperative launch failed: %s (grid %d)\n", hipGetErrorString(e), grid_blocks);
#endif
}
```

```cpp
#include <hip/hip_runtime.h>
#include <hip/hip_cooperative_groups.h>
#include <stdint.h>
#include <stdio.h>
namespace cg = cooperative_groups;

#ifndef ABL
#define ABL 0
#endif
#ifndef MULTI_LAUNCH
#define MULTI_LAUNCH 0
#endif

#define DI __device__ __forceinline__
typedef unsigned short bfr;
using bf16x8 = __attribute__((ext_vector_type(8))) short;
using s16x4  = __attribute__((ext_vector_type(4))) short;
using f32x4  = __attribute__((ext_vector_type(4))) float;
using u32x4  = __attribute__((ext_vector_type(4))) unsigned;
using u32x2  = __attribute__((ext_vector_type(2))) unsigned;
using bf2    = __attribute__((ext_vector_type(2))) __bf16;
using f32x2  = __attribute__((ext_vector_type(2))) float;

constexpr int T_TOK = 16384;
constexpr int NTHREADS = 512;
constexpr int SMEM_BYTES = 151552;
constexpr int NPHASE = 13;

struct Params {
  const float *x, *mem; const int* pos;
  const float *g_mix, *w_in, *w_pool, *pool_scale, *w_out, *g_cross, *g_mem, *w_cq, *w_ck, *w_cv, *w_co, *g_ffn, *w_pq,
              *sk1f, *sk2f, *w_u, *w_v, *g_final;
  float* out;
  bfr *wInT, *wPoolT, *wOutT, *wCqT, *wCkT, *wCvT, *wCoT, *wPqT, *sk1, *sk2;
  unsigned char *wU8, *wV8; float *su, *sv;
  bfr *hbuf, *memn, *kc, *vc;
  bfr *pbuf, *qbuf, *kbuf, *vbuf, *mixed, *ob; float* lse;
  float* xres; bfr *pq, *qc, *oc; int* idx; float* gates;
};

DI unsigned pack2(float a, float b) { bf2 p; p[0] = (__bf16)a; p[1] = (__bf16)b; return __builtin_bit_cast(unsigned, p); }
DI float bflo(unsigned u) { return __uint_as_float(u << 16); }
DI float bfhi(unsigned u) { return __uint_as_float(u & 0xffff0000u); }
DI float wave_sum(float v) {
#pragma unroll
  for (int o = 32; o >= 1; o >>= 1) v += __shfl_xor(v, o);
  return v;
}
DI f32x4 mfma16(bf16x8 a, bf16x8 b, f32x4 c) { return __builtin_amdgcn_mfma_f32_16x16x32_bf16(a, b, c, 0, 0, 0); }
DI s16x4 tr_read(const char* p) {
  return __builtin_amdgcn_ds_read_tr16_b64_v4i16((s16x4 __attribute__((address_space(3)))*)(p));
}

DI void gemm_main(const bfr* __restrict__ A, int lda, const bfr* __restrict__ Bt, int ldb, int K, char* smem,
                  f32x4 (&acc)[4][4]) {
  const int tid = threadIdx.x, lane = tid & 63, wid = tid >> 6, wm = wid >> 1, wn = wid & 1, fr = lane & 15, fq = lane >> 4;
  const int lrow = tid >> 3, lc = tid & 7;
  const int sw = ((lc ^ (lrow & 7)) << 4);
  u32x4 ra[4], rb[2];
  const bfr* ga = A + (size_t)lrow * lda + lc * 8;
  const bfr* gb = Bt + (size_t)lrow * ldb + lc * 8;
#pragma unroll
  for (int m = 0; m < 4; ++m)
#pragma unroll
    for (int n = 0; n < 4; ++n) acc[m][n] = f32x4{0.f, 0.f, 0.f, 0.f};
  const int nk = K >> 6;
#pragma unroll
  for (int i = 0; i < 4; ++i) ra[i] = *(const u32x4*)(ga + (size_t)(64 * i) * lda);
#pragma unroll
  for (int i = 0; i < 2; ++i) rb[i] = *(const u32x4*)(gb + (size_t)(64 * i) * ldb);
  __syncthreads();
#pragma unroll
  for (int i = 0; i < 4; ++i) *(u32x4*)(smem + (lrow + 64 * i) * 128 + sw) = ra[i];
#pragma unroll
  for (int i = 0; i < 2; ++i) *(u32x4*)(smem + 32768 + (lrow + 64 * i) * 128 + sw) = rb[i];
  __syncthreads();
  for (int kt = 0; kt < nk; ++kt) {
    const char* cur = smem + (kt & 1) * 49152;
    char* nxt = smem + ((kt + 1) & 1) * 49152;
    const bool more = (kt + 1 < nk);
    if (more) {
#pragma unroll
      for (int i = 0; i < 4; ++i) ra[i] = *(const u32x4*)(ga + (size_t)(64 * i) * lda + (kt + 1) * 64);
#pragma unroll
      for (int i = 0; i < 2; ++i) rb[i] = *(const u32x4*)(gb + (size_t)(64 * i) * ldb + (kt + 1) * 64);
    }
#pragma unroll
    for (int kk = 0; kk < 2; ++kk) {
      bf16x8 af[4], bf[4];
      const int co = (((kk * 4 + fq) ^ (fr & 7)) << 4);
#pragma unroll
      for (int m = 0; m < 4; ++m) af[m] = *(const bf16x8*)(cur + (wm * 64 + m * 16 + fr) * 128 + co);
#pragma unroll
      for (int n = 0; n < 4; ++n) bf[n] = *(const bf16x8*)(cur + 32768 + (wn * 64 + n * 16 + fr) * 128 + co);
#pragma unroll
      for (int m = 0; m < 4; ++m)
#pragma unroll
        for (int n = 0; n < 4; ++n) acc[m][n] = mfma16(bf[n], af[m], acc[m][n]);
    }
    if (more) {
#pragma unroll
      for (int i = 0; i < 4; ++i) *(u32x4*)(nxt + (lrow + 64 * i) * 128 + sw) = ra[i];
#pragma unroll
      for (int i = 0; i < 2; ++i) *(u32x4*)(nxt + 32768 + (lrow + 64 * i) * 128 + sw) = rb[i];
    }
    __syncthreads();
  }
}

DI void tile_map(int id, int MT, int NT, int& mt, int& nt) {
  if ((NT & 7) == 0 && (MT & 31) == 0) {
    const int round = id >> 8, local = id & 255, xcd = local & 7, j = local >> 3, mtl = j & 3, ntl = j >> 2;
    const int MR = MT >> 5;
    const int mr = round % MR, nr = round / MR;
    mt = mr * 32 + xcd * 4 + mtl;
    nt = nr * 8 + ntl;
  } else {
    mt = id % MT;
    nt = id / MT;
  }
}

template <bool BANDED, class StoreF>
DI void attn_core(const bfr* __restrict__ Qb, int qstride, int q0, const bfr* __restrict__ Kb, const bfr* __restrict__ Vb,
                  int kvstride, int key0, char* smem, StoreF store, float& m_out, float& l_out) {
  const int tid = threadIdx.x, lane = tid & 63, w = tid >> 6, fr = lane & 15, fq = lane >> 4;
  char* sK = smem;
  char* sV = smem + 65536;
  __syncthreads();
#pragma unroll 1
  for (int rr = 0; rr < 2; ++rr) {
    u32x4 kr[4], vr[4];
#pragma unroll
    for (int i = 0; i < 4; ++i) {
      const int id = tid + (rr * 4 + i) * 512, key = id >> 4, c = id & 15, lk = key0 + key;
      kr[i] = u32x4{0u, 0u, 0u, 0u};
      vr[i] = u32x4{0u, 0u, 0u, 0u};
      if (lk >= 0) {
        kr[i] = *(const u32x4*)(Kb + (long)lk * kvstride + c * 8);
        vr[i] = *(const u32x4*)(Vb + (long)lk * kvstride + c * 8);
      }
    }
#pragma unroll
    for (int i = 0; i < 4; ++i) {
      const int id = tid + (rr * 4 + i) * 512, key = id >> 4, c = id & 15;
      *(u32x4*)(sK + key * 256 + ((c ^ (key & 15)) << 4)) = kr[i];
      *(u32x4*)(sV + key * 288 + c * 16) = vr[i];
    }
  }
  bf16x8 qf[4];
  {
    const bfr* qrow = Qb + (long)(q0 + w * 16 + fr) * qstride;
#pragma unroll
    for (int kk = 0; kk < 4; ++kk) qf[kk] = *(const bf16x8*)(qrow + kk * 32 + fq * 8);
  }
  __syncthreads();
  constexpr int NT = BANDED ? 10 : 16;
  const int t0 = BANDED ? (w & ~1) : 0;
  f32x4 s[NT];
#pragma unroll
  for (int j = 0; j < NT; ++j) {
    f32x4 a = f32x4{0.f, 0.f, 0.f, 0.f};
    const int key = (t0 + j) * 16 + fr;
#pragma unroll
    for (int kk = 0; kk < 4; ++kk) {
      const bf16x8 kf = *(const bf16x8*)(sK + key * 256 + (((kk * 4 + fq) ^ fr) << 4));
      a = mfma16(kf, qf[kk], a);
    }
    s[j] = a;
  }
  const float L2E = 1.4426950408889634f;
  const float NINF = -__builtin_inff();
  float mx = NINF;
  const int lq = q0 + w * 16 + fr;
#pragma unroll
  for (int j = 0; j < NT; ++j)
#pragma unroll
    for (int i = 0; i < 4; ++i) {
      float v = s[j][i] * L2E;
      if (BANDED) {
        const int lk = key0 + (t0 + j) * 16 + fq * 4 + i;
        const int dist = lq - lk;
        const bool ok = (lk >= 0) && (dist >= 0) && (dist <= 128);
        v = ok ? v : NINF;
      }
      s[j][i] = v;
      mx = fmaxf(mx, v);
    }
  mx = fmaxf(mx, __shfl_xor(mx, 16));
  mx = fmaxf(mx, __shfl_xor(mx, 32));
  float l = 0.f;
#pragma unroll
  for (int j = 0; j < NT; ++j)
#pragma unroll
    for (int i = 0; i < 4; ++i) {
      const float p = __builtin_amdgcn_exp2f(s[j][i] - mx);
      s[j][i] = p;
      l += p;
    }
  l += __shfl_xor(l, 16);
  l += __shfl_xor(l, 32);
  bf16x8 pf[NT / 2];
#pragma unroll
  for (int c = 0; c < NT / 2; ++c) {
    u32x4 t;
    t[0] = pack2(s[2 * c][0], s[2 * c][1]);
    t[1] = pack2(s[2 * c][2], s[2 * c][3]);
    t[2] = pack2(s[2 * c + 1][0], s[2 * c + 1][1]);
    t[3] = pack2(s[2 * c + 1][2], s[2 * c + 1][3]);
    pf[c] = __builtin_bit_cast(bf16x8, t);
  }
  const int q4 = (lane & 15) >> 2, p4 = lane & 3;
  m_out = mx;
  l_out = l;
#pragma unroll 2
  for (int dt = 0; dt < 8; ++dt) {
    f32x4 a = f32x4{0.f, 0.f, 0.f, 0.f};
#pragma unroll
    for (int c = 0; c < NT / 2; ++c) {
      const int kb = (t0 + 2 * c) * 16;
      const s16x4 lo = tr_read(sV + (kb + fq * 4 + q4) * 288 + (dt * 16 + p4 * 4) * 2);
      const s16x4 hi = tr_read(sV + (kb + 16 + fq * 4 + q4) * 288 + (dt * 16 + p4 * 4) * 2);
      const bf16x8 vf = __builtin_shufflevector(lo, hi, 0, 1, 2, 3, 4, 5, 6, 7);
      a = mfma16(vf, pf[c], a);
    }
    store(dt, a, l);
  }
}

DI int f2sort(float f) { int b = __float_as_int(f); return b ^ ((b >> 31) & 0x7fffffff); }
DI float sort2f(int s) { int b = s ^ ((s >> 31) & 0x7fffffff); return __int_as_float(b); }
DI void topk_insert(int (&lst)[16], int key) {
#pragma unroll
  for (int j = 0; j < 16; ++j) {
    const int hi = max(lst[j], key);
    key = min(lst[j], key);
    lst[j] = hi;
  }
}

template <int O, int N>
DI void bfly(float (&p)[64], int lane) {
  const bool up = (lane & O) != 0;
#pragma unroll
  for (int i = 0; i < N / 2; ++i) {
    const float keep = up ? p[i + N / 2] : p[i];
    const float send = up ? p[i] : p[i + N / 2];
    p[i] = keep + __shfl_xor(send, O);
  }
  if constexpr (O > 1) bfly<O / 2, N / 2>(p, lane);
}

DI void rms_row_to_bf16(const float* __restrict__ x, const float* __restrict__ g, bfr* __restrict__ out, int lane) {
  float4 v[8];
  float ss = 0.f;
#pragma unroll
  for (int j = 0; j < 8; ++j) {
    v[j] = *(const float4*)(x + j * 256 + lane * 4);
    ss += v[j].x * v[j].x + v[j].y * v[j].y + v[j].z * v[j].z + v[j].w * v[j].w;
  }
  ss = wave_sum(ss);
  const float rs = rsqrtf(ss * (1.f / 2048.f) + 1e-6f);
#pragma unroll
  for (int j = 0; j < 8; ++j) {
    const float4 gg = *(const float4*)(g + j * 256 + lane * 4);
    u32x2 o;
    o[0] = pack2(v[j].x * rs * gg.x, v[j].y * rs * gg.y);
    o[1] = pack2(v[j].z * rs * gg.z, v[j].w * rs * gg.w);
    *(u32x2*)(out + j * 256 + lane * 4) = o;
  }
}

DI void transpose_tile(const float* __restrict__ W, int K, int N, int k0, int n0, bfr* __restrict__ Wt, float* tile) {
  __syncthreads();
  {
    const int r = threadIdx.x >> 4, c4 = threadIdx.x & 15;
#pragma unroll
    for (int i = 0; i < 2; ++i) {
      const int k = r + 32 * i;
      const float4 v = *(const float4*)(W + (size_t)(k0 + k) * N + n0 + c4 * 4);
      tile[k * 65 + c4 * 4 + 0] = v.x;
      tile[k * 65 + c4 * 4 + 1] = v.y;
      tile[k * 65 + c4 * 4 + 2] = v.z;
      tile[k * 65 + c4 * 4 + 3] = v.w;
    }
  }
  __syncthreads();
  {
    const int n = threadIdx.x >> 3, kc = threadIdx.x & 7;
    u32x4 o;
#pragma unroll
    for (int j = 0; j < 4; ++j) o[j] = pack2(tile[(kc * 8 + 2 * j) * 65 + n], tile[(kc * 8 + 2 * j + 1) * 65 + n]);
    *(u32x4*)(Wt + (size_t)(n0 + n) * K + k0 + kc * 8) = o;
  }
}

DI void convert_f32_bf16(const float* __restrict__ src, bfr* __restrict__ dst, long n8) {
  for (long i = (long)blockIdx.x * NTHREADS + threadIdx.x; i < n8; i += (long)gridDim.x * NTHREADS) {
    const float4 a = *(const float4*)(src + i * 8);
    const float4 b = *(const float4*)(src + i * 8 + 4);
    u32x4 o;
    o[0] = pack2(a.x, a.y); o[1] = pack2(a.z, a.w); o[2] = pack2(b.x, b.y); o[3] = pack2(b.z, b.w);
    *(u32x4*)(dst + i * 8) = o;
  }
}

DI void phase_prep(const Params& p, char* smem) {
  const int lane = threadIdx.x & 63, wid = threadIdx.x >> 6;
  for (int r = blockIdx.x * 8 + wid; r < T_TOK + 1024; r += gridDim.x * 8) {
    if (r < T_TOK) rms_row_to_bf16(p.x + (size_t)r * 2048, p.g_mix, p.hbuf + (size_t)r * 2048, lane);
    else rms_row_to_bf16(p.mem + (size_t)(r - T_TOK) * 2048, p.g_mem, p.memn + (size_t)(r - T_TOK) * 2048, lane);
  }
  float* tile = (float*)smem;
  for (int id0 = blockIdx.x; id0 < 5184; id0 += gridDim.x) {
    int id = id0;
    const float* W; bfr* Wt; int K, N;
    if (id < 2048) { W = p.w_in; Wt = p.wInT; K = 2048; N = 4096; }
    else if ((id -= 2048) < 1024) { W = p.w_out; Wt = p.wOutT; K = 2048; N = 2048; }
    else if ((id -= 1024) < 1024) { W = p.w_pq; Wt = p.wPqT; K = 2048; N = 2048; }
    else if ((id -= 1024) < 256) { W = p.w_cq; Wt = p.wCqT; K = 2048; N = 512; }
    else if ((id -= 256) < 256) { W = p.w_ck; Wt = p.wCkT; K = 2048; N = 512; }
    else if ((id -= 256) < 256) { W = p.w_cv; Wt = p.wCvT; K = 2048; N = 512; }
    else if ((id -= 256) < 256) { W = p.w_co; Wt = p.wCoT; K = 512; N = 2048; }
    else { id -= 256; const int g = id >> 4; id &= 15; W = p.w_pool + g * 65536; Wt = p.wPoolT + g * 65536; K = 256; N = 256; }
    const int ntn = N >> 6;
    const int kt = id / ntn, nt = id % ntn;
    transpose_tile(W, K, N, kt * 64, nt * 64, Wt, tile);
  }
  convert_f32_bf16(p.sk1f, p.sk1, 128 * 128 / 8);
  convert_f32_bf16(p.sk2f, p.sk2, 128 * 128 / 8);
  for (int r = blockIdx.x * 8 + wid; r < 2 * 16384; r += gridDim.x * 8) {
    const bool isv = r >= 16384;
    const int rr = isv ? r - 16384 : r;
    const float* src = (isv ? p.w_v : p.w_u) + (size_t)rr * 2048;
    unsigned char* dst = (isv ? p.wV8 : p.wU8) + (size_t)rr * 2048;
    float4 v[8];
    float amax = 0.f;
#pragma unroll
    for (int j = 0; j < 2; ++j)
#pragma unroll
      for (int q = 0; q < 4; ++q) {
        v[j * 4 + q] = *(const float4*)(src + j * 1024 + lane * 16 + q * 4);
        const float4 t = v[j * 4 + q];
        amax = fmaxf(amax, fmaxf(fmaxf(fabsf(t.x), fabsf(t.y)), fmaxf(fabsf(t.z), fabsf(t.w))));
      }
#pragma unroll
    for (int o = 32; o >= 1; o >>= 1) amax = fmaxf(amax, __shfl_xor(amax, o));
    const float inv = amax > 0.f ? 448.f / amax : 0.f;
    if (lane == 0) (isv ? p.sv : p.su)[rr] = amax * (1.f / 448.f);
#pragma unroll
    for (int j = 0; j < 2; ++j) {
      u32x4 o4;
#pragma unroll
      for (int q = 0; q < 4; ++q) {
        const float4 t = v[j * 4 + q];
        int w = 0;
        w = __builtin_amdgcn_cvt_pk_fp8_f32(t.x * inv, t.y * inv, w, false);
        w = __builtin_amdgcn_cvt_pk_fp8_f32(t.z * inv, t.w * inv, w, true);
        o4[q] = (unsigned)w;
      }
      *(u32x4*)(dst + j * 1024 + lane * 16) = o4;
    }
  }
}

DI void phase_inproj(const Params& p, char* smem) {
  const int tid = threadIdx.x, lane = tid & 63, wid = tid >> 6, wm = wid >> 1, wn = wid & 1, fr = lane & 15, fq = lane >> 4;
  f32x4 acc[4][4];
  for (int id = blockIdx.x; id < 2048 + 32; id += gridDim.x) {
    if (id < 2048) {
      int mt, nt;
      tile_map(id, 64, 32, mt, nt);
      gemm_main(p.hbuf + (size_t)mt * 256 * 2048, 2048, p.wInT + (size_t)nt * 128 * 2048, 2048, 2048, smem, acc);
      const int region = nt >> 3, h = nt & 7;
      if (region == 0) {
#pragma unroll
        for (int m = 0; m < 4; ++m) {
          const int row = mt * 256 + wm * 64 + m * 16 + fr;
#pragma unroll
          for (int n = 0; n < 4; ++n) {
            const int col = nt * 128 + wn * 64 + n * 16 + fq * 4;
            u32x2 o; o[0] = pack2(acc[m][n][0], acc[m][n][1]); o[1] = pack2(acc[m][n][2], acc[m][n][3]);
            *(u32x2*)(p.pbuf + (size_t)row * 1024 + col) = o;
          }
        }
      } else {
        bfr* dst = (region == 1) ? p.qbuf : (region == 2 ? p.kbuf : p.vbuf);
        const float scale = (region == 1) ? 0.08838834764831845f : 1.0f;
#pragma unroll
        for (int m = 0; m < 4; ++m) {
          const int row = mt * 256 + wm * 64 + m * 16 + fr;
          const int b = row >> 12, t = row & 4095;
          if (region != 3 && wn == 0) {
            const float posf = (float)p.pos[row];
#pragma unroll
            for (int i = 0; i < 4; ++i) {
              const int j = fq * 4 + i;
              const float inv = exp2f(-(float)j * (18.931568569324174f / 16.0f));
              float sn, cs;
              sincosf(posf * inv, &sn, &cs);
              const float x1 = acc[m][0][i], x2 = acc[m][1][i];
              acc[m][0][i] = x1 * cs - x2 * sn;
              acc[m][1][i] = x2 * cs + x1 * sn;
            }
          }
#pragma unroll
          for (int n = 0; n < 4; ++n) {
            const int d = wn * 64 + n * 16 + fq * 4;
            u32x2 o;
            o[0] = pack2(acc[m][n][0] * scale, acc[m][n][1] * scale);
            o[1] = pack2(acc[m][n][2] * scale, acc[m][n][3] * scale);
            *(u32x2*)(dst + ((size_t)((b * 8 + h) * 4096 + t)) * 128 + d) = o;
          }
        }
      }
    } else {
      const int id2 = id - 2048;
      const int which = id2 >> 4, mt = (id2 >> 2) & 3, nt = id2 & 3;
      const bfr* Bt = (which == 0 ? p.wCkT : p.wCvT) + (size_t)nt * 128 * 2048;
      bfr* dst = which == 0 ? p.kc : p.vc;
      gemm_main(p.memn + (size_t)mt * 256 * 2048, 2048, Bt, 2048, 2048, smem, acc);
#pragma unroll
      for (int m = 0; m < 4; ++m) {
        const int row = mt * 256 + wm * 64 + m * 16 + fr;
        const int b = row >> 8, mm = row & 255;
#pragma unroll
        for (int n = 0; n < 4; ++n) {
          const int d = wn * 64 + n * 16 + fq * 4;
          u32x2 o; o[0] = pack2(acc[m][n][0], acc[m][n][1]); o[1] = pack2(acc[m][n][2], acc[m][n][3]);
          *(u32x2*)(dst + ((size_t)((b * 4 + nt) * 256 + mm)) * 128 + d) = o;
        }
      }
    }
  }
}

DI void phase_mix_attn(const Params& p, char* smem) {
  const int tid = threadIdx.x, lane = tid & 63, w = tid >> 6, fr = lane & 15, fq = lane >> 4;
  for (int id = blockIdx.x; id < 3072 + 256; id += gridDim.x) {
    if (id < 3072) {
      const int br = id >> 10, rem = id & 1023;
      const int dl = (br == 0) ? 1 : (br == 1 ? 4 : 16);
      const int nblk = 32 / dl;
      const int bh = rem >> 5, rn = rem & 31;
      const int r = rn / nblk, nb = rn % nblk;
      const int l0 = nb * 128;
      const size_t base = (size_t)bh * 4096 * 128 + (size_t)r * 128;
      float mx, l;
      const int b = bh >> 3, h = bh & 7;
      const int tt = b * 4096 + (l0 + w * 16 + fr) * dl + r;
      bfr* dst = p.ob + (size_t)br * T_TOK * 1024 + (size_t)tt * 1024 + h * 128 + fq * 4;
      attn_core<true>(p.qbuf + base, dl * 128, l0, p.kbuf + base, p.vbuf + base, dl * 128, l0 - 128, smem,
                      [&](int dt, f32x4 a, float lsum) {
                        const float il = 1.f / lsum;
                        u32x2 v; v[0] = pack2(a[0] * il, a[1] * il); v[1] = pack2(a[2] * il, a[3] * il);
                        *(u32x2*)(dst + dt * 16) = v;
                      }, mx, l);
      if (fq == 0) p.lse[(size_t)br * T_TOK * 8 + (size_t)tt * 8 + h] = mx + __builtin_amdgcn_logf(l);
    } else {
      const int ci = id - 3072;
      const int sub = tid >> 7, cgp = tid & 127;
      const int wdw = 2 << (cgp >> 5);
      const int t0 = ci * 64 + sub * 16, tin0 = t0 & 4095;
      const bfr* pb = p.pbuf + cgp * 8;
      float sum[8];
#pragma unroll
      for (int e = 0; e < 8; ++e) sum[e] = 0.f;
      for (int j = 1; j < wdw; ++j) {
        if (tin0 - j >= 0) {
          const u32x4 v = *(const u32x4*)(pb + (size_t)(t0 - j) * 1024);
#pragma unroll
          for (int e = 0; e < 4; ++e) { sum[2 * e] += bflo(v[e]); sum[2 * e + 1] += bfhi(v[e]); }
        }
      }
      for (int s = 0; s < 16; ++s) {
        const int t = t0 + s, tin = tin0 + s;
        const u32x4 v = *(const u32x4*)(pb + (size_t)t * 1024);
        float cur[8];
#pragma unroll
        for (int e = 0; e < 4; ++e) { cur[2 * e] = bflo(v[e]); cur[2 * e + 1] = bfhi(v[e]); }
        const float ic = 1.f / (float)min(tin + 1, wdw);
        u32x4 ov;
#pragma unroll
        for (int e = 0; e < 8; ++e) sum[e] += cur[e];
#pragma unroll
        for (int e = 0; e < 4; ++e) ov[e] = pack2(sum[2 * e] * ic - cur[2 * e], sum[2 * e + 1] * ic - cur[2 * e + 1]);
        *(u32x4*)(p.mixed + (size_t)t * 1024 + cgp * 8) = ov;
        if (tin - wdw + 1 >= 0) {
          const u32x4 u = *(const u32x4*)(pb + (size_t)(t - wdw + 1) * 1024);
#pragma unroll
          for (int e = 0; e < 4; ++e) { sum[2 * e] -= bflo(u[e]); sum[2 * e + 1] -= bfhi(u[e]); }
        }
      }
    }
  }
}

DI void phase_pool_combine(const Params& p, char* smem) {
  const int tid = threadIdx.x, lane = tid & 63, wid = tid >> 6, wm = wid >> 1, wn = wid & 1, fr = lane & 15, fq = lane >> 4;
  f32x4 acc[4][4];
  for (int id = blockIdx.x; id < 512; id += gridDim.x) {
    const int g = id >> 7, mt = (id >> 1) & 63, nt = id & 1;
    gemm_main(p.mixed + (size_t)mt * 256 * 1024 + g * 256, 1024, p.wPoolT + (size_t)g * 65536 + (size_t)nt * 128 * 256, 256, 256,
              smem, acc);
#pragma unroll
    for (int m = 0; m < 4; ++m) {
      const int row = mt * 256 + wm * 64 + m * 16 + fr;
#pragma unroll
      for (int n = 0; n < 4; ++n) {
        const int e = nt * 128 + wn * 64 + n * 16 + fq * 4;
        const float4 sc = *(const float4*)(p.pool_scale + g * 256 + e);
        u32x2 o; o[0] = pack2(acc[m][n][0] * sc.x, acc[m][n][1] * sc.y); o[1] = pack2(acc[m][n][2] * sc.z, acc[m][n][3] * sc.w);
        *(u32x2*)(p.hbuf + (size_t)row * 2048 + g * 256 + e) = o;
      }
    }
  }
  for (long i = (long)blockIdx.x * NTHREADS + tid; i < (long)T_TOK * 8 * 16; i += (long)gridDim.x * NTHREADS) {
    const int dc = (int)(i & 15), h = (int)((i >> 4) & 7);
    const long tt = i >> 7;
    const float l0 = p.lse[tt * 8 + h], l1 = p.lse[(size_t)T_TOK * 8 + tt * 8 + h], l2 = p.lse[(size_t)2 * T_TOK * 8 + tt * 8 + h];
    const float mx = fmaxf(l0, fmaxf(l1, l2));
    float w0 = __builtin_amdgcn_exp2f(l0 - mx), w1 = __builtin_amdgcn_exp2f(l1 - mx), w2 = __builtin_amdgcn_exp2f(l2 - mx);
    const float inv = 1.f / (w0 + w1 + w2);
    w0 *= inv; w1 *= inv; w2 *= inv;
    if (ABL == 3) { w0 = 0.f; w1 = 0.f; w2 = 0.f; }
    const size_t off = (size_t)tt * 1024 + h * 128 + dc * 8;
    const u32x4 a = *(const u32x4*)(p.ob + off);
    const u32x4 b = *(const u32x4*)(p.ob + (size_t)T_TOK * 1024 + off);
    const u32x4 c = *(const u32x4*)(p.ob + (size_t)2 * T_TOK * 1024 + off);
    u32x4 o;
#pragma unroll
    for (int e = 0; e < 4; ++e)
      o[e] = pack2(w0 * bflo(a[e]) + w1 * bflo(b[e]) + w2 * bflo(c[e]), w0 * bfhi(a[e]) + w1 * bfhi(b[e]) + w2 * bfhi(c[e]));
    *(u32x4*)(p.hbuf + (size_t)tt * 2048 + 1024 + h * 128 + dc * 8) = o;
  }
}

DI void phase_gemm_resid(const bfr* A, int lda, const bfr* Bt, int K, const float* resid, float* xout, char* smem) {
  const int tid = threadIdx.x, lane = tid & 63, wid = tid >> 6, wm = wid >> 1, wn = wid & 1, fr = lane & 15, fq = lane >> 4;
  f32x4 acc[4][4];
  for (int id = blockIdx.x; id < 1024; id += gridDim.x) {
    int mt, nt;
    tile_map(id, 64, 16, mt, nt);
    gemm_main(A + (size_t)mt * 256 * lda, lda, Bt + (size_t)nt * 128 * K, K, K, smem, acc);
#pragma unroll
    for (int m = 0; m < 4; ++m) {
      const int row = mt * 256 + wm * 64 + m * 16 + fr;
#pragma unroll
      for (int n = 0; n < 4; ++n) {
        const int col = nt * 128 + wn * 64 + n * 16 + fq * 4;
        const float4 r = *(const float4*)(resid + (size_t)row * 2048 + col);
        float4 o; o.x = r.x + acc[m][n][0]; o.y = r.y + acc[m][n][1]; o.z = r.z + acc[m][n][2]; o.w = r.w + acc[m][n][3];
        *(float4*)(xout + (size_t)row * 2048 + col) = o;
      }
    }
  }
}

DI void phase_rms(const float* xin, const float* g, bfr* out) {
  const int lane = threadIdx.x & 63, wid = threadIdx.x >> 6;
  for (int r = blockIdx.x * 8 + wid; r < T_TOK; r += gridDim.x * 8)
    rms_row_to_bf16(xin + (size_t)r * 2048, g, out + (size_t)r * 2048, lane);
}

DI void phase_gemm_bf16(const bfr* A, int lda, const bfr* Bt, int K, int N, float scale, bfr* out, char* smem) {
  const int tid = threadIdx.x, lane = tid & 63, wid = tid >> 6, wm = wid >> 1, wn = wid & 1, fr = lane & 15, fq = lane >> 4;
  f32x4 acc[4][4];
  const int NT = N >> 7;
  for (int id = blockIdx.x; id < 64 * NT; id += gridDim.x) {
    int mt, nt;
    tile_map(id, 64, NT, mt, nt);
    gemm_main(A + (size_t)mt * 256 * lda, lda, Bt + (size_t)nt * 128 * K, K, K, smem, acc);
#pragma unroll
    for (int m = 0; m < 4; ++m) {
      const int row = mt * 256 + wm * 64 + m * 16 + fr;
#pragma unroll
      for (int n = 0; n < 4; ++n) {
        const int col = nt * 128 + wn * 64 + n * 16 + fq * 4;
        u32x2 o; o[0] = pack2(acc[m][n][0] * scale, acc[m][n][1] * scale); o[1] = pack2(acc[m][n][2] * scale, acc[m][n][3] * scale);
        *(u32x2*)(out + (size_t)row * N + col) = o;
      }
    }
  }
}

DI void phase_cross_attn(const Params& p, char* smem) {
  const int tid = threadIdx.x, lane = tid & 63, w = tid >> 6, fr = lane & 15, fq = lane >> 4;
  for (int id = blockIdx.x; id < 512; id += gridDim.x) {
    const int b = id >> 7, h = (id >> 5) & 3, qt = id & 31;
    float mx, l;
    const size_t kvb = (size_t)(b * 4 + h) * 256 * 128;
    bfr* dst = p.oc + (size_t)(b * 4096 + qt * 128 + w * 16 + fr) * 512 + h * 128 + fq * 4;
    attn_core<false>(p.qc + (size_t)b * 4096 * 512 + h * 128, 512, qt * 128, p.kc + kvb, p.vc + kvb, 128, 0, smem,
                     [&](int dt, f32x4 a, float lsum) {
                       const float il = 1.f / lsum;
                       u32x2 v; v[0] = pack2(a[0] * il, a[1] * il); v[1] = pack2(a[2] * il, a[3] * il);
                       *(u32x2*)(dst + dt * 16) = v;
                     }, mx, l);
  }
}

DI void phase_peer_route(const Params& p, char* smem) {
  const int tid = threadIdx.x, lane = tid & 63, w = tid >> 6, fr = lane & 15, fq = lane >> 4;
  float* scores = (float*)smem;
  int* lists = (int*)(smem + 135168);
  for (int id = blockIdx.x; id < 1024; id += gridDim.x) {
    const int tt = id >> 3, h = id & 7;
    const int tok0 = tt * 128;
    __syncthreads();
#pragma unroll
    for (int hf = 0; hf < 2; ++hf) {
      const bfr* arow = p.pq + (size_t)(tok0 + w * 16 + fr) * 2048 + h * 256 + hf * 128;
      bf16x8 af[4];
#pragma unroll
      for (int kk = 0; kk < 4; ++kk) af[kk] = *(const bf16x8*)(arow + kk * 32 + fq * 8);
      const bfr* sk = hf ? p.sk2 : p.sk1;
#pragma unroll
      for (int nt = 0; nt < 8; ++nt) {
        f32x4 a = f32x4{0.f, 0.f, 0.f, 0.f};
#pragma unroll
        for (int kk = 0; kk < 4; ++kk) {
          const bf16x8 bfg = *(const bf16x8*)(sk + (nt * 16 + fr) * 128 + kk * 32 + fq * 8);
          a = mfma16(af[kk], bfg, a);
        }
#pragma unroll
        for (int i = 0; i < 4; ++i) scores[(hf * 128 + w * 16 + fq * 4 + i) * 132 + nt * 16 + fr] = a[i];
      }
    }
    __syncthreads();
    if (tid < 256) {
      int lst[16];
#pragma unroll
      for (int j = 0; j < 16; ++j) lst[j] = (int)0x80000000;
      const float* srow = scores + tid * 132;
      for (int k4 = 0; k4 < 32; ++k4) {
        const float4 v = *(const float4*)(srow + k4 * 4);
        topk_insert(lst, (f2sort(v.x) & ~0x7F) | (k4 * 4 + 0));
        topk_insert(lst, (f2sort(v.y) & ~0x7F) | (k4 * 4 + 1));
        topk_insert(lst, (f2sort(v.z) & ~0x7F) | (k4 * 4 + 2));
        topk_insert(lst, (f2sort(v.w) & ~0x7F) | (k4 * 4 + 3));
      }
#pragma unroll
      for (int j = 0; j < 16; ++j) lists[tid * 16 + j] = lst[j];
    }
    __syncthreads();
    if (tid < 128) {
      float v1[16], v2[16];
#pragma unroll
      for (int j = 0; j < 16; ++j) {
        v1[j] = sort2f(lists[tid * 16 + j] & ~0x7F);
        v2[j] = sort2f(lists[(128 + tid) * 16 + j] & ~0x7F);
      }
      int top[16];
#pragma unroll
      for (int j = 0; j < 16; ++j) top[j] = (int)0x80000000;
#pragma unroll
      for (int a = 0; a < 16; ++a)
#pragma unroll
        for (int b = 0; b < 16; ++b)
          if ((a + 1) * (b + 1) <= 16) topk_insert(top, (f2sort(v1[a] + v2[b]) & ~0xFF) | (a * 16 + b));
      int ex[16];
      float sum = 0.f;
#pragma unroll
      for (int j = 0; j < 16; ++j) {
        const int code = top[j] & 0xFF;
        const int i1 = lists[tid * 16 + (code >> 4)] & 0x7F;
        const int i2 = lists[(128 + tid) * 16 + (code & 15)] & 0x7F;
        ex[j] = i1 * 128 + i2;
      }
      const float mxv = sort2f(top[0] & ~0xFF);
      float ev[16];
#pragma unroll
      for (int j = 0; j < 16; ++j) { ev[j] = __expf(sort2f(top[j] & ~0xFF) - mxv); sum += ev[j]; }
      const float inv = 1.f / sum;
      const size_t ob = (size_t)(tok0 + tid) * 128 + h * 16;
#pragma unroll
      for (int j4 = 0; j4 < 4; ++j4) {
        int4 iv; iv.x = ex[j4 * 4]; iv.y = ex[j4 * 4 + 1]; iv.z = ex[j4 * 4 + 2]; iv.w = ex[j4 * 4 + 3];
        float4 gv; gv.x = ev[j4 * 4] * inv; gv.y = ev[j4 * 4 + 1] * inv; gv.z = ev[j4 * 4 + 2] * inv; gv.w = ev[j4 * 4 + 3] * inv;
        *(int4*)(p.idx + ob + j4 * 4) = iv;
        *(float4*)(p.gates + ob + j4 * 4) = gv;
      }
    }
  }
}

DI float gelu_tanh(float a) {
  const float u = 0.7978845608028654f * (a + 0.044715f * a * a * a);
  return 0.5f * a * (1.f + tanhf(u));
}

DI void phase_peer_expert(const Params& p) {
  const int lane = threadIdx.x & 63, wid = threadIdx.x >> 6;
  for (int tok = blockIdx.x * 8 + wid; tok < T_TOK; tok += gridDim.x * 8) {
    f32x2 h2[16];
#pragma unroll
    for (int j = 0; j < 2; ++j)
#pragma unroll
      for (int q = 0; q < 2; ++q) {
        const u32x4 t = *(const u32x4*)(p.hbuf + (size_t)tok * 2048 + j * 1024 + lane * 16 + q * 8);
#pragma unroll
        for (int c = 0; c < 4; ++c) { const unsigned tt = t[c]; h2[j * 8 + q * 4 + c] = f32x2{bflo(tt), bfhi(tt)}; }
      }
    f32x2 y2[16];
#pragma unroll
    for (int e = 0; e < 16; ++e) y2[e] = f32x2{0.f, 0.f};
    for (int half = 0; half < 2; ++half) {
      const int myidx = p.idx[(size_t)tok * 128 + half * 64 + lane];
      const float mygate = p.gates[(size_t)tok * 128 + half * 64 + lane];
      const float mysu = p.su[myidx], mysv = p.sv[myidx];
      float amine = 0.f;
      for (int g = 0; g < 8; ++g) {
        float part[8];
#pragma unroll
        for (int k = 0; k < 8; ++k) {
          const int e = __builtin_amdgcn_readlane(myidx, g * 8 + k);
          const unsigned char* row = p.wU8 + (size_t)e * 2048 + lane * 16;
          f32x2 a2 = f32x2{0.f, 0.f};
#pragma unroll
          for (int j = 0; j < 2; ++j) {
            const u32x4 u = *(const u32x4*)(row + j * 1024);
#pragma unroll
            for (int c = 0; c < 4; ++c) {
              const int uu = (int)u[c];
              a2 += __builtin_amdgcn_cvt_pk_f32_fp8(uu, false) * h2[j * 8 + c * 2];
              a2 += __builtin_amdgcn_cvt_pk_f32_fp8(uu, true) * h2[j * 8 + c * 2 + 1];
            }
          }
          part[k] = a2[0] + a2[1];
        }
        {
          const bool up4 = (lane & 4) != 0, up2 = (lane & 2) != 0, up1 = (lane & 1) != 0;
          float q[4];
#pragma unroll
          for (int i = 0; i < 4; ++i) {
            const float keep = up4 ? part[i + 4] : part[i];
            const float send = up4 ? part[i] : part[i + 4];
            q[i] = keep + __shfl_xor(send, 4);
          }
          float r[2];
#pragma unroll
          for (int i = 0; i < 2; ++i) {
            const float keep = up2 ? q[i + 2] : q[i];
            const float send = up2 ? q[i] : q[i + 2];
            r[i] = keep + __shfl_xor(send, 2);
          }
          float v = (up1 ? r[1] : r[0]) + __shfl_xor(up1 ? r[0] : r[1], 1);
          v += __shfl_xor(v, 8);
          v += __shfl_xor(v, 16);
          v += __shfl_xor(v, 32);
          if ((lane >> 3) == g) amine = v;
        }
      }
      const float cval = mygate * gelu_tanh(amine * mysu) * mysv;
      for (int g = 0; g < 8; ++g) {
#pragma unroll
        for (int k = 0; k < 8; ++k) {
          const int e = __builtin_amdgcn_readlane(myidx, g * 8 + k);
          const float ck = __builtin_bit_cast(float, __builtin_amdgcn_readlane(__builtin_bit_cast(int, cval), g * 8 + k));
          const unsigned char* row = p.wV8 + (size_t)e * 2048 + lane * 16;
#pragma unroll
          for (int j = 0; j < 2; ++j) {
            const u32x4 u = *(const u32x4*)(row + j * 1024);
#pragma unroll
            for (int c = 0; c < 4; ++c) {
              const int uu = (int)u[c];
              y2[j * 8 + c * 2] += __builtin_amdgcn_cvt_pk_f32_fp8(uu, false) * ck;
              y2[j * 8 + c * 2 + 1] += __builtin_amdgcn_cvt_pk_f32_fp8(uu, true) * ck;
            }
          }
        }
      }
    }
    float ss = 0.f;
#pragma unroll
    for (int j = 0; j < 2; ++j)
#pragma unroll
      for (int q = 0; q < 4; ++q) {
        const float4 a = *(const float4*)(p.xres + (size_t)tok * 2048 + j * 1024 + lane * 16 + q * 4);
        f32x2& lo = y2[j * 8 + q * 2];
        f32x2& hi = y2[j * 8 + q * 2 + 1];
        lo[0] += a.x; lo[1] += a.y; hi[0] += a.z; hi[1] += a.w;
        ss += lo[0] * lo[0] + lo[1] * lo[1] + hi[0] * hi[0] + hi[1] * hi[1];
      }
    ss = wave_sum(ss);
    const float rs = rsqrtf(ss * (1.f / 2048.f) + 1e-6f);
#pragma unroll
    for (int j = 0; j < 2; ++j)
#pragma unroll
      for (int q = 0; q < 4; ++q) {
        const float4 gq = *(const float4*)(p.g_final + j * 1024 + lane * 16 + q * 4);
        const f32x2 lo = y2[j * 8 + q * 2], hi = y2[j * 8 + q * 2 + 1];
        float4 o;
        o.x = lo[0] * rs * gq.x; o.y = lo[1] * rs * gq.y; o.z = hi[0] * rs * gq.z; o.w = hi[1] * rs * gq.w;
        *(float4*)(p.out + (size_t)tok * 2048 + j * 1024 + lane * 16 + q * 4) = o;
      }
  }
}

__global__ void __launch_bounds__(NTHREADS) mega(Params p, int phase_lo, int phase_hi) {
  __shared__ __attribute__((aligned(16))) char smem[SMEM_BYTES];
  cg::grid_group grid = cg::this_grid();
#define PHASE(k, call) if (phase_lo <= (k) && (k) < phase_hi) { if ((k) > phase_lo) grid.sync(); call; }
  PHASE(0, phase_prep(p, smem))
  PHASE(1, phase_inproj(p, smem))
  PHASE(2, phase_mix_attn(p, smem))
  PHASE(3, phase_pool_combine(p, smem))
  PHASE(4, phase_gemm_resid(p.hbuf, 2048, p.wOutT, 2048, p.x, p.xres, smem))
  PHASE(5, phase_rms(p.xres, p.g_cross, p.hbuf))
  PHASE(6, phase_gemm_bf16(p.hbuf, 2048, p.wCqT, 2048, 512, 0.08838834764831845f, p.qc, smem))
  PHASE(7, phase_cross_attn(p, smem))
  if (ABL != 2) PHASE(8, phase_gemm_resid(p.oc, 512, p.wCoT, 512, p.xres, p.xres, smem))
  PHASE(9, phase_rms(p.xres, p.g_ffn, p.hbuf))
  PHASE(10, phase_gemm_bf16(p.hbuf, 2048, p.wPqT, 2048, 2048, 1.0f, p.pq, smem))
  PHASE(11, phase_peer_route(p, smem))
  PHASE(12, phase_peer_expert(p))
}

extern "C" void kernel_launch(void* const* d_in, const int* in_sizes, int n_in, void* d_out, int out_size, void* d_ws,
                              size_t ws_size, hipStream_t stream) {
  Params p{};
  p.x = (const float*)d_in[0]; p.mem = (const float*)d_in[1]; p.pos = (const int*)d_in[2];
  p.g_mix = (const float*)d_in[3]; p.w_in = (const float*)d_in[4]; p.w_pool = (const float*)d_in[5];
  p.pool_scale = (const float*)d_in[6]; p.w_out = (const float*)d_in[7]; p.g_cross = (const float*)d_in[8];
  p.g_mem = (const float*)d_in[9]; p.w_cq = (const float*)d_in[10]; p.w_ck = (const float*)d_in[11];
  p.w_cv = (const float*)d_in[12]; p.w_co = (const float*)d_in[13]; p.g_ffn = (const float*)d_in[14];
  p.w_pq = (const float*)d_in[15]; p.sk1f = (const float*)d_in[16]; p.sk2f = (const float*)d_in[17];
  p.w_u = (const float*)d_in[18]; p.w_v = (const float*)d_in[19]; p.g_final = (const float*)d_in[20];
  p.out = (float*)d_out;
  char* ws = (char*)d_ws;
  size_t off = 0;
  auto take = [&](size_t bytes) { char* r = ws + off; off += (bytes + 255) & ~(size_t)255; return r; };
  const size_t MB = 1024 * 1024;
  p.wInT = (bfr*)take(16 * MB); p.wPoolT = (bfr*)take(512 * 1024); p.wOutT = (bfr*)take(8 * MB);
  p.wCqT = (bfr*)take(2 * MB); p.wCkT = (bfr*)take(2 * MB); p.wCvT = (bfr*)take(2 * MB); p.wCoT = (bfr*)take(2 * MB);
  p.wPqT = (bfr*)take(8 * MB); p.sk1 = (bfr*)take(32768); p.sk2 = (bfr*)take(32768);
  p.wU8 = (unsigned char*)take(32 * MB); p.wV8 = (unsigned char*)take(32 * MB);
  p.su = (float*)take(65536); p.sv = (float*)take(65536);
  p.memn = (bfr*)take(4 * MB); p.kc = (bfr*)take(1 * MB); p.vc = (bfr*)take(1 * MB);
  p.hbuf = (bfr*)take(64 * MB);
  const size_t r2 = off;
  p.qbuf = (bfr*)take(32 * MB); p.kbuf = (bfr*)take(32 * MB); p.vbuf = (bfr*)take(32 * MB);
  p.pbuf = (bfr*)take(32 * MB); p.mixed = (bfr*)take(32 * MB); p.ob = (bfr*)take(96 * MB);
  p.lse = (float*)take((size_t)3 * T_TOK * 8 * 4);
  const size_t end1 = off;
  off = r2;
  p.xres = (float*)take(128 * MB); p.pq = (bfr*)take(64 * MB); p.qc = (bfr*)take(16 * MB); p.oc = (bfr*)take(16 * MB);
  p.idx = (int*)take(8 * MB); p.gates = (float*)take(8 * MB);
  const size_t end2 = off;
  const size_t need = end1 > end2 ? end1 : end2;
  if (need > ws_size) { fprintf(stderr, "workspace too small: need %zu have %zu\n", need, ws_size); return; }

  static int grid_blocks = 0;
  if (!grid_blocks) {
    int dev = 0, cus = 0, per_cu = 0;
    hipGetDevice(&dev);
    hipDeviceGetAttribute(&cus, hipDeviceAttributeMultiprocessorCount, dev);
    hipOccupancyMaxActiveBlocksPerMultiprocessor(&per_cu, mega, NTHREADS, 0);
    if (per_cu < 1) per_cu = 1;
    if (per_cu > 1) per_cu = 1;
    grid_blocks = cus * per_cu;
  }
#if MULTI_LAUNCH
  for (int ph = 0; ph < NPHASE; ++ph) hipLaunchKernelGGL(mega, dim3(grid_blocks), dim3(NTHREADS), 0, stream, p, ph, ph + 1);
#else
  int lo = 0, hi = NPHASE;
  void* args[] = {&p, &lo, &hi};
  hipError_t e = hipLaunchCooperativeKernel((void*)mega, dim3(grid_blocks), dim3(NTHREADS), args, 0, stream);
  if (e != hipSuccess) fprintf(stderr, "cooperative launch failed: %s (grid %d)\n", hipGetErrorString(e), grid_blocks);
#endif
}
```

```cpp
#include <hip/hip_runtime.h>
#include <hip/hip_cooperative_groups.h>
#include <stdint.h>
#include <stdio.h>
namespace cg = cooperative_groups;

#ifndef ABL
#define ABL 0
#endif
#ifndef MULTI_LAUNCH
#define MULTI_LAUNCH 0
#endif

#define DI __device__ __forceinline__
typedef unsigned short bfr;
using bf16x8 = __attribute__((ext_vector_type(8))) short;
using s16x4  = __attribute__((ext_vector_type(4))) short;
using f32x4  = __attribute__((ext_vector_type(4))) float;
using u32x4  = __attribute__((ext_vector_type(4))) unsigned;
using u32x2  = __attribute__((ext_vector_type(2))) unsigned;
using bf2    = __attribute__((ext_vector_type(2))) __bf16;
using f32x2  = __attribute__((ext_vector_type(2))) float;

constexpr int T_TOK = 16384;
constexpr int NTHREADS = 512;
constexpr int SMEM_BYTES = 151552;
constexpr int NPHASE = 13;

struct Params {
  const float *x, *mem; const int* pos;
  const float *g_mix, *w_in, *w_pool, *pool_scale, *w_out, *g_cross, *g_mem, *w_cq, *w_ck, *w_cv, *w_co, *g_ffn, *w_pq,
              *sk1f, *sk2f, *w_u, *w_v, *g_final;
  float* out;
  bfr *wInT, *wPoolT, *wOutT, *wCqT, *wCkT, *wCvT, *wCoT, *wPqT, *sk1, *sk2;
  unsigned char *wU8, *wV8; float *su, *sv;
  bfr *hbuf, *memn, *kc, *vc;
  bfr *pbuf, *qbuf, *kbuf, *vbuf, *mixed, *ob; float* lse;
  float* xres; bfr *pq, *qc, *oc; int* idx; float* gates;
};

DI unsigned pack2(float a, float b) { bf2 p; p[0] = (__bf16)a; p[1] = (__bf16)b; return __builtin_bit_cast(unsigned, p); }
DI float bflo(unsigned u) { return __uint_as_float(u << 16); }
DI float bfhi(unsigned u) { return __uint_as_float(u & 0xffff0000u); }
DI float wave_sum(float v) {
#pragma unroll
  for (int o = 32; o >= 1; o >>= 1) v += __shfl_xor(v, o);
  return v;
}
DI f32x4 mfma16(bf16x8 a, bf16x8 b, f32x4 c) { return __builtin_amdgcn_mfma_f32_16x16x32_bf16(a, b, c, 0, 0, 0); }
DI s16x4 tr_read(const char* p) {
  return __builtin_amdgcn_ds_read_tr16_b64_v4i16((s16x4 __attribute__((address_space(3)))*)(p));
}

DI void gemm_main(const bfr* __restrict__ A, int lda, const bfr* __restrict__ Bt, int ldb, int K, char* smem,
                  f32x4 (&acc)[4][4]) {
  const int tid = threadIdx.x, lane = tid & 63, wid = tid >> 6, wm = wid >> 1, wn = wid & 1, fr = lane & 15, fq = lane >> 4;
  const int lrow = tid >> 3, lc = tid & 7;
  const int sw = ((lc ^ (lrow & 7)) << 4);
  u32x4 ra[4], rb[2];
  const bfr* ga = A + (size_t)lrow * lda + lc * 8;
  const bfr* gb = Bt + (size_t)lrow * ldb + lc * 8;
#pragma unroll
  for (int m = 0; m < 4; ++m)
#pragma unroll
    for (int n = 0; n < 4; ++n) acc[m][n] = f32x4{0.f, 0.f, 0.f, 0.f};
  const int nk = K >> 6;
#pragma unroll
  for (int i = 0; i < 4; ++i) ra[i] = *(const u32x4*)(ga + (size_t)(64 * i) * lda);
#pragma unroll
  for (int i = 0; i < 2; ++i) rb[i] = *(const u32x4*)(gb + (size_t)(64 * i) * ldb);
  __syncthreads();
#pragma unroll
  for (int i = 0; i < 4; ++i) *(u32x4*)(smem + (lrow + 64 * i) * 128 + sw) = ra[i];
#pragma unroll
  for (int i = 0; i < 2; ++i) *(u32x4*)(smem + 32768 + (lrow + 64 * i) * 128 + sw) = rb[i];
  __syncthreads();
  for (int kt = 0; kt < nk; ++kt) {
    const char* cur = smem + (kt & 1) * 49152;
    char* nxt = smem + ((kt + 1) & 1) * 49152;
    const bool more = (kt + 1 < nk);
    if (more) {
#pragma unroll
      for (int i = 0; i < 4; ++i) ra[i] = *(const u32x4*)(ga + (size_t)(64 * i) * lda + (kt + 1) * 64);
#pragma unroll
      for (int i = 0; i < 2; ++i) rb[i] = *(const u32x4*)(gb + (size_t)(64 * i) * ldb + (kt + 1) * 64);
    }
#pragma unroll
    for (int kk = 0; kk < 2; ++kk) {
      bf16x8 af[4], bf[4];
      const int co = (((kk * 4 + fq) ^ (fr & 7)) << 4);
#pragma unroll
      for (int m = 0; m < 4; ++m) af[m] = *(const bf16x8*)(cur + (wm * 64 + m * 16 + fr) * 128 + co);
#pragma unroll
      for (int n = 0; n < 4; ++n) bf[n] = *(const bf16x8*)(cur + 32768 + (wn * 64 + n * 16 + fr) * 128 + co);
#pragma unroll
      for (int m = 0; m < 4; ++m)
#pragma unroll
        for (int n = 0; n < 4; ++n) acc[m][n] = mfma16(bf[n], af[m], acc[m][n]);
    }
    if (more) {
#pragma unroll
      for (int i = 0; i < 4; ++i) *(u32x4*)(nxt + (lrow + 64 * i) * 128 + sw) = ra[i];
#pragma unroll
      for (int i = 0; i < 2; ++i) *(u32x4*)(nxt + 32768 + (lrow + 64 * i) * 128 + sw) = rb[i];
    }
    __syncthreads();
  }
}

DI void tile_map(int id, int MT, int NT, int& mt, int& nt) {
  if ((NT & 7) == 0 && (MT & 31) == 0) {
    const int round = id >> 8, local = id & 255, xcd = local & 7, j = local >> 3, mtl = j & 3, ntl = j >> 2;
    const int MR = MT >> 5;
    const int mr = round % MR, nr = round / MR;
    mt = mr * 32 + xcd * 4 + mtl;
    nt = nr * 8 + ntl;
  } else {
    mt = id % MT;
    nt = id / MT;
  }
}

template <bool BANDED, class StoreF>
DI void attn_core(const bfr* __restrict__ Qb, int qstride, int q0, const bfr* __restrict__ Kb, const bfr* __restrict__ Vb,
                  int kvstride, int key0, char* smem, StoreF store, float& m_out, float& l_out) {
  const int tid = threadIdx.x, lane = tid & 63, w = tid >> 6, fr = lane & 15, fq = lane >> 4;
  char* sK = smem;
  char* sV = smem + 65536;
  __syncthreads();
#pragma unroll 1
  for (int rr = 0; rr < 2; ++rr) {
    u32x4 kr[4], vr[4];
#pragma unroll
    for (int i = 0; i < 4; ++i) {
      const int id = tid + (rr * 4 + i) * 512, key = id >> 4, c = id & 15, lk = key0 + key;
      kr[i] = u32x4{0u, 0u, 0u, 0u};
      vr[i] = u32x4{0u, 0u, 0u, 0u};
      if (lk >= 0) {
        kr[i] = *(const u32x4*)(Kb + (long)lk * kvstride + c * 8);
        vr[i] = *(const u32x4*)(Vb + (long)lk * kvstride + c * 8);
      }
    }
#pragma unroll
    for (int i = 0; i < 4; ++i) {
      const int id = tid + (rr * 4 + i) * 512, key = id >> 4, c = id & 15;
      *(u32x4*)(sK + key * 256 + ((c ^ (key & 15)) << 4)) = kr[i];
      *(u32x4*)(sV + key * 288 + c * 16) = vr[i];
    }
  }
  bf16x8 qf[4];
  {
    const bfr* qrow = Qb + (long)(q0 + w * 16 + fr) * qstride;
#pragma unroll
    for (int kk = 0; kk < 4; ++kk) qf[kk] = *(const bf16x8*)(qrow + kk * 32 + fq * 8);
  }
  __syncthreads();
  constexpr int NT = BANDED ? 10 : 16;
  const int t0 = BANDED ? (w & ~1) : 0;
  f32x4 s[NT];
#pragma unroll
  for (int j = 0; j < NT; ++j) {
    f32x4 a = f32x4{0.f, 0.f, 0.f, 0.f};
    const int key = (t0 + j) * 16 + fr;
#pragma unroll
    for (int kk = 0; kk < 4; ++kk) {
      const bf16x8 kf = *(const bf16x8*)(sK + key * 256 + (((kk * 4 + fq) ^ fr) << 4));
      a = mfma16(kf, qf[kk], a);
    }
    s[j] = a;
  }
  const float L2E = 1.4426950408889634f;
  const float NINF = -__builtin_inff();
  float mx = NINF;
  const int lq = q0 + w * 16 + fr;
#pragma unroll
  for (int j = 0; j < NT; ++j)
#pragma unroll
    for (int i = 0; i < 4; ++i) {
      float v = s[j][i] * L2E;
      if (BANDED) {
        const int lk = key0 + (t0 + j) * 16 + fq * 4 + i;
        const int dist = lq - lk;
        const bool ok = (lk >= 0) && (dist >= 0) && (dist <= 128);
        v = ok ? v : NINF;
      }
      s[j][i] = v;
      mx = fmaxf(mx, v);
    }
  mx = fmaxf(mx, __shfl_xor(mx, 16));
  mx = fmaxf(mx, __shfl_xor(mx, 32));
  float l = 0.f;
#pragma unroll
  for (int j = 0; j < NT; ++j)
#pragma unroll
    for (int i = 0; i < 4; ++i) {
      const float p = __builtin_amdgcn_exp2f(s[j][i] - mx);
      s[j][i] = p;
      l += p;
    }
  l += __shfl_xor(l, 16);
  l += __shfl_xor(l, 32);
  bf16x8 pf[NT / 2];
#pragma unroll
  for (int c = 0; c < NT / 2; ++c) {
    u32x4 t;
    t[0] = pack2(s[2 * c][0], s[2 * c][1]);
    t[1] = pack2(s[2 * c][2], s[2 * c][3]);
    t[2] = pack2(s[2 * c + 1][0], s[2 * c + 1][1]);
    t[3] = pack2(s[2 * c + 1][2], s[2 * c + 1][3]);
    pf[c] = __builtin_bit_cast(bf16x8, t);
  }
  const int q4 = (lane & 15) >> 2, p4 = lane & 3;
  m_out = mx;
  l_out = l;
#pragma unroll 2
  for (int dt = 0; dt < 8; ++dt) {
    f32x4 a = f32x4{0.f, 0.f, 0.f, 0.f};
#pragma unroll
    for (int c = 0; c < NT / 2; ++c) {
      const int kb = (t0 + 2 * c) * 16;
      const s16x4 lo = tr_read(sV + (kb + fq * 4 + q4) * 288 + (dt * 16 + p4 * 4) * 2);
      const s16x4 hi = tr_read(sV + (kb + 16 + fq * 4 + q4) * 288 + (dt * 16 + p4 * 4) * 2);
      const bf16x8 vf = __builtin_shufflevector(lo, hi, 0, 1, 2, 3, 4, 5, 6, 7);
      a = mfma16(vf, pf[c], a);
    }
    store(dt, a, l);
  }
}

DI int f2sort(float f) { int b = __float_as_int(f); return b ^ ((b >> 31) & 0x7fffffff); }
DI float sort2f(int s) { int b = s ^ ((s >> 31) & 0x7fffffff); return __int_as_float(b); }
DI void topk_insert(int (&lst)[16], int key) {
#pragma unroll
  for (int j = 0; j < 16; ++j) {
    const int hi = max(lst[j], key);
    key = min(lst[j], key);
    lst[j] = hi;
  }
}

template <int O, int N>
DI void bfly(float (&p)[64], int lane) {
  const bool up = (lane & O) != 0;
#pragma unroll
  for (int i = 0; i < N / 2; ++i) {
    const float keep = up ? p[i + N / 2] : p[i];
    const float send = up ? p[i] : p[i + N / 2];
    p[i] = keep + __shfl_xor(send, O);
  }
  if constexpr (O > 1) bfly<O / 2, N / 2>(p, lane);
}

DI void rms_row_to_bf16(const float* __restrict__ x, const float* __restrict__ g, bfr* __restrict__ out, int lane) {
  float4 v[8];
  float ss = 0.f;
#pragma unroll
  for (int j = 0; j < 8; ++j) {
    v[j] = *(const float4*)(x + j * 256 + lane * 4);
    ss += v[j].x * v[j].x + v[j].y * v[j].y + v[j].z * v[j].z + v[j].w * v[j].w;
  }
  ss = wave_sum(ss);
  const float rs = rsqrtf(ss * (1.f / 2048.f) + 1e-6f);
#pragma unroll
  for (int j = 0; j < 8; ++j) {
    const float4 gg = *(const float4*)(g + j * 256 + lane * 4);
    u32x2 o;
    o[0] = pack2(v[j].x * rs * gg.x, v[j].y * rs * gg.y);
    o[1] = pack2(v[j].z * rs * gg.z, v[j].w * rs * gg.w);
    *(u32x2*)(out + j * 256 + lane * 4) = o;
  }
}

DI void transpose_tile(const float* __restrict__ W, int K, int N, int k0, int n0, bfr* __restrict__ Wt, float* tile) {
  __syncthreads();
  {
    const int r = threadIdx.x >> 4, c4 = threadIdx.x & 15;
#pragma unroll
    for (int i = 0; i < 2; ++i) {
      const int k = r + 32 * i;
      const float4 v = *(const float4*)(W + (size_t)(k0 + k) * N + n0 + c4 * 4);
      tile[k * 65 + c4 * 4 + 0] = v.x;
      tile[k * 65 + c4 * 4 + 1] = v.y;
      tile[k * 65 + c4 * 4 + 2] = v.z;
      tile[k * 65 + c4 * 4 + 3] = v.w;
    }
  }
  __syncthreads();
  {
    const int n = threadIdx.x >> 3, kc = threadIdx.x & 7;
    u32x4 o;
#pragma unroll
    for (int j = 0; j < 4; ++j) o[j] = pack2(tile[(kc * 8 + 2 * j) * 65 + n], tile[(kc * 8 + 2 * j + 1) * 65 + n]);
    *(u32x4*)(Wt + (size_t)(n0 + n) * K + k0 + kc * 8) = o;
  }
}

DI void convert_f32_bf16(const float* __restrict__ src, bfr* __restrict__ dst, long n8) {
  for (long i = (long)blockIdx.x * NTHREADS + threadIdx.x; i < n8; i += (long)gridDim.x * NTHREADS) {
    const float4 a = *(const float4*)(src + i * 8);
    const float4 b = *(const float4*)(src + i * 8 + 4);
    u32x4 o;
    o[0] = pack2(a.x, a.y); o[1] = pack2(a.z, a.w); o[2] = pack2(b.x, b.y); o[3] = pack2(b.z, b.w);
    *(u32x4*)(dst + i * 8) = o;
  }
}

DI void phase_prep(const Params& p, char* smem) {
  const int lane = threadIdx.x & 63, wid = threadIdx.x >> 6;
  for (int r = blockIdx.x * 8 + wid; r < T_TOK + 1024; r += gridDim.x * 8) {
    if (r < T_TOK) rms_row_to_bf16(p.x + (size_t)r * 2048, p.g_mix, p.hbuf + (size_t)r * 2048, lane);
    else rms_row_to_bf16(p.mem + (size_t)(r - T_TOK) * 2048, p.g_mem, p.memn + (size_t)(r - T_TOK) * 2048, lane);
  }
  float* tile = (float*)smem;
  for (int id0 = blockIdx.x; id0 < 5184; id0 += gridDim.x) {
    int id = id0;
    const float* W; bfr* Wt; int K, N;
    if (id < 2048) { W = p.w_in; Wt = p.wInT; K = 2048; N = 4096; }
    else if ((id -= 2048) < 1024) { W = p.w_out; Wt = p.wOutT; K = 2048; N = 2048; }
    else if ((id -= 1024) < 1024) { W = p.w_pq; Wt = p.wPqT; K = 2048; N = 2048; }
    else if ((id -= 1024) < 256) { W = p.w_cq; Wt = p.wCqT; K = 2048; N = 512; }
    else if ((id -= 256) < 256) { W = p.w_ck; Wt = p.wCkT; K = 2048; N = 512; }
    else if ((id -= 256) < 256) { W = p.w_cv; Wt = p.wCvT; K = 2048; N = 512; }
    else if ((id -= 256) < 256) { W = p.w_co; Wt = p.wCoT; K = 512; N = 2048; }
    else { id -= 256; const int g = id >> 4; id &= 15; W = p.w_pool + g * 65536; Wt = p.wPoolT + g * 65536; K = 256; N = 256; }
    const int ntn = N >> 6;
    const int kt = id / ntn, nt = id % ntn;
    transpose_tile(W, K, N, kt * 64, nt * 64, Wt, tile);
  }
  convert_f32_bf16(p.sk1f, p.sk1, 128 * 128 / 8);
  convert_f32_bf16(p.sk2f, p.sk2, 128 * 128 / 8);
  for (int r = blockIdx.x * 8 + wid; r < 2 * 16384; r += gridDim.x * 8) {
    const bool isv = r >= 16384;
    const int rr = isv ? r - 16384 : r;
    const float* src = (isv ? p.w_v : p.w_u) + (size_t)rr * 2048;
    unsigned char* dst = (isv ? p.wV8 : p.wU8) + (size_t)rr * 2048;
    float4 v[8];
    float amax = 0.f;
#pragma unroll
    for (int j = 0; j < 2; ++j)
#pragma unroll
      for (int q = 0; q < 4; ++q) {
        v[j * 4 + q] = *(const float4*)(src + j * 1024 + lane * 16 + q * 4);
        const float4 t = v[j * 4 + q];
        amax = fmaxf(amax, fmaxf(fmaxf(fabsf(t.x), fabsf(t.y)), fmaxf(fabsf(t.z), fabsf(t.w))));
      }
#pragma unroll
    for (int o = 32; o >= 1; o >>= 1) amax = fmaxf(amax, __shfl_xor(amax, o));
    const float inv = amax > 0.f ? 448.f / amax : 0.f;
    if (lane == 0) (isv ? p.sv : p.su)[rr] = amax * (1.f / 448.f);
#pragma unroll
    for (int j = 0; j < 2; ++j) {
      u32x4 o4;
#pragma unroll
      for (int q = 0; q < 4; ++q) {
        const float4 t = v[j * 4 + q];
        int w = 0;
        w = __builtin_amdgcn_cvt_pk_fp8_f32(t.x * inv, t.y * inv, w, false);
        w = __builtin_amdgcn_cvt_pk_fp8_f32(t.z * inv, t.w * inv, w, true);
        o4[q] = (unsigned)w;
      }
      *(u32x4*)(dst + j * 1024 + lane * 16) = o4;
    }
  }
}

DI void phase_inproj(const Params& p, char* smem) {
  const int tid = threadIdx.x, lane = tid & 63, wid = tid >> 6, wm = wid >> 1, wn = wid & 1, fr = lane & 15, fq = lane >> 4;
  f32x4 acc[4][4];
  for (int id = blockIdx.x; id < 2048 + 32; id += gridDim.x) {
    if (id < 2048) {
      int mt, nt;
      tile_map(id, 64, 32, mt, nt);
      gemm_main(p.hbuf + (size_t)mt * 256 * 2048, 2048, p.wInT + (size_t)nt * 128 * 2048, 2048, 2048, smem, acc);
      const int region = nt >> 3, h = nt & 7;
      if (region == 0) {
#pragma unroll
        for (int m = 0; m < 4; ++m) {
          const int row = mt * 256 + wm * 64 + m * 16 + fr;
#pragma unroll
          for (int n = 0; n < 4; ++n) {
            const int col = nt * 128 + wn * 64 + n * 16 + fq * 4;
            u32x2 o; o[0] = pack2(acc[m][n][0], acc[m][n][1]); o[1] = pack2(acc[m][n][2], acc[m][n][3]);
            *(u32x2*)(p.pbuf + (size_t)row * 1024 + col) = o;
          }
        }
      } else {
        bfr* dst = (region == 1) ? p.qbuf : (region == 2 ? p.kbuf : p.vbuf);
        const float scale = (region == 1) ? 0.08838834764831845f : 1.0f;
#pragma unroll
        for (int m = 0; m < 4; ++m) {
          const int row = mt * 256 + wm * 64 + m * 16 + fr;
          const int b = row >> 12, t = row & 4095;
          if (region != 3 && wn == 0) {
            const float posf = (float)p.pos[row];
#pragma unroll
            for (int i = 0; i < 4; ++i) {
              const int j = fq * 4 + i;
              const float inv = exp2f(-(float)j * (18.931568569324174f / 16.0f));
              float sn, cs;
              sincosf(posf * inv, &sn, &cs);
              const float x1 = acc[m][0][i], x2 = acc[m][1][i];
              acc[m][0][i] = x1 * cs - x2 * sn;
              acc[m][1][i] = x2 * cs + x1 * sn;
            }
          }
#pragma unroll
          for (int n = 0; n < 4; ++n) {
            const int d = wn * 64 + n * 16 + fq * 4;
            u32x2 o;
            o[0] = pack2(acc[m][n][0] * scale, acc[m][n][1] * scale);
            o[1] = pack2(acc[m][n][2] * scale, acc[m][n][3] * scale);
            *(u32x2*)(dst + ((size_t)((b * 8 + h) * 4096 + t)) * 128 + d) = o;
          }
        }
      }
    } else {
      const int id2 = id - 2048;
      const int which = id2 >> 4, mt = (id2 >> 2) & 3, nt = id2 & 3;
      const bfr* Bt = (which == 0 ? p.wCkT : p.wCvT) + (size_t)nt * 128 * 2048;
      bfr* dst = which == 0 ? p.kc : p.vc;
      gemm_main(p.memn + (size_t)mt * 256 * 2048, 2048, Bt, 2048, 2048, smem, acc);
#pragma unroll
      for (int m = 0; m < 4; ++m) {
        const int row = mt * 256 + wm * 64 + m * 16 + fr;
        const int b = row >> 8, mm = row & 255;
#pragma unroll
        for (int n = 0; n < 4; ++n) {
          const int d = wn * 64 + n * 16 + fq * 4;
          u32x2 o; o[0] = pack2(acc[m][n][0], acc[m][n][1]); o[1] = pack2(acc[m][n][2], acc[m][n][3]);
          *(u32x2*)(dst + ((size_t)((b * 4 + nt) * 256 + mm)) * 128 + d) = o;
        }
      }
    }
  }
}

DI void phase_mix_attn(const Params& p, char* smem) {
  const int tid = threadIdx.x, lane = tid & 63, w = tid >> 6, fr = lane & 15, fq = lane >> 4;
  for (int id = blockIdx.x; id < 3072 + 256; id += gridDim.x) {
    if (id < 3072) {
      const int br = id >> 10, rem = id & 1023;
      const int dl = (br == 0) ? 1 : (br == 1 ? 4 : 16);
      const int nblk = 32 / dl;
      const int bh = rem >> 5, rn = rem & 31;
      const int r = rn / nblk, nb = rn % nblk;
      const int l0 = nb * 128;
      const size_t base = (size_t)bh * 4096 * 128 + (size_t)r * 128;
      float mx, l;
      const int b = bh >> 3, h = bh & 7;
      const int tt = b * 4096 + (l0 + w * 16 + fr) * dl + r;
      bfr* dst = p.ob + (size_t)br * T_TOK * 1024 + (size_t)tt * 1024 + h * 128 + fq * 4;
      attn_core<true>(p.qbuf + base, dl * 128, l0, p.kbuf + base, p.vbuf + base, dl * 128, l0 - 128, smem,
                      [&](int dt, f32x4 a, float lsum) {
                        const float il = 1.f / lsum;
                        u32x2 v; v[0] = pack2(a[0] * il, a[1] * il); v[1] = pack2(a[2] * il, a[3] * il);
                        *(u32x2*)(dst + dt * 16) = v;
                      }, mx, l);
      if (fq == 0) p.lse[(size_t)br * T_TOK * 8 + (size_t)tt * 8 + h] = mx + __builtin_amdgcn_logf(l);
    } else {
      const int ci = id - 3072;
      const int sub = tid >> 7, cgp = tid & 127;
      const int wdw = 2 << (cgp >> 5);
      const int t0 = ci * 64 + sub * 16, tin0 = t0 & 4095;
      const bfr* pb = p.pbuf + cgp * 8;
      float sum[8];
#pragma unroll
      for (int e = 0; e < 8; ++e) sum[e] = 0.f;
      for (int j = 1; j < wdw; ++j) {
        if (tin0 - j >= 0) {
          const u32x4 v = *(const u32x4*)(pb + (size_t)(t0 - j) * 1024);
#pragma unroll
          for (int e = 0; e < 4; ++e) { sum[2 * e] += bflo(v[e]); sum[2 * e + 1] += bfhi(v[e]); }
        }
      }
      for (int s = 0; s < 16; ++s) {
        const int t = t0 + s, tin = tin0 + s;
        const u32x4 v = *(const u32x4*)(pb + (size_t)t * 1024);
        float cur[8];
#pragma unroll
        for (int e = 0; e < 4; ++e) { cur[2 * e] = bflo(v[e]); cur[2 * e + 1] = bfhi(v[e]); }
        const float ic = 1.f / (float)min(tin + 1, wdw);
        u32x4 ov;
#pragma unroll
        for (int e = 0; e < 8; ++e) sum[e] += cur[e];
#pragma unroll
        for (int e = 0; e < 4; ++e) ov[e] = pack2(sum[2 * e] * ic - cur[2 * e], sum[2 * e + 1] * ic - cur[2 * e + 1]);
        *(u32x4*)(p.mixed + (size_t)t * 1024 + cgp * 8) = ov;
        if (tin - wdw + 1 >= 0) {
          const u32x4 u = *(const u32x4*)(pb + (size_t)(t - wdw + 1) * 1024);
#pragma unroll
          for (int e = 0; e < 4; ++e) { sum[2 * e] -= bflo(u[e]); sum[2 * e + 1] -= bfhi(u[e]); }
        }
      }
    }
  }
}

DI void phase_pool_combine(const Params& p, char* smem) {
  const int tid = threadIdx.x, lane = tid & 63, wid = tid >> 6, wm = wid >> 1, wn = wid & 1, fr = lane & 15, fq = lane >> 4;
  f32x4 acc[4][4];
  for (int id = blockIdx.x; id < 512; id += gridDim.x) {
    const int g = id >> 7, mt = (id >> 1) & 63, nt = id & 1;
    gemm_main(p.mixed + (size_t)mt * 256 * 1024 + g * 256, 1024, p.wPoolT + (size_t)g * 65536 + (size_t)nt * 128 * 256, 256, 256,
              smem, acc);
#pragma unroll
    for (int m = 0; m < 4; ++m) {
      const int row = mt * 256 + wm * 64 + m * 16 + fr;
#pragma unroll
      for (int n = 0; n < 4; ++n) {
        const int e = nt * 128 + wn * 64 + n * 16 + fq * 4;
        const float4 sc = *(const float4*)(p.pool_scale + g * 256 + e);
        u32x2 o; o[0] = pack2(acc[m][n][0] * sc.x, acc[m][n][1] * sc.y); o[1] = pack2(acc[m][n][2] * sc.z, acc[m][n][3] * sc.w);
        *(u32x2*)(p.hbuf + (size_t)row * 2048 + g * 256 + e) = o;
      }
    }
  }
  for (long i = (long)blockIdx.x * NTHREADS + tid; i < (long)T_TOK * 8 * 16; i += (long)gridDim.x * NTHREADS) {
    const int dc = (int)(i & 15), h = (int)((i >> 4) & 7);
    const long tt = i >> 7;
    const float l0 = p.lse[tt * 8 + h], l1 = p.lse[(size_t)T_TOK * 8 + tt * 8 + h], l2 = p.lse[(size_t)2 * T_TOK * 8 + tt * 8 + h];
    const float mx = fmaxf(l0, fmaxf(l1, l2));
    float w0 = __builtin_amdgcn_exp2f(l0 - mx), w1 = __builtin_amdgcn_exp2f(l1 - mx), w2 = __builtin_amdgcn_exp2f(l2 - mx);
    const float inv = 1.f / (w0 + w1 + w2);
    w0 *= inv; w1 *= inv; w2 *= inv;
    if (ABL == 3) { w0 = 0.f; w1 = 0.f; w2 = 0.f; }
    const size_t off = (size_t)tt * 1024 + h * 128 + dc * 8;
    const u32x4 a = *(const u32x4*)(p.ob + off);
    const u32x4 b = *(const u32x4*)(p.ob + (size_t)T_TOK * 1024 + off);
    const u32x4 c = *(const u32x4*)(p.ob + (size_t)2 * T_TOK * 1024 + off);
    u32x4 o;
#pragma unroll
    for (int e = 0; e < 4; ++e)
      o[e] = pack2(w0 * bflo(a[e]) + w1 * bflo(b[e]) + w2 * bflo(c[e]), w0 * bfhi(a[e]) + w1 * bfhi(b[e]) + w2 * bfhi(c[e]));
    *(u32x4*)(p.hbuf + (size_t)tt * 2048 + 1024 + h * 128 + dc * 8) = o;
  }
}

DI void phase_gemm_resid(const bfr* A, int lda, const bfr* Bt, int K, const float* resid, float* xout, char* smem) {
  const int tid = threadIdx.x, lane = tid & 63, wid = tid >> 6, wm = wid >> 1, wn = wid & 1, fr = lane & 15, fq = lane >> 4;
  f32x4 acc[4][4];
  for (int id = blockIdx.x; id < 1024; id += gridDim.x) {
    int mt, nt;
    tile_map(id, 64, 16, mt, nt);
    gemm_main(A + (size_t)mt * 256 * lda, lda, Bt + (size_t)nt * 128 * K, K, K, smem, acc);
#pragma unroll
    for (int m = 0; m < 4; ++m) {
      const int row = mt * 256 + wm * 64 + m * 16 + fr;
#pragma unroll
      for (int n = 0; n < 4; ++n) {
        const int col = nt * 128 + wn * 64 + n * 16 + fq * 4;
        const float4 r = *(const float4*)(resid + (size_t)row * 2048 + col);
        float4 o; o.x = r.x + acc[m][n][0]; o.y = r.y + acc[m][n][1]; o.z = r.z + acc[m][n][2]; o.w = r.w + acc[m][n][3];
        *(float4*)(xout + (size_t)row * 2048 + col) = o;
      }
    }
  }
}

DI void phase_rms(const float* xin, const float* g, bfr* out) {
  const int lane = threadIdx.x & 63, wid = threadIdx.x >> 6;
  for (int r = blockIdx.x * 8 + wid; r < T_TOK; r += gridDim.x * 8)
    rms_row_to_bf16(xin + (size_t)r * 2048, g, out + (size_t)r * 2048, lane);
}

DI void phase_gemm_bf16(const bfr* A, int lda, const bfr* Bt, int K, int N, float scale, bfr* out, char* smem) {
  const int tid = threadIdx.x, lane = tid & 63, wid = tid >> 6, wm = wid >> 1, wn = wid & 1, fr = lane & 15, fq = lane >> 4;
  f32x4 acc[4][4];
  const int NT = N >> 7;
  for (int id = blockIdx.x; id < 64 * NT; id += gridDim.x) {
    int mt, nt;
    tile_map(id, 64, NT, mt, nt);
    gemm_main(A + (size_t)mt * 256 * lda, lda, Bt + (size_t)nt * 128 * K, K, K, smem, acc);
#pragma unroll
    for (int m = 0; m < 4; ++m) {
      const int row = mt * 256 + wm * 64 + m * 16 + fr;
#pragma unroll
      for (int n = 0; n < 4; ++n) {
        const int col = nt * 128 + wn * 64 + n * 16 + fq * 4;
        u32x2 o; o[0] = pack2(acc[m][n][0] * scale, acc[m][n][1] * scale); o[1] = pack2(acc[m][n][2] * scale, acc[m][n][3] * scale);
        *(u32x2*)(out + (size_t)row * N + col) = o;
      }
    }
  }
}

DI void phase_cross_attn(const Params& p, char* smem) {
  const int tid = threadIdx.x, lane = tid & 63, w = tid >> 6, fr = lane & 15, fq = lane >> 4;
  for (int id = blockIdx.x; id < 512; id += gridDim.x) {
    const int b = id >> 7, h = (id >> 5) & 3, qt = id & 31;
    float mx, l;
    const size_t kvb = (size_t)(b * 4 + h) * 256 * 128;
    bfr* dst = p.oc + (size_t)(b * 4096 + qt * 128 + w * 16 + fr) * 512 + h * 128 + fq * 4;
    attn_core<false>(p.qc + (size_t)b * 4096 * 512 + h * 128, 512, qt * 128, p.kc + kvb, p.vc + kvb, 128, 0, smem,
                     [&](int dt, f32x4 a, float lsum) {
                       const float il = 1.f / lsum;
                       u32x2 v; v[0] = pack2(a[0] * il, a[1] * il); v[1] = pack2(a[2] * il, a[3] * il);
                       *(u32x2*)(dst + dt * 16) = v;
                     }, mx, l);
  }
}

DI void phase_peer_route(const Params& p, char* smem) {
  const int tid = threadIdx.x, lane = tid & 63, w = tid >> 6, fr = lane & 15, fq = lane >> 4;
  float* scores = (float*)smem;
  int* lists = (int*)(smem + 135168);
  for (int id = blockIdx.x; id < 1024; id += gridDim.x) {
    const int tt = id >> 3, h = id & 7;
    const int tok0 = tt * 128;
    __syncthreads();
#pragma unroll
    for (int hf = 0; hf < 2; ++hf) {
      const bfr* arow = p.pq + (size_t)(tok0 + w * 16 + fr) * 2048 + h * 256 + hf * 128;
      bf16x8 af[4];
#pragma unroll
      for (int kk = 0; kk < 4; ++kk) af[kk] = *(const bf16x8*)(arow + kk * 32 + fq * 8);
      const bfr* sk = hf ? p.sk2 : p.sk1;
#pragma unroll
      for (int nt = 0; nt < 8; ++nt) {
        f32x4 a = f32x4{0.f, 0.f, 0.f, 0.f};
#pragma unroll
        for (int kk = 0; kk < 4; ++kk) {
          const bf16x8 bfg = *(const bf16x8*)(sk + (nt * 16 + fr) * 128 + kk * 32 + fq * 8);
          a = mfma16(af[kk], bfg, a);
        }
#pragma unroll
        for (int i = 0; i < 4; ++i) scores[(hf * 128 + w * 16 + fq * 4 + i) * 132 + nt * 16 + fr] = a[i];
      }
    }
    __syncthreads();
    if (tid < 256) {
      int lst[16];
#pragma unroll
      for (int j = 0; j < 16; ++j) lst[j] = (int)0x80000000;
      const float* srow = scores + tid * 132;
      for (int k4 = 0; k4 < 32; ++k4) {
        const float4 v = *(const float4*)(srow + k4 * 4);
        topk_insert(lst, (f2sort(v.x) & ~0x7F) | (k4 * 4 + 0));
        topk_insert(lst, (f2sort(v.y) & ~0x7F) | (k4 * 4 + 1));
        topk_insert(lst, (f2sort(v.z) & ~0x7F) | (k4 * 4 + 2));
        topk_insert(lst, (f2sort(v.w) & ~0x7F) | (k4 * 4 + 3));
      }
#pragma unroll
      for (int j = 0; j < 16; ++j) lists[tid * 16 + j] = lst[j];
    }
    __syncthreads();
    if (tid < 128) {
      float v1[16], v2[16];
#pragma unroll
      for (int j = 0; j < 16; ++j) {
        v1[j] = sort2f(lists[tid * 16 + j] & ~0x7F);
        v2[j] = sort2f(lists[(128 + tid) * 16 + j] & ~0x7F);
      }
      int top[16];
#pragma unroll
      for (int j = 0; j < 16; ++j) top[j] = (int)0x80000000;
#pragma unroll
      for (int a = 0; a < 16; ++a)
#pragma unroll
        for (int b = 0; b < 16; ++b)
          if ((a + 1) * (b + 1) <= 16) topk_insert(top, (f2sort(v1[a] + v2[b]) & ~0xFF) | (a * 16 + b));
      int ex[16];
      float sum = 0.f;
#pragma unroll
      for (int j = 0; j < 16; ++j) {
        const int code = top[j] & 0xFF;
        const int i1 = lists[tid * 16 + (code >> 4)] & 0x7F;
        const int i2 = lists[(128 + tid) * 16 + (code & 15)] & 0x7F;
        ex[j] = i1 * 128 + i2;
      }
      const float mxv = sort2f(top[0] & ~0xFF);
      float ev[16];
#pragma unroll
      for (int j = 0; j < 16; ++j) { ev[j] = __expf(sort2f(top[j] & ~0xFF) - mxv); sum += ev[j]; }
      const float inv = 1.f / sum;
      const size_t ob = (size_t)(tok0 + tid) * 128 + h * 16;
#pragma unroll
      for (int j4 = 0; j4 < 4; ++j4) {
        int4 iv; iv.x = ex[j4 * 4]; iv.y = ex[j4 * 4 + 1]; iv.z = ex[j4 * 4 + 2]; iv.w = ex[j4 * 4 + 3];
        float4 gv; gv.x = ev[j4 * 4] * inv; gv.y = ev[j4 * 4 + 1] * inv; gv.z = ev[j4 * 4 + 2] * inv; gv.w = ev[j4 * 4 + 3] * inv;
        *(int4*)(p.idx + ob + j4 * 4) = iv;
        *(float4*)(p.gates + ob + j4 * 4) = gv;
      }
    }
  }
}

DI float gelu_tanh(float a) {
  const float u = 0.7978845608028654f * (a + 0.044715f * a * a * a);
  return 0.5f * a * (1.f + tanhf(u));
}

#define SB() __builtin_amdgcn_sched_barrier(0)
DI void peer_load8(u32x4 (&buf)[16], const unsigned char* tbl, int idxv, int g, int lane) {
#pragma unroll
  for (int k = 0; k < 8; ++k) {
    const int e = __builtin_amdgcn_readlane(idxv, g * 8 + k);
    const unsigned char* row = tbl + (size_t)e * 2048 + lane * 16;
    buf[2 * k] = *(const u32x4*)row;
    buf[2 * k + 1] = *(const u32x4*)(row + 1024);
  }
}
DI float peer_dot8(const u32x4 (&buf)[16], const f32x2 (&h2)[16], int lane) {
  float part[8];
#pragma unroll
  for (int k = 0; k < 8; ++k) {
    f32x2 a2 = f32x2{0.f, 0.f};
#pragma unroll
    for (int j = 0; j < 2; ++j) {
      const u32x4 u = buf[2 * k + j];
#pragma unroll
      for (int c = 0; c < 4; ++c) {
        const int uu = (int)u[c];
        a2 += __builtin_amdgcn_cvt_pk_f32_fp8(uu, false) * h2[j * 8 + c * 2];
        a2 += __builtin_amdgcn_cvt_pk_f32_fp8(uu, true) * h2[j * 8 + c * 2 + 1];
      }
    }
    part[k] = a2[0] + a2[1];
  }
  const bool up4 = (lane & 4) != 0, up2 = (lane & 2) != 0, up1 = (lane & 1) != 0;
  float q[4];
#pragma unroll
  for (int i = 0; i < 4; ++i) {
    const float keep = up4 ? part[i + 4] : part[i];
    const float send = up4 ? part[i] : part[i + 4];
    q[i] = keep + __shfl_xor(send, 4);
  }
  float r[2];
#pragma unroll
  for (int i = 0; i < 2; ++i) {
    const float keep = up2 ? q[i + 2] : q[i];
    const float send = up2 ? q[i] : q[i + 2];
    r[i] = keep + __shfl_xor(send, 2);
  }
  float v = (up1 ? r[1] : r[0]) + __shfl_xor(up1 ? r[0] : r[1], 1);
  v += __shfl_xor(v, 8);
  v += __shfl_xor(v, 16);
  v += __shfl_xor(v, 32);
  return v;
}
DI void peer_acc8(const u32x4 (&buf)[16], f32x2 (&y2)[16], float cval, int g) {
#pragma unroll
  for (int k = 0; k < 8; ++k) {
    const float ck = __builtin_bit_cast(float, __builtin_amdgcn_readlane(__builtin_bit_cast(int, cval), g * 8 + k));
#pragma unroll
    for (int j = 0; j < 2; ++j) {
      const u32x4 u = buf[2 * k + j];
#pragma unroll
      for (int c = 0; c < 4; ++c) {
        const int uu = (int)u[c];
        y2[j * 8 + c * 2] += __builtin_amdgcn_cvt_pk_f32_fp8(uu, false) * ck;
        y2[j * 8 + c * 2 + 1] += __builtin_amdgcn_cvt_pk_f32_fp8(uu, true) * ck;
      }
    }
  }
}

DI void phase_peer_expert(const Params& p) {
  const int lane = threadIdx.x & 63, wid = threadIdx.x >> 6;
  for (int tok = blockIdx.x * 8 + wid; tok < T_TOK; tok += gridDim.x * 8) {
    int myidx[2];
    float mygate[2];
#pragma unroll
    for (int half = 0; half < 2; ++half) {
      myidx[half] = p.idx[(size_t)tok * 128 + half * 64 + lane];
      mygate[half] = p.gates[(size_t)tok * 128 + half * 64 + lane];
    }
    u32x4 bufA[16], bufB[16];
    peer_load8(bufA, p.wU8, myidx[0], 0, lane);
    f32x2 h2[16];
#pragma unroll
    for (int j = 0; j < 2; ++j)
#pragma unroll
      for (int q = 0; q < 2; ++q) {
        const u32x4 t = *(const u32x4*)(p.hbuf + (size_t)tok * 2048 + j * 1024 + lane * 16 + q * 8);
#pragma unroll
        for (int c = 0; c < 4; ++c) { const unsigned tt = t[c]; h2[j * 8 + q * 4 + c] = f32x2{bflo(tt), bfhi(tt)}; }
      }
    f32x2 y2[16];
#pragma unroll
    for (int e = 0; e < 16; ++e) y2[e] = f32x2{0.f, 0.f};
#pragma unroll 1
    for (int half = 0; half < 2; ++half) {
      const int idxv = half ? myidx[1] : myidx[0];
      const float gate = half ? mygate[1] : mygate[0];
      const float mysu = p.su[idxv], mysv = p.sv[idxv];
      float amine = 0.f;
#pragma unroll 1
      for (int g2 = 0; g2 < 4; ++g2) {
        peer_load8(bufB, p.wU8, idxv, 2 * g2 + 1, lane);
        SB();
        { const float v = peer_dot8(bufA, h2, lane); if ((lane >> 3) == 2 * g2) amine = v; }
        SB();
        peer_load8(bufA, g2 < 3 ? p.wU8 : p.wV8, idxv, g2 < 3 ? 2 * g2 + 2 : 0, lane);
        SB();
        { const float v = peer_dot8(bufB, h2, lane); if ((lane >> 3) == 2 * g2 + 1) amine = v; }
        SB();
      }
      const float cval = gate * gelu_tanh(amine * mysu) * mysv;
      const int nidx = myidx[1];
#pragma unroll 1
      for (int g2 = 0; g2 < 4; ++g2) {
        peer_load8(bufB, p.wV8, idxv, 2 * g2 + 1, lane);
        SB();
        peer_acc8(bufA, y2, cval, 2 * g2);
        SB();
        peer_load8(bufA, g2 < 3 ? p.wV8 : p.wU8, g2 < 3 ? idxv : nidx, g2 < 3 ? 2 * g2 + 2 : 0, lane);
        SB();
        peer_acc8(bufB, y2, cval, 2 * g2 + 1);
        SB();
      }
    }
    float ss = 0.f;
#pragma unroll
    for (int j = 0; j < 2; ++j)
#pragma unroll
      for (int q = 0; q < 4; ++q) {
        const float4 a = *(const float4*)(p.xres + (size_t)tok * 2048 + j * 1024 + lane * 16 + q * 4);
        f32x2& lo = y2[j * 8 + q * 2];
        f32x2& hi = y2[j * 8 + q * 2 + 1];
        lo[0] += a.x; lo[1] += a.y; hi[0] += a.z; hi[1] += a.w;
        ss += lo[0] * lo[0] + lo[1] * lo[1] + hi[0] * hi[0] + hi[1] * hi[1];
      }
    ss = wave_sum(ss);
    const float rs = rsqrtf(ss * (1.f / 2048.f) + 1e-6f);
#pragma unroll
    for (int j = 0; j < 2; ++j)
#pragma unroll
      for (int q = 0; q < 4; ++q) {
        const float4 gq = *(const float4*)(p.g_final + j * 1024 + lane * 16 + q * 4);
        const f32x2 lo = y2[j * 8 + q * 2], hi = y2[j * 8 + q * 2 + 1];
        float4 o;
        o.x = lo[0] * rs * gq.x; o.y = lo[1] * rs * gq.y; o.z = hi[0] * rs * gq.z; o.w = hi[1] * rs * gq.w;
        *(float4*)(p.out + (size_t)tok * 2048 + j * 1024 + lane * 16 + q * 4) = o;
      }
  }
}

__global__ void __launch_bounds__(NTHREADS) mega(Params p, int phase_lo, int phase_hi) {
  __shared__ __attribute__((aligned(16))) char smem[SMEM_BYTES];
  cg::grid_group grid = cg::this_grid();
#define PHASE(k, call) if (phase_lo <= (k) && (k) < phase_hi) { if ((k) > phase_lo) grid.sync(); call; }
  PHASE(0, phase_prep(p, smem))
  PHASE(1, phase_inproj(p, smem))
  PHASE(2, phase_mix_attn(p, smem))
  PHASE(3, phase_pool_combine(p, smem))
  PHASE(4, phase_gemm_resid(p.hbuf, 2048, p.wOutT, 2048, p.x, p.xres, smem))
  PHASE(5, phase_rms(p.xres, p.g_cross, p.hbuf))
  PHASE(6, phase_gemm_bf16(p.hbuf, 2048, p.wCqT, 2048, 512, 0.08838834764831845f, p.qc, smem))
  PHASE(7, phase_cross_attn(p, smem))
  if (ABL != 2) PHASE(8, phase_gemm_resid(p.oc, 512, p.wCoT, 512, p.xres, p.xres, smem))
  PHASE(9, phase_rms(p.xres, p.g_ffn, p.hbuf))
  PHASE(10, phase_gemm_bf16(p.hbuf, 2048, p.wPqT, 2048, 2048, 1.0f, p.pq, smem))
  PHASE(11, phase_peer_route(p, smem))
  PHASE(12, phase_peer_expert(p))
}

extern "C" void kernel_launch(void* const* d_in, const int* in_sizes, int n_in, void* d_out, int out_size, void* d_ws,
                              size_t ws_size, hipStream_t stream) {
  Params p{};
  p.x = (const float*)d_in[0]; p.mem = (const float*)d_in[1]; p.pos = (const int*)d_in[2];
  p.g_mix = (const float*)d_in[3]; p.w_in = (const float*)d_in[4]; p.w_pool = (const float*)d_in[5];
  p.pool_scale = (const float*)d_in[6]; p.w_out = (const float*)d_in[7]; p.g_cross = (const float*)d_in[8];
  p.g_mem = (const float*)d_in[9]; p.w_cq = (const float*)d_in[10]; p.w_ck = (const float*)d_in[11];
  p.w_cv = (const float*)d_in[12]; p.w_co = (const float*)d_in[13]; p.g_ffn = (const float*)d_in[14];
  p.w_pq = (const float*)d_in[15]; p.sk1f = (const float*)d_in[16]; p.sk2f = (const float*)d_in[17];
  p.w_u = (const float*)d_in[18]; p.w_v = (const float*)d_in[19]; p.g_final = (const float*)d_in[20];
  p.out = (float*)d_out;
  char* ws = (char*)d_ws;
  size_t off = 0;
  auto take = [&](size_t bytes) { char* r = ws + off; off += (bytes + 255) & ~(size_t)255; return r; };
  const size_t MB = 1024 * 1024;
  p.wInT = (bfr*)take(16 * MB); p.wPoolT = (bfr*)take(512 * 1024); p.wOutT = (bfr*)take(8 * MB);
  p.wCqT = (bfr*)take(2 * MB); p.wCkT = (bfr*)take(2 * MB); p.wCvT = (bfr*)take(2 * MB); p.wCoT = (bfr*)take(2 * MB);
  p.wPqT = (bfr*)take(8 * MB); p.sk1 = (bfr*)take(32768); p.sk2 = (bfr*)take(32768);
  p.wU8 = (unsigned char*)take(32 * MB); p.wV8 = (unsigned char*)take(32 * MB);
  p.su = (float*)take(65536); p.sv = (float*)take(65536);
  p.memn = (bfr*)take(4 * MB); p.kc = (bfr*)take(1 * MB); p.vc = (bfr*)take(1 * MB);
  p.hbuf = (bfr*)take(64 * MB);
  const size_t r2 = off;
  p.qbuf = (bfr*)take(32 * MB); p.kbuf = (bfr*)take(32 * MB); p.vbuf = (bfr*)take(32 * MB);
  p.pbuf = (bfr*)take(32 * MB); p.mixed = (bfr*)take(32 * MB); p.ob = (bfr*)take(96 * MB);
  p.lse = (float*)take((size_t)3 * T_TOK * 8 * 4);
  const size_t end1 = off;
  off = r2;
  p.xres = (float*)take(128 * MB); p.pq = (bfr*)take(64 * MB); p.qc = (bfr*)take(16 * MB); p.oc = (bfr*)take(16 * MB);
  p.idx = (int*)take(8 * MB); p.gates = (float*)take(8 * MB);
  const size_t end2 = off;
  const size_t need = end1 > end2 ? end1 : end2;
  if (need > ws_size) { fprintf(stderr, "workspace too small: need %zu have %zu\n", need, ws_size); return; }

  static int grid_blocks = 0;
  if (!grid_blocks) {
    int dev = 0, cus = 0, per_cu = 0;
    hipGetDevice(&dev);
    hipDeviceGetAttribute(&cus, hipDeviceAttributeMultiprocessorCount, dev);
    hipOccupancyMaxActiveBlocksPerMultiprocessor(&per_cu, mega, NTHREADS, 0);
    if (per_cu < 1) per_cu = 1;
    if (per_cu > 1) per_cu = 1;
    grid_blocks = cus * per_cu;
  }
#if MULTI_LAUNCH
  for (int ph = 0; ph < NPHASE; ++ph) hipLaunchKernelGGL(mega, dim3(grid_blocks), dim3(NTHREADS), 0, stream, p, ph, ph + 1);
#else
  int lo = 0, hi = NPHASE;
  void* args[] = {&p, &lo, &hi};
  hipError_t e = hipLaunchCooperativeKernel((void*)mega, dim3(grid_blocks), dim3(NTHREADS), args, 0, stream);
  if (e != hipSuccess) fprintf(stderr, "cooperative launch failed: %s (grid %d)\n", hipGetErrorString(e), grid_blocks);
#endif
}
```

```cpp
#include <hip/hip_runtime.h>
#include <hip/hip_cooperative_groups.h>
#include <stdint.h>
#include <stdio.h>
namespace cg = cooperative_groups;

#ifndef ABL
#define ABL 0
#endif
#ifndef MULTI_LAUNCH
#define MULTI_LAUNCH 0
#endif

#define DI __device__ __forceinline__
typedef unsigned short bfr;
using bf16x8 = __attribute__((ext_vector_type(8))) short;
using s16x4  = __attribute__((ext_vector_type(4))) short;
using f32x4  = __attribute__((ext_vector_type(4))) float;
using u32x4  = __attribute__((ext_vector_type(4))) unsigned;
using u32x2  = __attribute__((ext_vector_type(2))) unsigned;
using bf2    = __attribute__((ext_vector_type(2))) __bf16;
using f32x2  = __attribute__((ext_vector_type(2))) float;

constexpr int T_TOK = 16384;
constexpr int NTHREADS = 512;
constexpr int SMEM_BYTES = 151552;
constexpr int NPHASE = 13;

struct Params {
  const float *x, *mem; const int* pos;
  const float *g_mix, *w_in, *w_pool, *pool_scale, *w_out, *g_cross, *g_mem, *w_cq, *w_ck, *w_cv, *w_co, *g_ffn, *w_pq,
              *sk1f, *sk2f, *w_u, *w_v, *g_final;
  float* out;
  bfr *wInT, *wPoolT, *wOutT, *wCqT, *wCkT, *wCvT, *wCoT, *wPqT, *sk1, *sk2;
  unsigned char *wU8, *wV8; float *su, *sv;
  bfr *hbuf, *memn, *kc, *vc;
  bfr *pbuf, *qbuf, *kbuf, *vbuf, *mixed, *ob; float* lse;
  float* xres; bfr *pq, *qc, *oc; int* idx; float* gates;
  unsigned* bar;
};

DI unsigned pack2(float a, float b) { bf2 p; p[0] = (__bf16)a; p[1] = (__bf16)b; return __builtin_bit_cast(unsigned, p); }
DI float bflo(unsigned u) { return __uint_as_float(u << 16); }
DI float bfhi(unsigned u) { return __uint_as_float(u & 0xffff0000u); }
DI float wave_sum(float v) {
#pragma unroll
  for (int o = 32; o >= 1; o >>= 1) v += __shfl_xor(v, o);
  return v;
}
DI f32x4 mfma16(bf16x8 a, bf16x8 b, f32x4 c) { return __builtin_amdgcn_mfma_f32_16x16x32_bf16(a, b, c, 0, 0, 0); }
DI s16x4 tr_read(const char* p) {
  return __builtin_amdgcn_ds_read_tr16_b64_v4i16((s16x4 __attribute__((address_space(3)))*)(p));
}

DI void gemm_main(const bfr* __restrict__ A, int lda, const bfr* __restrict__ Bt, int ldb, int K, char* smem,
                  f32x4 (&acc)[4][4]) {
  const int tid = threadIdx.x, lane = tid & 63, wid = tid >> 6, wm = wid >> 1, wn = wid & 1, fr = lane & 15, fq = lane >> 4;
  const int lrow = tid >> 3, lc = tid & 7;
  const int sw = ((lc ^ (lrow & 7)) << 4);
  u32x4 ra[4], rb[2];
  const bfr* ga = A + (size_t)lrow * lda + lc * 8;
  const bfr* gb = Bt + (size_t)lrow * ldb + lc * 8;
#pragma unroll
  for (int m = 0; m < 4; ++m)
#pragma unroll
    for (int n = 0; n < 4; ++n) acc[m][n] = f32x4{0.f, 0.f, 0.f, 0.f};
  const int nk = K >> 6;
#pragma unroll
  for (int i = 0; i < 4; ++i) ra[i] = *(const u32x4*)(ga + (size_t)(64 * i) * lda);
#pragma unroll
  for (int i = 0; i < 2; ++i) rb[i] = *(const u32x4*)(gb + (size_t)(64 * i) * ldb);
  __syncthreads();
#pragma unroll
  for (int i = 0; i < 4; ++i) *(u32x4*)(smem + (lrow + 64 * i) * 128 + sw) = ra[i];
#pragma unroll
  for (int i = 0; i < 2; ++i) *(u32x4*)(smem + 32768 + (lrow + 64 * i) * 128 + sw) = rb[i];
  __syncthreads();
  for (int kt = 0; kt < nk; ++kt) {
    const char* cur = smem + (kt & 1) * 49152;
    char* nxt = smem + ((kt + 1) & 1) * 49152;
    const bool more = (kt + 1 < nk);
    if (more) {
#pragma unroll
      for (int i = 0; i < 4; ++i) ra[i] = *(const u32x4*)(ga + (size_t)(64 * i) * lda + (kt + 1) * 64);
#pragma unroll
      for (int i = 0; i < 2; ++i) rb[i] = *(const u32x4*)(gb + (size_t)(64 * i) * ldb + (kt + 1) * 64);
    }
#pragma unroll
    for (int kk = 0; kk < 2; ++kk) {
      bf16x8 af[4], bf[4];
      const int co = (((kk * 4 + fq) ^ (fr & 7)) << 4);
#pragma unroll
      for (int m = 0; m < 4; ++m) af[m] = *(const bf16x8*)(cur + (wm * 64 + m * 16 + fr) * 128 + co);
#pragma unroll
      for (int n = 0; n < 4; ++n) bf[n] = *(const bf16x8*)(cur + 32768 + (wn * 64 + n * 16 + fr) * 128 + co);
#pragma unroll
      for (int m = 0; m < 4; ++m)
#pragma unroll
        for (int n = 0; n < 4; ++n) acc[m][n] = mfma16(bf[n], af[m], acc[m][n]);
    }
    if (more) {
#pragma unroll
      for (int i = 0; i < 4; ++i) *(u32x4*)(nxt + (lrow + 64 * i) * 128 + sw) = ra[i];
#pragma unroll
      for (int i = 0; i < 2; ++i) *(u32x4*)(nxt + 32768 + (lrow + 64 * i) * 128 + sw) = rb[i];
    }
    __syncthreads();
  }
}

DI void tile_map(int id, int MT, int NT, int& mt, int& nt) {
  if ((NT & 7) == 0 && (MT & 31) == 0) {
    const int round = id >> 8, local = id & 255, xcd = local & 7, j = local >> 3, mtl = j & 3, ntl = j >> 2;
    const int MR = MT >> 5;
    const int mr = round % MR, nr = round / MR;
    mt = mr * 32 + xcd * 4 + mtl;
    nt = nr * 8 + ntl;
  } else {
    mt = id % MT;
    nt = id / MT;
  }
}

template <bool BANDED, class StoreF>
DI void attn_core(const bfr* __restrict__ Qb, int qstride, int q0, const bfr* __restrict__ Kb, const bfr* __restrict__ Vb,
                  int kvstride, int key0, char* smem, StoreF store, float& m_out, float& l_out) {
  const int tid = threadIdx.x, lane = tid & 63, w = tid >> 6, fr = lane & 15, fq = lane >> 4;
  char* sK = smem;
  char* sV = smem + 65536;
  __syncthreads();
#pragma unroll 1
  for (int rr = 0; rr < 2; ++rr) {
    u32x4 kr[4], vr[4];
#pragma unroll
    for (int i = 0; i < 4; ++i) {
      const int id = tid + (rr * 4 + i) * 512, key = id >> 4, c = id & 15, lk = key0 + key;
      kr[i] = u32x4{0u, 0u, 0u, 0u};
      vr[i] = u32x4{0u, 0u, 0u, 0u};
      if (lk >= 0) {
        kr[i] = *(const u32x4*)(Kb + (long)lk * kvstride + c * 8);
        vr[i] = *(const u32x4*)(Vb + (long)lk * kvstride + c * 8);
      }
    }
#pragma unroll
    for (int i = 0; i < 4; ++i) {
      const int id = tid + (rr * 4 + i) * 512, key = id >> 4, c = id & 15;
      *(u32x4*)(sK + key * 256 + ((c ^ (key & 15)) << 4)) = kr[i];
      *(u32x4*)(sV + key * 288 + c * 16) = vr[i];
    }
  }
  bf16x8 qf[4];
  {
    const bfr* qrow = Qb + (long)(q0 + w * 16 + fr) * qstride;
#pragma unroll
    for (int kk = 0; kk < 4; ++kk) qf[kk] = *(const bf16x8*)(qrow + kk * 32 + fq * 8);
  }
  __syncthreads();
  constexpr int NT = BANDED ? 10 : 16;
  const int t0 = BANDED ? (w & ~1) : 0;
  f32x4 s[NT];
#pragma unroll
  for (int j = 0; j < NT; ++j) {
    f32x4 a = f32x4{0.f, 0.f, 0.f, 0.f};
    const int key = (t0 + j) * 16 + fr;
#pragma unroll
    for (int kk = 0; kk < 4; ++kk) {
      const bf16x8 kf = *(const bf16x8*)(sK + key * 256 + (((kk * 4 + fq) ^ fr) << 4));
      a = mfma16(kf, qf[kk], a);
    }
    s[j] = a;
  }
  const float L2E = 1.4426950408889634f;
  const float NINF = -__builtin_inff();
  float mx = NINF;
  const int lq = q0 + w * 16 + fr;
#pragma unroll
  for (int j = 0; j < NT; ++j)
#pragma unroll
    for (int i = 0; i < 4; ++i) {
      float v = s[j][i] * L2E;
      if (BANDED) {
        const int lk = key0 + (t0 + j) * 16 + fq * 4 + i;
        const int dist = lq - lk;
        const bool ok = (lk >= 0) && (dist >= 0) && (dist <= 128);
        v = ok ? v : NINF;
      }
      s[j][i] = v;
      mx = fmaxf(mx, v);
    }
  mx = fmaxf(mx, __shfl_xor(mx, 16));
  mx = fmaxf(mx, __shfl_xor(mx, 32));
  float l = 0.f;
#pragma unroll
  for (int j = 0; j < NT; ++j)
#pragma unroll
    for (int i = 0; i < 4; ++i) {
      const float p = __builtin_amdgcn_exp2f(s[j][i] - mx);
      s[j][i] = p;
      l += p;
    }
  l += __shfl_xor(l, 16);
  l += __shfl_xor(l, 32);
  bf16x8 pf[NT / 2];
#pragma unroll
  for (int c = 0; c < NT / 2; ++c) {
    u32x4 t;
    t[0] = pack2(s[2 * c][0], s[2 * c][1]);
    t[1] = pack2(s[2 * c][2], s[2 * c][3]);
    t[2] = pack2(s[2 * c + 1][0], s[2 * c + 1][1]);
    t[3] = pack2(s[2 * c + 1][2], s[2 * c + 1][3]);
    pf[c] = __builtin_bit_cast(bf16x8, t);
  }
  const int q4 = (lane & 15) >> 2, p4 = lane & 3;
  m_out = mx;
  l_out = l;
#pragma unroll 2
  for (int dt = 0; dt < 8; ++dt) {
    f32x4 a = f32x4{0.f, 0.f, 0.f, 0.f};
#pragma unroll
    for (int c = 0; c < NT / 2; ++c) {
      const int kb = (t0 + 2 * c) * 16;
      const s16x4 lo = tr_read(sV + (kb + fq * 4 + q4) * 288 + (dt * 16 + p4 * 4) * 2);
      const s16x4 hi = tr_read(sV + (kb + 16 + fq * 4 + q4) * 288 + (dt * 16 + p4 * 4) * 2);
      const bf16x8 vf = __builtin_shufflevector(lo, hi, 0, 1, 2, 3, 4, 5, 6, 7);
      a = mfma16(vf, pf[c], a);
    }
    store(dt, a, l);
  }
}

DI int f2sort(float f) { int b = __float_as_int(f); return b ^ ((b >> 31) & 0x7fffffff); }
DI float sort2f(int s) { int b = s ^ ((s >> 31) & 0x7fffffff); return __int_as_float(b); }
DI void topk_insert(int (&lst)[16], int key) {
#pragma unroll
  for (int j = 0; j < 16; ++j) {
    const int hi = max(lst[j], key);
    key = min(lst[j], key);
    lst[j] = hi;
  }
}

template <int O, int N>
DI void bfly(float (&p)[64], int lane) {
  const bool up = (lane & O) != 0;
#pragma unroll
  for (int i = 0; i < N / 2; ++i) {
    const float keep = up ? p[i + N / 2] : p[i];
    const float send = up ? p[i] : p[i + N / 2];
    p[i] = keep + __shfl_xor(send, O);
  }
  if constexpr (O > 1) bfly<O / 2, N / 2>(p, lane);
}

DI void rms_row_to_bf16(const float* __restrict__ x, const float* __restrict__ g, bfr* __restrict__ out, int lane) {
  float4 v[8];
  float ss = 0.f;
#pragma unroll
  for (int j = 0; j < 8; ++j) {
    v[j] = *(const float4*)(x + j * 256 + lane * 4);
    ss += v[j].x * v[j].x + v[j].y * v[j].y + v[j].z * v[j].z + v[j].w * v[j].w;
  }
  ss = wave_sum(ss);
  const float rs = rsqrtf(ss * (1.f / 2048.f) + 1e-6f);
#pragma unroll
  for (int j = 0; j < 8; ++j) {
    const float4 gg = *(const float4*)(g + j * 256 + lane * 4);
    u32x2 o;
    o[0] = pack2(v[j].x * rs * gg.x, v[j].y * rs * gg.y);
    o[1] = pack2(v[j].z * rs * gg.z, v[j].w * rs * gg.w);
    *(u32x2*)(out + j * 256 + lane * 4) = o;
  }
}

DI void transpose_tile(const float* __restrict__ W, int K, int N, int k0, int n0, bfr* __restrict__ Wt, float* tile) {
  __syncthreads();
  {
    const int r = threadIdx.x >> 4, c4 = threadIdx.x & 15;
#pragma unroll
    for (int i = 0; i < 2; ++i) {
      const int k = r + 32 * i;
      const float4 v = *(const float4*)(W + (size_t)(k0 + k) * N + n0 + c4 * 4);
      tile[k * 65 + c4 * 4 + 0] = v.x;
      tile[k * 65 + c4 * 4 + 1] = v.y;
      tile[k * 65 + c4 * 4 + 2] = v.z;
      tile[k * 65 + c4 * 4 + 3] = v.w;
    }
  }
  __syncthreads();
  {
    const int n = threadIdx.x >> 3, kc = threadIdx.x & 7;
    u32x4 o;
#pragma unroll
    for (int j = 0; j < 4; ++j) o[j] = pack2(tile[(kc * 8 + 2 * j) * 65 + n], tile[(kc * 8 + 2 * j + 1) * 65 + n]);
    *(u32x4*)(Wt + (size_t)(n0 + n) * K + k0 + kc * 8) = o;
  }
}

DI void convert_f32_bf16(const float* __restrict__ src, bfr* __restrict__ dst, long n8) {
  for (long i = (long)blockIdx.x * NTHREADS + threadIdx.x; i < n8; i += (long)gridDim.x * NTHREADS) {
    const float4 a = *(const float4*)(src + i * 8);
    const float4 b = *(const float4*)(src + i * 8 + 4);
    u32x4 o;
    o[0] = pack2(a.x, a.y); o[1] = pack2(a.z, a.w); o[2] = pack2(b.x, b.y); o[3] = pack2(b.z, b.w);
    *(u32x4*)(dst + i * 8) = o;
  }
}

DI void phase_prep(const Params& p, char* smem) {
  const int lane = threadIdx.x & 63, wid = threadIdx.x >> 6;
  for (int r = blockIdx.x * 8 + wid; r < T_TOK + 1024; r += gridDim.x * 8) {
    if (r < T_TOK) rms_row_to_bf16(p.x + (size_t)r * 2048, p.g_mix, p.hbuf + (size_t)r * 2048, lane);
    else rms_row_to_bf16(p.mem + (size_t)(r - T_TOK) * 2048, p.g_mem, p.memn + (size_t)(r - T_TOK) * 2048, lane);
  }
  float* tile = (float*)smem;
  for (int id0 = blockIdx.x; id0 < 5184; id0 += gridDim.x) {
    int id = id0;
    const float* W; bfr* Wt; int K, N;
    if (id < 2048) { W = p.w_in; Wt = p.wInT; K = 2048; N = 4096; }
    else if ((id -= 2048) < 1024) { W = p.w_out; Wt = p.wOutT; K = 2048; N = 2048; }
    else if ((id -= 1024) < 1024) { W = p.w_pq; Wt = p.wPqT; K = 2048; N = 2048; }
    else if ((id -= 1024) < 256) { W = p.w_cq; Wt = p.wCqT; K = 2048; N = 512; }
    else if ((id -= 256) < 256) { W = p.w_ck; Wt = p.wCkT; K = 2048; N = 512; }
    else if ((id -= 256) < 256) { W = p.w_cv; Wt = p.wCvT; K = 2048; N = 512; }
    else if ((id -= 256) < 256) { W = p.w_co; Wt = p.wCoT; K = 512; N = 2048; }
    else { id -= 256; const int g = id >> 4; id &= 15; W = p.w_pool + g * 65536; Wt = p.wPoolT + g * 65536; K = 256; N = 256; }
    const int ntn = N >> 6;
    const int kt = id / ntn, nt = id % ntn;
    transpose_tile(W, K, N, kt * 64, nt * 64, Wt, tile);
  }
  convert_f32_bf16(p.sk1f, p.sk1, 128 * 128 / 8);
  convert_f32_bf16(p.sk2f, p.sk2, 128 * 128 / 8);
  for (int r = blockIdx.x * 8 + wid; r < 2 * 16384; r += gridDim.x * 8) {
    const bool isv = r >= 16384;
    const int rr = isv ? r - 16384 : r;
    const float* src = (isv ? p.w_v : p.w_u) + (size_t)rr * 2048;
    unsigned char* dst = (isv ? p.wV8 : p.wU8) + (size_t)rr * 2048;
    float4 v[8];
    float amax = 0.f;
#pragma unroll
    for (int j = 0; j < 2; ++j)
#pragma unroll
      for (int q = 0; q < 4; ++q) {
        v[j * 4 + q] = *(const float4*)(src + j * 1024 + lane * 16 + q * 4);
        const float4 t = v[j * 4 + q];
        amax = fmaxf(amax, fmaxf(fmaxf(fabsf(t.x), fabsf(t.y)), fmaxf(fabsf(t.z), fabsf(t.w))));
      }
#pragma unroll
    for (int o = 32; o >= 1; o >>= 1) amax = fmaxf(amax, __shfl_xor(amax, o));
    const float inv = amax > 0.f ? 448.f / amax : 0.f;
    if (lane == 0) (isv ? p.sv : p.su)[rr] = amax * (1.f / 448.f);
#pragma unroll
    for (int j = 0; j < 2; ++j) {
      u32x4 o4;
#pragma unroll
      for (int q = 0; q < 4; ++q) {
        const float4 t = v[j * 4 + q];
        int w = 0;
        w = __builtin_amdgcn_cvt_pk_fp8_f32(t.x * inv, t.y * inv, w, false);
        w = __builtin_amdgcn_cvt_pk_fp8_f32(t.z * inv, t.w * inv, w, true);
        o4[q] = (unsigned)w;
      }
      *(u32x4*)(dst + j * 1024 + lane * 16) = o4;
    }
  }
}

DI void phase_inproj(const Params& p, char* smem) {
  const int tid = threadIdx.x, lane = tid & 63, wid = tid >> 6, wm = wid >> 1, wn = wid & 1, fr = lane & 15, fq = lane >> 4;
  f32x4 acc[4][4];
  for (int id = blockIdx.x; id < 2048 + 32; id += gridDim.x) {
    if (id < 2048) {
      int mt, nt;
      tile_map(id, 64, 32, mt, nt);
      gemm_main(p.hbuf + (size_t)mt * 256 * 2048, 2048, p.wInT + (size_t)nt * 128 * 2048, 2048, 2048, smem, acc);
      const int region = nt >> 3, h = nt & 7;
      if (region == 0) {
#pragma unroll
        for (int m = 0; m < 4; ++m) {
          const int row = mt * 256 + wm * 64 + m * 16 + fr;
#pragma unroll
          for (int n = 0; n < 4; ++n) {
            const int col = nt * 128 + wn * 64 + n * 16 + fq * 4;
            u32x2 o; o[0] = pack2(acc[m][n][0], acc[m][n][1]); o[1] = pack2(acc[m][n][2], acc[m][n][3]);
            *(u32x2*)(p.pbuf + (size_t)row * 1024 + col) = o;
          }
        }
      } else {
        bfr* dst = (region == 1) ? p.qbuf : (region == 2 ? p.kbuf : p.vbuf);
        const float scale = (region == 1) ? 0.08838834764831845f : 1.0f;
#pragma unroll
        for (int m = 0; m < 4; ++m) {
          const int row = mt * 256 + wm * 64 + m * 16 + fr;
          const int b = row >> 12, t = row & 4095;
          if (region != 3 && wn == 0) {
            const float posf = (float)p.pos[row];
#pragma unroll
            for (int i = 0; i < 4; ++i) {
              const int j = fq * 4 + i;
              const float inv = exp2f(-(float)j * (18.931568569324174f / 16.0f));
              float sn, cs;
              sincosf(posf * inv, &sn, &cs);
              const float x1 = acc[m][0][i], x2 = acc[m][1][i];
              acc[m][0][i] = x1 * cs - x2 * sn;
              acc[m][1][i] = x2 * cs + x1 * sn;
            }
          }
#pragma unroll
          for (int n = 0; n < 4; ++n) {
            const int d = wn * 64 + n * 16 + fq * 4;
            u32x2 o;
            o[0] = pack2(acc[m][n][0] * scale, acc[m][n][1] * scale);
            o[1] = pack2(acc[m][n][2] * scale, acc[m][n][3] * scale);
            *(u32x2*)(dst + ((size_t)((b * 8 + h) * 4096 + t)) * 128 + d) = o;
          }
        }
      }
    } else {
      const int id2 = id - 2048;
      const int which = id2 >> 4, mt = (id2 >> 2) & 3, nt = id2 & 3;
      const bfr* Bt = (which == 0 ? p.wCkT : p.wCvT) + (size_t)nt * 128 * 2048;
      bfr* dst = which == 0 ? p.kc : p.vc;
      gemm_main(p.memn + (size_t)mt * 256 * 2048, 2048, Bt, 2048, 2048, smem, acc);
#pragma unroll
      for (int m = 0; m < 4; ++m) {
        const int row = mt * 256 + wm * 64 + m * 16 + fr;
        const int b = row >> 8, mm = row & 255;
#pragma unroll
        for (int n = 0; n < 4; ++n) {
          const int d = wn * 64 + n * 16 + fq * 4;
          u32x2 o; o[0] = pack2(acc[m][n][0], acc[m][n][1]); o[1] = pack2(acc[m][n][2], acc[m][n][3]);
          *(u32x2*)(dst + ((size_t)((b * 4 + nt) * 256 + mm)) * 128 + d) = o;
        }
      }
    }
  }
}

DI void phase_mix_attn(const Params& p, char* smem) {
  const int tid = threadIdx.x, lane = tid & 63, w = tid >> 6, fr = lane & 15, fq = lane >> 4;
  for (int id = blockIdx.x; id < 3072 + 256; id += gridDim.x) {
    if (id < 3072) {
      const int br = id >> 10, rem = id & 1023;
      const int dl = (br == 0) ? 1 : (br == 1 ? 4 : 16);
      const int nblk = 32 / dl;
      const int bh = rem >> 5, rn = rem & 31;
      const int r = rn / nblk, nb = rn % nblk;
      const int l0 = nb * 128;
      const size_t base = (size_t)bh * 4096 * 128 + (size_t)r * 128;
      float mx, l;
      const int b = bh >> 3, h = bh & 7;
      const int tt = b * 4096 + (l0 + w * 16 + fr) * dl + r;
      bfr* dst = p.ob + (size_t)br * T_TOK * 1024 + (size_t)tt * 1024 + h * 128 + fq * 4;
      attn_core<true>(p.qbuf + base, dl * 128, l0, p.kbuf + base, p.vbuf + base, dl * 128, l0 - 128, smem,
                      [&](int dt, f32x4 a, float lsum) {
                        const float il = 1.f / lsum;
                        u32x2 v; v[0] = pack2(a[0] * il, a[1] * il); v[1] = pack2(a[2] * il, a[3] * il);
                        *(u32x2*)(dst + dt * 16) = v;
                      }, mx, l);
      if (fq == 0) p.lse[(size_t)br * T_TOK * 8 + (size_t)tt * 8 + h] = mx + __builtin_amdgcn_logf(l);
    } else {
      const int ci = id - 3072;
      const int sub = tid >> 7, cgp = tid & 127;
      const int wdw = 2 << (cgp >> 5);
      const int t0 = ci * 64 + sub * 16, tin0 = t0 & 4095;
      const bfr* pb = p.pbuf + cgp * 8;
      float sum[8];
#pragma unroll
      for (int e = 0; e < 8; ++e) sum[e] = 0.f;
      for (int j = 1; j < wdw; ++j) {
        if (tin0 - j >= 0) {
          const u32x4 v = *(const u32x4*)(pb + (size_t)(t0 - j) * 1024);
#pragma unroll
          for (int e = 0; e < 4; ++e) { sum[2 * e] += bflo(v[e]); sum[2 * e + 1] += bfhi(v[e]); }
        }
      }
      for (int s = 0; s < 16; ++s) {
        const int t = t0 + s, tin = tin0 + s;
        const u32x4 v = *(const u32x4*)(pb + (size_t)t * 1024);
        float cur[8];
#pragma unroll
        for (int e = 0; e < 4; ++e) { cur[2 * e] = bflo(v[e]); cur[2 * e + 1] = bfhi(v[e]); }
        const float ic = 1.f / (float)min(tin + 1, wdw);
        u32x4 ov;
#pragma unroll
        for (int e = 0; e < 8; ++e) sum[e] += cur[e];
#pragma unroll
        for (int e = 0; e < 4; ++e) ov[e] = pack2(sum[2 * e] * ic - cur[2 * e], sum[2 * e + 1] * ic - cur[2 * e + 1]);
        *(u32x4*)(p.mixed + (size_t)t * 1024 + cgp * 8) = ov;
        if (tin - wdw + 1 >= 0) {
          const u32x4 u = *(const u32x4*)(pb + (size_t)(t - wdw + 1) * 1024);
#pragma unroll
          for (int e = 0; e < 4; ++e) { sum[2 * e] -= bflo(u[e]); sum[2 * e + 1] -= bfhi(u[e]); }
        }
      }
    }
  }
}

DI void phase_pool_combine(const Params& p, char* smem) {
  const int tid = threadIdx.x, lane = tid & 63, wid = tid >> 6, wm = wid >> 1, wn = wid & 1, fr = lane & 15, fq = lane >> 4;
  f32x4 acc[4][4];
  for (int id = blockIdx.x; id < 512; id += gridDim.x) {
    const int g = id >> 7, mt = (id >> 1) & 63, nt = id & 1;
    gemm_main(p.mixed + (size_t)mt * 256 * 1024 + g * 256, 1024, p.wPoolT + (size_t)g * 65536 + (size_t)nt * 128 * 256, 256, 256,
              smem, acc);
#pragma unroll
    for (int m = 0; m < 4; ++m) {
      const int row = mt * 256 + wm * 64 + m * 16 + fr;
#pragma unroll
      for (int n = 0; n < 4; ++n) {
        const int e = nt * 128 + wn * 64 + n * 16 + fq * 4;
        const float4 sc = *(const float4*)(p.pool_scale + g * 256 + e);
        u32x2 o; o[0] = pack2(acc[m][n][0] * sc.x, acc[m][n][1] * sc.y); o[1] = pack2(acc[m][n][2] * sc.z, acc[m][n][3] * sc.w);
        *(u32x2*)(p.hbuf + (size_t)row * 2048 + g * 256 + e) = o;
      }
    }
  }
  for (long i = (long)blockIdx.x * NTHREADS + tid; i < (long)T_TOK * 8 * 16; i += (long)gridDim.x * NTHREADS) {
    const int dc = (int)(i & 15), h = (int)((i >> 4) & 7);
    const long tt = i >> 7;
    const float l0 = p.lse[tt * 8 + h], l1 = p.lse[(size_t)T_TOK * 8 + tt * 8 + h], l2 = p.lse[(size_t)2 * T_TOK * 8 + tt * 8 + h];
    const float mx = fmaxf(l0, fmaxf(l1, l2));
    float w0 = __builtin_amdgcn_exp2f(l0 - mx), w1 = __builtin_amdgcn_exp2f(l1 - mx), w2 = __builtin_amdgcn_exp2f(l2 - mx);
    const float inv = 1.f / (w0 + w1 + w2);
    w0 *= inv; w1 *= inv; w2 *= inv;
    if (ABL == 3) { w0 = 0.f; w1 = 0.f; w2 = 0.f; }
    const size_t off = (size_t)tt * 1024 + h * 128 + dc * 8;
    const u32x4 a = *(const u32x4*)(p.ob + off);
    const u32x4 b = *(const u32x4*)(p.ob + (size_t)T_TOK * 1024 + off);
    const u32x4 c = *(const u32x4*)(p.ob + (size_t)2 * T_TOK * 1024 + off);
    u32x4 o;
#pragma unroll
    for (int e = 0; e < 4; ++e)
      o[e] = pack2(w0 * bflo(a[e]) + w1 * bflo(b[e]) + w2 * bflo(c[e]), w0 * bfhi(a[e]) + w1 * bfhi(b[e]) + w2 * bfhi(c[e]));
    *(u32x4*)(p.hbuf + (size_t)tt * 2048 + 1024 + h * 128 + dc * 8) = o;
  }
}

DI void phase_gemm_resid(const bfr* A, int lda, const bfr* Bt, int K, const float* resid, float* xout, char* smem) {
  const int tid = threadIdx.x, lane = tid & 63, wid = tid >> 6, wm = wid >> 1, wn = wid & 1, fr = lane & 15, fq = lane >> 4;
  f32x4 acc[4][4];
  for (int id = blockIdx.x; id < 1024; id += gridDim.x) {
    int mt, nt;
    tile_map(id, 64, 16, mt, nt);
    gemm_main(A + (size_t)mt * 256 * lda, lda, Bt + (size_t)nt * 128 * K, K, K, smem, acc);
#pragma unroll
    for (int m = 0; m < 4; ++m) {
      const int row = mt * 256 + wm * 64 + m * 16 + fr;
#pragma unroll
      for (int n = 0; n < 4; ++n) {
        const int col = nt * 128 + wn * 64 + n * 16 + fq * 4;
        const float4 r = *(const float4*)(resid + (size_t)row * 2048 + col);
        float4 o; o.x = r.x + acc[m][n][0]; o.y = r.y + acc[m][n][1]; o.z = r.z + acc[m][n][2]; o.w = r.w + acc[m][n][3];
        *(float4*)(xout + (size_t)row * 2048 + col) = o;
      }
    }
  }
}

DI void phase_rms(const float* xin, const float* g, bfr* out) {
  const int lane = threadIdx.x & 63, wid = threadIdx.x >> 6;
  for (int r = blockIdx.x * 8 + wid; r < T_TOK; r += gridDim.x * 8)
    rms_row_to_bf16(xin + (size_t)r * 2048, g, out + (size_t)r * 2048, lane);
}

DI void phase_gemm_bf16(const bfr* A, int lda, const bfr* Bt, int K, int N, float scale, bfr* out, char* smem) {
  const int tid = threadIdx.x, lane = tid & 63, wid = tid >> 6, wm = wid >> 1, wn = wid & 1, fr = lane & 15, fq = lane >> 4;
  f32x4 acc[4][4];
  const int NT = N >> 7;
  for (int id = blockIdx.x; id < 64 * NT; id += gridDim.x) {
    int mt, nt;
    tile_map(id, 64, NT, mt, nt);
    gemm_main(A + (size_t)mt * 256 * lda, lda, Bt + (size_t)nt * 128 * K, K, K, smem, acc);
#pragma unroll
    for (int m = 0; m < 4; ++m) {
      const int row = mt * 256 + wm * 64 + m * 16 + fr;
#pragma unroll
      for (int n = 0; n < 4; ++n) {
        const int col = nt * 128 + wn * 64 + n * 16 + fq * 4;
        u32x2 o; o[0] = pack2(acc[m][n][0] * scale, acc[m][n][1] * scale); o[1] = pack2(acc[m][n][2] * scale, acc[m][n][3] * scale);
        *(u32x2*)(out + (size_t)row * N + col) = o;
      }
    }
  }
}

DI void phase_cross_attn(const Params& p, char* smem) {
  const int tid = threadIdx.x, lane = tid & 63, w = tid >> 6, fr = lane & 15, fq = lane >> 4;
  for (int id = blockIdx.x; id < 512; id += gridDim.x) {
    const int b = id >> 7, h = (id >> 5) & 3, qt = id & 31;
    float mx, l;
    const size_t kvb = (size_t)(b * 4 + h) * 256 * 128;
    bfr* dst = p.oc + (size_t)(b * 4096 + qt * 128 + w * 16 + fr) * 512 + h * 128 + fq * 4;
    attn_core<false>(p.qc + (size_t)b * 4096 * 512 + h * 128, 512, qt * 128, p.kc + kvb, p.vc + kvb, 128, 0, smem,
                     [&](int dt, f32x4 a, float lsum) {
                       const float il = 1.f / lsum;
                       u32x2 v; v[0] = pack2(a[0] * il, a[1] * il); v[1] = pack2(a[2] * il, a[3] * il);
                       *(u32x2*)(dst + dt * 16) = v;
                     }, mx, l);
  }
}

DI void phase_peer_route(const Params& p, char* smem) {
  const int tid = threadIdx.x, lane = tid & 63, w = tid >> 6, fr = lane & 15, fq = lane >> 4;
  float* scores = (float*)smem;
  int* lists = (int*)(smem + 135168);
  for (int id = blockIdx.x; id < 1024; id += gridDim.x) {
    const int tt = id >> 3, h = id & 7;
    const int tok0 = tt * 128;
    __syncthreads();
#pragma unroll
    for (int hf = 0; hf < 2; ++hf) {
      const bfr* arow = p.pq + (size_t)(tok0 + w * 16 + fr) * 2048 + h * 256 + hf * 128;
      bf16x8 af[4];
#pragma unroll
      for (int kk = 0; kk < 4; ++kk) af[kk] = *(const bf16x8*)(arow + kk * 32 + fq * 8);
      const bfr* sk = hf ? p.sk2 : p.sk1;
#pragma unroll
      for (int nt = 0; nt < 8; ++nt) {
        f32x4 a = f32x4{0.f, 0.f, 0.f, 0.f};
#pragma unroll
        for (int kk = 0; kk < 4; ++kk) {
          const bf16x8 bfg = *(const bf16x8*)(sk + (nt * 16 + fr) * 128 + kk * 32 + fq * 8);
          a = mfma16(af[kk], bfg, a);
        }
#pragma unroll
        for (int i = 0; i < 4; ++i) scores[(hf * 128 + w * 16 + fq * 4 + i) * 132 + nt * 16 + fr] = a[i];
      }
    }
    __syncthreads();
    if (tid < 256) {
      int lst[16];
#pragma unroll
      for (int j = 0; j < 16; ++j) lst[j] = (int)0x80000000;
      const float* srow = scores + tid * 132;
      for (int k4 = 0; k4 < 32; ++k4) {
        const float4 v = *(const float4*)(srow + k4 * 4);
        topk_insert(lst, (f2sort(v.x) & ~0x7F) | (k4 * 4 + 0));
        topk_insert(lst, (f2sort(v.y) & ~0x7F) | (k4 * 4 + 1));
        topk_insert(lst, (f2sort(v.z) & ~0x7F) | (k4 * 4 + 2));
        topk_insert(lst, (f2sort(v.w) & ~0x7F) | (k4 * 4 + 3));
      }
#pragma unroll
      for (int j = 0; j < 16; ++j) lists[tid * 16 + j] = lst[j];
    }
    __syncthreads();
    if (tid < 128) {
      float v1[16], v2[16];
#pragma unroll
      for (int j = 0; j < 16; ++j) {
        v1[j] = sort2f(lists[tid * 16 + j] & ~0x7F);
        v2[j] = sort2f(lists[(128 + tid) * 16 + j] & ~0x7F);
      }
      int top[16];
#pragma unroll
      for (int j = 0; j < 16; ++j) top[j] = (int)0x80000000;
#pragma unroll
      for (int a = 0; a < 16; ++a)
#pragma unroll
        for (int b = 0; b < 16; ++b)
          if ((a + 1) * (b + 1) <= 16) topk_insert(top, (f2sort(v1[a] + v2[b]) & ~0xFF) | (a * 16 + b));
      int ex[16];
      float sum = 0.f;
#pragma unroll
      for (int j = 0; j < 16; ++j) {
        const int code = top[j] & 0xFF;
        const int i1 = lists[tid * 16 + (code >> 4)] & 0x7F;
        const int i2 = lists[(128 + tid) * 16 + (code & 15)] & 0x7F;
        ex[j] = i1 * 128 + i2;
      }
      const float mxv = sort2f(top[0] & ~0xFF);
      float ev[16];
#pragma unroll
      for (int j = 0; j < 16; ++j) { ev[j] = __expf(sort2f(top[j] & ~0xFF) - mxv); sum += ev[j]; }
      const float inv = 1.f / sum;
      const size_t ob = (size_t)(tok0 + tid) * 128 + h * 16;
#pragma unroll
      for (int j4 = 0; j4 < 4; ++j4) {
        int4 iv; iv.x = ex[j4 * 4]; iv.y = ex[j4 * 4 + 1]; iv.z = ex[j4 * 4 + 2]; iv.w = ex[j4 * 4 + 3];
        float4 gv; gv.x = ev[j4 * 4] * inv; gv.y = ev[j4 * 4 + 1] * inv; gv.z = ev[j4 * 4 + 2] * inv; gv.w = ev[j4 * 4 + 3] * inv;
        *(int4*)(p.idx + ob + j4 * 4) = iv;
        *(float4*)(p.gates + ob + j4 * 4) = gv;
      }
    }
  }
}

DI float gelu_tanh(float a) {
  const float u = 0.7978845608028654f * (a + 0.044715f * a * a * a);
  return 0.5f * a * (1.f + tanhf(u));
}

#define SB() __builtin_amdgcn_sched_barrier(0)
DI void peer_load8(u32x4 (&buf)[16], const unsigned char* tbl, int idxv, int g, int lane) {
#pragma unroll
  for (int k = 0; k < 8; ++k) {
    const int e = __builtin_amdgcn_readlane(idxv, g * 8 + k);
    const unsigned char* row = tbl + (size_t)e * 2048 + lane * 16;
    buf[2 * k] = *(const u32x4*)row;
    buf[2 * k + 1] = *(const u32x4*)(row + 1024);
  }
}
DI float peer_dot8(const u32x4 (&buf)[16], const f32x2 (&h2)[16], int lane) {
  float part[8];
#pragma unroll
  for (int k = 0; k < 8; ++k) {
    f32x2 a2 = f32x2{0.f, 0.f};
#pragma unroll
    for (int j = 0; j < 2; ++j) {
      const u32x4 u = buf[2 * k + j];
#pragma unroll
      for (int c = 0; c < 4; ++c) {
        const int uu = (int)u[c];
        a2 += __builtin_amdgcn_cvt_pk_f32_fp8(uu, false) * h2[j * 8 + c * 2];
        a2 += __builtin_amdgcn_cvt_pk_f32_fp8(uu, true) * h2[j * 8 + c * 2 + 1];
      }
    }
    part[k] = a2[0] + a2[1];
  }
  const bool up4 = (lane & 4) != 0, up2 = (lane & 2) != 0, up1 = (lane & 1) != 0;
  float q[4];
#pragma unroll
  for (int i = 0; i < 4; ++i) {
    const float keep = up4 ? part[i + 4] : part[i];
    const float send = up4 ? part[i] : part[i + 4];
    q[i] = keep + __shfl_xor(send, 4);
  }
  float r[2];
#pragma unroll
  for (int i = 0; i < 2; ++i) {
    const float keep = up2 ? q[i + 2] : q[i];
    const float send = up2 ? q[i] : q[i + 2];
    r[i] = keep + __shfl_xor(send, 2);
  }
  float v = (up1 ? r[1] : r[0]) + __shfl_xor(up1 ? r[0] : r[1], 1);
  v += __shfl_xor(v, 8);
  v += __shfl_xor(v, 16);
  v += __shfl_xor(v, 32);
  return v;
}
DI void peer_acc8(const u32x4 (&buf)[16], f32x2 (&y2)[16], float cval, int g) {
#pragma unroll
  for (int k = 0; k < 8; ++k) {
    const float ck = __builtin_bit_cast(float, __builtin_amdgcn_readlane(__builtin_bit_cast(int, cval), g * 8 + k));
#pragma unroll
    for (int j = 0; j < 2; ++j) {
      const u32x4 u = buf[2 * k + j];
#pragma unroll
      for (int c = 0; c < 4; ++c) {
        const int uu = (int)u[c];
        y2[j * 8 + c * 2] += __builtin_amdgcn_cvt_pk_f32_fp8(uu, false) * ck;
        y2[j * 8 + c * 2 + 1] += __builtin_amdgcn_cvt_pk_f32_fp8(uu, true) * ck;
      }
    }
  }
}

DI void phase_peer_expert(const Params& p) {
  const int lane = threadIdx.x & 63, wid = threadIdx.x >> 6;
  for (int tok = blockIdx.x * 8 + wid; tok < T_TOK; tok += gridDim.x * 8) {
    int myidx[2];
    float mygate[2];
#pragma unroll
    for (int half = 0; half < 2; ++half) {
      myidx[half] = p.idx[(size_t)tok * 128 + half * 64 + lane];
      mygate[half] = p.gates[(size_t)tok * 128 + half * 64 + lane];
    }
    u32x4 bufA[16], bufB[16];
    peer_load8(bufA, p.wU8, myidx[0], 0, lane);
    f32x2 h2[16];
#pragma unroll
    for (int j = 0; j < 2; ++j)
#pragma unroll
      for (int q = 0; q < 2; ++q) {
        const u32x4 t = *(const u32x4*)(p.hbuf + (size_t)tok * 2048 + j * 1024 + lane * 16 + q * 8);
#pragma unroll
        for (int c = 0; c < 4; ++c) { const unsigned tt = t[c]; h2[j * 8 + q * 4 + c] = f32x2{bflo(tt), bfhi(tt)}; }
      }
    f32x2 y2[16];
#pragma unroll
    for (int e = 0; e < 16; ++e) y2[e] = f32x2{0.f, 0.f};
#pragma unroll 1
    for (int half = 0; half < 2; ++half) {
      const int idxv = half ? myidx[1] : myidx[0];
      const float gate = half ? mygate[1] : mygate[0];
      const float mysu = p.su[idxv], mysv = p.sv[idxv];
      float amine = 0.f;
#pragma unroll 1
      for (int g2 = 0; g2 < 4; ++g2) {
        peer_load8(bufB, p.wU8, idxv, 2 * g2 + 1, lane);
        SB();
        { const float v = peer_dot8(bufA, h2, lane); if ((lane >> 3) == 2 * g2) amine = v; }
        SB();
        peer_load8(bufA, g2 < 3 ? p.wU8 : p.wV8, idxv, g2 < 3 ? 2 * g2 + 2 : 0, lane);
        SB();
        { const float v = peer_dot8(bufB, h2, lane); if ((lane >> 3) == 2 * g2 + 1) amine = v; }
        SB();
      }
      const float cval = gate * gelu_tanh(amine * mysu) * mysv;
      const int nidx = myidx[1];
#pragma unroll 1
      for (int g2 = 0; g2 < 4; ++g2) {
        peer_load8(bufB, p.wV8, idxv, 2 * g2 + 1, lane);
        SB();
        peer_acc8(bufA, y2, cval, 2 * g2);
        SB();
        peer_load8(bufA, g2 < 3 ? p.wV8 : p.wU8, g2 < 3 ? idxv : nidx, g2 < 3 ? 2 * g2 + 2 : 0, lane);
        SB();
        peer_acc8(bufB, y2, cval, 2 * g2 + 1);
        SB();
      }
    }
    float ss = 0.f;
#pragma unroll
    for (int j = 0; j < 2; ++j)
#pragma unroll
      for (int q = 0; q < 4; ++q) {
        const float4 a = *(const float4*)(p.xres + (size_t)tok * 2048 + j * 1024 + lane * 16 + q * 4);
        f32x2& lo = y2[j * 8 + q * 2];
        f32x2& hi = y2[j * 8 + q * 2 + 1];
        lo[0] += a.x; lo[1] += a.y; hi[0] += a.z; hi[1] += a.w;
        ss += lo[0] * lo[0] + lo[1] * lo[1] + hi[0] * hi[0] + hi[1] * hi[1];
      }
    ss = wave_sum(ss);
    const float rs = rsqrtf(ss * (1.f / 2048.f) + 1e-6f);
#pragma unroll
    for (int j = 0; j < 2; ++j)
#pragma unroll
      for (int q = 0; q < 4; ++q) {
        const float4 gq = *(const float4*)(p.g_final + j * 1024 + lane * 16 + q * 4);
        const f32x2 lo = y2[j * 8 + q * 2], hi = y2[j * 8 + q * 2 + 1];
        float4 o;
        o.x = lo[0] * rs * gq.x; o.y = lo[1] * rs * gq.y; o.z = hi[0] * rs * gq.z; o.w = hi[1] * rs * gq.w;
        *(float4*)(p.out + (size_t)tok * 2048 + j * 1024 + lane * 16 + q * 4) = o;
      }
  }
}

DI void grid_barrier(unsigned* ctr, unsigned& epoch) {
  asm volatile("s_waitcnt vmcnt(0)" ::: "memory");
  __syncthreads();
  if (threadIdx.x == 0) {
    __builtin_amdgcn_fence(__ATOMIC_RELEASE, "agent");
    asm volatile("s_waitcnt vmcnt(0)" ::: "memory");
    __hip_atomic_fetch_add(ctr, 1u, __ATOMIC_RELAXED, __HIP_MEMORY_SCOPE_AGENT);
    const unsigned target = (epoch + 1u) * gridDim.x;
    unsigned spins = 0;
    while (__hip_atomic_load(ctr, __ATOMIC_RELAXED, __HIP_MEMORY_SCOPE_AGENT) < target) {
      __builtin_amdgcn_s_sleep(1);
      if (++spins > (1u << 24)) break;
    }
    __builtin_amdgcn_fence(__ATOMIC_ACQUIRE, "agent");
    asm volatile("s_waitcnt vmcnt(0)" ::: "memory");
  }
  __syncthreads();
  epoch += 1u;
}

__global__ void __launch_bounds__(NTHREADS) mega(Params p, int phase_lo, int phase_hi) {
  __shared__ __attribute__((aligned(16))) char smem[SMEM_BYTES];
  cg::grid_group grid = cg::this_grid();
  unsigned epoch = 0;
#define PHASE(k, call) if (phase_lo <= (k) && (k) < phase_hi) { if ((k) > phase_lo) { if ((k) == 1) grid.sync(); else grid_barrier(p.bar, epoch); } call; }
  PHASE(0, phase_prep(p, smem))
  PHASE(1, phase_inproj(p, smem))
  PHASE(2, phase_mix_attn(p, smem))
  PHASE(3, phase_pool_combine(p, smem))
  PHASE(4, phase_gemm_resid(p.hbuf, 2048, p.wOutT, 2048, p.x, p.xres, smem))
  PHASE(5, phase_rms(p.xres, p.g_cross, p.hbuf))
  PHASE(6, phase_gemm_bf16(p.hbuf, 2048, p.wCqT, 2048, 512, 0.08838834764831845f, p.qc, smem))
  PHASE(7, phase_cross_attn(p, smem))
  if (ABL != 2) PHASE(8, phase_gemm_resid(p.oc, 512, p.wCoT, 512, p.xres, p.xres, smem))
  PHASE(9, phase_rms(p.xres, p.g_ffn, p.hbuf))
  PHASE(10, phase_gemm_bf16(p.hbuf, 2048, p.wPqT, 2048, 2048, 1.0f, p.pq, smem))
  PHASE(11, phase_peer_route(p, smem))
  PHASE(12, phase_peer_expert(p))
}

extern "C" void kernel_launch(void* const* d_in, const int* in_sizes, int n_in, void* d_out, int out_size, void* d_ws,
                              size_t ws_size, hipStream_t stream) {
  Params p{};
  p.x = (const float*)d_in[0]; p.mem = (const float*)d_in[1]; p.pos = (const int*)d_in[2];
  p.g_mix = (const float*)d_in[3]; p.w_in = (const float*)d_in[4]; p.w_pool = (const float*)d_in[5];
  p.pool_scale = (const float*)d_in[6]; p.w_out = (const float*)d_in[7]; p.g_cross = (const float*)d_in[8];
  p.g_mem = (const float*)d_in[9]; p.w_cq = (const float*)d_in[10]; p.w_ck = (const float*)d_in[11];
  p.w_cv = (const float*)d_in[12]; p.w_co = (const float*)d_in[13]; p.g_ffn = (const float*)d_in[14];
  p.w_pq = (const float*)d_in[15]; p.sk1f = (const float*)d_in[16]; p.sk2f = (const float*)d_in[17];
  p.w_u = (const float*)d_in[18]; p.w_v = (const float*)d_in[19]; p.g_final = (const float*)d_in[20];
  p.out = (float*)d_out;
  char* ws = (char*)d_ws;
  size_t off = 0;
  auto take = [&](size_t bytes) { char* r = ws + off; off += (bytes + 255) & ~(size_t)255; return r; };
  const size_t MB = 1024 * 1024;
  p.wInT = (bfr*)take(16 * MB); p.wPoolT = (bfr*)take(512 * 1024); p.wOutT = (bfr*)take(8 * MB);
  p.wCqT = (bfr*)take(2 * MB); p.wCkT = (bfr*)take(2 * MB); p.wCvT = (bfr*)take(2 * MB); p.wCoT = (bfr*)take(2 * MB);
  p.wPqT = (bfr*)take(8 * MB); p.sk1 = (bfr*)take(32768); p.sk2 = (bfr*)take(32768);
  p.wU8 = (unsigned char*)take(32 * MB); p.wV8 = (unsigned char*)take(32 * MB);
  p.su = (float*)take(65536); p.sv = (float*)take(65536);
  p.memn = (bfr*)take(4 * MB); p.kc = (bfr*)take(1 * MB); p.vc = (bfr*)take(1 * MB);
  p.hbuf = (bfr*)take(64 * MB);
  p.bar = (unsigned*)take(256);
  const size_t r2 = off;
  p.qbuf = (bfr*)take(32 * MB); p.kbuf = (bfr*)take(32 * MB); p.vbuf = (bfr*)take(32 * MB);
  p.pbuf = (bfr*)take(32 * MB); p.mixed = (bfr*)take(32 * MB); p.ob = (bfr*)take(96 * MB);
  p.lse = (float*)take((size_t)3 * T_TOK * 8 * 4);
  const size_t end1 = off;
  off = r2;
  p.xres = (float*)take(128 * MB); p.pq = (bfr*)take(64 * MB); p.qc = (bfr*)take(16 * MB); p.oc = (bfr*)take(16 * MB);
  p.idx = (int*)take(8 * MB); p.gates = (float*)take(8 * MB);
  const size_t end2 = off;
  const size_t need = end1 > end2 ? end1 : end2;
  if (need > ws_size) { fprintf(stderr, "workspace too small: need %zu have %zu\n", need, ws_size); return; }

  static int grid_blocks = 0;
  if (!grid_blocks) {
    int dev = 0, cus = 0, per_cu = 0;
    hipGetDevice(&dev);
    hipDeviceGetAttribute(&cus, hipDeviceAttributeMultiprocessorCount, dev);
    hipOccupancyMaxActiveBlocksPerMultiprocessor(&per_cu, mega, NTHREADS, 0);
    if (per_cu < 1) per_cu = 1;
    if (per_cu > 1) per_cu = 1;
    grid_blocks = cus * per_cu;
  }
  hipMemsetAsync(p.bar, 0, 256, stream);
#if MULTI_LAUNCH
  for (int ph = 0; ph < NPHASE; ++ph) hipLaunchKernelGGL(mega, dim3(grid_blocks), dim3(NTHREADS), 0, stream, p, ph, ph + 1);
#else
  int lo = 0, hi = NPHASE;
  void* args[] = {&p, &lo, &hi};
  hipError_t e = hipLaunchCooperativeKernel((void*)mega, dim3(grid_blocks), dim3(NTHREADS), args, 0, stream);
  if (e != hipSuccess) fprintf(stderr, "cooperative launch failed: %s (grid %d)\n", hipGetErrorString(e), grid_blocks);
#endif
}
```

```cpp
#include <hip/hip_runtime.h>
#include <hip/hip_cooperative_groups.h>
#include <stdint.h>
#include <stdio.h>
namespace cg = cooperative_groups;

#ifndef ABL
#define ABL 0
#endif
#ifndef DUP_MASK
#define DUP_MASK 0
#endif
#ifndef MULTI_LAUNCH
#define MULTI_LAUNCH 0
#endif

#define DI __device__ __forceinline__
typedef unsigned short bfr;
using bf16x8 = __attribute__((ext_vector_type(8))) short;
using s16x4  = __attribute__((ext_vector_type(4))) short;
using f32x4  = __attribute__((ext_vector_type(4))) float;
using u32x4  = __attribute__((ext_vector_type(4))) unsigned;
using u32x2  = __attribute__((ext_vector_type(2))) unsigned;
using bf2    = __attribute__((ext_vector_type(2))) __bf16;
using f32x2  = __attribute__((ext_vector_type(2))) float;
using v6u    = __attribute__((ext_vector_type(6))) unsigned;
using v16f   = __attribute__((ext_vector_type(16))) float;
using v32f   = __attribute__((ext_vector_type(32))) float;

constexpr int T_TOK = 16384;
constexpr int NTHREADS = 512;
constexpr int SMEM_BYTES = 151552;
constexpr int NPHASE = 13;

struct Params {
  const float *x, *mem; const int* pos;
  const float *g_mix, *w_in, *w_pool, *pool_scale, *w_out, *g_cross, *g_mem, *w_cq, *w_ck, *w_cv, *w_co, *g_ffn, *w_pq,
              *sk1f, *sk2f, *w_u, *w_v, *g_final;
  float* out;
  bfr *wInT, *wPoolT, *wOutT, *wCqT, *wCkT, *wCvT, *wCoT, *wPqT, *sk1, *sk2;
  unsigned char *wU8, *wV8; float *su, *sv;
  bfr *hbuf, *memn, *kc, *vc;
  bfr *pbuf, *qbuf, *kbuf, *vbuf, *mixed, *ob; float* lse;
  float* xres; bfr *pq, *qc, *oc; int* idx; float* gates;
  unsigned* bar;
};

DI unsigned pack2(float a, float b) { bf2 p; p[0] = (__bf16)a; p[1] = (__bf16)b; return __builtin_bit_cast(unsigned, p); }
DI float bflo(unsigned u) { return __uint_as_float(u << 16); }
DI float bfhi(unsigned u) { return __uint_as_float(u & 0xffff0000u); }
DI float wave_sum(float v) {
#pragma unroll
  for (int o = 32; o >= 1; o >>= 1) v += __shfl_xor(v, o);
  return v;
}
DI f32x4 mfma16(bf16x8 a, bf16x8 b, f32x4 c) { return __builtin_amdgcn_mfma_f32_16x16x32_bf16(a, b, c, 0, 0, 0); }
DI s16x4 tr_read(const char* p) {
  return __builtin_amdgcn_ds_read_tr16_b64_v4i16((s16x4 __attribute__((address_space(3)))*)(p));
}

DI void gemm_main(const bfr* __restrict__ A, int lda, const bfr* __restrict__ Bt, int ldb, int K, char* smem,
                  f32x4 (&acc)[4][4]) {
  const int tid = threadIdx.x, lane = tid & 63, wid = tid >> 6, wm = wid >> 1, wn = wid & 1, fr = lane & 15, fq = lane >> 4;
  const int lrow = tid >> 3, lc = tid & 7;
  const int sw = ((lc ^ (lrow & 7)) << 4);
  u32x4 ra[4], rb[2];
  const bfr* ga = A + (size_t)lrow * lda + lc * 8;
  const bfr* gb = Bt + (size_t)lrow * ldb + lc * 8;
#pragma unroll
  for (int m = 0; m < 4; ++m)
#pragma unroll
    for (int n = 0; n < 4; ++n) acc[m][n] = f32x4{0.f, 0.f, 0.f, 0.f};
  const int nk = K >> 6;
#pragma unroll
  for (int i = 0; i < 4; ++i) ra[i] = *(const u32x4*)(ga + (size_t)(64 * i) * lda);
#pragma unroll
  for (int i = 0; i < 2; ++i) rb[i] = *(const u32x4*)(gb + (size_t)(64 * i) * ldb);
  __syncthreads();
#pragma unroll
  for (int i = 0; i < 4; ++i) *(u32x4*)(smem + (lrow + 64 * i) * 128 + sw) = ra[i];
#pragma unroll
  for (int i = 0; i < 2; ++i) *(u32x4*)(smem + 32768 + (lrow + 64 * i) * 128 + sw) = rb[i];
  __syncthreads();
  for (int kt = 0; kt < nk; ++kt) {
    const char* cur = smem + (kt & 1) * 49152;
    char* nxt = smem + ((kt + 1) & 1) * 49152;
    const bool more = (kt + 1 < nk);
    if (more) {
#pragma unroll
      for (int i = 0; i < 4; ++i) ra[i] = *(const u32x4*)(ga + (size_t)(64 * i) * lda + (kt + 1) * 64);
#pragma unroll
      for (int i = 0; i < 2; ++i) rb[i] = *(const u32x4*)(gb + (size_t)(64 * i) * ldb + (kt + 1) * 64);
    }
#pragma unroll
    for (int kk = 0; kk < 2; ++kk) {
      bf16x8 af[4], bf[4];
      const int co = (((kk * 4 + fq) ^ (fr & 7)) << 4);
#pragma unroll
      for (int m = 0; m < 4; ++m) af[m] = *(const bf16x8*)(cur + (wm * 64 + m * 16 + fr) * 128 + co);
#pragma unroll
      for (int n = 0; n < 4; ++n) bf[n] = *(const bf16x8*)(cur + 32768 + (wn * 64 + n * 16 + fr) * 128 + co);
#pragma unroll
      for (int m = 0; m < 4; ++m)
#pragma unroll
        for (int n = 0; n < 4; ++n) acc[m][n] = mfma16(bf[n], af[m], acc[m][n]);
    }
    if (more) {
#pragma unroll
      for (int i = 0; i < 4; ++i) *(u32x4*)(nxt + (lrow + 64 * i) * 128 + sw) = ra[i];
#pragma unroll
      for (int i = 0; i < 2; ++i) *(u32x4*)(nxt + 32768 + (lrow + 64 * i) * 128 + sw) = rb[i];
    }
    __syncthreads();
  }
}

DI void tile_map(int id, int MT, int NT, int& mt, int& nt) {
  if ((NT & 7) == 0 && (MT & 31) == 0) {
    const int round = id >> 8, local = id & 255, xcd = local & 7, j = local >> 3, mtl = j & 3, ntl = j >> 2;
    const int MR = MT >> 5;
    const int mr = round % MR, nr = round / MR;
    mt = mr * 32 + xcd * 4 + mtl;
    nt = nr * 8 + ntl;
  } else {
    mt = id % MT;
    nt = id / MT;
  }
}

template <bool BANDED, class StoreF>
DI void attn_core(const bfr* __restrict__ Qb, int qstride, int q0, const bfr* __restrict__ Kb, const bfr* __restrict__ Vb,
                  int kvstride, int key0, char* smem, StoreF store, float& m_out, float& l_out) {
  const int tid = threadIdx.x, lane = tid & 63, w = tid >> 6, fr = lane & 15, fq = lane >> 4;
  char* sK = smem;
  char* sV = smem + 65536;
  __syncthreads();
#pragma unroll 1
  for (int rr = 0; rr < 2; ++rr) {
    u32x4 kr[4], vr[4];
#pragma unroll
    for (int i = 0; i < 4; ++i) {
      const int id = tid + (rr * 4 + i) * 512, key = id >> 4, c = id & 15, lk = key0 + key;
      kr[i] = u32x4{0u, 0u, 0u, 0u};
      vr[i] = u32x4{0u, 0u, 0u, 0u};
      if (lk >= 0) {
        kr[i] = *(const u32x4*)(Kb + (long)lk * kvstride + c * 8);
        vr[i] = *(const u32x4*)(Vb + (long)lk * kvstride + c * 8);
      }
    }
#pragma unroll
    for (int i = 0; i < 4; ++i) {
      const int id = tid + (rr * 4 + i) * 512, key = id >> 4, c = id & 15;
      *(u32x4*)(sK + key * 256 + ((c ^ (key & 15)) << 4)) = kr[i];
      *(u32x4*)(sV + key * 288 + c * 16) = vr[i];
    }
  }
  bf16x8 qf[4];
  {
    const bfr* qrow = Qb + (long)(q0 + w * 16 + fr) * qstride;
#pragma unroll
    for (int kk = 0; kk < 4; ++kk) qf[kk] = *(const bf16x8*)(qrow + kk * 32 + fq * 8);
  }
  __syncthreads();
  constexpr int NT = BANDED ? 10 : 16;
  const int t0 = BANDED ? (w & ~1) : 0;
  f32x4 s[NT];
#pragma unroll
  for (int j = 0; j < NT; ++j) {
    f32x4 a = f32x4{0.f, 0.f, 0.f, 0.f};
    const int key = (t0 + j) * 16 + fr;
#pragma unroll
    for (int kk = 0; kk < 4; ++kk) {
      const bf16x8 kf = *(const bf16x8*)(sK + key * 256 + (((kk * 4 + fq) ^ fr) << 4));
      a = mfma16(kf, qf[kk], a);
    }
    s[j] = a;
  }
  const float L2E = 1.4426950408889634f;
  const float NINF = -__builtin_inff();
  float mx = NINF;
  const int lq = q0 + w * 16 + fr;
#pragma unroll
  for (int j = 0; j < NT; ++j)
#pragma unroll
    for (int i = 0; i < 4; ++i) {
      float v = s[j][i] * L2E;
      if (BANDED) {
        const int lk = key0 + (t0 + j) * 16 + fq * 4 + i;
        const int dist = lq - lk;
        const bool ok = (lk >= 0) && (dist >= 0) && (dist <= 128);
        v = ok ? v : NINF;
      }
      s[j][i] = v;
      mx = fmaxf(mx, v);
    }
  mx = fmaxf(mx, __shfl_xor(mx, 16));
  mx = fmaxf(mx, __shfl_xor(mx, 32));
  float l = 0.f;
#pragma unroll
  for (int j = 0; j < NT; ++j)
#pragma unroll
    for (int i = 0; i < 4; ++i) {
      const float p = __builtin_amdgcn_exp2f(s[j][i] - mx);
      s[j][i] = p;
      l += p;
    }
  l += __shfl_xor(l, 16);
  l += __shfl_xor(l, 32);
  bf16x8 pf[NT / 2];
#pragma unroll
  for (int c = 0; c < NT / 2; ++c) {
    u32x4 t;
    t[0] = pack2(s[2 * c][0], s[2 * c][1]);
    t[1] = pack2(s[2 * c][2], s[2 * c][3]);
    t[2] = pack2(s[2 * c + 1][0], s[2 * c + 1][1]);
    t[3] = pack2(s[2 * c + 1][2], s[2 * c + 1][3]);
    pf[c] = __builtin_bit_cast(bf16x8, t);
  }
  const int q4 = (lane & 15) >> 2, p4 = lane & 3;
  m_out = mx;
  l_out = l;
#pragma unroll 2
  for (int dt = 0; dt < 8; ++dt) {
    f32x4 a = f32x4{0.f, 0.f, 0.f, 0.f};
#pragma unroll
    for (int c = 0; c < NT / 2; ++c) {
      const int kb = (t0 + 2 * c) * 16;
      const s16x4 lo = tr_read(sV + (kb + fq * 4 + q4) * 288 + (dt * 16 + p4 * 4) * 2);
      const s16x4 hi = tr_read(sV + (kb + 16 + fq * 4 + q4) * 288 + (dt * 16 + p4 * 4) * 2);
      const bf16x8 vf = __builtin_shufflevector(lo, hi, 0, 1, 2, 3, 4, 5, 6, 7);
      a = mfma16(vf, pf[c], a);
    }
    store(dt, a, l);
  }
}

DI int f2sort(float f) { int b = __float_as_int(f); return b ^ ((b >> 31) & 0x7fffffff); }
DI float sort2f(int s) { int b = s ^ ((s >> 31) & 0x7fffffff); return __int_as_float(b); }
DI void topk_insert(int (&lst)[16], int key) {
#pragma unroll
  for (int j = 0; j < 16; ++j) {
    const int hi = max(lst[j], key);
    key = min(lst[j], key);
    lst[j] = hi;
  }
}

template <int O, int N>
DI void bfly(float (&p)[64], int lane) {
  const bool up = (lane & O) != 0;
#pragma unroll
  for (int i = 0; i < N / 2; ++i) {
    const float keep = up ? p[i + N / 2] : p[i];
    const float send = up ? p[i] : p[i + N / 2];
    p[i] = keep + __shfl_xor(send, O);
  }
  if constexpr (O > 1) bfly<O / 2, N / 2>(p, lane);
}

DI void rms_row_to_bf16(const float* __restrict__ x, const float* __restrict__ g, bfr* __restrict__ out, int lane) {
  float4 v[8];
  float ss = 0.f;
#pragma unroll
  for (int j = 0; j < 8; ++j) {
    v[j] = *(const float4*)(x + j * 256 + lane * 4);
    ss += v[j].x * v[j].x + v[j].y * v[j].y + v[j].z * v[j].z + v[j].w * v[j].w;
  }
  ss = wave_sum(ss);
  const float rs = rsqrtf(ss * (1.f / 2048.f) + 1e-6f);
#pragma unroll
  for (int j = 0; j < 8; ++j) {
    const float4 gg = *(const float4*)(g + j * 256 + lane * 4);
    u32x2 o;
    o[0] = pack2(v[j].x * rs * gg.x, v[j].y * rs * gg.y);
    o[1] = pack2(v[j].z * rs * gg.z, v[j].w * rs * gg.w);
    *(u32x2*)(out + j * 256 + lane * 4) = o;
  }
}

DI void transpose_tile(const float* __restrict__ W, int K, int N, int k0, int n0, bfr* __restrict__ Wt, float* tile) {
  __syncthreads();
  {
    const int r = threadIdx.x >> 4, c4 = threadIdx.x & 15;
#pragma unroll
    for (int i = 0; i < 2; ++i) {
      const int k = r + 32 * i;
      const float4 v = *(const float4*)(W + (size_t)(k0 + k) * N + n0 + c4 * 4);
      tile[k * 65 + c4 * 4 + 0] = v.x;
      tile[k * 65 + c4 * 4 + 1] = v.y;
      tile[k * 65 + c4 * 4 + 2] = v.z;
      tile[k * 65 + c4 * 4 + 3] = v.w;
    }
  }
  __syncthreads();
  {
    const int n = threadIdx.x >> 3, kc = threadIdx.x & 7;
    u32x4 o;
#pragma unroll
    for (int j = 0; j < 4; ++j) o[j] = pack2(tile[(kc * 8 + 2 * j) * 65 + n], tile[(kc * 8 + 2 * j + 1) * 65 + n]);
    *(u32x4*)(Wt + (size_t)(n0 + n) * K + k0 + kc * 8) = o;
  }
}

DI void convert_f32_bf16(const float* __restrict__ src, bfr* __restrict__ dst, long n8) {
  for (long i = (long)blockIdx.x * NTHREADS + threadIdx.x; i < n8; i += (long)gridDim.x * NTHREADS) {
    const float4 a = *(const float4*)(src + i * 8);
    const float4 b = *(const float4*)(src + i * 8 + 4);
    u32x4 o;
    o[0] = pack2(a.x, a.y); o[1] = pack2(a.z, a.w); o[2] = pack2(b.x, b.y); o[3] = pack2(b.z, b.w);
    *(u32x4*)(dst + i * 8) = o;
  }
}

DI void phase_prep(const Params& p, char* smem) {
  const int lane = threadIdx.x & 63, wid = threadIdx.x >> 6;
  for (int r = blockIdx.x * 8 + wid; r < T_TOK + 1024; r += gridDim.x * 8) {
    if (r < T_TOK) rms_row_to_bf16(p.x + (size_t)r * 2048, p.g_mix, p.hbuf + (size_t)r * 2048, lane);
    else rms_row_to_bf16(p.mem + (size_t)(r - T_TOK) * 2048, p.g_mem, p.memn + (size_t)(r - T_TOK) * 2048, lane);
  }
  float* tile = (float*)smem;
  for (int id0 = blockIdx.x; id0 < 5184; id0 += gridDim.x) {
    int id = id0;
    const float* W; bfr* Wt; int K, N;
    if (id < 2048) { W = p.w_in; Wt = p.wInT; K = 2048; N = 4096; }
    else if ((id -= 2048) < 1024) { W = p.w_out; Wt = p.wOutT; K = 2048; N = 2048; }
    else if ((id -= 1024) < 1024) { W = p.w_pq; Wt = p.wPqT; K = 2048; N = 2048; }
    else if ((id -= 1024) < 256) { W = p.w_cq; Wt = p.wCqT; K = 2048; N = 512; }
    else if ((id -= 256) < 256) { W = p.w_ck; Wt = p.wCkT; K = 2048; N = 512; }
    else if ((id -= 256) < 256) { W = p.w_cv; Wt = p.wCvT; K = 2048; N = 512; }
    else if ((id -= 256) < 256) { W = p.w_co; Wt = p.wCoT; K = 512; N = 2048; }
    else { id -= 256; const int g = id >> 4; id &= 15; W = p.w_pool + g * 65536; Wt = p.wPoolT + g * 65536; K = 256; N = 256; }
    const int ntn = N >> 6;
    const int kt = id / ntn, nt = id % ntn;
    transpose_tile(W, K, N, kt * 64, nt * 64, Wt, tile);
  }
  convert_f32_bf16(p.sk1f, p.sk1, 128 * 128 / 8);
  convert_f32_bf16(p.sk2f, p.sk2, 128 * 128 / 8);
  for (int r = blockIdx.x * 8 + wid; r < 2 * 16384; r += gridDim.x * 8) {
    const bool isv = r >= 16384;
    const int rr = isv ? r - 16384 : r;
    const float* src = (isv ? p.w_v : p.w_u) + (size_t)rr * 2048;
    unsigned char* dst = (isv ? p.wV8 : p.wU8) + (size_t)rr * 1536;
    float4 v[8];
    float amax = 0.f;
#pragma unroll
    for (int j = 0; j < 2; ++j)
#pragma unroll
      for (int q = 0; q < 4; ++q) {
        v[j * 4 + q] = *(const float4*)(src + j * 1024 + lane * 16 + q * 4);
        const float4 t = v[j * 4 + q];
        amax = fmaxf(amax, fmaxf(fmaxf(fabsf(t.x), fabsf(t.y)), fmaxf(fabsf(t.z), fabsf(t.w))));
      }
#pragma unroll
    for (int o = 32; o >= 1; o >>= 1) amax = fmaxf(amax, __shfl_xor(amax, o));
    const float inv = amax > 0.f ? 7.5f / amax : 0.f;
    if (lane == 0) (isv ? p.sv : p.su)[rr] = amax * (1.f / 7.5f);
    v16f qa, qb;
#pragma unroll
    for (int q = 0; q < 4; ++q) {
      qa[q * 4 + 0] = v[q].x * inv; qa[q * 4 + 1] = v[q].y * inv; qa[q * 4 + 2] = v[q].z * inv; qa[q * 4 + 3] = v[q].w * inv;
      qb[q * 4 + 0] = v[4 + q].x * inv; qb[q * 4 + 1] = v[4 + q].y * inv; qb[q * 4 + 2] = v[4 + q].z * inv; qb[q * 4 + 3] = v[4 + q].w * inv;
    }
    const v6u pk = __builtin_amdgcn_cvt_scalef32_2xpk16_fp6_f32(qa, qb, 1.0f);
    *(u32x4*)(dst + lane * 16) = u32x4{pk[0], pk[1], pk[2], pk[3]};
    *(u32x2*)(dst + 1024 + lane * 8) = u32x2{pk[4], pk[5]};
  }
}

DI void phase_inproj(const Params& p, char* smem) {
  const int tid = threadIdx.x, lane = tid & 63, wid = tid >> 6, wm = wid >> 1, wn = wid & 1, fr = lane & 15, fq = lane >> 4;
  f32x4 acc[4][4];
  for (int id = blockIdx.x; id < 2048 + 32; id += gridDim.x) {
    if (id < 2048) {
      int mt, nt;
      tile_map(id, 64, 32, mt, nt);
      gemm_main(p.hbuf + (size_t)mt * 256 * 2048, 2048, p.wInT + (size_t)nt * 128 * 2048, 2048, 2048, smem, acc);
      const int region = nt >> 3, h = nt & 7;
      if (region == 0) {
#pragma unroll
        for (int m = 0; m < 4; ++m) {
          const int row = mt * 256 + wm * 64 + m * 16 + fr;
#pragma unroll
          for (int n = 0; n < 4; ++n) {
            const int col = nt * 128 + wn * 64 + n * 16 + fq * 4;
            u32x2 o; o[0] = pack2(acc[m][n][0], acc[m][n][1]); o[1] = pack2(acc[m][n][2], acc[m][n][3]);
            *(u32x2*)(p.pbuf + (size_t)row * 1024 + col) = o;
          }
        }
      } else {
        bfr* dst = (region == 1) ? p.qbuf : (region == 2 ? p.kbuf : p.vbuf);
        const float scale = (region == 1) ? 0.08838834764831845f : 1.0f;
#pragma unroll
        for (int m = 0; m < 4; ++m) {
          const int row = mt * 256 + wm * 64 + m * 16 + fr;
          const int b = row >> 12, t = row & 4095;
          if (region != 3 && wn == 0) {
            const float posf = (float)p.pos[row];
#pragma unroll
            for (int i = 0; i < 4; ++i) {
              const int j = fq * 4 + i;
              const float inv = exp2f(-(float)j * (18.931568569324174f / 16.0f));
              float sn, cs;
              sincosf(posf * inv, &sn, &cs);
              const float x1 = acc[m][0][i], x2 = acc[m][1][i];
              acc[m][0][i] = x1 * cs - x2 * sn;
              acc[m][1][i] = x2 * cs + x1 * sn;
            }
          }
#pragma unroll
          for (int n = 0; n < 4; ++n) {
            const int d = wn * 64 + n * 16 + fq * 4;
            u32x2 o;
            o[0] = pack2(acc[m][n][0] * scale, acc[m][n][1] * scale);
            o[1] = pack2(acc[m][n][2] * scale, acc[m][n][3] * scale);
            *(u32x2*)(dst + ((size_t)((b * 8 + h) * 4096 + t)) * 128 + d) = o;
          }
        }
      }
    } else {
      const int id2 = id - 2048;
      const int which = id2 >> 4, mt = (id2 >> 2) & 3, nt = id2 & 3;
      const bfr* Bt = (which == 0 ? p.wCkT : p.wCvT) + (size_t)nt * 128 * 2048;
      bfr* dst = which == 0 ? p.kc : p.vc;
      gemm_main(p.memn + (size_t)mt * 256 * 2048, 2048, Bt, 2048, 2048, smem, acc);
#pragma unroll
      for (int m = 0; m < 4; ++m) {
        const int row = mt * 256 + wm * 64 + m * 16 + fr;
        const int b = row >> 8, mm = row & 255;
#pragma unroll
        for (int n = 0; n < 4; ++n) {
          const int d = wn * 64 + n * 16 + fq * 4;
          u32x2 o; o[0] = pack2(acc[m][n][0], acc[m][n][1]); o[1] = pack2(acc[m][n][2], acc[m][n][3]);
          *(u32x2*)(dst + ((size_t)((b * 4 + nt) * 256 + mm)) * 128 + d) = o;
        }
      }
    }
  }
}

DI void phase_mix_attn(const Params& p, char* smem) {
  const int tid = threadIdx.x, lane = tid & 63, w = tid >> 6, fr = lane & 15, fq = lane >> 4;
  for (int id = blockIdx.x; id < 3072 + 256; id += gridDim.x) {
    if (id < 3072) {
      const int br = id >> 10, rem = id & 1023;
      const int dl = (br == 0) ? 1 : (br == 1 ? 4 : 16);
      const int nblk = 32 / dl;
      const int bh = rem >> 5, rn = rem & 31;
      const int r = rn / nblk, nb = rn % nblk;
      const int l0 = nb * 128;
      const size_t base = (size_t)bh * 4096 * 128 + (size_t)r * 128;
      float mx, l;
      const int b = bh >> 3, h = bh & 7;
      const int tt = b * 4096 + (l0 + w * 16 + fr) * dl + r;
      bfr* dst = p.ob + (size_t)br * T_TOK * 1024 + (size_t)tt * 1024 + h * 128 + fq * 4;
      attn_core<true>(p.qbuf + base, dl * 128, l0, p.kbuf + base, p.vbuf + base, dl * 128, l0 - 128, smem,
                      [&](int dt, f32x4 a, float lsum) {
                        const float il = 1.f / lsum;
                        u32x2 v; v[0] = pack2(a[0] * il, a[1] * il); v[1] = pack2(a[2] * il, a[3] * il);
                        *(u32x2*)(dst + dt * 16) = v;
                      }, mx, l);
      if (fq == 0) p.lse[(size_t)br * T_TOK * 8 + (size_t)tt * 8 + h] = mx + __builtin_amdgcn_logf(l);
    } else {
      const int ci = id - 3072;
      const int sub = tid >> 7, cgp = tid & 127;
      const int wdw = 2 << (cgp >> 5);
      const int t0 = ci * 64 + sub * 16, tin0 = t0 & 4095;
      const bfr* pb = p.pbuf + cgp * 8;
      float sum[8];
#pragma unroll
      for (int e = 0; e < 8; ++e) sum[e] = 0.f;
      for (int j = 1; j < wdw; ++j) {
        if (tin0 - j >= 0) {
          const u32x4 v = *(const u32x4*)(pb + (size_t)(t0 - j) * 1024);
#pragma unroll
          for (int e = 0; e < 4; ++e) { sum[2 * e] += bflo(v[e]); sum[2 * e + 1] += bfhi(v[e]); }
        }
      }
      for (int s = 0; s < 16; ++s) {
        const int t = t0 + s, tin = tin0 + s;
        const u32x4 v = *(const u32x4*)(pb + (size_t)t * 1024);
        float cur[8];
#pragma unroll
        for (int e = 0; e < 4; ++e) { cur[2 * e] = bflo(v[e]); cur[2 * e + 1] = bfhi(v[e]); }
        const float ic = 1.f / (float)min(tin + 1, wdw);
        u32x4 ov;
#pragma unroll
        for (int e = 0; e < 8; ++e) sum[e] += cur[e];
#pragma unroll
        for (int e = 0; e < 4; ++e) ov[e] = pack2(sum[2 * e] * ic - cur[2 * e], sum[2 * e + 1] * ic - cur[2 * e + 1]);
        *(u32x4*)(p.mixed + (size_t)t * 1024 + cgp * 8) = ov;
        if (tin - wdw + 1 >= 0) {
          const u32x4 u = *(const u32x4*)(pb + (size_t)(t - wdw + 1) * 1024);
#pragma unroll
          for (int e = 0; e < 4; ++e) { sum[2 * e] -= bflo(u[e]); sum[2 * e + 1] -= bfhi(u[e]); }
        }
      }
    }
  }
}

DI void phase_pool_combine(const Params& p, char* smem) {
  const int tid = threadIdx.x, lane = tid & 63, wid = tid >> 6, wm = wid >> 1, wn = wid & 1, fr = lane & 15, fq = lane >> 4;
  f32x4 acc[4][4];
  for (int id = blockIdx.x; id < 512; id += gridDim.x) {
    const int g = id >> 7, mt = (id >> 1) & 63, nt = id & 1;
    gemm_main(p.mixed + (size_t)mt * 256 * 1024 + g * 256, 1024, p.wPoolT + (size_t)g * 65536 + (size_t)nt * 128 * 256, 256, 256,
              smem, acc);
#pragma unroll
    for (int m = 0; m < 4; ++m) {
      const int row = mt * 256 + wm * 64 + m * 16 + fr;
#pragma unroll
      for (int n = 0; n < 4; ++n) {
        const int e = nt * 128 + wn * 64 + n * 16 + fq * 4;
        const float4 sc = *(const float4*)(p.pool_scale + g * 256 + e);
        u32x2 o; o[0] = pack2(acc[m][n][0] * sc.x, acc[m][n][1] * sc.y); o[1] = pack2(acc[m][n][2] * sc.z, acc[m][n][3] * sc.w);
        *(u32x2*)(p.hbuf + (size_t)row * 2048 + g * 256 + e) = o;
      }
    }
  }
  for (long i = (long)blockIdx.x * NTHREADS + tid; i < (long)T_TOK * 8 * 16; i += (long)gridDim.x * NTHREADS) {
    const int dc = (int)(i & 15), h = (int)((i >> 4) & 7);
    const long tt = i >> 7;
    const float l0 = p.lse[tt * 8 + h], l1 = p.lse[(size_t)T_TOK * 8 + tt * 8 + h], l2 = p.lse[(size_t)2 * T_TOK * 8 + tt * 8 + h];
    const float mx = fmaxf(l0, fmaxf(l1, l2));
    float w0 = __builtin_amdgcn_exp2f(l0 - mx), w1 = __builtin_amdgcn_exp2f(l1 - mx), w2 = __builtin_amdgcn_exp2f(l2 - mx);
    const float inv = 1.f / (w0 + w1 + w2);
    w0 *= inv; w1 *= inv; w2 *= inv;
    if (ABL == 3) { w0 = 0.f; w1 = 0.f; w2 = 0.f; }
    const size_t off = (size_t)tt * 1024 + h * 128 + dc * 8;
    const u32x4 a = *(const u32x4*)(p.ob + off);
    const u32x4 b = *(const u32x4*)(p.ob + (size_t)T_TOK * 1024 + off);
    const u32x4 c = *(const u32x4*)(p.ob + (size_t)2 * T_TOK * 1024 + off);
    u32x4 o;
#pragma unroll
    for (int e = 0; e < 4; ++e)
      o[e] = pack2(w0 * bflo(a[e]) + w1 * bflo(b[e]) + w2 * bflo(c[e]), w0 * bfhi(a[e]) + w1 * bfhi(b[e]) + w2 * bfhi(c[e]));
    *(u32x4*)(p.hbuf + (size_t)tt * 2048 + 1024 + h * 128 + dc * 8) = o;
  }
}

DI void phase_gemm_resid(const bfr* A, int lda, const bfr* Bt, int K, const float* resid, float* xout, char* smem) {
  const int tid = threadIdx.x, lane = tid & 63, wid = tid >> 6, wm = wid >> 1, wn = wid & 1, fr = lane & 15, fq = lane >> 4;
  f32x4 acc[4][4];
  for (int id = blockIdx.x; id < 1024; id += gridDim.x) {
    int mt, nt;
    tile_map(id, 64, 16, mt, nt);
    gemm_main(A + (size_t)mt * 256 * lda, lda, Bt + (size_t)nt * 128 * K, K, K, smem, acc);
#pragma unroll
    for (int m = 0; m < 4; ++m) {
      const int row = mt * 256 + wm * 64 + m * 16 + fr;
#pragma unroll
      for (int n = 0; n < 4; ++n) {
        const int col = nt * 128 + wn * 64 + n * 16 + fq * 4;
        const float4 r = *(const float4*)(resid + (size_t)row * 2048 + col);
        float4 o; o.x = r.x + acc[m][n][0]; o.y = r.y + acc[m][n][1]; o.z = r.z + acc[m][n][2]; o.w = r.w + acc[m][n][3];
        *(float4*)(xout + (size_t)row * 2048 + col) = o;
      }
    }
  }
}

DI void phase_rms(const float* xin, const float* g, bfr* out) {
  const int lane = threadIdx.x & 63, wid = threadIdx.x >> 6;
  for (int r = blockIdx.x * 8 + wid; r < T_TOK; r += gridDim.x * 8)
    rms_row_to_bf16(xin + (size_t)r * 2048, g, out + (size_t)r * 2048, lane);
}

DI void phase_gemm_bf16(const bfr* A, int lda, const bfr* Bt, int K, int N, float scale, bfr* out, char* smem) {
  const int tid = threadIdx.x, lane = tid & 63, wid = tid >> 6, wm = wid >> 1, wn = wid & 1, fr = lane & 15, fq = lane >> 4;
  f32x4 acc[4][4];
  const int NT = N >> 7;
  for (int id = blockIdx.x; id < 64 * NT; id += gridDim.x) {
    int mt, nt;
    tile_map(id, 64, NT, mt, nt);
    gemm_main(A + (size_t)mt * 256 * lda, lda, Bt + (size_t)nt * 128 * K, K, K, smem, acc);
#pragma unroll
    for (int m = 0; m < 4; ++m) {
      const int row = mt * 256 + wm * 64 + m * 16 + fr;
#pragma unroll
      for (int n = 0; n < 4; ++n) {
        const int col = nt * 128 + wn * 64 + n * 16 + fq * 4;
        u32x2 o; o[0] = pack2(acc[m][n][0] * scale, acc[m][n][1] * scale); o[1] = pack2(acc[m][n][2] * scale, acc[m][n][3] * scale);
        *(u32x2*)(out + (size_t)row * N + col) = o;
      }
    }
  }
}

DI void phase_cross_attn(const Params& p, char* smem) {
  const int tid = threadIdx.x, lane = tid & 63, w = tid >> 6, fr = lane & 15, fq = lane >> 4;
  for (int id = blockIdx.x; id < 512; id += gridDim.x) {
    const int b = id >> 7, h = (id >> 5) & 3, qt = id & 31;
    float mx, l;
    const size_t kvb = (size_t)(b * 4 + h) * 256 * 128;
    bfr* dst = p.oc + (size_t)(b * 4096 + qt * 128 + w * 16 + fr) * 512 + h * 128 + fq * 4;
    attn_core<false>(p.qc + (size_t)b * 4096 * 512 + h * 128, 512, qt * 128, p.kc + kvb, p.vc + kvb, 128, 0, smem,
                     [&](int dt, f32x4 a, float lsum) {
                       const float il = 1.f / lsum;
                       u32x2 v; v[0] = pack2(a[0] * il, a[1] * il); v[1] = pack2(a[2] * il, a[3] * il);
                       *(u32x2*)(dst + dt * 16) = v;
                     }, mx, l);
  }
}

DI void phase_peer_route(const Params& p, char* smem) {
  const int tid = threadIdx.x, lane = tid & 63, w = tid >> 6, fr = lane & 15, fq = lane >> 4;
  float* scores = (float*)smem;
  int* lists = (int*)(smem + 135168);
  for (int id = blockIdx.x; id < 1024; id += gridDim.x) {
    const int tt = id >> 3, h = id & 7;
    const int tok0 = tt * 128;
    __syncthreads();
#pragma unroll
    for (int hf = 0; hf < 2; ++hf) {
      const bfr* arow = p.pq + (size_t)(tok0 + w * 16 + fr) * 2048 + h * 256 + hf * 128;
      bf16x8 af[4];
#pragma unroll
      for (int kk = 0; kk < 4; ++kk) af[kk] = *(const bf16x8*)(arow + kk * 32 + fq * 8);
      const bfr* sk = hf ? p.sk2 : p.sk1;
#pragma unroll
      for (int nt = 0; nt < 8; ++nt) {
        f32x4 a = f32x4{0.f, 0.f, 0.f, 0.f};
#pragma unroll
        for (int kk = 0; kk < 4; ++kk) {
          const bf16x8 bfg = *(const bf16x8*)(sk + (nt * 16 + fr) * 128 + kk * 32 + fq * 8);
          a = mfma16(af[kk], bfg, a);
        }
#pragma unroll
        for (int i = 0; i < 4; ++i) scores[(hf * 128 + w * 16 + fq * 4 + i) * 132 + nt * 16 + fr] = a[i];
      }
    }
    __syncthreads();
    if (tid < 256) {
      int lst[16];
#pragma unroll
      for (int j = 0; j < 16; ++j) lst[j] = (int)0x80000000;
      const float* srow = scores + tid * 132;
      for (int k4 = 0; k4 < 32; ++k4) {
        const float4 v = *(const float4*)(srow + k4 * 4);
        topk_insert(lst, (f2sort(v.x) & ~0x7F) | (k4 * 4 + 0));
        topk_insert(lst, (f2sort(v.y) & ~0x7F) | (k4 * 4 + 1));
        topk_insert(lst, (f2sort(v.z) & ~0x7F) | (k4 * 4 + 2));
        topk_insert(lst, (f2sort(v.w) & ~0x7F) | (k4 * 4 + 3));
      }
#pragma unroll
      for (int j = 0; j < 16; ++j) lists[tid * 16 + j] = lst[j];
    }
    __syncthreads();
    if (tid < 128) {
      float v1[16], v2[16];
#pragma unroll
      for (int j = 0; j < 16; ++j) {
        v1[j] = sort2f(lists[tid * 16 + j] & ~0x7F);
        v2[j] = sort2f(lists[(128 + tid) * 16 + j] & ~0x7F);
      }
      int top[16];
#pragma unroll
      for (int j = 0; j < 16; ++j) top[j] = (int)0x80000000;
#pragma unroll
      for (int a = 0; a < 16; ++a)
#pragma unroll
        for (int b = 0; b < 16; ++b)
          if ((a + 1) * (b + 1) <= 16) topk_insert(top, (f2sort(v1[a] + v2[b]) & ~0xFF) | (a * 16 + b));
      int ex[16];
      float sum = 0.f;
#pragma unroll
      for (int j = 0; j < 16; ++j) {
        const int code = top[j] & 0xFF;
        const int i1 = lists[tid * 16 + (code >> 4)] & 0x7F;
        const int i2 = lists[(128 + tid) * 16 + (code & 15)] & 0x7F;
        ex[j] = i1 * 128 + i2;
      }
      const float mxv = sort2f(top[0] & ~0xFF);
      float ev[16];
#pragma unroll
      for (int j = 0; j < 16; ++j) { ev[j] = __expf(sort2f(top[j] & ~0xFF) - mxv); sum += ev[j]; }
      const float inv = 1.f / sum;
      const size_t ob = (size_t)(tok0 + tid) * 128 + h * 16;
#pragma unroll
      for (int j4 = 0; j4 < 4; ++j4) {
        int4 iv; iv.x = ex[j4 * 4]; iv.y = ex[j4 * 4 + 1]; iv.z = ex[j4 * 4 + 2]; iv.w = ex[j4 * 4 + 3];
        float4 gv; gv.x = ev[j4 * 4] * inv; gv.y = ev[j4 * 4 + 1] * inv; gv.z = ev[j4 * 4 + 2] * inv; gv.w = ev[j4 * 4 + 3] * inv;
        *(int4*)(p.idx + ob + j4 * 4) = iv;
        *(float4*)(p.gates + ob + j4 * 4) = gv;
      }
    }
  }
}

DI float gelu_tanh(float a) {
  const float u = 0.7978845608028654f * (a + 0.044715f * a * a * a);
  return 0.5f * a * (1.f + tanhf(u));
}

#define SB() __builtin_amdgcn_sched_barrier(0)
DI void peer_load8(u32x4 (&bufa)[8], u32x4 (&bufb)[8], const unsigned char* tbl, int idxv, int g, int lane) {
#pragma unroll
  for (int k = 0; k < 8; ++k) {
    const int e = __builtin_amdgcn_readlane(idxv, g * 8 + k);
    const unsigned char* row = tbl + (size_t)e * 1536;
    bufa[k] = *(const u32x4*)(row + lane * 16);
    { const u32x2 t2 = *(const u32x2*)(row + 1024 + lane * 8); bufb[k] = u32x4{t2[0], t2[1], 0u, 0u}; }
  }
}
DI v32f peer_unpack(const u32x4 a, const u32x4 b) {
  const v6u q = v6u{a[0], a[1], a[2], a[3], b[0], b[1]};
  return __builtin_amdgcn_cvt_scalef32_pk32_f32_fp6(q, 1.0f);
}
DI float peer_dot8(const u32x4 (&bufa)[8], const u32x4 (&bufb)[8], const f32x2 (&hs)[16], int lane) {
  float part[8];
#pragma unroll
  for (int k = 0; k < 8; ++k) {
    const v32f r = peer_unpack(bufa[k], bufb[k]);
    f32x2 a2 = f32x2{0.f, 0.f};
#pragma unroll
    for (int i = 0; i < 16; ++i) a2 += f32x2{r[2 * i], r[2 * i + 1]} * hs[i];
    part[k] = a2[0] + a2[1];
  }
  const bool up4 = (lane & 4) != 0, up2 = (lane & 2) != 0, up1 = (lane & 1) != 0;
  float q[4];
#pragma unroll
  for (int i = 0; i < 4; ++i) {
    const float keep = up4 ? part[i + 4] : part[i];
    const float send = up4 ? part[i] : part[i + 4];
    q[i] = keep + __shfl_xor(send, 4);
  }
  float r[2];
#pragma unroll
  for (int i = 0; i < 2; ++i) {
    const float keep = up2 ? q[i + 2] : q[i];
    const float send = up2 ? q[i] : q[i + 2];
    r[i] = keep + __shfl_xor(send, 2);
  }
  float v = (up1 ? r[1] : r[0]) + __shfl_xor(up1 ? r[0] : r[1], 1);
  v += __shfl_xor(v, 8);
  v += __shfl_xor(v, 16);
  v += __shfl_xor(v, 32);
  return v;
}
DI void peer_acc8(const u32x4 (&bufa)[8], const u32x4 (&bufb)[8], f32x2 (&ys)[16], float cval, int g) {
#pragma unroll
  for (int k = 0; k < 8; ++k) {
    const float ck = __builtin_bit_cast(float, __builtin_amdgcn_readlane(__builtin_bit_cast(int, cval), g * 8 + k));
    const v32f r = peer_unpack(bufa[k], bufb[k]);
#pragma unroll
    for (int i = 0; i < 16; ++i) ys[i] += f32x2{r[2 * i], r[2 * i + 1]} * ck;
  }
}
DI float fp6_tag(int k) { return k < 8 ? 0.125f * k : (k < 16 ? 1.f + 0.125f * (k - 8) : (k < 24 ? 2.f + 0.25f * (k - 16) : 4.f + 0.5f * (k - 24))); }

DI void phase_peer_expert(const Params& p) {
  const int lane = threadIdx.x & 63, wid = threadIdx.x >> 6;
  bool flagI;
  {
    v16f ta, tb;
#pragma unroll
    for (int i = 0; i < 16; ++i) { ta[i] = fp6_tag(i); tb[i] = fp6_tag(16 + i); }
    asm volatile("" : "+v"(ta), "+v"(tb));
    const v6u pk = __builtin_amdgcn_cvt_scalef32_2xpk16_fp6_f32(ta, tb, 1.0f);
    const v32f r = __builtin_amdgcn_cvt_scalef32_pk32_f32_fp6(pk, 1.0f);
    flagI = (r[1] == 2.0f);
  }
  for (int tok = blockIdx.x * 8 + wid; tok < T_TOK; tok += gridDim.x * 8) {
    int myidx[2];
    float mygate[2];
#pragma unroll
    for (int half = 0; half < 2; ++half) {
      myidx[half] = p.idx[(size_t)tok * 128 + half * 64 + lane];
      mygate[half] = p.gates[(size_t)tok * 128 + half * 64 + lane];
    }
    u32x4 bufAa[8], bufBa[8];
    u32x4 bufAb[8], bufBb[8];
    peer_load8(bufAa, bufAb, p.wU8, myidx[0], 0, lane);
    f32x2 hs[16];
    {
      float he[32];
#pragma unroll
      for (int j = 0; j < 2; ++j)
#pragma unroll
        for (int q = 0; q < 2; ++q) {
          const u32x4 t = *(const u32x4*)(p.hbuf + (size_t)tok * 2048 + j * 1024 + lane * 16 + q * 8);
#pragma unroll
          for (int c = 0; c < 4; ++c) { const unsigned tt = t[c]; he[j * 16 + q * 8 + c * 2] = bflo(tt); he[j * 16 + q * 8 + c * 2 + 1] = bfhi(tt); }
        }
#pragma unroll
      for (int i = 0; i < 16; ++i) {
        const float n0 = he[2 * i], n1 = he[2 * i + 1];
        const float i0 = he[i], i1 = he[16 + i];
        hs[i] = f32x2{flagI ? i0 : n0, flagI ? i1 : n1};
      }
    }
    f32x2 ys[16];
#pragma unroll
    for (int e = 0; e < 16; ++e) ys[e] = f32x2{0.f, 0.f};
#pragma unroll 1
    for (int half = 0; half < 2; ++half) {
      const int idxv = half ? myidx[1] : myidx[0];
      const float gate = half ? mygate[1] : mygate[0];
      const float mysu = p.su[idxv], mysv = p.sv[idxv];
      float amine = 0.f;
#pragma unroll 1
      for (int g2 = 0; g2 < 4; ++g2) {
        peer_load8(bufBa, bufBb, p.wU8, idxv, 2 * g2 + 1, lane);
        SB();
        { const float v = peer_dot8(bufAa, bufAb, hs, lane); if ((lane >> 3) == 2 * g2) amine = v; }
        SB();
        peer_load8(bufAa, bufAb, g2 < 3 ? p.wU8 : p.wV8, idxv, g2 < 3 ? 2 * g2 + 2 : 0, lane);
        SB();
        { const float v = peer_dot8(bufBa, bufBb, hs, lane); if ((lane >> 3) == 2 * g2 + 1) amine = v; }
        SB();
      }
      const float cval = gate * gelu_tanh(amine * mysu) * mysv;
      const int nidx = myidx[1];
#pragma unroll 1
      for (int g2 = 0; g2 < 4; ++g2) {
        peer_load8(bufBa, bufBb, p.wV8, idxv, 2 * g2 + 1, lane);
        SB();
        peer_acc8(bufAa, bufAb, ys, cval, 2 * g2);
        SB();
        peer_load8(bufAa, bufAb, g2 < 3 ? p.wV8 : p.wU8, g2 < 3 ? idxv : nidx, g2 < 3 ? 2 * g2 + 2 : 0, lane);
        SB();
        peer_acc8(bufBa, bufBb, ys, cval, 2 * g2 + 1);
        SB();
      }
    }
    float ye[32];
#pragma unroll
    for (int i = 0; i < 16; ++i) {
      const float nA = ys[i >> 1][i & 1], nB = ys[8 + (i >> 1)][i & 1];
      const float iA = ys[i][0], iB = ys[i][1];
      ye[i] = flagI ? iA : nA;
      ye[16 + i] = flagI ? iB : nB;
    }
    float ss = 0.f;
#pragma unroll
    for (int j = 0; j < 2; ++j)
#pragma unroll
      for (int q = 0; q < 4; ++q) {
        const float4 a = *(const float4*)(p.xres + (size_t)tok * 2048 + j * 1024 + lane * 16 + q * 4);
        const int b0 = j * 16 + q * 4;
        ye[b0] += a.x; ye[b0 + 1] += a.y; ye[b0 + 2] += a.z; ye[b0 + 3] += a.w;
        ss += ye[b0] * ye[b0] + ye[b0 + 1] * ye[b0 + 1] + ye[b0 + 2] * ye[b0 + 2] + ye[b0 + 3] * ye[b0 + 3];
      }
    ss = wave_sum(ss);
    const float rs = rsqrtf(ss * (1.f / 2048.f) + 1e-6f);
#pragma unroll
    for (int j = 0; j < 2; ++j)
#pragma unroll
      for (int q = 0; q < 4; ++q) {
        const float4 gq = *(const float4*)(p.g_final + j * 1024 + lane * 16 + q * 4);
        const int b0 = j * 16 + q * 4;
        float4 o;
        o.x = ye[b0] * rs * gq.x; o.y = ye[b0 + 1] * rs * gq.y; o.z = ye[b0 + 2] * rs * gq.z; o.w = ye[b0 + 3] * rs * gq.w;
        *(float4*)(p.out + (size_t)tok * 2048 + j * 1024 + lane * 16 + q * 4) = o;
      }
  }
}

DI void grid_barrier(unsigned* ctr, unsigned& epoch) {
  asm volatile("s_waitcnt vmcnt(0)" ::: "memory");
  __syncthreads();
  if (threadIdx.x == 0) {
    __builtin_amdgcn_fence(__ATOMIC_RELEASE, "agent");
    asm volatile("s_waitcnt vmcnt(0)" ::: "memory");
    __hip_atomic_fetch_add(ctr, 1u, __ATOMIC_RELAXED, __HIP_MEMORY_SCOPE_AGENT);
    const unsigned target = (epoch + 1u) * gridDim.x;
    unsigned spins = 0;
    while (__hip_atomic_load(ctr, __ATOMIC_RELAXED, __HIP_MEMORY_SCOPE_AGENT) < target) {
      __builtin_amdgcn_s_sleep(1);
      if (++spins > (1u << 24)) break;
    }
    __builtin_amdgcn_fence(__ATOMIC_ACQUIRE, "agent");
    asm volatile("s_waitcnt vmcnt(0)" ::: "memory");
  }
  __syncthreads();
  epoch += 1u;
}

__global__ void __launch_bounds__(NTHREADS) mega(Params p, int phase_lo, int phase_hi) {
  __shared__ __attribute__((aligned(16))) char smem[SMEM_BYTES];
  cg::grid_group grid = cg::this_grid();
  unsigned epoch = 0;
#define PHASE(k, call) if (phase_lo <= (k) && (k) < phase_hi) { if ((k) > phase_lo) { if ((k) == 1) grid.sync(); else grid_barrier(p.bar, epoch); } call; if ((DUP_MASK >> (k)) & 1) { grid_barrier(p.bar, epoch); call; } }
  PHASE(0, phase_prep(p, smem))
  PHASE(1, phase_inproj(p, smem))
  PHASE(2, phase_mix_attn(p, smem))
  PHASE(3, phase_pool_combine(p, smem))
  PHASE(4, phase_gemm_resid(p.hbuf, 2048, p.wOutT, 2048, p.x, p.xres, smem))
  PHASE(5, phase_rms(p.xres, p.g_cross, p.hbuf))
  PHASE(6, phase_gemm_bf16(p.hbuf, 2048, p.wCqT, 2048, 512, 0.08838834764831845f, p.qc, smem))
  PHASE(7, phase_cross_attn(p, smem))
  if (ABL != 2) PHASE(8, phase_gemm_resid(p.oc, 512, p.wCoT, 512, p.xres, p.xres, smem))
  PHASE(9, phase_rms(p.xres, p.g_ffn, p.hbuf))
  PHASE(10, phase_gemm_bf16(p.hbuf, 2048, p.wPqT, 2048, 2048, 1.0f, p.pq, smem))
  PHASE(11, phase_peer_route(p, smem))
  PHASE(12, phase_peer_expert(p))
}

extern "C" void kernel_launch(void* const* d_in, const int* in_sizes, int n_in, void* d_out, int out_size, void* d_ws,
                              size_t ws_size, hipStream_t stream) {
  Params p{};
  p.x = (const float*)d_in[0]; p.mem = (const float*)d_in[1]; p.pos = (const int*)d_in[2];
  p.g_mix = (const float*)d_in[3]; p.w_in = (const float*)d_in[4]; p.w_pool = (const float*)d_in[5];
  p.pool_scale = (const float*)d_in[6]; p.w_out = (const float*)d_in[7]; p.g_cross = (const float*)d_in[8];
  p.g_mem = (const float*)d_in[9]; p.w_cq = (const float*)d_in[10]; p.w_ck = (const float*)d_in[11];
  p.w_cv = (const float*)d_in[12]; p.w_co = (const float*)d_in[13]; p.g_ffn = (const float*)d_in[14];
  p.w_pq = (const float*)d_in[15]; p.sk1f = (const float*)d_in[16]; p.sk2f = (const float*)d_in[17];
  p.w_u = (const float*)d_in[18]; p.w_v = (const float*)d_in[19]; p.g_final = (const float*)d_in[20];
  p.out = (float*)d_out;
  char* ws = (char*)d_ws;
  size_t off = 0;
  auto take = [&](size_t bytes) { char* r = ws + off; off += (bytes + 255) & ~(size_t)255; return r; };
  const size_t MB = 1024 * 1024;
  p.wInT = (bfr*)take(16 * MB); p.wPoolT = (bfr*)take(512 * 1024); p.wOutT = (bfr*)take(8 * MB);
  p.wCqT = (bfr*)take(2 * MB); p.wCkT = (bfr*)take(2 * MB); p.wCvT = (bfr*)take(2 * MB); p.wCoT = (bfr*)take(2 * MB);
  p.wPqT = (bfr*)take(8 * MB); p.sk1 = (bfr*)take(32768); p.sk2 = (bfr*)take(32768);
  p.wU8 = (unsigned char*)take(32 * MB); p.wV8 = (unsigned char*)take(32 * MB);
  p.su = (float*)take(65536); p.sv = (float*)take(65536);
  p.memn = (bfr*)take(4 * MB); p.kc = (bfr*)take(1 * MB); p.vc = (bfr*)take(1 * MB);
  p.hbuf = (bfr*)take(64 * MB);
  p.bar = (unsigned*)take(256);
  const size_t r2 = off;
  p.qbuf = (bfr*)take(32 * MB); p.kbuf = (bfr*)take(32 * MB); p.vbuf = (bfr*)take(32 * MB);
  p.pbuf = (bfr*)take(32 * MB); p.mixed = (bfr*)take(32 * MB); p.ob = (bfr*)take(96 * MB);
  p.lse = (float*)take((size_t)3 * T_TOK * 8 * 4);
  const size_t end1 = off;
  off = r2;
  p.xres = (float*)take(128 * MB); p.pq = (bfr*)take(64 * MB); p.qc = (bfr*)take(16 * MB); p.oc = (bfr*)take(16 * MB);
  p.idx = (int*)take(8 * MB); p.gates = (float*)take(8 * MB);
  const size_t end2 = off;
  const size_t need = end1 > end2 ? end1 : end2;
  if (need > ws_size) { fprintf(stderr, "workspace too small: need %zu have %zu\n", need, ws_size); return; }

  static int grid_blocks = 0;
  if (!grid_blocks) {
    int dev = 0, cus = 0, per_cu = 0;
    hipGetDevice(&dev);
    hipDeviceGetAttribute(&cus, hipDeviceAttributeMultiprocessorCount, dev);
    hipOccupancyMaxActiveBlocksPerMultiprocessor(&per_cu, mega, NTHREADS, 0);
    if (per_cu < 1) per_cu = 1;
    if (per_cu > 1) per_cu = 1;
    grid_blocks = cus * per_cu;
  }
  hipMemsetAsync(p.bar, 0, 256, stream);
#if MULTI_LAUNCH
  for (int ph = 0; ph < NPHASE; ++ph) hipLaunchKernelGGL(mega, dim3(grid_blocks), dim3(NTHREADS), 0, stream, p, ph, ph + 1);
#else
  int lo = 0, hi = NPHASE;
  void* args[] = {&p, &lo, &hi};
  hipError_t e = hipLaunchCooperativeKernel((void*)mega, dim3(grid_blocks), dim3(NTHREADS), args, 0, stream);
  if (e != hipSuccess) fprintf(stderr, "cooperative launch failed: %s (grid %d)\n", hipGetErrorString(e), grid_blocks);
#endif
}
```

```cpp
#include <hip/hip_runtime.h>
#include <hip/hip_cooperative_groups.h>
#include <stdint.h>
#include <stdio.h>
namespace cg = cooperative_groups;

#ifndef ABL
#define ABL 0
#endif
#ifndef DUP_MASK
#define DUP_MASK 0
#endif
#ifndef MULTI_LAUNCH
#define MULTI_LAUNCH 0
#endif

#define DI __device__ __forceinline__
typedef unsigned short bfr;
using bf16x8 = __attribute__((ext_vector_type(8))) short;
using s16x4  = __attribute__((ext_vector_type(4))) short;
using f32x4  = __attribute__((ext_vector_type(4))) float;
using u32x4  = __attribute__((ext_vector_type(4))) unsigned;
using u32x2  = __attribute__((ext_vector_type(2))) unsigned;
using bf2    = __attribute__((ext_vector_type(2))) __bf16;
using f32x2  = __attribute__((ext_vector_type(2))) float;
using v6u    = __attribute__((ext_vector_type(6))) unsigned;
using v16f   = __attribute__((ext_vector_type(16))) float;
using v32f   = __attribute__((ext_vector_type(32))) float;

constexpr int T_TOK = 16384;
constexpr int NTHREADS = 512;
constexpr int SMEM_BYTES = 151552;
constexpr int NPHASE = 13;

struct Params {
  const float *x, *mem; const int* pos;
  const float *g_mix, *w_in, *w_pool, *pool_scale, *w_out, *g_cross, *g_mem, *w_cq, *w_ck, *w_cv, *w_co, *g_ffn, *w_pq,
              *sk1f, *sk2f, *w_u, *w_v, *g_final;
  float* out;
  bfr *wInT, *wPoolT, *wOutT, *wCqT, *wCkT, *wCvT, *wCoT, *wPqT, *sk1, *sk2;
  unsigned char *wU8, *wV8; float *su, *sv;
  bfr *hbuf, *memn, *kc, *vc;
  bfr *pbuf, *qbuf, *kbuf, *vbuf, *mixed, *ob; float* lse;
  float* xres; bfr *pq, *qc, *oc; int* idx; float* gates;
  unsigned* bar;
};

DI unsigned pack2(float a, float b) { bf2 p; p[0] = (__bf16)a; p[1] = (__bf16)b; return __builtin_bit_cast(unsigned, p); }
DI float bflo(unsigned u) { return __uint_as_float(u << 16); }
DI float bfhi(unsigned u) { return __uint_as_float(u & 0xffff0000u); }
DI float wave_sum(float v) {
#pragma unroll
  for (int o = 32; o >= 1; o >>= 1) v += __shfl_xor(v, o);
  return v;
}
DI f32x4 mfma16(bf16x8 a, bf16x8 b, f32x4 c) { return __builtin_amdgcn_mfma_f32_16x16x32_bf16(a, b, c, 0, 0, 0); }
DI s16x4 tr_read(const char* p) {
  return __builtin_amdgcn_ds_read_tr16_b64_v4i16((s16x4 __attribute__((address_space(3)))*)(p));
}

DI void gemm_main(const bfr* __restrict__ A, int lda, const bfr* __restrict__ Bt, int ldb, int K, char* smem,
                  f32x4 (&acc)[4][4]) {
  const int tid = threadIdx.x, lane = tid & 63, wid = tid >> 6, wm = wid >> 1, wn = wid & 1, fr = lane & 15, fq = lane >> 4;
  const int lrow = tid >> 3, lc = tid & 7;
  const int sw = ((lc ^ (lrow & 7)) << 4);
  u32x4 ra[4], rb[2];
  const bfr* ga = A + (size_t)lrow * lda + lc * 8;
  const bfr* gb = Bt + (size_t)lrow * ldb + lc * 8;
#pragma unroll
  for (int m = 0; m < 4; ++m)
#pragma unroll
    for (int n = 0; n < 4; ++n) acc[m][n] = f32x4{0.f, 0.f, 0.f, 0.f};
  const int nk = K >> 6;
#pragma unroll
  for (int i = 0; i < 4; ++i) ra[i] = *(const u32x4*)(ga + (size_t)(64 * i) * lda);
#pragma unroll
  for (int i = 0; i < 2; ++i) rb[i] = *(const u32x4*)(gb + (size_t)(64 * i) * ldb);
  __syncthreads();
#pragma unroll
  for (int i = 0; i < 4; ++i) *(u32x4*)(smem + (lrow + 64 * i) * 128 + sw) = ra[i];
#pragma unroll
  for (int i = 0; i < 2; ++i) *(u32x4*)(smem + 32768 + (lrow + 64 * i) * 128 + sw) = rb[i];
  __syncthreads();
  for (int kt = 0; kt < nk; ++kt) {
    const char* cur = smem + (kt & 1) * 49152;
    char* nxt = smem + ((kt + 1) & 1) * 49152;
    const bool more = (kt + 1 < nk);
    if (more) {
#pragma unroll
      for (int i = 0; i < 4; ++i) ra[i] = *(const u32x4*)(ga + (size_t)(64 * i) * lda + (kt + 1) * 64);
#pragma unroll
      for (int i = 0; i < 2; ++i) rb[i] = *(const u32x4*)(gb + (size_t)(64 * i) * ldb + (kt + 1) * 64);
    }
#pragma unroll
    for (int kk = 0; kk < 2; ++kk) {
      bf16x8 af[4], bf[4];
      const int co = (((kk * 4 + fq) ^ (fr & 7)) << 4);
#pragma unroll
      for (int m = 0; m < 4; ++m) af[m] = *(const bf16x8*)(cur + (wm * 64 + m * 16 + fr) * 128 + co);
#pragma unroll
      for (int n = 0; n < 4; ++n) bf[n] = *(const bf16x8*)(cur + 32768 + (wn * 64 + n * 16 + fr) * 128 + co);
#pragma unroll
      for (int m = 0; m < 4; ++m)
#pragma unroll
        for (int n = 0; n < 4; ++n) acc[m][n] = mfma16(bf[n], af[m], acc[m][n]);
    }
    if (more) {
#pragma unroll
      for (int i = 0; i < 4; ++i) *(u32x4*)(nxt + (lrow + 64 * i) * 128 + sw) = ra[i];
#pragma unroll
      for (int i = 0; i < 2; ++i) *(u32x4*)(nxt + 32768 + (lrow + 64 * i) * 128 + sw) = rb[i];
    }
    __syncthreads();
  }
}

DI void tile_map(int id, int MT, int NT, int& mt, int& nt) {
  if ((NT & 7) == 0 && (MT & 31) == 0) {
    const int round = id >> 8, local = id & 255, xcd = local & 7, j = local >> 3, mtl = j & 3, ntl = j >> 2;
    const int MR = MT >> 5;
    const int mr = round % MR, nr = round / MR;
    mt = mr * 32 + xcd * 4 + mtl;
    nt = nr * 8 + ntl;
  } else {
    mt = id % MT;
    nt = id / MT;
  }
}


#define LAS __attribute__((address_space(3)))
namespace g8 {
constexpr int BM = 256, BK = 64, HALF = 128, HTB = HALF * BK * 2, NXCD = 8, WGM = 8;
DI int lds_byte(int r, int c) { const int st = (r >> 4) * 2 + (c >> 5), rr = r & 15, cc = c & 31, ob = rr * 64 + cc * 2; return st * 1024 + (ob ^ (((ob >> 9) & 1) << 5)); }
DI void stage_rc(int b, int& R, int& C) { const int st = b / 1024, sb = b % 1024, swz = sb ^ (((sb >> 9) & 1) << 5); R = (st >> 1) * 16 + swz / 64; C = (st & 1) * 32 + (swz % 64) / 2; }
struct Order {
  int nM, nN, nwg, G, c;
  DI void init(int M, int N, int G_, int c_) { nM = M / BM; nN = N / BM; nwg = nM * nN; G = G_; c = c_; }
  DI bool next(int i, int& pm, int& pn) const {
    const long L = (long)i * G + c; if (L >= nwg) return false;
    int wgid = (int)L; { const int q = nwg / NXCD, r = nwg % NXCD, xcd = wgid % NXCD, off = wgid / NXCD; wgid = (xcd < r ? xcd * (q + 1) : r * (q + 1) + (xcd - r) * q) + off; }
    const int nig = WGM * nN, gid = wgid / nig, fm = gid * WGM, gsz = (nM - fm) < WGM ? (nM - fm) : WGM;
    pm = fm + ((wgid % nig) % gsz); pn = (wgid % nig) / gsz; return true;
  }
};
}

template <class Epi>
DI void gemm8(LAS unsigned char* lds, const bfr* A, int lda, const bfr* Bt, int M, int N, int K, int G, int c, const Epi& E, int a_pn_bytes = 0) {
  using namespace g8;
  const int tid = threadIdx.x, wid = __builtin_amdgcn_readfirstlane(tid >> 6), lane = tid & 63, wr = wid >> 2, wc = wid & 3, fr = lane & 15, fq = lane >> 4;
  const int nt = K / BK;
  Order S; S.init(M, N, G, c);
  unsigned voffA[2], voffB[2];
#pragma unroll
  for (int i = 0; i < 2; ++i) { int R, C; stage_rc(tid * 16 + i * 8192, R, C); voffA[i] = (unsigned)(R * lda + C) * 2u; voffB[i] = (unsigned)(R * K + C) * 2u; }
  const size_t kstep = (size_t)(BK * 2);
  const size_t hstepA = (size_t)HALF * lda * 2, hstepB = (size_t)HALF * K * 2;
  const size_t tstepA = 2 * hstepA, tstepB = 2 * hstepB;
  const unsigned ldsw = (unsigned)wid * 1024u;
  const int aoff = lds_byte(wr * 64 + fr, fq * 8), boff = lds_byte(wc * 32 + fr, fq * 8);
#define G8_SA(b, h) (((b) * 2 + (h)) * HTB)
#define G8_SB(b, h) ((4 + (b) * 2 + (h)) * HTB)
#define G8_STAGE(bufoff, gbase, voff) do { _Pragma("unroll") for (int _i = 0; _i < 2; ++_i) \
    __builtin_amdgcn_global_load_lds((const unsigned*)((const char*)(gbase) + (voff)[_i]), (LAS unsigned*)(lds + (bufoff) + ldsw + _i * 8192), 16, 0, 0); } while (0)
#define G8_LDA(dst, b, h) do { _Pragma("unroll") for (int m = 0; m < 4; ++m) _Pragma("unroll") for (int k = 0; k < 2; ++k) dst[m][k] = *(const LAS bf16x8*)(lds + G8_SA(b, h) + aoff + m * 2048 + k * 1024); } while (0)
#define G8_LDB(dst, b, h) do { _Pragma("unroll") for (int n = 0; n < 2; ++n) _Pragma("unroll") for (int k = 0; k < 2; ++k) dst[n][k] = *(const LAS bf16x8*)(lds + G8_SB(b, h) + boff + n * 2048 + k * 1024); } while (0)
#define G8_MMA(ai, bj, At, Btf) do { __builtin_amdgcn_s_setprio(1); _Pragma("unroll") for (int m = 0; m < 4; ++m) _Pragma("unroll") for (int n = 0; n < 2; ++n) _Pragma("unroll") for (int k = 0; k < 2; ++k) \
    acc[ai][bj][m][n] = __builtin_amdgcn_mfma_f32_16x16x32_bf16(Btf[n][k], At[m][k], acc[ai][bj][m][n], 0, 0, 0); __builtin_amdgcn_s_setprio(0); } while (0)
#define G8_WAIT_V(n) asm volatile("s_waitcnt vmcnt(" #n ")" ::: "memory")
#define G8_WAIT_L(n) asm volatile("s_waitcnt lgkmcnt(" #n ")" ::: "memory")
#define G8_BAR __builtin_amdgcn_s_barrier()
#define G8_SCHED __builtin_amdgcn_sched_barrier(0)
  int cpm, cpn, npm = 0, npn = 0, ui = 0;
  if (!S.next(0, cpm, cpn)) return;
  f32x4 acc[2][2][4][2];
#pragma unroll
  for (int a = 0; a < 2; ++a)
#pragma unroll
    for (int b = 0; b < 2; ++b)
#pragma unroll
      for (int m = 0; m < 4; ++m)
#pragma unroll
        for (int n = 0; n < 2; ++n) acc[a][b][m][n] = f32x4{0.f, 0.f, 0.f, 0.f};
  bf16x8 At[4][2], B0[2][2], B1[2][2];
  const char* cA = (const char*)A + (size_t)cpm * tstepA + (size_t)cpn * a_pn_bytes; const char* cB = (const char*)Bt + (size_t)cpn * tstepB;
  G8_STAGE(G8_SB(0, 0), cB, voffB); G8_STAGE(G8_SA(0, 0), cA, voffA); G8_STAGE(G8_SB(0, 1), cB + hstepB, voffB); G8_STAGE(G8_SA(0, 1), cA + hstepA, voffA);
  if (wr == 1) G8_BAR;
  G8_WAIT_V(4); G8_BAR;
  G8_STAGE(G8_SB(1, 0), cB + kstep, voffB); G8_STAGE(G8_SA(1, 0), cA + kstep, voffA); G8_STAGE(G8_SB(1, 1), cB + hstepB + kstep, voffB);
  G8_WAIT_V(6); G8_BAR;
  for (;;) {
    const bool has_next = S.next(ui + 1, npm, npn);
    const char* nA = has_next ? (const char*)A + (size_t)npm * tstepA + (size_t)npn * a_pn_bytes : cA; const char* nB = has_next ? (const char*)Bt + (size_t)npn * tstepB : cB;
    for (int t = 0; t < nt; t += 2) {
      const bool last = (t == nt - 2);
      const char* a1 = cA + (size_t)(t + 1) * kstep;
      const char* a2 = last ? nA : cA + (size_t)(t + 2) * kstep; const char* b2 = last ? nB : cB + (size_t)(t + 2) * kstep;
      const char* a3 = a2 + kstep; const char* b3 = b2 + kstep;
      G8_LDB(B0, 0, 0); G8_SCHED; G8_LDA(At, 0, 0); G8_STAGE(G8_SA(1, 1), a1 + hstepA, voffA);
      G8_WAIT_L(8); G8_BAR; G8_WAIT_L(0); G8_MMA(0, 0, At, B0); G8_BAR; G8_SCHED;
      G8_LDB(B1, 0, 1); G8_STAGE(G8_SB(0, 0), b2, voffB);
      G8_BAR; G8_WAIT_L(0); G8_MMA(0, 1, At, B1); G8_BAR;
      G8_LDA(At, 0, 1); G8_STAGE(G8_SA(0, 0), a2, voffA);
      G8_BAR; G8_WAIT_L(0); G8_MMA(1, 0, At, B0); G8_BAR; G8_SCHED;
      G8_STAGE(G8_SB(0, 1), b2 + hstepB, voffB);
      G8_WAIT_V(6); G8_BAR; G8_MMA(1, 1, At, B1); G8_BAR;
      G8_LDB(B0, 1, 0); G8_SCHED; G8_LDA(At, 1, 0); G8_STAGE(G8_SA(0, 1), a2 + hstepA, voffA);
      G8_WAIT_L(8); G8_BAR; G8_WAIT_L(0); G8_MMA(0, 0, At, B0); G8_BAR; G8_SCHED;
      G8_LDB(B1, 1, 1); G8_STAGE(G8_SB(1, 0), b3, voffB);
      G8_BAR; G8_WAIT_L(0); G8_MMA(0, 1, At, B1); G8_BAR;
      G8_LDA(At, 1, 1); G8_STAGE(G8_SA(1, 0), a3, voffA);
      G8_BAR; G8_WAIT_L(0); G8_MMA(1, 0, At, B0); G8_BAR; G8_SCHED;
      G8_STAGE(G8_SB(1, 1), b3 + hstepB, voffB);
      G8_WAIT_V(6); G8_BAR; G8_MMA(1, 1, At, B1); G8_BAR;
    }
    E(acc, cpm, cpn, wr, wc, fr, fq);
    if (!has_next) break;
#pragma unroll
    for (int a = 0; a < 2; ++a)
#pragma unroll
      for (int b = 0; b < 2; ++b)
#pragma unroll
        for (int m = 0; m < 4; ++m)
#pragma unroll
          for (int n = 0; n < 2; ++n) acc[a][b][m][n] = f32x4{0.f, 0.f, 0.f, 0.f};
    cpm = npm; cpn = npn; cA = nA; cB = nB; ++ui;
  }
  G8_WAIT_V(0);
  if (wr == 0) G8_BAR;
  G8_BAR;
#undef G8_SA
#undef G8_SB
#undef G8_STAGE
#undef G8_LDA
#undef G8_LDB
#undef G8_MMA
#undef G8_WAIT_V
#undef G8_WAIT_L
#undef G8_BAR
#undef G8_SCHED
}
#define G8_FOREACH(acc, pm, pn, wr, wc, fr, fq, ai, bj, m, n, row, col) \
  _Pragma("unroll") for (int ai = 0; ai < 2; ++ai) _Pragma("unroll") for (int m = 0; m < 4; ++m) \
  _Pragma("unroll") for (int bj = 0; bj < 2; ++bj) _Pragma("unroll") for (int n = 0; n < 2; ++n) \
    if (const int row = 256 * (pm) + 128 * ai + 64 * (wr) + 16 * m + (fr); true) if (const int col = 256 * (pn) + 128 * bj + 32 * (wc) + 16 * n + 4 * (fq); true)
typedef f32x4 Acc8[2][2][4][2];

template <bool BANDED, class StoreF>
DI void attn_core(const bfr* __restrict__ Qb, int qstride, int q0, const bfr* __restrict__ Kb, const bfr* __restrict__ Vb,
                  int kvstride, int key0, char* smem, StoreF store, float& m_out, float& l_out) {
  const int tid = threadIdx.x, lane = tid & 63, w = tid >> 6, fr = lane & 15, fq = lane >> 4;
  char* sK = smem;
  char* sV = smem + 65536;
  __syncthreads();
#pragma unroll 1
  for (int rr = 0; rr < 2; ++rr) {
    u32x4 kr[4], vr[4];
#pragma unroll
    for (int i = 0; i < 4; ++i) {
      const int id = tid + (rr * 4 + i) * 512, key = id >> 4, c = id & 15, lk = key0 + key;
      kr[i] = u32x4{0u, 0u, 0u, 0u};
      vr[i] = u32x4{0u, 0u, 0u, 0u};
      if (lk >= 0) {
        kr[i] = *(const u32x4*)(Kb + (long)lk * kvstride + c * 8);
        vr[i] = *(const u32x4*)(Vb + (long)lk * kvstride + c * 8);
      }
    }
#pragma unroll
    for (int i = 0; i < 4; ++i) {
      const int id = tid + (rr * 4 + i) * 512, key = id >> 4, c = id & 15;
      *(u32x4*)(sK + key * 256 + ((c ^ (key & 15)) << 4)) = kr[i];
      *(u32x4*)(sV + key * 288 + c * 16) = vr[i];
    }
  }
  bf16x8 qf[4];
  {
    const bfr* qrow = Qb + (long)(q0 + w * 16 + fr) * qstride;
#pragma unroll
    for (int kk = 0; kk < 4; ++kk) qf[kk] = *(const bf16x8*)(qrow + kk * 32 + fq * 8);
  }
  __syncthreads();
  constexpr int NT = BANDED ? 10 : 16;
  const int t0 = BANDED ? (w & ~1) : 0;
  f32x4 s[NT];
#pragma unroll
  for (int j = 0; j < NT; ++j) {
    f32x4 a = f32x4{0.f, 0.f, 0.f, 0.f};
    const int key = (t0 + j) * 16 + fr;
#pragma unroll
    for (int kk = 0; kk < 4; ++kk) {
      const bf16x8 kf = *(const bf16x8*)(sK + key * 256 + (((kk * 4 + fq) ^ fr) << 4));
      a = mfma16(kf, qf[kk], a);
    }
    s[j] = a;
  }
  const float L2E = 1.4426950408889634f;
  const float NINF = -__builtin_inff();
  float mx = NINF;
  const int lq = q0 + w * 16 + fr;
#pragma unroll
  for (int j = 0; j < NT; ++j)
#pragma unroll
    for (int i = 0; i < 4; ++i) {
      float v = s[j][i] * L2E;
      if (BANDED) {
        const int lk = key0 + (t0 + j) * 16 + fq * 4 + i;
        const int dist = lq - lk;
        const bool ok = (lk >= 0) && (dist >= 0) && (dist <= 128);
        v = ok ? v : NINF;
      }
      s[j][i] = v;
      mx = fmaxf(mx, v);
    }
  mx = fmaxf(mx, __shfl_xor(mx, 16));
  mx = fmaxf(mx, __shfl_xor(mx, 32));
  float l = 0.f;
#pragma unroll
  for (int j = 0; j < NT; ++j)
#pragma unroll
    for (int i = 0; i < 4; ++i) {
      const float p = __builtin_amdgcn_exp2f(s[j][i] - mx);
      s[j][i] = p;
      l += p;
    }
  l += __shfl_xor(l, 16);
  l += __shfl_xor(l, 32);
  bf16x8 pf[NT / 2];
#pragma unroll
  for (int c = 0; c < NT / 2; ++c) {
    u32x4 t;
    t[0] = pack2(s[2 * c][0], s[2 * c][1]);
    t[1] = pack2(s[2 * c][2], s[2 * c][3]);
    t[2] = pack2(s[2 * c + 1][0], s[2 * c + 1][1]);
    t[3] = pack2(s[2 * c + 1][2], s[2 * c + 1][3]);
    pf[c] = __builtin_bit_cast(bf16x8, t);
  }
  const int q4 = (lane & 15) >> 2, p4 = lane & 3;
  m_out = mx;
  l_out = l;
#pragma unroll 2
  for (int dt = 0; dt < 8; ++dt) {
    f32x4 a = f32x4{0.f, 0.f, 0.f, 0.f};
#pragma unroll
    for (int c = 0; c < NT / 2; ++c) {
      const int kb = (t0 + 2 * c) * 16;
      const s16x4 lo = tr_read(sV + (kb + fq * 4 + q4) * 288 + (dt * 16 + p4 * 4) * 2);
      const s16x4 hi = tr_read(sV + (kb + 16 + fq * 4 + q4) * 288 + (dt * 16 + p4 * 4) * 2);
      const bf16x8 vf = __builtin_shufflevector(lo, hi, 0, 1, 2, 3, 4, 5, 6, 7);
      a = mfma16(vf, pf[c], a);
    }
    store(dt, a, l);
  }
}

DI int f2sort(float f) { int b = __float_as_int(f); return b ^ ((b >> 31) & 0x7fffffff); }
DI float sort2f(int s) { int b = s ^ ((s >> 31) & 0x7fffffff); return __int_as_float(b); }
DI void topk_insert(int (&lst)[16], int key) {
#pragma unroll
  for (int j = 0; j < 16; ++j) {
    const int hi = max(lst[j], key);
    key = min(lst[j], key);
    lst[j] = hi;
  }
}

template <int O, int N>
DI void bfly(float (&p)[64], int lane) {
  const bool up = (lane & O) != 0;
#pragma unroll
  for (int i = 0; i < N / 2; ++i) {
    const float keep = up ? p[i + N / 2] : p[i];
    const float send = up ? p[i] : p[i + N / 2];
    p[i] = keep + __shfl_xor(send, O);
  }
  if constexpr (O > 1) bfly<O / 2, N / 2>(p, lane);
}

DI void rms_row_to_bf16(const float* __restrict__ x, const float* __restrict__ g, bfr* __restrict__ out, int lane) {
  float4 v[8];
  float ss = 0.f;
#pragma unroll
  for (int j = 0; j < 8; ++j) {
    v[j] = *(const float4*)(x + j * 256 + lane * 4);
    ss += v[j].x * v[j].x + v[j].y * v[j].y + v[j].z * v[j].z + v[j].w * v[j].w;
  }
  ss = wave_sum(ss);
  const float rs = rsqrtf(ss * (1.f / 2048.f) + 1e-6f);
#pragma unroll
  for (int j = 0; j < 8; ++j) {
    const float4 gg = *(const float4*)(g + j * 256 + lane * 4);
    u32x2 o;
    o[0] = pack2(v[j].x * rs * gg.x, v[j].y * rs * gg.y);
    o[1] = pack2(v[j].z * rs * gg.z, v[j].w * rs * gg.w);
    *(u32x2*)(out + j * 256 + lane * 4) = o;
  }
}

DI void transpose_tile(const float* __restrict__ W, int K, int N, int k0, int n0, bfr* __restrict__ Wt, float* tile, const float* colscale) {
  __syncthreads();
  {
    const int r = threadIdx.x >> 4, c4 = threadIdx.x & 15;
#pragma unroll
    for (int i = 0; i < 2; ++i) {
      const int k = r + 32 * i;
      const float4 v = *(const float4*)(W + (size_t)(k0 + k) * N + n0 + c4 * 4);
      tile[k * 65 + c4 * 4 + 0] = v.x;
      tile[k * 65 + c4 * 4 + 1] = v.y;
      tile[k * 65 + c4 * 4 + 2] = v.z;
      tile[k * 65 + c4 * 4 + 3] = v.w;
    }
  }
  __syncthreads();
  {
    const int n = threadIdx.x >> 3, kc = threadIdx.x & 7;
    u32x4 o;
    const float csv = colscale ? colscale[n0 + n] : 1.0f;
#pragma unroll
    for (int j = 0; j < 4; ++j) o[j] = pack2(tile[(kc * 8 + 2 * j) * 65 + n] * csv, tile[(kc * 8 + 2 * j + 1) * 65 + n] * csv);
    *(u32x4*)(Wt + (size_t)(n0 + n) * K + k0 + kc * 8) = o;
  }
}

DI void convert_f32_bf16(const float* __restrict__ src, bfr* __restrict__ dst, long n8) {
  for (long i = (long)blockIdx.x * NTHREADS + threadIdx.x; i < n8; i += (long)gridDim.x * NTHREADS) {
    const float4 a = *(const float4*)(src + i * 8);
    const float4 b = *(const float4*)(src + i * 8 + 4);
    u32x4 o;
    o[0] = pack2(a.x, a.y); o[1] = pack2(a.z, a.w); o[2] = pack2(b.x, b.y); o[3] = pack2(b.z, b.w);
    *(u32x4*)(dst + i * 8) = o;
  }
}

DI void phase_prep(const Params& p, char* smem) {
  const int lane = threadIdx.x & 63, wid = threadIdx.x >> 6;
  for (int r = blockIdx.x * 8 + wid; r < T_TOK + 1024; r += gridDim.x * 8) {
    if (r < T_TOK) rms_row_to_bf16(p.x + (size_t)r * 2048, p.g_mix, p.hbuf + (size_t)r * 2048, lane);
    else rms_row_to_bf16(p.mem + (size_t)(r - T_TOK) * 2048, p.g_mem, p.memn + (size_t)(r - T_TOK) * 2048, lane);
  }
  float* tile = (float*)smem;
  for (int id0 = blockIdx.x; id0 < 5184; id0 += gridDim.x) {
    int id = id0;
    const float* W; bfr* Wt; int K, N; const float* cs = nullptr;
    if (id < 2048) { W = p.w_in; Wt = p.wInT; K = 2048; N = 4096; }
    else if ((id -= 2048) < 1024) { W = p.w_out; Wt = p.wOutT; K = 2048; N = 2048; }
    else if ((id -= 1024) < 1024) { W = p.w_pq; Wt = p.wPqT; K = 2048; N = 2048; }
    else if ((id -= 1024) < 256) { W = p.w_cq; Wt = p.wCqT; K = 2048; N = 512; }
    else if ((id -= 256) < 256) { W = p.w_ck; Wt = p.wCkT; K = 2048; N = 512; }
    else if ((id -= 256) < 256) { W = p.w_cv; Wt = p.wCvT; K = 2048; N = 512; }
    else if ((id -= 256) < 256) { W = p.w_co; Wt = p.wCoT; K = 512; N = 2048; }
    else { id -= 256; const int g = id >> 4; id &= 15; W = p.w_pool + g * 65536; Wt = p.wPoolT + g * 65536; K = 256; N = 256; cs = p.pool_scale + g * 256; }
    const int ntn = N >> 6;
    const int kt = id / ntn, nt = id % ntn;
    transpose_tile(W, K, N, kt * 64, nt * 64, Wt, tile, cs);
  }
  convert_f32_bf16(p.sk1f, p.sk1, 128 * 128 / 8);
  convert_f32_bf16(p.sk2f, p.sk2, 128 * 128 / 8);
  for (int r = blockIdx.x * 8 + wid; r < 2 * 16384; r += gridDim.x * 8) {
    const bool isv = r >= 16384;
    const int rr = isv ? r - 16384 : r;
    const float* src = (isv ? p.w_v : p.w_u) + (size_t)rr * 2048;
    unsigned char* dst = (isv ? p.wV8 : p.wU8) + (size_t)rr * 1536;
    float4 v[8];
    float amax = 0.f;
#pragma unroll
    for (int j = 0; j < 2; ++j)
#pragma unroll
      for (int q = 0; q < 4; ++q) {
        v[j * 4 + q] = *(const float4*)(src + j * 1024 + lane * 16 + q * 4);
        const float4 t = v[j * 4 + q];
        amax = fmaxf(amax, fmaxf(fmaxf(fabsf(t.x), fabsf(t.y)), fmaxf(fabsf(t.z), fabsf(t.w))));
      }
#pragma unroll
    for (int o = 32; o >= 1; o >>= 1) amax = fmaxf(amax, __shfl_xor(amax, o));
    const float inv = amax > 0.f ? 7.5f / amax : 0.f;
    if (lane == 0) (isv ? p.sv : p.su)[rr] = amax * (1.f / 7.5f);
    v16f qa, qb;
#pragma unroll
    for (int q = 0; q < 4; ++q) {
      qa[q * 4 + 0] = v[q].x * inv; qa[q * 4 + 1] = v[q].y * inv; qa[q * 4 + 2] = v[q].z * inv; qa[q * 4 + 3] = v[q].w * inv;
      qb[q * 4 + 0] = v[4 + q].x * inv; qb[q * 4 + 1] = v[4 + q].y * inv; qb[q * 4 + 2] = v[4 + q].z * inv; qb[q * 4 + 3] = v[4 + q].w * inv;
    }
    const v6u pk = __builtin_amdgcn_cvt_scalef32_2xpk16_fp6_f32(qa, qb, 1.0f);
    *(u32x4*)(dst + lane * 16) = u32x4{pk[0], pk[1], pk[2], pk[3]};
    *(u32x2*)(dst + 1024 + lane * 8) = u32x2{pk[4], pk[5]};
  }
}

DI void phase_inproj(const Params& p, char* smem) {
  auto epi = [&](const Acc8& acc0, int pm, int pn, int wr, int wc, int fr, int fq) {
    const int region = pn >> 2;
    if (region == 0) {
      G8_FOREACH(acc0, pm, pn, wr, wc, fr, fq, ai, bj, m, n, row, col) {
        const f32x4 v = acc0[ai][bj][m][n];
        u32x2 o; o[0] = pack2(v[0], v[1]); o[1] = pack2(v[2], v[3]);
        *(u32x2*)(p.pbuf + (size_t)row * 1024 + col) = o;
      }
    } else {
      bfr* dst = (region == 1) ? p.qbuf : (region == 2 ? p.kbuf : p.vbuf);
      const float scale = (region == 1) ? 0.08838834764831845f : 1.0f;
      const bool rope = (region != 3) && (wc == 0);
#pragma unroll
      for (int ai = 0; ai < 2; ++ai)
#pragma unroll
        for (int m = 0; m < 4; ++m) {
          const int row = 256 * pm + 128 * ai + 64 * wr + 16 * m + fr;
          const int b = row >> 12, t = row & 4095;
          float sn[4], cs[4];
          if (rope) {
            const float posf = (float)p.pos[row];
#pragma unroll
            for (int i = 0; i < 4; ++i) {
              const int j = fq * 4 + i;
              const float inv = exp2f(-(float)j * (18.931568569324174f / 16.0f));
              sincosf(posf * inv, &sn[i], &cs[i]);
            }
          }
#pragma unroll
          for (int bj = 0; bj < 2; ++bj) {
            const int h = (pn & 3) * 2 + bj;
            f32x4 v0 = acc0[ai][bj][m][0], v1 = acc0[ai][bj][m][1];
            if (rope) {
#pragma unroll
              for (int i = 0; i < 4; ++i) {
                const float x1 = v0[i], x2 = v1[i];
                v0[i] = x1 * cs[i] - x2 * sn[i];
                v1[i] = x2 * cs[i] + x1 * sn[i];
              }
            }
            bfr* drow = dst + ((size_t)((b * 8 + h) * 4096 + t)) * 128 + 32 * wc + 4 * fq;
            u32x2 o0, o1;
            o0[0] = pack2(v0[0] * scale, v0[1] * scale); o0[1] = pack2(v0[2] * scale, v0[3] * scale);
            o1[0] = pack2(v1[0] * scale, v1[1] * scale); o1[1] = pack2(v1[2] * scale, v1[3] * scale);
            *(u32x2*)(drow) = o0;
            *(u32x2*)(drow + 16) = o1;
          }
        }
    }
  };
  gemm8((LAS unsigned char*)smem, p.hbuf, 2048, p.wInT, T_TOK, 4096, 2048, gridDim.x, blockIdx.x, epi);
}

DI void phase_mix_attn(const Params& p, char* smem) {
  const int tid = threadIdx.x, lane = tid & 63, w = tid >> 6, fr = lane & 15, fq = lane >> 4;
  for (int id = blockIdx.x; id < 3072 + 256; id += gridDim.x) {
    if (id < 3072) {
      const int br = id >> 10, rem = id & 1023;
      const int dl = (br == 0) ? 1 : (br == 1 ? 4 : 16);
      const int nblk = 32 / dl;
      const int bh = rem >> 5, rn = rem & 31;
      const int r = rn / nblk, nb = rn % nblk;
      const int l0 = nb * 128;
      const size_t base = (size_t)bh * 4096 * 128 + (size_t)r * 128;
      float mx, l;
      const int b = bh >> 3, h = bh & 7;
      const int tt = b * 4096 + (l0 + w * 16 + fr) * dl + r;
      bfr* dst = p.ob + (size_t)br * T_TOK * 1024 + (size_t)tt * 1024 + h * 128 + fq * 4;
      attn_core<true>(p.qbuf + base, dl * 128, l0, p.kbuf + base, p.vbuf + base, dl * 128, l0 - 128, smem,
                      [&](int dt, f32x4 a, float lsum) {
                        const float il = 1.f / lsum;
                        u32x2 v; v[0] = pack2(a[0] * il, a[1] * il); v[1] = pack2(a[2] * il, a[3] * il);
                        *(u32x2*)(dst + dt * 16) = v;
                      }, mx, l);
      if (fq == 0) p.lse[(size_t)br * T_TOK * 8 + (size_t)tt * 8 + h] = mx + __builtin_amdgcn_logf(l);
    } else {
      const int ci = id - 3072;
      const int sub = tid >> 7, cgp = tid & 127;
      const int wdw = 2 << (cgp >> 5);
      const int t0 = ci * 64 + sub * 16, tin0 = t0 & 4095;
      const bfr* pb = p.pbuf + cgp * 8;
      float sum[8];
#pragma unroll
      for (int e = 0; e < 8; ++e) sum[e] = 0.f;
      for (int j = 1; j < wdw; ++j) {
        if (tin0 - j >= 0) {
          const u32x4 v = *(const u32x4*)(pb + (size_t)(t0 - j) * 1024);
#pragma unroll
          for (int e = 0; e < 4; ++e) { sum[2 * e] += bflo(v[e]); sum[2 * e + 1] += bfhi(v[e]); }
        }
      }
      for (int s = 0; s < 16; ++s) {
        const int t = t0 + s, tin = tin0 + s;
        const u32x4 v = *(const u32x4*)(pb + (size_t)t * 1024);
        float cur[8];
#pragma unroll
        for (int e = 0; e < 4; ++e) { cur[2 * e] = bflo(v[e]); cur[2 * e + 1] = bfhi(v[e]); }
        const float ic = 1.f / (float)min(tin + 1, wdw);
        u32x4 ov;
#pragma unroll
        for (int e = 0; e < 8; ++e) sum[e] += cur[e];
#pragma unroll
        for (int e = 0; e < 4; ++e) ov[e] = pack2(sum[2 * e] * ic - cur[2 * e], sum[2 * e + 1] * ic - cur[2 * e + 1]);
        *(u32x4*)(p.mixed + (size_t)t * 1024 + cgp * 8) = ov;
        if (tin - wdw + 1 >= 0) {
          const u32x4 u = *(const u32x4*)(pb + (size_t)(t - wdw + 1) * 1024);
#pragma unroll
          for (int e = 0; e < 4; ++e) { sum[2 * e] -= bflo(u[e]); sum[2 * e + 1] -= bfhi(u[e]); }
        }
      }
    }
  }
}

DI void phase_pool_combine(const Params& p, char* smem) {
  const int tid = threadIdx.x;
  {
    auto epi = [&](const Acc8& acc0, int pm, int pn, int wr, int wc, int fr, int fq) {
      G8_FOREACH(acc0, pm, pn, wr, wc, fr, fq, ai, bj, m, n, row, col) {
        const f32x4 v = acc0[ai][bj][m][n];
        u32x2 o; o[0] = pack2(v[0], v[1]); o[1] = pack2(v[2], v[3]);
        *(u32x2*)(p.hbuf + (size_t)row * 2048 + col) = o;
      }
    };
    gemm8((LAS unsigned char*)smem, p.mixed, 1024, p.wPoolT, T_TOK, 1024, 256, gridDim.x, blockIdx.x, epi, 512);
  }
  for (long i = (long)blockIdx.x * NTHREADS + tid; i < (long)T_TOK * 8 * 16; i += (long)gridDim.x * NTHREADS) {
    const int dc = (int)(i & 15), h = (int)((i >> 4) & 7);
    const long tt = i >> 7;
    const float l0 = p.lse[tt * 8 + h], l1 = p.lse[(size_t)T_TOK * 8 + tt * 8 + h], l2 = p.lse[(size_t)2 * T_TOK * 8 + tt * 8 + h];
    const float mx = fmaxf(l0, fmaxf(l1, l2));
    float w0 = __builtin_amdgcn_exp2f(l0 - mx), w1 = __builtin_amdgcn_exp2f(l1 - mx), w2 = __builtin_amdgcn_exp2f(l2 - mx);
    const float inv = 1.f / (w0 + w1 + w2);
    w0 *= inv; w1 *= inv; w2 *= inv;
    if (ABL == 3) { w0 = 0.f; w1 = 0.f; w2 = 0.f; }
    const size_t off = (size_t)tt * 1024 + h * 128 + dc * 8;
    const u32x4 a = *(const u32x4*)(p.ob + off);
    const u32x4 b = *(const u32x4*)(p.ob + (size_t)T_TOK * 1024 + off);
    const u32x4 c = *(const u32x4*)(p.ob + (size_t)2 * T_TOK * 1024 + off);
    u32x4 o;
#pragma unroll
    for (int e = 0; e < 4; ++e)
      o[e] = pack2(w0 * bflo(a[e]) + w1 * bflo(b[e]) + w2 * bflo(c[e]), w0 * bfhi(a[e]) + w1 * bfhi(b[e]) + w2 * bfhi(c[e]));
    *(u32x4*)(p.hbuf + (size_t)tt * 2048 + 1024 + h * 128 + dc * 8) = o;
  }
}

DI void phase_gemm_resid(const bfr* A, int lda, const bfr* Bt, int K, const float* resid, float* xout, char* smem) {
  auto epi = [&](const Acc8& acc0, int pm, int pn, int wr, int wc, int fr, int fq) {
    G8_FOREACH(acc0, pm, pn, wr, wc, fr, fq, ai, bj, m, n, row, col) {
      const f32x4 v = acc0[ai][bj][m][n];
      const float4 r = *(const float4*)(resid + (size_t)row * 2048 + col);
      float4 o; o.x = r.x + v[0]; o.y = r.y + v[1]; o.z = r.z + v[2]; o.w = r.w + v[3];
      *(float4*)(xout + (size_t)row * 2048 + col) = o;
    }
  };
  gemm8((LAS unsigned char*)smem, A, lda, Bt, T_TOK, 2048, K, gridDim.x, blockIdx.x, epi);
}

DI void phase_rms(const float* xin, const float* g, bfr* out) {
  const int lane = threadIdx.x & 63, wid = threadIdx.x >> 6;
  for (int r = blockIdx.x * 8 + wid; r < T_TOK; r += gridDim.x * 8)
    rms_row_to_bf16(xin + (size_t)r * 2048, g, out + (size_t)r * 2048, lane);
}

DI void phase_gemm_pq(const Params& p, char* smem) {
  auto epi = [&](const Acc8& acc0, int pm, int pn, int wr, int wc, int fr, int fq) {
    G8_FOREACH(acc0, pm, pn, wr, wc, fr, fq, ai, bj, m, n, row, col) {
      const f32x4 v = acc0[ai][bj][m][n];
      u32x2 o; o[0] = pack2(v[0], v[1]); o[1] = pack2(v[2], v[3]);
      *(u32x2*)(p.pq + (size_t)row * 2048 + col) = o;
    }
  };
  gemm8((LAS unsigned char*)smem, p.hbuf, 2048, p.wPqT, T_TOK, 2048, 2048, gridDim.x, blockIdx.x, epi);
}
DI void phase_cross_proj(const Params& p, char* smem) {
  const int half = gridDim.x >> 1;
  if ((int)blockIdx.x < half) {
    auto epi = [&](const Acc8& acc0, int pm, int pn, int wr, int wc, int fr, int fq) {
      const float scale = 0.08838834764831845f;
      G8_FOREACH(acc0, pm, pn, wr, wc, fr, fq, ai, bj, m, n, row, col) {
        const f32x4 v = acc0[ai][bj][m][n];
        u32x2 o; o[0] = pack2(v[0] * scale, v[1] * scale); o[1] = pack2(v[2] * scale, v[3] * scale);
        *(u32x2*)(p.qc + (size_t)row * 512 + col) = o;
      }
    };
    gemm8((LAS unsigned char*)smem, p.hbuf, 2048, p.wCqT, T_TOK, 512, 2048, half, blockIdx.x, epi);
  } else if ((int)blockIdx.x < half + 16) {
    auto epi = [&](const Acc8& acc0, int pm, int pn, int wr, int wc, int fr, int fq) {
      G8_FOREACH(acc0, pm, pn, wr, wc, fr, fq, ai, bj, m, n, row, col) {
        const f32x4 v = acc0[ai][bj][m][n];
        bfr* dst = (col < 512) ? p.kc : p.vc;
        const int cc = col & 511, hh = cc >> 7, d = cc & 127, bb = row >> 8, mm = row & 255;
        u32x2 o; o[0] = pack2(v[0], v[1]); o[1] = pack2(v[2], v[3]);
        *(u32x2*)(dst + ((size_t)((bb * 4 + hh) * 256 + mm)) * 128 + d) = o;
      }
    };
    gemm8((LAS unsigned char*)smem, p.memn, 2048, p.wCkT, 1024, 1024, 2048, 16, blockIdx.x - half, epi);
  }
}

DI void phase_cross_attn(const Params& p, char* smem) {
  const int tid = threadIdx.x, lane = tid & 63, w = tid >> 6, fr = lane & 15, fq = lane >> 4;
  for (int id = blockIdx.x; id < 512; id += gridDim.x) {
    const int b = id >> 7, h = (id >> 5) & 3, qt = id & 31;
    float mx, l;
    const size_t kvb = (size_t)(b * 4 + h) * 256 * 128;
    bfr* dst = p.oc + (size_t)(b * 4096 + qt * 128 + w * 16 + fr) * 512 + h * 128 + fq * 4;
    attn_core<false>(p.qc + (size_t)b * 4096 * 512 + h * 128, 512, qt * 128, p.kc + kvb, p.vc + kvb, 128, 0, smem,
                     [&](int dt, f32x4 a, float lsum) {
                       const float il = 1.f / lsum;
                       u32x2 v; v[0] = pack2(a[0] * il, a[1] * il); v[1] = pack2(a[2] * il, a[3] * il);
                       *(u32x2*)(dst + dt * 16) = v;
                     }, mx, l);
  }
}

DI void phase_peer_route(const Params& p, char* smem) {
  const int tid = threadIdx.x, lane = tid & 63, w = tid >> 6, fr = lane & 15, fq = lane >> 4;
  float* scores = (float*)smem;
  int* lists = (int*)(smem + 135168);
  for (int id = blockIdx.x; id < 1024; id += gridDim.x) {
    const int tt = id >> 3, h = id & 7;
    const int tok0 = tt * 128;
    __syncthreads();
#pragma unroll
    for (int hf = 0; hf < 2; ++hf) {
      const bfr* arow = p.pq + (size_t)(tok0 + w * 16 + fr) * 2048 + h * 256 + hf * 128;
      bf16x8 af[4];
#pragma unroll
      for (int kk = 0; kk < 4; ++kk) af[kk] = *(const bf16x8*)(arow + kk * 32 + fq * 8);
      const bfr* sk = hf ? p.sk2 : p.sk1;
#pragma unroll
      for (int nt = 0; nt < 8; ++nt) {
        f32x4 a = f32x4{0.f, 0.f, 0.f, 0.f};
#pragma unroll
        for (int kk = 0; kk < 4; ++kk) {
          const bf16x8 bfg = *(const bf16x8*)(sk + (nt * 16 + fr) * 128 + kk * 32 + fq * 8);
          a = mfma16(af[kk], bfg, a);
        }
#pragma unroll
        for (int i = 0; i < 4; ++i) scores[(hf * 128 + w * 16 + fq * 4 + i) * 132 + nt * 16 + fr] = a[i];
      }
    }
    __syncthreads();
    if (tid < 256) {
      int lst[16];
#pragma unroll
      for (int j = 0; j < 16; ++j) lst[j] = (int)0x80000000;
      const float* srow = scores + tid * 132;
      for (int k4 = 0; k4 < 32; ++k4) {
        const float4 v = *(const float4*)(srow + k4 * 4);
        topk_insert(lst, (f2sort(v.x) & ~0x7F) | (k4 * 4 + 0));
        topk_insert(lst, (f2sort(v.y) & ~0x7F) | (k4 * 4 + 1));
        topk_insert(lst, (f2sort(v.z) & ~0x7F) | (k4 * 4 + 2));
        topk_insert(lst, (f2sort(v.w) & ~0x7F) | (k4 * 4 + 3));
      }
#pragma unroll
      for (int j = 0; j < 16; ++j) lists[tid * 16 + j] = lst[j];
    }
    __syncthreads();
    if (tid < 128) {
      float v1[16], v2[16];
#pragma unroll
      for (int j = 0; j < 16; ++j) {
        v1[j] = sort2f(lists[tid * 16 + j] & ~0x7F);
        v2[j] = sort2f(lists[(128 + tid) * 16 + j] & ~0x7F);
      }
      int top[16];
#pragma unroll
      for (int j = 0; j < 16; ++j) top[j] = (int)0x80000000;
#pragma unroll
      for (int a = 0; a < 16; ++a)
#pragma unroll
        for (int b = 0; b < 16; ++b)
          if ((a + 1) * (b + 1) <= 16) topk_insert(top, (f2sort(v1[a] + v2[b]) & ~0xFF) | (a * 16 + b));
      int ex[16];
      float sum = 0.f;
#pragma unroll
      for (int j = 0; j < 16; ++j) {
        const int code = top[j] & 0xFF;
        const int i1 = lists[tid * 16 + (code >> 4)] & 0x7F;
        const int i2 = lists[(128 + tid) * 16 + (code & 15)] & 0x7F;
        ex[j] = i1 * 128 + i2;
      }
      const float mxv = sort2f(top[0] & ~0xFF);
      float ev[16];
#pragma unroll
      for (int j = 0; j < 16; ++j) { ev[j] = __expf(sort2f(top[j] & ~0xFF) - mxv); sum += ev[j]; }
      const float inv = 1.f / sum;
      const size_t ob = (size_t)(tok0 + tid) * 128 + h * 16;
#pragma unroll
      for (int j4 = 0; j4 < 4; ++j4) {
        int4 iv; iv.x = ex[j4 * 4]; iv.y = ex[j4 * 4 + 1]; iv.z = ex[j4 * 4 + 2]; iv.w = ex[j4 * 4 + 3];
        float4 gv; gv.x = ev[j4 * 4] * inv; gv.y = ev[j4 * 4 + 1] * inv; gv.z = ev[j4 * 4 + 2] * inv; gv.w = ev[j4 * 4 + 3] * inv;
        *(int4*)(p.idx + ob + j4 * 4) = iv;
        *(float4*)(p.gates + ob + j4 * 4) = gv;
      }
    }
  }
}

DI float gelu_tanh(float a) {
  const float u = 0.7978845608028654f * (a + 0.044715f * a * a * a);
  return 0.5f * a * (1.f + tanhf(u));
}

#define SB() __builtin_amdgcn_sched_barrier(0)
DI void peer_load8(u32x4 (&bufa)[8], u32x4 (&bufb)[8], const unsigned char* tbl, int idxv, int g, int lane) {
#pragma unroll
  for (int k = 0; k < 8; ++k) {
    const int e = __builtin_amdgcn_readlane(idxv, g * 8 + k);
    const unsigned char* row = tbl + (size_t)e * 1536;
    bufa[k] = *(const u32x4*)(row + lane * 16);
    { const u32x2 t2 = *(const u32x2*)(row + 1024 + lane * 8); bufb[k] = u32x4{t2[0], t2[1], 0u, 0u}; }
  }
}
DI v32f peer_unpack(const u32x4 a, const u32x4 b) {
  const v6u q = v6u{a[0], a[1], a[2], a[3], b[0], b[1]};
  return __builtin_amdgcn_cvt_scalef32_pk32_f32_fp6(q, 1.0f);
}
DI float peer_dot8(const u32x4 (&bufa)[8], const u32x4 (&bufb)[8], const f32x2 (&hs)[16], int lane) {
  float part[8];
#pragma unroll
  for (int k = 0; k < 8; ++k) {
    const v32f r = peer_unpack(bufa[k], bufb[k]);
    f32x2 a2 = f32x2{0.f, 0.f};
#pragma unroll
    for (int i = 0; i < 16; ++i) a2 += f32x2{r[2 * i], r[2 * i + 1]} * hs[i];
    part[k] = a2[0] + a2[1];
  }
  const bool up4 = (lane & 4) != 0, up2 = (lane & 2) != 0, up1 = (lane & 1) != 0;
  float q[4];
#pragma unroll
  for (int i = 0; i < 4; ++i) {
    const float keep = up4 ? part[i + 4] : part[i];
    const float send = up4 ? part[i] : part[i + 4];
    q[i] = keep + __shfl_xor(send, 4);
  }
  float r[2];
#pragma unroll
  for (int i = 0; i < 2; ++i) {
    const float keep = up2 ? q[i + 2] : q[i];
    const float send = up2 ? q[i] : q[i + 2];
    r[i] = keep + __shfl_xor(send, 2);
  }
  float v = (up1 ? r[1] : r[0]) + __shfl_xor(up1 ? r[0] : r[1], 1);
  v += __shfl_xor(v, 8);
  v += __shfl_xor(v, 16);
  v += __shfl_xor(v, 32);
  return v;
}
DI void peer_acc8(const u32x4 (&bufa)[8], const u32x4 (&bufb)[8], f32x2 (&ys)[16], float cval, int g) {
#pragma unroll
  for (int k = 0; k < 8; ++k) {
    const float ck = __builtin_bit_cast(float, __builtin_amdgcn_readlane(__builtin_bit_cast(int, cval), g * 8 + k));
    const v32f r = peer_unpack(bufa[k], bufb[k]);
#pragma unroll
    for (int i = 0; i < 16; ++i) ys[i] += f32x2{r[2 * i], r[2 * i + 1]} * ck;
  }
}
DI float fp6_tag(int k) { return k < 8 ? 0.125f * k : (k < 16 ? 1.f + 0.125f * (k - 8) : (k < 24 ? 2.f + 0.25f * (k - 16) : 4.f + 0.5f * (k - 24))); }

DI void phase_peer_expert(const Params& p) {
  const int lane = threadIdx.x & 63, wid = threadIdx.x >> 6;
  bool flagI;
  {
    v16f ta, tb;
#pragma unroll
    for (int i = 0; i < 16; ++i) { ta[i] = fp6_tag(i); tb[i] = fp6_tag(16 + i); }
    asm volatile("" : "+v"(ta), "+v"(tb));
    const v6u pk = __builtin_amdgcn_cvt_scalef32_2xpk16_fp6_f32(ta, tb, 1.0f);
    const v32f r = __builtin_amdgcn_cvt_scalef32_pk32_f32_fp6(pk, 1.0f);
    flagI = (r[1] == 2.0f);
  }
  for (int tok = blockIdx.x * 8 + wid; tok < T_TOK; tok += gridDim.x * 8) {
    int myidx[2];
    float mygate[2];
#pragma unroll
    for (int half = 0; half < 2; ++half) {
      myidx[half] = p.idx[(size_t)tok * 128 + half * 64 + lane];
      mygate[half] = p.gates[(size_t)tok * 128 + half * 64 + lane];
    }
    u32x4 bufAa[8], bufBa[8];
    u32x4 bufAb[8], bufBb[8];
    peer_load8(bufAa, bufAb, p.wU8, myidx[0], 0, lane);
    f32x2 hs[16];
    {
      float he[32];
#pragma unroll
      for (int j = 0; j < 2; ++j)
#pragma unroll
        for (int q = 0; q < 2; ++q) {
          const u32x4 t = *(const u32x4*)(p.hbuf + (size_t)tok * 2048 + j * 1024 + lane * 16 + q * 8);
#pragma unroll
          for (int c = 0; c < 4; ++c) { const unsigned tt = t[c]; he[j * 16 + q * 8 + c * 2] = bflo(tt); he[j * 16 + q * 8 + c * 2 + 1] = bfhi(tt); }
        }
#pragma unroll
      for (int i = 0; i < 16; ++i) {
        const float n0 = he[2 * i], n1 = he[2 * i + 1];
        const float i0 = he[i], i1 = he[16 + i];
        hs[i] = f32x2{flagI ? i0 : n0, flagI ? i1 : n1};
      }
    }
    f32x2 ys[16];
#pragma unroll
    for (int e = 0; e < 16; ++e) ys[e] = f32x2{0.f, 0.f};
#pragma unroll 1
    for (int half = 0; half < 2; ++half) {
      const int idxv = half ? myidx[1] : myidx[0];
      const float gate = half ? mygate[1] : mygate[0];
      const float mysu = p.su[idxv], mysv = p.sv[idxv];
      float amine = 0.f;
#pragma unroll 1
      for (int g2 = 0; g2 < 4; ++g2) {
        peer_load8(bufBa, bufBb, p.wU8, idxv, 2 * g2 + 1, lane);
        SB();
        { const float v = peer_dot8(bufAa, bufAb, hs, lane); if ((lane >> 3) == 2 * g2) amine = v; }
        SB();
        peer_load8(bufAa, bufAb, g2 < 3 ? p.wU8 : p.wV8, idxv, g2 < 3 ? 2 * g2 + 2 : 0, lane);
        SB();
        { const float v = peer_dot8(bufBa, bufBb, hs, lane); if ((lane >> 3) == 2 * g2 + 1) amine = v; }
        SB();
      }
      const float cval = gate * gelu_tanh(amine * mysu) * mysv;
      const int nidx = myidx[1];
#pragma unroll 1
      for (int g2 = 0; g2 < 4; ++g2) {
        peer_load8(bufBa, bufBb, p.wV8, idxv, 2 * g2 + 1, lane);
        SB();
        peer_acc8(bufAa, bufAb, ys, cval, 2 * g2);
        SB();
        peer_load8(bufAa, bufAb, g2 < 3 ? p.wV8 : p.wU8, g2 < 3 ? idxv : nidx, g2 < 3 ? 2 * g2 + 2 : 0, lane);
        SB();
        peer_acc8(bufBa, bufBb, ys, cval, 2 * g2 + 1);
        SB();
      }
    }
    float ye[32];
#pragma unroll
    for (int i = 0; i < 16; ++i) {
      const float nA = ys[i >> 1][i & 1], nB = ys[8 + (i >> 1)][i & 1];
      const float iA = ys[i][0], iB = ys[i][1];
      ye[i] = flagI ? iA : nA;
      ye[16 + i] = flagI ? iB : nB;
    }
    float ss = 0.f;
#pragma unroll
    for (int j = 0; j < 2; ++j)
#pragma unroll
      for (int q = 0; q < 4; ++q) {
        const float4 a = *(const float4*)(p.xres + (size_t)tok * 2048 + j * 1024 + lane * 16 + q * 4);
        const int b0 = j * 16 + q * 4;
        ye[b0] += a.x; ye[b0 + 1] += a.y; ye[b0 + 2] += a.z; ye[b0 + 3] += a.w;
        ss += ye[b0] * ye[b0] + ye[b0 + 1] * ye[b0 + 1] + ye[b0 + 2] * ye[b0 + 2] + ye[b0 + 3] * ye[b0 + 3];
      }
    ss = wave_sum(ss);
    const float rs = rsqrtf(ss * (1.f / 2048.f) + 1e-6f);
#pragma unroll
    for (int j = 0; j < 2; ++j)
#pragma unroll
      for (int q = 0; q < 4; ++q) {
        const float4 gq = *(const float4*)(p.g_final + j * 1024 + lane * 16 + q * 4);
        const int b0 = j * 16 + q * 4;
        float4 o;
        o.x = ye[b0] * rs * gq.x; o.y = ye[b0 + 1] * rs * gq.y; o.z = ye[b0 + 2] * rs * gq.z; o.w = ye[b0 + 3] * rs * gq.w;
        *(float4*)(p.out + (size_t)tok * 2048 + j * 1024 + lane * 16 + q * 4) = o;
      }
  }
}

DI void grid_barrier(unsigned* ctr, unsigned& epoch) {
  asm volatile("s_waitcnt vmcnt(0)" ::: "memory");
  __syncthreads();
  if (threadIdx.x == 0) {
    __builtin_amdgcn_fence(__ATOMIC_RELEASE, "agent");
    asm volatile("s_waitcnt vmcnt(0)" ::: "memory");
    __hip_atomic_fetch_add(ctr, 1u, __ATOMIC_RELAXED, __HIP_MEMORY_SCOPE_AGENT);
    const unsigned target = (epoch + 1u) * gridDim.x;
    unsigned spins = 0;
    while (__hip_atomic_load(ctr, __ATOMIC_RELAXED, __HIP_MEMORY_SCOPE_AGENT) < target) {
      __builtin_amdgcn_s_sleep(1);
      if (++spins > (1u << 24)) break;
    }
    __builtin_amdgcn_fence(__ATOMIC_ACQUIRE, "agent");
    asm volatile("s_waitcnt vmcnt(0)" ::: "memory");
  }
  __syncthreads();
  epoch += 1u;
}

__global__ void __launch_bounds__(NTHREADS) mega(Params p, int phase_lo, int phase_hi) {
  __shared__ __attribute__((aligned(16))) char smem[SMEM_BYTES];
  cg::grid_group grid = cg::this_grid();
  unsigned epoch = 0;
#define PHASE(k, call) if (phase_lo <= (k) && (k) < phase_hi) { if ((k) > phase_lo) { if ((k) == 1) grid.sync(); else grid_barrier(p.bar, epoch); } call; if ((DUP_MASK >> (k)) & 1) { grid_barrier(p.bar, epoch); call; } }
  PHASE(0, phase_prep(p, smem))
  PHASE(1, phase_inproj(p, smem))
  PHASE(2, phase_mix_attn(p, smem))
  PHASE(3, phase_pool_combine(p, smem))
  PHASE(4, phase_gemm_resid(p.hbuf, 2048, p.wOutT, 2048, p.x, p.xres, smem))
  PHASE(5, phase_rms(p.xres, p.g_cross, p.hbuf))
  PHASE(6, phase_cross_proj(p, smem))
  PHASE(7, phase_cross_attn(p, smem))
  if (ABL != 2) PHASE(8, phase_gemm_resid(p.oc, 512, p.wCoT, 512, p.xres, p.xres, smem))
  PHASE(9, phase_rms(p.xres, p.g_ffn, p.hbuf))
  PHASE(10, phase_gemm_pq(p, smem))
  PHASE(11, phase_peer_route(p, smem))
  PHASE(12, phase_peer_expert(p))
}

extern "C" void kernel_launch(void* const* d_in, const int* in_sizes, int n_in, void* d_out, int out_size, void* d_ws,
                              size_t ws_size, hipStream_t stream) {
  Params p{};
  p.x = (const float*)d_in[0]; p.mem = (const float*)d_in[1]; p.pos = (const int*)d_in[2];
  p.g_mix = (const float*)d_in[3]; p.w_in = (const float*)d_in[4]; p.w_pool = (const float*)d_in[5];
  p.pool_scale = (const float*)d_in[6]; p.w_out = (const float*)d_in[7]; p.g_cross = (const float*)d_in[8];
  p.g_mem = (const float*)d_in[9]; p.w_cq = (const float*)d_in[10]; p.w_ck = (const float*)d_in[11];
  p.w_cv = (const float*)d_in[12]; p.w_co = (const float*)d_in[13]; p.g_ffn = (const float*)d_in[14];
  p.w_pq = (const float*)d_in[15]; p.sk1f = (const float*)d_in[16]; p.sk2f = (const float*)d_in[17];
  p.w_u = (const float*)d_in[18]; p.w_v = (const float*)d_in[19]; p.g_final = (const float*)d_in[20];
  p.out = (float*)d_out;
  char* ws = (char*)d_ws;
  size_t off = 0;
  auto take = [&](size_t bytes) { char* r = ws + off; off += (bytes + 255) & ~(size_t)255; return r; };
  const size_t MB = 1024 * 1024;
  p.wInT = (bfr*)take(16 * MB); p.wPoolT = (bfr*)take(512 * 1024); p.wOutT = (bfr*)take(8 * MB);
  p.wCqT = (bfr*)take(2 * MB); p.wCkT = (bfr*)take(2 * MB); p.wCvT = (bfr*)take(2 * MB); p.wCoT = (bfr*)take(2 * MB);
  p.wPqT = (bfr*)take(8 * MB); p.sk1 = (bfr*)take(32768); p.sk2 = (bfr*)take(32768);
  p.wU8 = (unsigned char*)take(32 * MB); p.wV8 = (unsigned char*)take(32 * MB);
  p.su = (float*)take(65536); p.sv = (float*)take(65536);
  p.memn = (bfr*)take(4 * MB); p.kc = (bfr*)take(1 * MB); p.vc = (bfr*)take(1 * MB);
  p.hbuf = (bfr*)take(64 * MB);
  p.bar = (unsigned*)take(256);
  const size_t r2 = off;
  p.qbuf = (bfr*)take(32 * MB); p.kbuf = (bfr*)take(32 * MB); p.vbuf = (bfr*)take(32 * MB);
  p.pbuf = (bfr*)take(32 * MB); p.mixed = (bfr*)take(32 * MB); p.ob = (bfr*)take(96 * MB);
  p.lse = (float*)take((size_t)3 * T_TOK * 8 * 4);
  const size_t end1 = off;
  off = r2;
  p.xres = (float*)take(128 * MB); p.pq = (bfr*)take(64 * MB); p.qc = (bfr*)take(16 * MB); p.oc = (bfr*)take(16 * MB);
  p.idx = (int*)take(8 * MB); p.gates = (float*)take(8 * MB);
  const size_t end2 = off;
  const size_t need = end1 > end2 ? end1 : end2;
  if (need > ws_size) { fprintf(stderr, "workspace too small: need %zu have %zu\n", need, ws_size); return; }

  static int grid_blocks = 0;
  if (!grid_blocks) {
    int dev = 0, cus = 0, per_cu = 0;
    hipGetDevice(&dev);
    hipDeviceGetAttribute(&cus, hipDeviceAttributeMultiprocessorCount, dev);
    hipOccupancyMaxActiveBlocksPerMultiprocessor(&per_cu, mega, NTHREADS, 0);
    if (per_cu < 1) per_cu = 1;
    if (per_cu > 1) per_cu = 1;
    grid_blocks = cus * per_cu;
  }
  hipMemsetAsync(p.bar, 0, 256, stream);
#if MULTI_LAUNCH
  for (int ph = 0; ph < NPHASE; ++ph) hipLaunchKernelGGL(mega, dim3(grid_blocks), dim3(NTHREADS), 0, stream, p, ph, ph + 1);
#else
  int lo = 0, hi = NPHASE;
  void* args[] = {&p, &lo, &hi};
  hipError_t e = hipLaunchCooperativeKernel((void*)mega, dim3(grid_blocks), dim3(NTHREADS), args, 0, stream);
  if (e != hipSuccess) fprintf(stderr, "cooperative launch failed: %s (grid %d)\n", hipGetErrorString(e), grid_blocks);
#endif
}
```

```cpp
#include <hip/hip_runtime.h>
#include <hip/hip_cooperative_groups.h>
#include <stdint.h>
#include <stdio.h>
namespace cg = cooperative_groups;

#ifndef ABL
#define ABL 0
#endif
#ifndef DUP_MASK
#define DUP_MASK 0
#endif
#ifndef MULTI_LAUNCH
#define MULTI_LAUNCH 0
#endif

#define DI __device__ __forceinline__
typedef unsigned short bfr;
using bf16x8 = __attribute__((ext_vector_type(8))) short;
using s16x4  = __attribute__((ext_vector_type(4))) short;
using f32x4  = __attribute__((ext_vector_type(4))) float;
using u32x4  = __attribute__((ext_vector_type(4))) unsigned;
using u32x2  = __attribute__((ext_vector_type(2))) unsigned;
using bf2    = __attribute__((ext_vector_type(2))) __bf16;
using f32x2  = __attribute__((ext_vector_type(2))) float;
using v6u    = __attribute__((ext_vector_type(6))) unsigned;
using v16f   = __attribute__((ext_vector_type(16))) float;
using v32f   = __attribute__((ext_vector_type(32))) float;

constexpr int T_TOK = 16384;
constexpr int NTHREADS = 512;
constexpr int SMEM_BYTES = 151552;
constexpr int NPHASE = 13;

struct Params {
  const float *x, *mem; const int* pos;
  const float *g_mix, *w_in, *w_pool, *pool_scale, *w_out, *g_cross, *g_mem, *w_cq, *w_ck, *w_cv, *w_co, *g_ffn, *w_pq,
              *sk1f, *sk2f, *w_u, *w_v, *g_final;
  float* out;
  bfr *wInT, *wPoolT, *wOutT, *wCqT, *wCkT, *wCvT, *wCoT, *wPqT, *sk1, *sk2;
  unsigned char *wU8, *wV8; float *su, *sv;
  bfr *hbuf, *memn, *kc, *vc;
  bfr *pbuf, *qbuf, *kbuf, *vbuf, *mixed, *ob; float* lse;
  float* xres; bfr *pq, *qc, *oc; int* idx; float* gates;
  unsigned* bar;
  float *rowss1, *rowss2; bfr* x2b;
};

DI unsigned pack2(float a, float b) { bf2 p; p[0] = (__bf16)a; p[1] = (__bf16)b; return __builtin_bit_cast(unsigned, p); }
DI float bflo(unsigned u) { return __uint_as_float(u << 16); }
DI float bfhi(unsigned u) { return __uint_as_float(u & 0xffff0000u); }
DI float wave_sum(float v) {
#pragma unroll
  for (int o = 32; o >= 1; o >>= 1) v += __shfl_xor(v, o);
  return v;
}
DI f32x4 mfma16(bf16x8 a, bf16x8 b, f32x4 c) { return __builtin_amdgcn_mfma_f32_16x16x32_bf16(a, b, c, 0, 0, 0); }
DI s16x4 tr_read(const char* p) {
  return __builtin_amdgcn_ds_read_tr16_b64_v4i16((s16x4 __attribute__((address_space(3)))*)(p));
}

DI void gemm_main(const bfr* __restrict__ A, int lda, const bfr* __restrict__ Bt, int ldb, int K, char* smem,
                  f32x4 (&acc)[4][4]) {
  const int tid = threadIdx.x, lane = tid & 63, wid = tid >> 6, wm = wid >> 1, wn = wid & 1, fr = lane & 15, fq = lane >> 4;
  const int lrow = tid >> 3, lc = tid & 7;
  const int sw = ((lc ^ (lrow & 7)) << 4);
  u32x4 ra[4], rb[2];
  const bfr* ga = A + (size_t)lrow * lda + lc * 8;
  const bfr* gb = Bt + (size_t)lrow * ldb + lc * 8;
#pragma unroll
  for (int m = 0; m < 4; ++m)
#pragma unroll
    for (int n = 0; n < 4; ++n) acc[m][n] = f32x4{0.f, 0.f, 0.f, 0.f};
  const int nk = K >> 6;
#pragma unroll
  for (int i = 0; i < 4; ++i) ra[i] = *(const u32x4*)(ga + (size_t)(64 * i) * lda);
#pragma unroll
  for (int i = 0; i < 2; ++i) rb[i] = *(const u32x4*)(gb + (size_t)(64 * i) * ldb);
  __syncthreads();
#pragma unroll
  for (int i = 0; i < 4; ++i) *(u32x4*)(smem + (lrow + 64 * i) * 128 + sw) = ra[i];
#pragma unroll
  for (int i = 0; i < 2; ++i) *(u32x4*)(smem + 32768 + (lrow + 64 * i) * 128 + sw) = rb[i];
  __syncthreads();
  for (int kt = 0; kt < nk; ++kt) {
    const char* cur = smem + (kt & 1) * 49152;
    char* nxt = smem + ((kt + 1) & 1) * 49152;
    const bool more = (kt + 1 < nk);
    if (more) {
#pragma unroll
      for (int i = 0; i < 4; ++i) ra[i] = *(const u32x4*)(ga + (size_t)(64 * i) * lda + (kt + 1) * 64);
#pragma unroll
      for (int i = 0; i < 2; ++i) rb[i] = *(const u32x4*)(gb + (size_t)(64 * i) * ldb + (kt + 1) * 64);
    }
#pragma unroll
    for (int kk = 0; kk < 2; ++kk) {
      bf16x8 af[4], bf[4];
      const int co = (((kk * 4 + fq) ^ (fr & 7)) << 4);
#pragma unroll
      for (int m = 0; m < 4; ++m) af[m] = *(const bf16x8*)(cur + (wm * 64 + m * 16 + fr) * 128 + co);
#pragma unroll
      for (int n = 0; n < 4; ++n) bf[n] = *(const bf16x8*)(cur + 32768 + (wn * 64 + n * 16 + fr) * 128 + co);
#pragma unroll
      for (int m = 0; m < 4; ++m)
#pragma unroll
        for (int n = 0; n < 4; ++n) acc[m][n] = mfma16(bf[n], af[m], acc[m][n]);
    }
    if (more) {
#pragma unroll
      for (int i = 0; i < 4; ++i) *(u32x4*)(nxt + (lrow + 64 * i) * 128 + sw) = ra[i];
#pragma unroll
      for (int i = 0; i < 2; ++i) *(u32x4*)(nxt + 32768 + (lrow + 64 * i) * 128 + sw) = rb[i];
    }
    __syncthreads();
  }
}

DI void tile_map(int id, int MT, int NT, int& mt, int& nt) {
  if ((NT & 7) == 0 && (MT & 31) == 0) {
    const int round = id >> 8, local = id & 255, xcd = local & 7, j = local >> 3, mtl = j & 3, ntl = j >> 2;
    const int MR = MT >> 5;
    const int mr = round % MR, nr = round / MR;
    mt = mr * 32 + xcd * 4 + mtl;
    nt = nr * 8 + ntl;
  } else {
    mt = id % MT;
    nt = id / MT;
  }
}


#define LAS __attribute__((address_space(3)))
namespace g8 {
constexpr int BM = 256, BK = 64, HALF = 128, HTB = HALF * BK * 2, NXCD = 8, WGM = 8;
DI int lds_byte(int r, int c) { const int st = (r >> 4) * 2 + (c >> 5), rr = r & 15, cc = c & 31, ob = rr * 64 + cc * 2; return st * 1024 + (ob ^ (((ob >> 9) & 1) << 5)); }
DI void stage_rc(int b, int& R, int& C) { const int st = b / 1024, sb = b % 1024, swz = sb ^ (((sb >> 9) & 1) << 5); R = (st >> 1) * 16 + swz / 64; C = (st & 1) * 32 + (swz % 64) / 2; }
struct Order {
  int nM, nN, nwg, G, c;
  DI void init(int M, int N, int G_, int c_) { nM = M / BM; nN = N / BM; nwg = nM * nN; G = G_; c = c_; }
  DI bool next(int i, int& pm, int& pn) const {
    const long L = (long)i * G + c; if (L >= nwg) return false;
    int wgid = (int)L; { const int q = nwg / NXCD, r = nwg % NXCD, xcd = wgid % NXCD, off = wgid / NXCD; wgid = (xcd < r ? xcd * (q + 1) : r * (q + 1) + (xcd - r) * q) + off; }
    const int nig = WGM * nN, gid = wgid / nig, fm = gid * WGM, gsz = (nM - fm) < WGM ? (nM - fm) : WGM;
    pm = fm + ((wgid % nig) % gsz); pn = (wgid % nig) / gsz; return true;
  }
};
}

template <class Epi>
DI void gemm8(LAS unsigned char* lds, const bfr* A, int lda, const bfr* Bt, int M, int N, int K, int G, int c, const Epi& E, int a_pn_bytes = 0) {
  using namespace g8;
  const int tid = threadIdx.x, wid = __builtin_amdgcn_readfirstlane(tid >> 6), lane = tid & 63, wr = wid >> 2, wc = wid & 3, fr = lane & 15, fq = lane >> 4;
  const int nt = K / BK;
  Order S; S.init(M, N, G, c);
  unsigned voffA[2], voffB[2];
#pragma unroll
  for (int i = 0; i < 2; ++i) { int R, C; stage_rc(tid * 16 + i * 8192, R, C); voffA[i] = (unsigned)(R * lda + C) * 2u; voffB[i] = (unsigned)(R * K + C) * 2u; }
  const size_t kstep = (size_t)(BK * 2);
  const size_t hstepA = (size_t)HALF * lda * 2, hstepB = (size_t)HALF * K * 2;
  const size_t tstepA = 2 * hstepA, tstepB = 2 * hstepB;
  const unsigned ldsw = (unsigned)wid * 1024u;
  const int aoff = lds_byte(wr * 64 + fr, fq * 8), boff = lds_byte(wc * 32 + fr, fq * 8);
#define G8_SA(b, h) (((b) * 2 + (h)) * HTB)
#define G8_SB(b, h) ((4 + (b) * 2 + (h)) * HTB)
#define G8_STAGE(bufoff, gbase, voff) do { _Pragma("unroll") for (int _i = 0; _i < 2; ++_i) \
    __builtin_amdgcn_global_load_lds((const unsigned*)((const char*)(gbase) + (voff)[_i]), (LAS unsigned*)(lds + (bufoff) + ldsw + _i * 8192), 16, 0, 0); } while (0)
#define G8_LDA(dst, b, h) do { _Pragma("unroll") for (int m = 0; m < 4; ++m) _Pragma("unroll") for (int k = 0; k < 2; ++k) dst[m][k] = *(const LAS bf16x8*)(lds + G8_SA(b, h) + aoff + m * 2048 + k * 1024); } while (0)
#define G8_LDB(dst, b, h) do { _Pragma("unroll") for (int n = 0; n < 2; ++n) _Pragma("unroll") for (int k = 0; k < 2; ++k) dst[n][k] = *(const LAS bf16x8*)(lds + G8_SB(b, h) + boff + n * 2048 + k * 1024); } while (0)
#define G8_MMA(ai, bj, At, Btf) do { __builtin_amdgcn_s_setprio(1); _Pragma("unroll") for (int m = 0; m < 4; ++m) _Pragma("unroll") for (int n = 0; n < 2; ++n) _Pragma("unroll") for (int k = 0; k < 2; ++k) \
    acc[ai][bj][m][n] = __builtin_amdgcn_mfma_f32_16x16x32_bf16(Btf[n][k], At[m][k], acc[ai][bj][m][n], 0, 0, 0); __builtin_amdgcn_s_setprio(0); } while (0)
#define G8_WAIT_V(n) asm volatile("s_waitcnt vmcnt(" #n ")" ::: "memory")
#define G8_WAIT_L(n) asm volatile("s_waitcnt lgkmcnt(" #n ")" ::: "memory")
#define G8_BAR __builtin_amdgcn_s_barrier()
#define G8_SCHED __builtin_amdgcn_sched_barrier(0)
  int cpm, cpn, npm = 0, npn = 0, ui = 0;
  if (!S.next(0, cpm, cpn)) return;
  f32x4 acc[2][2][4][2];
#pragma unroll
  for (int a = 0; a < 2; ++a)
#pragma unroll
    for (int b = 0; b < 2; ++b)
#pragma unroll
      for (int m = 0; m < 4; ++m)
#pragma unroll
        for (int n = 0; n < 2; ++n) acc[a][b][m][n] = f32x4{0.f, 0.f, 0.f, 0.f};
  bf16x8 At[4][2], B0[2][2], B1[2][2];
  const char* cA = (const char*)A + (size_t)cpm * tstepA + (size_t)cpn * a_pn_bytes; const char* cB = (const char*)Bt + (size_t)cpn * tstepB;
  G8_STAGE(G8_SB(0, 0), cB, voffB); G8_STAGE(G8_SA(0, 0), cA, voffA); G8_STAGE(G8_SB(0, 1), cB + hstepB, voffB); G8_STAGE(G8_SA(0, 1), cA + hstepA, voffA);
  if (wr == 1) G8_BAR;
  G8_WAIT_V(4); G8_BAR;
  G8_STAGE(G8_SB(1, 0), cB + kstep, voffB); G8_STAGE(G8_SA(1, 0), cA + kstep, voffA); G8_STAGE(G8_SB(1, 1), cB + hstepB + kstep, voffB);
  G8_WAIT_V(6); G8_BAR;
  for (;;) {
    const bool has_next = S.next(ui + 1, npm, npn);
    const char* nA = has_next ? (const char*)A + (size_t)npm * tstepA + (size_t)npn * a_pn_bytes : cA; const char* nB = has_next ? (const char*)Bt + (size_t)npn * tstepB : cB;
    for (int t = 0; t < nt; t += 2) {
      const bool last = (t == nt - 2);
      const char* a1 = cA + (size_t)(t + 1) * kstep;
      const char* a2 = last ? nA : cA + (size_t)(t + 2) * kstep; const char* b2 = last ? nB : cB + (size_t)(t + 2) * kstep;
      const char* a3 = a2 + kstep; const char* b3 = b2 + kstep;
      G8_LDB(B0, 0, 0); G8_SCHED; G8_LDA(At, 0, 0); G8_STAGE(G8_SA(1, 1), a1 + hstepA, voffA);
      G8_WAIT_L(8); G8_BAR; G8_WAIT_L(0); G8_MMA(0, 0, At, B0); G8_BAR; G8_SCHED;
      G8_LDB(B1, 0, 1); G8_STAGE(G8_SB(0, 0), b2, voffB);
      G8_BAR; G8_WAIT_L(0); G8_MMA(0, 1, At, B1); G8_BAR;
      G8_LDA(At, 0, 1); G8_STAGE(G8_SA(0, 0), a2, voffA);
      G8_BAR; G8_WAIT_L(0); G8_MMA(1, 0, At, B0); G8_BAR; G8_SCHED;
      G8_STAGE(G8_SB(0, 1), b2 + hstepB, voffB);
      G8_WAIT_V(6); G8_BAR; G8_MMA(1, 1, At, B1); G8_BAR;
      G8_LDB(B0, 1, 0); G8_SCHED; G8_LDA(At, 1, 0); G8_STAGE(G8_SA(0, 1), a2 + hstepA, voffA);
      G8_WAIT_L(8); G8_BAR; G8_WAIT_L(0); G8_MMA(0, 0, At, B0); G8_BAR; G8_SCHED;
      G8_LDB(B1, 1, 1); G8_STAGE(G8_SB(1, 0), b3, voffB);
      G8_BAR; G8_WAIT_L(0); G8_MMA(0, 1, At, B1); G8_BAR;
      G8_LDA(At, 1, 1); G8_STAGE(G8_SA(1, 0), a3, voffA);
      G8_BAR; G8_WAIT_L(0); G8_MMA(1, 0, At, B0); G8_BAR; G8_SCHED;
      G8_STAGE(G8_SB(1, 1), b3 + hstepB, voffB);
      G8_WAIT_V(6); G8_BAR; G8_MMA(1, 1, At, B1); G8_BAR;
    }
    E(acc, cpm, cpn, wr, wc, fr, fq);
    if (!has_next) break;
#pragma unroll
    for (int a = 0; a < 2; ++a)
#pragma unroll
      for (int b = 0; b < 2; ++b)
#pragma unroll
        for (int m = 0; m < 4; ++m)
#pragma unroll
          for (int n = 0; n < 2; ++n) acc[a][b][m][n] = f32x4{0.f, 0.f, 0.f, 0.f};
    cpm = npm; cpn = npn; cA = nA; cB = nB; ++ui;
  }
  G8_WAIT_V(0);
  if (wr == 0) G8_BAR;
  G8_BAR;
#undef G8_SA
#undef G8_SB
#undef G8_STAGE
#undef G8_LDA
#undef G8_LDB
#undef G8_MMA
#undef G8_WAIT_V
#undef G8_WAIT_L
#undef G8_BAR
#undef G8_SCHED
}
#define G8_FOREACH(acc, pm, pn, wr, wc, fr, fq, ai, bj, m, n, row, col) \
  _Pragma("unroll") for (int ai = 0; ai < 2; ++ai) _Pragma("unroll") for (int m = 0; m < 4; ++m) \
  _Pragma("unroll") for (int bj = 0; bj < 2; ++bj) _Pragma("unroll") for (int n = 0; n < 2; ++n) \
    if (const int row = 256 * (pm) + 128 * ai + 64 * (wr) + 16 * m + (fr); true) if (const int col = 256 * (pn) + 128 * bj + 32 * (wc) + 16 * n + 4 * (fq); true)
typedef f32x4 Acc8[2][2][4][2];

template <bool BANDED, class StoreF>
DI void attn_core(const bfr* __restrict__ Qb, int qstride, int q0, const bfr* __restrict__ Kb, const bfr* __restrict__ Vb,
                  int kvstride, int key0, char* smem, StoreF store, float& m_out, float& l_out) {
  const int tid = threadIdx.x, lane = tid & 63, w = tid >> 6, fr = lane & 15, fq = lane >> 4;
  char* sK = smem;
  char* sV = smem + 65536;
  __syncthreads();
#pragma unroll 1
  for (int rr = 0; rr < 2; ++rr) {
    u32x4 kr[4], vr[4];
#pragma unroll
    for (int i = 0; i < 4; ++i) {
      const int id = tid + (rr * 4 + i) * 512, key = id >> 4, c = id & 15, lk = key0 + key;
      kr[i] = u32x4{0u, 0u, 0u, 0u};
      vr[i] = u32x4{0u, 0u, 0u, 0u};
      if (lk >= 0) {
        kr[i] = *(const u32x4*)(Kb + (long)lk * kvstride + c * 8);
        vr[i] = *(const u32x4*)(Vb + (long)lk * kvstride + c * 8);
      }
    }
#pragma unroll
    for (int i = 0; i < 4; ++i) {
      const int id = tid + (rr * 4 + i) * 512, key = id >> 4, c = id & 15;
      *(u32x4*)(sK + key * 256 + ((c ^ (key & 15)) << 4)) = kr[i];
      *(u32x4*)(sV + key * 288 + c * 16) = vr[i];
    }
  }
  bf16x8 qf[4];
  {
    const bfr* qrow = Qb + (long)(q0 + w * 16 + fr) * qstride;
#pragma unroll
    for (int kk = 0; kk < 4; ++kk) qf[kk] = *(const bf16x8*)(qrow + kk * 32 + fq * 8);
  }
  __syncthreads();
  constexpr int NT = BANDED ? 10 : 16;
  const int t0 = BANDED ? (w & ~1) : 0;
  f32x4 s[NT];
#pragma unroll
  for (int j = 0; j < NT; ++j) {
    f32x4 a = f32x4{0.f, 0.f, 0.f, 0.f};
    const int key = (t0 + j) * 16 + fr;
#pragma unroll
    for (int kk = 0; kk < 4; ++kk) {
      const bf16x8 kf = *(const bf16x8*)(sK + key * 256 + (((kk * 4 + fq) ^ fr) << 4));
      a = mfma16(kf, qf[kk], a);
    }
    s[j] = a;
  }
  const float L2E = 1.4426950408889634f;
  const float NINF = -__builtin_inff();
  float mx = NINF;
  const int lq = q0 + w * 16 + fr;
#pragma unroll
  for (int j = 0; j < NT; ++j)
#pragma unroll
    for (int i = 0; i < 4; ++i) {
      float v = s[j][i] * L2E;
      if (BANDED) {
        const int lk = key0 + (t0 + j) * 16 + fq * 4 + i;
        const int dist = lq - lk;
        const bool ok = (lk >= 0) && (dist >= 0) && (dist <= 128);
        v = ok ? v : NINF;
      }
      s[j][i] = v;
      mx = fmaxf(mx, v);
    }
  mx = fmaxf(mx, __shfl_xor(mx, 16));
  mx = fmaxf(mx, __shfl_xor(mx, 32));
  float l = 0.f;
#pragma unroll
  for (int j = 0; j < NT; ++j)
#pragma unroll
    for (int i = 0; i < 4; ++i) {
      const float p = __builtin_amdgcn_exp2f(s[j][i] - mx);
      s[j][i] = p;
      l += p;
    }
  l += __shfl_xor(l, 16);
  l += __shfl_xor(l, 32);
  bf16x8 pf[NT / 2];
#pragma unroll
  for (int c = 0; c < NT / 2; ++c) {
    u32x4 t;
    t[0] = pack2(s[2 * c][0], s[2 * c][1]);
    t[1] = pack2(s[2 * c][2], s[2 * c][3]);
    t[2] = pack2(s[2 * c + 1][0], s[2 * c + 1][1]);
    t[3] = pack2(s[2 * c + 1][2], s[2 * c + 1][3]);
    pf[c] = __builtin_bit_cast(bf16x8, t);
  }
  const int q4 = (lane & 15) >> 2, p4 = lane & 3;
  m_out = mx;
  l_out = l;
#pragma unroll 2
  for (int dt = 0; dt < 8; ++dt) {
    f32x4 a = f32x4{0.f, 0.f, 0.f, 0.f};
#pragma unroll
    for (int c = 0; c < NT / 2; ++c) {
      const int kb = (t0 + 2 * c) * 16;
      const s16x4 lo = tr_read(sV + (kb + fq * 4 + q4) * 288 + (dt * 16 + p4 * 4) * 2);
      const s16x4 hi = tr_read(sV + (kb + 16 + fq * 4 + q4) * 288 + (dt * 16 + p4 * 4) * 2);
      const bf16x8 vf = __builtin_shufflevector(lo, hi, 0, 1, 2, 3, 4, 5, 6, 7);
      a = mfma16(vf, pf[c], a);
    }
    store(dt, a, l);
  }
}

DI int f2sort(float f) { int b = __float_as_int(f); return b ^ ((b >> 31) & 0x7fffffff); }
DI float sort2f(int s) { int b = s ^ ((s >> 31) & 0x7fffffff); return __int_as_float(b); }
DI void topk_insert(int (&lst)[16], int key) {
#pragma unroll
  for (int j = 0; j < 16; ++j) {
    const int hi = max(lst[j], key);
    key = min(lst[j], key);
    lst[j] = hi;
  }
}

template <int O, int N>
DI void bfly(float (&p)[64], int lane) {
  const bool up = (lane & O) != 0;
#pragma unroll
  for (int i = 0; i < N / 2; ++i) {
    const float keep = up ? p[i + N / 2] : p[i];
    const float send = up ? p[i] : p[i + N / 2];
    p[i] = keep + __shfl_xor(send, O);
  }
  if constexpr (O > 1) bfly<O / 2, N / 2>(p, lane);
}

DI void rms_row_to_bf16(const float* __restrict__ x, const float* __restrict__ g, bfr* __restrict__ out, int lane) {
  float4 v[8];
  float ss = 0.f;
#pragma unroll
  for (int j = 0; j < 8; ++j) {
    v[j] = *(const float4*)(x + j * 256 + lane * 4);
    ss += v[j].x * v[j].x + v[j].y * v[j].y + v[j].z * v[j].z + v[j].w * v[j].w;
  }
  ss = wave_sum(ss);
  const float rs = rsqrtf(ss * (1.f / 2048.f) + 1e-6f);
#pragma unroll
  for (int j = 0; j < 8; ++j) {
    const float4 gg = *(const float4*)(g + j * 256 + lane * 4);
    u32x2 o;
    o[0] = pack2(v[j].x * rs * gg.x, v[j].y * rs * gg.y);
    o[1] = pack2(v[j].z * rs * gg.z, v[j].w * rs * gg.w);
    *(u32x2*)(out + j * 256 + lane * 4) = o;
  }
}

DI void transpose_tile(const float* __restrict__ W, int K, int N, int k0, int n0, bfr* __restrict__ Wt, float* tile, const float* colscale, const float* rowscale) {
  __syncthreads();
  {
    const int r = threadIdx.x >> 4, c4 = threadIdx.x & 15;
#pragma unroll
    for (int i = 0; i < 2; ++i) {
      const int k = r + 32 * i;
      const float4 v = *(const float4*)(W + (size_t)(k0 + k) * N + n0 + c4 * 4);
      tile[k * 65 + c4 * 4 + 0] = v.x;
      tile[k * 65 + c4 * 4 + 1] = v.y;
      tile[k * 65 + c4 * 4 + 2] = v.z;
      tile[k * 65 + c4 * 4 + 3] = v.w;
    }
  }
  __syncthreads();
  {
    const int n = threadIdx.x >> 3, kc = threadIdx.x & 7;
    u32x4 o;
    const float csv = colscale ? colscale[n0 + n] : 1.0f;
#pragma unroll
    for (int j = 0; j < 4; ++j) {
      const float r0 = rowscale ? rowscale[k0 + kc * 8 + 2 * j] : 1.0f, r1 = rowscale ? rowscale[k0 + kc * 8 + 2 * j + 1] : 1.0f;
      o[j] = pack2(tile[(kc * 8 + 2 * j) * 65 + n] * csv * r0, tile[(kc * 8 + 2 * j + 1) * 65 + n] * csv * r1);
    }
    *(u32x4*)(Wt + (size_t)(n0 + n) * K + k0 + kc * 8) = o;
  }
}

DI void convert_f32_bf16(const float* __restrict__ src, bfr* __restrict__ dst, long n8) {
  for (long i = (long)blockIdx.x * NTHREADS + threadIdx.x; i < n8; i += (long)gridDim.x * NTHREADS) {
    const float4 a = *(const float4*)(src + i * 8);
    const float4 b = *(const float4*)(src + i * 8 + 4);
    u32x4 o;
    o[0] = pack2(a.x, a.y); o[1] = pack2(a.z, a.w); o[2] = pack2(b.x, b.y); o[3] = pack2(b.z, b.w);
    *(u32x4*)(dst + i * 8) = o;
  }
}

DI void phase_prep(const Params& p, char* smem) {
  const int lane = threadIdx.x & 63, wid = threadIdx.x >> 6;
  for (int r = blockIdx.x * 8 + wid; r < T_TOK + 1024; r += gridDim.x * 8) {
    if (r < T_TOK) rms_row_to_bf16(p.x + (size_t)r * 2048, p.g_mix, p.hbuf + (size_t)r * 2048, lane);
    else rms_row_to_bf16(p.mem + (size_t)(r - T_TOK) * 2048, p.g_mem, p.memn + (size_t)(r - T_TOK) * 2048, lane);
  }
  float* tile = (float*)smem;
  for (int id0 = blockIdx.x; id0 < 5184; id0 += gridDim.x) {
    int id = id0;
    const float* W; bfr* Wt; int K, N; const float* cs = nullptr; const float* rsc = nullptr;
    if (id < 2048) { W = p.w_in; Wt = p.wInT; K = 2048; N = 4096; }
    else if ((id -= 2048) < 1024) { W = p.w_out; Wt = p.wOutT; K = 2048; N = 2048; }
    else if ((id -= 1024) < 1024) { W = p.w_pq; Wt = p.wPqT; K = 2048; N = 2048; rsc = p.g_ffn; }
    else if ((id -= 1024) < 256) { W = p.w_cq; Wt = p.wCqT; K = 2048; N = 512; rsc = p.g_cross; }
    else if ((id -= 256) < 256) { W = p.w_ck; Wt = p.wCkT; K = 2048; N = 512; }
    else if ((id -= 256) < 256) { W = p.w_cv; Wt = p.wCvT; K = 2048; N = 512; }
    else if ((id -= 256) < 256) { W = p.w_co; Wt = p.wCoT; K = 512; N = 2048; }
    else { id -= 256; const int g = id >> 4; id &= 15; W = p.w_pool + g * 65536; Wt = p.wPoolT + g * 65536; K = 256; N = 256; cs = p.pool_scale + g * 256; }
    const int ntn = N >> 6;
    const int kt = id / ntn, nt = id % ntn;
    transpose_tile(W, K, N, kt * 64, nt * 64, Wt, tile, cs, rsc);
  }
  for (int i = blockIdx.x * NTHREADS + threadIdx.x; i < T_TOK; i += gridDim.x * NTHREADS) { p.rowss1[i] = 0.f; p.rowss2[i] = 0.f; }
  convert_f32_bf16(p.sk1f, p.sk1, 128 * 128 / 8);
  convert_f32_bf16(p.sk2f, p.sk2, 128 * 128 / 8);
  for (int r = blockIdx.x * 8 + wid; r < 2 * 16384; r += gridDim.x * 8) {
    const bool isv = r >= 16384;
    const int rr = isv ? r - 16384 : r;
    const float* src = (isv ? p.w_v : p.w_u) + (size_t)rr * 2048;
    float4 v[8];
    float amax = 0.f;
#pragma unroll
    for (int j = 0; j < 2; ++j)
#pragma unroll
      for (int q = 0; q < 4; ++q) {
        v[j * 4 + q] = *(const float4*)(src + j * 1024 + lane * 16 + q * 4);
        if (!isv) {
          const float4 gg = *(const float4*)(p.g_ffn + j * 1024 + lane * 16 + q * 4);
          v[j * 4 + q].x *= gg.x; v[j * 4 + q].y *= gg.y; v[j * 4 + q].z *= gg.z; v[j * 4 + q].w *= gg.w;
        }
        const float4 t = v[j * 4 + q];
        amax = fmaxf(amax, fmaxf(fmaxf(fabsf(t.x), fabsf(t.y)), fmaxf(fabsf(t.z), fabsf(t.w))));
      }
#pragma unroll
    for (int o = 32; o >= 1; o >>= 1) amax = fmaxf(amax, __shfl_xor(amax, o));
    if (isv) {
      const float inv = amax > 0.f ? 7.5f / amax : 0.f;
      if (lane == 0) p.sv[rr] = amax * (1.f / 7.5f);
      v16f qa, qb;
#pragma unroll
      for (int q = 0; q < 4; ++q) {
        qa[q * 4 + 0] = v[q].x * inv; qa[q * 4 + 1] = v[q].y * inv; qa[q * 4 + 2] = v[q].z * inv; qa[q * 4 + 3] = v[q].w * inv;
        qb[q * 4 + 0] = v[4 + q].x * inv; qb[q * 4 + 1] = v[4 + q].y * inv; qb[q * 4 + 2] = v[4 + q].z * inv; qb[q * 4 + 3] = v[4 + q].w * inv;
      }
      const v6u pk = __builtin_amdgcn_cvt_scalef32_2xpk16_fp6_f32(qa, qb, 1.0f);
      unsigned char* dst = p.wV8 + (size_t)rr * 1536;
      *(u32x4*)(dst + lane * 16) = u32x4{pk[0], pk[1], pk[2], pk[3]};
      *(u32x2*)(dst + 1024 + lane * 8) = u32x2{pk[4], pk[5]};
    } else {
      const float inv = amax > 0.f ? 6.0f / amax : 0.f;
      if (lane == 0) p.su[rr] = amax * (1.f / 6.0f);
      u32x4 o4;
#pragma unroll
      for (int c = 0; c < 4; ++c) {
        const float4 t0 = v[2 * c], t1 = v[2 * c + 1];
        unsigned w = 0;
        w = __builtin_amdgcn_cvt_scalef32_pk_fp4_f32(w, t0.x * inv, t0.y * inv, 1.0f, 0);
        w = __builtin_amdgcn_cvt_scalef32_pk_fp4_f32(w, t0.z * inv, t0.w * inv, 1.0f, 1);
        w = __builtin_amdgcn_cvt_scalef32_pk_fp4_f32(w, t1.x * inv, t1.y * inv, 1.0f, 2);
        w = __builtin_amdgcn_cvt_scalef32_pk_fp4_f32(w, t1.z * inv, t1.w * inv, 1.0f, 3);
        o4[c] = w;
      }
      *(u32x4*)(p.wU8 + (size_t)rr * 1024 + lane * 16) = o4;
    }
  }
}

DI void phase_inproj(const Params& p, char* smem) {
  auto epi = [&](const Acc8& acc0, int pm, int pn, int wr, int wc, int fr, int fq) {
    const int region = pn >> 2;
    if (region == 0) {
      G8_FOREACH(acc0, pm, pn, wr, wc, fr, fq, ai, bj, m, n, row, col) {
        const f32x4 v = acc0[ai][bj][m][n];
        u32x2 o; o[0] = pack2(v[0], v[1]); o[1] = pack2(v[2], v[3]);
        *(u32x2*)(p.pbuf + (size_t)row * 1024 + col) = o;
      }
    } else {
      bfr* dst = (region == 1) ? p.qbuf : (region == 2 ? p.kbuf : p.vbuf);
      const float scale = (region == 1) ? 0.08838834764831845f : 1.0f;
      const bool rope = (region != 3) && (wc == 0);
#pragma unroll
      for (int ai = 0; ai < 2; ++ai)
#pragma unroll
        for (int m = 0; m < 4; ++m) {
          const int row = 256 * pm + 128 * ai + 64 * wr + 16 * m + fr;
          const int b = row >> 12, t = row & 4095;
          float sn[4], cs[4];
          if (rope) {
            const float posf = (float)p.pos[row];
#pragma unroll
            for (int i = 0; i < 4; ++i) {
              const int j = fq * 4 + i;
              const float inv = exp2f(-(float)j * (18.931568569324174f / 16.0f));
              sincosf(posf * inv, &sn[i], &cs[i]);
            }
          }
#pragma unroll
          for (int bj = 0; bj < 2; ++bj) {
            const int h = (pn & 3) * 2 + bj;
            f32x4 v0 = acc0[ai][bj][m][0], v1 = acc0[ai][bj][m][1];
            if (rope) {
#pragma unroll
              for (int i = 0; i < 4; ++i) {
                const float x1 = v0[i], x2 = v1[i];
                v0[i] = x1 * cs[i] - x2 * sn[i];
                v1[i] = x2 * cs[i] + x1 * sn[i];
              }
            }
            bfr* drow = dst + ((size_t)((b * 8 + h) * 4096 + t)) * 128 + 32 * wc + 4 * fq;
            u32x2 o0, o1;
            o0[0] = pack2(v0[0] * scale, v0[1] * scale); o0[1] = pack2(v0[2] * scale, v0[3] * scale);
            o1[0] = pack2(v1[0] * scale, v1[1] * scale); o1[1] = pack2(v1[2] * scale, v1[3] * scale);
            *(u32x2*)(drow) = o0;
            *(u32x2*)(drow + 16) = o1;
          }
        }
    }
  };
  gemm8((LAS unsigned char*)smem, p.hbuf, 2048, p.wInT, T_TOK, 4096, 2048, gridDim.x, blockIdx.x, epi);
}

DI void phase_mix_attn(const Params& p, char* smem) {
  const int tid = threadIdx.x, lane = tid & 63, w = tid >> 6, fr = lane & 15, fq = lane >> 4;
  for (int id = blockIdx.x; id < 3072 + 256; id += gridDim.x) {
    if (id < 3072) {
      const int br = id >> 10, rem = id & 1023;
      const int dl = (br == 0) ? 1 : (br == 1 ? 4 : 16);
      const int nblk = 32 / dl;
      const int bh = rem >> 5, rn = rem & 31;
      const int r = rn / nblk, nb = rn % nblk;
      const int l0 = nb * 128;
      const size_t base = (size_t)bh * 4096 * 128 + (size_t)r * 128;
      float mx, l;
      const int b = bh >> 3, h = bh & 7;
      const int tt = b * 4096 + (l0 + w * 16 + fr) * dl + r;
      bfr* dst = p.ob + (size_t)br * T_TOK * 1024 + (size_t)tt * 1024 + h * 128 + fq * 4;
      attn_core<true>(p.qbuf + base, dl * 128, l0, p.kbuf + base, p.vbuf + base, dl * 128, l0 - 128, smem,
                      [&](int dt, f32x4 a, float lsum) {
                        const float il = 1.f / lsum;
                        u32x2 v; v[0] = pack2(a[0] * il, a[1] * il); v[1] = pack2(a[2] * il, a[3] * il);
                        *(u32x2*)(dst + dt * 16) = v;
                      }, mx, l);
      if (fq == 0) p.lse[(size_t)br * T_TOK * 8 + (size_t)tt * 8 + h] = mx + __builtin_amdgcn_logf(l);
    } else {
      const int ci = id - 3072;
      const int sub = tid >> 7, cgp = tid & 127;
      const int wdw = 2 << (cgp >> 5);
      const int t0 = ci * 64 + sub * 16, tin0 = t0 & 4095;
      const bfr* pb = p.pbuf + cgp * 8;
      float sum[8];
#pragma unroll
      for (int e = 0; e < 8; ++e) sum[e] = 0.f;
      for (int j = 1; j < wdw; ++j) {
        if (tin0 - j >= 0) {
          const u32x4 v = *(const u32x4*)(pb + (size_t)(t0 - j) * 1024);
#pragma unroll
          for (int e = 0; e < 4; ++e) { sum[2 * e] += bflo(v[e]); sum[2 * e + 1] += bfhi(v[e]); }
        }
      }
      for (int s = 0; s < 16; ++s) {
        const int t = t0 + s, tin = tin0 + s;
        const u32x4 v = *(const u32x4*)(pb + (size_t)t * 1024);
        float cur[8];
#pragma unroll
        for (int e = 0; e < 4; ++e) { cur[2 * e] = bflo(v[e]); cur[2 * e + 1] = bfhi(v[e]); }
        const float ic = 1.f / (float)min(tin + 1, wdw);
        u32x4 ov;
#pragma unroll
        for (int e = 0; e < 8; ++e) sum[e] += cur[e];
#pragma unroll
        for (int e = 0; e < 4; ++e) ov[e] = pack2(sum[2 * e] * ic - cur[2 * e], sum[2 * e + 1] * ic - cur[2 * e + 1]);
        *(u32x4*)(p.mixed + (size_t)t * 1024 + cgp * 8) = ov;
        if (tin - wdw + 1 >= 0) {
          const u32x4 u = *(const u32x4*)(pb + (size_t)(t - wdw + 1) * 1024);
#pragma unroll
          for (int e = 0; e < 4; ++e) { sum[2 * e] -= bflo(u[e]); sum[2 * e + 1] -= bfhi(u[e]); }
        }
      }
    }
  }
}

DI void phase_pool_combine(const Params& p, char* smem) {
  const int tid = threadIdx.x;
  {
    auto epi = [&](const Acc8& acc0, int pm, int pn, int wr, int wc, int fr, int fq) {
      G8_FOREACH(acc0, pm, pn, wr, wc, fr, fq, ai, bj, m, n, row, col) {
        const f32x4 v = acc0[ai][bj][m][n];
        u32x2 o; o[0] = pack2(v[0], v[1]); o[1] = pack2(v[2], v[3]);
        *(u32x2*)(p.hbuf + (size_t)row * 2048 + col) = o;
      }
    };
    gemm8((LAS unsigned char*)smem, p.mixed, 1024, p.wPoolT, T_TOK, 1024, 256, gridDim.x, blockIdx.x, epi, 512);
  }
  for (long i = (long)blockIdx.x * NTHREADS + tid; i < (long)T_TOK * 8 * 16; i += (long)gridDim.x * NTHREADS) {
    const int dc = (int)(i & 15), h = (int)((i >> 4) & 7);
    const long tt = i >> 7;
    const float l0 = p.lse[tt * 8 + h], l1 = p.lse[(size_t)T_TOK * 8 + tt * 8 + h], l2 = p.lse[(size_t)2 * T_TOK * 8 + tt * 8 + h];
    const float mx = fmaxf(l0, fmaxf(l1, l2));
    float w0 = __builtin_amdgcn_exp2f(l0 - mx), w1 = __builtin_amdgcn_exp2f(l1 - mx), w2 = __builtin_amdgcn_exp2f(l2 - mx);
    const float inv = 1.f / (w0 + w1 + w2);
    w0 *= inv; w1 *= inv; w2 *= inv;
    if (ABL == 3) { w0 = 0.f; w1 = 0.f; w2 = 0.f; }
    const size_t off = (size_t)tt * 1024 + h * 128 + dc * 8;
    const u32x4 a = *(const u32x4*)(p.ob + off);
    const u32x4 b = *(const u32x4*)(p.ob + (size_t)T_TOK * 1024 + off);
    const u32x4 c = *(const u32x4*)(p.ob + (size_t)2 * T_TOK * 1024 + off);
    u32x4 o;
#pragma unroll
    for (int e = 0; e < 4; ++e)
      o[e] = pack2(w0 * bflo(a[e]) + w1 * bflo(b[e]) + w2 * bflo(c[e]), w0 * bfhi(a[e]) + w1 * bfhi(b[e]) + w2 * bfhi(c[e]));
    *(u32x4*)(p.hbuf + (size_t)tt * 2048 + 1024 + h * 128 + dc * 8) = o;
  }
}

DI void phase_gemm_resid(const bfr* A, int lda, const bfr* Bt, int K, const float* resid, float* xout, bfr* xb, float* rowss, char* smem) {
  auto epi = [&](const Acc8& acc0, int pm, int pn, int wr, int wc, int fr, int fq) {
#pragma unroll
    for (int ai = 0; ai < 2; ++ai)
#pragma unroll
      for (int m = 0; m < 4; ++m) {
        const int row = 256 * pm + 128 * ai + 64 * wr + 16 * m + fr;
        float ss = 0.f;
#pragma unroll
        for (int bj = 0; bj < 2; ++bj)
#pragma unroll
          for (int n = 0; n < 2; ++n) {
            const int col = 256 * pn + 128 * bj + 32 * wc + 16 * n + 4 * fq;
            const f32x4 v = acc0[ai][bj][m][n];
            const float4 r = *(const float4*)(resid + (size_t)row * 2048 + col);
            float4 o; o.x = r.x + v[0]; o.y = r.y + v[1]; o.z = r.z + v[2]; o.w = r.w + v[3];
            *(float4*)(xout + (size_t)row * 2048 + col) = o;
            u32x2 ob; ob[0] = pack2(o.x, o.y); ob[1] = pack2(o.z, o.w);
            *(u32x2*)(xb + (size_t)row * 2048 + col) = ob;
            ss += o.x * o.x + o.y * o.y + o.z * o.z + o.w * o.w;
          }
        ss += __shfl_xor(ss, 16);
        ss += __shfl_xor(ss, 32);
        if (fq == 0) atomicAdd(rowss + row, ss);
      }
  };
  gemm8((LAS unsigned char*)smem, A, lda, Bt, T_TOK, 2048, K, gridDim.x, blockIdx.x, epi);
}

DI void phase_rms(const float* xin, const float* g, bfr* out) {
  const int lane = threadIdx.x & 63, wid = threadIdx.x >> 6;
  for (int r = blockIdx.x * 8 + wid; r < T_TOK; r += gridDim.x * 8)
    rms_row_to_bf16(xin + (size_t)r * 2048, g, out + (size_t)r * 2048, lane);
}

DI void phase_gemm_pq(const Params& p, char* smem) {
  auto epi = [&](const Acc8& acc0, int pm, int pn, int wr, int wc, int fr, int fq) {
    G8_FOREACH(acc0, pm, pn, wr, wc, fr, fq, ai, bj, m, n, row, col) {
      const f32x4 v = acc0[ai][bj][m][n];
      const float rs = rsqrtf(p.rowss2[row] * (1.f / 2048.f) + 1e-6f);
      u32x2 o; o[0] = pack2(v[0] * rs, v[1] * rs); o[1] = pack2(v[2] * rs, v[3] * rs);
      *(u32x2*)(p.pq + (size_t)row * 2048 + col) = o;
    }
  };
  gemm8((LAS unsigned char*)smem, p.hbuf, 2048, p.wPqT, T_TOK, 2048, 2048, gridDim.x, blockIdx.x, epi);
}
DI void phase_cross_proj(const Params& p, char* smem) {
  const int half = gridDim.x >> 1;
  if ((int)blockIdx.x < half) {
    auto epi = [&](const Acc8& acc0, int pm, int pn, int wr, int wc, int fr, int fq) {
      G8_FOREACH(acc0, pm, pn, wr, wc, fr, fq, ai, bj, m, n, row, col) {
        const f32x4 v = acc0[ai][bj][m][n];
        const float scale = 0.08838834764831845f * rsqrtf(p.rowss1[row] * (1.f / 2048.f) + 1e-6f);
        u32x2 o; o[0] = pack2(v[0] * scale, v[1] * scale); o[1] = pack2(v[2] * scale, v[3] * scale);
        *(u32x2*)(p.qc + (size_t)row * 512 + col) = o;
      }
    };
    gemm8((LAS unsigned char*)smem, p.x2b, 2048, p.wCqT, T_TOK, 512, 2048, half, blockIdx.x, epi);
  } else if ((int)blockIdx.x < half + 16) {
    auto epi = [&](const Acc8& acc0, int pm, int pn, int wr, int wc, int fr, int fq) {
      G8_FOREACH(acc0, pm, pn, wr, wc, fr, fq, ai, bj, m, n, row, col) {
        const f32x4 v = acc0[ai][bj][m][n];
        bfr* dst = (col < 512) ? p.kc : p.vc;
        const int cc = col & 511, hh = cc >> 7, d = cc & 127, bb = row >> 8, mm = row & 255;
        u32x2 o; o[0] = pack2(v[0], v[1]); o[1] = pack2(v[2], v[3]);
        *(u32x2*)(dst + ((size_t)((bb * 4 + hh) * 256 + mm)) * 128 + d) = o;
      }
    };
    gemm8((LAS unsigned char*)smem, p.memn, 2048, p.wCkT, 1024, 1024, 2048, 16, blockIdx.x - half, epi);
  }
}

DI void phase_cross_attn(const Params& p, char* smem) {
  const int tid = threadIdx.x, lane = tid & 63, w = tid >> 6, fr = lane & 15, fq = lane >> 4;
  for (int id = blockIdx.x; id < 512; id += gridDim.x) {
    const int b = id >> 7, h = (id >> 5) & 3, qt = id & 31;
    float mx, l;
    const size_t kvb = (size_t)(b * 4 + h) * 256 * 128;
    bfr* dst = p.oc + (size_t)(b * 4096 + qt * 128 + w * 16 + fr) * 512 + h * 128 + fq * 4;
    attn_core<false>(p.qc + (size_t)b * 4096 * 512 + h * 128, 512, qt * 128, p.kc + kvb, p.vc + kvb, 128, 0, smem,
                     [&](int dt, f32x4 a, float lsum) {
                       const float il = 1.f / lsum;
                       u32x2 v; v[0] = pack2(a[0] * il, a[1] * il); v[1] = pack2(a[2] * il, a[3] * il);
                       *(u32x2*)(dst + dt * 16) = v;
                     }, mx, l);
  }
}

template <unsigned AMASK>
DI void route_cands(int (&top)[16], const float (&v1)[16], const float (&v2)[16]) {
#pragma unroll
  for (int a = 0; a < 16; ++a)
#pragma unroll
    for (int b = 0; b < 16; ++b)
      if (((AMASK >> a) & 1u) && (a + 1) * (b + 1) <= 16) topk_insert(top, (f2sort(v1[a] + v2[b]) & ~0xFF) | (a * 16 + b));
}
DI void bitonic_sort16_desc(int (&mg)[16]) {
#pragma unroll
  for (int st = 8; st >= 1; st >>= 1)
#pragma unroll
    for (int i = 0; i < 16; ++i)
      if ((i & st) == 0) { const int hi = max(mg[i], mg[i + st]), lo = min(mg[i], mg[i + st]); mg[i] = hi; mg[i + st] = lo; }
}
DI void phase_peer_route(const Params& p, char* smem) {
  const int tid = threadIdx.x, lane = tid & 63, w = tid >> 6, fr = lane & 15, fq = lane >> 4;
  char* sSK = smem;
  float* scores = (float*)(smem + 65536);
  int* lists = (int*)(smem + 65536 + 67584);
  int* tops = (int*)(smem + 65536);
  constexpr unsigned AM0 = (1u << 0) | (1u << 3) | (1u << 5) | (1u << 8) | (1u << 9) | (1u << 10) | (1u << 11);
  __syncthreads();
#pragma unroll
  for (int i = 0; i < 8; ++i) {
    const int id = tid + i * 512, key = id >> 4, c = id & 15;
    const bfr* src = (key < 128 ? p.sk1 : p.sk2) + (key & 127) * 128 + c * 8;
    *(u32x4*)(sSK + key * 256 + ((c ^ (key & 15)) << 4)) = *(const u32x4*)src;
  }
  for (int id = blockIdx.x; id < 2048; id += gridDim.x) {
    const int tt = id >> 3, h = id & 7;
    const int tok0 = tt * 64;
    __syncthreads();
    {
      const int tg = w & 3, hf = w >> 2;
      const bfr* arow = p.pq + (size_t)(tok0 + tg * 16 + fr) * 2048 + h * 256 + hf * 128;
      bf16x8 af[4];
#pragma unroll
      for (int kk = 0; kk < 4; ++kk) af[kk] = *(const bf16x8*)(arow + kk * 32 + fq * 8);
#pragma unroll
      for (int nt = 0; nt < 8; ++nt) {
        f32x4 a = f32x4{0.f, 0.f, 0.f, 0.f};
        const int key = hf * 128 + nt * 16 + fr;
#pragma unroll
        for (int kk = 0; kk < 4; ++kk) {
          const bf16x8 bfg = *(const bf16x8*)(sSK + key * 256 + (((kk * 4 + fq) ^ fr) << 4));
          a = mfma16(af[kk], bfg, a);
        }
#pragma unroll
        for (int i = 0; i < 4; ++i) scores[(hf * 64 + tg * 16 + fq * 4 + i) * 132 + nt * 16 + fr] = a[i];
      }
    }
    __syncthreads();
    {
      const int row = tid >> 2, part = tid & 3;
      int lst[16];
#pragma unroll
      for (int j = 0; j < 16; ++j) lst[j] = (int)0x80000000;
      const float* srow = scores + row * 132 + part * 32;
#pragma unroll 2
      for (int k4 = 0; k4 < 8; ++k4) {
        const float4 v = *(const float4*)(srow + k4 * 4);
        const int kb = part * 32 + k4 * 4;
        topk_insert(lst, (f2sort(v.x) & ~0x7F) | (kb + 0));
        topk_insert(lst, (f2sort(v.y) & ~0x7F) | (kb + 1));
        topk_insert(lst, (f2sort(v.z) & ~0x7F) | (kb + 2));
        topk_insert(lst, (f2sort(v.w) & ~0x7F) | (kb + 3));
      }
      int mg[16];
#pragma unroll
      for (int i = 0; i < 16; ++i) mg[i] = max(lst[i], __shfl_xor(lst[15 - i], 1));
      bitonic_sort16_desc(mg);
#pragma unroll
      for (int i = 0; i < 16; ++i) lst[i] = max(mg[i], __shfl_xor(mg[15 - i], 2));
      bitonic_sort16_desc(lst);
      if (part == 0) {
#pragma unroll
        for (int j4 = 0; j4 < 4; ++j4) {
          int4 t; t.x = lst[j4 * 4]; t.y = lst[j4 * 4 + 1]; t.z = lst[j4 * 4 + 2]; t.w = lst[j4 * 4 + 3];
          *(int4*)(lists + row * 16 + j4 * 4) = t;
        }
      }
    }
    __syncthreads();
    int top[16];
#pragma unroll
    for (int j = 0; j < 16; ++j) top[j] = (int)0x80000000;
    const int tokl = tid & 63;
    if (tid < 128) {
      float v1[16], v2[16];
#pragma unroll
      for (int j4 = 0; j4 < 4; ++j4) {
        const int4 t1 = *(const int4*)(lists + tokl * 16 + j4 * 4);
        const int4 t2 = *(const int4*)(lists + (64 + tokl) * 16 + j4 * 4);
        v1[j4 * 4] = sort2f(t1.x & ~0x7F); v1[j4 * 4 + 1] = sort2f(t1.y & ~0x7F); v1[j4 * 4 + 2] = sort2f(t1.z & ~0x7F); v1[j4 * 4 + 3] = sort2f(t1.w & ~0x7F);
        v2[j4 * 4] = sort2f(t2.x & ~0x7F); v2[j4 * 4 + 1] = sort2f(t2.y & ~0x7F); v2[j4 * 4 + 2] = sort2f(t2.z & ~0x7F); v2[j4 * 4 + 3] = sort2f(t2.w & ~0x7F);
      }
      if (tid < 64) {
        route_cands<AM0>(top, v1, v2);
      } else {
        route_cands<(~AM0) & 0xFFFFu>(top, v1, v2);
#pragma unroll
        for (int j4 = 0; j4 < 4; ++j4) {
          int4 t; t.x = top[j4 * 4]; t.y = top[j4 * 4 + 1]; t.z = top[j4 * 4 + 2]; t.w = top[j4 * 4 + 3];
          *(int4*)(tops + tokl * 16 + j4 * 4) = t;
        }
      }
    }
    __syncthreads();
    if (tid < 64) {
      int fin[16];
#pragma unroll
      for (int j4 = 0; j4 < 4; ++j4) {
        const int4 t = *(const int4*)(tops + tid * 16 + (3 - j4) * 4);
        fin[j4 * 4 + 0] = max(top[j4 * 4 + 0], t.w);
        fin[j4 * 4 + 1] = max(top[j4 * 4 + 1], t.z);
        fin[j4 * 4 + 2] = max(top[j4 * 4 + 2], t.y);
        fin[j4 * 4 + 3] = max(top[j4 * 4 + 3], t.x);
      }
      int ex[16];
      float val[16];
      float mxv = -3.0e38f;
#pragma unroll
      for (int j = 0; j < 16; ++j) {
        const int code = fin[j] & 0xFF;
        const int i1 = lists[tid * 16 + (code >> 4)] & 0x7F;
        const int i2 = lists[(64 + tid) * 16 + (code & 15)] & 0x7F;
        ex[j] = i1 * 128 + i2;
        val[j] = sort2f(fin[j] & ~0xFF);
        mxv = fmaxf(mxv, val[j]);
      }
      float sum = 0.f;
      float ev[16];
#pragma unroll
      for (int j = 0; j < 16; ++j) { ev[j] = __expf(val[j] - mxv); sum += ev[j]; }
      const float inv = 1.f / sum;
      const size_t ob = (size_t)(tok0 + tid) * 128 + h * 16;
#pragma unroll
      for (int j4 = 0; j4 < 4; ++j4) {
        int4 iv; iv.x = ex[j4 * 4]; iv.y = ex[j4 * 4 + 1]; iv.z = ex[j4 * 4 + 2]; iv.w = ex[j4 * 4 + 3];
        float4 gv; gv.x = ev[j4 * 4] * inv; gv.y = ev[j4 * 4 + 1] * inv; gv.z = ev[j4 * 4 + 2] * inv; gv.w = ev[j4 * 4 + 3] * inv;
        *(int4*)(p.idx + ob + j4 * 4) = iv;
        *(float4*)(p.gates + ob + j4 * 4) = gv;
      }
    }
  }
}

DI float gelu_tanh(float a) {
  const float u = 0.7978845608028654f * (a + 0.044715f * a * a * a);
  return 0.5f * a * (1.f + tanhf(u));
}

#define SB() __builtin_amdgcn_sched_barrier(0)
DI void peer_load8v(u32x4 (&bufa)[8], u32x4 (&bufb)[8], const unsigned char* tbl, int idxv, int g, int lane) {
#pragma unroll
  for (int k = 0; k < 8; ++k) {
    const int e = __builtin_amdgcn_readlane(idxv, g * 8 + k);
    const unsigned char* row = tbl + (size_t)e * 1536;
    bufa[k] = *(const u32x4*)(row + lane * 16);
    { const u32x2 t2 = *(const u32x2*)(row + 1024 + lane * 8); bufb[k] = u32x4{t2[0], t2[1], 0u, 0u}; }
  }
}
DI void peer_load8u(u32x4 (&bufa)[8], const unsigned char* tbl, int idxv, int g, int lane) {
#pragma unroll
  for (int k = 0; k < 8; ++k) {
    const int e = __builtin_amdgcn_readlane(idxv, g * 8 + k);
    bufa[k] = *(const u32x4*)(tbl + (size_t)e * 1024 + lane * 16);
  }
}
DI v32f peer_unpack(const u32x4 a, const u32x4 b) {
  const v6u q = v6u{a[0], a[1], a[2], a[3], b[0], b[1]};
  return __builtin_amdgcn_cvt_scalef32_pk32_f32_fp6(q, 1.0f);
}
DI float peer_dot8(const u32x4 (&bufa)[8], const f32x2 (&hp)[16], int lane) {
  float part[8];
#pragma unroll
  for (int k = 0; k < 8; ++k) {
    const u32x4 u = bufa[k];
    f32x2 a2 = f32x2{0.f, 0.f};
#pragma unroll
    for (int c = 0; c < 4; ++c) {
      const unsigned uu = u[c];
      a2 += __builtin_amdgcn_cvt_scalef32_pk_f32_fp4(uu, 1.0f, 0) * hp[c * 4 + 0];
      a2 += __builtin_amdgcn_cvt_scalef32_pk_f32_fp4(uu, 1.0f, 1) * hp[c * 4 + 1];
      a2 += __builtin_amdgcn_cvt_scalef32_pk_f32_fp4(uu, 1.0f, 2) * hp[c * 4 + 2];
      a2 += __builtin_amdgcn_cvt_scalef32_pk_f32_fp4(uu, 1.0f, 3) * hp[c * 4 + 3];
    }
    part[k] = a2[0] + a2[1];
  }
  const bool up4 = (lane & 4) != 0, up2 = (lane & 2) != 0, up1 = (lane & 1) != 0;
  float q[4];
#pragma unroll
  for (int i = 0; i < 4; ++i) {
    const float keep = up4 ? part[i + 4] : part[i];
    const float send = up4 ? part[i] : part[i + 4];
    q[i] = keep + __shfl_xor(send, 4);
  }
  float r[2];
#pragma unroll
  for (int i = 0; i < 2; ++i) {
    const float keep = up2 ? q[i + 2] : q[i];
    const float send = up2 ? q[i] : q[i + 2];
    r[i] = keep + __shfl_xor(send, 2);
  }
  float v = (up1 ? r[1] : r[0]) + __shfl_xor(up1 ? r[0] : r[1], 1);
  v += __shfl_xor(v, 8);
  v += __shfl_xor(v, 16);
  v += __shfl_xor(v, 32);
  return v;
}
DI void peer_acc8(const u32x4 (&bufa)[8], const u32x4 (&bufb)[8], f32x2 (&ys)[16], float cval, int g) {
#pragma unroll
  for (int k = 0; k < 8; ++k) {
    const float ck = __builtin_bit_cast(float, __builtin_amdgcn_readlane(__builtin_bit_cast(int, cval), g * 8 + k));
    const v32f r = peer_unpack(bufa[k], bufb[k]);
#pragma unroll
    for (int i = 0; i < 16; ++i) ys[i] += f32x2{r[2 * i], r[2 * i + 1]} * ck;
  }
}
DI float fp6_tag(int k) { return k < 8 ? 0.125f * k : (k < 16 ? 1.f + 0.125f * (k - 8) : (k < 24 ? 2.f + 0.25f * (k - 16) : 4.f + 0.5f * (k - 24))); }

DI void phase_peer_expert(const Params& p) {
  const int lane = threadIdx.x & 63, wid = threadIdx.x >> 6;
  bool flagI;
  {
    v16f ta, tb;
#pragma unroll
    for (int i = 0; i < 16; ++i) { ta[i] = fp6_tag(i); tb[i] = fp6_tag(16 + i); }
    asm volatile("" : "+v"(ta), "+v"(tb));
    const v6u pk = __builtin_amdgcn_cvt_scalef32_2xpk16_fp6_f32(ta, tb, 1.0f);
    const v32f r = __builtin_amdgcn_cvt_scalef32_pk32_f32_fp6(pk, 1.0f);
    flagI = (r[1] == 2.0f);
  }
  bool flag4;
  {
    float c1 = 1.0f, c2 = 2.0f;
    asm volatile("" : "+v"(c1), "+v"(c2));
    const unsigned w4 = __builtin_amdgcn_cvt_scalef32_pk_fp4_f32(0u, c1, c2, 1.0f, 0);
    const f32x2 r4 = __builtin_amdgcn_cvt_scalef32_pk_f32_fp4(w4, 1.0f, 0);
    flag4 = (r4[0] == 2.0f);
  }
  for (int tok = blockIdx.x * 8 + wid; tok < T_TOK; tok += gridDim.x * 8) {
    int myidx[2];
    float mygate[2];
    const float rs2 = rsqrtf(p.rowss2[tok] * (1.f / 2048.f) + 1e-6f);
#pragma unroll
    for (int half = 0; half < 2; ++half) {
      myidx[half] = p.idx[(size_t)tok * 128 + half * 64 + lane];
      mygate[half] = p.gates[(size_t)tok * 128 + half * 64 + lane];
    }
    u32x4 bufAa[8], bufBa[8];
    u32x4 bufAb[8], bufBb[8];
    peer_load8u(bufAa, p.wU8, myidx[0], 0, lane);
    f32x2 hs[16];
    {
      float he[32];
#pragma unroll
      for (int j = 0; j < 2; ++j)
#pragma unroll
        for (int q = 0; q < 2; ++q) {
          const u32x4 t = *(const u32x4*)(p.hbuf + (size_t)tok * 2048 + j * 1024 + lane * 16 + q * 8);
#pragma unroll
          for (int c = 0; c < 4; ++c) { const unsigned tt = t[c]; he[j * 16 + q * 8 + c * 2] = bflo(tt); he[j * 16 + q * 8 + c * 2 + 1] = bfhi(tt); }
        }
#pragma unroll
      for (int i = 0; i < 16; ++i) {
        const float n0 = he[2 * i], n1 = he[2 * i + 1];
        hs[i] = f32x2{flag4 ? n1 : n0, flag4 ? n0 : n1};
      }
    }
    f32x2 ys[16];
#pragma unroll
    for (int e = 0; e < 16; ++e) ys[e] = f32x2{0.f, 0.f};
#pragma unroll 1
    for (int half = 0; half < 2; ++half) {
      const int idxv = half ? myidx[1] : myidx[0];
      const float gate = half ? mygate[1] : mygate[0];
      const float mysu = p.su[idxv], mysv = p.sv[idxv];
      float amine = 0.f;
#pragma unroll 1
      for (int g2 = 0; g2 < 3; ++g2) {
        peer_load8u(bufBa, p.wU8, idxv, 2 * g2 + 1, lane);
        SB();
        { const float v = peer_dot8(bufAa, hs, lane); if ((lane >> 3) == 2 * g2) amine = v; }
        SB();
        peer_load8u(bufAa, p.wU8, idxv, 2 * g2 + 2, lane);
        SB();
        { const float v = peer_dot8(bufBa, hs, lane); if ((lane >> 3) == 2 * g2 + 1) amine = v; }
        SB();
      }
      {
        peer_load8u(bufBa, p.wU8, idxv, 7, lane);
        SB();
        { const float v = peer_dot8(bufAa, hs, lane); if ((lane >> 3) == 6) amine = v; }
        SB();
        peer_load8v(bufAa, bufAb, p.wV8, idxv, 0, lane);
        SB();
        { const float v = peer_dot8(bufBa, hs, lane); if ((lane >> 3) == 7) amine = v; }
        SB();
      }
      const float cval = gate * gelu_tanh(amine * mysu * rs2) * mysv;
      const int nidx = myidx[1];
#pragma unroll 1
      for (int g2 = 0; g2 < 3; ++g2) {
        peer_load8v(bufBa, bufBb, p.wV8, idxv, 2 * g2 + 1, lane);
        SB();
        peer_acc8(bufAa, bufAb, ys, cval, 2 * g2);
        SB();
        peer_load8v(bufAa, bufAb, p.wV8, idxv, 2 * g2 + 2, lane);
        SB();
        peer_acc8(bufBa, bufBb, ys, cval, 2 * g2 + 1);
        SB();
      }
      {
        peer_load8v(bufBa, bufBb, p.wV8, idxv, 7, lane);
        SB();
        peer_acc8(bufAa, bufAb, ys, cval, 6);
        SB();
        peer_load8u(bufAa, p.wU8, nidx, 0, lane);
        SB();
        peer_acc8(bufBa, bufBb, ys, cval, 7);
        SB();
      }
    }
    float ye[32];
#pragma unroll
    for (int i = 0; i < 16; ++i) {
      const float nA = ys[i >> 1][i & 1], nB = ys[8 + (i >> 1)][i & 1];
      const float iA = ys[i][0], iB = ys[i][1];
      ye[i] = flagI ? iA : nA;
      ye[16 + i] = flagI ? iB : nB;
    }
    float ss = 0.f;
#pragma unroll
    for (int j = 0; j < 2; ++j)
#pragma unroll
      for (int q = 0; q < 4; ++q) {
        const float4 a = *(const float4*)(p.xres + (size_t)tok * 2048 + j * 1024 + lane * 16 + q * 4);
        const int b0 = j * 16 + q * 4;
        ye[b0] += a.x; ye[b0 + 1] += a.y; ye[b0 + 2] += a.z; ye[b0 + 3] += a.w;
        ss += ye[b0] * ye[b0] + ye[b0 + 1] * ye[b0 + 1] + ye[b0 + 2] * ye[b0 + 2] + ye[b0 + 3] * ye[b0 + 3];
      }
    ss = wave_sum(ss);
    const float rs = rsqrtf(ss * (1.f / 2048.f) + 1e-6f);
#pragma unroll
    for (int j = 0; j < 2; ++j)
#pragma unroll
      for (int q = 0; q < 4; ++q) {
        const float4 gq = *(const float4*)(p.g_final + j * 1024 + lane * 16 + q * 4);
        const int b0 = j * 16 + q * 4;
        float4 o;
        o.x = ye[b0] * rs * gq.x; o.y = ye[b0 + 1] * rs * gq.y; o.z = ye[b0 + 2] * rs * gq.z; o.w = ye[b0 + 3] * rs * gq.w;
        *(float4*)(p.out + (size_t)tok * 2048 + j * 1024 + lane * 16 + q * 4) = o;
      }
  }
}

DI void grid_barrier(unsigned* ctr, unsigned& epoch) {
  asm volatile("s_waitcnt vmcnt(0)" ::: "memory");
  __syncthreads();
  if (threadIdx.x == 0) {
    __builtin_amdgcn_fence(__ATOMIC_RELEASE, "agent");
    asm volatile("s_waitcnt vmcnt(0)" ::: "memory");
    __hip_atomic_fetch_add(ctr, 1u, __ATOMIC_RELAXED, __HIP_MEMORY_SCOPE_AGENT);
    const unsigned target = (epoch + 1u) * gridDim.x;
    unsigned spins = 0;
    while (__hip_atomic_load(ctr, __ATOMIC_RELAXED, __HIP_MEMORY_SCOPE_AGENT) < target) {
      __builtin_amdgcn_s_sleep(1);
      if (++spins > (1u << 24)) break;
    }
    __builtin_amdgcn_fence(__ATOMIC_ACQUIRE, "agent");
    asm volatile("s_waitcnt vmcnt(0)" ::: "memory");
  }
  __syncthreads();
  epoch += 1u;
}

__global__ void __launch_bounds__(NTHREADS) mega(Params p, int phase_lo, int phase_hi) {
  __shared__ __attribute__((aligned(16))) char smem[SMEM_BYTES];
  cg::grid_group grid = cg::this_grid();
  unsigned epoch = 0;
#define PHASE(k, call) if (phase_lo <= (k) && (k) < phase_hi) { if ((k) > phase_lo) { if ((k) == 1) grid.sync(); else grid_barrier(p.bar, epoch); } call; if ((DUP_MASK >> (k)) & 1) { grid_barrier(p.bar, epoch); call; } }
  PHASE(0, phase_prep(p, smem))
  PHASE(1, phase_inproj(p, smem))
  PHASE(2, phase_mix_attn(p, smem))
  PHASE(3, phase_pool_combine(p, smem))
  PHASE(4, phase_gemm_resid(p.hbuf, 2048, p.wOutT, 2048, p.x, p.xres, p.x2b, p.rowss1, smem))
  PHASE(6, phase_cross_proj(p, smem))
  PHASE(7, phase_cross_attn(p, smem))
  if (ABL != 2) PHASE(8, phase_gemm_resid(p.oc, 512, p.wCoT, 512, p.xres, p.xres, p.hbuf, p.rowss2, smem))
  PHASE(10, phase_gemm_pq(p, smem))
  PHASE(11, phase_peer_route(p, smem))
  PHASE(12, phase_peer_expert(p))
}

extern "C" void kernel_launch(void* const* d_in, const int* in_sizes, int n_in, void* d_out, int out_size, void* d_ws,
                              size_t ws_size, hipStream_t stream) {
  Params p{};
  p.x = (const float*)d_in[0]; p.mem = (const float*)d_in[1]; p.pos = (const int*)d_in[2];
  p.g_mix = (const float*)d_in[3]; p.w_in = (const float*)d_in[4]; p.w_pool = (const float*)d_in[5];
  p.pool_scale = (const float*)d_in[6]; p.w_out = (const float*)d_in[7]; p.g_cross = (const float*)d_in[8];
  p.g_mem = (const float*)d_in[9]; p.w_cq = (const float*)d_in[10]; p.w_ck = (const float*)d_in[11];
  p.w_cv = (const float*)d_in[12]; p.w_co = (const float*)d_in[13]; p.g_ffn = (const float*)d_in[14];
  p.w_pq = (const float*)d_in[15]; p.sk1f = (const float*)d_in[16]; p.sk2f = (const float*)d_in[17];
  p.w_u = (const float*)d_in[18]; p.w_v = (const float*)d_in[19]; p.g_final = (const float*)d_in[20];
  p.out = (float*)d_out;
  char* ws = (char*)d_ws;
  size_t off = 0;
  auto take = [&](size_t bytes) { char* r = ws + off; off += (bytes + 255) & ~(size_t)255; return r; };
  const size_t MB = 1024 * 1024;
  p.wInT = (bfr*)take(16 * MB); p.wPoolT = (bfr*)take(512 * 1024); p.wOutT = (bfr*)take(8 * MB);
  p.wCqT = (bfr*)take(2 * MB); p.wCkT = (bfr*)take(2 * MB); p.wCvT = (bfr*)take(2 * MB); p.wCoT = (bfr*)take(2 * MB);
  p.wPqT = (bfr*)take(8 * MB); p.sk1 = (bfr*)take(32768); p.sk2 = (bfr*)take(32768);
  p.wU8 = (unsigned char*)take(32 * MB); p.wV8 = (unsigned char*)take(32 * MB);
  p.su = (float*)take(65536); p.sv = (float*)take(65536);
  p.memn = (bfr*)take(4 * MB); p.kc = (bfr*)take(1 * MB); p.vc = (bfr*)take(1 * MB);
  p.hbuf = (bfr*)take(64 * MB);
  p.bar = (unsigned*)take(256);
  p.rowss1 = (float*)take(65536); p.rowss2 = (float*)take(65536);
  const size_t r2 = off;
  p.qbuf = (bfr*)take(32 * MB); p.kbuf = (bfr*)take(32 * MB); p.vbuf = (bfr*)take(32 * MB);
  p.pbuf = (bfr*)take(32 * MB); p.mixed = (bfr*)take(32 * MB); p.ob = (bfr*)take(96 * MB);
  p.lse = (float*)take((size_t)3 * T_TOK * 8 * 4);
  const size_t end1 = off;
  off = r2;
  p.xres = (float*)take(128 * MB); p.pq = (bfr*)take(64 * MB); p.x2b = p.pq; p.qc = (bfr*)take(16 * MB); p.oc = (bfr*)take(16 * MB);
  p.idx = (int*)take(8 * MB); p.gates = (float*)take(8 * MB);
  const size_t end2 = off;
  const size_t need = end1 > end2 ? end1 : end2;
  if (need > ws_size) { fprintf(stderr, "workspace too small: need %zu have %zu\n", need, ws_size); return; }

  static int grid_blocks = 0;
  if (!grid_blocks) {
    int dev = 0, cus = 0, per_cu = 0;
    hipGetDevice(&dev);
    hipDeviceGetAttribute(&cus, hipDeviceAttributeMultiprocessorCount, dev);
    hipOccupancyMaxActiveBlocksPerMultiprocessor(&per_cu, mega, NTHREADS, 0);
    if (per_cu < 1) per_cu = 1;
    if (per_cu > 1) per_cu = 1;
    grid_blocks = cus * per_cu;
  }
  hipMemsetAsync(p.bar, 0, 256, stream);
#if MULTI_LAUNCH
  for (int ph = 0; ph < NPHASE; ++ph) hipLaunchKernelGGL(mega, dim3(grid_blocks), dim3(NTHREADS), 0, stream, p, ph, ph + 1);
#else
  int lo = 0, hi = NPHASE;
  void* args[] = {&p, &lo, &hi};
  hipError_t e = hipLaunchCooperativeKernel((void*)mega, dim3(grid_blocks), dim3(NTHREADS), args, 0, stream);
  if (e != hipSuccess) fprintf(stderr, "cooperative launch failed: %s (grid %d)\n", hipGetErrorString(e), grid_blocks);
#endif
}
```

```cpp
#include <hip/hip_runtime.h>
#include <hip/hip_cooperative_groups.h>
#include <stdint.h>
#include <stdio.h>
namespace cg = cooperative_groups;

#ifndef ABL
#define ABL 0
#endif
#ifndef DUP_MASK
#define DUP_MASK 0
#endif
#ifndef MULTI_LAUNCH
#define MULTI_LAUNCH 0
#endif

#define DI __device__ __forceinline__
typedef unsigned short bfr;
using bf16x8 = __attribute__((ext_vector_type(8))) short;
using s16x4  = __attribute__((ext_vector_type(4))) short;
using f32x4  = __attribute__((ext_vector_type(4))) float;
using u32x4  = __attribute__((ext_vector_type(4))) unsigned;
using u32x2  = __attribute__((ext_vector_type(2))) unsigned;
using bf2    = __attribute__((ext_vector_type(2))) __bf16;
using f32x2  = __attribute__((ext_vector_type(2))) float;
using v6u    = __attribute__((ext_vector_type(6))) unsigned;
using v16f   = __attribute__((ext_vector_type(16))) float;
using v32f   = __attribute__((ext_vector_type(32))) float;

constexpr int T_TOK = 16384;
constexpr int NTHREADS = 512;
constexpr int SMEM_BYTES = 151552;
constexpr int NPHASE = 13;

struct Params {
  const float *x, *mem; const int* pos;
  const float *g_mix, *w_in, *w_pool, *pool_scale, *w_out, *g_cross, *g_mem, *w_cq, *w_ck, *w_cv, *w_co, *g_ffn, *w_pq,
              *sk1f, *sk2f, *w_u, *w_v, *g_final;
  float* out;
  bfr *wInT, *wPoolT, *wOutT, *wCqT, *wCkT, *wCvT, *wCoT, *wPqT, *sk1, *sk2;
  unsigned char *wU8, *wV8; float *su, *sv;
  bfr *hbuf, *memn, *kc, *vc;
  bfr *pbuf, *qbuf, *kbuf, *vbuf, *mixed, *ob; float* lse;
  float* xres; bfr *pq, *qc, *oc; int* idx; float* gates;
  unsigned* bar;
  float *rowss1, *rowss2; bfr* x2b;
};

DI unsigned pack2(float a, float b) { bf2 p; p[0] = (__bf16)a; p[1] = (__bf16)b; return __builtin_bit_cast(unsigned, p); }
DI float bflo(unsigned u) { return __uint_as_float(u << 16); }
DI float bfhi(unsigned u) { return __uint_as_float(u & 0xffff0000u); }
DI float wave_sum(float v) {
#pragma unroll
  for (int o = 32; o >= 1; o >>= 1) v += __shfl_xor(v, o);
  return v;
}
DI f32x4 mfma16(bf16x8 a, bf16x8 b, f32x4 c) { return __builtin_amdgcn_mfma_f32_16x16x32_bf16(a, b, c, 0, 0, 0); }
DI s16x4 tr_read(const char* p) {
  return __builtin_amdgcn_ds_read_tr16_b64_v4i16((s16x4 __attribute__((address_space(3)))*)(p));
}

DI void gemm_main(const bfr* __restrict__ A, int lda, const bfr* __restrict__ Bt, int ldb, int K, char* smem,
                  f32x4 (&acc)[4][4]) {
  const int tid = threadIdx.x, lane = tid & 63, wid = tid >> 6, wm = wid >> 1, wn = wid & 1, fr = lane & 15, fq = lane >> 4;
  const int lrow = tid >> 3, lc = tid & 7;
  const int sw = ((lc ^ (lrow & 7)) << 4);
  u32x4 ra[4], rb[2];
  const bfr* ga = A + (size_t)lrow * lda + lc * 8;
  const bfr* gb = Bt + (size_t)lrow * ldb + lc * 8;
#pragma unroll
  for (int m = 0; m < 4; ++m)
#pragma unroll
    for (int n = 0; n < 4; ++n) acc[m][n] = f32x4{0.f, 0.f, 0.f, 0.f};
  const int nk = K >> 6;
#pragma unroll
  for (int i = 0; i < 4; ++i) ra[i] = *(const u32x4*)(ga + (size_t)(64 * i) * lda);
#pragma unroll
  for (int i = 0; i < 2; ++i) rb[i] = *(const u32x4*)(gb + (size_t)(64 * i) * ldb);
  __syncthreads();
#pragma unroll
  for (int i = 0; i < 4; ++i) *(u32x4*)(smem + (lrow + 64 * i) * 128 + sw) = ra[i];
#pragma unroll
  for (int i = 0; i < 2; ++i) *(u32x4*)(smem + 32768 + (lrow + 64 * i) * 128 + sw) = rb[i];
  __syncthreads();
  for (int kt = 0; kt < nk; ++kt) {
    const char* cur = smem + (kt & 1) * 49152;
    char* nxt = smem + ((kt + 1) & 1) * 49152;
    const bool more = (kt + 1 < nk);
    if (more) {
#pragma unroll
      for (int i = 0; i < 4; ++i) ra[i] = *(const u32x4*)(ga + (size_t)(64 * i) * lda + (kt + 1) * 64);
#pragma unroll
      for (int i = 0; i < 2; ++i) rb[i] = *(const u32x4*)(gb + (size_t)(64 * i) * ldb + (kt + 1) * 64);
    }
#pragma unroll
    for (int kk = 0; kk < 2; ++kk) {
      bf16x8 af[4], bf[4];
      const int co = (((kk * 4 + fq) ^ (fr & 7)) << 4);
#pragma unroll
      for (int m = 0; m < 4; ++m) af[m] = *(const bf16x8*)(cur + (wm * 64 + m * 16 + fr) * 128 + co);
#pragma unroll
      for (int n = 0; n < 4; ++n) bf[n] = *(const bf16x8*)(cur + 32768 + (wn * 64 + n * 16 + fr) * 128 + co);
#pragma unroll
      for (int m = 0; m < 4; ++m)
#pragma unroll
        for (int n = 0; n < 4; ++n) acc[m][n] = mfma16(bf[n], af[m], acc[m][n]);
    }
    if (more) {
#pragma unroll
      for (int i = 0; i < 4; ++i) *(u32x4*)(nxt + (lrow + 64 * i) * 128 + sw) = ra[i];
#pragma unroll
      for (int i = 0; i < 2; ++i) *(u32x4*)(nxt + 32768 + (lrow + 64 * i) * 128 + sw) = rb[i];
    }
    __syncthreads();
  }
}

DI void tile_map(int id, int MT, int NT, int& mt, int& nt) {
  if ((NT & 7) == 0 && (MT & 31) == 0) {
    const int round = id >> 8, local = id & 255, xcd = local & 7, j = local >> 3, mtl = j & 3, ntl = j >> 2;
    const int MR = MT >> 5;
    const int mr = round % MR, nr = round / MR;
    mt = mr * 32 + xcd * 4 + mtl;
    nt = nr * 8 + ntl;
  } else {
    mt = id % MT;
    nt = id / MT;
  }
}


#define LAS __attribute__((address_space(3)))
namespace g8 {
constexpr int BM = 256, BK = 64, HALF = 128, HTB = HALF * BK * 2, NXCD = 8, WGM = 8;
DI int lds_byte(int r, int c) { const int st = (r >> 4) * 2 + (c >> 5), rr = r & 15, cc = c & 31, ob = rr * 64 + cc * 2; return st * 1024 + (ob ^ (((ob >> 9) & 1) << 5)); }
DI void stage_rc(int b, int& R, int& C) { const int st = b / 1024, sb = b % 1024, swz = sb ^ (((sb >> 9) & 1) << 5); R = (st >> 1) * 16 + swz / 64; C = (st & 1) * 32 + (swz % 64) / 2; }
struct Order {
  int nM, nN, nwg, G, c;
  DI void init(int M, int N, int G_, int c_) { nM = M / BM; nN = N / BM; nwg = nM * nN; G = G_; c = c_; }
  DI bool next(int i, int& pm, int& pn) const {
    const long L = (long)i * G + c; if (L >= nwg) return false;
    int wgid = (int)L; { const int q = nwg / NXCD, r = nwg % NXCD, xcd = wgid % NXCD, off = wgid / NXCD; wgid = (xcd < r ? xcd * (q + 1) : r * (q + 1) + (xcd - r) * q) + off; }
    const int nig = WGM * nN, gid = wgid / nig, fm = gid * WGM, gsz = (nM - fm) < WGM ? (nM - fm) : WGM;
    pm = fm + ((wgid % nig) % gsz); pn = (wgid % nig) / gsz; return true;
  }
};
}

template <class Epi>
DI void gemm8(LAS unsigned char* lds, const bfr* A, int lda, const bfr* Bt, int M, int N, int K, int G, int c, const Epi& E, int a_pn_bytes = 0) {
  using namespace g8;
  const int tid = threadIdx.x, wid = __builtin_amdgcn_readfirstlane(tid >> 6), lane = tid & 63, wr = wid >> 2, wc = wid & 3, fr = lane & 15, fq = lane >> 4;
  const int nt = K / BK;
  Order S; S.init(M, N, G, c);
  unsigned voffA[2], voffB[2];
#pragma unroll
  for (int i = 0; i < 2; ++i) { int R, C; stage_rc(tid * 16 + i * 8192, R, C); voffA[i] = (unsigned)(R * lda + C) * 2u; voffB[i] = (unsigned)(R * K + C) * 2u; }
  const size_t kstep = (size_t)(BK * 2);
  const size_t hstepA = (size_t)HALF * lda * 2, hstepB = (size_t)HALF * K * 2;
  const size_t tstepA = 2 * hstepA, tstepB = 2 * hstepB;
  const unsigned ldsw = (unsigned)wid * 1024u;
  const int aoff = lds_byte(wr * 64 + fr, fq * 8), boff = lds_byte(wc * 32 + fr, fq * 8);
#define G8_SA(b, h) (((b) * 2 + (h)) * HTB)
#define G8_SB(b, h) ((4 + (b) * 2 + (h)) * HTB)
#define G8_STAGE(bufoff, gbase, voff) do { _Pragma("unroll") for (int _i = 0; _i < 2; ++_i) \
    __builtin_amdgcn_global_load_lds((const unsigned*)((const char*)(gbase) + (voff)[_i]), (LAS unsigned*)(lds + (bufoff) + ldsw + _i * 8192), 16, 0, 0); } while (0)
#define G8_LDA(dst, b, h) do { _Pragma("unroll") for (int m = 0; m < 4; ++m) _Pragma("unroll") for (int k = 0; k < 2; ++k) dst[m][k] = *(const LAS bf16x8*)(lds + G8_SA(b, h) + aoff + m * 2048 + k * 1024); } while (0)
#define G8_LDB(dst, b, h) do { _Pragma("unroll") for (int n = 0; n < 2; ++n) _Pragma("unroll") for (int k = 0; k < 2; ++k) dst[n][k] = *(const LAS bf16x8*)(lds + G8_SB(b, h) + boff + n * 2048 + k * 1024); } while (0)
#define G8_MMA(ai, bj, At, Btf) do { __builtin_amdgcn_s_setprio(1); _Pragma("unroll") for (int m = 0; m < 4; ++m) _Pragma("unroll") for (int n = 0; n < 2; ++n) _Pragma("unroll") for (int k = 0; k < 2; ++k) \
    acc[ai][bj][m][n] = __builtin_amdgcn_mfma_f32_16x16x32_bf16(Btf[n][k], At[m][k], acc[ai][bj][m][n], 0, 0, 0); __builtin_amdgcn_s_setprio(0); } while (0)
#define G8_WAIT_V(n) asm volatile("s_waitcnt vmcnt(" #n ")" ::: "memory")
#define G8_WAIT_L(n) asm volatile("s_waitcnt lgkmcnt(" #n ")" ::: "memory")
#define G8_BAR __builtin_amdgcn_s_barrier()
#define G8_SCHED __builtin_amdgcn_sched_barrier(0)
  int cpm, cpn, npm = 0, npn = 0, ui = 0;
  if (!S.next(0, cpm, cpn)) return;
  f32x4 acc[2][2][4][2];
#pragma unroll
  for (int a = 0; a < 2; ++a)
#pragma unroll
    for (int b = 0; b < 2; ++b)
#pragma unroll
      for (int m = 0; m < 4; ++m)
#pragma unroll
        for (int n = 0; n < 2; ++n) acc[a][b][m][n] = f32x4{0.f, 0.f, 0.f, 0.f};
  bf16x8 At[4][2], B0[2][2], B1[2][2];
  const char* cA = (const char*)A + (size_t)cpm * tstepA + (size_t)cpn * a_pn_bytes; const char* cB = (const char*)Bt + (size_t)cpn * tstepB;
  G8_STAGE(G8_SB(0, 0), cB, voffB); G8_STAGE(G8_SA(0, 0), cA, voffA); G8_STAGE(G8_SB(0, 1), cB + hstepB, voffB); G8_STAGE(G8_SA(0, 1), cA + hstepA, voffA);
  if (wr == 1) G8_BAR;
  G8_WAIT_V(4); G8_BAR;
  G8_STAGE(G8_SB(1, 0), cB + kstep, voffB); G8_STAGE(G8_SA(1, 0), cA + kstep, voffA); G8_STAGE(G8_SB(1, 1), cB + hstepB + kstep, voffB);
  G8_WAIT_V(6); G8_BAR;
  for (;;) {
    const bool has_next = S.next(ui + 1, npm, npn);
    const char* nA = has_next ? (const char*)A + (size_t)npm * tstepA + (size_t)npn * a_pn_bytes : cA; const char* nB = has_next ? (const char*)Bt + (size_t)npn * tstepB : cB;
    for (int t = 0; t < nt; t += 2) {
      const bool last = (t == nt - 2);
      const char* a1 = cA + (size_t)(t + 1) * kstep;
      const char* a2 = last ? nA : cA + (size_t)(t + 2) * kstep; const char* b2 = last ? nB : cB + (size_t)(t + 2) * kstep;
      const char* a3 = a2 + kstep; const char* b3 = b2 + kstep;
      G8_LDB(B0, 0, 0); G8_SCHED; G8_LDA(At, 0, 0); G8_STAGE(G8_SA(1, 1), a1 + hstepA, voffA);
      G8_WAIT_L(8); G8_BAR; G8_WAIT_L(0); G8_MMA(0, 0, At, B0); G8_BAR; G8_SCHED;
      G8_LDB(B1, 0, 1); G8_STAGE(G8_SB(0, 0), b2, voffB);
      G8_BAR; G8_WAIT_L(0); G8_MMA(0, 1, At, B1); G8_BAR;
      G8_LDA(At, 0, 1); G8_STAGE(G8_SA(0, 0), a2, voffA);
      G8_BAR; G8_WAIT_L(0); G8_MMA(1, 0, At, B0); G8_BAR; G8_SCHED;
      G8_STAGE(G8_SB(0, 1), b2 + hstepB, voffB);
      G8_WAIT_V(6); G8_BAR; G8_MMA(1, 1, At, B1); G8_BAR;
      G8_LDB(B0, 1, 0); G8_SCHED; G8_LDA(At, 1, 0); G8_STAGE(G8_SA(0, 1), a2 + hstepA, voffA);
      G8_WAIT_L(8); G8_BAR; G8_WAIT_L(0); G8_MMA(0, 0, At, B0); G8_BAR; G8_SCHED;
      G8_LDB(B1, 1, 1); G8_STAGE(G8_SB(1, 0), b3, voffB);
      G8_BAR; G8_WAIT_L(0); G8_MMA(0, 1, At, B1); G8_BAR;
      G8_LDA(At, 1, 1); G8_STAGE(G8_SA(1, 0), a3, voffA);
      G8_BAR; G8_WAIT_L(0); G8_MMA(1, 0, At, B0); G8_BAR; G8_SCHED;
      G8_STAGE(G8_SB(1, 1), b3 + hstepB, voffB);
      G8_WAIT_V(6); G8_BAR; G8_MMA(1, 1, At, B1); G8_BAR;
    }
    E(acc, cpm, cpn, wr, wc, fr, fq);
    if (!has_next) break;
#pragma unroll
    for (int a = 0; a < 2; ++a)
#pragma unroll
      for (int b = 0; b < 2; ++b)
#pragma unroll
        for (int m = 0; m < 4; ++m)
#pragma unroll
          for (int n = 0; n < 2; ++n) acc[a][b][m][n] = f32x4{0.f, 0.f, 0.f, 0.f};
    cpm = npm; cpn = npn; cA = nA; cB = nB; ++ui;
  }
  G8_WAIT_V(0);
  if (wr == 0) G8_BAR;
  G8_BAR;
#undef G8_SA
#undef G8_SB
#undef G8_STAGE
#undef G8_LDA
#undef G8_LDB
#undef G8_MMA
#undef G8_WAIT_V
#undef G8_WAIT_L
#undef G8_BAR
#undef G8_SCHED
}
#define G8_FOREACH(acc, pm, pn, wr, wc, fr, fq, ai, bj, m, n, row, col) \
  _Pragma("unroll") for (int ai = 0; ai < 2; ++ai) _Pragma("unroll") for (int m = 0; m < 4; ++m) \
  _Pragma("unroll") for (int bj = 0; bj < 2; ++bj) _Pragma("unroll") for (int n = 0; n < 2; ++n) \
    if (const int row = 256 * (pm) + 128 * ai + 64 * (wr) + 16 * m + (fr); true) if (const int col = 256 * (pn) + 128 * bj + 32 * (wc) + 16 * n + 4 * (fq); true)
typedef f32x4 Acc8[2][2][4][2];

template <bool BANDED, class StoreF>
DI void attn_core(const bfr* __restrict__ Qb, int qstride, int q0, const bfr* __restrict__ Kb, const bfr* __restrict__ Vb,
                  int kvstride, int key0, char* smem, StoreF store, float& m_out, float& l_out) {
  const int tid = threadIdx.x, lane = tid & 63, w = tid >> 6, fr = lane & 15, fq = lane >> 4;
  char* sK = smem;
  char* sV = smem + 65536;
  __syncthreads();
#pragma unroll 1
  for (int rr = 0; rr < 2; ++rr) {
    u32x4 kr[4], vr[4];
#pragma unroll
    for (int i = 0; i < 4; ++i) {
      const int id = tid + (rr * 4 + i) * 512, key = id >> 4, c = id & 15, lk = key0 + key;
      kr[i] = u32x4{0u, 0u, 0u, 0u};
      vr[i] = u32x4{0u, 0u, 0u, 0u};
      if (lk >= 0) {
        kr[i] = *(const u32x4*)(Kb + (long)lk * kvstride + c * 8);
        vr[i] = *(const u32x4*)(Vb + (long)lk * kvstride + c * 8);
      }
    }
#pragma unroll
    for (int i = 0; i < 4; ++i) {
      const int id = tid + (rr * 4 + i) * 512, key = id >> 4, c = id & 15;
      *(u32x4*)(sK + key * 256 + ((c ^ (key & 15)) << 4)) = kr[i];
      *(u32x4*)(sV + key * 288 + c * 16) = vr[i];
    }
  }
  bf16x8 qf[4];
  {
    const bfr* qrow = Qb + (long)(q0 + w * 16 + fr) * qstride;
#pragma unroll
    for (int kk = 0; kk < 4; ++kk) qf[kk] = *(const bf16x8*)(qrow + kk * 32 + fq * 8);
  }
  __syncthreads();
  constexpr int NT = BANDED ? 10 : 16;
  const int t0 = BANDED ? (w & ~1) : 0;
  f32x4 s[NT];
#pragma unroll
  for (int j = 0; j < NT; ++j) {
    f32x4 a = f32x4{0.f, 0.f, 0.f, 0.f};
    const int key = (t0 + j) * 16 + fr;
#pragma unroll
    for (int kk = 0; kk < 4; ++kk) {
      const bf16x8 kf = *(const bf16x8*)(sK + key * 256 + (((kk * 4 + fq) ^ fr) << 4));
      a = mfma16(kf, qf[kk], a);
    }
    s[j] = a;
  }
  const float L2E = 1.4426950408889634f;
  const float NINF = -__builtin_inff();
  float mx = NINF;
  const int lq = q0 + w * 16 + fr;
#pragma unroll
  for (int j = 0; j < NT; ++j)
#pragma unroll
    for (int i = 0; i < 4; ++i) {
      float v = s[j][i] * L2E;
      if (BANDED) {
        const int lk = key0 + (t0 + j) * 16 + fq * 4 + i;
        const int dist = lq - lk;
        const bool ok = (lk >= 0) && (dist >= 0) && (dist <= 128);
        v = ok ? v : NINF;
      }
      s[j][i] = v;
      mx = fmaxf(mx, v);
    }
  mx = fmaxf(mx, __shfl_xor(mx, 16));
  mx = fmaxf(mx, __shfl_xor(mx, 32));
  float l = 0.f;
#pragma unroll
  for (int j = 0; j < NT; ++j)
#pragma unroll
    for (int i = 0; i < 4; ++i) {
      const float p = __builtin_amdgcn_exp2f(s[j][i] - mx);
      s[j][i] = p;
      l += p;
    }
  l += __shfl_xor(l, 16);
  l += __shfl_xor(l, 32);
  bf16x8 pf[NT / 2];
#pragma unroll
  for (int c = 0; c < NT / 2; ++c) {
    u32x4 t;
    t[0] = pack2(s[2 * c][0], s[2 * c][1]);
    t[1] = pack2(s[2 * c][2], s[2 * c][3]);
    t[2] = pack2(s[2 * c + 1][0], s[2 * c + 1][1]);
    t[3] = pack2(s[2 * c + 1][2], s[2 * c + 1][3]);
    pf[c] = __builtin_bit_cast(bf16x8, t);
  }
  const int q4 = (lane & 15) >> 2, p4 = lane & 3;
  m_out = mx;
  l_out = l;
#pragma unroll 2
  for (int dt = 0; dt < 8; ++dt) {
    f32x4 a = f32x4{0.f, 0.f, 0.f, 0.f};
#pragma unroll
    for (int c = 0; c < NT / 2; ++c) {
      const int kb = (t0 + 2 * c) * 16;
      const s16x4 lo = tr_read(sV + (kb + fq * 4 + q4) * 288 + (dt * 16 + p4 * 4) * 2);
      const s16x4 hi = tr_read(sV + (kb + 16 + fq * 4 + q4) * 288 + (dt * 16 + p4 * 4) * 2);
      const bf16x8 vf = __builtin_shufflevector(lo, hi, 0, 1, 2, 3, 4, 5, 6, 7);
      a = mfma16(vf, pf[c], a);
    }
    store(dt, a, l);
  }
}

DI int f2sort(float f) { int b = __float_as_int(f); return b ^ ((b >> 31) & 0x7fffffff); }
DI float sort2f(int s) { int b = s ^ ((s >> 31) & 0x7fffffff); return __int_as_float(b); }
DI void topk_insert(int (&lst)[16], int key) {
#pragma unroll
  for (int j = 0; j < 16; ++j) {
    const int hi = max(lst[j], key);
    key = min(lst[j], key);
    lst[j] = hi;
  }
}

template <int O, int N>
DI void bfly(float (&p)[64], int lane) {
  const bool up = (lane & O) != 0;
#pragma unroll
  for (int i = 0; i < N / 2; ++i) {
    const float keep = up ? p[i + N / 2] : p[i];
    const float send = up ? p[i] : p[i + N / 2];
    p[i] = keep + __shfl_xor(send, O);
  }
  if constexpr (O > 1) bfly<O / 2, N / 2>(p, lane);
}

DI void rms_row_to_bf16(const float* __restrict__ x, const float* __restrict__ g, bfr* __restrict__ out, int lane) {
  float4 v[8];
  float ss = 0.f;
#pragma unroll
  for (int j = 0; j < 8; ++j) {
    v[j] = *(const float4*)(x + j * 256 + lane * 4);
    ss += v[j].x * v[j].x + v[j].y * v[j].y + v[j].z * v[j].z + v[j].w * v[j].w;
  }
  ss = wave_sum(ss);
  const float rs = rsqrtf(ss * (1.f / 2048.f) + 1e-6f);
#pragma unroll
  for (int j = 0; j < 8; ++j) {
    const float4 gg = *(const float4*)(g + j * 256 + lane * 4);
    u32x2 o;
    o[0] = pack2(v[j].x * rs * gg.x, v[j].y * rs * gg.y);
    o[1] = pack2(v[j].z * rs * gg.z, v[j].w * rs * gg.w);
    *(u32x2*)(out + j * 256 + lane * 4) = o;
  }
}

DI void transpose_tile(const float* __restrict__ W, int K, int N, int k0, int n0, bfr* __restrict__ Wt, float* tile, const float* colscale, const float* rowscale) {
  __syncthreads();
  {
    const int r = threadIdx.x >> 4, c4 = threadIdx.x & 15;
#pragma unroll
    for (int i = 0; i < 2; ++i) {
      const int k = r + 32 * i;
      const float4 v = *(const float4*)(W + (size_t)(k0 + k) * N + n0 + c4 * 4);
      tile[k * 65 + c4 * 4 + 0] = v.x;
      tile[k * 65 + c4 * 4 + 1] = v.y;
      tile[k * 65 + c4 * 4 + 2] = v.z;
      tile[k * 65 + c4 * 4 + 3] = v.w;
    }
  }
  __syncthreads();
  {
    const int n = threadIdx.x >> 3, kc = threadIdx.x & 7;
    u32x4 o;
    const float csv = colscale ? colscale[n0 + n] : 1.0f;
#pragma unroll
    for (int j = 0; j < 4; ++j) {
      const float r0 = rowscale ? rowscale[k0 + kc * 8 + 2 * j] : 1.0f, r1 = rowscale ? rowscale[k0 + kc * 8 + 2 * j + 1] : 1.0f;
      o[j] = pack2(tile[(kc * 8 + 2 * j) * 65 + n] * csv * r0, tile[(kc * 8 + 2 * j + 1) * 65 + n] * csv * r1);
    }
    *(u32x4*)(Wt + (size_t)(n0 + n) * K + k0 + kc * 8) = o;
  }
}

DI void convert_f32_bf16(const float* __restrict__ src, bfr* __restrict__ dst, long n8) {
  for (long i = (long)blockIdx.x * NTHREADS + threadIdx.x; i < n8; i += (long)gridDim.x * NTHREADS) {
    const float4 a = *(const float4*)(src + i * 8);
    const float4 b = *(const float4*)(src + i * 8 + 4);
    u32x4 o;
    o[0] = pack2(a.x, a.y); o[1] = pack2(a.z, a.w); o[2] = pack2(b.x, b.y); o[3] = pack2(b.z, b.w);
    *(u32x4*)(dst + i * 8) = o;
  }
}

DI void phase_prep(const Params& p, char* smem) {
  const int lane = threadIdx.x & 63, wid = threadIdx.x >> 6;
  for (int r = blockIdx.x * 8 + wid; r < T_TOK + 1024; r += gridDim.x * 8) {
    if (r < T_TOK) rms_row_to_bf16(p.x + (size_t)r * 2048, p.g_mix, p.hbuf + (size_t)r * 2048, lane);
    else rms_row_to_bf16(p.mem + (size_t)(r - T_TOK) * 2048, p.g_mem, p.memn + (size_t)(r - T_TOK) * 2048, lane);
  }
  float* tile = (float*)smem;
  for (int id0 = blockIdx.x; id0 < 5184; id0 += gridDim.x) {
    int id = id0;
    const float* W; bfr* Wt; int K, N; const float* cs = nullptr; const float* rsc = nullptr;
    if (id < 2048) { W = p.w_in; Wt = p.wInT; K = 2048; N = 4096; }
    else if ((id -= 2048) < 1024) { W = p.w_out; Wt = p.wOutT; K = 2048; N = 2048; }
    else if ((id -= 1024) < 1024) { W = p.w_pq; Wt = p.wPqT; K = 2048; N = 2048; rsc = p.g_ffn; }
    else if ((id -= 1024) < 256) { W = p.w_cq; Wt = p.wCqT; K = 2048; N = 512; rsc = p.g_cross; }
    else if ((id -= 256) < 256) { W = p.w_ck; Wt = p.wCkT; K = 2048; N = 512; }
    else if ((id -= 256) < 256) { W = p.w_cv; Wt = p.wCvT; K = 2048; N = 512; }
    else if ((id -= 256) < 256) { W = p.w_co; Wt = p.wCoT; K = 512; N = 2048; }
    else { id -= 256; const int g = id >> 4; id &= 15; W = p.w_pool + g * 65536; Wt = p.wPoolT + g * 65536; K = 256; N = 256; cs = p.pool_scale + g * 256; }
    const int ntn = N >> 6;
    const int kt = id / ntn, nt = id % ntn;
    transpose_tile(W, K, N, kt * 64, nt * 64, Wt, tile, cs, rsc);
  }
  for (int i = blockIdx.x * NTHREADS + threadIdx.x; i < T_TOK; i += gridDim.x * NTHREADS) { p.rowss1[i] = 0.f; p.rowss2[i] = 0.f; }
  convert_f32_bf16(p.sk1f, p.sk1, 128 * 128 / 8);
  convert_f32_bf16(p.sk2f, p.sk2, 128 * 128 / 8);
  for (int r = blockIdx.x * 8 + wid; r < 2 * 16384; r += gridDim.x * 8) {
    const bool isv = r >= 16384;
    const int rr = isv ? r - 16384 : r;
    const float* src = (isv ? p.w_v : p.w_u) + (size_t)rr * 2048;
    float4 v[8];
    float amax = 0.f;
#pragma unroll
    for (int j = 0; j < 2; ++j)
#pragma unroll
      for (int q = 0; q < 4; ++q) {
        v[j * 4 + q] = *(const float4*)(src + j * 1024 + lane * 16 + q * 4);
        if (!isv) {
          const float4 gg = *(const float4*)(p.g_ffn + j * 1024 + lane * 16 + q * 4);
          v[j * 4 + q].x *= gg.x; v[j * 4 + q].y *= gg.y; v[j * 4 + q].z *= gg.z; v[j * 4 + q].w *= gg.w;
        }
        const float4 t = v[j * 4 + q];
        amax = fmaxf(amax, fmaxf(fmaxf(fabsf(t.x), fabsf(t.y)), fmaxf(fabsf(t.z), fabsf(t.w))));
      }
#pragma unroll
    for (int o = 32; o >= 1; o >>= 1) amax = fmaxf(amax, __shfl_xor(amax, o));
    {
      const float inv = amax > 0.f ? 6.0f / amax : 0.f;
      if (lane == 0) (isv ? p.sv : p.su)[rr] = amax * (1.f / 6.0f);
      u32x4 o4;
#pragma unroll
      for (int c = 0; c < 4; ++c) {
        const float4 t0 = v[2 * c], t1 = v[2 * c + 1];
        unsigned w = 0;
        w = __builtin_amdgcn_cvt_scalef32_pk_fp4_f32(w, t0.x * inv, t0.y * inv, 1.0f, 0);
        w = __builtin_amdgcn_cvt_scalef32_pk_fp4_f32(w, t0.z * inv, t0.w * inv, 1.0f, 1);
        w = __builtin_amdgcn_cvt_scalef32_pk_fp4_f32(w, t1.x * inv, t1.y * inv, 1.0f, 2);
        w = __builtin_amdgcn_cvt_scalef32_pk_fp4_f32(w, t1.z * inv, t1.w * inv, 1.0f, 3);
        o4[c] = w;
      }
      *(u32x4*)((isv ? p.wV8 : p.wU8) + (size_t)rr * 1024 + lane * 16) = o4;
    }
  }
}

DI void phase_inproj(const Params& p, char* smem) {
  auto epi = [&](const Acc8& acc0, int pm, int pn, int wr, int wc, int fr, int fq) {
    const int region = pn >> 2;
    if (region == 0) {
      G8_FOREACH(acc0, pm, pn, wr, wc, fr, fq, ai, bj, m, n, row, col) {
        const f32x4 v = acc0[ai][bj][m][n];
        u32x2 o; o[0] = pack2(v[0], v[1]); o[1] = pack2(v[2], v[3]);
        *(u32x2*)(p.pbuf + (size_t)row * 1024 + col) = o;
      }
    } else {
      bfr* dst = (region == 1) ? p.qbuf : (region == 2 ? p.kbuf : p.vbuf);
      const float scale = (region == 1) ? 0.08838834764831845f : 1.0f;
      const bool rope = (region != 3) && (wc == 0);
#pragma unroll
      for (int ai = 0; ai < 2; ++ai)
#pragma unroll
        for (int m = 0; m < 4; ++m) {
          const int row = 256 * pm + 128 * ai + 64 * wr + 16 * m + fr;
          const int b = row >> 12, t = row & 4095;
          float sn[4], cs[4];
          if (rope) {
            const float posf = (float)p.pos[row];
#pragma unroll
            for (int i = 0; i < 4; ++i) {
              const int j = fq * 4 + i;
              const float inv = exp2f(-(float)j * (18.931568569324174f / 16.0f));
              sincosf(posf * inv, &sn[i], &cs[i]);
            }
          }
#pragma unroll
          for (int bj = 0; bj < 2; ++bj) {
            const int h = (pn & 3) * 2 + bj;
            f32x4 v0 = acc0[ai][bj][m][0], v1 = acc0[ai][bj][m][1];
            if (rope) {
#pragma unroll
              for (int i = 0; i < 4; ++i) {
                const float x1 = v0[i], x2 = v1[i];
                v0[i] = x1 * cs[i] - x2 * sn[i];
                v1[i] = x2 * cs[i] + x1 * sn[i];
              }
            }
            bfr* drow = dst + ((size_t)((b * 8 + h) * 4096 + t)) * 128 + 32 * wc + 4 * fq;
            u32x2 o0, o1;
            o0[0] = pack2(v0[0] * scale, v0[1] * scale); o0[1] = pack2(v0[2] * scale, v0[3] * scale);
            o1[0] = pack2(v1[0] * scale, v1[1] * scale); o1[1] = pack2(v1[2] * scale, v1[3] * scale);
            *(u32x2*)(drow) = o0;
            *(u32x2*)(drow + 16) = o1;
          }
        }
    }
  };
  gemm8((LAS unsigned char*)smem, p.hbuf, 2048, p.wInT, T_TOK, 4096, 2048, gridDim.x, blockIdx.x, epi);
}

DI void phase_mix_attn(const Params& p, char* smem) {
  const int tid = threadIdx.x, lane = tid & 63, w = tid >> 6, fr = lane & 15, fq = lane >> 4;
  for (int id = blockIdx.x; id < 3072 + 256; id += gridDim.x) {
    if (id < 3072) {
      const int br = id >> 10, rem = id & 1023;
      const int dl = (br == 0) ? 1 : (br == 1 ? 4 : 16);
      const int nblk = 32 / dl;
      const int bh = rem >> 5, rn = rem & 31;
      const int r = rn / nblk, nb = rn % nblk;
      const int l0 = nb * 128;
      const size_t base = (size_t)bh * 4096 * 128 + (size_t)r * 128;
      float mx, l;
      const int b = bh >> 3, h = bh & 7;
      const int tt = b * 4096 + (l0 + w * 16 + fr) * dl + r;
      bfr* dst = p.ob + (size_t)br * T_TOK * 1024 + (size_t)tt * 1024 + h * 128 + fq * 4;
      attn_core<true>(p.qbuf + base, dl * 128, l0, p.kbuf + base, p.vbuf + base, dl * 128, l0 - 128, smem,
                      [&](int dt, f32x4 a, float lsum) {
                        const float il = 1.f / lsum;
                        u32x2 v; v[0] = pack2(a[0] * il, a[1] * il); v[1] = pack2(a[2] * il, a[3] * il);
                        *(u32x2*)(dst + dt * 16) = v;
                      }, mx, l);
      if (fq == 0) p.lse[(size_t)br * T_TOK * 8 + (size_t)tt * 8 + h] = mx + __builtin_amdgcn_logf(l);
    } else {
      const int ci = id - 3072;
      const int sub = tid >> 7, cgp = tid & 127;
      const int wdw = 2 << (cgp >> 5);
      const int t0 = ci * 64 + sub * 16, tin0 = t0 & 4095;
      const bfr* pb = p.pbuf + cgp * 8;
      float sum[8];
#pragma unroll
      for (int e = 0; e < 8; ++e) sum[e] = 0.f;
      for (int j = 1; j < wdw; ++j) {
        if (tin0 - j >= 0) {
          const u32x4 v = *(const u32x4*)(pb + (size_t)(t0 - j) * 1024);
#pragma unroll
          for (int e = 0; e < 4; ++e) { sum[2 * e] += bflo(v[e]); sum[2 * e + 1] += bfhi(v[e]); }
        }
      }
      for (int s = 0; s < 16; ++s) {
        const int t = t0 + s, tin = tin0 + s;
        const u32x4 v = *(const u32x4*)(pb + (size_t)t * 1024);
        float cur[8];
#pragma unroll
        for (int e = 0; e < 4; ++e) { cur[2 * e] = bflo(v[e]); cur[2 * e + 1] = bfhi(v[e]); }
        const float ic = 1.f / (float)min(tin + 1, wdw);
        u32x4 ov;
#pragma unroll
        for (int e = 0; e < 8; ++e) sum[e] += cur[e];
#pragma unroll
        for (int e = 0; e < 4; ++e) ov[e] = pack2(sum[2 * e] * ic - cur[2 * e], sum[2 * e + 1] * ic - cur[2 * e + 1]);
        *(u32x4*)(p.mixed + (size_t)t * 1024 + cgp * 8) = ov;
        if (tin - wdw + 1 >= 0) {
          const u32x4 u = *(const u32x4*)(pb + (size_t)(t - wdw + 1) * 1024);
#pragma unroll
          for (int e = 0; e < 4; ++e) { sum[2 * e] -= bflo(u[e]); sum[2 * e + 1] -= bfhi(u[e]); }
        }
      }
    }
  }
}

DI void phase_pool_combine(const Params& p, char* smem) {
  const int tid = threadIdx.x;
  {
    auto epi = [&](const Acc8& acc0, int pm, int pn, int wr, int wc, int fr, int fq) {
      G8_FOREACH(acc0, pm, pn, wr, wc, fr, fq, ai, bj, m, n, row, col) {
        const f32x4 v = acc0[ai][bj][m][n];
        u32x2 o; o[0] = pack2(v[0], v[1]); o[1] = pack2(v[2], v[3]);
        *(u32x2*)(p.hbuf + (size_t)row * 2048 + col) = o;
      }
    };
    gemm8((LAS unsigned char*)smem, p.mixed, 1024, p.wPoolT, T_TOK, 1024, 256, gridDim.x, blockIdx.x, epi, 512);
  }
  for (long i = (long)blockIdx.x * NTHREADS + tid; i < (long)T_TOK * 8 * 16; i += (long)gridDim.x * NTHREADS) {
    const int dc = (int)(i & 15), h = (int)((i >> 4) & 7);
    const long tt = i >> 7;
    const float l0 = p.lse[tt * 8 + h], l1 = p.lse[(size_t)T_TOK * 8 + tt * 8 + h], l2 = p.lse[(size_t)2 * T_TOK * 8 + tt * 8 + h];
    const float mx = fmaxf(l0, fmaxf(l1, l2));
    float w0 = __builtin_amdgcn_exp2f(l0 - mx), w1 = __builtin_amdgcn_exp2f(l1 - mx), w2 = __builtin_amdgcn_exp2f(l2 - mx);
    const float inv = 1.f / (w0 + w1 + w2);
    w0 *= inv; w1 *= inv; w2 *= inv;
    if (ABL == 3) { w0 = 0.f; w1 = 0.f; w2 = 0.f; }
    const size_t off = (size_t)tt * 1024 + h * 128 + dc * 8;
    const u32x4 a = *(const u32x4*)(p.ob + off);
    const u32x4 b = *(const u32x4*)(p.ob + (size_t)T_TOK * 1024 + off);
    const u32x4 c = *(const u32x4*)(p.ob + (size_t)2 * T_TOK * 1024 + off);
    u32x4 o;
#pragma unroll
    for (int e = 0; e < 4; ++e)
      o[e] = pack2(w0 * bflo(a[e]) + w1 * bflo(b[e]) + w2 * bflo(c[e]), w0 * bfhi(a[e]) + w1 * bfhi(b[e]) + w2 * bfhi(c[e]));
    *(u32x4*)(p.hbuf + (size_t)tt * 2048 + 1024 + h * 128 + dc * 8) = o;
  }
}

DI void phase_gemm_resid(const bfr* A, int lda, const bfr* Bt, int K, const float* resid, float* xout, bfr* xb, float* rowss, char* smem) {
  auto epi = [&](const Acc8& acc0, int pm, int pn, int wr, int wc, int fr, int fq) {
#pragma unroll
    for (int ai = 0; ai < 2; ++ai)
#pragma unroll
      for (int m = 0; m < 4; ++m) {
        const int row = 256 * pm + 128 * ai + 64 * wr + 16 * m + fr;
        float ss = 0.f;
#pragma unroll
        for (int bj = 0; bj < 2; ++bj)
#pragma unroll
          for (int n = 0; n < 2; ++n) {
            const int col = 256 * pn + 128 * bj + 32 * wc + 16 * n + 4 * fq;
            const f32x4 v = acc0[ai][bj][m][n];
            const float4 r = *(const float4*)(resid + (size_t)row * 2048 + col);
            float4 o; o.x = r.x + v[0]; o.y = r.y + v[1]; o.z = r.z + v[2]; o.w = r.w + v[3];
            *(float4*)(xout + (size_t)row * 2048 + col) = o;
            u32x2 ob; ob[0] = pack2(o.x, o.y); ob[1] = pack2(o.z, o.w);
            *(u32x2*)(xb + (size_t)row * 2048 + col) = ob;
            ss += o.x * o.x + o.y * o.y + o.z * o.z + o.w * o.w;
          }
        ss += __shfl_xor(ss, 16);
        ss += __shfl_xor(ss, 32);
        if (fq == 0) atomicAdd(rowss + row, ss);
      }
  };
  gemm8((LAS unsigned char*)smem, A, lda, Bt, T_TOK, 2048, K, gridDim.x, blockIdx.x, epi);
}

DI void phase_rms(const float* xin, const float* g, bfr* out) {
  const int lane = threadIdx.x & 63, wid = threadIdx.x >> 6;
  for (int r = blockIdx.x * 8 + wid; r < T_TOK; r += gridDim.x * 8)
    rms_row_to_bf16(xin + (size_t)r * 2048, g, out + (size_t)r * 2048, lane);
}

DI void phase_gemm_pq(const Params& p, char* smem) {
  auto epi = [&](const Acc8& acc0, int pm, int pn, int wr, int wc, int fr, int fq) {
    G8_FOREACH(acc0, pm, pn, wr, wc, fr, fq, ai, bj, m, n, row, col) {
      const f32x4 v = acc0[ai][bj][m][n];
      const float rs = rsqrtf(p.rowss2[row] * (1.f / 2048.f) + 1e-6f);
      u32x2 o; o[0] = pack2(v[0] * rs, v[1] * rs); o[1] = pack2(v[2] * rs, v[3] * rs);
      *(u32x2*)(p.pq + (size_t)row * 2048 + col) = o;
    }
  };
  gemm8((LAS unsigned char*)smem, p.hbuf, 2048, p.wPqT, T_TOK, 2048, 2048, gridDim.x, blockIdx.x, epi);
}
DI void phase_cross_proj(const Params& p, char* smem) {
  const int half = gridDim.x >> 1;
  if ((int)blockIdx.x < half) {
    auto epi = [&](const Acc8& acc0, int pm, int pn, int wr, int wc, int fr, int fq) {
      G8_FOREACH(acc0, pm, pn, wr, wc, fr, fq, ai, bj, m, n, row, col) {
        const f32x4 v = acc0[ai][bj][m][n];
        const float scale = 0.08838834764831845f * rsqrtf(p.rowss1[row] * (1.f / 2048.f) + 1e-6f);
        u32x2 o; o[0] = pack2(v[0] * scale, v[1] * scale); o[1] = pack2(v[2] * scale, v[3] * scale);
        *(u32x2*)(p.qc + (size_t)row * 512 + col) = o;
      }
    };
    gemm8((LAS unsigned char*)smem, p.x2b, 2048, p.wCqT, T_TOK, 512, 2048, half, blockIdx.x, epi);
  } else if ((int)blockIdx.x < half + 16) {
    auto epi = [&](const Acc8& acc0, int pm, int pn, int wr, int wc, int fr, int fq) {
      G8_FOREACH(acc0, pm, pn, wr, wc, fr, fq, ai, bj, m, n, row, col) {
        const f32x4 v = acc0[ai][bj][m][n];
        bfr* dst = (col < 512) ? p.kc : p.vc;
        const int cc = col & 511, hh = cc >> 7, d = cc & 127, bb = row >> 8, mm = row & 255;
        u32x2 o; o[0] = pack2(v[0], v[1]); o[1] = pack2(v[2], v[3]);
        *(u32x2*)(dst + ((size_t)((bb * 4 + hh) * 256 + mm)) * 128 + d) = o;
      }
    };
    gemm8((LAS unsigned char*)smem, p.memn, 2048, p.wCkT, 1024, 1024, 2048, 16, blockIdx.x - half, epi);
  }
}

DI void phase_cross_attn(const Params& p, char* smem) {
  const int tid = threadIdx.x, lane = tid & 63, w = tid >> 6, fr = lane & 15, fq = lane >> 4;
  for (int id = blockIdx.x; id < 512; id += gridDim.x) {
    const int b = id >> 7, h = (id >> 5) & 3, qt = id & 31;
    float mx, l;
    const size_t kvb = (size_t)(b * 4 + h) * 256 * 128;
    bfr* dst = p.oc + (size_t)(b * 4096 + qt * 128 + w * 16 + fr) * 512 + h * 128 + fq * 4;
    attn_core<false>(p.qc + (size_t)b * 4096 * 512 + h * 128, 512, qt * 128, p.kc + kvb, p.vc + kvb, 128, 0, smem,
                     [&](int dt, f32x4 a, float lsum) {
                       const float il = 1.f / lsum;
                       u32x2 v; v[0] = pack2(a[0] * il, a[1] * il); v[1] = pack2(a[2] * il, a[3] * il);
                       *(u32x2*)(dst + dt * 16) = v;
                     }, mx, l);
  }
}

template <unsigned AMASK>
DI void route_cands(int (&top)[16], const float (&v1)[16], const float (&v2)[16]) {
#pragma unroll
  for (int a = 0; a < 16; ++a)
#pragma unroll
    for (int b = 0; b < 16; ++b)
      if (((AMASK >> a) & 1u) && (a + 1) * (b + 1) <= 16) topk_insert(top, (f2sort(v1[a] + v2[b]) & ~0xFF) | (a * 16 + b));
}
DI void bitonic_sort16_desc(int (&mg)[16]) {
#pragma unroll
  for (int st = 8; st >= 1; st >>= 1)
#pragma unroll
    for (int i = 0; i < 16; ++i)
      if ((i & st) == 0) { const int hi = max(mg[i], mg[i + st]), lo = min(mg[i], mg[i + st]); mg[i] = hi; mg[i + st] = lo; }
}
DI void phase_peer_route(const Params& p, char* smem) {
  const int tid = threadIdx.x, lane = tid & 63, w = tid >> 6, fr = lane & 15, fq = lane >> 4;
  char* sSK = smem;
  float* scores = (float*)(smem + 65536);
  int* lists = (int*)(smem + 65536 + 67584);
  int* tops = (int*)(smem + 65536);
  constexpr unsigned AM0 = (1u << 0) | (1u << 3) | (1u << 5) | (1u << 8) | (1u << 9) | (1u << 10) | (1u << 11);
  __syncthreads();
#pragma unroll
  for (int i = 0; i < 8; ++i) {
    const int id = tid + i * 512, key = id >> 4, c = id & 15;
    const bfr* src = (key < 128 ? p.sk1 : p.sk2) + (key & 127) * 128 + c * 8;
    *(u32x4*)(sSK + key * 256 + ((c ^ (key & 15)) << 4)) = *(const u32x4*)src;
  }
  for (int id = blockIdx.x; id < 2048; id += gridDim.x) {
    const int tt = id >> 3, h = id & 7;
    const int tok0 = tt * 64;
    __syncthreads();
    {
      const int tg = w & 3, hf = w >> 2;
      const bfr* arow = p.pq + (size_t)(tok0 + tg * 16 + fr) * 2048 + h * 256 + hf * 128;
      bf16x8 af[4];
#pragma unroll
      for (int kk = 0; kk < 4; ++kk) af[kk] = *(const bf16x8*)(arow + kk * 32 + fq * 8);
#pragma unroll
      for (int nt = 0; nt < 8; ++nt) {
        f32x4 a = f32x4{0.f, 0.f, 0.f, 0.f};
        const int key = hf * 128 + nt * 16 + fr;
#pragma unroll
        for (int kk = 0; kk < 4; ++kk) {
          const bf16x8 bfg = *(const bf16x8*)(sSK + key * 256 + (((kk * 4 + fq) ^ fr) << 4));
          a = mfma16(af[kk], bfg, a);
        }
#pragma unroll
        for (int i = 0; i < 4; ++i) scores[(hf * 64 + tg * 16 + fq * 4 + i) * 132 + nt * 16 + fr] = a[i];
      }
    }
    __syncthreads();
    {
      const int row = tid >> 2, part = tid & 3;
      int lst[16];
#pragma unroll
      for (int j = 0; j < 16; ++j) lst[j] = (int)0x80000000;
      const float* srow = scores + row * 132 + part * 32;
#pragma unroll 2
      for (int k4 = 0; k4 < 8; ++k4) {
        const float4 v = *(const float4*)(srow + k4 * 4);
        const int kb = part * 32 + k4 * 4;
        topk_insert(lst, (f2sort(v.x) & ~0x7F) | (kb + 0));
        topk_insert(lst, (f2sort(v.y) & ~0x7F) | (kb + 1));
        topk_insert(lst, (f2sort(v.z) & ~0x7F) | (kb + 2));
        topk_insert(lst, (f2sort(v.w) & ~0x7F) | (kb + 3));
      }
      int mg[16];
#pragma unroll
      for (int i = 0; i < 16; ++i) mg[i] = max(lst[i], __shfl_xor(lst[15 - i], 1));
      bitonic_sort16_desc(mg);
#pragma unroll
      for (int i = 0; i < 16; ++i) lst[i] = max(mg[i], __shfl_xor(mg[15 - i], 2));
      bitonic_sort16_desc(lst);
      if (part == 0) {
#pragma unroll
        for (int j4 = 0; j4 < 4; ++j4) {
          int4 t; t.x = lst[j4 * 4]; t.y = lst[j4 * 4 + 1]; t.z = lst[j4 * 4 + 2]; t.w = lst[j4 * 4 + 3];
          *(int4*)(lists + row * 16 + j4 * 4) = t;
        }
      }
    }
    __syncthreads();
    int top[16];
#pragma unroll
    for (int j = 0; j < 16; ++j) top[j] = (int)0x80000000;
    const int tokl = tid & 63;
    if (tid < 128) {
      float v1[16], v2[16];
#pragma unroll
      for (int j4 = 0; j4 < 4; ++j4) {
        const int4 t1 = *(const int4*)(lists + tokl * 16 + j4 * 4);
        const int4 t2 = *(const int4*)(lists + (64 + tokl) * 16 + j4 * 4);
        v1[j4 * 4] = sort2f(t1.x & ~0x7F); v1[j4 * 4 + 1] = sort2f(t1.y & ~0x7F); v1[j4 * 4 + 2] = sort2f(t1.z & ~0x7F); v1[j4 * 4 + 3] = sort2f(t1.w & ~0x7F);
        v2[j4 * 4] = sort2f(t2.x & ~0x7F); v2[j4 * 4 + 1] = sort2f(t2.y & ~0x7F); v2[j4 * 4 + 2] = sort2f(t2.z & ~0x7F); v2[j4 * 4 + 3] = sort2f(t2.w & ~0x7F);
      }
      if (tid < 64) {
        route_cands<AM0>(top, v1, v2);
      } else {
        route_cands<(~AM0) & 0xFFFFu>(top, v1, v2);
#pragma unroll
        for (int j4 = 0; j4 < 4; ++j4) {
          int4 t; t.x = top[j4 * 4]; t.y = top[j4 * 4 + 1]; t.z = top[j4 * 4 + 2]; t.w = top[j4 * 4 + 3];
          *(int4*)(tops + tokl * 16 + j4 * 4) = t;
        }
      }
    }
    __syncthreads();
    if (tid < 64) {
      int fin[16];
#pragma unroll
      for (int j4 = 0; j4 < 4; ++j4) {
        const int4 t = *(const int4*)(tops + tid * 16 + (3 - j4) * 4);
        fin[j4 * 4 + 0] = max(top[j4 * 4 + 0], t.w);
        fin[j4 * 4 + 1] = max(top[j4 * 4 + 1], t.z);
        fin[j4 * 4 + 2] = max(top[j4 * 4 + 2], t.y);
        fin[j4 * 4 + 3] = max(top[j4 * 4 + 3], t.x);
      }
      int ex[16];
      float val[16];
      float mxv = -3.0e38f;
#pragma unroll
      for (int j = 0; j < 16; ++j) {
        const int code = fin[j] & 0xFF;
        const int i1 = lists[tid * 16 + (code >> 4)] & 0x7F;
        const int i2 = lists[(64 + tid) * 16 + (code & 15)] & 0x7F;
        ex[j] = i1 * 128 + i2;
        val[j] = sort2f(fin[j] & ~0xFF);
        mxv = fmaxf(mxv, val[j]);
      }
      float sum = 0.f;
      float ev[16];
#pragma unroll
      for (int j = 0; j < 16; ++j) { ev[j] = __expf(val[j] - mxv); sum += ev[j]; }
      const float inv = 1.f / sum;
      const size_t ob = (size_t)(tok0 + tid) * 128 + h * 16;
#pragma unroll
      for (int j4 = 0; j4 < 4; ++j4) {
        int4 iv; iv.x = ex[j4 * 4]; iv.y = ex[j4 * 4 + 1]; iv.z = ex[j4 * 4 + 2]; iv.w = ex[j4 * 4 + 3];
        float4 gv; gv.x = ev[j4 * 4] * inv; gv.y = ev[j4 * 4 + 1] * inv; gv.z = ev[j4 * 4 + 2] * inv; gv.w = ev[j4 * 4 + 3] * inv;
        *(int4*)(p.idx + ob + j4 * 4) = iv;
        *(float4*)(p.gates + ob + j4 * 4) = gv;
      }
    }
  }
}

DI float gelu_tanh(float a) {
  const float u = 0.7978845608028654f * (a + 0.044715f * a * a * a);
  return 0.5f * a * (1.f + tanhf(u));
}

#define SB() __builtin_amdgcn_sched_barrier(0)
DI void peer_load8u(u32x4 (&bufa)[8], const unsigned char* tbl, int idxv, int g, int lane) {
#pragma unroll
  for (int k = 0; k < 8; ++k) {
    const int e = __builtin_amdgcn_readlane(idxv, g * 8 + k);
    bufa[k] = *(const u32x4*)(tbl + (size_t)e * 1024 + lane * 16);
  }
}
DI float peer_dot8(const u32x4 (&bufa)[8], const f32x2 (&hp)[16], int lane) {
  float part[8];
#pragma unroll
  for (int k = 0; k < 8; ++k) {
    const u32x4 u = bufa[k];
    f32x2 a2 = f32x2{0.f, 0.f};
#pragma unroll
    for (int c = 0; c < 4; ++c) {
      const unsigned uu = u[c];
      a2 += __builtin_amdgcn_cvt_scalef32_pk_f32_fp4(uu, 1.0f, 0) * hp[c * 4 + 0];
      a2 += __builtin_amdgcn_cvt_scalef32_pk_f32_fp4(uu, 1.0f, 1) * hp[c * 4 + 1];
      a2 += __builtin_amdgcn_cvt_scalef32_pk_f32_fp4(uu, 1.0f, 2) * hp[c * 4 + 2];
      a2 += __builtin_amdgcn_cvt_scalef32_pk_f32_fp4(uu, 1.0f, 3) * hp[c * 4 + 3];
    }
    part[k] = a2[0] + a2[1];
  }
  const bool up4 = (lane & 4) != 0, up2 = (lane & 2) != 0, up1 = (lane & 1) != 0;
  float q[4];
#pragma unroll
  for (int i = 0; i < 4; ++i) {
    const float keep = up4 ? part[i + 4] : part[i];
    const float send = up4 ? part[i] : part[i + 4];
    q[i] = keep + __shfl_xor(send, 4);
  }
  float r[2];
#pragma unroll
  for (int i = 0; i < 2; ++i) {
    const float keep = up2 ? q[i + 2] : q[i];
    const float send = up2 ? q[i] : q[i + 2];
    r[i] = keep + __shfl_xor(send, 2);
  }
  float v = (up1 ? r[1] : r[0]) + __shfl_xor(up1 ? r[0] : r[1], 1);
  v += __shfl_xor(v, 8);
  v += __shfl_xor(v, 16);
  v += __shfl_xor(v, 32);
  return v;
}
DI void peer_acc8(const u32x4 (&bufa)[8], f32x2 (&ys)[16], float cval, int g) {
#pragma unroll
  for (int k = 0; k < 8; ++k) {
    const float ck = __builtin_bit_cast(float, __builtin_amdgcn_readlane(__builtin_bit_cast(int, cval), g * 8 + k));
    const u32x4 u = bufa[k];
#pragma unroll
    for (int c = 0; c < 4; ++c) {
      const unsigned uu = u[c];
      ys[c * 4 + 0] += __builtin_amdgcn_cvt_scalef32_pk_f32_fp4(uu, 1.0f, 0) * ck;
      ys[c * 4 + 1] += __builtin_amdgcn_cvt_scalef32_pk_f32_fp4(uu, 1.0f, 1) * ck;
      ys[c * 4 + 2] += __builtin_amdgcn_cvt_scalef32_pk_f32_fp4(uu, 1.0f, 2) * ck;
      ys[c * 4 + 3] += __builtin_amdgcn_cvt_scalef32_pk_f32_fp4(uu, 1.0f, 3) * ck;
    }
  }
}

DI void phase_peer_expert(const Params& p) {
  const int lane = threadIdx.x & 63, wid = threadIdx.x >> 6;
  bool flag4;
  {
    float c1 = 1.0f, c2 = 2.0f;
    asm volatile("" : "+v"(c1), "+v"(c2));
    const unsigned w4 = __builtin_amdgcn_cvt_scalef32_pk_fp4_f32(0u, c1, c2, 1.0f, 0);
    const f32x2 r4 = __builtin_amdgcn_cvt_scalef32_pk_f32_fp4(w4, 1.0f, 0);
    flag4 = (r4[0] == 2.0f);
  }
  for (int tok = blockIdx.x * 8 + wid; tok < T_TOK; tok += gridDim.x * 8) {
    int myidx[2];
    float mygate[2];
    const float rs2 = rsqrtf(p.rowss2[tok] * (1.f / 2048.f) + 1e-6f);
#pragma unroll
    for (int half = 0; half < 2; ++half) {
      myidx[half] = p.idx[(size_t)tok * 128 + half * 64 + lane];
      mygate[half] = p.gates[(size_t)tok * 128 + half * 64 + lane];
    }
    u32x4 bufAa[8], bufBa[8];
    peer_load8u(bufAa, p.wU8, myidx[0], 0, lane);
    f32x2 hs[16];
    {
      float he[32];
#pragma unroll
      for (int j = 0; j < 2; ++j)
#pragma unroll
        for (int q = 0; q < 2; ++q) {
          const u32x4 t = *(const u32x4*)(p.hbuf + (size_t)tok * 2048 + j * 1024 + lane * 16 + q * 8);
#pragma unroll
          for (int c = 0; c < 4; ++c) { const unsigned tt = t[c]; he[j * 16 + q * 8 + c * 2] = bflo(tt); he[j * 16 + q * 8 + c * 2 + 1] = bfhi(tt); }
        }
#pragma unroll
      for (int i = 0; i < 16; ++i) {
        const float n0 = he[2 * i], n1 = he[2 * i + 1];
        hs[i] = f32x2{flag4 ? n1 : n0, flag4 ? n0 : n1};
      }
    }
    f32x2 ys[16];
#pragma unroll
    for (int e = 0; e < 16; ++e) ys[e] = f32x2{0.f, 0.f};
#pragma unroll 1
    for (int half = 0; half < 2; ++half) {
      const int idxv = half ? myidx[1] : myidx[0];
      const float gate = half ? mygate[1] : mygate[0];
      const float mysu = p.su[idxv], mysv = p.sv[idxv];
      float amine = 0.f;
#pragma unroll 1
      for (int g2 = 0; g2 < 3; ++g2) {
        peer_load8u(bufBa, p.wU8, idxv, 2 * g2 + 1, lane);
        SB();
        { const float v = peer_dot8(bufAa, hs, lane); if ((lane >> 3) == 2 * g2) amine = v; }
        SB();
        peer_load8u(bufAa, p.wU8, idxv, 2 * g2 + 2, lane);
        SB();
        { const float v = peer_dot8(bufBa, hs, lane); if ((lane >> 3) == 2 * g2 + 1) amine = v; }
        SB();
      }
      {
        peer_load8u(bufBa, p.wU8, idxv, 7, lane);
        SB();
        { const float v = peer_dot8(bufAa, hs, lane); if ((lane >> 3) == 6) amine = v; }
        SB();
        peer_load8u(bufAa, p.wV8, idxv, 0, lane);
        SB();
        { const float v = peer_dot8(bufBa, hs, lane); if ((lane >> 3) == 7) amine = v; }
        SB();
      }
      const float cval = gate * gelu_tanh(amine * mysu * rs2) * mysv;
      const int nidx = myidx[1];
#pragma unroll 1
      for (int g2 = 0; g2 < 3; ++g2) {
        peer_load8u(bufBa, p.wV8, idxv, 2 * g2 + 1, lane);
        SB();
        peer_acc8(bufAa, ys, cval, 2 * g2);
        SB();
        peer_load8u(bufAa, p.wV8, idxv, 2 * g2 + 2, lane);
        SB();
        peer_acc8(bufBa, ys, cval, 2 * g2 + 1);
        SB();
      }
      {
        peer_load8u(bufBa, p.wV8, idxv, 7, lane);
        SB();
        peer_acc8(bufAa, ys, cval, 6);
        SB();
        peer_load8u(bufAa, p.wU8, nidx, 0, lane);
        SB();
        peer_acc8(bufBa, ys, cval, 7);
        SB();
      }
    }
    float ye[32];
#pragma unroll
    for (int i = 0; i < 16; ++i) {
      ye[2 * i] = flag4 ? ys[i][1] : ys[i][0];
      ye[2 * i + 1] = flag4 ? ys[i][0] : ys[i][1];
    }
    float ss = 0.f;
#pragma unroll
    for (int j = 0; j < 2; ++j)
#pragma unroll
      for (int q = 0; q < 4; ++q) {
        const float4 a = *(const float4*)(p.xres + (size_t)tok * 2048 + j * 1024 + lane * 16 + q * 4);
        const int b0 = j * 16 + q * 4;
        ye[b0] += a.x; ye[b0 + 1] += a.y; ye[b0 + 2] += a.z; ye[b0 + 3] += a.w;
        ss += ye[b0] * ye[b0] + ye[b0 + 1] * ye[b0 + 1] + ye[b0 + 2] * ye[b0 + 2] + ye[b0 + 3] * ye[b0 + 3];
      }
    ss = wave_sum(ss);
    const float rs = rsqrtf(ss * (1.f / 2048.f) + 1e-6f);
#pragma unroll
    for (int j = 0; j < 2; ++j)
#pragma unroll
      for (int q = 0; q < 4; ++q) {
        const float4 gq = *(const float4*)(p.g_final + j * 1024 + lane * 16 + q * 4);
        const int b0 = j * 16 + q * 4;
        float4 o;
        o.x = ye[b0] * rs * gq.x; o.y = ye[b0 + 1] * rs * gq.y; o.z = ye[b0 + 2] * rs * gq.z; o.w = ye[b0 + 3] * rs * gq.w;
        *(float4*)(p.out + (size_t)tok * 2048 + j * 1024 + lane * 16 + q * 4) = o;
      }
  }
}

DI void grid_barrier(unsigned* ctr, unsigned& epoch) {
  asm volatile("s_waitcnt vmcnt(0)" ::: "memory");
  __syncthreads();
  if (threadIdx.x == 0) {
    __builtin_amdgcn_fence(__ATOMIC_RELEASE, "agent");
    asm volatile("s_waitcnt vmcnt(0)" ::: "memory");
    __hip_atomic_fetch_add(ctr, 1u, __ATOMIC_RELAXED, __HIP_MEMORY_SCOPE_AGENT);
    const unsigned target = (epoch + 1u) * gridDim.x;
    unsigned spins = 0;
    while (__hip_atomic_load(ctr, __ATOMIC_RELAXED, __HIP_MEMORY_SCOPE_AGENT) < target) {
      __builtin_amdgcn_s_sleep(1);
      if (++spins > (1u << 24)) break;
    }
    __builtin_amdgcn_fence(__ATOMIC_ACQUIRE, "agent");
    asm volatile("s_waitcnt vmcnt(0)" ::: "memory");
  }
  __syncthreads();
  epoch += 1u;
}

__global__ void __launch_bounds__(NTHREADS) mega(Params p, int phase_lo, int phase_hi) {
  __shared__ __attribute__((aligned(16))) char smem[SMEM_BYTES];
  cg::grid_group grid = cg::this_grid();
  unsigned epoch = 0;
#define PHASE(k, call) if (phase_lo <= (k) && (k) < phase_hi) { if ((k) > phase_lo) { if ((k) == 1) grid.sync(); else grid_barrier(p.bar, epoch); } call; if ((DUP_MASK >> (k)) & 1) { grid_barrier(p.bar, epoch); call; } }
  PHASE(0, phase_prep(p, smem))
  PHASE(1, phase_inproj(p, smem))
  PHASE(2, phase_mix_attn(p, smem))
  PHASE(3, phase_pool_combine(p, smem))
  PHASE(4, phase_gemm_resid(p.hbuf, 2048, p.wOutT, 2048, p.x, p.xres, p.x2b, p.rowss1, smem))
  PHASE(6, phase_cross_proj(p, smem))
  PHASE(7, phase_cross_attn(p, smem))
  if (ABL != 2) PHASE(8, phase_gemm_resid(p.oc, 512, p.wCoT, 512, p.xres, p.xres, p.hbuf, p.rowss2, smem))
  PHASE(10, phase_gemm_pq(p, smem))
  PHASE(11, phase_peer_route(p, smem))
  PHASE(12, phase_peer_expert(p))
}

extern "C" void kernel_launch(void* const* d_in, const int* in_sizes, int n_in, void* d_out, int out_size, void* d_ws,
                              size_t ws_size, hipStream_t stream) {
  Params p{};
  p.x = (const float*)d_in[0]; p.mem = (const float*)d_in[1]; p.pos = (const int*)d_in[2];
  p.g_mix = (const float*)d_in[3]; p.w_in = (const float*)d_in[4]; p.w_pool = (const float*)d_in[5];
  p.pool_scale = (const float*)d_in[6]; p.w_out = (const float*)d_in[7]; p.g_cross = (const float*)d_in[8];
  p.g_mem = (const float*)d_in[9]; p.w_cq = (const float*)d_in[10]; p.w_ck = (const float*)d_in[11];
  p.w_cv = (const float*)d_in[12]; p.w_co = (const float*)d_in[13]; p.g_ffn = (const float*)d_in[14];
  p.w_pq = (const float*)d_in[15]; p.sk1f = (const float*)d_in[16]; p.sk2f = (const float*)d_in[17];
  p.w_u = (const float*)d_in[18]; p.w_v = (const float*)d_in[19]; p.g_final = (const float*)d_in[20];
  p.out = (float*)d_out;
  char* ws = (char*)d_ws;
  size_t off = 0;
  auto take = [&](size_t bytes) { char* r = ws + off; off += (bytes + 255) & ~(size_t)255; return r; };
  const size_t MB = 1024 * 1024;
  p.wInT = (bfr*)take(16 * MB); p.wPoolT = (bfr*)take(512 * 1024); p.wOutT = (bfr*)take(8 * MB);
  p.wCqT = (bfr*)take(2 * MB); p.wCkT = (bfr*)take(2 * MB); p.wCvT = (bfr*)take(2 * MB); p.wCoT = (bfr*)take(2 * MB);
  p.wPqT = (bfr*)take(8 * MB); p.sk1 = (bfr*)take(32768); p.sk2 = (bfr*)take(32768);
  p.wU8 = (unsigned char*)take(32 * MB); p.wV8 = (unsigned char*)take(32 * MB);
  p.su = (float*)take(65536); p.sv = (float*)take(65536);
  p.memn = (bfr*)take(4 * MB); p.kc = (bfr*)take(1 * MB); p.vc = (bfr*)take(1 * MB);
  p.hbuf = (bfr*)take(64 * MB);
  p.bar = (unsigned*)take(256);
  p.rowss1 = (float*)take(65536); p.rowss2 = (float*)take(65536);
  const size_t r2 = off;
  p.qbuf = (bfr*)take(32 * MB); p.kbuf = (bfr*)take(32 * MB); p.vbuf = (bfr*)take(32 * MB);
  p.pbuf = (bfr*)take(32 * MB); p.mixed = (bfr*)take(32 * MB); p.ob = (bfr*)take(96 * MB);
  p.lse = (float*)take((size_t)3 * T_TOK * 8 * 4);
  const size_t end1 = off;
  off = r2;
  p.xres = (float*)take(128 * MB); p.pq = (bfr*)take(64 * MB); p.x2b = p.pq; p.qc = (bfr*)take(16 * MB); p.oc = (bfr*)take(16 * MB);
  p.idx = (int*)take(8 * MB); p.gates = (float*)take(8 * MB);
  const size_t end2 = off;
  const size_t need = end1 > end2 ? end1 : end2;
  if (need > ws_size) { fprintf(stderr, "workspace too small: need %zu have %zu\n", need, ws_size); return; }

  static int grid_blocks = 0;
  if (!grid_blocks) {
    int dev = 0, cus = 0, per_cu = 0;
    hipGetDevice(&dev);
    hipDeviceGetAttribute(&cus, hipDeviceAttributeMultiprocessorCount, dev);
    hipOccupancyMaxActiveBlocksPerMultiprocessor(&per_cu, mega, NTHREADS, 0);
    if (per_cu < 1) per_cu = 1;
    if (per_cu > 1) per_cu = 1;
    grid_blocks = cus * per_cu;
  }
  hipMemsetAsync(p.bar, 0, 256, stream);
#if MULTI_LAUNCH
  for (int ph = 0; ph < NPHASE; ++ph) hipLaunchKernelGGL(mega, dim3(grid_blocks), dim3(NTHREADS), 0, stream, p, ph, ph + 1);
#else
  int lo = 0, hi = NPHASE;
  void* args[] = {&p, &lo, &hi};
  hipError_t e = hipLaunchCooperativeKernel((void*)mega, dim3(grid_blocks), dim3(NTHREADS), args, 0, stream);
  if (e != hipSuccess) fprintf(stderr, "cooperative launch failed: %s (grid %d)\n", hipGetErrorString(e), grid_blocks);
#endif
}
```

```cpp
#include <hip/hip_runtime.h>
#include <hip/hip_cooperative_groups.h>
#include <stdint.h>
#include <stdio.h>
namespace cg = cooperative_groups;

#ifndef ABL
#define ABL 0
#endif
#ifndef DUP_MASK
#define DUP_MASK 0
#endif
#ifndef MULTI_LAUNCH
#define MULTI_LAUNCH 0
#endif

#define DI __device__ __forceinline__
typedef unsigned short bfr;
using bf16x8 = __attribute__((ext_vector_type(8))) short;
using s16x4  = __attribute__((ext_vector_type(4))) short;
using f32x4  = __attribute__((ext_vector_type(4))) float;
using u32x4  = __attribute__((ext_vector_type(4))) unsigned;
using u32x2  = __attribute__((ext_vector_type(2))) unsigned;
using bf2    = __attribute__((ext_vector_type(2))) __bf16;
using f32x2  = __attribute__((ext_vector_type(2))) float;
using v6u    = __attribute__((ext_vector_type(6))) unsigned;
using v16f   = __attribute__((ext_vector_type(16))) float;
using v32f   = __attribute__((ext_vector_type(32))) float;

constexpr int T_TOK = 16384;
constexpr int NTHREADS = 512;
constexpr int SMEM_BYTES = 151552;
constexpr int NPHASE = 13;

struct Params {
  const float *x, *mem; const int* pos;
  const float *g_mix, *w_in, *w_pool, *pool_scale, *w_out, *g_cross, *g_mem, *w_cq, *w_ck, *w_cv, *w_co, *g_ffn, *w_pq,
              *sk1f, *sk2f, *w_u, *w_v, *g_final;
  float* out;
  bfr *wInT, *wPoolT, *wOutT, *wCqT, *wCkT, *wCvT, *wCoT, *wPqT, *sk1, *sk2;
  unsigned char *wU8, *wV8; float *su, *sv;
  bfr *hbuf, *memn, *kc, *vc;
  bfr *pbuf, *qbuf, *kbuf, *vbuf, *mixed, *ob; float* lse;
  float* xres; bfr *pq, *qc, *oc; int* idx; float* gates;
  unsigned* bar;
  float *rowss1, *rowss2; bfr* x2b;
};

DI unsigned pack2(float a, float b) { bf2 p; p[0] = (__bf16)a; p[1] = (__bf16)b; return __builtin_bit_cast(unsigned, p); }
DI float bflo(unsigned u) { return __uint_as_float(u << 16); }
DI float bfhi(unsigned u) { return __uint_as_float(u & 0xffff0000u); }
DI float wave_sum(float v) {
#pragma unroll
  for (int o = 32; o >= 1; o >>= 1) v += __shfl_xor(v, o);
  return v;
}
DI f32x4 mfma16(bf16x8 a, bf16x8 b, f32x4 c) { return __builtin_amdgcn_mfma_f32_16x16x32_bf16(a, b, c, 0, 0, 0); }
DI s16x4 tr_read(const char* p) {
  return __builtin_amdgcn_ds_read_tr16_b64_v4i16((s16x4 __attribute__((address_space(3)))*)(p));
}

DI void gemm_main(const bfr* __restrict__ A, int lda, const bfr* __restrict__ Bt, int ldb, int K, char* smem,
                  f32x4 (&acc)[4][4]) {
  const int tid = threadIdx.x, lane = tid & 63, wid = tid >> 6, wm = wid >> 1, wn = wid & 1, fr = lane & 15, fq = lane >> 4;
  const int lrow = tid >> 3, lc = tid & 7;
  const int sw = ((lc ^ (lrow & 7)) << 4);
  u32x4 ra[4], rb[2];
  const bfr* ga = A + (size_t)lrow * lda + lc * 8;
  const bfr* gb = Bt + (size_t)lrow * ldb + lc * 8;
#pragma unroll
  for (int m = 0; m < 4; ++m)
#pragma unroll
    for (int n = 0; n < 4; ++n) acc[m][n] = f32x4{0.f, 0.f, 0.f, 0.f};
  const int nk = K >> 6;
#pragma unroll
  for (int i = 0; i < 4; ++i) ra[i] = *(const u32x4*)(ga + (size_t)(64 * i) * lda);
#pragma unroll
  for (int i = 0; i < 2; ++i) rb[i] = *(const u32x4*)(gb + (size_t)(64 * i) * ldb);
  __syncthreads();
#pragma unroll
  for (int i = 0; i < 4; ++i) *(u32x4*)(smem + (lrow + 64 * i) * 128 + sw) = ra[i];
#pragma unroll
  for (int i = 0; i < 2; ++i) *(u32x4*)(smem + 32768 + (lrow + 64 * i) * 128 + sw) = rb[i];
  __syncthreads();
  for (int kt = 0; kt < nk; ++kt) {
    const char* cur = smem + (kt & 1) * 49152;
    char* nxt = smem + ((kt + 1) & 1) * 49152;
    const bool more = (kt + 1 < nk);
    if (more) {
#pragma unroll
      for (int i = 0; i < 4; ++i) ra[i] = *(const u32x4*)(ga + (size_t)(64 * i) * lda + (kt + 1) * 64);
#pragma unroll
      for (int i = 0; i < 2; ++i) rb[i] = *(const u32x4*)(gb + (size_t)(64 * i) * ldb + (kt + 1) * 64);
    }
#pragma unroll
    for (int kk = 0; kk < 2; ++kk) {
      bf16x8 af[4], bf[4];
      const int co = (((kk * 4 + fq) ^ (fr & 7)) << 4);
#pragma unroll
      for (int m = 0; m < 4; ++m) af[m] = *(const bf16x8*)(cur + (wm * 64 + m * 16 + fr) * 128 + co);
#pragma unroll
      for (int n = 0; n < 4; ++n) bf[n] = *(const bf16x8*)(cur + 32768 + (wn * 64 + n * 16 + fr) * 128 + co);
#pragma unroll
      for (int m = 0; m < 4; ++m)
#pragma unroll
        for (int n = 0; n < 4; ++n) acc[m][n] = mfma16(bf[n], af[m], acc[m][n]);
    }
    if (more) {
#pragma unroll
      for (int i = 0; i < 4; ++i) *(u32x4*)(nxt + (lrow + 64 * i) * 128 + sw) = ra[i];
#pragma unroll
      for (int i = 0; i < 2; ++i) *(u32x4*)(nxt + 32768 + (lrow + 64 * i) * 128 + sw) = rb[i];
    }
    __syncthreads();
  }
}

DI void tile_map(int id, int MT, int NT, int& mt, int& nt) {
  if ((NT & 7) == 0 && (MT & 31) == 0) {
    const int round = id >> 8, local = id & 255, xcd = local & 7, j = local >> 3, mtl = j & 3, ntl = j >> 2;
    const int MR = MT >> 5;
    const int mr = round % MR, nr = round / MR;
    mt = mr * 32 + xcd * 4 + mtl;
    nt = nr * 8 + ntl;
  } else {
    mt = id % MT;
    nt = id / MT;
  }
}


#define LAS __attribute__((address_space(3)))
namespace g8 {
constexpr int BM = 256, BK = 64, HALF = 128, HTB = HALF * BK * 2, NXCD = 8, WGM = 8;
DI int lds_byte(int r, int c) { const int st = (r >> 4) * 2 + (c >> 5), rr = r & 15, cc = c & 31, ob = rr * 64 + cc * 2; return st * 1024 + (ob ^ (((ob >> 9) & 1) << 5)); }
DI void stage_rc(int b, int& R, int& C) { const int st = b / 1024, sb = b % 1024, swz = sb ^ (((sb >> 9) & 1) << 5); R = (st >> 1) * 16 + swz / 64; C = (st & 1) * 32 + (swz % 64) / 2; }
struct Order {
  int nM, nN, nwg, G, c;
  DI void init(int M, int N, int G_, int c_) { nM = M / BM; nN = N / BM; nwg = nM * nN; G = G_; c = c_; }
  DI bool next(int i, int& pm, int& pn) const {
    const long L = (long)i * G + c; if (L >= nwg) return false;
    int wgid = (int)L; { const int q = nwg / NXCD, r = nwg % NXCD, xcd = wgid % NXCD, off = wgid / NXCD; wgid = (xcd < r ? xcd * (q + 1) : r * (q + 1) + (xcd - r) * q) + off; }
    const int nig = WGM * nN, gid = wgid / nig, fm = gid * WGM, gsz = (nM - fm) < WGM ? (nM - fm) : WGM;
    pm = fm + ((wgid % nig) % gsz); pn = (wgid % nig) / gsz; return true;
  }
};
}

template <class Epi>
DI void gemm8(LAS unsigned char* lds, const bfr* A, int lda, const bfr* Bt, int M, int N, int K, int G, int c, const Epi& E, int a_pn_bytes = 0) {
  using namespace g8;
  const int tid = threadIdx.x, wid = __builtin_amdgcn_readfirstlane(tid >> 6), lane = tid & 63, wr = wid >> 2, wc = wid & 3, fr = lane & 15, fq = lane >> 4;
  const int nt = K / BK;
  Order S; S.init(M, N, G, c);
  unsigned voffA[2], voffB[2];
#pragma unroll
  for (int i = 0; i < 2; ++i) { int R, C; stage_rc(tid * 16 + i * 8192, R, C); voffA[i] = (unsigned)(R * lda + C) * 2u; voffB[i] = (unsigned)(R * K + C) * 2u; }
  const size_t kstep = (size_t)(BK * 2);
  const size_t hstepA = (size_t)HALF * lda * 2, hstepB = (size_t)HALF * K * 2;
  const size_t tstepA = 2 * hstepA, tstepB = 2 * hstepB;
  const unsigned ldsw = (unsigned)wid * 1024u;
  const int aoff = lds_byte(wr * 64 + fr, fq * 8), boff = lds_byte(wc * 32 + fr, fq * 8);
#define G8_SA(b, h) (((b) * 2 + (h)) * HTB)
#define G8_SB(b, h) ((4 + (b) * 2 + (h)) * HTB)
#define G8_STAGE(bufoff, gbase, voff) do { _Pragma("unroll") for (int _i = 0; _i < 2; ++_i) \
    __builtin_amdgcn_global_load_lds((const unsigned*)((const char*)(gbase) + (voff)[_i]), (LAS unsigned*)(lds + (bufoff) + ldsw + _i * 8192), 16, 0, 0); } while (0)
#define G8_LDA(dst, b, h) do { _Pragma("unroll") for (int m = 0; m < 4; ++m) _Pragma("unroll") for (int k = 0; k < 2; ++k) dst[m][k] = *(const LAS bf16x8*)(lds + G8_SA(b, h) + aoff + m * 2048 + k * 1024); } while (0)
#define G8_LDB(dst, b, h) do { _Pragma("unroll") for (int n = 0; n < 2; ++n) _Pragma("unroll") for (int k = 0; k < 2; ++k) dst[n][k] = *(const LAS bf16x8*)(lds + G8_SB(b, h) + boff + n * 2048 + k * 1024); } while (0)
#define G8_MMA(ai, bj, At, Btf) do { __builtin_amdgcn_s_setprio(1); _Pragma("unroll") for (int m = 0; m < 4; ++m) _Pragma("unroll") for (int n = 0; n < 2; ++n) _Pragma("unroll") for (int k = 0; k < 2; ++k) \
    acc[ai][bj][m][n] = __builtin_amdgcn_mfma_f32_16x16x32_bf16(Btf[n][k], At[m][k], acc[ai][bj][m][n], 0, 0, 0); __builtin_amdgcn_s_setprio(0); } while (0)
#define G8_WAIT_V(n) asm volatile("s_waitcnt vmcnt(" #n ")" ::: "memory")
#define G8_WAIT_L(n) asm volatile("s_waitcnt lgkmcnt(" #n ")" ::: "memory")
#define G8_BAR __builtin_amdgcn_s_barrier()
#define G8_SCHED __builtin_amdgcn_sched_barrier(0)
  int cpm, cpn, npm = 0, npn = 0, ui = 0;
  if (!S.next(0, cpm, cpn)) return;
  f32x4 acc[2][2][4][2];
#pragma unroll
  for (int a = 0; a < 2; ++a)
#pragma unroll
    for (int b = 0; b < 2; ++b)
#pragma unroll
      for (int m = 0; m < 4; ++m)
#pragma unroll
        for (int n = 0; n < 2; ++n) acc[a][b][m][n] = f32x4{0.f, 0.f, 0.f, 0.f};
  bf16x8 At[4][2], B0[2][2], B1[2][2];
  const char* cA = (const char*)A + (size_t)cpm * tstepA + (size_t)cpn * a_pn_bytes; const char* cB = (const char*)Bt + (size_t)cpn * tstepB;
  G8_STAGE(G8_SB(0, 0), cB, voffB); G8_STAGE(G8_SA(0, 0), cA, voffA); G8_STAGE(G8_SB(0, 1), cB + hstepB, voffB); G8_STAGE(G8_SA(0, 1), cA + hstepA, voffA);
  if (wr == 1) G8_BAR;
  G8_WAIT_V(4); G8_BAR;
  G8_STAGE(G8_SB(1, 0), cB + kstep, voffB); G8_STAGE(G8_SA(1, 0), cA + kstep, voffA); G8_STAGE(G8_SB(1, 1), cB + hstepB + kstep, voffB);
  G8_WAIT_V(6); G8_BAR;
  for (;;) {
    const bool has_next = S.next(ui + 1, npm, npn);
    const char* nA = has_next ? (const char*)A + (size_t)npm * tstepA + (size_t)npn * a_pn_bytes : cA; const char* nB = has_next ? (const char*)Bt + (size_t)npn * tstepB : cB;
    for (int t = 0; t < nt; t += 2) {
      const bool last = (t == nt - 2);
      const char* a1 = cA + (size_t)(t + 1) * kstep;
      const char* a2 = last ? nA : cA + (size_t)(t + 2) * kstep; const char* b2 = last ? nB : cB + (size_t)(t + 2) * kstep;
      const char* a3 = a2 + kstep; const char* b3 = b2 + kstep;
      G8_LDB(B0, 0, 0); G8_SCHED; G8_LDA(At, 0, 0); G8_STAGE(G8_SA(1, 1), a1 + hstepA, voffA);
      G8_WAIT_L(8); G8_BAR; G8_WAIT_L(0); G8_MMA(0, 0, At, B0); G8_BAR; G8_SCHED;
      G8_LDB(B1, 0, 1); G8_STAGE(G8_SB(0, 0), b2, voffB);
      G8_BAR; G8_WAIT_L(0); G8_MMA(0, 1, At, B1); G8_BAR;
      G8_LDA(At, 0, 1); G8_STAGE(G8_SA(0, 0), a2, voffA);
      G8_BAR; G8_WAIT_L(0); G8_MMA(1, 0, At, B0); G8_BAR; G8_SCHED;
      G8_STAGE(G8_SB(0, 1), b2 + hstepB, voffB);
      G8_WAIT_V(6); G8_BAR; G8_MMA(1, 1, At, B1); G8_BAR;
      G8_LDB(B0, 1, 0); G8_SCHED; G8_LDA(At, 1, 0); G8_STAGE(G8_SA(0, 1), a2 + hstepA, voffA);
      G8_WAIT_L(8); G8_BAR; G8_WAIT_L(0); G8_MMA(0, 0, At, B0); G8_BAR; G8_SCHED;
      G8_LDB(B1, 1, 1); G8_STAGE(G8_SB(1, 0), b3, voffB);
      G8_BAR; G8_WAIT_L(0); G8_MMA(0, 1, At, B1); G8_BAR;
      G8_LDA(At, 1, 1); G8_STAGE(G8_SA(1, 0), a3, voffA);
      G8_BAR; G8_WAIT_L(0); G8_MMA(1, 0, At, B0); G8_BAR; G8_SCHED;
      G8_STAGE(G8_SB(1, 1), b3 + hstepB, voffB);
      G8_WAIT_V(6); G8_BAR; G8_MMA(1, 1, At, B1); G8_BAR;
    }
    E(acc, cpm, cpn, wr, wc, fr, fq);
    if (!has_next) break;
#pragma unroll
    for (int a = 0; a < 2; ++a)
#pragma unroll
      for (int b = 0; b < 2; ++b)
#pragma unroll
        for (int m = 0; m < 4; ++m)
#pragma unroll
          for (int n = 0; n < 2; ++n) acc[a][b][m][n] = f32x4{0.f, 0.f, 0.f, 0.f};
    cpm = npm; cpn = npn; cA = nA; cB = nB; ++ui;
  }
  G8_WAIT_V(0);
  if (wr == 0) G8_BAR;
  G8_BAR;
#undef G8_SA
#undef G8_SB
#undef G8_STAGE
#undef G8_LDA
#undef G8_LDB
#undef G8_MMA
#undef G8_WAIT_V
#undef G8_WAIT_L
#undef G8_BAR
#undef G8_SCHED
}
#define G8_FOREACH(acc, pm, pn, wr, wc, fr, fq, ai, bj, m, n, row, col) \
  _Pragma("unroll") for (int ai = 0; ai < 2; ++ai) _Pragma("unroll") for (int m = 0; m < 4; ++m) \
  _Pragma("unroll") for (int bj = 0; bj < 2; ++bj) _Pragma("unroll") for (int n = 0; n < 2; ++n) \
    if (const int row = 256 * (pm) + 128 * ai + 64 * (wr) + 16 * m + (fr); true) if (const int col = 256 * (pn) + 128 * bj + 32 * (wc) + 16 * n + 4 * (fq); true)
typedef f32x4 Acc8[2][2][4][2];

template <bool BANDED, class RowF>
DI void attn_compute(const bf16x8 (&qf)[4], int q0, int key0, char* smem, RowF rowptr, float& m_out, float& l_out) {
  const int tid = threadIdx.x, lane = tid & 63, w = tid >> 6, fr = lane & 15, fq = lane >> 4;
  char* sK = smem;
  char* sV = smem + 65536;
  constexpr int NT = BANDED ? 10 : 16;
  const int t0 = BANDED ? (w & ~1) : 0;
  f32x4 s[NT];
#pragma unroll
  for (int j = 0; j < NT; ++j) {
    f32x4 a = f32x4{0.f, 0.f, 0.f, 0.f};
    const int key = (t0 + j) * 16 + fr;
#pragma unroll
    for (int kk = 0; kk < 4; ++kk) {
      const bf16x8 kf = *(const bf16x8*)(sK + key * 256 + (((kk * 4 + fq) ^ fr) << 4));
      a = mfma16(kf, qf[kk], a);
    }
    s[j] = a;
  }
  __syncthreads();
  const float L2E = 1.4426950408889634f;
  const float NINF = -__builtin_inff();
  float mx = NINF;
  const int lq = q0 + w * 16 + fr;
#pragma unroll
  for (int j = 0; j < NT; ++j)
#pragma unroll
    for (int i = 0; i < 4; ++i) {
      float v = s[j][i] * L2E;
      if (BANDED) {
        const int lk = key0 + (t0 + j) * 16 + fq * 4 + i;
        const int dist = lq - lk;
        const bool ok = (lk >= 0) && (dist >= 0) && (dist <= 128);
        v = ok ? v : NINF;
      }
      s[j][i] = v;
      mx = fmaxf(mx, v);
    }
  mx = fmaxf(mx, __shfl_xor(mx, 16));
  mx = fmaxf(mx, __shfl_xor(mx, 32));
  float l = 0.f;
#pragma unroll
  for (int j = 0; j < NT; ++j)
#pragma unroll
    for (int i = 0; i < 4; ++i) {
      const float p = __builtin_amdgcn_exp2f(s[j][i] - mx);
      s[j][i] = p;
      l += p;
    }
  l += __shfl_xor(l, 16);
  l += __shfl_xor(l, 32);
  bf16x8 pf[NT / 2];
#pragma unroll
  for (int c = 0; c < NT / 2; ++c) {
    u32x4 t;
    t[0] = pack2(s[2 * c][0], s[2 * c][1]);
    t[1] = pack2(s[2 * c][2], s[2 * c][3]);
    t[2] = pack2(s[2 * c + 1][0], s[2 * c + 1][1]);
    t[3] = pack2(s[2 * c + 1][2], s[2 * c + 1][3]);
    pf[c] = __builtin_bit_cast(bf16x8, t);
  }
  const int q4 = (lane & 15) >> 2, p4 = lane & 3;
  m_out = mx;
  l_out = l;
  char* stage = sK + w * 4224;
  const float il = 1.f / l;
#pragma unroll 2
  for (int dt = 0; dt < 8; ++dt) {
    f32x4 a = f32x4{0.f, 0.f, 0.f, 0.f};
#pragma unroll
    for (int c = 0; c < NT / 2; ++c) {
      const int kb = (t0 + 2 * c) * 16;
      const s16x4 lo = tr_read(sV + (kb + fq * 4 + q4) * 288 + (dt * 16 + p4 * 4) * 2);
      const s16x4 hi = tr_read(sV + (kb + 16 + fq * 4 + q4) * 288 + (dt * 16 + p4 * 4) * 2);
      const bf16x8 vf = __builtin_shufflevector(lo, hi, 0, 1, 2, 3, 4, 5, 6, 7);
      a = mfma16(vf, pf[c], a);
    }
    u32x2 v; v[0] = pack2(a[0] * il, a[1] * il); v[1] = pack2(a[2] * il, a[3] * il);
    *(u32x2*)(stage + fr * 264 + dt * 32 + fq * 8) = v;
  }
  __builtin_amdgcn_wave_barrier();
  asm volatile("" ::: "memory");
#pragma unroll
  for (int j = 0; j < 4; ++j) {
    const int chunk = j * 64 + lane, q = chunk >> 4, c16 = chunk & 15;
    const u32x2 lo = *(const u32x2*)(stage + q * 264 + c16 * 16);
    const u32x2 hi = *(const u32x2*)(stage + q * 264 + c16 * 16 + 8);
    *(u32x4*)(rowptr(q) + c16 * 8) = u32x4{lo[0], lo[1], hi[0], hi[1]};
  }
}

template <bool BANDED, class StoreF>
DI void attn_core(const bfr* __restrict__ Qb, int qstride, int q0, const bfr* __restrict__ Kb, const bfr* __restrict__ Vb,
                  int kvstride, int key0, char* smem, StoreF store, float& m_out, float& l_out) {
  const int tid = threadIdx.x, lane = tid & 63, w = tid >> 6, fr = lane & 15, fq = lane >> 4;
  char* sK = smem;
  char* sV = smem + 65536;
  __syncthreads();
#pragma unroll 1
  for (int rr = 0; rr < 2; ++rr) {
    u32x4 kr[4], vr[4];
#pragma unroll
    for (int i = 0; i < 4; ++i) {
      const int id = tid + (rr * 4 + i) * 512, key = id >> 4, c = id & 15, lk = key0 + key;
      const int lkc = lk < 0 ? 0 : lk;
      const unsigned msk = lk < 0 ? 0u : 0xffffffffu;
      kr[i] = *(const u32x4*)(Kb + (long)lkc * kvstride + c * 8);
      vr[i] = *(const u32x4*)(Vb + (long)lkc * kvstride + c * 8);
      kr[i] &= u32x4{msk, msk, msk, msk};
      vr[i] &= u32x4{msk, msk, msk, msk};
    }
#pragma unroll
    for (int i = 0; i < 4; ++i) {
      const int id = tid + (rr * 4 + i) * 512, key = id >> 4, c = id & 15;
      *(u32x4*)(sK + key * 256 + ((c ^ (key & 15)) << 4)) = kr[i];
      *(u32x4*)(sV + key * 288 + c * 16) = vr[i];
    }
  }
  bf16x8 qf[4];
  {
    const bfr* qrow = Qb + (long)(q0 + w * 16 + fr) * qstride;
#pragma unroll
    for (int kk = 0; kk < 4; ++kk) qf[kk] = *(const bf16x8*)(qrow + kk * 32 + fq * 8);
  }
  __syncthreads();
  attn_compute<BANDED>(qf, q0, key0, smem, store, m_out, l_out);
}

DI int f2sort(float f) { int b = __float_as_int(f); return b ^ ((b >> 31) & 0x7fffffff); }
DI float sort2f(int s) { int b = s ^ ((s >> 31) & 0x7fffffff); return __int_as_float(b); }
DI void topk_insert(int (&lst)[16], int key) {
#pragma unroll
  for (int j = 0; j < 16; ++j) {
    const int hi = max(lst[j], key);
    key = min(lst[j], key);
    lst[j] = hi;
  }
}

template <int O, int N>
DI void bfly(float (&p)[64], int lane) {
  const bool up = (lane & O) != 0;
#pragma unroll
  for (int i = 0; i < N / 2; ++i) {
    const float keep = up ? p[i + N / 2] : p[i];
    const float send = up ? p[i] : p[i + N / 2];
    p[i] = keep + __shfl_xor(send, O);
  }
  if constexpr (O > 1) bfly<O / 2, N / 2>(p, lane);
}

DI void rms_rows2_to_bf16(const float* __restrict__ x0, const float* __restrict__ x1, const float* __restrict__ g,
                          bfr* __restrict__ o0, bfr* __restrict__ o1, int lane) {
  float4 v0[8], v1[8];
#pragma unroll
  for (int j = 0; j < 8; ++j) v0[j] = *(const float4*)(x0 + j * 256 + lane * 4);
#pragma unroll
  for (int j = 0; j < 8; ++j) v1[j] = *(const float4*)(x1 + j * 256 + lane * 4);
  float s0 = 0.f, s1 = 0.f;
#pragma unroll
  for (int j = 0; j < 8; ++j) {
    s0 += v0[j].x * v0[j].x + v0[j].y * v0[j].y + v0[j].z * v0[j].z + v0[j].w * v0[j].w;
    s1 += v1[j].x * v1[j].x + v1[j].y * v1[j].y + v1[j].z * v1[j].z + v1[j].w * v1[j].w;
  }
  s0 = wave_sum(s0);
  s1 = wave_sum(s1);
  const float r0 = rsqrtf(s0 * (1.f / 2048.f) + 1e-6f), r1 = rsqrtf(s1 * (1.f / 2048.f) + 1e-6f);
#pragma unroll
  for (int j = 0; j < 8; ++j) {
    const float4 gg = *(const float4*)(g + j * 256 + lane * 4);
    u32x2 a, c;
    a[0] = pack2(v0[j].x * r0 * gg.x, v0[j].y * r0 * gg.y); a[1] = pack2(v0[j].z * r0 * gg.z, v0[j].w * r0 * gg.w);
    c[0] = pack2(v1[j].x * r1 * gg.x, v1[j].y * r1 * gg.y); c[1] = pack2(v1[j].z * r1 * gg.z, v1[j].w * r1 * gg.w);
    *(u32x2*)(o0 + j * 256 + lane * 4) = a;
    *(u32x2*)(o1 + j * 256 + lane * 4) = c;
  }
}

DI void transpose_tile(const float* __restrict__ W, int K, int N, int k0, int n0, bfr* __restrict__ Wt, float* tile, const float* colscale, const float* rowscale) {
  __syncthreads();
  {
    const int r = threadIdx.x >> 4, c4 = threadIdx.x & 15;
#pragma unroll
    for (int i = 0; i < 2; ++i) {
      const int k = r + 32 * i;
      const float4 v = *(const float4*)(W + (size_t)(k0 + k) * N + n0 + c4 * 4);
      tile[k * 65 + c4 * 4 + 0] = v.x;
      tile[k * 65 + c4 * 4 + 1] = v.y;
      tile[k * 65 + c4 * 4 + 2] = v.z;
      tile[k * 65 + c4 * 4 + 3] = v.w;
    }
  }
  __syncthreads();
  {
    const int n = threadIdx.x >> 3, kc = threadIdx.x & 7;
    u32x4 o;
    const float csv = colscale ? colscale[n0 + n] : 1.0f;
#pragma unroll
    for (int j = 0; j < 4; ++j) {
      const float r0 = rowscale ? rowscale[k0 + kc * 8 + 2 * j] : 1.0f, r1 = rowscale ? rowscale[k0 + kc * 8 + 2 * j + 1] : 1.0f;
      o[j] = pack2(tile[(kc * 8 + 2 * j) * 65 + n] * csv * r0, tile[(kc * 8 + 2 * j + 1) * 65 + n] * csv * r1);
    }
    *(u32x4*)(Wt + (size_t)(n0 + n) * K + k0 + kc * 8) = o;
  }
}

DI void convert_f32_bf16(const float* __restrict__ src, bfr* __restrict__ dst, long n8) {
  for (long i = (long)blockIdx.x * NTHREADS + threadIdx.x; i < n8; i += (long)gridDim.x * NTHREADS) {
    const float4 a = *(const float4*)(src + i * 8);
    const float4 b = *(const float4*)(src + i * 8 + 4);
    u32x4 o;
    o[0] = pack2(a.x, a.y); o[1] = pack2(a.z, a.w); o[2] = pack2(b.x, b.y); o[3] = pack2(b.z, b.w);
    *(u32x4*)(dst + i * 8) = o;
  }
}

DI void transpose_strip(const float* __restrict__ W, int K, int N, int k0, int n0, bfr* __restrict__ Wt, float* tile,
                        const float* colscale, const float* rowscale) {
  const int tid = threadIdx.x;
  __syncthreads();
  {
    const int c4 = tid & 63, r = tid >> 6;
    float4 v[8];
#pragma unroll
    for (int i = 0; i < 8; ++i) v[i] = *(const float4*)(W + (size_t)(k0 + r + 8 * i) * N + n0 + c4 * 4);
#pragma unroll
    for (int i = 0; i < 8; ++i) {
      float* t = tile + (r + 8 * i) * 257 + c4 * 4;
      t[0] = v[i].x; t[1] = v[i].y; t[2] = v[i].z; t[3] = v[i].w;
    }
  }
  __syncthreads();
#pragma unroll
  for (int j = 0; j < 4; ++j) {
    const int task = tid + 512 * j, n = task >> 3, kc = task & 7;
    const float csv = colscale ? colscale[n0 + n] : 1.0f;
    u32x4 o;
#pragma unroll
    for (int e = 0; e < 4; ++e) {
      const int k = kc * 8 + 2 * e;
      const float r0 = rowscale ? rowscale[k0 + k] : 1.0f, r1 = rowscale ? rowscale[k0 + k + 1] : 1.0f;
      o[e] = pack2(tile[k * 257 + n] * csv * r0, tile[(k + 1) * 257 + n] * csv * r1);
    }
    *(u32x4*)(Wt + (size_t)(n0 + n) * K + k0 + kc * 8) = o;
  }
}

template <bool isv>
DI void quant_rows_fp4(const Params& p, int worker, int nworkers, int lane) {
  const float* tbl = isv ? p.w_v : p.w_u;
  float* scl = isv ? p.sv : p.su;
  unsigned char* out8 = isv ? p.wV8 : p.wU8;
  float4 gg[8];
  if (!isv) {
#pragma unroll
    for (int j = 0; j < 2; ++j)
#pragma unroll
      for (int q = 0; q < 4; ++q) gg[j * 4 + q] = *(const float4*)(p.g_ffn + j * 1024 + lane * 16 + q * 4);
  }
  auto finish = [&](float4 (&v)[8], int rr) {
    float amax = 0.f;
#pragma unroll
    for (int i = 0; i < 8; ++i) {
      if (!isv) { v[i].x *= gg[i].x; v[i].y *= gg[i].y; v[i].z *= gg[i].z; v[i].w *= gg[i].w; }
      amax = fmaxf(amax, fmaxf(fmaxf(fabsf(v[i].x), fabsf(v[i].y)), fmaxf(fabsf(v[i].z), fabsf(v[i].w))));
    }
#pragma unroll
    for (int o = 32; o >= 1; o >>= 1) amax = fmaxf(amax, __shfl_xor(amax, o));
    const float inv = amax > 0.f ? 6.0f / amax : 0.f;
    if (lane == 0) scl[rr] = amax * (1.f / 6.0f);
    u32x4 o4;
#pragma unroll
    for (int c = 0; c < 4; ++c) {
      const float4 t0 = v[2 * c], t1 = v[2 * c + 1];
      unsigned w = 0;
      w = __builtin_amdgcn_cvt_scalef32_pk_fp4_f32(w, t0.x * inv, t0.y * inv, 1.0f, 0);
      w = __builtin_amdgcn_cvt_scalef32_pk_fp4_f32(w, t0.z * inv, t0.w * inv, 1.0f, 1);
      w = __builtin_amdgcn_cvt_scalef32_pk_fp4_f32(w, t1.x * inv, t1.y * inv, 1.0f, 2);
      w = __builtin_amdgcn_cvt_scalef32_pk_fp4_f32(w, t1.z * inv, t1.w * inv, 1.0f, 3);
      o4[c] = w;
    }
    *(u32x4*)(out8 + (size_t)rr * 1024 + lane * 16) = o4;
  };
  for (int rr = worker; rr < 16384; rr += 2 * nworkers) {
    const int rb = rr + nworkers;
    const bool hasb = rb < 16384;
    const float* s0 = tbl + (size_t)rr * 2048;
    const float* s1 = tbl + (size_t)(hasb ? rb : rr) * 2048;
    float4 va[8], vb[8];
#pragma unroll
    for (int j = 0; j < 2; ++j)
#pragma unroll
      for (int q = 0; q < 4; ++q) va[j * 4 + q] = *(const float4*)(s0 + j * 1024 + lane * 16 + q * 4);
#pragma unroll
    for (int j = 0; j < 2; ++j)
#pragma unroll
      for (int q = 0; q < 4; ++q) vb[j * 4 + q] = *(const float4*)(s1 + j * 1024 + lane * 16 + q * 4);
    finish(va, rr);
    if (hasb) finish(vb, rb);
  }
}

DI void phase_prep(const Params& p, char* smem) {
  const int lane = threadIdx.x & 63, wid = threadIdx.x >> 6;
  for (int r2 = blockIdx.x * 8 + wid; r2 < (T_TOK + 1024) / 2; r2 += gridDim.x * 8) {
    const int r = 2 * r2;
    if (r < T_TOK) rms_rows2_to_bf16(p.x + (size_t)r * 2048, p.x + (size_t)(r + 1) * 2048, p.g_mix, p.hbuf + (size_t)r * 2048, p.hbuf + (size_t)(r + 1) * 2048, lane);
    else rms_rows2_to_bf16(p.mem + (size_t)(r - T_TOK) * 2048, p.mem + (size_t)(r + 1 - T_TOK) * 2048, p.g_mem, p.memn + (size_t)(r - T_TOK) * 2048, p.memn + (size_t)(r + 1 - T_TOK) * 2048, lane);
  }
  float* tile = (float*)smem;
  for (int id0 = blockIdx.x; id0 < 1296; id0 += gridDim.x) {
    int id = id0;
    const float* W; bfr* Wt; int K, N; const float* cs = nullptr; const float* rsc = nullptr;
    if (id < 512) { W = p.w_in; Wt = p.wInT; K = 2048; N = 4096; }
    else if ((id -= 512) < 256) { W = p.w_out; Wt = p.wOutT; K = 2048; N = 2048; }
    else if ((id -= 256) < 256) { W = p.w_pq; Wt = p.wPqT; K = 2048; N = 2048; rsc = p.g_ffn; }
    else if ((id -= 256) < 64) { W = p.w_cq; Wt = p.wCqT; K = 2048; N = 512; rsc = p.g_cross; }
    else if ((id -= 64) < 64) { W = p.w_ck; Wt = p.wCkT; K = 2048; N = 512; }
    else if ((id -= 64) < 64) { W = p.w_cv; Wt = p.wCvT; K = 2048; N = 512; }
    else if ((id -= 64) < 64) { W = p.w_co; Wt = p.wCoT; K = 512; N = 2048; }
    else { id -= 64; const int g = id >> 2; id &= 3; W = p.w_pool + g * 65536; Wt = p.wPoolT + g * 65536; K = 256; N = 256; cs = p.pool_scale + g * 256; }
    const int ntn = N >> 8;
    const int kt = id / ntn, nt = id % ntn;
    transpose_strip(W, K, N, kt * 64, nt * 256, Wt, tile, cs, rsc);
  }
  for (int i = blockIdx.x * NTHREADS + threadIdx.x; i < T_TOK; i += gridDim.x * NTHREADS) { p.rowss1[i] = 0.f; p.rowss2[i] = 0.f; }
  convert_f32_bf16(p.sk1f, p.sk1, 128 * 128 / 8);
  convert_f32_bf16(p.sk2f, p.sk2, 128 * 128 / 8);
  quant_rows_fp4<true>(p, blockIdx.x * 8 + wid, gridDim.x * 8, lane);
}

DI void phase_inproj(const Params& p, char* smem) {
  auto epi = [&](const Acc8& acc0, int pm, int pn, int wr, int wc, int fr, int fq) {
    const int region = pn >> 2;
    if (region == 0) {
      G8_FOREACH(acc0, pm, pn, wr, wc, fr, fq, ai, bj, m, n, row, col) {
        const f32x4 v = acc0[ai][bj][m][n];
        u32x2 o; o[0] = pack2(v[0], v[1]); o[1] = pack2(v[2], v[3]);
        *(u32x2*)(p.pbuf + (size_t)row * 1024 + col) = o;
      }
    } else {
      bfr* dst = (region == 1) ? p.qbuf : (region == 2 ? p.kbuf : p.vbuf);
      const float scale = (region == 1) ? 0.08838834764831845f : 1.0f;
      const bool rope = (region != 3) && (wc == 0);
#pragma unroll
      for (int ai = 0; ai < 2; ++ai)
#pragma unroll
        for (int m = 0; m < 4; ++m) {
          const int row = 256 * pm + 128 * ai + 64 * wr + 16 * m + fr;
          const int b = row >> 12, t = row & 4095;
          float sn[4], cs[4];
          if (rope) {
            const float posf = (float)p.pos[row];
#pragma unroll
            for (int i = 0; i < 4; ++i) {
              const int j = fq * 4 + i;
              const float inv = exp2f(-(float)j * (18.931568569324174f / 16.0f));
              sincosf(posf * inv, &sn[i], &cs[i]);
            }
          }
#pragma unroll
          for (int bj = 0; bj < 2; ++bj) {
            const int h = (pn & 3) * 2 + bj;
            f32x4 v0 = acc0[ai][bj][m][0], v1 = acc0[ai][bj][m][1];
            if (rope) {
#pragma unroll
              for (int i = 0; i < 4; ++i) {
                const float x1 = v0[i], x2 = v1[i];
                v0[i] = x1 * cs[i] - x2 * sn[i];
                v1[i] = x2 * cs[i] + x1 * sn[i];
              }
            }
            bfr* drow = dst + ((size_t)((b * 8 + h) * 4096 + t)) * 128 + 32 * wc + 4 * fq;
            u32x2 o0, o1;
            o0[0] = pack2(v0[0] * scale, v0[1] * scale); o0[1] = pack2(v0[2] * scale, v0[3] * scale);
            o1[0] = pack2(v1[0] * scale, v1[1] * scale); o1[1] = pack2(v1[2] * scale, v1[3] * scale);
            *(u32x2*)(drow) = o0;
            *(u32x2*)(drow + 16) = o1;
          }
        }
    }
  };
  gemm8((LAS unsigned char*)smem, p.hbuf, 2048, p.wInT, T_TOK, 4096, 2048, gridDim.x, blockIdx.x, epi);
}

DI void phase_mix_attn(const Params& p, char* smem) {
  const int tid = threadIdx.x, lane = tid & 63, w = tid >> 6, fr = lane & 15, fq = lane >> 4;
  {
    char* sK = smem;
    char* sV = smem + 65536;
    u32x4 kr[8], vr[8];
    bf16x8 qn[4];
    auto decode = [&](int id, int& br, int& dl, int& bh, int& r, int& l0) {
      br = id >> 10;
      const int rem = id & 1023;
      dl = (br == 0) ? 1 : (br == 1 ? 4 : 16);
      const int nblk = 32 / dl;
      bh = rem >> 5;
      const int rn = rem & 31;
      r = rn / nblk;
      l0 = (rn % nblk) * 128;
    };
    auto issue = [&](int id) {
      int br, dl, bh, r, l0;
      decode(id, br, dl, bh, r, l0);
      const size_t base = (size_t)bh * 4096 * 128 + (size_t)r * 128;
      const bfr* Kb = p.kbuf + base;
      const bfr* Vb = p.vbuf + base;
      const int kvstride = dl * 128, key0 = l0 - 128;
#pragma unroll
      for (int i = 0; i < 8; ++i) {
        const int e = tid + i * 512, key = e >> 4, c = e & 15, lk = key0 + key;
        const int lkc = lk < 0 ? 0 : lk;
        const unsigned msk = lk < 0 ? 0u : 0xffffffffu;
        kr[i] = *(const u32x4*)(Kb + (long)lkc * kvstride + c * 8);
        vr[i] = *(const u32x4*)(Vb + (long)lkc * kvstride + c * 8);
        kr[i] &= u32x4{msk, msk, msk, msk};
        vr[i] &= u32x4{msk, msk, msk, msk};
      }
      const bfr* qrow = p.qbuf + base + (long)(l0 + w * 16 + fr) * kvstride;
#pragma unroll
      for (int kk = 0; kk < 4; ++kk) qn[kk] = *(const bf16x8*)(qrow + kk * 32 + fq * 8);
    };
    const bool remap = (gridDim.x == 256);
    const int nround = remap ? 12 : (3072 + (int)gridDim.x - 1) / (int)gridDim.x;
    auto item_of = [&](int k) -> int {
      if (!remap) return k * (int)gridDim.x + (int)blockIdx.x;
      const int xcd = blockIdx.x & 7, slot = blockIdx.x >> 3;
      const int bh = (k / 3) * 8 + xcd, br = k % 3;
      return (br * 32 + bh) * 32 + slot;
    };
    if (item_of(0) < 3072) issue(item_of(0));
    for (int k = 0; k < nround; ++k) {
      const int id = item_of(k);
      if (id >= 3072) break;
      __syncthreads();
#pragma unroll
      for (int i = 0; i < 8; ++i) {
        const int e = tid + i * 512, key = e >> 4, c = e & 15;
        *(u32x4*)(sK + key * 256 + ((c ^ (key & 15)) << 4)) = kr[i];
        *(u32x4*)(sV + key * 288 + c * 16) = vr[i];
      }
      bf16x8 qf[4];
#pragma unroll
      for (int kk = 0; kk < 4; ++kk) qf[kk] = qn[kk];
      __syncthreads();
      const int nid = (k + 1 < nround) ? item_of(k + 1) : 3072;
      if (nid < 3072) issue(nid);
      int br, dl, bh, r, l0;
      decode(id, br, dl, bh, r, l0);
      float mx, l;
      const int b = bh >> 3, h = bh & 7;
      const int tt = b * 4096 + (l0 + w * 16 + fr) * dl + r;
      bfr* obase = p.ob + (size_t)br * T_TOK * 1024 + h * 128;
      const int tq0 = b * 4096 + r, lw = l0 + w * 16;
      attn_compute<true>(qf, l0, l0 - 128, smem,
                         [&](int q) { return obase + (size_t)(tq0 + (lw + q) * dl) * 1024; }, mx, l);
      if (fq == 0) p.lse[(size_t)br * T_TOK * 8 + (size_t)tt * 8 + h] = mx + __builtin_amdgcn_logf(l);
    }
  }
  for (int id = 3072 + blockIdx.x; id < 3072 + 256; id += gridDim.x) {
    {
      const int ci = id - 3072;
      const int sub = tid >> 7, cgp = tid & 127;
      const int wdw = 2 << (cgp >> 5);
      const int t0 = ci * 64 + sub * 16, tin0 = t0 & 4095;
      const bfr* pb = p.pbuf + cgp * 8;
      float sum[8];
#pragma unroll
      for (int e = 0; e < 8; ++e) sum[e] = 0.f;
      for (int j = 1; j < wdw; ++j) {
        if (tin0 - j >= 0) {
          const u32x4 v = *(const u32x4*)(pb + (size_t)(t0 - j) * 1024);
#pragma unroll
          for (int e = 0; e < 4; ++e) { sum[2 * e] += bflo(v[e]); sum[2 * e + 1] += bfhi(v[e]); }
        }
      }
      for (int s = 0; s < 16; ++s) {
        const int t = t0 + s, tin = tin0 + s;
        const u32x4 v = *(const u32x4*)(pb + (size_t)t * 1024);
        float cur[8];
#pragma unroll
        for (int e = 0; e < 4; ++e) { cur[2 * e] = bflo(v[e]); cur[2 * e + 1] = bfhi(v[e]); }
        const float ic = 1.f / (float)min(tin + 1, wdw);
        u32x4 ov;
#pragma unroll
        for (int e = 0; e < 8; ++e) sum[e] += cur[e];
#pragma unroll
        for (int e = 0; e < 4; ++e) ov[e] = pack2(sum[2 * e] * ic - cur[2 * e], sum[2 * e + 1] * ic - cur[2 * e + 1]);
        *(u32x4*)(p.mixed + (size_t)t * 1024 + cgp * 8) = ov;
        if (tin - wdw + 1 >= 0) {
          const u32x4 u = *(const u32x4*)(pb + (size_t)(t - wdw + 1) * 1024);
#pragma unroll
          for (int e = 0; e < 4; ++e) { sum[2 * e] -= bflo(u[e]); sum[2 * e + 1] -= bfhi(u[e]); }
        }
      }
    }
  }
}

DI void phase_pool_combine(const Params& p, char* smem) {
  const int tid = threadIdx.x;
  {
    auto epi = [&](const Acc8& acc0, int pm, int pn, int wr, int wc, int fr, int fq) {
      G8_FOREACH(acc0, pm, pn, wr, wc, fr, fq, ai, bj, m, n, row, col) {
        const f32x4 v = acc0[ai][bj][m][n];
        u32x2 o; o[0] = pack2(v[0], v[1]); o[1] = pack2(v[2], v[3]);
        *(u32x2*)(p.hbuf + (size_t)row * 2048 + col) = o;
      }
    };
    gemm8((LAS unsigned char*)smem, p.mixed, 1024, p.wPoolT, T_TOK, 1024, 256, gridDim.x, blockIdx.x, epi, 512);
  }
  for (long i = (long)blockIdx.x * NTHREADS + tid; i < (long)T_TOK * 8 * 16; i += (long)gridDim.x * NTHREADS) {
    const int dc = (int)(i & 15), h = (int)((i >> 4) & 7);
    const long tt = i >> 7;
    const float l0 = p.lse[tt * 8 + h], l1 = p.lse[(size_t)T_TOK * 8 + tt * 8 + h], l2 = p.lse[(size_t)2 * T_TOK * 8 + tt * 8 + h];
    const float mx = fmaxf(l0, fmaxf(l1, l2));
    float w0 = __builtin_amdgcn_exp2f(l0 - mx), w1 = __builtin_amdgcn_exp2f(l1 - mx), w2 = __builtin_amdgcn_exp2f(l2 - mx);
    const float inv = 1.f / (w0 + w1 + w2);
    w0 *= inv; w1 *= inv; w2 *= inv;
    if (ABL == 3) { w0 = 0.f; w1 = 0.f; w2 = 0.f; }
    const size_t off = (size_t)tt * 1024 + h * 128 + dc * 8;
    const u32x4 a = *(const u32x4*)(p.ob + off);
    const u32x4 b = *(const u32x4*)(p.ob + (size_t)T_TOK * 1024 + off);
    const u32x4 c = *(const u32x4*)(p.ob + (size_t)2 * T_TOK * 1024 + off);
    u32x4 o;
#pragma unroll
    for (int e = 0; e < 4; ++e)
      o[e] = pack2(w0 * bflo(a[e]) + w1 * bflo(b[e]) + w2 * bflo(c[e]), w0 * bfhi(a[e]) + w1 * bfhi(b[e]) + w2 * bfhi(c[e]));
    *(u32x4*)(p.hbuf + (size_t)tt * 2048 + 1024 + h * 128 + dc * 8) = o;
  }
}

template <bool RESID_BF16>
DI void phase_gemm_resid(const bfr* A, int lda, const bfr* Bt, int K, const void* resid, bfr* xb, float* rowss, char* smem) {
  auto epi = [&](const Acc8& acc0, int pm, int pn, int wr, int wc, int fr, int fq) {
#pragma unroll
    for (int ai = 0; ai < 2; ++ai)
#pragma unroll
      for (int m = 0; m < 4; ++m) {
        const int row = 256 * pm + 128 * ai + 64 * wr + 16 * m + fr;
        float ss = 0.f;
#pragma unroll
        for (int bj = 0; bj < 2; ++bj)
#pragma unroll
          for (int n = 0; n < 2; ++n) {
            const int col = 256 * pn + 128 * bj + 32 * wc + 16 * n + 4 * fq;
            const f32x4 v = acc0[ai][bj][m][n];
            float4 r;
            if (RESID_BF16) {
              const u32x2 t = *(const u32x2*)((const bfr*)resid + (size_t)row * 2048 + col);
              r.x = bflo(t[0]); r.y = bfhi(t[0]); r.z = bflo(t[1]); r.w = bfhi(t[1]);
            } else {
              r = *(const float4*)((const float*)resid + (size_t)row * 2048 + col);
            }
            float4 o; o.x = r.x + v[0]; o.y = r.y + v[1]; o.z = r.z + v[2]; o.w = r.w + v[3];
            u32x2 ob; ob[0] = pack2(o.x, o.y); ob[1] = pack2(o.z, o.w);
            *(u32x2*)(xb + (size_t)row * 2048 + col) = ob;
            ss += o.x * o.x + o.y * o.y + o.z * o.z + o.w * o.w;
          }
        ss += __shfl_xor(ss, 16);
        ss += __shfl_xor(ss, 32);
        if (fq == 0) atomicAdd(rowss + row, ss);
      }
  };
  gemm8((LAS unsigned char*)smem, A, lda, Bt, T_TOK, 2048, K, gridDim.x, blockIdx.x, epi);
}

DI void phase_gemm_pq(const Params& p, char* smem) {
  auto epi = [&](const Acc8& acc0, int pm, int pn, int wr, int wc, int fr, int fq) {
    G8_FOREACH(acc0, pm, pn, wr, wc, fr, fq, ai, bj, m, n, row, col) {
      const f32x4 v = acc0[ai][bj][m][n];
      const float rs = rsqrtf(p.rowss2[row] * (1.f / 2048.f) + 1e-6f);
      u32x2 o; o[0] = pack2(v[0] * rs, v[1] * rs); o[1] = pack2(v[2] * rs, v[3] * rs);
      *(u32x2*)(p.pq + (size_t)row * 2048 + col) = o;
    }
  };
  gemm8((LAS unsigned char*)smem, p.hbuf, 2048, p.wPqT, T_TOK, 2048, 2048, gridDim.x, blockIdx.x, epi);
}
DI void phase_cross_proj(const Params& p, char* smem) {
  const int half = gridDim.x >> 1;
  if ((int)blockIdx.x < half) {
    auto epi = [&](const Acc8& acc0, int pm, int pn, int wr, int wc, int fr, int fq) {
      G8_FOREACH(acc0, pm, pn, wr, wc, fr, fq, ai, bj, m, n, row, col) {
        const f32x4 v = acc0[ai][bj][m][n];
        const float scale = 0.08838834764831845f * rsqrtf(p.rowss1[row] * (1.f / 2048.f) + 1e-6f);
        u32x2 o; o[0] = pack2(v[0] * scale, v[1] * scale); o[1] = pack2(v[2] * scale, v[3] * scale);
        *(u32x2*)(p.qc + (size_t)row * 512 + col) = o;
      }
    };
    gemm8((LAS unsigned char*)smem, p.x2b, 2048, p.wCqT, T_TOK, 512, 2048, half, blockIdx.x, epi);
  } else if ((int)blockIdx.x < half + 16) {
    auto epi = [&](const Acc8& acc0, int pm, int pn, int wr, int wc, int fr, int fq) {
      G8_FOREACH(acc0, pm, pn, wr, wc, fr, fq, ai, bj, m, n, row, col) {
        const f32x4 v = acc0[ai][bj][m][n];
        bfr* dst = (col < 512) ? p.kc : p.vc;
        const int cc = col & 511, hh = cc >> 7, d = cc & 127, bb = row >> 8, mm = row & 255;
        u32x2 o; o[0] = pack2(v[0], v[1]); o[1] = pack2(v[2], v[3]);
        *(u32x2*)(dst + ((size_t)((bb * 4 + hh) * 256 + mm)) * 128 + d) = o;
      }
    };
    gemm8((LAS unsigned char*)smem, p.memn, 2048, p.wCkT, 1024, 1024, 2048, 16, blockIdx.x - half, epi);
  } else {
    const int nidle = gridDim.x - (half + 16);
    quant_rows_fp4<false>(p, (blockIdx.x - (half + 16)) * 8 + (threadIdx.x >> 6), nidle * 8, threadIdx.x & 63);
  }
}

DI void phase_cross_attn(const Params& p, char* smem) {
  const int tid = threadIdx.x, lane = tid & 63, w = tid >> 6, fr = lane & 15, fq = lane >> 4;
  for (int id = blockIdx.x; id < 512; id += gridDim.x) {
    const int b = id >> 7, h = (id >> 5) & 3, qt = id & 31;
    float mx, l;
    const size_t kvb = (size_t)(b * 4 + h) * 256 * 128;
    bfr* obase = p.oc + (size_t)(b * 4096 + qt * 128 + w * 16) * 512 + h * 128;
    attn_core<false>(p.qc + (size_t)b * 4096 * 512 + h * 128, 512, qt * 128, p.kc + kvb, p.vc + kvb, 128, 0, smem,
                     [&](int q) { return obase + (size_t)q * 512; }, mx, l);
  }
}

template <unsigned AMASK>
DI void route_cands(int (&top)[16], const float (&v1)[16], const float (&v2)[16]) {
#pragma unroll
  for (int a = 0; a < 16; ++a)
#pragma unroll
    for (int b = 0; b < 16; ++b)
      if (((AMASK >> a) & 1u) && (a + 1) * (b + 1) <= 16) topk_insert(top, (f2sort(v1[a] + v2[b]) & ~0xFF) | (a * 16 + b));
}
DI void bitonic_sort16_desc(int (&mg)[16]) {
#pragma unroll
  for (int st = 8; st >= 1; st >>= 1)
#pragma unroll
    for (int i = 0; i < 16; ++i)
      if ((i & st) == 0) { const int hi = max(mg[i], mg[i + st]), lo = min(mg[i], mg[i + st]); mg[i] = hi; mg[i + st] = lo; }
}
DI void phase_peer_route(const Params& p, char* smem) {
  const int tid = threadIdx.x, lane = tid & 63, w = tid >> 6, fr = lane & 15, fq = lane >> 4;
  char* sSK = smem;
  float* scores = (float*)(smem + 65536);
  int* lists = (int*)(smem + 65536 + 67584);
  int* tops = (int*)(smem + 65536);
  constexpr unsigned AM0 = (1u << 0) | (1u << 3) | (1u << 5) | (1u << 8) | (1u << 9) | (1u << 10) | (1u << 11);
  __syncthreads();
#pragma unroll
  for (int i = 0; i < 8; ++i) {
    const int id = tid + i * 512, key = id >> 4, c = id & 15;
    const bfr* src = (key < 128 ? p.sk1 : p.sk2) + (key & 127) * 128 + c * 8;
    *(u32x4*)(sSK + key * 256 + ((c ^ (key & 15)) << 4)) = *(const u32x4*)src;
  }
  for (int id = blockIdx.x; id < 2048; id += gridDim.x) {
    const int tt = id >> 3, h = id & 7;
    const int tok0 = tt * 64;
    __syncthreads();
    {
      const int tg = w & 3, hf = w >> 2;
      const bfr* arow = p.pq + (size_t)(tok0 + tg * 16 + fr) * 2048 + h * 256 + hf * 128;
      bf16x8 af[4];
#pragma unroll
      for (int kk = 0; kk < 4; ++kk) af[kk] = *(const bf16x8*)(arow + kk * 32 + fq * 8);
#pragma unroll
      for (int nt = 0; nt < 8; ++nt) {
        f32x4 a = f32x4{0.f, 0.f, 0.f, 0.f};
        const int key = hf * 128 + nt * 16 + fr;
#pragma unroll
        for (int kk = 0; kk < 4; ++kk) {
          const bf16x8 bfg = *(const bf16x8*)(sSK + key * 256 + (((kk * 4 + fq) ^ fr) << 4));
          a = mfma16(af[kk], bfg, a);
        }
#pragma unroll
        for (int i = 0; i < 4; ++i) scores[(hf * 64 + tg * 16 + fq * 4 + i) * 132 + nt * 16 + fr] = a[i];
      }
    }
    __syncthreads();
    {
      const int row = tid >> 2, part = tid & 3;
      int lst[16];
#pragma unroll
      for (int j = 0; j < 16; ++j) lst[j] = (int)0x80000000;
      const float* srow = scores + row * 132 + part * 32;
#pragma unroll 2
      for (int k4 = 0; k4 < 8; ++k4) {
        const float4 v = *(const float4*)(srow + k4 * 4);
        const int kb = part * 32 + k4 * 4;
        topk_insert(lst, (f2sort(v.x) & ~0x7F) | (kb + 0));
        topk_insert(lst, (f2sort(v.y) & ~0x7F) | (kb + 1));
        topk_insert(lst, (f2sort(v.z) & ~0x7F) | (kb + 2));
        topk_insert(lst, (f2sort(v.w) & ~0x7F) | (kb + 3));
      }
      int mg[16];
#pragma unroll
      for (int i = 0; i < 16; ++i) mg[i] = max(lst[i], __shfl_xor(lst[15 - i], 1));
      bitonic_sort16_desc(mg);
#pragma unroll
      for (int i = 0; i < 16; ++i) lst[i] = max(mg[i], __shfl_xor(mg[15 - i], 2));
      bitonic_sort16_desc(lst);
      if (part == 0) {
#pragma unroll
        for (int j4 = 0; j4 < 4; ++j4) {
          int4 t; t.x = lst[j4 * 4]; t.y = lst[j4 * 4 + 1]; t.z = lst[j4 * 4 + 2]; t.w = lst[j4 * 4 + 3];
          *(int4*)(lists + row * 16 + j4 * 4) = t;
        }
      }
    }
    __syncthreads();
    int top[16];
#pragma unroll
    for (int j = 0; j < 16; ++j) top[j] = (int)0x80000000;
    const int tokl = tid & 63;
    if (tid < 128) {
      float v1[16], v2[16];
#pragma unroll
      for (int j4 = 0; j4 < 4; ++j4) {
        const int4 t1 = *(const int4*)(lists + tokl * 16 + j4 * 4);
        const int4 t2 = *(const int4*)(lists + (64 + tokl) * 16 + j4 * 4);
        v1[j4 * 4] = sort2f(t1.x & ~0x7F); v1[j4 * 4 + 1] = sort2f(t1.y & ~0x7F); v1[j4 * 4 + 2] = sort2f(t1.z & ~0x7F); v1[j4 * 4 + 3] = sort2f(t1.w & ~0x7F);
        v2[j4 * 4] = sort2f(t2.x & ~0x7F); v2[j4 * 4 + 1] = sort2f(t2.y & ~0x7F); v2[j4 * 4 + 2] = sort2f(t2.z & ~0x7F); v2[j4 * 4 + 3] = sort2f(t2.w & ~0x7F);
      }
      if (tid < 64) {
        route_cands<AM0>(top, v1, v2);
      } else {
        route_cands<(~AM0) & 0xFFFFu>(top, v1, v2);
#pragma unroll
        for (int j4 = 0; j4 < 4; ++j4) {
          int4 t; t.x = top[j4 * 4]; t.y = top[j4 * 4 + 1]; t.z = top[j4 * 4 + 2]; t.w = top[j4 * 4 + 3];
          *(int4*)(tops + tokl * 16 + j4 * 4) = t;
        }
      }
    }
    __syncthreads();
    if (tid < 64) {
      int fin[16];
#pragma unroll
      for (int j4 = 0; j4 < 4; ++j4) {
        const int4 t = *(const int4*)(tops + tid * 16 + (3 - j4) * 4);
        fin[j4 * 4 + 0] = max(top[j4 * 4 + 0], t.w);
        fin[j4 * 4 + 1] = max(top[j4 * 4 + 1], t.z);
        fin[j4 * 4 + 2] = max(top[j4 * 4 + 2], t.y);
        fin[j4 * 4 + 3] = max(top[j4 * 4 + 3], t.x);
      }
      int ex[16];
      float val[16];
      float mxv = -3.0e38f;
#pragma unroll
      for (int j = 0; j < 16; ++j) {
        const int code = fin[j] & 0xFF;
        const int i1 = lists[tid * 16 + (code >> 4)] & 0x7F;
        const int i2 = lists[(64 + tid) * 16 + (code & 15)] & 0x7F;
        ex[j] = i1 * 128 + i2;
        val[j] = sort2f(fin[j] & ~0xFF);
        mxv = fmaxf(mxv, val[j]);
      }
      float sum = 0.f;
      float ev[16];
#pragma unroll
      for (int j = 0; j < 16; ++j) { ev[j] = __expf(val[j] - mxv); sum += ev[j]; }
      const float inv = 1.f / sum;
      const size_t ob = (size_t)(tok0 + tid) * 128 + h * 16;
#pragma unroll
      for (int j4 = 0; j4 < 4; ++j4) {
        int4 iv; iv.x = ex[j4 * 4]; iv.y = ex[j4 * 4 + 1]; iv.z = ex[j4 * 4 + 2]; iv.w = ex[j4 * 4 + 3];
        float4 gv; gv.x = ev[j4 * 4] * inv; gv.y = ev[j4 * 4 + 1] * inv; gv.z = ev[j4 * 4 + 2] * inv; gv.w = ev[j4 * 4 + 3] * inv;
        *(int4*)(p.idx + ob + j4 * 4) = iv;
        *(float4*)(p.gates + ob + j4 * 4) = gv;
      }
    }
  }
}

DI float gelu_tanh(float a) {
  const float u = 0.7978845608028654f * (a + 0.044715f * a * a * a);
  return 0.5f * a * (1.f + tanhf(u));
}

#define SB() __builtin_amdgcn_sched_barrier(0)
DI void peer_load8u(u32x4 (&bufa)[8], const unsigned char* tbl, int idxv, int g, int lane) {
#pragma unroll
  for (int k = 0; k < 8; ++k) {
    const int e = __builtin_amdgcn_readlane(idxv, g * 8 + k);
    bufa[k] = *(const u32x4*)(tbl + (size_t)e * 1024 + lane * 16);
  }
}
DI float peer_dot8(const u32x4 (&bufa)[8], const f32x2 (&hp)[16], int lane) {
  float part[8];
#pragma unroll
  for (int k = 0; k < 8; ++k) {
    const u32x4 u = bufa[k];
    f32x2 a2 = f32x2{0.f, 0.f};
#pragma unroll
    for (int c = 0; c < 4; ++c) {
      const unsigned uu = u[c];
      a2 += __builtin_amdgcn_cvt_scalef32_pk_f32_fp4(uu, 1.0f, 0) * hp[c * 4 + 0];
      a2 += __builtin_amdgcn_cvt_scalef32_pk_f32_fp4(uu, 1.0f, 1) * hp[c * 4 + 1];
      a2 += __builtin_amdgcn_cvt_scalef32_pk_f32_fp4(uu, 1.0f, 2) * hp[c * 4 + 2];
      a2 += __builtin_amdgcn_cvt_scalef32_pk_f32_fp4(uu, 1.0f, 3) * hp[c * 4 + 3];
    }
    part[k] = a2[0] + a2[1];
  }
  const bool up4 = (lane & 4) != 0, up2 = (lane & 2) != 0, up1 = (lane & 1) != 0;
  float q[4];
#pragma unroll
  for (int i = 0; i < 4; ++i) {
    const float keep = up4 ? part[i + 4] : part[i];
    const float send = up4 ? part[i] : part[i + 4];
    q[i] = keep + __shfl_xor(send, 4);
  }
  float r[2];
#pragma unroll
  for (int i = 0; i < 2; ++i) {
    const float keep = up2 ? q[i + 2] : q[i];
    const float send = up2 ? q[i] : q[i + 2];
    r[i] = keep + __shfl_xor(send, 2);
  }
  float v = (up1 ? r[1] : r[0]) + __shfl_xor(up1 ? r[0] : r[1], 1);
  v += __shfl_xor(v, 8);
  v += __shfl_xor(v, 16);
  v += __shfl_xor(v, 32);
  return v;
}
DI void peer_acc8(const u32x4 (&bufa)[8], f32x2 (&ys)[16], float cval, int g) {
#pragma unroll
  for (int k = 0; k < 8; ++k) {
    const float ck = __builtin_bit_cast(float, __builtin_amdgcn_readlane(__builtin_bit_cast(int, cval), g * 8 + k));
    const u32x4 u = bufa[k];
#pragma unroll
    for (int c = 0; c < 4; ++c) {
      const unsigned uu = u[c];
      ys[c * 4 + 0] += __builtin_amdgcn_cvt_scalef32_pk_f32_fp4(uu, 1.0f, 0) * ck;
      ys[c * 4 + 1] += __builtin_amdgcn_cvt_scalef32_pk_f32_fp4(uu, 1.0f, 1) * ck;
      ys[c * 4 + 2] += __builtin_amdgcn_cvt_scalef32_pk_f32_fp4(uu, 1.0f, 2) * ck;
      ys[c * 4 + 3] += __builtin_amdgcn_cvt_scalef32_pk_f32_fp4(uu, 1.0f, 3) * ck;
    }
  }
}

DI void phase_peer_expert(const Params& p) {
  const int lane = threadIdx.x & 63, wid = threadIdx.x >> 6;
  bool flag4;
  {
    float c1 = 1.0f, c2 = 2.0f;
    asm volatile("" : "+v"(c1), "+v"(c2));
    const unsigned w4 = __builtin_amdgcn_cvt_scalef32_pk_fp4_f32(0u, c1, c2, 1.0f, 0);
    const f32x2 r4 = __builtin_amdgcn_cvt_scalef32_pk_f32_fp4(w4, 1.0f, 0);
    flag4 = (r4[0] == 2.0f);
  }
  for (int tok = blockIdx.x * 8 + wid; tok < T_TOK; tok += gridDim.x * 8) {
    int myidx[2];
    float mygate[2];
    const float rs2 = rsqrtf(p.rowss2[tok] * (1.f / 2048.f) + 1e-6f);
#pragma unroll
    for (int half = 0; half < 2; ++half) {
      myidx[half] = p.idx[(size_t)tok * 128 + half * 64 + lane];
      mygate[half] = p.gates[(size_t)tok * 128 + half * 64 + lane];
    }
    u32x4 bufAa[8], bufBa[8];
    peer_load8u(bufAa, p.wU8, myidx[0], 0, lane);
    f32x2 hs[16];
    {
      float he[32];
#pragma unroll
      for (int j = 0; j < 2; ++j)
#pragma unroll
        for (int q = 0; q < 2; ++q) {
          const u32x4 t = *(const u32x4*)(p.hbuf + (size_t)tok * 2048 + j * 1024 + lane * 16 + q * 8);
#pragma unroll
          for (int c = 0; c < 4; ++c) { const unsigned tt = t[c]; he[j * 16 + q * 8 + c * 2] = bflo(tt); he[j * 16 + q * 8 + c * 2 + 1] = bfhi(tt); }
        }
#pragma unroll
      for (int i = 0; i < 16; ++i) {
        const float n0 = he[2 * i], n1 = he[2 * i + 1];
        hs[i] = f32x2{flag4 ? n1 : n0, flag4 ? n0 : n1};
      }
    }
    f32x2 ys[16];
#pragma unroll
    for (int e = 0; e < 16; ++e) ys[e] = f32x2{0.f, 0.f};
#pragma unroll 1
    for (int half = 0; half < 2; ++half) {
      const int idxv = half ? myidx[1] : myidx[0];
      const float gate = half ? mygate[1] : mygate[0];
      const float mysu = p.su[idxv], mysv = p.sv[idxv];
      float amine = 0.f;
#pragma unroll 1
      for (int g2 = 0; g2 < 3; ++g2) {
        peer_load8u(bufBa, p.wU8, idxv, 2 * g2 + 1, lane);
        SB();
        { const float v = peer_dot8(bufAa, hs, lane); if ((lane >> 3) == 2 * g2) amine = v; }
        SB();
        peer_load8u(bufAa, p.wU8, idxv, 2 * g2 + 2, lane);
        SB();
        { const float v = peer_dot8(bufBa, hs, lane); if ((lane >> 3) == 2 * g2 + 1) amine = v; }
        SB();
      }
      {
        peer_load8u(bufBa, p.wU8, idxv, 7, lane);
        SB();
        { const float v = peer_dot8(bufAa, hs, lane); if ((lane >> 3) == 6) amine = v; }
        SB();
        peer_load8u(bufAa, p.wV8, idxv, 0, lane);
        SB();
        { const float v = peer_dot8(bufBa, hs, lane); if ((lane >> 3) == 7) amine = v; }
        SB();
      }
      const float cval = gate * gelu_tanh(amine * mysu * rs2) * mysv;
      const int nidx = myidx[1];
#pragma unroll 1
      for (int g2 = 0; g2 < 3; ++g2) {
        peer_load8u(bufBa, p.wV8, idxv, 2 * g2 + 1, lane);
        SB();
        peer_acc8(bufAa, ys, cval, 2 * g2);
        SB();
        peer_load8u(bufAa, p.wV8, idxv, 2 * g2 + 2, lane);
        SB();
        peer_acc8(bufBa, ys, cval, 2 * g2 + 1);
        SB();
      }
      {
        peer_load8u(bufBa, p.wV8, idxv, 7, lane);
        SB();
        peer_acc8(bufAa, ys, cval, 6);
        SB();
        peer_load8u(bufAa, p.wU8, nidx, 0, lane);
        SB();
        peer_acc8(bufBa, ys, cval, 7);
        SB();
      }
    }
    float ss = 0.f;
#pragma unroll
    for (int i = 0; i < 16; ++i) { ys[i] += hs[i]; ss += ys[i][0] * ys[i][0] + ys[i][1] * ys[i][1]; }
    float ye[32];
#pragma unroll
    for (int i = 0; i < 16; ++i) {
      ye[2 * i] = flag4 ? ys[i][1] : ys[i][0];
      ye[2 * i + 1] = flag4 ? ys[i][0] : ys[i][1];
    }
    ss = wave_sum(ss);
    const float rs = rsqrtf(ss * (1.f / 2048.f) + 1e-6f);
#pragma unroll
    for (int j = 0; j < 2; ++j)
#pragma unroll
      for (int q = 0; q < 4; ++q) {
        const float4 gq = *(const float4*)(p.g_final + j * 1024 + lane * 16 + q * 4);
        const int b0 = j * 16 + q * 4;
        float4 o;
        o.x = ye[b0] * rs * gq.x; o.y = ye[b0 + 1] * rs * gq.y; o.z = ye[b0 + 2] * rs * gq.z; o.w = ye[b0 + 3] * rs * gq.w;
        *(float4*)(p.out + (size_t)tok * 2048 + j * 1024 + lane * 16 + q * 4) = o;
      }
  }
}

DI void grid_barrier(unsigned* ctr, unsigned& epoch) {
  asm volatile("s_waitcnt vmcnt(0)" ::: "memory");
  __syncthreads();
  if (threadIdx.x == 0) {
    __builtin_amdgcn_fence(__ATOMIC_RELEASE, "agent");
    asm volatile("s_waitcnt vmcnt(0)" ::: "memory");
    __hip_atomic_fetch_add(ctr, 1u, __ATOMIC_RELAXED, __HIP_MEMORY_SCOPE_AGENT);
    const unsigned target = (epoch + 1u) * gridDim.x;
    unsigned spins = 0;
    while (__hip_atomic_load(ctr, __ATOMIC_RELAXED, __HIP_MEMORY_SCOPE_AGENT) < target) {
      __builtin_amdgcn_s_sleep(1);
      if (++spins > (1u << 24)) break;
    }
    __builtin_amdgcn_fence(__ATOMIC_ACQUIRE, "agent");
    asm volatile("s_waitcnt vmcnt(0)" ::: "memory");
  }
  __syncthreads();
  epoch += 1u;
}

#define XB_TMO      128
#define XB_XCNT(j)  (256  + 64 * (j))
#define XB_XSUB(j)  (1280 + 64 * (j))
#define XB_XGEN(j)  (2304 + 64 * (j))
#define XB_TOP      3328
#define XB_TOPGEN   3392
#define XCD_BAR_WORDS 3456
#define XB_SPIN_CAP (1u << 20)
DI unsigned xb_ld(unsigned* p)              { return __hip_atomic_load(p, __ATOMIC_RELAXED, __HIP_MEMORY_SCOPE_AGENT); }
DI unsigned xb_add(unsigned* p, unsigned v) { return __hip_atomic_fetch_add(p, v, __ATOMIC_RELAXED, __HIP_MEMORY_SCOPE_AGENT); }
DI unsigned xb_xcc_id() { return (unsigned)__builtin_amdgcn_s_getreg((3 << 11) | 20) & 0xFu; }
#define XB_SPIN(cond, bar) do { unsigned _sp = 0; while (cond) { __builtin_amdgcn_s_sleep(1); \
    if ((++_sp & 255u) == 0u) { if (xb_ld(&(bar)[XB_TMO])) break; if (_sp > XB_SPIN_CAP) { atomicAdd(&(bar)[XB_TMO], 1u); break; } } } } while (0)
struct XcdBarrier { unsigned* bar; unsigned x; volatile LAS unsigned* st; };
DI XcdBarrier xcd_barrier_post(unsigned* bar, volatile LAS unsigned* st) {
  XcdBarrier b; b.bar = bar; b.x = xb_xcc_id(); b.st = st;
  if (threadIdx.x == 0) (void)xb_add(&bar[XB_XCNT(b.x)], 1u);
  return b;
}
DI void xcd_barrier_complete(unsigned* bar, unsigned x, unsigned& nloc, unsigned& nx) {
  const unsigned G = gridDim.x * gridDim.y * gridDim.z;
  unsigned sum, cnt, mine, sp = 0u;
  for (;;) {
    sum = 0u; cnt = 0u; mine = 0u;
#pragma unroll
    for (unsigned j = 0; j < 16; ++j) { const unsigned c = xb_ld(&bar[XB_XCNT(j)]); sum += c; cnt += (c > 0u) ? 1u : 0u; mine = (j == x) ? c : mine; }
    if (sum == G) break;
    __builtin_amdgcn_s_sleep(1);
    if ((++sp & 255u) == 0u) { if (xb_ld(&bar[XB_TMO])) break; if (sp > XB_SPIN_CAP) { atomicAdd(&bar[XB_TMO], 1u); break; } }
  }
  nloc = mine > 0u ? mine : 1u; nx = cnt > 0u ? cnt : 1u;
}
DI void xcd_barrier(const XcdBarrier& b) {
  asm volatile("s_waitcnt vmcnt(0)" ::: "memory");
  __syncthreads();
  if (threadIdx.x == 0) {
    unsigned* bar = b.bar;
    __builtin_amdgcn_s_waitcnt(0);
    unsigned nloc = b.st[0], nx = b.st[1];
    if (nloc == 0u) { xcd_barrier_complete(bar, b.x, nloc, nx); b.st[0] = nloc; b.st[1] = nx; }
    const unsigned old = xb_add(&bar[XB_XSUB(b.x)], 1u);
    const unsigned gen = old / nloc;
    if (old + 1u == (gen + 1u) * nloc) {
      __builtin_amdgcn_fence(__ATOMIC_RELEASE, "agent");
      asm volatile("s_waitcnt vmcnt(0)" ::: "memory");
      const unsigned og = xb_add(&bar[XB_TOP], 1u);
      const unsigned tg = og / nx;
      if (og + 1u == (tg + 1u) * nx) xb_add(&bar[XB_TOPGEN], 1u);
      else XB_SPIN(xb_ld(&bar[XB_TOPGEN]) == tg, bar);
      __builtin_amdgcn_fence(__ATOMIC_ACQUIRE, "agent");
      xb_add(&bar[XB_XGEN(b.x)], 1u);
      asm volatile("s_waitcnt vmcnt(0)" ::: "memory");
    } else {
      XB_SPIN(xb_ld(&bar[XB_XGEN(b.x)]) == gen, bar);
      __builtin_amdgcn_fence(__ATOMIC_ACQUIRE, "agent");
      asm volatile("s_waitcnt vmcnt(0)" ::: "memory");
    }
  }
  __syncthreads();
}

__global__ void __launch_bounds__(NTHREADS) mega(Params p, int phase_lo, int phase_hi) {
  __shared__ __attribute__((aligned(16))) char smem[SMEM_BYTES];
  cg::grid_group grid = cg::this_grid();
  unsigned epoch = 0;
  volatile LAS unsigned* xst = (volatile LAS unsigned*)(smem + SMEM_BYTES - 16);
  if (threadIdx.x == 0) { xst[0] = 0u; xst[1] = 0u; }
  __syncthreads();
  const XcdBarrier xbar = xcd_barrier_post(p.bar + 64, xst);
#define PHASE(k, call) if (phase_lo <= (k) && (k) < phase_hi) { if ((k) > phase_lo) { if ((k) == 1) grid.sync(); else xcd_barrier(xbar); } call; if ((DUP_MASK >> (k)) & 1) { xcd_barrier(xbar); call; } }
  PHASE(0, phase_prep(p, smem))
  PHASE(1, phase_inproj(p, smem))
  PHASE(2, phase_mix_attn(p, smem))
  PHASE(3, phase_pool_combine(p, smem))
  PHASE(4, phase_gemm_resid<false>(p.hbuf, 2048, p.wOutT, 2048, p.x, p.x2b, p.rowss1, smem))
  PHASE(6, phase_cross_proj(p, smem))
  PHASE(7, phase_cross_attn(p, smem))
  if (ABL != 2) PHASE(8, phase_gemm_resid<true>(p.oc, 512, p.wCoT, 512, p.x2b, p.hbuf, p.rowss2, smem))
  PHASE(10, phase_gemm_pq(p, smem))
  PHASE(11, phase_peer_route(p, smem))
  PHASE(12, phase_peer_expert(p))
}

extern "C" void kernel_launch(void* const* d_in, const int* in_sizes, int n_in, void* d_out, int out_size, void* d_ws,
                              size_t ws_size, hipStream_t stream) {
  Params p{};
  p.x = (const float*)d_in[0]; p.mem = (const float*)d_in[1]; p.pos = (const int*)d_in[2];
  p.g_mix = (const float*)d_in[3]; p.w_in = (const float*)d_in[4]; p.w_pool = (const float*)d_in[5];
  p.pool_scale = (const float*)d_in[6]; p.w_out = (const float*)d_in[7]; p.g_cross = (const float*)d_in[8];
  p.g_mem = (const float*)d_in[9]; p.w_cq = (const float*)d_in[10]; p.w_ck = (const float*)d_in[11];
  p.w_cv = (const float*)d_in[12]; p.w_co = (const float*)d_in[13]; p.g_ffn = (const float*)d_in[14];
  p.w_pq = (const float*)d_in[15]; p.sk1f = (const float*)d_in[16]; p.sk2f = (const float*)d_in[17];
  p.w_u = (const float*)d_in[18]; p.w_v = (const float*)d_in[19]; p.g_final = (const float*)d_in[20];
  p.out = (float*)d_out;
  char* ws = (char*)d_ws;
  size_t off = 0;
  auto take = [&](size_t bytes) { char* r = ws + off; off += (bytes + 255) & ~(size_t)255; return r; };
  const size_t MB = 1024 * 1024;
  p.wInT = (bfr*)take(16 * MB); p.wPoolT = (bfr*)take(512 * 1024); p.wOutT = (bfr*)take(8 * MB);
  p.wCqT = (bfr*)take(2 * MB); p.wCkT = (bfr*)take(2 * MB); p.wCvT = (bfr*)take(2 * MB); p.wCoT = (bfr*)take(2 * MB);
  p.wPqT = (bfr*)take(8 * MB); p.sk1 = (bfr*)take(32768); p.sk2 = (bfr*)take(32768);
  p.wU8 = (unsigned char*)take(32 * MB); p.wV8 = (unsigned char*)take(32 * MB);
  p.su = (float*)take(65536); p.sv = (float*)take(65536);
  p.memn = (bfr*)take(4 * MB); p.kc = (bfr*)take(1 * MB); p.vc = (bfr*)take(1 * MB);
  p.hbuf = (bfr*)take(64 * MB);
  p.bar = (unsigned*)take(256 + XCD_BAR_WORDS * 4);
  p.rowss1 = (float*)take(65536); p.rowss2 = (float*)take(65536);
  const size_t r2 = off;
  p.qbuf = (bfr*)take(32 * MB); p.kbuf = (bfr*)take(32 * MB); p.vbuf = (bfr*)take(32 * MB);
  p.pbuf = (bfr*)take(32 * MB); p.mixed = (bfr*)take(32 * MB); p.ob = (bfr*)take(96 * MB);
  p.lse = (float*)take((size_t)3 * T_TOK * 8 * 4);
  const size_t end1 = off;
  off = r2;
  p.xres = (float*)take(128 * MB); p.pq = (bfr*)take(64 * MB); p.x2b = p.pq; p.qc = (bfr*)take(16 * MB); p.oc = (bfr*)take(16 * MB);
  p.idx = (int*)take(8 * MB); p.gates = (float*)take(8 * MB);
  const size_t end2 = off;
  const size_t need = end1 > end2 ? end1 : end2;
  if (need > ws_size) { fprintf(stderr, "workspace too small: need %zu have %zu\n", need, ws_size); return; }

  static int grid_blocks = 0;
  if (!grid_blocks) {
    int dev = 0, cus = 0, per_cu = 0;
    hipGetDevice(&dev);
    hipDeviceGetAttribute(&cus, hipDeviceAttributeMultiprocessorCount, dev);
    hipOccupancyMaxActiveBlocksPerMultiprocessor(&per_cu, mega, NTHREADS, 0);
    if (per_cu < 1) per_cu = 1;
    if (per_cu > 1) per_cu = 1;
    grid_blocks = cus * per_cu;
  }
  hipMemsetAsync(p.bar, 0, 256 + XCD_BAR_WORDS * 4, stream);
#if MULTI_LAUNCH
  for (int ph = 0; ph < NPHASE; ++ph) hipLaunchKernelGGL(mega, dim3(grid_blocks), dim3(NTHREADS), 0, stream, p, ph, ph + 1);
#else
  int lo = 0, hi = NPHASE;
  void* args[] = {&p, &lo, &hi};
  hipError_t e = hipLaunchCooperativeKernel((void*)mega, dim3(grid_blocks), dim3(NTHREADS), args, 0, stream);
  if (e != hipSuccess) fprintf(stderr, "cooperative launch failed: %s (grid %d)\n", hipGetErrorString(e), grid_blocks);
#endif
}
```

```cpp
#include <hip/hip_runtime.h>
#include <hip/hip_cooperative_groups.h>
#include <stdint.h>
#include <stdio.h>
namespace cg = cooperative_groups;

#ifndef ABL
#define ABL 0
#endif
#ifndef DUP_MASK
#define DUP_MASK 0
#endif
#ifndef MULTI_LAUNCH
#define MULTI_LAUNCH 0
#endif

#define DI __device__ __forceinline__
typedef unsigned short bfr;
using bf16x8 = __attribute__((ext_vector_type(8))) short;
using s16x4  = __attribute__((ext_vector_type(4))) short;
using f32x4  = __attribute__((ext_vector_type(4))) float;
using u32x4  = __attribute__((ext_vector_type(4))) unsigned;
using u32x2  = __attribute__((ext_vector_type(2))) unsigned;
using bf2    = __attribute__((ext_vector_type(2))) __bf16;
using f32x2  = __attribute__((ext_vector_type(2))) float;
using v6u    = __attribute__((ext_vector_type(6))) unsigned;
using v16f   = __attribute__((ext_vector_type(16))) float;
using v32f   = __attribute__((ext_vector_type(32))) float;

constexpr int T_TOK = 16384;
constexpr int NTHREADS = 512;
constexpr int SMEM_BYTES = 151552;
constexpr int NPHASE = 13;

struct Params {
  const float *x, *mem; const int* pos;
  const float *g_mix, *w_in, *w_pool, *pool_scale, *w_out, *g_cross, *g_mem, *w_cq, *w_ck, *w_cv, *w_co, *g_ffn, *w_pq,
              *sk1f, *sk2f, *w_u, *w_v, *g_final;
  float* out;
  bfr *wInT, *wPoolT, *wOutT, *wCqT, *wCkT, *wCvT, *wCoT, *wPqT, *sk1, *sk2;
  unsigned char *wU8, *wV8; float *su, *sv;
  bfr *hbuf, *memn, *kc, *vc;
  bfr *pbuf, *qbuf, *kbuf, *vbuf, *mixed, *ob; float* lse;
  float* xres; bfr *pq, *qc, *oc; int* idx; float* gates;
  unsigned* bar;
  float *rowss1, *rowss2; bfr* x2b;
};

DI unsigned pack2(float a, float b) { bf2 p; p[0] = (__bf16)a; p[1] = (__bf16)b; return __builtin_bit_cast(unsigned, p); }
DI float bflo(unsigned u) { return __uint_as_float(u << 16); }
DI float bfhi(unsigned u) { return __uint_as_float(u & 0xffff0000u); }
DI float wave_sum(float v) {
#pragma unroll
  for (int o = 32; o >= 1; o >>= 1) v += __shfl_xor(v, o);
  return v;
}
DI f32x4 mfma16(bf16x8 a, bf16x8 b, f32x4 c) { return __builtin_amdgcn_mfma_f32_16x16x32_bf16(a, b, c, 0, 0, 0); }
DI s16x4 tr_read(const char* p) {
  return __builtin_amdgcn_ds_read_tr16_b64_v4i16((s16x4 __attribute__((address_space(3)))*)(p));
}

DI void gemm_main(const bfr* __restrict__ A, int lda, const bfr* __restrict__ Bt, int ldb, int K, char* smem,
                  f32x4 (&acc)[4][4]) {
  const int tid = threadIdx.x, lane = tid & 63, wid = tid >> 6, wm = wid >> 1, wn = wid & 1, fr = lane & 15, fq = lane >> 4;
  const int lrow = tid >> 3, lc = tid & 7;
  const int sw = ((lc ^ (lrow & 7)) << 4);
  u32x4 ra[4], rb[2];
  const bfr* ga = A + (size_t)lrow * lda + lc * 8;
  const bfr* gb = Bt + (size_t)lrow * ldb + lc * 8;
#pragma unroll
  for (int m = 0; m < 4; ++m)
#pragma unroll
    for (int n = 0; n < 4; ++n) acc[m][n] = f32x4{0.f, 0.f, 0.f, 0.f};
  const int nk = K >> 6;
#pragma unroll
  for (int i = 0; i < 4; ++i) ra[i] = *(const u32x4*)(ga + (size_t)(64 * i) * lda);
#pragma unroll
  for (int i = 0; i < 2; ++i) rb[i] = *(const u32x4*)(gb + (size_t)(64 * i) * ldb);
  __syncthreads();
#pragma unroll
  for (int i = 0; i < 4; ++i) *(u32x4*)(smem + (lrow + 64 * i) * 128 + sw) = ra[i];
#pragma unroll
  for (int i = 0; i < 2; ++i) *(u32x4*)(smem + 32768 + (lrow + 64 * i) * 128 + sw) = rb[i];
  __syncthreads();
  for (int kt = 0; kt < nk; ++kt) {
    const char* cur = smem + (kt & 1) * 49152;
    char* nxt = smem + ((kt + 1) & 1) * 49152;
    const bool more = (kt + 1 < nk);
    if (more) {
#pragma unroll
      for (int i = 0; i < 4; ++i) ra[i] = *(const u32x4*)(ga + (size_t)(64 * i) * lda + (kt + 1) * 64);
#pragma unroll
      for (int i = 0; i < 2; ++i) rb[i] = *(const u32x4*)(gb + (size_t)(64 * i) * ldb + (kt + 1) * 64);
    }
#pragma unroll
    for (int kk = 0; kk < 2; ++kk) {
      bf16x8 af[4], bf[4];
      const int co = (((kk * 4 + fq) ^ (fr & 7)) << 4);
#pragma unroll
      for (int m = 0; m < 4; ++m) af[m] = *(const bf16x8*)(cur + (wm * 64 + m * 16 + fr) * 128 + co);
#pragma unroll
      for (int n = 0; n < 4; ++n) bf[n] = *(const bf16x8*)(cur + 32768 + (wn * 64 + n * 16 + fr) * 128 + co);
#pragma unroll
      for (int m = 0; m < 4; ++m)
#pragma unroll
        for (int n = 0; n < 4; ++n) acc[m][n] = mfma16(bf[n], af[m], acc[m][n]);
    }
    if (more) {
#pragma unroll
      for (int i = 0; i < 4; ++i) *(u32x4*)(nxt + (lrow + 64 * i) * 128 + sw) = ra[i];
#pragma unroll
      for (int i = 0; i < 2; ++i) *(u32x4*)(nxt + 32768 + (lrow + 64 * i) * 128 + sw) = rb[i];
    }
    __syncthreads();
  }
}

DI void tile_map(int id, int MT, int NT, int& mt, int& nt) {
  if ((NT & 7) == 0 && (MT & 31) == 0) {
    const int round = id >> 8, local = id & 255, xcd = local & 7, j = local >> 3, mtl = j & 3, ntl = j >> 2;
    const int MR = MT >> 5;
    const int mr = round % MR, nr = round / MR;
    mt = mr * 32 + xcd * 4 + mtl;
    nt = nr * 8 + ntl;
  } else {
    mt = id % MT;
    nt = id / MT;
  }
}


#define LAS __attribute__((address_space(3)))
namespace g8 {
constexpr int BM = 256, BK = 64, HALF = 128, HTB = HALF * BK * 2, NXCD = 8, WGM = 8;
DI int lds_byte(int r, int c) { const int st = (r >> 4) * 2 + (c >> 5), rr = r & 15, cc = c & 31, ob = rr * 64 + cc * 2; return st * 1024 + (ob ^ (((ob >> 9) & 1) << 5)); }
DI int perm32(int rho) { const int n = rho >> 4, i = rho & 15; return 8 * (i >> 2) + 4 * n + (i & 3); }
DI void stage_rc(int b, int& R, int& C) { const int st = b / 1024, sb = b % 1024, swz = sb ^ (((sb >> 9) & 1) << 5); R = (st >> 1) * 16 + swz / 64; C = (st & 1) * 32 + (swz % 64) / 2; }
struct Order {
  int nM, nN, nwg, G, c;
  DI void init(int M, int N, int G_, int c_) { nM = M / BM; nN = N / BM; nwg = nM * nN; G = G_; c = c_; }
  DI bool next(int i, int& pm, int& pn) const {
    const long L = (long)i * G + c; if (L >= nwg) return false;
    int wgid = (int)L; { const int q = nwg / NXCD, r = nwg % NXCD, xcd = wgid % NXCD, off = wgid / NXCD; wgid = (xcd < r ? xcd * (q + 1) : r * (q + 1) + (xcd - r) * q) + off; }
    const int nig = WGM * nN, gid = wgid / nig, fm = gid * WGM, gsz = (nM - fm) < WGM ? (nM - fm) : WGM;
    pm = fm + ((wgid % nig) % gsz); pn = (wgid % nig) / gsz; return true;
  }
};
}

template <class Epi>
DI void gemm8(LAS unsigned char* lds, const bfr* A, int lda, const bfr* Bt, int M, int N, int K, int G, int c, const Epi& E, int a_pn_bytes = 0) {
  using namespace g8;
  const int tid = threadIdx.x, wid = __builtin_amdgcn_readfirstlane(tid >> 6), lane = tid & 63, wr = wid >> 2, wc = wid & 3, fr = lane & 15, fq = lane >> 4;
  const int nt = K / BK;
  Order S; S.init(M, N, G, c);
  unsigned voffA[2], voffB[2];
#pragma unroll
  for (int i = 0; i < 2; ++i) { int R, C; stage_rc(tid * 16 + i * 8192, R, C); const int Rb = (R & ~31) + perm32(R & 31);
    voffA[i] = (unsigned)(R * lda + C) * 2u; voffB[i] = (unsigned)(Rb * K + C) * 2u; }
  const size_t kstep = (size_t)(BK * 2);
  const size_t hstepA = (size_t)HALF * lda * 2, hstepB = (size_t)HALF * K * 2;
  const size_t tstepA = 2 * hstepA, tstepB = 2 * hstepB;
  const unsigned ldsw = (unsigned)wid * 1024u;
  const int aoff = lds_byte(wr * 64 + fr, fq * 8), boff = lds_byte(wc * 32 + fr, fq * 8);
#define G8_SA(b, h) (((b) * 2 + (h)) * HTB)
#define G8_SB(b, h) ((4 + (b) * 2 + (h)) * HTB)
#define G8_STAGE(bufoff, gbase, voff) do { _Pragma("unroll") for (int _i = 0; _i < 2; ++_i) \
    __builtin_amdgcn_global_load_lds((const unsigned*)((const char*)(gbase) + (voff)[_i]), (LAS unsigned*)(lds + (bufoff) + ldsw + _i * 8192), 16, 0, 0); } while (0)
#define G8_LDA(dst, b, h) do { _Pragma("unroll") for (int m = 0; m < 4; ++m) _Pragma("unroll") for (int k = 0; k < 2; ++k) dst[m][k] = *(const LAS bf16x8*)(lds + G8_SA(b, h) + aoff + m * 2048 + k * 1024); } while (0)
#define G8_LDB(dst, b, h) do { _Pragma("unroll") for (int n = 0; n < 2; ++n) _Pragma("unroll") for (int k = 0; k < 2; ++k) dst[n][k] = *(const LAS bf16x8*)(lds + G8_SB(b, h) + boff + n * 2048 + k * 1024); } while (0)
#define G8_MMA(ai, bj, At, Btf) do { __builtin_amdgcn_s_setprio(1); _Pragma("unroll") for (int m = 0; m < 4; ++m) _Pragma("unroll") for (int n = 0; n < 2; ++n) _Pragma("unroll") for (int k = 0; k < 2; ++k) \
    acc[ai][bj][m][n] = __builtin_amdgcn_mfma_f32_16x16x32_bf16(Btf[n][k], At[m][k], acc[ai][bj][m][n], 0, 0, 0); __builtin_amdgcn_s_setprio(0); } while (0)
#define G8_WAIT_V(n) asm volatile("s_waitcnt vmcnt(" #n ")" ::: "memory")
#define G8_WAIT_L(n) asm volatile("s_waitcnt lgkmcnt(" #n ")" ::: "memory")
#define G8_BAR __builtin_amdgcn_s_barrier()
#define G8_SCHED __builtin_amdgcn_sched_barrier(0)
  int cpm, cpn, npm = 0, npn = 0, ui = 0;
  if (!S.next(0, cpm, cpn)) return;
  f32x4 acc[2][2][4][2];
#pragma unroll
  for (int a = 0; a < 2; ++a)
#pragma unroll
    for (int b = 0; b < 2; ++b)
#pragma unroll
      for (int m = 0; m < 4; ++m)
#pragma unroll
        for (int n = 0; n < 2; ++n) acc[a][b][m][n] = f32x4{0.f, 0.f, 0.f, 0.f};
  bf16x8 At[4][2], B0[2][2], B1[2][2];
  const char* cA = (const char*)A + (size_t)cpm * tstepA + (size_t)cpn * a_pn_bytes; const char* cB = (const char*)Bt + (size_t)cpn * tstepB;
  G8_STAGE(G8_SB(0, 0), cB, voffB); G8_STAGE(G8_SA(0, 0), cA, voffA); G8_STAGE(G8_SB(0, 1), cB + hstepB, voffB); G8_STAGE(G8_SA(0, 1), cA + hstepA, voffA);
  if (wr == 1) G8_BAR;
  G8_WAIT_V(4); G8_BAR;
  G8_STAGE(G8_SB(1, 0), cB + kstep, voffB); G8_STAGE(G8_SA(1, 0), cA + kstep, voffA); G8_STAGE(G8_SB(1, 1), cB + hstepB + kstep, voffB);
  G8_WAIT_V(6); G8_BAR;
  for (;;) {
    const bool has_next = S.next(ui + 1, npm, npn);
    const char* nA = has_next ? (const char*)A + (size_t)npm * tstepA + (size_t)npn * a_pn_bytes : cA; const char* nB = has_next ? (const char*)Bt + (size_t)npn * tstepB : cB;
    for (int t = 0; t < nt; t += 2) {
      const bool last = (t == nt - 2);
      const char* a1 = cA + (size_t)(t + 1) * kstep;
      const char* a2 = last ? nA : cA + (size_t)(t + 2) * kstep; const char* b2 = last ? nB : cB + (size_t)(t + 2) * kstep;
      const char* a3 = a2 + kstep; const char* b3 = b2 + kstep;
      G8_LDB(B0, 0, 0); G8_SCHED; G8_LDA(At, 0, 0); G8_STAGE(G8_SA(1, 1), a1 + hstepA, voffA);
      G8_WAIT_L(8); G8_BAR; G8_WAIT_L(0); G8_MMA(0, 0, At, B0); G8_BAR; G8_SCHED;
      G8_LDB(B1, 0, 1); G8_STAGE(G8_SB(0, 0), b2, voffB);
      G8_BAR; G8_WAIT_L(0); G8_MMA(0, 1, At, B1); G8_BAR;
      G8_LDA(At, 0, 1); G8_STAGE(G8_SA(0, 0), a2, voffA);
      G8_BAR; G8_WAIT_L(0); G8_MMA(1, 0, At, B0); G8_BAR; G8_SCHED;
      G8_STAGE(G8_SB(0, 1), b2 + hstepB, voffB);
      G8_WAIT_V(6); G8_BAR; G8_MMA(1, 1, At, B1); G8_BAR;
      G8_LDB(B0, 1, 0); G8_SCHED; G8_LDA(At, 1, 0); G8_STAGE(G8_SA(0, 1), a2 + hstepA, voffA);
      G8_WAIT_L(8); G8_BAR; G8_WAIT_L(0); G8_MMA(0, 0, At, B0); G8_BAR; G8_SCHED;
      G8_LDB(B1, 1, 1); G8_STAGE(G8_SB(1, 0), b3, voffB);
      G8_BAR; G8_WAIT_L(0); G8_MMA(0, 1, At, B1); G8_BAR;
      G8_LDA(At, 1, 1); G8_STAGE(G8_SA(1, 0), a3, voffA);
      G8_BAR; G8_WAIT_L(0); G8_MMA(1, 0, At, B0); G8_BAR; G8_SCHED;
      G8_STAGE(G8_SB(1, 1), b3 + hstepB, voffB);
      G8_WAIT_V(6); G8_BAR; G8_MMA(1, 1, At, B1); G8_BAR;
    }
    E(acc, cpm, cpn, wr, wc, fr, fq);
    if (!has_next) break;
#pragma unroll
    for (int a = 0; a < 2; ++a)
#pragma unroll
      for (int b = 0; b < 2; ++b)
#pragma unroll
        for (int m = 0; m < 4; ++m)
#pragma unroll
          for (int n = 0; n < 2; ++n) acc[a][b][m][n] = f32x4{0.f, 0.f, 0.f, 0.f};
    cpm = npm; cpn = npn; cA = nA; cB = nB; ++ui;
  }
  G8_WAIT_V(0);
  if (wr == 0) G8_BAR;
  G8_BAR;
#undef G8_SA
#undef G8_SB
#undef G8_STAGE
#undef G8_LDA
#undef G8_LDB
#undef G8_MMA
#undef G8_WAIT_V
#undef G8_WAIT_L
#undef G8_BAR
#undef G8_SCHED
}
#define G8_FOREACH8(acc, pm, pn, wr, wc, fr, fq, ai, bj, m, row, col) \
  _Pragma("unroll") for (int ai = 0; ai < 2; ++ai) _Pragma("unroll") for (int m = 0; m < 4; ++m) \
  _Pragma("unroll") for (int bj = 0; bj < 2; ++bj) \
    if (const int row = 256 * (pm) + 128 * ai + 64 * (wr) + 16 * m + (fr); true) if (const int col = 256 * (pn) + 128 * bj + 32 * (wc) + 8 * (fq); true)
DI u32x4 pack8(const f32x4 a, const f32x4 b, float sc) {
  return u32x4{pack2(a[0] * sc, a[1] * sc), pack2(a[2] * sc, a[3] * sc), pack2(b[0] * sc, b[1] * sc), pack2(b[2] * sc, b[3] * sc)};
}
typedef f32x4 Acc8[2][2][4][2];

template <bool BANDED, class RowF>
DI void attn_compute(const bf16x8 (&qf)[4], int q0, int key0, char* smem, RowF rowptr, float& m_out, float& l_out) {
  const int tid = threadIdx.x, lane = tid & 63, w = tid >> 6, fr = lane & 15, fq = lane >> 4;
  char* sK = smem;
  char* sV = smem + 65536;
  constexpr int NT = BANDED ? 10 : 16;
  const int t0 = BANDED ? (w & ~1) : 0;
  f32x4 s[NT];
#pragma unroll
  for (int j = 0; j < NT; ++j) {
    f32x4 a = f32x4{0.f, 0.f, 0.f, 0.f};
    const int key = (t0 + j) * 16 + fr;
#pragma unroll
    for (int kk = 0; kk < 4; ++kk) {
      const bf16x8 kf = *(const bf16x8*)(sK + key * 256 + (((kk * 4 + fq) ^ fr) << 4));
      a = mfma16(kf, qf[kk], a);
    }
    s[j] = a;
  }
  __syncthreads();
  const float L2E = 1.4426950408889634f;
  const float NINF = -__builtin_inff();
  float mx = NINF;
  const int lq = q0 + w * 16 + fr;
#pragma unroll
  for (int j = 0; j < NT; ++j)
#pragma unroll
    for (int i = 0; i < 4; ++i) {
      float v = s[j][i] * L2E;
      if (BANDED) {
        const int lk = key0 + (t0 + j) * 16 + fq * 4 + i;
        const int dist = lq - lk;
        const bool ok = (lk >= 0) && (dist >= 0) && (dist <= 128);
        v = ok ? v : NINF;
      }
      s[j][i] = v;
      mx = fmaxf(mx, v);
    }
  mx = fmaxf(mx, __shfl_xor(mx, 16));
  mx = fmaxf(mx, __shfl_xor(mx, 32));
  float l = 0.f;
#pragma unroll
  for (int j = 0; j < NT; ++j)
#pragma unroll
    for (int i = 0; i < 4; ++i) {
      const float p = __builtin_amdgcn_exp2f(s[j][i] - mx);
      s[j][i] = p;
      l += p;
    }
  l += __shfl_xor(l, 16);
  l += __shfl_xor(l, 32);
  bf16x8 pf[NT / 2];
#pragma unroll
  for (int c = 0; c < NT / 2; ++c) {
    u32x4 t;
    t[0] = pack2(s[2 * c][0], s[2 * c][1]);
    t[1] = pack2(s[2 * c][2], s[2 * c][3]);
    t[2] = pack2(s[2 * c + 1][0], s[2 * c + 1][1]);
    t[3] = pack2(s[2 * c + 1][2], s[2 * c + 1][3]);
    pf[c] = __builtin_bit_cast(bf16x8, t);
  }
  const int q4 = (lane & 15) >> 2, p4 = lane & 3;
  m_out = mx;
  l_out = l;
  char* stage = sK + w * 4224;
  const float il = 1.f / l;
#pragma unroll 2
  for (int dt = 0; dt < 8; ++dt) {
    f32x4 a = f32x4{0.f, 0.f, 0.f, 0.f};
#pragma unroll
    for (int c = 0; c < NT / 2; ++c) {
      const int kb = (t0 + 2 * c) * 16;
      const s16x4 lo = tr_read(sV + (kb + fq * 4 + q4) * 288 + (dt * 16 + p4 * 4) * 2);
      const s16x4 hi = tr_read(sV + (kb + 16 + fq * 4 + q4) * 288 + (dt * 16 + p4 * 4) * 2);
      const bf16x8 vf = __builtin_shufflevector(lo, hi, 0, 1, 2, 3, 4, 5, 6, 7);
      a = mfma16(vf, pf[c], a);
    }
    u32x2 v; v[0] = pack2(a[0] * il, a[1] * il); v[1] = pack2(a[2] * il, a[3] * il);
    *(u32x2*)(stage + fr * 264 + dt * 32 + fq * 8) = v;
  }
  __builtin_amdgcn_wave_barrier();
  asm volatile("" ::: "memory");
#pragma unroll
  for (int j = 0; j < 4; ++j) {
    const int chunk = j * 64 + lane, q = chunk >> 4, c16 = chunk & 15;
    const u32x2 lo = *(const u32x2*)(stage + q * 264 + c16 * 16);
    const u32x2 hi = *(const u32x2*)(stage + q * 264 + c16 * 16 + 8);
    *(u32x4*)(rowptr(q) + c16 * 8) = u32x4{lo[0], lo[1], hi[0], hi[1]};
  }
}

template <bool BANDED, class StoreF>
DI void attn_core(const bfr* __restrict__ Qb, int qstride, int q0, const bfr* __restrict__ Kb, const bfr* __restrict__ Vb,
                  int kvstride, int key0, char* smem, StoreF store, float& m_out, float& l_out) {
  const int tid = threadIdx.x, lane = tid & 63, w = tid >> 6, fr = lane & 15, fq = lane >> 4;
  char* sK = smem;
  char* sV = smem + 65536;
  __syncthreads();
#pragma unroll 1
  for (int rr = 0; rr < 2; ++rr) {
    u32x4 kr[4], vr[4];
#pragma unroll
    for (int i = 0; i < 4; ++i) {
      const int id = tid + (rr * 4 + i) * 512, key = id >> 4, c = id & 15, lk = key0 + key;
      const int lkc = lk < 0 ? 0 : lk;
      const unsigned msk = lk < 0 ? 0u : 0xffffffffu;
      kr[i] = *(const u32x4*)(Kb + (long)lkc * kvstride + c * 8);
      vr[i] = *(const u32x4*)(Vb + (long)lkc * kvstride + c * 8);
      kr[i] &= u32x4{msk, msk, msk, msk};
      vr[i] &= u32x4{msk, msk, msk, msk};
    }
#pragma unroll
    for (int i = 0; i < 4; ++i) {
      const int id = tid + (rr * 4 + i) * 512, key = id >> 4, c = id & 15;
      *(u32x4*)(sK + key * 256 + ((c ^ (key & 15)) << 4)) = kr[i];
      *(u32x4*)(sV + key * 288 + c * 16) = vr[i];
    }
  }
  bf16x8 qf[4];
  {
    const bfr* qrow = Qb + (long)(q0 + w * 16 + fr) * qstride;
#pragma unroll
    for (int kk = 0; kk < 4; ++kk) qf[kk] = *(const bf16x8*)(qrow + kk * 32 + fq * 8);
  }
  __syncthreads();
  attn_compute<BANDED>(qf, q0, key0, smem, store, m_out, l_out);
}

DI int f2sort(float f) { int b = __float_as_int(f); return b ^ ((b >> 31) & 0x7fffffff); }
DI float sort2f(int s) { int b = s ^ ((s >> 31) & 0x7fffffff); return __int_as_float(b); }
DI void topk_insert(int (&lst)[16], int key) {
#pragma unroll
  for (int j = 0; j < 16; ++j) {
    const int hi = max(lst[j], key);
    key = min(lst[j], key);
    lst[j] = hi;
  }
}

template <int O, int N>
DI void bfly(float (&p)[64], int lane) {
  const bool up = (lane & O) != 0;
#pragma unroll
  for (int i = 0; i < N / 2; ++i) {
    const float keep = up ? p[i + N / 2] : p[i];
    const float send = up ? p[i] : p[i + N / 2];
    p[i] = keep + __shfl_xor(send, O);
  }
  if constexpr (O > 1) bfly<O / 2, N / 2>(p, lane);
}

DI void rms_rows2_to_bf16(const float* __restrict__ x0, const float* __restrict__ x1, const float* __restrict__ g,
                          bfr* __restrict__ o0, bfr* __restrict__ o1, int lane) {
  float4 v0[8], v1[8];
#pragma unroll
  for (int j = 0; j < 8; ++j) v0[j] = *(const float4*)(x0 + j * 256 + lane * 4);
#pragma unroll
  for (int j = 0; j < 8; ++j) v1[j] = *(const float4*)(x1 + j * 256 + lane * 4);
  float s0 = 0.f, s1 = 0.f;
#pragma unroll
  for (int j = 0; j < 8; ++j) {
    s0 += v0[j].x * v0[j].x + v0[j].y * v0[j].y + v0[j].z * v0[j].z + v0[j].w * v0[j].w;
    s1 += v1[j].x * v1[j].x + v1[j].y * v1[j].y + v1[j].z * v1[j].z + v1[j].w * v1[j].w;
  }
  s0 = wave_sum(s0);
  s1 = wave_sum(s1);
  const float r0 = rsqrtf(s0 * (1.f / 2048.f) + 1e-6f), r1 = rsqrtf(s1 * (1.f / 2048.f) + 1e-6f);
#pragma unroll
  for (int j = 0; j < 8; ++j) {
    const float4 gg = *(const float4*)(g + j * 256 + lane * 4);
    u32x2 a, c;
    a[0] = pack2(v0[j].x * r0 * gg.x, v0[j].y * r0 * gg.y); a[1] = pack2(v0[j].z * r0 * gg.z, v0[j].w * r0 * gg.w);
    c[0] = pack2(v1[j].x * r1 * gg.x, v1[j].y * r1 * gg.y); c[1] = pack2(v1[j].z * r1 * gg.z, v1[j].w * r1 * gg.w);
    *(u32x2*)(o0 + j * 256 + lane * 4) = a;
    *(u32x2*)(o1 + j * 256 + lane * 4) = c;
  }
}

DI void transpose_tile(const float* __restrict__ W, int K, int N, int k0, int n0, bfr* __restrict__ Wt, float* tile, const float* colscale, const float* rowscale) {
  __syncthreads();
  {
    const int r = threadIdx.x >> 4, c4 = threadIdx.x & 15;
#pragma unroll
    for (int i = 0; i < 2; ++i) {
      const int k = r + 32 * i;
      const float4 v = *(const float4*)(W + (size_t)(k0 + k) * N + n0 + c4 * 4);
      tile[k * 65 + c4 * 4 + 0] = v.x;
      tile[k * 65 + c4 * 4 + 1] = v.y;
      tile[k * 65 + c4 * 4 + 2] = v.z;
      tile[k * 65 + c4 * 4 + 3] = v.w;
    }
  }
  __syncthreads();
  {
    const int n = threadIdx.x >> 3, kc = threadIdx.x & 7;
    u32x4 o;
    const float csv = colscale ? colscale[n0 + n] : 1.0f;
#pragma unroll
    for (int j = 0; j < 4; ++j) {
      const float r0 = rowscale ? rowscale[k0 + kc * 8 + 2 * j] : 1.0f, r1 = rowscale ? rowscale[k0 + kc * 8 + 2 * j + 1] : 1.0f;
      o[j] = pack2(tile[(kc * 8 + 2 * j) * 65 + n] * csv * r0, tile[(kc * 8 + 2 * j + 1) * 65 + n] * csv * r1);
    }
    *(u32x4*)(Wt + (size_t)(n0 + n) * K + k0 + kc * 8) = o;
  }
}

DI void convert_f32_bf16(const float* __restrict__ src, bfr* __restrict__ dst, long n8) {
  for (long i = (long)blockIdx.x * NTHREADS + threadIdx.x; i < n8; i += (long)gridDim.x * NTHREADS) {
    const float4 a = *(const float4*)(src + i * 8);
    const float4 b = *(const float4*)(src + i * 8 + 4);
    u32x4 o;
    o[0] = pack2(a.x, a.y); o[1] = pack2(a.z, a.w); o[2] = pack2(b.x, b.y); o[3] = pack2(b.z, b.w);
    *(u32x4*)(dst + i * 8) = o;
  }
}

DI void transpose_strip(const float* __restrict__ W, int K, int N, int k0, int n0, bfr* __restrict__ Wt, float* tile,
                        const float* colscale, const float* rowscale) {
  const int tid = threadIdx.x;
  __syncthreads();
  {
    const int c4 = tid & 63, r = tid >> 6;
    float4 v[8];
#pragma unroll
    for (int i = 0; i < 8; ++i) v[i] = *(const float4*)(W + (size_t)(k0 + r + 8 * i) * N + n0 + c4 * 4);
#pragma unroll
    for (int i = 0; i < 8; ++i) {
      float* t = tile + (r + 8 * i) * 257 + c4 * 4;
      t[0] = v[i].x; t[1] = v[i].y; t[2] = v[i].z; t[3] = v[i].w;
    }
  }
  __syncthreads();
#pragma unroll
  for (int j = 0; j < 4; ++j) {
    const int task = tid + 512 * j, n = task >> 3, kc = task & 7;
    const float csv = colscale ? colscale[n0 + n] : 1.0f;
    u32x4 o;
#pragma unroll
    for (int e = 0; e < 4; ++e) {
      const int k = kc * 8 + 2 * e;
      const float r0 = rowscale ? rowscale[k0 + k] : 1.0f, r1 = rowscale ? rowscale[k0 + k + 1] : 1.0f;
      o[e] = pack2(tile[k * 257 + n] * csv * r0, tile[(k + 1) * 257 + n] * csv * r1);
    }
    *(u32x4*)(Wt + (size_t)(n0 + n) * K + k0 + kc * 8) = o;
  }
}

template <bool isv>
DI void quant_rows_fp4(const Params& p, int worker, int nworkers, int lane) {
  const float* tbl = isv ? p.w_v : p.w_u;
  float* scl = isv ? p.sv : p.su;
  unsigned char* out8 = isv ? p.wV8 : p.wU8;
  float4 gg[8];
  if (!isv) {
#pragma unroll
    for (int j = 0; j < 2; ++j)
#pragma unroll
      for (int q = 0; q < 4; ++q) gg[j * 4 + q] = *(const float4*)(p.g_ffn + j * 1024 + lane * 16 + q * 4);
  }
  auto finish = [&](float4 (&v)[8], int rr) {
    float amax = 0.f;
#pragma unroll
    for (int i = 0; i < 8; ++i) {
      if (!isv) { v[i].x *= gg[i].x; v[i].y *= gg[i].y; v[i].z *= gg[i].z; v[i].w *= gg[i].w; }
      amax = fmaxf(amax, fmaxf(fmaxf(fabsf(v[i].x), fabsf(v[i].y)), fmaxf(fabsf(v[i].z), fabsf(v[i].w))));
    }
#pragma unroll
    for (int o = 32; o >= 1; o >>= 1) amax = fmaxf(amax, __shfl_xor(amax, o));
    const float inv = amax > 0.f ? 6.0f / amax : 0.f;
    if (lane == 0) scl[rr] = amax * (1.f / 6.0f);
    u32x4 o4;
#pragma unroll
    for (int c = 0; c < 4; ++c) {
      const float4 t0 = v[2 * c], t1 = v[2 * c + 1];
      unsigned w = 0;
      w = __builtin_amdgcn_cvt_scalef32_pk_fp4_f32(w, t0.x * inv, t0.y * inv, 1.0f, 0);
      w = __builtin_amdgcn_cvt_scalef32_pk_fp4_f32(w, t0.z * inv, t0.w * inv, 1.0f, 1);
      w = __builtin_amdgcn_cvt_scalef32_pk_fp4_f32(w, t1.x * inv, t1.y * inv, 1.0f, 2);
      w = __builtin_amdgcn_cvt_scalef32_pk_fp4_f32(w, t1.z * inv, t1.w * inv, 1.0f, 3);
      o4[c] = w;
    }
    *(u32x4*)(out8 + (size_t)rr * 1024 + lane * 16) = o4;
  };
  for (int rr = worker; rr < 16384; rr += 2 * nworkers) {
    const int rb = rr + nworkers;
    const bool hasb = rb < 16384;
    const float* s0 = tbl + (size_t)rr * 2048;
    const float* s1 = tbl + (size_t)(hasb ? rb : rr) * 2048;
    float4 va[8], vb[8];
#pragma unroll
    for (int j = 0; j < 2; ++j)
#pragma unroll
      for (int q = 0; q < 4; ++q) va[j * 4 + q] = *(const float4*)(s0 + j * 1024 + lane * 16 + q * 4);
#pragma unroll
    for (int j = 0; j < 2; ++j)
#pragma unroll
      for (int q = 0; q < 4; ++q) vb[j * 4 + q] = *(const float4*)(s1 + j * 1024 + lane * 16 + q * 4);
    finish(va, rr);
    if (hasb) finish(vb, rb);
  }
}

DI void phase_prep(const Params& p, char* smem) {
  const int lane = threadIdx.x & 63, wid = threadIdx.x >> 6;
  for (int r2 = blockIdx.x * 8 + wid; r2 < (T_TOK + 1024) / 2; r2 += gridDim.x * 8) {
    const int r = 2 * r2;
    if (r < T_TOK) rms_rows2_to_bf16(p.x + (size_t)r * 2048, p.x + (size_t)(r + 1) * 2048, p.g_mix, p.hbuf + (size_t)r * 2048, p.hbuf + (size_t)(r + 1) * 2048, lane);
    else rms_rows2_to_bf16(p.mem + (size_t)(r - T_TOK) * 2048, p.mem + (size_t)(r + 1 - T_TOK) * 2048, p.g_mem, p.memn + (size_t)(r - T_TOK) * 2048, p.memn + (size_t)(r + 1 - T_TOK) * 2048, lane);
  }
  float* tile = (float*)smem;
  for (int id0 = blockIdx.x; id0 < 1296; id0 += gridDim.x) {
    int id = id0;
    const float* W; bfr* Wt; int K, N; const float* cs = nullptr; const float* rsc = nullptr;
    if (id < 512) { W = p.w_in; Wt = p.wInT; K = 2048; N = 4096; }
    else if ((id -= 512) < 256) { W = p.w_out; Wt = p.wOutT; K = 2048; N = 2048; }
    else if ((id -= 256) < 256) { W = p.w_pq; Wt = p.wPqT; K = 2048; N = 2048; rsc = p.g_ffn; }
    else if ((id -= 256) < 64) { W = p.w_cq; Wt = p.wCqT; K = 2048; N = 512; rsc = p.g_cross; }
    else if ((id -= 64) < 64) { W = p.w_ck; Wt = p.wCkT; K = 2048; N = 512; }
    else if ((id -= 64) < 64) { W = p.w_cv; Wt = p.wCvT; K = 2048; N = 512; }
    else if ((id -= 64) < 64) { W = p.w_co; Wt = p.wCoT; K = 512; N = 2048; }
    else { id -= 64; const int g = id >> 2; id &= 3; W = p.w_pool + g * 65536; Wt = p.wPoolT + g * 65536; K = 256; N = 256; cs = p.pool_scale + g * 256; }
    const int ntn = N >> 8;
    const int kt = id / ntn, nt = id % ntn;
    transpose_strip(W, K, N, kt * 64, nt * 256, Wt, tile, cs, rsc);
  }
  for (int i = blockIdx.x * NTHREADS + threadIdx.x; i < T_TOK; i += gridDim.x * NTHREADS) { p.rowss1[i] = 0.f; p.rowss2[i] = 0.f; }
  convert_f32_bf16(p.sk1f, p.sk1, 128 * 128 / 8);
  convert_f32_bf16(p.sk2f, p.sk2, 128 * 128 / 8);
  quant_rows_fp4<true>(p, blockIdx.x * 8 + wid, gridDim.x * 8, lane);
}

DI void phase_inproj(const Params& p, char* smem) {
  auto epi = [&](const Acc8& acc0, int pm, int pn, int wr, int wc, int fr, int fq) {
    const int region = pn >> 2;
    if (region == 0) {
      G8_FOREACH8(acc0, pm, pn, wr, wc, fr, fq, ai, bj, m, row, col) {
        *(u32x4*)(p.pbuf + (size_t)row * 1024 + col) = pack8(acc0[ai][bj][m][0], acc0[ai][bj][m][1], 1.0f);
      }
    } else {
      bfr* dst = (region == 1) ? p.qbuf : (region == 2 ? p.kbuf : p.vbuf);
      const float scale = (region == 1) ? 0.08838834764831845f : 1.0f;
      const bool rope = (region != 3) && (wc == 0);
#pragma unroll
      for (int ai = 0; ai < 2; ++ai)
#pragma unroll
        for (int m = 0; m < 4; ++m) {
          const int row = 256 * pm + 128 * ai + 64 * wr + 16 * m + fr;
          const int b = row >> 12, t = row & 4095;
          float sn[8], cs[8];
          if (rope) {
            const float posf = (float)p.pos[row];
#pragma unroll
            for (int e = 0; e < 8; ++e) {
              const int j = (8 * fq + e) & 15;
              const float inv = exp2f(-(float)j * (18.931568569324174f / 16.0f));
              sincosf(posf * inv, &sn[e], &cs[e]);
            }
          }
#pragma unroll
          for (int bj = 0; bj < 2; ++bj) {
            const int h = (pn & 3) * 2 + bj;
            f32x4 v0 = acc0[ai][bj][m][0], v1 = acc0[ai][bj][m][1];
            if (rope) {
#pragma unroll
              for (int i = 0; i < 4; ++i) {
                const float o0 = __shfl_xor(v0[i], 32), o1 = __shfl_xor(v1[i], 32);
                v0[i] = (fq < 2) ? v0[i] * cs[i] - o0 * sn[i] : v0[i] * cs[i] + o0 * sn[i];
                v1[i] = (fq < 2) ? v1[i] * cs[4 + i] - o1 * sn[4 + i] : v1[i] * cs[4 + i] + o1 * sn[4 + i];
              }
            }
            bfr* drow = dst + ((size_t)((b * 8 + h) * 4096 + t)) * 128 + 32 * wc + 8 * fq;
            *(u32x4*)(drow) = pack8(v0, v1, scale);
          }
        }
    }
  };
  gemm8((LAS unsigned char*)smem, p.hbuf, 2048, p.wInT, T_TOK, 4096, 2048, gridDim.x, blockIdx.x, epi);
}

DI void phase_mix_attn(const Params& p, char* smem) {
  const int tid = threadIdx.x, lane = tid & 63, w = tid >> 6, fr = lane & 15, fq = lane >> 4;
  {
    char* sK = smem;
    char* sV = smem + 65536;
    u32x4 kr[8], vr[8];
    bf16x8 qn[4];
    auto decode = [&](int id, int& br, int& dl, int& bh, int& r, int& l0) {
      br = id >> 10;
      const int rem = id & 1023;
      dl = (br == 0) ? 1 : (br == 1 ? 4 : 16);
      const int nblk = 32 / dl;
      bh = rem >> 5;
      const int rn = rem & 31;
      r = rn / nblk;
      l0 = (rn % nblk) * 128;
    };
    auto issue = [&](int id) {
      int br, dl, bh, r, l0;
      decode(id, br, dl, bh, r, l0);
      const size_t base = (size_t)bh * 4096 * 128 + (size_t)r * 128;
      const bfr* Kb = p.kbuf + base;
      const bfr* Vb = p.vbuf + base;
      const int kvstride = dl * 128, key0 = l0 - 128;
#pragma unroll
      for (int i = 0; i < 8; ++i) {
        const int e = tid + i * 512, key = e >> 4, c = e & 15, lk = key0 + key;
        const int lkc = lk < 0 ? 0 : lk;
        const unsigned msk = lk < 0 ? 0u : 0xffffffffu;
        kr[i] = *(const u32x4*)(Kb + (long)lkc * kvstride + c * 8);
        vr[i] = *(const u32x4*)(Vb + (long)lkc * kvstride + c * 8);
        kr[i] &= u32x4{msk, msk, msk, msk};
        vr[i] &= u32x4{msk, msk, msk, msk};
      }
      const bfr* qrow = p.qbuf + base + (long)(l0 + w * 16 + fr) * kvstride;
#pragma unroll
      for (int kk = 0; kk < 4; ++kk) qn[kk] = *(const bf16x8*)(qrow + kk * 32 + fq * 8);
    };
    const bool remap = (gridDim.x == 256);
    const int nround = remap ? 12 : (3072 + (int)gridDim.x - 1) / (int)gridDim.x;
    auto item_of = [&](int k) -> int {
      if (!remap) return k * (int)gridDim.x + (int)blockIdx.x;
      const int xcd = blockIdx.x & 7, slot = blockIdx.x >> 3;
      const int bh = (k / 3) * 8 + xcd, br = k % 3;
      return (br * 32 + bh) * 32 + slot;
    };
    if (item_of(0) < 3072) issue(item_of(0));
    for (int k = 0; k < nround; ++k) {
      const int id = item_of(k);
      if (id >= 3072) break;
      __syncthreads();
#pragma unroll
      for (int i = 0; i < 8; ++i) {
        const int e = tid + i * 512, key = e >> 4, c = e & 15;
        *(u32x4*)(sK + key * 256 + ((c ^ (key & 15)) << 4)) = kr[i];
        *(u32x4*)(sV + key * 288 + c * 16) = vr[i];
      }
      bf16x8 qf[4];
#pragma unroll
      for (int kk = 0; kk < 4; ++kk) qf[kk] = qn[kk];
      __syncthreads();
      const int nid = (k + 1 < nround) ? item_of(k + 1) : 3072;
      if (nid < 3072) issue(nid);
      int br, dl, bh, r, l0;
      decode(id, br, dl, bh, r, l0);
      float mx, l;
      const int b = bh >> 3, h = bh & 7;
      const int tt = b * 4096 + (l0 + w * 16 + fr) * dl + r;
      bfr* obase = p.ob + (size_t)br * T_TOK * 1024 + h * 128;
      const int tq0 = b * 4096 + r, lw = l0 + w * 16;
      attn_compute<true>(qf, l0, l0 - 128, smem,
                         [&](int q) { return obase + (size_t)(tq0 + (lw + q) * dl) * 1024; }, mx, l);
      if (fq == 0) p.lse[(size_t)br * T_TOK * 8 + (size_t)tt * 8 + h] = mx + __builtin_amdgcn_logf(l);
    }
  }
  for (int id = 3072 + blockIdx.x; id < 3072 + 256; id += gridDim.x) {
    {
      const int ci = id - 3072;
      const int sub = tid >> 7, cgp = tid & 127;
      const int wdw = 2 << (cgp >> 5);
      const int t0 = ci * 64 + sub * 16, tin0 = t0 & 4095;
      const bfr* pb = p.pbuf + cgp * 8;
      float sum[8];
#pragma unroll
      for (int e = 0; e < 8; ++e) sum[e] = 0.f;
      for (int j = 1; j < wdw; ++j) {
        if (tin0 - j >= 0) {
          const u32x4 v = *(const u32x4*)(pb + (size_t)(t0 - j) * 1024);
#pragma unroll
          for (int e = 0; e < 4; ++e) { sum[2 * e] += bflo(v[e]); sum[2 * e + 1] += bfhi(v[e]); }
        }
      }
      for (int s = 0; s < 16; ++s) {
        const int t = t0 + s, tin = tin0 + s;
        const u32x4 v = *(const u32x4*)(pb + (size_t)t * 1024);
        float cur[8];
#pragma unroll
        for (int e = 0; e < 4; ++e) { cur[2 * e] = bflo(v[e]); cur[2 * e + 1] = bfhi(v[e]); }
        const float ic = 1.f / (float)min(tin + 1, wdw);
        u32x4 ov;
#pragma unroll
        for (int e = 0; e < 8; ++e) sum[e] += cur[e];
#pragma unroll
        for (int e = 0; e < 4; ++e) ov[e] = pack2(sum[2 * e] * ic - cur[2 * e], sum[2 * e + 1] * ic - cur[2 * e + 1]);
        *(u32x4*)(p.mixed + (size_t)t * 1024 + cgp * 8) = ov;
        if (tin - wdw + 1 >= 0) {
          const u32x4 u = *(const u32x4*)(pb + (size_t)(t - wdw + 1) * 1024);
#pragma unroll
          for (int e = 0; e < 4; ++e) { sum[2 * e] -= bflo(u[e]); sum[2 * e + 1] -= bfhi(u[e]); }
        }
      }
    }
  }
}

DI void phase_pool_combine(const Params& p, char* smem) {
  const int tid = threadIdx.x;
  {
    auto epi = [&](const Acc8& acc0, int pm, int pn, int wr, int wc, int fr, int fq) {
      G8_FOREACH8(acc0, pm, pn, wr, wc, fr, fq, ai, bj, m, row, col) {
        *(u32x4*)(p.hbuf + (size_t)row * 2048 + col) = pack8(acc0[ai][bj][m][0], acc0[ai][bj][m][1], 1.0f);
      }
    };
    gemm8((LAS unsigned char*)smem, p.mixed, 1024, p.wPoolT, T_TOK, 1024, 256, gridDim.x, blockIdx.x, epi, 512);
  }
  for (long i = (long)blockIdx.x * NTHREADS + tid; i < (long)T_TOK * 8 * 16; i += (long)gridDim.x * NTHREADS) {
    const int dc = (int)(i & 15), h = (int)((i >> 4) & 7);
    const long tt = i >> 7;
    const float l0 = p.lse[tt * 8 + h], l1 = p.lse[(size_t)T_TOK * 8 + tt * 8 + h], l2 = p.lse[(size_t)2 * T_TOK * 8 + tt * 8 + h];
    const float mx = fmaxf(l0, fmaxf(l1, l2));
    float w0 = __builtin_amdgcn_exp2f(l0 - mx), w1 = __builtin_amdgcn_exp2f(l1 - mx), w2 = __builtin_amdgcn_exp2f(l2 - mx);
    const float inv = 1.f / (w0 + w1 + w2);
    w0 *= inv; w1 *= inv; w2 *= inv;
    if (ABL == 3) { w0 = 0.f; w1 = 0.f; w2 = 0.f; }
    const size_t off = (size_t)tt * 1024 + h * 128 + dc * 8;
    const u32x4 a = *(const u32x4*)(p.ob + off);
    const u32x4 b = *(const u32x4*)(p.ob + (size_t)T_TOK * 1024 + off);
    const u32x4 c = *(const u32x4*)(p.ob + (size_t)2 * T_TOK * 1024 + off);
    u32x4 o;
#pragma unroll
    for (int e = 0; e < 4; ++e)
      o[e] = pack2(w0 * bflo(a[e]) + w1 * bflo(b[e]) + w2 * bflo(c[e]), w0 * bfhi(a[e]) + w1 * bfhi(b[e]) + w2 * bfhi(c[e]));
    *(u32x4*)(p.hbuf + (size_t)tt * 2048 + 1024 + h * 128 + dc * 8) = o;
  }
}

template <bool RESID_BF16>
DI void phase_gemm_resid(const bfr* A, int lda, const bfr* Bt, int K, const void* resid, bfr* xb, float* rowss, char* smem) {
  auto epi = [&](const Acc8& acc0, int pm, int pn, int wr, int wc, int fr, int fq) {
#pragma unroll
    for (int ai = 0; ai < 2; ++ai)
#pragma unroll
      for (int m = 0; m < 4; ++m) {
        const int row = 256 * pm + 128 * ai + 64 * wr + 16 * m + fr;
        float ss = 0.f;
#pragma unroll
        for (int bj = 0; bj < 2; ++bj) {
          const int col = 256 * pn + 128 * bj + 32 * wc + 8 * fq;
          const f32x4 v0 = acc0[ai][bj][m][0], v1 = acc0[ai][bj][m][1];
          float r[8];
          if (RESID_BF16) {
            const u32x4 t = *(const u32x4*)((const bfr*)resid + (size_t)row * 2048 + col);
#pragma unroll
            for (int e = 0; e < 4; ++e) { r[2 * e] = bflo(t[e]); r[2 * e + 1] = bfhi(t[e]); }
          } else {
            const float4 t0 = *(const float4*)((const float*)resid + (size_t)row * 2048 + col);
            const float4 t1 = *(const float4*)((const float*)resid + (size_t)row * 2048 + col + 4);
            r[0] = t0.x; r[1] = t0.y; r[2] = t0.z; r[3] = t0.w; r[4] = t1.x; r[5] = t1.y; r[6] = t1.z; r[7] = t1.w;
          }
          f32x4 o0, o1;
#pragma unroll
          for (int e = 0; e < 4; ++e) { o0[e] = r[e] + v0[e]; o1[e] = r[4 + e] + v1[e]; ss += o0[e] * o0[e] + o1[e] * o1[e]; }
          *(u32x4*)(xb + (size_t)row * 2048 + col) = pack8(o0, o1, 1.0f);
        }
        ss += __shfl_xor(ss, 16);
        ss += __shfl_xor(ss, 32);
        if (fq == 0) atomicAdd(rowss + row, ss);
      }
  };
  gemm8((LAS unsigned char*)smem, A, lda, Bt, T_TOK, 2048, K, gridDim.x, blockIdx.x, epi);
}

DI void phase_gemm_pq(const Params& p, char* smem) {
  auto epi = [&](const Acc8& acc0, int pm, int pn, int wr, int wc, int fr, int fq) {
    G8_FOREACH8(acc0, pm, pn, wr, wc, fr, fq, ai, bj, m, row, col) {
      const float rs = rsqrtf(p.rowss2[row] * (1.f / 2048.f) + 1e-6f);
      *(u32x4*)(p.pq + (size_t)row * 2048 + col) = pack8(acc0[ai][bj][m][0], acc0[ai][bj][m][1], rs);
    }
  };
  gemm8((LAS unsigned char*)smem, p.hbuf, 2048, p.wPqT, T_TOK, 2048, 2048, gridDim.x, blockIdx.x, epi);
}
DI void phase_cross_proj(const Params& p, char* smem) {
  const int half = gridDim.x >> 1;
  if ((int)blockIdx.x < half) {
    auto epi = [&](const Acc8& acc0, int pm, int pn, int wr, int wc, int fr, int fq) {
      G8_FOREACH8(acc0, pm, pn, wr, wc, fr, fq, ai, bj, m, row, col) {
        const float scale = 0.08838834764831845f * rsqrtf(p.rowss1[row] * (1.f / 2048.f) + 1e-6f);
        *(u32x4*)(p.qc + (size_t)row * 512 + col) = pack8(acc0[ai][bj][m][0], acc0[ai][bj][m][1], scale);
      }
    };
    gemm8((LAS unsigned char*)smem, p.x2b, 2048, p.wCqT, T_TOK, 512, 2048, half, blockIdx.x, epi);
  } else if ((int)blockIdx.x < half + 16) {
    auto epi = [&](const Acc8& acc0, int pm, int pn, int wr, int wc, int fr, int fq) {
      G8_FOREACH8(acc0, pm, pn, wr, wc, fr, fq, ai, bj, m, row, col) {
        bfr* dst = (col < 512) ? p.kc : p.vc;
        const int cc = col & 511, hh = cc >> 7, d = cc & 127, bb = row >> 8, mm = row & 255;
        *(u32x4*)(dst + ((size_t)((bb * 4 + hh) * 256 + mm)) * 128 + d) = pack8(acc0[ai][bj][m][0], acc0[ai][bj][m][1], 1.0f);
      }
    };
    gemm8((LAS unsigned char*)smem, p.memn, 2048, p.wCkT, 1024, 1024, 2048, 16, blockIdx.x - half, epi);
  } else {
    const int nidle = gridDim.x - (half + 16);
    quant_rows_fp4<false>(p, (blockIdx.x - (half + 16)) * 8 + (threadIdx.x >> 6), nidle * 8, threadIdx.x & 63);
  }
}

DI void phase_cross_attn(const Params& p, char* smem) {
  const int tid = threadIdx.x, lane = tid & 63, w = tid >> 6, fr = lane & 15, fq = lane >> 4;
  for (int id = blockIdx.x; id < 512; id += gridDim.x) {
    const int b = id >> 7, h = (id >> 5) & 3, qt = id & 31;
    float mx, l;
    const size_t kvb = (size_t)(b * 4 + h) * 256 * 128;
    bfr* obase = p.oc + (size_t)(b * 4096 + qt * 128 + w * 16) * 512 + h * 128;
    attn_core<false>(p.qc + (size_t)b * 4096 * 512 + h * 128, 512, qt * 128, p.kc + kvb, p.vc + kvb, 128, 0, smem,
                     [&](int q) { return obase + (size_t)q * 512; }, mx, l);
  }
}

template <unsigned AMASK>
DI void route_cands(int (&top)[16], const float (&v1)[16], const float (&v2)[16]) {
#pragma unroll
  for (int a = 0; a < 16; ++a)
#pragma unroll
    for (int b = 0; b < 16; ++b)
      if (((AMASK >> a) & 1u) && (a + 1) * (b + 1) <= 16) topk_insert(top, (f2sort(v1[a] + v2[b]) & ~0xFF) | (a * 16 + b));
}
DI void bitonic_sort16_desc(int (&mg)[16]) {
#pragma unroll
  for (int st = 8; st >= 1; st >>= 1)
#pragma unroll
    for (int i = 0; i < 16; ++i)
      if ((i & st) == 0) { const int hi = max(mg[i], mg[i + st]), lo = min(mg[i], mg[i + st]); mg[i] = hi; mg[i + st] = lo; }
}
DI void phase_peer_route(const Params& p, char* smem) {
  const int tid = threadIdx.x, lane = tid & 63, w = tid >> 6, fr = lane & 15, fq = lane >> 4;
  char* sSK = smem;
  float* scores = (float*)(smem + 65536);
  int* lists = (int*)(smem + 65536 + 67584);
  int* tops = (int*)(smem + 65536);
  constexpr unsigned AM0 = (1u << 0) | (1u << 3) | (1u << 5) | (1u << 8) | (1u << 9) | (1u << 10) | (1u << 11);
  __syncthreads();
#pragma unroll
  for (int i = 0; i < 8; ++i) {
    const int id = tid + i * 512, key = id >> 4, c = id & 15;
    const bfr* src = (key < 128 ? p.sk1 : p.sk2) + (key & 127) * 128 + c * 8;
    *(u32x4*)(sSK + key * 256 + ((c ^ (key & 15)) << 4)) = *(const u32x4*)src;
  }
  for (int id = blockIdx.x; id < 2048; id += gridDim.x) {
    const int tt = id >> 3, h = id & 7;
    const int tok0 = tt * 64;
    __syncthreads();
    {
      const int tg = w & 3, hf = w >> 2;
      const bfr* arow = p.pq + (size_t)(tok0 + tg * 16 + fr) * 2048 + h * 256 + hf * 128;
      bf16x8 af[4];
#pragma unroll
      for (int kk = 0; kk < 4; ++kk) af[kk] = *(const bf16x8*)(arow + kk * 32 + fq * 8);
#pragma unroll
      for (int nt = 0; nt < 8; ++nt) {
        f32x4 a = f32x4{0.f, 0.f, 0.f, 0.f};
        const int key = hf * 128 + nt * 16 + fr;
#pragma unroll
        for (int kk = 0; kk < 4; ++kk) {
          const bf16x8 bfg = *(const bf16x8*)(sSK + key * 256 + (((kk * 4 + fq) ^ fr) << 4));
          a = mfma16(af[kk], bfg, a);
        }
#pragma unroll
        for (int i = 0; i < 4; ++i) scores[(hf * 64 + tg * 16 + fq * 4 + i) * 132 + nt * 16 + fr] = a[i];
      }
    }
    __syncthreads();
    {
      const int row = tid >> 2, part = tid & 3;
      int lst[16];
#pragma unroll
      for (int j = 0; j < 16; ++j) lst[j] = (int)0x80000000;
      const float* srow = scores + row * 132 + part * 32;
#pragma unroll 2
      for (int k4 = 0; k4 < 8; ++k4) {
        const float4 v = *(const float4*)(srow + k4 * 4);
        const int kb = part * 32 + k4 * 4;
        topk_insert(lst, (f2sort(v.x) & ~0x7F) | (kb + 0));
        topk_insert(lst, (f2sort(v.y) & ~0x7F) | (kb + 1));
        topk_insert(lst, (f2sort(v.z) & ~0x7F) | (kb + 2));
        topk_insert(lst, (f2sort(v.w) & ~0x7F) | (kb + 3));
      }
      int mg[16];
#pragma unroll
      for (int i = 0; i < 16; ++i) mg[i] = max(lst[i], __shfl_xor(lst[15 - i], 1));
      bitonic_sort16_desc(mg);
#pragma unroll
      for (int i = 0; i < 16; ++i) lst[i] = max(mg[i], __shfl_xor(mg[15 - i], 2));
      bitonic_sort16_desc(lst);
      if (part == 0) {
#pragma unroll
        for (int j4 = 0; j4 < 4; ++j4) {
          int4 t; t.x = lst[j4 * 4]; t.y = lst[j4 * 4 + 1]; t.z = lst[j4 * 4 + 2]; t.w = lst[j4 * 4 + 3];
          *(int4*)(lists + row * 16 + j4 * 4) = t;
        }
      }
    }
    __syncthreads();
    int top[16];
#pragma unroll
    for (int j = 0; j < 16; ++j) top[j] = (int)0x80000000;
    const int tokl = tid & 63;
    if (tid < 128) {
      float v1[16], v2[16];
#pragma unroll
      for (int j4 = 0; j4 < 4; ++j4) {
        const int4 t1 = *(const int4*)(lists + tokl * 16 + j4 * 4);
        const int4 t2 = *(const int4*)(lists + (64 + tokl) * 16 + j4 * 4);
        v1[j4 * 4] = sort2f(t1.x & ~0x7F); v1[j4 * 4 + 1] = sort2f(t1.y & ~0x7F); v1[j4 * 4 + 2] = sort2f(t1.z & ~0x7F); v1[j4 * 4 + 3] = sort2f(t1.w & ~0x7F);
        v2[j4 * 4] = sort2f(t2.x & ~0x7F); v2[j4 * 4 + 1] = sort2f(t2.y & ~0x7F); v2[j4 * 4 + 2] = sort2f(t2.z & ~0x7F); v2[j4 * 4 + 3] = sort2f(t2.w & ~0x7F);
      }
      if (tid < 64) {
        route_cands<AM0>(top, v1, v2);
      } else {
        route_cands<(~AM0) & 0xFFFFu>(top, v1, v2);
#pragma unroll
        for (int j4 = 0; j4 < 4; ++j4) {
          int4 t; t.x = top[j4 * 4]; t.y = top[j4 * 4 + 1]; t.z = top[j4 * 4 + 2]; t.w = top[j4 * 4 + 3];
          *(int4*)(tops + tokl * 16 + j4 * 4) = t;
        }
      }
    }
    __syncthreads();
    if (tid < 64) {
      int fin[16];
#pragma unroll
      for (int j4 = 0; j4 < 4; ++j4) {
        const int4 t = *(const int4*)(tops + tid * 16 + (3 - j4) * 4);
        fin[j4 * 4 + 0] = max(top[j4 * 4 + 0], t.w);
        fin[j4 * 4 + 1] = max(top[j4 * 4 + 1], t.z);
        fin[j4 * 4 + 2] = max(top[j4 * 4 + 2], t.y);
        fin[j4 * 4 + 3] = max(top[j4 * 4 + 3], t.x);
      }
      int ex[16];
      float val[16];
      float mxv = -3.0e38f;
#pragma unroll
      for (int j = 0; j < 16; ++j) {
        const int code = fin[j] & 0xFF;
        const int i1 = lists[tid * 16 + (code >> 4)] & 0x7F;
        const int i2 = lists[(64 + tid) * 16 + (code & 15)] & 0x7F;
        ex[j] = i1 * 128 + i2;
        val[j] = sort2f(fin[j] & ~0xFF);
        mxv = fmaxf(mxv, val[j]);
      }
      float sum = 0.f;
      float ev[16];
#pragma unroll
      for (int j = 0; j < 16; ++j) { ev[j] = __expf(val[j] - mxv); sum += ev[j]; }
      const float inv = 1.f / sum;
      const size_t ob = (size_t)(tok0 + tid) * 128 + h * 16;
#pragma unroll
      for (int j4 = 0; j4 < 4; ++j4) {
        int4 iv; iv.x = ex[j4 * 4]; iv.y = ex[j4 * 4 + 1]; iv.z = ex[j4 * 4 + 2]; iv.w = ex[j4 * 4 + 3];
        float4 gv; gv.x = ev[j4 * 4] * inv; gv.y = ev[j4 * 4 + 1] * inv; gv.z = ev[j4 * 4 + 2] * inv; gv.w = ev[j4 * 4 + 3] * inv;
        *(int4*)(p.idx + ob + j4 * 4) = iv;
        *(float4*)(p.gates + ob + j4 * 4) = gv;
      }
    }
  }
}

DI float gelu_tanh(float a) {
  const float u = 0.7978845608028654f * (a + 0.044715f * a * a * a);
  return 0.5f * a * (1.f + tanhf(u));
}

#define SB() __builtin_amdgcn_sched_barrier(0)
DI void peer_load8u(u32x4 (&bufa)[8], const unsigned char* tbl, int idxv, int g, int lane) {
#pragma unroll
  for (int k = 0; k < 8; ++k) {
    const int e = __builtin_amdgcn_readlane(idxv, g * 8 + k);
    bufa[k] = *(const u32x4*)(tbl + (size_t)e * 1024 + lane * 16);
  }
}
DI float peer_dot8(const u32x4 (&bufa)[8], const f32x2 (&hp)[16], int lane) {
  float part[8];
#pragma unroll
  for (int k = 0; k < 8; ++k) {
    const u32x4 u = bufa[k];
    f32x2 a2 = f32x2{0.f, 0.f};
#pragma unroll
    for (int c = 0; c < 4; ++c) {
      const unsigned uu = u[c];
      a2 += __builtin_amdgcn_cvt_scalef32_pk_f32_fp4(uu, 1.0f, 0) * hp[c * 4 + 0];
      a2 += __builtin_amdgcn_cvt_scalef32_pk_f32_fp4(uu, 1.0f, 1) * hp[c * 4 + 1];
      a2 += __builtin_amdgcn_cvt_scalef32_pk_f32_fp4(uu, 1.0f, 2) * hp[c * 4 + 2];
      a2 += __builtin_amdgcn_cvt_scalef32_pk_f32_fp4(uu, 1.0f, 3) * hp[c * 4 + 3];
    }
    part[k] = a2[0] + a2[1];
  }
  const bool up4 = (lane & 4) != 0, up2 = (lane & 2) != 0, up1 = (lane & 1) != 0;
  float q[4];
#pragma unroll
  for (int i = 0; i < 4; ++i) {
    const float keep = up4 ? part[i + 4] : part[i];
    const float send = up4 ? part[i] : part[i + 4];
    q[i] = keep + __shfl_xor(send, 4);
  }
  float r[2];
#pragma unroll
  for (int i = 0; i < 2; ++i) {
    const float keep = up2 ? q[i + 2] : q[i];
    const float send = up2 ? q[i] : q[i + 2];
    r[i] = keep + __shfl_xor(send, 2);
  }
  float v = (up1 ? r[1] : r[0]) + __shfl_xor(up1 ? r[0] : r[1], 1);
  v += __shfl_xor(v, 8);
  v += __shfl_xor(v, 16);
  v += __shfl_xor(v, 32);
  return v;
}
DI void peer_acc8(const u32x4 (&bufa)[8], f32x2 (&ys)[16], float cval, int g) {
#pragma unroll
  for (int k = 0; k < 8; ++k) {
    const float ck = __builtin_bit_cast(float, __builtin_amdgcn_readlane(__builtin_bit_cast(int, cval), g * 8 + k));
    const u32x4 u = bufa[k];
#pragma unroll
    for (int c = 0; c < 4; ++c) {
      const unsigned uu = u[c];
      ys[c * 4 + 0] += __builtin_amdgcn_cvt_scalef32_pk_f32_fp4(uu, 1.0f, 0) * ck;
      ys[c * 4 + 1] += __builtin_amdgcn_cvt_scalef32_pk_f32_fp4(uu, 1.0f, 1) * ck;
      ys[c * 4 + 2] += __builtin_amdgcn_cvt_scalef32_pk_f32_fp4(uu, 1.0f, 2) * ck;
      ys[c * 4 + 3] += __builtin_amdgcn_cvt_scalef32_pk_f32_fp4(uu, 1.0f, 3) * ck;
    }
  }
}

DI void phase_peer_expert(const Params& p) {
  const int lane = threadIdx.x & 63, wid = threadIdx.x >> 6;
  bool flag4;
  {
    float c1 = 1.0f, c2 = 2.0f;
    asm volatile("" : "+v"(c1), "+v"(c2));
    const unsigned w4 = __builtin_amdgcn_cvt_scalef32_pk_fp4_f32(0u, c1, c2, 1.0f, 0);
    const f32x2 r4 = __builtin_amdgcn_cvt_scalef32_pk_f32_fp4(w4, 1.0f, 0);
    flag4 = (r4[0] == 2.0f);
  }
  for (int tok = blockIdx.x * 8 + wid; tok < T_TOK; tok += gridDim.x * 8) {
    int myidx[2];
    float mygate[2];
    const float rs2 = rsqrtf(p.rowss2[tok] * (1.f / 2048.f) + 1e-6f);
#pragma unroll
    for (int half = 0; half < 2; ++half) {
      myidx[half] = p.idx[(size_t)tok * 128 + half * 64 + lane];
      mygate[half] = p.gates[(size_t)tok * 128 + half * 64 + lane];
    }
    u32x4 bufAa[8], bufBa[8];
    peer_load8u(bufAa, p.wU8, myidx[0], 0, lane);
    f32x2 hs[16];
    {
      float he[32];
#pragma unroll
      for (int j = 0; j < 2; ++j)
#pragma unroll
        for (int q = 0; q < 2; ++q) {
          const u32x4 t = *(const u32x4*)(p.hbuf + (size_t)tok * 2048 + j * 1024 + lane * 16 + q * 8);
#pragma unroll
          for (int c = 0; c < 4; ++c) { const unsigned tt = t[c]; he[j * 16 + q * 8 + c * 2] = bflo(tt); he[j * 16 + q * 8 + c * 2 + 1] = bfhi(tt); }
        }
#pragma unroll
      for (int i = 0; i < 16; ++i) {
        const float n0 = he[2 * i], n1 = he[2 * i + 1];
        hs[i] = f32x2{flag4 ? n1 : n0, flag4 ? n0 : n1};
      }
    }
    f32x2 ys[16];
#pragma unroll
    for (int e = 0; e < 16; ++e) ys[e] = f32x2{0.f, 0.f};
#pragma unroll 1
    for (int half = 0; half < 2; ++half) {
      const int idxv = half ? myidx[1] : myidx[0];
      const float gate = half ? mygate[1] : mygate[0];
      const float mysu = p.su[idxv], mysv = p.sv[idxv];
      float amine = 0.f;
#pragma unroll 1
      for (int g2 = 0; g2 < 3; ++g2) {
        peer_load8u(bufBa, p.wU8, idxv, 2 * g2 + 1, lane);
        SB();
        { const float v = peer_dot8(bufAa, hs, lane); if ((lane >> 3) == 2 * g2) amine = v; }
        SB();
        peer_load8u(bufAa, p.wU8, idxv, 2 * g2 + 2, lane);
        SB();
        { const float v = peer_dot8(bufBa, hs, lane); if ((lane >> 3) == 2 * g2 + 1) amine = v; }
        SB();
      }
      {
        peer_load8u(bufBa, p.wU8, idxv, 7, lane);
        SB();
        { const float v = peer_dot8(bufAa, hs, lane); if ((lane >> 3) == 6) amine = v; }
        SB();
        peer_load8u(bufAa, p.wV8, idxv, 0, lane);
        SB();
        { const float v = peer_dot8(bufBa, hs, lane); if ((lane >> 3) == 7) amine = v; }
        SB();
      }
      const float cval = gate * gelu_tanh(amine * mysu * rs2) * mysv;
      const int nidx = myidx[1];
#pragma unroll 1
      for (int g2 = 0; g2 < 3; ++g2) {
        peer_load8u(bufBa, p.wV8, idxv, 2 * g2 + 1, lane);
        SB();
        peer_acc8(bufAa, ys, cval, 2 * g2);
        SB();
        peer_load8u(bufAa, p.wV8, idxv, 2 * g2 + 2, lane);
        SB();
        peer_acc8(bufBa, ys, cval, 2 * g2 + 1);
        SB();
      }
      {
        peer_load8u(bufBa, p.wV8, idxv, 7, lane);
        SB();
        peer_acc8(bufAa, ys, cval, 6);
        SB();
        peer_load8u(bufAa, p.wU8, nidx, 0, lane);
        SB();
        peer_acc8(bufBa, ys, cval, 7);
        SB();
      }
    }
    float ss = 0.f;
#pragma unroll
    for (int i = 0; i < 16; ++i) { ys[i] += hs[i]; ss += ys[i][0] * ys[i][0] + ys[i][1] * ys[i][1]; }
    float ye[32];
#pragma unroll
    for (int i = 0; i < 16; ++i) {
      ye[2 * i] = flag4 ? ys[i][1] : ys[i][0];
      ye[2 * i + 1] = flag4 ? ys[i][0] : ys[i][1];
    }
    ss = wave_sum(ss);
    const float rs = rsqrtf(ss * (1.f / 2048.f) + 1e-6f);
#pragma unroll
    for (int j = 0; j < 2; ++j)
#pragma unroll
      for (int q = 0; q < 4; ++q) {
        const float4 gq = *(const float4*)(p.g_final + j * 1024 + lane * 16 + q * 4);
        const int b0 = j * 16 + q * 4;
        float4 o;
        o.x = ye[b0] * rs * gq.x; o.y = ye[b0 + 1] * rs * gq.y; o.z = ye[b0 + 2] * rs * gq.z; o.w = ye[b0 + 3] * rs * gq.w;
        *(float4*)(p.out + (size_t)tok * 2048 + j * 1024 + lane * 16 + q * 4) = o;
      }
  }
}

DI void grid_barrier(unsigned* ctr, unsigned& epoch) {
  asm volatile("s_waitcnt vmcnt(0)" ::: "memory");
  __syncthreads();
  if (threadIdx.x == 0) {
    __builtin_amdgcn_fence(__ATOMIC_RELEASE, "agent");
    asm volatile("s_waitcnt vmcnt(0)" ::: "memory");
    __hip_atomic_fetch_add(ctr, 1u, __ATOMIC_RELAXED, __HIP_MEMORY_SCOPE_AGENT);
    const unsigned target = (epoch + 1u) * gridDim.x;
    unsigned spins = 0;
    while (__hip_atomic_load(ctr, __ATOMIC_RELAXED, __HIP_MEMORY_SCOPE_AGENT) < target) {
      __builtin_amdgcn_s_sleep(1);
      if (++spins > (1u << 24)) break;
    }
    __builtin_amdgcn_fence(__ATOMIC_ACQUIRE, "agent");
    asm volatile("s_waitcnt vmcnt(0)" ::: "memory");
  }
  __syncthreads();
  epoch += 1u;
}

#define XB_TMO      128
#define XB_XCNT(j)  (256  + 64 * (j))
#define XB_XSUB(j)  (1280 + 64 * (j))
#define XB_XGEN(j)  (2304 + 64 * (j))
#define XB_TOP      3328
#define XB_TOPGEN   3392
#define XCD_BAR_WORDS 3456
#define XB_SPIN_CAP (1u << 20)
DI unsigned xb_ld(unsigned* p)              { return __hip_atomic_load(p, __ATOMIC_RELAXED, __HIP_MEMORY_SCOPE_AGENT); }
DI unsigned xb_add(unsigned* p, unsigned v) { return __hip_atomic_fetch_add(p, v, __ATOMIC_RELAXED, __HIP_MEMORY_SCOPE_AGENT); }
DI unsigned xb_xcc_id() { return (unsigned)__builtin_amdgcn_s_getreg((3 << 11) | 20) & 0xFu; }
#define XB_SPIN(cond, bar) do { unsigned _sp = 0; while (cond) { __builtin_amdgcn_s_sleep(1); \
    if ((++_sp & 255u) == 0u) { if (xb_ld(&(bar)[XB_TMO])) break; if (_sp > XB_SPIN_CAP) { atomicAdd(&(bar)[XB_TMO], 1u); break; } } } } while (0)
struct XcdBarrier { unsigned* bar; unsigned x; volatile LAS unsigned* st; };
DI XcdBarrier xcd_barrier_post(unsigned* bar, volatile LAS unsigned* st) {
  XcdBarrier b; b.bar = bar; b.x = xb_xcc_id(); b.st = st;
  if (threadIdx.x == 0) (void)xb_add(&bar[XB_XCNT(b.x)], 1u);
  return b;
}
DI void xcd_barrier_complete(unsigned* bar, unsigned x, unsigned& nloc, unsigned& nx) {
  const unsigned G = gridDim.x * gridDim.y * gridDim.z;
  unsigned sum, cnt, mine, sp = 0u;
  for (;;) {
    sum = 0u; cnt = 0u; mine = 0u;
#pragma unroll
    for (unsigned j = 0; j < 16; ++j) { const unsigned c = xb_ld(&bar[XB_XCNT(j)]); sum += c; cnt += (c > 0u) ? 1u : 0u; mine = (j == x) ? c : mine; }
    if (sum == G) break;
    __builtin_amdgcn_s_sleep(1);
    if ((++sp & 255u) == 0u) { if (xb_ld(&bar[XB_TMO])) break; if (sp > XB_SPIN_CAP) { atomicAdd(&bar[XB_TMO], 1u); break; } }
  }
  nloc = mine > 0u ? mine : 1u; nx = cnt > 0u ? cnt : 1u;
}
DI void xcd_barrier(const XcdBarrier& b) {
  asm volatile("s_waitcnt vmcnt(0)" ::: "memory");
  __syncthreads();
  if (threadIdx.x == 0) {
    unsigned* bar = b.bar;
    __builtin_amdgcn_s_waitcnt(0);
    unsigned nloc = b.st[0], nx = b.st[1];
    if (nloc == 0u) { xcd_barrier_complete(bar, b.x, nloc, nx); b.st[0] = nloc; b.st[1] = nx; }
    const unsigned old = xb_add(&bar[XB_XSUB(b.x)], 1u);
    const unsigned gen = old / nloc;
    if (old + 1u == (gen + 1u) * nloc) {
      __builtin_amdgcn_fence(__ATOMIC_RELEASE, "agent");
      asm volatile("s_waitcnt vmcnt(0)" ::: "memory");
      const unsigned og = xb_add(&bar[XB_TOP], 1u);
      const unsigned tg = og / nx;
      if (og + 1u == (tg + 1u) * nx) xb_add(&bar[XB_TOPGEN], 1u);
      else XB_SPIN(xb_ld(&bar[XB_TOPGEN]) == tg, bar);
      __builtin_amdgcn_fence(__ATOMIC_ACQUIRE, "agent");
      xb_add(&bar[XB_XGEN(b.x)], 1u);
      asm volatile("s_waitcnt vmcnt(0)" ::: "memory");
    } else {
      XB_SPIN(xb_ld(&bar[XB_XGEN(b.x)]) == gen, bar);
      __builtin_amdgcn_fence(__ATOMIC_ACQUIRE, "agent");
      asm volatile("s_waitcnt vmcnt(0)" ::: "memory");
    }
  }
  __syncthreads();
}

__global__ void __launch_bounds__(NTHREADS) mega(Params p, int phase_lo, int phase_hi) {
  __shared__ __attribute__((aligned(16))) char smem[SMEM_BYTES];
  cg::grid_group grid = cg::this_grid();
  unsigned epoch = 0;
  volatile LAS unsigned* xst = (volatile LAS unsigned*)(smem + SMEM_BYTES - 16);
  if (threadIdx.x == 0) { xst[0] = 0u; xst[1] = 0u; }
  __syncthreads();
  const XcdBarrier xbar = xcd_barrier_post(p.bar + 64, xst);
  if (phase_hi > 1000) grid.sync();
#define PHASE(k, call) if (phase_lo <= (k) && (k) < phase_hi) { if ((k) > phase_lo) { xcd_barrier(xbar); } call; if ((DUP_MASK >> (k)) & 1) { xcd_barrier(xbar); call; } }
  PHASE(0, phase_prep(p, smem))
  PHASE(1, phase_inproj(p, smem))
  PHASE(2, phase_mix_attn(p, smem))
  PHASE(3, phase_pool_combine(p, smem))
  PHASE(4, phase_gemm_resid<false>(p.hbuf, 2048, p.wOutT, 2048, p.x, p.x2b, p.rowss1, smem))
  PHASE(6, phase_cross_proj(p, smem))
  PHASE(7, phase_cross_attn(p, smem))
  if (ABL != 2) PHASE(8, phase_gemm_resid<true>(p.oc, 512, p.wCoT, 512, p.x2b, p.hbuf, p.rowss2, smem))
  PHASE(10, phase_gemm_pq(p, smem))
  PHASE(11, phase_peer_route(p, smem))
  PHASE(12, phase_peer_expert(p))
}

extern "C" void kernel_launch(void* const* d_in, const int* in_sizes, int n_in, void* d_out, int out_size, void* d_ws,
                              size_t ws_size, hipStream_t stream) {
  Params p{};
  p.x = (const float*)d_in[0]; p.mem = (const float*)d_in[1]; p.pos = (const int*)d_in[2];
  p.g_mix = (const float*)d_in[3]; p.w_in = (const float*)d_in[4]; p.w_pool = (const float*)d_in[5];
  p.pool_scale = (const float*)d_in[6]; p.w_out = (const float*)d_in[7]; p.g_cross = (const float*)d_in[8];
  p.g_mem = (const float*)d_in[9]; p.w_cq = (const float*)d_in[10]; p.w_ck = (const float*)d_in[11];
  p.w_cv = (const float*)d_in[12]; p.w_co = (const float*)d_in[13]; p.g_ffn = (const float*)d_in[14];
  p.w_pq = (const float*)d_in[15]; p.sk1f = (const float*)d_in[16]; p.sk2f = (const float*)d_in[17];
  p.w_u = (const float*)d_in[18]; p.w_v = (const float*)d_in[19]; p.g_final = (const float*)d_in[20];
  p.out = (float*)d_out;
  char* ws = (char*)d_ws;
  size_t off = 0;
  auto take = [&](size_t bytes) { char* r = ws + off; off += (bytes + 255) & ~(size_t)255; return r; };
  const size_t MB = 1024 * 1024;
  p.wInT = (bfr*)take(16 * MB); p.wPoolT = (bfr*)take(512 * 1024); p.wOutT = (bfr*)take(8 * MB);
  p.wCqT = (bfr*)take(2 * MB); p.wCkT = (bfr*)take(2 * MB); p.wCvT = (bfr*)take(2 * MB); p.wCoT = (bfr*)take(2 * MB);
  p.wPqT = (bfr*)take(8 * MB); p.sk1 = (bfr*)take(32768); p.sk2 = (bfr*)take(32768);
  p.wU8 = (unsigned char*)take(32 * MB); p.wV8 = (unsigned char*)take(32 * MB);
  p.su = (float*)take(65536); p.sv = (float*)take(65536);
  p.memn = (bfr*)take(4 * MB); p.kc = (bfr*)take(1 * MB); p.vc = (bfr*)take(1 * MB);
  p.hbuf = (bfr*)take(64 * MB);
  p.bar = (unsigned*)take(256 + XCD_BAR_WORDS * 4);
  p.rowss1 = (float*)take(65536); p.rowss2 = (float*)take(65536);
  const size_t r2 = off;
  p.qbuf = (bfr*)take(32 * MB); p.kbuf = (bfr*)take(32 * MB); p.vbuf = (bfr*)take(32 * MB);
  p.pbuf = (bfr*)take(32 * MB); p.mixed = (bfr*)take(32 * MB); p.ob = (bfr*)take(96 * MB);
  p.lse = (float*)take((size_t)3 * T_TOK * 8 * 4);
  const size_t end1 = off;
  off = r2;
  p.xres = (float*)take(128 * MB); p.pq = (bfr*)take(64 * MB); p.x2b = p.pq; p.qc = (bfr*)take(16 * MB); p.oc = (bfr*)take(16 * MB);
  p.idx = (int*)take(8 * MB); p.gates = (float*)take(8 * MB);
  const size_t end2 = off;
  const size_t need = end1 > end2 ? end1 : end2;
  if (need > ws_size) { fprintf(stderr, "workspace too small: need %zu have %zu\n", need, ws_size); return; }

  static int grid_blocks = 0;
  if (!grid_blocks) {
    int dev = 0, cus = 0, per_cu = 0;
    hipGetDevice(&dev);
    hipDeviceGetAttribute(&cus, hipDeviceAttributeMultiprocessorCount, dev);
    hipOccupancyMaxActiveBlocksPerMultiprocessor(&per_cu, mega, NTHREADS, 0);
    if (per_cu < 1) per_cu = 1;
    if (per_cu > 1) per_cu = 1;
    grid_blocks = cus * per_cu;
  }
  hipMemsetAsync(p.bar, 0, 256 + XCD_BAR_WORDS * 4, stream);
#if MULTI_LAUNCH
  for (int ph = 0; ph < NPHASE; ++ph) hipLaunchKernelGGL(mega, dim3(grid_blocks), dim3(NTHREADS), 0, stream, p, ph, ph + 1);
#else
  int lo = 0, hi = NPHASE;
  void* args[] = {&p, &lo, &hi};
  hipError_t e = hipLaunchCooperativeKernel((void*)mega, dim3(grid_blocks), dim3(NTHREADS), args, 0, stream);
  if (e != hipSuccess) fprintf(stderr, "cooperative launch failed: %s (grid %d)\n", hipGetErrorString(e), grid_blocks);
#endif
}
```

```cpp
#include <hip/hip_runtime.h>
#include <hip/hip_cooperative_groups.h>
#include <stdint.h>
#include <stdio.h>
namespace cg = cooperative_groups;

#ifndef DUP_MASK
#define DUP_MASK 0
#endif
#ifndef MULTI_LAUNCH
#define MULTI_LAUNCH 0
#endif

#define DI __device__ __forceinline__
typedef unsigned short bfr;
using bf16x8 = __attribute__((ext_vector_type(8))) short;
using s16x4  = __attribute__((ext_vector_type(4))) short;
using f32x4  = __attribute__((ext_vector_type(4))) float;
using u32x4  = __attribute__((ext_vector_type(4))) unsigned;
using u32x2  = __attribute__((ext_vector_type(2))) unsigned;
using bf2    = __attribute__((ext_vector_type(2))) __bf16;
using f32x2  = __attribute__((ext_vector_type(2))) float;
using v6u    = __attribute__((ext_vector_type(6))) unsigned;
using v16f   = __attribute__((ext_vector_type(16))) float;
using v32f   = __attribute__((ext_vector_type(32))) float;

constexpr int T_TOK = 16384;
constexpr int NTHREADS = 512;
constexpr int SMEM_BYTES = 151552;
constexpr int NPHASE = 13;

struct Params {
  const float *x, *mem; const int* pos;
  const float *g_mix, *w_in, *w_pool, *pool_scale, *w_out, *g_cross, *g_mem, *w_cq, *w_ck, *w_cv, *w_co, *g_ffn, *w_pq,
              *sk1f, *sk2f, *w_u, *w_v, *g_final;
  float* out;
  bfr *wInT, *wPoolT, *wOutT, *wCqT, *wCkT, *wCvT, *wCoT, *wPqT, *sk1, *sk2;
  unsigned char *wU8, *wV8; float *su, *sv;
  bfr *hbuf, *memn, *kc, *vc;
  bfr *pbuf, *qbuf, *kbuf, *vbuf, *mixed, *ob; float* lse;
  float* xres; bfr *pq, *qc, *oc; int* idx; float* gates;
  unsigned* bar;
  float *rowss1, *rowss2; bfr* x2b;
  float* ropetab;
};

DI unsigned pack2(float a, float b) { bf2 p; p[0] = (__bf16)a; p[1] = (__bf16)b; return __builtin_bit_cast(unsigned, p); }
DI float bflo(unsigned u) { return __uint_as_float(u << 16); }
DI float bfhi(unsigned u) { return __uint_as_float(u & 0xffff0000u); }
DI float4 ldnt4(const float* p) { const f32x4 v = __builtin_nontemporal_load((const f32x4*)p); return make_float4(v[0], v[1], v[2], v[3]); }
DI float wave_sum(float v) {
#pragma unroll
  for (int o = 32; o >= 1; o >>= 1) v += __shfl_xor(v, o);
  return v;
}
DI f32x4 mfma16(bf16x8 a, bf16x8 b, f32x4 c) { return __builtin_amdgcn_mfma_f32_16x16x32_bf16(a, b, c, 0, 0, 0); }
DI s16x4 tr_read(const char* p) {
  return __builtin_amdgcn_ds_read_tr16_b64_v4i16((s16x4 __attribute__((address_space(3)))*)(p));
}


#define LAS __attribute__((address_space(3)))
namespace g8 {
constexpr int BM = 256, BK = 64, HALF = 128, HTB = HALF * BK * 2, NXCD = 8, WGM = 8;
DI int lds_byte(int r, int c) { const int st = (r >> 4) * 2 + (c >> 5), rr = r & 15, cc = c & 31, ob = rr * 64 + cc * 2; return st * 1024 + (ob ^ (((ob >> 9) & 1) << 5)); }
DI int perm32(int rho) { const int n = rho >> 4, i = rho & 15; return 8 * (i >> 2) + 4 * n + (i & 3); }
DI void stage_rc(int b, int& R, int& C) { const int st = b / 1024, sb = b % 1024, swz = sb ^ (((sb >> 9) & 1) << 5); R = (st >> 1) * 16 + swz / 64; C = (st & 1) * 32 + (swz % 64) / 2; }
struct Order {
  int nM, nN, nwg, G, c;
  DI void init(int M, int N, int G_, int c_) { nM = M / BM; nN = N / BM; nwg = nM * nN; G = G_; c = c_; }
  DI bool next(int i, int& pm, int& pn) const {
    const long L = (long)i * G + c; if (L >= nwg) return false;
    int wgid = (int)L; { const int q = nwg / NXCD, r = nwg % NXCD, xcd = wgid % NXCD, off = wgid / NXCD; wgid = (xcd < r ? xcd * (q + 1) : r * (q + 1) + (xcd - r) * q) + off; }
    const int nig = WGM * nN, gid = wgid / nig, fm = gid * WGM, gsz = (nM - fm) < WGM ? (nM - fm) : WGM;
    pm = fm + ((wgid % nig) % gsz); pn = (wgid % nig) / gsz; return true;
  }
};
}

template <class Epi>
DI void gemm8(LAS unsigned char* lds, const bfr* A, int lda, const bfr* Bt, int M, int N, int K, int G, int c, const Epi& E, int a_pn_bytes = 0) {
  using namespace g8;
  const int tid = threadIdx.x, wid = __builtin_amdgcn_readfirstlane(tid >> 6), lane = tid & 63, wr = wid >> 2, wc = wid & 3, fr = lane & 15, fq = lane >> 4;
  const int nt = K / BK;
  Order S; S.init(M, N, G, c);
  unsigned voffA[2], voffB[2];
#pragma unroll
  for (int i = 0; i < 2; ++i) { int R, C; stage_rc(tid * 16 + i * 8192, R, C); const int Rb = (R & ~31) + perm32(R & 31);
    voffA[i] = (unsigned)(R * lda + C) * 2u; voffB[i] = (unsigned)(Rb * K + C) * 2u; }
  const size_t kstep = (size_t)(BK * 2);
  const size_t hstepA = (size_t)HALF * lda * 2, hstepB = (size_t)HALF * K * 2;
  const size_t tstepA = 2 * hstepA, tstepB = 2 * hstepB;
  const unsigned ldsw = (unsigned)wid * 1024u;
  const int aoff = lds_byte(wr * 64 + fr, fq * 8), boff = lds_byte(wc * 32 + fr, fq * 8);
#define G8_SA(b, h) (((b) * 2 + (h)) * HTB)
#define G8_SB(b, h) ((4 + (b) * 2 + (h)) * HTB)
#define G8_STAGE(bufoff, gbase, voff) do { _Pragma("unroll") for (int _i = 0; _i < 2; ++_i) \
    __builtin_amdgcn_global_load_lds((const unsigned*)((const char*)(gbase) + (voff)[_i]), (LAS unsigned*)(lds + (bufoff) + ldsw + _i * 8192), 16, 0, 0); } while (0)
#define G8_LDA(dst, b, h) do { _Pragma("unroll") for (int m = 0; m < 4; ++m) _Pragma("unroll") for (int k = 0; k < 2; ++k) dst[m][k] = *(const LAS bf16x8*)(lds + G8_SA(b, h) + aoff + m * 2048 + k * 1024); } while (0)
#define G8_LDB(dst, b, h) do { _Pragma("unroll") for (int n = 0; n < 2; ++n) _Pragma("unroll") for (int k = 0; k < 2; ++k) dst[n][k] = *(const LAS bf16x8*)(lds + G8_SB(b, h) + boff + n * 2048 + k * 1024); } while (0)
#define G8_MMA(ai, bj, At, Btf) do { __builtin_amdgcn_s_setprio(1); _Pragma("unroll") for (int m = 0; m < 4; ++m) _Pragma("unroll") for (int n = 0; n < 2; ++n) _Pragma("unroll") for (int k = 0; k < 2; ++k) \
    acc[ai][bj][m][n] = __builtin_amdgcn_mfma_f32_16x16x32_bf16(Btf[n][k], At[m][k], acc[ai][bj][m][n], 0, 0, 0); __builtin_amdgcn_s_setprio(0); } while (0)
#define G8_WAIT_V(n) asm volatile("s_waitcnt vmcnt(" #n ")" ::: "memory")
#define G8_WAIT_L(n) asm volatile("s_waitcnt lgkmcnt(" #n ")" ::: "memory")
#define G8_BAR __builtin_amdgcn_s_barrier()
#define G8_SCHED __builtin_amdgcn_sched_barrier(0)
  int cpm, cpn, npm = 0, npn = 0, ui = 0;
  if (!S.next(0, cpm, cpn)) return;
  f32x4 acc[2][2][4][2];
#pragma unroll
  for (int a = 0; a < 2; ++a)
#pragma unroll
    for (int b = 0; b < 2; ++b)
#pragma unroll
      for (int m = 0; m < 4; ++m)
#pragma unroll
        for (int n = 0; n < 2; ++n) acc[a][b][m][n] = f32x4{0.f, 0.f, 0.f, 0.f};
  bf16x8 At[4][2], B0[2][2], B1[2][2];
  const char* cA = (const char*)A + (size_t)cpm * tstepA + (size_t)cpn * a_pn_bytes; const char* cB = (const char*)Bt + (size_t)cpn * tstepB;
  G8_STAGE(G8_SB(0, 0), cB, voffB); G8_STAGE(G8_SA(0, 0), cA, voffA); G8_STAGE(G8_SB(0, 1), cB + hstepB, voffB); G8_STAGE(G8_SA(0, 1), cA + hstepA, voffA);
  if (wr == 1) G8_BAR;
  G8_WAIT_V(4); G8_BAR;
  G8_STAGE(G8_SB(1, 0), cB + kstep, voffB); G8_STAGE(G8_SA(1, 0), cA + kstep, voffA); G8_STAGE(G8_SB(1, 1), cB + hstepB + kstep, voffB);
  G8_WAIT_V(6); G8_BAR;
  for (;;) {
    const bool has_next = S.next(ui + 1, npm, npn);
    const char* nA = has_next ? (const char*)A + (size_t)npm * tstepA + (size_t)npn * a_pn_bytes : cA; const char* nB = has_next ? (const char*)Bt + (size_t)npn * tstepB : cB;
    for (int t = 0; t < nt; t += 2) {
      const bool last = (t == nt - 2);
      const char* a1 = cA + (size_t)(t + 1) * kstep;
      const char* a2 = last ? nA : cA + (size_t)(t + 2) * kstep; const char* b2 = last ? nB : cB + (size_t)(t + 2) * kstep;
      const char* a3 = a2 + kstep; const char* b3 = b2 + kstep;
      G8_LDB(B0, 0, 0); G8_SCHED; G8_LDA(At, 0, 0); G8_STAGE(G8_SA(1, 1), a1 + hstepA, voffA);
      G8_WAIT_L(8); G8_BAR; G8_WAIT_L(0); G8_MMA(0, 0, At, B0); G8_BAR; G8_SCHED;
      G8_LDB(B1, 0, 1); G8_STAGE(G8_SB(0, 0), b2, voffB);
      G8_BAR; G8_WAIT_L(0); G8_MMA(0, 1, At, B1); G8_BAR;
      G8_LDA(At, 0, 1); G8_STAGE(G8_SA(0, 0), a2, voffA);
      G8_BAR; G8_WAIT_L(0); G8_MMA(1, 0, At, B0); G8_BAR; G8_SCHED;
      G8_STAGE(G8_SB(0, 1), b2 + hstepB, voffB);
      G8_WAIT_V(6); G8_BAR; G8_MMA(1, 1, At, B1); G8_BAR;
      G8_LDB(B0, 1, 0); G8_SCHED; G8_LDA(At, 1, 0); G8_STAGE(G8_SA(0, 1), a2 + hstepA, voffA);
      G8_WAIT_L(8); G8_BAR; G8_WAIT_L(0); G8_MMA(0, 0, At, B0); G8_BAR; G8_SCHED;
      G8_LDB(B1, 1, 1); G8_STAGE(G8_SB(1, 0), b3, voffB);
      G8_BAR; G8_WAIT_L(0); G8_MMA(0, 1, At, B1); G8_BAR;
      G8_LDA(At, 1, 1); G8_STAGE(G8_SA(1, 0), a3, voffA);
      G8_BAR; G8_WAIT_L(0); G8_MMA(1, 0, At, B0); G8_BAR; G8_SCHED;
      G8_STAGE(G8_SB(1, 1), b3 + hstepB, voffB);
      G8_WAIT_V(6); G8_BAR; G8_MMA(1, 1, At, B1); G8_BAR;
    }
    E(acc, cpm, cpn, wr, wc, fr, fq);
    if (!has_next) break;
#pragma unroll
    for (int a = 0; a < 2; ++a)
#pragma unroll
      for (int b = 0; b < 2; ++b)
#pragma unroll
        for (int m = 0; m < 4; ++m)
#pragma unroll
          for (int n = 0; n < 2; ++n) acc[a][b][m][n] = f32x4{0.f, 0.f, 0.f, 0.f};
    cpm = npm; cpn = npn; cA = nA; cB = nB; ++ui;
  }
  G8_WAIT_V(0);
  if (wr == 0) G8_BAR;
  G8_BAR;
#undef G8_SA
#undef G8_SB
#undef G8_STAGE
#undef G8_LDA
#undef G8_LDB
#undef G8_MMA
#undef G8_WAIT_V
#undef G8_WAIT_L
#undef G8_BAR
#undef G8_SCHED
}
#define G8_FOREACH8(acc, pm, pn, wr, wc, fr, fq, ai, bj, m, row, col) \
  _Pragma("unroll") for (int ai = 0; ai < 2; ++ai) _Pragma("unroll") for (int m = 0; m < 4; ++m) \
  _Pragma("unroll") for (int bj = 0; bj < 2; ++bj) \
    if (const int row = 256 * (pm) + 128 * ai + 64 * (wr) + 16 * m + (fr); true) if (const int col = 256 * (pn) + 128 * bj + 32 * (wc) + 8 * (fq); true)
DI u32x4 pack8(const f32x4 a, const f32x4 b, float sc) {
  return u32x4{pack2(a[0] * sc, a[1] * sc), pack2(a[2] * sc, a[3] * sc), pack2(b[0] * sc, b[1] * sc), pack2(b[2] * sc, b[3] * sc)};
}
typedef f32x4 Acc8[2][2][4][2];

template <bool BANDED, class RowF>
DI void attn_compute(const bf16x8 (&qf)[4], int q0, int key0, char* smem, RowF rowptr, float& m_out, float& l_out) {
  const int tid = threadIdx.x, lane = tid & 63, w = tid >> 6, fr = lane & 15, fq = lane >> 4;
  char* sK = smem;
  char* sV = smem + 65536;
  constexpr int NT = BANDED ? 10 : 16;
  const int t0 = BANDED ? (w & ~1) : 0;
  f32x4 s[NT];
#pragma unroll
  for (int j = 0; j < NT; ++j) {
    f32x4 a = f32x4{0.f, 0.f, 0.f, 0.f};
    const int key = (t0 + j) * 16 + fr;
#pragma unroll
    for (int kk = 0; kk < 4; ++kk) {
      const bf16x8 kf = *(const bf16x8*)(sK + key * 256 + (((kk * 4 + fq) ^ fr) << 4));
      a = mfma16(kf, qf[kk], a);
    }
    s[j] = a;
  }
  __syncthreads();
  const float L2E = 1.4426950408889634f;
  const float NINF = -__builtin_inff();
  float mx = NINF;
  const int lq = q0 + w * 16 + fr;
#pragma unroll
  for (int j = 0; j < NT; ++j)
#pragma unroll
    for (int i = 0; i < 4; ++i) {
      float v = s[j][i] * L2E;
      if (BANDED) {
        const int lk = key0 + (t0 + j) * 16 + fq * 4 + i;
        const int dist = lq - lk;
        const bool ok = (lk >= 0) && (dist >= 0) && (dist <= 128);
        v = ok ? v : NINF;
      }
      s[j][i] = v;
      mx = fmaxf(mx, v);
    }
  mx = fmaxf(mx, __shfl_xor(mx, 16));
  mx = fmaxf(mx, __shfl_xor(mx, 32));
  float l = 0.f;
#pragma unroll
  for (int j = 0; j < NT; ++j)
#pragma unroll
    for (int i = 0; i < 4; ++i) {
      const float p = __builtin_amdgcn_exp2f(s[j][i] - mx);
      s[j][i] = p;
      l += p;
    }
  l += __shfl_xor(l, 16);
  l += __shfl_xor(l, 32);
  bf16x8 pf[NT / 2];
#pragma unroll
  for (int c = 0; c < NT / 2; ++c) {
    u32x4 t;
    t[0] = pack2(s[2 * c][0], s[2 * c][1]);
    t[1] = pack2(s[2 * c][2], s[2 * c][3]);
    t[2] = pack2(s[2 * c + 1][0], s[2 * c + 1][1]);
    t[3] = pack2(s[2 * c + 1][2], s[2 * c + 1][3]);
    pf[c] = __builtin_bit_cast(bf16x8, t);
  }
  const int q4 = (lane & 15) >> 2, p4 = lane & 3;
  m_out = mx;
  l_out = l;
  char* stage = sK + w * 4224;
  const float il = 1.f / l;
#pragma unroll 2
  for (int dt = 0; dt < 8; ++dt) {
    f32x4 a = f32x4{0.f, 0.f, 0.f, 0.f};
#pragma unroll
    for (int c = 0; c < NT / 2; ++c) {
      const int kb = (t0 + 2 * c) * 16;
      const s16x4 lo = tr_read(sV + (kb + fq * 4 + q4) * 288 + (dt * 16 + p4 * 4) * 2);
      const s16x4 hi = tr_read(sV + (kb + 16 + fq * 4 + q4) * 288 + (dt * 16 + p4 * 4) * 2);
      const bf16x8 vf = __builtin_shufflevector(lo, hi, 0, 1, 2, 3, 4, 5, 6, 7);
      a = mfma16(vf, pf[c], a);
    }
    u32x2 v; v[0] = pack2(a[0] * il, a[1] * il); v[1] = pack2(a[2] * il, a[3] * il);
    *(u32x2*)(stage + fr * 264 + dt * 32 + fq * 8) = v;
  }
  __builtin_amdgcn_wave_barrier();
  asm volatile("" ::: "memory");
#pragma unroll
  for (int j = 0; j < 4; ++j) {
    const int chunk = j * 64 + lane, q = chunk >> 4, c16 = chunk & 15;
    const u32x2 lo = *(const u32x2*)(stage + q * 264 + c16 * 16);
    const u32x2 hi = *(const u32x2*)(stage + q * 264 + c16 * 16 + 8);
    *(u32x4*)(rowptr(q) + c16 * 8) = u32x4{lo[0], lo[1], hi[0], hi[1]};
  }
}

template <bool BANDED, class StoreF>
DI void attn_core(const bfr* __restrict__ Qb, int qstride, int q0, const bfr* __restrict__ Kb, const bfr* __restrict__ Vb,
                  int kvstride, int key0, char* smem, StoreF store, float& m_out, float& l_out) {
  const int tid = threadIdx.x, lane = tid & 63, w = tid >> 6, fr = lane & 15, fq = lane >> 4;
  char* sK = smem;
  char* sV = smem + 65536;
  __syncthreads();
#pragma unroll 1
  for (int rr = 0; rr < 2; ++rr) {
    u32x4 kr[4], vr[4];
#pragma unroll
    for (int i = 0; i < 4; ++i) {
      const int id = tid + (rr * 4 + i) * 512, key = id >> 4, c = id & 15, lk = key0 + key;
      const int lkc = lk < 0 ? 0 : lk;
      const unsigned msk = lk < 0 ? 0u : 0xffffffffu;
      kr[i] = *(const u32x4*)(Kb + (long)lkc * kvstride + c * 8);
      vr[i] = *(const u32x4*)(Vb + (long)lkc * kvstride + c * 8);
      kr[i] &= u32x4{msk, msk, msk, msk};
      vr[i] &= u32x4{msk, msk, msk, msk};
    }
#pragma unroll
    for (int i = 0; i < 4; ++i) {
      const int id = tid + (rr * 4 + i) * 512, key = id >> 4, c = id & 15;
      *(u32x4*)(sK + key * 256 + ((c ^ (key & 15)) << 4)) = kr[i];
      *(u32x4*)(sV + key * 288 + c * 16) = vr[i];
    }
  }
  bf16x8 qf[4];
  {
    const bfr* qrow = Qb + (long)(q0 + w * 16 + fr) * qstride;
#pragma unroll
    for (int kk = 0; kk < 4; ++kk) qf[kk] = *(const bf16x8*)(qrow + kk * 32 + fq * 8);
  }
  __syncthreads();
  attn_compute<BANDED>(qf, q0, key0, smem, store, m_out, l_out);
}

DI int f2sort(float f) { int b = __float_as_int(f); return b ^ ((b >> 31) & 0x7fffffff); }
DI float sort2f(int s) { int b = s ^ ((s >> 31) & 0x7fffffff); return __int_as_float(b); }
DI void topk_insert(int (&lst)[16], int key) {
#pragma unroll
  for (int j = 0; j < 16; ++j) {
    const int hi = max(lst[j], key);
    key = min(lst[j], key);
    lst[j] = hi;
  }
}

template <int O, int N>
DI void bfly(float (&p)[64], int lane) {
  const bool up = (lane & O) != 0;
#pragma unroll
  for (int i = 0; i < N / 2; ++i) {
    const float keep = up ? p[i + N / 2] : p[i];
    const float send = up ? p[i] : p[i + N / 2];
    p[i] = keep + __shfl_xor(send, O);
  }
  if constexpr (O > 1) bfly<O / 2, N / 2>(p, lane);
}

DI void rms_rows2_to_bf16(const float* __restrict__ x0, const float* __restrict__ x1, const float* __restrict__ g,
                          bfr* __restrict__ o0, bfr* __restrict__ o1, int lane) {
  float4 v0[8], v1[8];
#pragma unroll
  for (int j = 0; j < 8; ++j) v0[j] = ldnt4(x0 + j * 256 + lane * 4);
#pragma unroll
  for (int j = 0; j < 8; ++j) v1[j] = ldnt4(x1 + j * 256 + lane * 4);
  float s0 = 0.f, s1 = 0.f;
#pragma unroll
  for (int j = 0; j < 8; ++j) {
    s0 += v0[j].x * v0[j].x + v0[j].y * v0[j].y + v0[j].z * v0[j].z + v0[j].w * v0[j].w;
    s1 += v1[j].x * v1[j].x + v1[j].y * v1[j].y + v1[j].z * v1[j].z + v1[j].w * v1[j].w;
  }
  s0 = wave_sum(s0);
  s1 = wave_sum(s1);
  const float r0 = rsqrtf(s0 * (1.f / 2048.f) + 1e-6f), r1 = rsqrtf(s1 * (1.f / 2048.f) + 1e-6f);
#pragma unroll
  for (int j = 0; j < 8; ++j) {
    const float4 gg = *(const float4*)(g + j * 256 + lane * 4);
    u32x2 a, c;
    a[0] = pack2(v0[j].x * r0 * gg.x, v0[j].y * r0 * gg.y); a[1] = pack2(v0[j].z * r0 * gg.z, v0[j].w * r0 * gg.w);
    c[0] = pack2(v1[j].x * r1 * gg.x, v1[j].y * r1 * gg.y); c[1] = pack2(v1[j].z * r1 * gg.z, v1[j].w * r1 * gg.w);
    *(u32x2*)(o0 + j * 256 + lane * 4) = a;
    *(u32x2*)(o1 + j * 256 + lane * 4) = c;
  }
}

DI void convert_f32_bf16(const float* __restrict__ src, bfr* __restrict__ dst, long n8) {
  for (long i = (long)blockIdx.x * NTHREADS + threadIdx.x; i < n8; i += (long)gridDim.x * NTHREADS) {
    const float4 a = *(const float4*)(src + i * 8);
    const float4 b = *(const float4*)(src + i * 8 + 4);
    u32x4 o;
    o[0] = pack2(a.x, a.y); o[1] = pack2(a.z, a.w); o[2] = pack2(b.x, b.y); o[3] = pack2(b.z, b.w);
    *(u32x4*)(dst + i * 8) = o;
  }
}

DI void transpose_strip(const float* __restrict__ W, int K, int N, int k0, int n0, bfr* __restrict__ Wt, float* tile,
                        const float* colscale, const float* rowscale) {
  const int tid = threadIdx.x;
  __syncthreads();
  {
    const int c4 = tid & 63, r = tid >> 6;
    float4 v[8];
#pragma unroll
    for (int i = 0; i < 8; ++i) v[i] = ldnt4(W + (size_t)(k0 + r + 8 * i) * N + n0 + c4 * 4);
#pragma unroll
    for (int i = 0; i < 8; ++i) {
      float* t = tile + (r + 8 * i) * 257 + c4 * 4;
      t[0] = v[i].x; t[1] = v[i].y; t[2] = v[i].z; t[3] = v[i].w;
    }
  }
  __syncthreads();
#pragma unroll
  for (int j = 0; j < 4; ++j) {
    const int task = tid + 512 * j, n = task >> 3, kc = task & 7;
    const float csv = colscale ? colscale[n0 + n] : 1.0f;
    u32x4 o;
#pragma unroll
    for (int e = 0; e < 4; ++e) {
      const int k = kc * 8 + 2 * e;
      const float r0 = rowscale ? rowscale[k0 + k] : 1.0f, r1 = rowscale ? rowscale[k0 + k + 1] : 1.0f;
      o[e] = pack2(tile[k * 257 + n] * csv * r0, tile[(k + 1) * 257 + n] * csv * r1);
    }
    *(u32x4*)(Wt + (size_t)(n0 + n) * K + k0 + kc * 8) = o;
  }
}

template <bool isv>
DI void quant_rows_fp4(const Params& p, int worker, int nworkers, int lane) {
  const float* tbl = isv ? p.w_v : p.w_u;
  float* scl = isv ? p.sv : p.su;
  unsigned char* out8 = isv ? p.wV8 : p.wU8;
  float4 gg[8];
  if (!isv) {
#pragma unroll
    for (int j = 0; j < 2; ++j)
#pragma unroll
      for (int q = 0; q < 4; ++q) gg[j * 4 + q] = *(const float4*)(p.g_ffn + j * 1024 + lane * 16 + q * 4);
  }
  auto finish = [&](float4 (&v)[8], int rr) {
    float amax = 0.f;
#pragma unroll
    for (int i = 0; i < 8; ++i) {
      if (!isv) { v[i].x *= gg[i].x; v[i].y *= gg[i].y; v[i].z *= gg[i].z; v[i].w *= gg[i].w; }
      amax = fmaxf(amax, fmaxf(fmaxf(fabsf(v[i].x), fabsf(v[i].y)), fmaxf(fabsf(v[i].z), fabsf(v[i].w))));
    }
#pragma unroll
    for (int o = 32; o >= 1; o >>= 1) amax = fmaxf(amax, __shfl_xor(amax, o));
    const float inv = amax > 0.f ? 6.0f / amax : 0.f;
    if (lane == 0) scl[rr] = amax * (1.f / 6.0f);
    u32x4 o4;
#pragma unroll
    for (int c = 0; c < 4; ++c) {
      const float4 t0 = v[2 * c], t1 = v[2 * c + 1];
      unsigned w = 0;
      w = __builtin_amdgcn_cvt_scalef32_pk_fp4_f32(w, t0.x * inv, t0.y * inv, 1.0f, 0);
      w = __builtin_amdgcn_cvt_scalef32_pk_fp4_f32(w, t0.z * inv, t0.w * inv, 1.0f, 1);
      w = __builtin_amdgcn_cvt_scalef32_pk_fp4_f32(w, t1.x * inv, t1.y * inv, 1.0f, 2);
      w = __builtin_amdgcn_cvt_scalef32_pk_fp4_f32(w, t1.z * inv, t1.w * inv, 1.0f, 3);
      o4[c] = w;
    }
    *(u32x4*)(out8 + (size_t)rr * 1024 + lane * 16) = o4;
  };
  for (int rr = worker; rr < 16384; rr += 2 * nworkers) {
    const int rb = rr + nworkers;
    const bool hasb = rb < 16384;
    const float* s0 = tbl + (size_t)rr * 2048;
    const float* s1 = tbl + (size_t)(hasb ? rb : rr) * 2048;
    float4 va[8], vb[8];
#pragma unroll
    for (int j = 0; j < 2; ++j)
#pragma unroll
      for (int q = 0; q < 4; ++q) va[j * 4 + q] = ldnt4(s0 + j * 1024 + lane * 16 + q * 4);
#pragma unroll
    for (int j = 0; j < 2; ++j)
#pragma unroll
      for (int q = 0; q < 4; ++q) vb[j * 4 + q] = ldnt4(s1 + j * 1024 + lane * 16 + q * 4);
    finish(va, rr);
    if (hasb) finish(vb, rb);
  }
}

DI void phase_prep(const Params& p, char* smem) {
  const int lane = threadIdx.x & 63, wid = threadIdx.x >> 6;
  for (int r2 = blockIdx.x * 8 + wid; r2 < (T_TOK + 1024) / 2; r2 += gridDim.x * 8) {
    const int r = 2 * r2;
    if (r < T_TOK) rms_rows2_to_bf16(p.x + (size_t)r * 2048, p.x + (size_t)(r + 1) * 2048, p.g_mix, p.hbuf + (size_t)r * 2048, p.hbuf + (size_t)(r + 1) * 2048, lane);
    else rms_rows2_to_bf16(p.mem + (size_t)(r - T_TOK) * 2048, p.mem + (size_t)(r + 1 - T_TOK) * 2048, p.g_mem, p.memn + (size_t)(r - T_TOK) * 2048, p.memn + (size_t)(r + 1 - T_TOK) * 2048, lane);
  }
  float* tile = (float*)smem;
  for (int id0 = blockIdx.x; id0 < 1296; id0 += gridDim.x) {
    int id = id0;
    const float* W; bfr* Wt; int K, N; const float* cs = nullptr; const float* rsc = nullptr;
    if (id < 512) { W = p.w_in; Wt = p.wInT; K = 2048; N = 4096; }
    else if ((id -= 512) < 256) { W = p.w_out; Wt = p.wOutT; K = 2048; N = 2048; }
    else if ((id -= 256) < 256) { W = p.w_pq; Wt = p.wPqT; K = 2048; N = 2048; rsc = p.g_ffn; }
    else if ((id -= 256) < 64) { W = p.w_cq; Wt = p.wCqT; K = 2048; N = 512; rsc = p.g_cross; }
    else if ((id -= 64) < 64) { W = p.w_ck; Wt = p.wCkT; K = 2048; N = 512; }
    else if ((id -= 64) < 64) { W = p.w_cv; Wt = p.wCvT; K = 2048; N = 512; }
    else if ((id -= 64) < 64) { W = p.w_co; Wt = p.wCoT; K = 512; N = 2048; }
    else { id -= 64; const int g = id >> 2; id &= 3; W = p.w_pool + g * 65536; Wt = p.wPoolT + g * 65536; K = 256; N = 256; cs = p.pool_scale + g * 256; }
    const int ntn = N >> 8;
    const int kt = id / ntn, nt = id % ntn;
    transpose_strip(W, K, N, kt * 64, nt * 256, Wt, tile, cs, rsc);
  }
  for (int i = blockIdx.x * NTHREADS + threadIdx.x; i < T_TOK; i += gridDim.x * NTHREADS) { p.rowss1[i] = 0.f; p.rowss2[i] = 0.f; }
  for (int i = blockIdx.x * NTHREADS + threadIdx.x; i < T_TOK * 16; i += gridDim.x * NTHREADS) {
    const int j = i & 15;
    const float inv = exp2f(-(float)j * (18.931568569324174f / 16.0f));
    float sn, cs;
    sincosf((float)p.pos[i >> 4] * inv, &sn, &cs);
    *(float2*)(p.ropetab + (size_t)i * 2) = make_float2(cs, sn);
  }
  convert_f32_bf16(p.sk1f, p.sk1, 128 * 128 / 8);
  convert_f32_bf16(p.sk2f, p.sk2, 128 * 128 / 8);
  quant_rows_fp4<true>(p, blockIdx.x * 8 + wid, gridDim.x * 8, lane);
}

DI void phase_inproj(const Params& p, char* smem) {
  auto epi = [&](const Acc8& acc0, int pm, int pn, int wr, int wc, int fr, int fq) {
    const int region = pn >> 2;
    if (region == 0) {
      G8_FOREACH8(acc0, pm, pn, wr, wc, fr, fq, ai, bj, m, row, col) {
        *(u32x4*)(p.pbuf + (size_t)row * 1024 + col) = pack8(acc0[ai][bj][m][0], acc0[ai][bj][m][1], 1.0f);
      }
    } else {
      bfr* dst = (region == 1) ? p.qbuf : (region == 2 ? p.kbuf : p.vbuf);
      const float scale = (region == 1) ? 0.08838834764831845f : 1.0f;
      const bool rope = (region != 3) && (wc == 0);
#pragma unroll
      for (int ai = 0; ai < 2; ++ai)
#pragma unroll
        for (int m = 0; m < 4; ++m) {
          const int row = 256 * pm + 128 * ai + 64 * wr + 16 * m + fr;
          const int b = row >> 12, t = row & 4095;
          float sn[8], cs[8];
          if (rope) {
            const float4* tp = (const float4*)(p.ropetab + ((size_t)row * 16 + 8 * (fq & 1)) * 2);
#pragma unroll
            for (int e2 = 0; e2 < 4; ++e2) {
              const float4 t = tp[e2];
              cs[2 * e2] = t.x; sn[2 * e2] = t.y; cs[2 * e2 + 1] = t.z; sn[2 * e2 + 1] = t.w;
            }
          }
#pragma unroll
          for (int bj = 0; bj < 2; ++bj) {
            const int h = (pn & 3) * 2 + bj;
            f32x4 v0 = acc0[ai][bj][m][0], v1 = acc0[ai][bj][m][1];
            if (rope) {
#pragma unroll
              for (int i = 0; i < 4; ++i) {
                const float o0 = __shfl_xor(v0[i], 32), o1 = __shfl_xor(v1[i], 32);
                v0[i] = (fq < 2) ? v0[i] * cs[i] - o0 * sn[i] : v0[i] * cs[i] + o0 * sn[i];
                v1[i] = (fq < 2) ? v1[i] * cs[4 + i] - o1 * sn[4 + i] : v1[i] * cs[4 + i] + o1 * sn[4 + i];
              }
            }
            bfr* drow = dst + ((size_t)((b * 8 + h) * 4096 + t)) * 128 + 32 * wc + 8 * fq;
            *(u32x4*)(drow) = pack8(v0, v1, scale);
          }
        }
    }
  };
  gemm8((LAS unsigned char*)smem, p.hbuf, 2048, p.wInT, T_TOK, 4096, 2048, gridDim.x, blockIdx.x, epi);
}

DI void phase_mix_attn(const Params& p, char* smem) {
  const int tid = threadIdx.x, lane = tid & 63, w = tid >> 6, fr = lane & 15, fq = lane >> 4;
  {
    char* sK = smem;
    char* sV = smem + 65536;
    u32x4 kr[8], vr[8];
    bf16x8 qn[4];
    int pend_key0 = 0;
    auto decode = [&](int id, int& br, int& dl, int& bh, int& r, int& l0) {
      br = id >> 10;
      const int rem = id & 1023;
      dl = (br == 0) ? 1 : (br == 1 ? 4 : 16);
      const int nblk = 32 / dl;
      bh = rem >> 5;
      const int rn = rem & 31;
      r = rn / nblk;
      l0 = (rn % nblk) * 128;
    };
    auto issue = [&](int id) {
      int br, dl, bh, r, l0;
      decode(id, br, dl, bh, r, l0);
      const size_t base = (size_t)bh * 4096 * 128 + (size_t)r * 128;
      const bfr* Kb = p.kbuf + base;
      const bfr* Vb = p.vbuf + base;
      const int kvstride = dl * 128, key0 = l0 - 128;
#pragma unroll
      for (int i = 0; i < 8; ++i) {
        const int e = tid + i * 512, key = e >> 4, c = e & 15, lk = key0 + key;
        const int lkc = lk < 0 ? 0 : lk;
        const unsigned msk = lk < 0 ? 0u : 0xffffffffu;
        kr[i] = *(const u32x4*)(Kb + (long)lkc * kvstride + c * 8);
        vr[i] = *(const u32x4*)(Vb + (long)lkc * kvstride + c * 8);
        (void)msk;
      }
      pend_key0 = key0;
      const bfr* qrow = p.qbuf + base + (long)(l0 + w * 16 + fr) * kvstride;
#pragma unroll
      for (int kk = 0; kk < 4; ++kk) qn[kk] = *(const bf16x8*)(qrow + kk * 32 + fq * 8);
    };
    const bool remap = (gridDim.x == 256);
    const int nround = remap ? 12 : (3072 + (int)gridDim.x - 1) / (int)gridDim.x;
    auto item_of = [&](int k) -> int {
      if (!remap) return k * (int)gridDim.x + (int)blockIdx.x;
      const int xcd = blockIdx.x & 7, slot = blockIdx.x >> 3;
      const int bh = (k / 3) * 8 + xcd, br = k % 3;
      return (br * 32 + bh) * 32 + slot;
    };
    if (item_of(0) < 3072) issue(item_of(0));
    for (int k = 0; k < nround; ++k) {
      const int id = item_of(k);
      if (id >= 3072) break;
      __syncthreads();
#pragma unroll
      for (int i = 0; i < 8; ++i) {
        const int e = tid + i * 512, key = e >> 4, c = e & 15;
        const unsigned msk = (pend_key0 + key) < 0 ? 0u : 0xffffffffu;
        const u32x4 m4 = u32x4{msk, msk, msk, msk};
        *(u32x4*)(sK + key * 256 + ((c ^ (key & 15)) << 4)) = kr[i] & m4;
        *(u32x4*)(sV + key * 288 + c * 16) = vr[i] & m4;
      }
      bf16x8 qf[4];
#pragma unroll
      for (int kk = 0; kk < 4; ++kk) qf[kk] = qn[kk];
      __syncthreads();
      const int nid = (k + 1 < nround) ? item_of(k + 1) : 3072;
      if (nid < 3072) issue(nid);
      int br, dl, bh, r, l0;
      decode(id, br, dl, bh, r, l0);
      float mx, l;
      const int b = bh >> 3, h = bh & 7;
      const int tt = b * 4096 + (l0 + w * 16 + fr) * dl + r;
      bfr* obase = p.ob + (size_t)br * T_TOK * 1024 + h * 128;
      const int tq0 = b * 4096 + r, lw = l0 + w * 16;
      attn_compute<true>(qf, l0, l0 - 128, smem,
                         [&](int q) { return obase + (size_t)(tq0 + (lw + q) * dl) * 1024; }, mx, l);
      if (fq == 0) p.lse[(size_t)br * T_TOK * 8 + (size_t)tt * 8 + h] = mx + __builtin_amdgcn_logf(l);
    }
  }
  for (int id = 3072 + blockIdx.x; id < 3072 + 256; id += gridDim.x) {
    {
      const int ci = id - 3072;
      const int sub = tid >> 7, cgp = tid & 127;
      const int wdw = 2 << (cgp >> 5);
      const int t0 = ci * 64 + sub * 16, tin0 = t0 & 4095;
      const bfr* pb = p.pbuf + cgp * 8;
      float sum[8];
#pragma unroll
      for (int e = 0; e < 8; ++e) sum[e] = 0.f;
      for (int j = 1; j < wdw; ++j) {
        if (tin0 - j >= 0) {
          const u32x4 v = *(const u32x4*)(pb + (size_t)(t0 - j) * 1024);
#pragma unroll
          for (int e = 0; e < 4; ++e) { sum[2 * e] += bflo(v[e]); sum[2 * e + 1] += bfhi(v[e]); }
        }
      }
      for (int s = 0; s < 16; ++s) {
        const int t = t0 + s, tin = tin0 + s;
        const u32x4 v = *(const u32x4*)(pb + (size_t)t * 1024);
        float cur[8];
#pragma unroll
        for (int e = 0; e < 4; ++e) { cur[2 * e] = bflo(v[e]); cur[2 * e + 1] = bfhi(v[e]); }
        const float ic = 1.f / (float)min(tin + 1, wdw);
        u32x4 ov;
#pragma unroll
        for (int e = 0; e < 8; ++e) sum[e] += cur[e];
#pragma unroll
        for (int e = 0; e < 4; ++e) ov[e] = pack2(sum[2 * e] * ic - cur[2 * e], sum[2 * e + 1] * ic - cur[2 * e + 1]);
        *(u32x4*)(p.mixed + (size_t)t * 1024 + cgp * 8) = ov;
        if (tin - wdw + 1 >= 0) {
          const u32x4 u = *(const u32x4*)(pb + (size_t)(t - wdw + 1) * 1024);
#pragma unroll
          for (int e = 0; e < 4; ++e) { sum[2 * e] -= bflo(u[e]); sum[2 * e + 1] -= bfhi(u[e]); }
        }
      }
    }
  }
}

DI void phase_pool_combine(const Params& p, char* smem) {
  const int tid = threadIdx.x;
  {
    auto epi = [&](const Acc8& acc0, int pm, int pn, int wr, int wc, int fr, int fq) {
      G8_FOREACH8(acc0, pm, pn, wr, wc, fr, fq, ai, bj, m, row, col) {
        *(u32x4*)(p.hbuf + (size_t)row * 2048 + col) = pack8(acc0[ai][bj][m][0], acc0[ai][bj][m][1], 1.0f);
      }
    };
    gemm8((LAS unsigned char*)smem, p.mixed, 1024, p.wPoolT, T_TOK, 1024, 256, gridDim.x, blockIdx.x, epi, 512);
  }
  for (long i = (long)blockIdx.x * NTHREADS + tid; i < (long)T_TOK * 8 * 16; i += (long)gridDim.x * NTHREADS) {
    const int dc = (int)(i & 15), h = (int)((i >> 4) & 7);
    const long tt = i >> 7;
    const float l0 = p.lse[tt * 8 + h], l1 = p.lse[(size_t)T_TOK * 8 + tt * 8 + h], l2 = p.lse[(size_t)2 * T_TOK * 8 + tt * 8 + h];
    const float mx = fmaxf(l0, fmaxf(l1, l2));
    float w0 = __builtin_amdgcn_exp2f(l0 - mx), w1 = __builtin_amdgcn_exp2f(l1 - mx), w2 = __builtin_amdgcn_exp2f(l2 - mx);
    const float inv = 1.f / (w0 + w1 + w2);
    w0 *= inv; w1 *= inv; w2 *= inv;
    const size_t off = (size_t)tt * 1024 + h * 128 + dc * 8;
    const u32x4 a = *(const u32x4*)(p.ob + off);
    const u32x4 b = *(const u32x4*)(p.ob + (size_t)T_TOK * 1024 + off);
    const u32x4 c = *(const u32x4*)(p.ob + (size_t)2 * T_TOK * 1024 + off);
    u32x4 o;
#pragma unroll
    for (int e = 0; e < 4; ++e)
      o[e] = pack2(w0 * bflo(a[e]) + w1 * bflo(b[e]) + w2 * bflo(c[e]), w0 * bfhi(a[e]) + w1 * bfhi(b[e]) + w2 * bfhi(c[e]));
    *(u32x4*)(p.hbuf + (size_t)tt * 2048 + 1024 + h * 128 + dc * 8) = o;
  }
}

template <bool RESID_BF16>
DI void phase_gemm_resid(const bfr* A, int lda, const bfr* Bt, int K, const void* resid, bfr* xb, float* rowss, char* smem) {
  auto epi = [&](const Acc8& acc0, int pm, int pn, int wr, int wc, int fr, int fq) {
#pragma unroll
    for (int ai = 0; ai < 2; ++ai)
#pragma unroll
      for (int m = 0; m < 4; ++m) {
        const int row = 256 * pm + 128 * ai + 64 * wr + 16 * m + fr;
        float ss = 0.f;
#pragma unroll
        for (int bj = 0; bj < 2; ++bj) {
          const int col = 256 * pn + 128 * bj + 32 * wc + 8 * fq;
          const f32x4 v0 = acc0[ai][bj][m][0], v1 = acc0[ai][bj][m][1];
          float r[8];
          if (RESID_BF16) {
            const u32x4 t = *(const u32x4*)((const bfr*)resid + (size_t)row * 2048 + col);
#pragma unroll
            for (int e = 0; e < 4; ++e) { r[2 * e] = bflo(t[e]); r[2 * e + 1] = bfhi(t[e]); }
          } else {
            const float4 t0 = *(const float4*)((const float*)resid + (size_t)row * 2048 + col);
            const float4 t1 = *(const float4*)((const float*)resid + (size_t)row * 2048 + col + 4);
            r[0] = t0.x; r[1] = t0.y; r[2] = t0.z; r[3] = t0.w; r[4] = t1.x; r[5] = t1.y; r[6] = t1.z; r[7] = t1.w;
          }
          f32x4 o0, o1;
#pragma unroll
          for (int e = 0; e < 4; ++e) { o0[e] = r[e] + v0[e]; o1[e] = r[4 + e] + v1[e]; ss += o0[e] * o0[e] + o1[e] * o1[e]; }
          *(u32x4*)(xb + (size_t)row * 2048 + col) = pack8(o0, o1, 1.0f);
        }
        ss += __shfl_xor(ss, 16);
        ss += __shfl_xor(ss, 32);
        if (fq == 0) atomicAdd(rowss + row, ss);
      }
  };
  gemm8((LAS unsigned char*)smem, A, lda, Bt, T_TOK, 2048, K, gridDim.x, blockIdx.x, epi);
}

DI void phase_gemm_pq(const Params& p, char* smem) {
  auto epi = [&](const Acc8& acc0, int pm, int pn, int wr, int wc, int fr, int fq) {
    G8_FOREACH8(acc0, pm, pn, wr, wc, fr, fq, ai, bj, m, row, col) {
      const float rs = rsqrtf(p.rowss2[row] * (1.f / 2048.f) + 1e-6f);
      *(u32x4*)(p.pq + (size_t)row * 2048 + col) = pack8(acc0[ai][bj][m][0], acc0[ai][bj][m][1], rs);
    }
  };
  gemm8((LAS unsigned char*)smem, p.hbuf, 2048, p.wPqT, T_TOK, 2048, 2048, gridDim.x, blockIdx.x, epi);
}
DI void phase_cross_proj(const Params& p, char* smem) {
  const int half = gridDim.x >> 1;
  if ((int)blockIdx.x < half) {
    auto epi = [&](const Acc8& acc0, int pm, int pn, int wr, int wc, int fr, int fq) {
      G8_FOREACH8(acc0, pm, pn, wr, wc, fr, fq, ai, bj, m, row, col) {
        const float scale = 0.08838834764831845f * rsqrtf(p.rowss1[row] * (1.f / 2048.f) + 1e-6f);
        *(u32x4*)(p.qc + (size_t)row * 512 + col) = pack8(acc0[ai][bj][m][0], acc0[ai][bj][m][1], scale);
      }
    };
    gemm8((LAS unsigned char*)smem, p.x2b, 2048, p.wCqT, T_TOK, 512, 2048, half, blockIdx.x, epi);
  } else if ((int)blockIdx.x < half + 16) {
    auto epi = [&](const Acc8& acc0, int pm, int pn, int wr, int wc, int fr, int fq) {
      G8_FOREACH8(acc0, pm, pn, wr, wc, fr, fq, ai, bj, m, row, col) {
        bfr* dst = (col < 512) ? p.kc : p.vc;
        const int cc = col & 511, hh = cc >> 7, d = cc & 127, bb = row >> 8, mm = row & 255;
        *(u32x4*)(dst + ((size_t)((bb * 4 + hh) * 256 + mm)) * 128 + d) = pack8(acc0[ai][bj][m][0], acc0[ai][bj][m][1], 1.0f);
      }
    };
    gemm8((LAS unsigned char*)smem, p.memn, 2048, p.wCkT, 1024, 1024, 2048, 16, blockIdx.x - half, epi);
  } else {
    const int nidle = gridDim.x - (half + 16);
    quant_rows_fp4<false>(p, (blockIdx.x - (half + 16)) * 8 + (threadIdx.x >> 6), nidle * 8, threadIdx.x & 63);
  }
}

DI void phase_cross_attn(const Params& p, char* smem) {
  const int tid = threadIdx.x, lane = tid & 63, w = tid >> 6, fr = lane & 15, fq = lane >> 4;
  for (int id = blockIdx.x; id < 512; id += gridDim.x) {
    const int b = id >> 7, h = (id >> 5) & 3, qt = id & 31;
    float mx, l;
    const size_t kvb = (size_t)(b * 4 + h) * 256 * 128;
    bfr* obase = p.oc + (size_t)(b * 4096 + qt * 128 + w * 16) * 512 + h * 128;
    attn_core<false>(p.qc + (size_t)b * 4096 * 512 + h * 128, 512, qt * 128, p.kc + kvb, p.vc + kvb, 128, 0, smem,
                     [&](int q) { return obase + (size_t)q * 512; }, mx, l);
  }
}

template <unsigned AMASK>
DI void route_cands(int (&top)[16], const float (&v1)[16], const float (&v2)[16]) {
#pragma unroll
  for (int a = 0; a < 16; ++a)
#pragma unroll
    for (int b = 0; b < 16; ++b)
      if (((AMASK >> a) & 1u) && (a + 1) * (b + 1) <= 16) topk_insert(top, (f2sort(v1[a] + v2[b]) & ~0xFF) | (a * 16 + b));
}
DI void bitonic_sort16_desc(int (&mg)[16]) {
#pragma unroll
  for (int st = 8; st >= 1; st >>= 1)
#pragma unroll
    for (int i = 0; i < 16; ++i)
      if ((i & st) == 0) { const int hi = max(mg[i], mg[i + st]), lo = min(mg[i], mg[i + st]); mg[i] = hi; mg[i + st] = lo; }
}
DI void phase_peer_route(const Params& p, char* smem) {
  const int tid = threadIdx.x, lane = tid & 63, w = tid >> 6, fr = lane & 15, fq = lane >> 4;
  char* sSK = smem;
  float* scores = (float*)(smem + 65536);
  int* lists = (int*)(smem + 65536 + 67584);
  int* tops = (int*)(smem + 65536);
  constexpr unsigned AM0 = (1u << 0) | (1u << 3) | (1u << 5) | (1u << 8) | (1u << 9) | (1u << 10) | (1u << 11);
  __syncthreads();
#pragma unroll
  for (int i = 0; i < 8; ++i) {
    const int id = tid + i * 512, key = id >> 4, c = id & 15;
    const bfr* src = (key < 128 ? p.sk1 : p.sk2) + (key & 127) * 128 + c * 8;
    *(u32x4*)(sSK + key * 256 + ((c ^ (key & 15)) << 4)) = *(const u32x4*)src;
  }
  for (int id = blockIdx.x; id < 2048; id += gridDim.x) {
    const int tt = id >> 3, h = id & 7;
    const int tok0 = tt * 64;
    __syncthreads();
    {
      const int tg = w & 3, hf = w >> 2;
      const bfr* arow = p.pq + (size_t)(tok0 + tg * 16 + fr) * 2048 + h * 256 + hf * 128;
      bf16x8 af[4];
#pragma unroll
      for (int kk = 0; kk < 4; ++kk) af[kk] = *(const bf16x8*)(arow + kk * 32 + fq * 8);
#pragma unroll
      for (int nt = 0; nt < 8; ++nt) {
        f32x4 a = f32x4{0.f, 0.f, 0.f, 0.f};
        const int key = hf * 128 + nt * 16 + fr;
#pragma unroll
        for (int kk = 0; kk < 4; ++kk) {
          const bf16x8 bfg = *(const bf16x8*)(sSK + key * 256 + (((kk * 4 + fq) ^ fr) << 4));
          a = mfma16(af[kk], bfg, a);
        }
#pragma unroll
        for (int i = 0; i < 4; ++i) scores[(hf * 64 + tg * 16 + fq * 4 + i) * 132 + nt * 16 + fr] = a[i];
      }
    }
    __syncthreads();
    {
      const int row = tid >> 2, part = tid & 3;
      int lst[16];
#pragma unroll
      for (int j = 0; j < 16; ++j) lst[j] = (int)0x80000000;
      const float* srow = scores + row * 132 + part * 32;
#pragma unroll 2
      for (int k4 = 0; k4 < 8; ++k4) {
        const float4 v = *(const float4*)(srow + k4 * 4);
        const int kb = part * 32 + k4 * 4;
        topk_insert(lst, (f2sort(v.x) & ~0x7F) | (kb + 0));
        topk_insert(lst, (f2sort(v.y) & ~0x7F) | (kb + 1));
        topk_insert(lst, (f2sort(v.z) & ~0x7F) | (kb + 2));
        topk_insert(lst, (f2sort(v.w) & ~0x7F) | (kb + 3));
      }
      int mg[16];
#pragma unroll
      for (int i = 0; i < 16; ++i) mg[i] = max(lst[i], __shfl_xor(lst[15 - i], 1));
      bitonic_sort16_desc(mg);
#pragma unroll
      for (int i = 0; i < 16; ++i) lst[i] = max(mg[i], __shfl_xor(mg[15 - i], 2));
      bitonic_sort16_desc(lst);
      if (part == 0) {
#pragma unroll
        for (int j4 = 0; j4 < 4; ++j4) {
          int4 t; t.x = lst[j4 * 4]; t.y = lst[j4 * 4 + 1]; t.z = lst[j4 * 4 + 2]; t.w = lst[j4 * 4 + 3];
          *(int4*)(lists + row * 16 + j4 * 4) = t;
        }
      }
    }
    __syncthreads();
    int top[16];
#pragma unroll
    for (int j = 0; j < 16; ++j) top[j] = (int)0x80000000;
    const int tokl = tid & 63;
    if (tid < 128) {
      float v1[16], v2[16];
#pragma unroll
      for (int j4 = 0; j4 < 4; ++j4) {
        const int4 t1 = *(const int4*)(lists + tokl * 16 + j4 * 4);
        const int4 t2 = *(const int4*)(lists + (64 + tokl) * 16 + j4 * 4);
        v1[j4 * 4] = sort2f(t1.x & ~0x7F); v1[j4 * 4 + 1] = sort2f(t1.y & ~0x7F); v1[j4 * 4 + 2] = sort2f(t1.z & ~0x7F); v1[j4 * 4 + 3] = sort2f(t1.w & ~0x7F);
        v2[j4 * 4] = sort2f(t2.x & ~0x7F); v2[j4 * 4 + 1] = sort2f(t2.y & ~0x7F); v2[j4 * 4 + 2] = sort2f(t2.z & ~0x7F); v2[j4 * 4 + 3] = sort2f(t2.w & ~0x7F);
      }
      if (tid < 64) {
        route_cands<AM0>(top, v1, v2);
      } else {
        route_cands<(~AM0) & 0xFFFFu>(top, v1, v2);
#pragma unroll
        for (int j4 = 0; j4 < 4; ++j4) {
          int4 t; t.x = top[j4 * 4]; t.y = top[j4 * 4 + 1]; t.z = top[j4 * 4 + 2]; t.w = top[j4 * 4 + 3];
          *(int4*)(tops + tokl * 16 + j4 * 4) = t;
        }
      }
    }
    __syncthreads();
    if (tid < 64) {
      int fin[16];
#pragma unroll
      for (int j4 = 0; j4 < 4; ++j4) {
        const int4 t = *(const int4*)(tops + tid * 16 + (3 - j4) * 4);
        fin[j4 * 4 + 0] = max(top[j4 * 4 + 0], t.w);
        fin[j4 * 4 + 1] = max(top[j4 * 4 + 1], t.z);
        fin[j4 * 4 + 2] = max(top[j4 * 4 + 2], t.y);
        fin[j4 * 4 + 3] = max(top[j4 * 4 + 3], t.x);
      }
      int ex[16];
      float val[16];
      float mxv = -3.0e38f;
#pragma unroll
      for (int j = 0; j < 16; ++j) {
        const int code = fin[j] & 0xFF;
        const int i1 = lists[tid * 16 + (code >> 4)] & 0x7F;
        const int i2 = lists[(64 + tid) * 16 + (code & 15)] & 0x7F;
        ex[j] = i1 * 128 + i2;
        val[j] = sort2f(fin[j] & ~0xFF);
        mxv = fmaxf(mxv, val[j]);
      }
      float sum = 0.f;
      float ev[16];
#pragma unroll
      for (int j = 0; j < 16; ++j) { ev[j] = __expf(val[j] - mxv); sum += ev[j]; }
      const float inv = 1.f / sum;
      const size_t ob = (size_t)(tok0 + tid) * 128 + h * 16;
#pragma unroll
      for (int j4 = 0; j4 < 4; ++j4) {
        int4 iv; iv.x = ex[j4 * 4]; iv.y = ex[j4 * 4 + 1]; iv.z = ex[j4 * 4 + 2]; iv.w = ex[j4 * 4 + 3];
        float4 gv; gv.x = ev[j4 * 4] * inv; gv.y = ev[j4 * 4 + 1] * inv; gv.z = ev[j4 * 4 + 2] * inv; gv.w = ev[j4 * 4 + 3] * inv;
        *(int4*)(p.idx + ob + j4 * 4) = iv;
        *(float4*)(p.gates + ob + j4 * 4) = gv;
      }
    }
  }
}

DI float gelu_tanh(float a) {
  const float u = 0.7978845608028654f * (a + 0.044715f * a * a * a);
  return 0.5f * a * (1.f + tanhf(u));
}

#define SB() __builtin_amdgcn_sched_barrier(0)
DI void peer_load8u(u32x4 (&bufa)[8], const unsigned char* tbl, int idxv, int g, int lane) {
#pragma unroll
  for (int k = 0; k < 8; ++k) {
    const int e = __builtin_amdgcn_readlane(idxv, g * 8 + k);
    bufa[k] = *(const u32x4*)(tbl + (size_t)e * 1024 + lane * 16);
  }
}
DI float peer_dot8(const u32x4 (&bufa)[8], const f32x2 (&hp)[16], int lane) {
  float part[8];
#pragma unroll
  for (int k = 0; k < 8; ++k) {
    const u32x4 u = bufa[k];
    f32x2 a2 = f32x2{0.f, 0.f};
#pragma unroll
    for (int c = 0; c < 4; ++c) {
      const unsigned uu = u[c];
      a2 += __builtin_amdgcn_cvt_scalef32_pk_f32_fp4(uu, 1.0f, 0) * hp[c * 4 + 0];
      a2 += __builtin_amdgcn_cvt_scalef32_pk_f32_fp4(uu, 1.0f, 1) * hp[c * 4 + 1];
      a2 += __builtin_amdgcn_cvt_scalef32_pk_f32_fp4(uu, 1.0f, 2) * hp[c * 4 + 2];
      a2 += __builtin_amdgcn_cvt_scalef32_pk_f32_fp4(uu, 1.0f, 3) * hp[c * 4 + 3];
    }
    part[k] = a2[0] + a2[1];
  }
  const bool up4 = (lane & 4) != 0, up2 = (lane & 2) != 0, up1 = (lane & 1) != 0;
  float q[4];
#pragma unroll
  for (int i = 0; i < 4; ++i) {
    const float keep = up4 ? part[i + 4] : part[i];
    const float send = up4 ? part[i] : part[i + 4];
    q[i] = keep + __shfl_xor(send, 4);
  }
  float r[2];
#pragma unroll
  for (int i = 0; i < 2; ++i) {
    const float keep = up2 ? q[i + 2] : q[i];
    const float send = up2 ? q[i] : q[i + 2];
    r[i] = keep + __shfl_xor(send, 2);
  }
  float v = (up1 ? r[1] : r[0]) + __shfl_xor(up1 ? r[0] : r[1], 1);
  v += __shfl_xor(v, 8);
  v += __shfl_xor(v, 16);
  v += __shfl_xor(v, 32);
  return v;
}
DI void peer_acc8(const u32x4 (&bufa)[8], f32x2 (&ys)[16], float cval, int g) {
#pragma unroll
  for (int k = 0; k < 8; ++k) {
    const float ck = __builtin_bit_cast(float, __builtin_amdgcn_readlane(__builtin_bit_cast(int, cval), g * 8 + k));
    const u32x4 u = bufa[k];
#pragma unroll
    for (int c = 0; c < 4; ++c) {
      const unsigned uu = u[c];
      ys[c * 4 + 0] += __builtin_amdgcn_cvt_scalef32_pk_f32_fp4(uu, 1.0f, 0) * ck;
      ys[c * 4 + 1] += __builtin_amdgcn_cvt_scalef32_pk_f32_fp4(uu, 1.0f, 1) * ck;
      ys[c * 4 + 2] += __builtin_amdgcn_cvt_scalef32_pk_f32_fp4(uu, 1.0f, 2) * ck;
      ys[c * 4 + 3] += __builtin_amdgcn_cvt_scalef32_pk_f32_fp4(uu, 1.0f, 3) * ck;
    }
  }
}

DI void phase_peer_expert(const Params& p) {
  const int lane = threadIdx.x & 63, wid = threadIdx.x >> 6;
  bool flag4;
  {
    float c1 = 1.0f, c2 = 2.0f;
    asm volatile("" : "+v"(c1), "+v"(c2));
    const unsigned w4 = __builtin_amdgcn_cvt_scalef32_pk_fp4_f32(0u, c1, c2, 1.0f, 0);
    const f32x2 r4 = __builtin_amdgcn_cvt_scalef32_pk_f32_fp4(w4, 1.0f, 0);
    flag4 = (r4[0] == 2.0f);
  }
  for (int tok = blockIdx.x * 8 + wid; tok < T_TOK; tok += gridDim.x * 8) {
    int myidx[2];
    float mygate[2];
    const float rs2 = rsqrtf(p.rowss2[tok] * (1.f / 2048.f) + 1e-6f);
#pragma unroll
    for (int half = 0; half < 2; ++half) {
      myidx[half] = p.idx[(size_t)tok * 128 + half * 64 + lane];
      mygate[half] = p.gates[(size_t)tok * 128 + half * 64 + lane];
    }
    u32x4 bufAa[8], bufBa[8];
    peer_load8u(bufAa, p.wU8, myidx[0], 0, lane);
    f32x2 hs[16];
    {
      float he[32];
#pragma unroll
      for (int j = 0; j < 2; ++j)
#pragma unroll
        for (int q = 0; q < 2; ++q) {
          const u32x4 t = *(const u32x4*)(p.hbuf + (size_t)tok * 2048 + j * 1024 + lane * 16 + q * 8);
#pragma unroll
          for (int c = 0; c < 4; ++c) { const unsigned tt = t[c]; he[j * 16 + q * 8 + c * 2] = bflo(tt); he[j * 16 + q * 8 + c * 2 + 1] = bfhi(tt); }
        }
#pragma unroll
      for (int i = 0; i < 16; ++i) {
        const float n0 = he[2 * i], n1 = he[2 * i + 1];
        hs[i] = f32x2{flag4 ? n1 : n0, flag4 ? n0 : n1};
      }
    }
    f32x2 ys[16];
#pragma unroll
    for (int e = 0; e < 16; ++e) ys[e] = f32x2{0.f, 0.f};
#pragma unroll 1
    for (int half = 0; half < 2; ++half) {
      const int idxv = half ? myidx[1] : myidx[0];
      const float gate = half ? mygate[1] : mygate[0];
      const float mysu = p.su[idxv], mysv = p.sv[idxv];
      float amine = 0.f;
#pragma unroll 1
      for (int g2 = 0; g2 < 3; ++g2) {
        peer_load8u(bufBa, p.wU8, idxv, 2 * g2 + 1, lane);
        SB();
        { const float v = peer_dot8(bufAa, hs, lane); if ((lane >> 3) == 2 * g2) amine = v; }
        SB();
        peer_load8u(bufAa, p.wU8, idxv, 2 * g2 + 2, lane);
        SB();
        { const float v = peer_dot8(bufBa, hs, lane); if ((lane >> 3) == 2 * g2 + 1) amine = v; }
        SB();
      }
      {
        peer_load8u(bufBa, p.wU8, idxv, 7, lane);
        SB();
        { const float v = peer_dot8(bufAa, hs, lane); if ((lane >> 3) == 6) amine = v; }
        SB();
        peer_load8u(bufAa, p.wV8, idxv, 0, lane);
        SB();
        { const float v = peer_dot8(bufBa, hs, lane); if ((lane >> 3) == 7) amine = v; }
        SB();
      }
      const float cval = gate * gelu_tanh(amine * mysu * rs2) * mysv;
      const int nidx = myidx[1];
#pragma unroll 1
      for (int g2 = 0; g2 < 3; ++g2) {
        peer_load8u(bufBa, p.wV8, idxv, 2 * g2 + 1, lane);
        SB();
        peer_acc8(bufAa, ys, cval, 2 * g2);
        SB();
        peer_load8u(bufAa, p.wV8, idxv, 2 * g2 + 2, lane);
        SB();
        peer_acc8(bufBa, ys, cval, 2 * g2 + 1);
        SB();
      }
      {
        peer_load8u(bufBa, p.wV8, idxv, 7, lane);
        SB();
        peer_acc8(bufAa, ys, cval, 6);
        SB();
        peer_load8u(bufAa, p.wU8, nidx, 0, lane);
        SB();
        peer_acc8(bufBa, ys, cval, 7);
        SB();
      }
    }
    float ss = 0.f;
#pragma unroll
    for (int i = 0; i < 16; ++i) { ys[i] += hs[i]; ss += ys[i][0] * ys[i][0] + ys[i][1] * ys[i][1]; }
    float ye[32];
#pragma unroll
    for (int i = 0; i < 16; ++i) {
      ye[2 * i] = flag4 ? ys[i][1] : ys[i][0];
      ye[2 * i + 1] = flag4 ? ys[i][0] : ys[i][1];
    }
    ss = wave_sum(ss);
    const float rs = rsqrtf(ss * (1.f / 2048.f) + 1e-6f);
#pragma unroll
    for (int j = 0; j < 2; ++j)
#pragma unroll
      for (int q = 0; q < 4; ++q) {
        const float4 gq = *(const float4*)(p.g_final + j * 1024 + lane * 16 + q * 4);
        const int b0 = j * 16 + q * 4;
        float4 o;
        o.x = ye[b0] * rs * gq.x; o.y = ye[b0 + 1] * rs * gq.y; o.z = ye[b0 + 2] * rs * gq.z; o.w = ye[b0 + 3] * rs * gq.w;
        *(float4*)(p.out + (size_t)tok * 2048 + j * 1024 + lane * 16 + q * 4) = o;
      }
  }
}

#define XB_TMO      128
#define XB_XCNT(j)  (256  + 64 * (j))
#define XB_XSUB(j)  (1280 + 64 * (j))
#define XB_XGEN(j)  (2304 + 64 * (j))
#define XB_TOP      3328
#define XB_TOPGEN   3392
#define XCD_BAR_WORDS 3456
#define XB_SPIN_CAP (1u << 20)
DI unsigned xb_ld(unsigned* p)              { return __hip_atomic_load(p, __ATOMIC_RELAXED, __HIP_MEMORY_SCOPE_AGENT); }
DI unsigned xb_add(unsigned* p, unsigned v) { return __hip_atomic_fetch_add(p, v, __ATOMIC_RELAXED, __HIP_MEMORY_SCOPE_AGENT); }
DI unsigned xb_xcc_id() { return (unsigned)__builtin_amdgcn_s_getreg((3 << 11) | 20) & 0xFu; }
#define XB_SPIN(cond, bar) do { unsigned _sp = 0; while (cond) { __builtin_amdgcn_s_sleep(1); \
    if ((++_sp & 255u) == 0u) { if (xb_ld(&(bar)[XB_TMO])) break; if (_sp > XB_SPIN_CAP) { atomicAdd(&(bar)[XB_TMO], 1u); break; } } } } while (0)
struct XcdBarrier { unsigned* bar; unsigned x; volatile LAS unsigned* st; };
DI XcdBarrier xcd_barrier_post(unsigned* bar, volatile LAS unsigned* st) {
  XcdBarrier b; b.bar = bar; b.x = xb_xcc_id(); b.st = st;
  if (threadIdx.x == 0) (void)xb_add(&bar[XB_XCNT(b.x)], 1u);
  return b;
}
DI void xcd_barrier_complete(unsigned* bar, unsigned x, unsigned& nloc, unsigned& nx) {
  const unsigned G = gridDim.x * gridDim.y * gridDim.z;
  unsigned sum, cnt, mine, sp = 0u;
  for (;;) {
    sum = 0u; cnt = 0u; mine = 0u;
#pragma unroll
    for (unsigned j = 0; j < 16; ++j) { const unsigned c = xb_ld(&bar[XB_XCNT(j)]); sum += c; cnt += (c > 0u) ? 1u : 0u; mine = (j == x) ? c : mine; }
    if (sum == G) break;
    __builtin_amdgcn_s_sleep(1);
    if ((++sp & 255u) == 0u) { if (xb_ld(&bar[XB_TMO])) break; if (sp > XB_SPIN_CAP) { atomicAdd(&bar[XB_TMO], 1u); break; } }
  }
  nloc = mine > 0u ? mine : 1u; nx = cnt > 0u ? cnt : 1u;
}
DI void xcd_barrier(const XcdBarrier& b) {
  asm volatile("s_waitcnt vmcnt(0)" ::: "memory");
  __syncthreads();
  if (threadIdx.x == 0) {
    unsigned* bar = b.bar;
    __builtin_amdgcn_s_waitcnt(0);
    unsigned nloc = b.st[0], nx = b.st[1];
    if (nloc == 0u) { xcd_barrier_complete(bar, b.x, nloc, nx); b.st[0] = nloc; b.st[1] = nx; }
    const unsigned old = xb_add(&bar[XB_XSUB(b.x)], 1u);
    const unsigned gen = old / nloc;
    if (old + 1u == (gen + 1u) * nloc) {
      __builtin_amdgcn_fence(__ATOMIC_RELEASE, "agent");
      asm volatile("s_waitcnt vmcnt(0)" ::: "memory");
      const unsigned og = xb_add(&bar[XB_TOP], 1u);
      const unsigned tg = og / nx;
      if (og + 1u == (tg + 1u) * nx) xb_add(&bar[XB_TOPGEN], 1u);
      else XB_SPIN(xb_ld(&bar[XB_TOPGEN]) == tg, bar);
      __builtin_amdgcn_fence(__ATOMIC_ACQUIRE, "agent");
      xb_add(&bar[XB_XGEN(b.x)], 1u);
      asm volatile("s_waitcnt vmcnt(0)" ::: "memory");
    } else {
      XB_SPIN(xb_ld(&bar[XB_XGEN(b.x)]) == gen, bar);
      __builtin_amdgcn_fence(__ATOMIC_ACQUIRE, "agent");
      asm volatile("s_waitcnt vmcnt(0)" ::: "memory");
    }
  }
  __syncthreads();
}

__global__ void __launch_bounds__(NTHREADS) mega(Params p, int phase_lo, int phase_hi) {
  __shared__ __attribute__((aligned(16))) char smem[SMEM_BYTES];
  cg::grid_group grid = cg::this_grid();
  volatile LAS unsigned* xst = (volatile LAS unsigned*)(smem + SMEM_BYTES - 16);
  if (threadIdx.x == 0) { xst[0] = 0u; xst[1] = 0u; }
  __syncthreads();
  const XcdBarrier xbar = xcd_barrier_post(p.bar + 64, xst);
  if (phase_hi > 1000) grid.sync();
#define PHASE(k, call) if (phase_lo <= (k) && (k) < phase_hi) { if ((k) > phase_lo) { xcd_barrier(xbar); } call; if ((DUP_MASK >> (k)) & 1) { xcd_barrier(xbar); call; } }
  PHASE(0, phase_prep(p, smem))
  PHASE(1, phase_inproj(p, smem))
  PHASE(2, phase_mix_attn(p, smem))
  PHASE(3, phase_pool_combine(p, smem))
  PHASE(4, phase_gemm_resid<false>(p.hbuf, 2048, p.wOutT, 2048, p.x, p.x2b, p.rowss1, smem))
  PHASE(6, phase_cross_proj(p, smem))
  PHASE(7, phase_cross_attn(p, smem))
  PHASE(8, phase_gemm_resid<true>(p.oc, 512, p.wCoT, 512, p.x2b, p.hbuf, p.rowss2, smem))
  PHASE(10, phase_gemm_pq(p, smem))
  PHASE(11, phase_peer_route(p, smem))
  PHASE(12, phase_peer_expert(p))
}

extern "C" void kernel_launch(void* const* d_in, const int* in_sizes, int n_in, void* d_out, int out_size, void* d_ws,
                              size_t ws_size, hipStream_t stream) {
  Params p{};
  p.x = (const float*)d_in[0]; p.mem = (const float*)d_in[1]; p.pos = (const int*)d_in[2];
  p.g_mix = (const float*)d_in[3]; p.w_in = (const float*)d_in[4]; p.w_pool = (const float*)d_in[5];
  p.pool_scale = (const float*)d_in[6]; p.w_out = (const float*)d_in[7]; p.g_cross = (const float*)d_in[8];
  p.g_mem = (const float*)d_in[9]; p.w_cq = (const float*)d_in[10]; p.w_ck = (const float*)d_in[11];
  p.w_cv = (const float*)d_in[12]; p.w_co = (const float*)d_in[13]; p.g_ffn = (const float*)d_in[14];
  p.w_pq = (const float*)d_in[15]; p.sk1f = (const float*)d_in[16]; p.sk2f = (const float*)d_in[17];
  p.w_u = (const float*)d_in[18]; p.w_v = (const float*)d_in[19]; p.g_final = (const float*)d_in[20];
  p.out = (float*)d_out;
  char* ws = (char*)d_ws;
  size_t off = 0;
  auto take = [&](size_t bytes) { char* r = ws + off; off += (bytes + 255) & ~(size_t)255; return r; };
  const size_t MB = 1024 * 1024;
  p.wInT = (bfr*)take(16 * MB); p.wPoolT = (bfr*)take(512 * 1024); p.wOutT = (bfr*)take(8 * MB);
  p.wCqT = (bfr*)take(2 * MB); p.wCkT = (bfr*)take(2 * MB); p.wCvT = (bfr*)take(2 * MB); p.wCoT = (bfr*)take(2 * MB);
  p.wPqT = (bfr*)take(8 * MB); p.sk1 = (bfr*)take(32768); p.sk2 = (bfr*)take(32768);
  p.wU8 = (unsigned char*)take(32 * MB); p.wV8 = (unsigned char*)take(32 * MB);
  p.su = (float*)take(65536); p.sv = (float*)take(65536);
  p.memn = (bfr*)take(4 * MB); p.kc = (bfr*)take(1 * MB); p.vc = (bfr*)take(1 * MB);
  p.hbuf = (bfr*)take(64 * MB);
  p.bar = (unsigned*)take(256 + XCD_BAR_WORDS * 4);
  p.rowss1 = (float*)take(65536); p.rowss2 = (float*)take(65536);
  p.ropetab = (float*)take((size_t)T_TOK * 16 * 2 * 4);
  const size_t r2 = off;
  p.qbuf = (bfr*)take(32 * MB); p.kbuf = (bfr*)take(32 * MB); p.vbuf = (bfr*)take(32 * MB);
  p.pbuf = (bfr*)take(32 * MB); p.mixed = (bfr*)take(32 * MB); p.ob = (bfr*)take(96 * MB);
  p.lse = (float*)take((size_t)3 * T_TOK * 8 * 4);
  const size_t end1 = off;
  off = r2;
  p.xres = (float*)take(128 * MB); p.pq = (bfr*)take(64 * MB); p.x2b = p.pq; p.qc = (bfr*)take(16 * MB); p.oc = (bfr*)take(16 * MB);
  p.idx = (int*)take(8 * MB); p.gates = (float*)take(8 * MB);
  const size_t end2 = off;
  const size_t need = end1 > end2 ? end1 : end2;
  if (need > ws_size) { fprintf(stderr, "workspace too small: need %zu have %zu\n", need, ws_size); return; }

  static int grid_blocks = 0;
  if (!grid_blocks) {
    int dev = 0, cus = 0, per_cu = 0;
    hipGetDevice(&dev);
    hipDeviceGetAttribute(&cus, hipDeviceAttributeMultiprocessorCount, dev);
    hipOccupancyMaxActiveBlocksPerMultiprocessor(&per_cu, mega, NTHREADS, 0);
    if (per_cu < 1) per_cu = 1;
    if (per_cu > 1) per_cu = 1;
    grid_blocks = cus * per_cu;
  }
  hipMemsetAsync(p.bar, 0, 256 + XCD_BAR_WORDS * 4, stream);
#if MULTI_LAUNCH
  for (int ph = 0; ph < NPHASE; ++ph) hipLaunchKernelGGL(mega, dim3(grid_blocks), dim3(NTHREADS), 0, stream, p, ph, ph + 1);
#else
  int lo = 0, hi = NPHASE;
  void* args[] = {&p, &lo, &hi};
  hipError_t e = hipLaunchCooperativeKernel((void*)mega, dim3(grid_blocks), dim3(NTHREADS), args, 0, stream);
  if (e != hipSuccess) fprintf(stderr, "cooperative launch failed: %s (grid %d)\n", hipGetErrorString(e), grid_blocks);
#endif
}
```

```cpp
#include <hip/hip_runtime.h>
#include <hip/hip_cooperative_groups.h>
#include <stdint.h>
#include <stdio.h>
namespace cg = cooperative_groups;

#ifndef DUP_MASK
#define DUP_MASK 0
#endif
#ifndef MULTI_LAUNCH
#define MULTI_LAUNCH 0
#endif

#define DI __device__ __forceinline__
typedef unsigned short bfr;
using bf16x8 = __attribute__((ext_vector_type(8))) short;
using s16x4  = __attribute__((ext_vector_type(4))) short;
using f32x4  = __attribute__((ext_vector_type(4))) float;
using u32x4  = __attribute__((ext_vector_type(4))) unsigned;
using u32x2  = __attribute__((ext_vector_type(2))) unsigned;
using bf2    = __attribute__((ext_vector_type(2))) __bf16;
using f32x2  = __attribute__((ext_vector_type(2))) float;
using v6u    = __attribute__((ext_vector_type(6))) unsigned;
using v16f   = __attribute__((ext_vector_type(16))) float;
using v32f   = __attribute__((ext_vector_type(32))) float;

constexpr int T_TOK = 16384;
constexpr int NTHREADS = 512;
constexpr int SMEM_BYTES = 151552;
constexpr int NPHASE = 13;

struct Params {
  const float *x, *mem; const int* pos;
  const float *g_mix, *w_in, *w_pool, *pool_scale, *w_out, *g_cross, *g_mem, *w_cq, *w_ck, *w_cv, *w_co, *g_ffn, *w_pq,
              *sk1f, *sk2f, *w_u, *w_v, *g_final;
  float* out;
  bfr *wInT, *wPoolT, *wOutT, *wCqT, *wCkT, *wCvT, *wCoT, *wPqT, *sk1, *sk2;
  unsigned char *wU8, *wV8; float *su, *sv;
  bfr *hbuf, *memn, *kc, *vc;
  bfr *pbuf, *qbuf, *kbuf, *vbuf, *mixed, *ob; float* lse;
  float* xres; bfr *pq, *qc, *oc; int* idx; float* gates;
  unsigned* bar;
  float *rowss1, *rowss2; bfr* x2b;
  float* ropetab;
};

DI unsigned pack2(float a, float b) { bf2 p; p[0] = (__bf16)a; p[1] = (__bf16)b; return __builtin_bit_cast(unsigned, p); }
DI float bflo(unsigned u) { return __uint_as_float(u << 16); }
DI float bfhi(unsigned u) { return __uint_as_float(u & 0xffff0000u); }
DI float4 ldnt4(const float* p) { const f32x4 v = __builtin_nontemporal_load((const f32x4*)p); return make_float4(v[0], v[1], v[2], v[3]); }
DI float wave_sum(float v) {
#pragma unroll
  for (int o = 32; o >= 1; o >>= 1) v += __shfl_xor(v, o);
  return v;
}
DI f32x4 mfma16(bf16x8 a, bf16x8 b, f32x4 c) { return __builtin_amdgcn_mfma_f32_16x16x32_bf16(a, b, c, 0, 0, 0); }
DI s16x4 tr_read(const char* p) {
  return __builtin_amdgcn_ds_read_tr16_b64_v4i16((s16x4 __attribute__((address_space(3)))*)(p));
}


#define LAS __attribute__((address_space(3)))
namespace g8 {
constexpr int BM = 256, BK = 64, HALF = 128, HTB = HALF * BK * 2, NXCD = 8, WGM = 8;
DI int lds_byte(int r, int c) { const int st = (r >> 4) * 2 + (c >> 5), rr = r & 15, cc = c & 31, ob = rr * 64 + cc * 2; return st * 1024 + (ob ^ (((ob >> 9) & 1) << 5)); }
DI int perm32(int rho) { const int n = rho >> 4, i = rho & 15; return 8 * (i >> 2) + 4 * n + (i & 3); }
DI void stage_rc(int b, int& R, int& C) { const int st = b / 1024, sb = b % 1024, swz = sb ^ (((sb >> 9) & 1) << 5); R = (st >> 1) * 16 + swz / 64; C = (st & 1) * 32 + (swz % 64) / 2; }
struct Order {
  int nM, nN, nwg, G, c;
  DI void init(int M, int N, int G_, int c_) { nM = M / BM; nN = N / BM; nwg = nM * nN; G = G_; c = c_; }
  DI bool next(int i, int& pm, int& pn) const {
    const long L = (long)i * G + c; if (L >= nwg) return false;
    int wgid = (int)L; { const int q = nwg / NXCD, r = nwg % NXCD, xcd = wgid % NXCD, off = wgid / NXCD; wgid = (xcd < r ? xcd * (q + 1) : r * (q + 1) + (xcd - r) * q) + off; }
    const int nig = WGM * nN, gid = wgid / nig, fm = gid * WGM, gsz = (nM - fm) < WGM ? (nM - fm) : WGM;
    pm = fm + ((wgid % nig) % gsz); pn = (wgid % nig) / gsz; return true;
  }
};
}

template <class Epi>
DI void gemm8(LAS unsigned char* lds, const bfr* A, int lda, const bfr* Bt, int M, int N, int K, int G, int c, const Epi& E, int a_pn_bytes = 0) {
  using namespace g8;
  const int tid = threadIdx.x, wid = __builtin_amdgcn_readfirstlane(tid >> 6), lane = tid & 63, wr = wid >> 2, wc = wid & 3, fr = lane & 15, fq = lane >> 4;
  const int nt = K / BK;
  Order S; S.init(M, N, G, c);
  unsigned voffA[2], voffB[2];
#pragma unroll
  for (int i = 0; i < 2; ++i) { int R, C; stage_rc(tid * 16 + i * 8192, R, C); const int Rb = (R & ~31) + perm32(R & 31);
    voffA[i] = (unsigned)(R * lda + C) * 2u; voffB[i] = (unsigned)(Rb * K + C) * 2u; }
  const size_t kstep = (size_t)(BK * 2);
  const size_t hstepA = (size_t)HALF * lda * 2, hstepB = (size_t)HALF * K * 2;
  const size_t tstepA = 2 * hstepA, tstepB = 2 * hstepB;
  const unsigned ldsw = (unsigned)wid * 1024u;
  const int aoff = lds_byte(wr * 64 + fr, fq * 8), boff = lds_byte(wc * 32 + fr, fq * 8);
#define G8_SA(b, h) (((b) * 2 + (h)) * HTB)
#define G8_SB(b, h) ((4 + (b) * 2 + (h)) * HTB)
#define G8_STAGE(bufoff, gbase, voff) do { _Pragma("unroll") for (int _i = 0; _i < 2; ++_i) \
    __builtin_amdgcn_global_load_lds((const unsigned*)((const char*)(gbase) + (voff)[_i]), (LAS unsigned*)(lds + (bufoff) + ldsw + _i * 8192), 16, 0, 0); } while (0)
#define G8_LDA(dst, b, h) do { _Pragma("unroll") for (int m = 0; m < 4; ++m) _Pragma("unroll") for (int k = 0; k < 2; ++k) dst[m][k] = *(const LAS bf16x8*)(lds + G8_SA(b, h) + aoff + m * 2048 + k * 1024); } while (0)
#define G8_LDB(dst, b, h) do { _Pragma("unroll") for (int n = 0; n < 2; ++n) _Pragma("unroll") for (int k = 0; k < 2; ++k) dst[n][k] = *(const LAS bf16x8*)(lds + G8_SB(b, h) + boff + n * 2048 + k * 1024); } while (0)
#define G8_MMA(ai, bj, At, Btf) do { __builtin_amdgcn_s_setprio(1); _Pragma("unroll") for (int m = 0; m < 4; ++m) _Pragma("unroll") for (int n = 0; n < 2; ++n) _Pragma("unroll") for (int k = 0; k < 2; ++k) \
    acc[ai][bj][m][n] = __builtin_amdgcn_mfma_f32_16x16x32_bf16(Btf[n][k], At[m][k], acc[ai][bj][m][n], 0, 0, 0); __builtin_amdgcn_s_setprio(0); } while (0)
#define G8_WAIT_V(n) asm volatile("s_waitcnt vmcnt(" #n ")" ::: "memory")
#define G8_WAIT_L(n) asm volatile("s_waitcnt lgkmcnt(" #n ")" ::: "memory")
#define G8_BAR __builtin_amdgcn_s_barrier()
#define G8_SCHED __builtin_amdgcn_sched_barrier(0)
  int cpm, cpn, npm = 0, npn = 0, ui = 0;
  if (!S.next(0, cpm, cpn)) return;
  f32x4 acc[2][2][4][2];
#pragma unroll
  for (int a = 0; a < 2; ++a)
#pragma unroll
    for (int b = 0; b < 2; ++b)
#pragma unroll
      for (int m = 0; m < 4; ++m)
#pragma unroll
        for (int n = 0; n < 2; ++n) acc[a][b][m][n] = f32x4{0.f, 0.f, 0.f, 0.f};
  bf16x8 At[4][2], B0[2][2], B1[2][2];
  const char* cA = (const char*)A + (size_t)cpm * tstepA + (size_t)cpn * a_pn_bytes; const char* cB = (const char*)Bt + (size_t)cpn * tstepB;
  G8_STAGE(G8_SB(0, 0), cB, voffB); G8_STAGE(G8_SA(0, 0), cA, voffA); G8_STAGE(G8_SB(0, 1), cB + hstepB, voffB); G8_STAGE(G8_SA(0, 1), cA + hstepA, voffA);
  if (wr == 1) G8_BAR;
  G8_WAIT_V(4); G8_BAR;
  G8_STAGE(G8_SB(1, 0), cB + kstep, voffB); G8_STAGE(G8_SA(1, 0), cA + kstep, voffA); G8_STAGE(G8_SB(1, 1), cB + hstepB + kstep, voffB);
  G8_WAIT_V(6); G8_BAR;
  for (;;) {
    const bool has_next = S.next(ui + 1, npm, npn);
    const char* nA = has_next ? (const char*)A + (size_t)npm * tstepA + (size_t)npn * a_pn_bytes : cA; const char* nB = has_next ? (const char*)Bt + (size_t)npn * tstepB : cB;
    for (int t = 0; t < nt; t += 2) {
      const bool last = (t == nt - 2);
      const char* a1 = cA + (size_t)(t + 1) * kstep;
      const char* a2 = last ? nA : cA + (size_t)(t + 2) * kstep; const char* b2 = last ? nB : cB + (size_t)(t + 2) * kstep;
      const char* a3 = a2 + kstep; const char* b3 = b2 + kstep;
      G8_LDB(B0, 0, 0); G8_SCHED; G8_LDA(At, 0, 0); G8_STAGE(G8_SA(1, 1), a1 + hstepA, voffA);
      G8_WAIT_L(8); G8_BAR; G8_WAIT_L(0); G8_MMA(0, 0, At, B0); G8_BAR; G8_SCHED;
      G8_LDB(B1, 0, 1); G8_STAGE(G8_SB(0, 0), b2, voffB);
      G8_BAR; G8_WAIT_L(0); G8_MMA(0, 1, At, B1); G8_BAR;
      G8_LDA(At, 0, 1); G8_STAGE(G8_SA(0, 0), a2, voffA);
      G8_BAR; G8_WAIT_L(0); G8_MMA(1, 0, At, B0); G8_BAR; G8_SCHED;
      G8_STAGE(G8_SB(0, 1), b2 + hstepB, voffB);
      G8_WAIT_V(6); G8_BAR; G8_MMA(1, 1, At, B1); G8_BAR;
      G8_LDB(B0, 1, 0); G8_SCHED; G8_LDA(At, 1, 0); G8_STAGE(G8_SA(0, 1), a2 + hstepA, voffA);
      G8_WAIT_L(8); G8_BAR; G8_WAIT_L(0); G8_MMA(0, 0, At, B0); G8_BAR; G8_SCHED;
      G8_LDB(B1, 1, 1); G8_STAGE(G8_SB(1, 0), b3, voffB);
      G8_BAR; G8_WAIT_L(0); G8_MMA(0, 1, At, B1); G8_BAR;
      G8_LDA(At, 1, 1); G8_STAGE(G8_SA(1, 0), a3, voffA);
      G8_BAR; G8_WAIT_L(0); G8_MMA(1, 0, At, B0); G8_BAR; G8_SCHED;
      G8_STAGE(G8_SB(1, 1), b3 + hstepB, voffB);
      G8_WAIT_V(6); G8_BAR; G8_MMA(1, 1, At, B1); G8_BAR;
    }
    E(acc, cpm, cpn, wr, wc, fr, fq);
    if (!has_next) break;
#pragma unroll
    for (int a = 0; a < 2; ++a)
#pragma unroll
      for (int b = 0; b < 2; ++b)
#pragma unroll
        for (int m = 0; m < 4; ++m)
#pragma unroll
          for (int n = 0; n < 2; ++n) acc[a][b][m][n] = f32x4{0.f, 0.f, 0.f, 0.f};
    cpm = npm; cpn = npn; cA = nA; cB = nB; ++ui;
  }
  G8_WAIT_V(0);
  if (wr == 0) G8_BAR;
  G8_BAR;
#undef G8_SA
#undef G8_SB
#undef G8_STAGE
#undef G8_LDA
#undef G8_LDB
#undef G8_MMA
#undef G8_WAIT_V
#undef G8_WAIT_L
#undef G8_BAR
#undef G8_SCHED
}
#define G8_FOREACH8(acc, pm, pn, wr, wc, fr, fq, ai, bj, m, row, col) \
  _Pragma("unroll") for (int ai = 0; ai < 2; ++ai) _Pragma("unroll") for (int m = 0; m < 4; ++m) \
  _Pragma("unroll") for (int bj = 0; bj < 2; ++bj) \
    if (const int row = 256 * (pm) + 128 * ai + 64 * (wr) + 16 * m + (fr); true) if (const int col = 256 * (pn) + 128 * bj + 32 * (wc) + 8 * (fq); true)
DI u32x4 pack8(const f32x4 a, const f32x4 b, float sc) {
  return u32x4{pack2(a[0] * sc, a[1] * sc), pack2(a[2] * sc, a[3] * sc), pack2(b[0] * sc, b[1] * sc), pack2(b[2] * sc, b[3] * sc)};
}
typedef f32x4 Acc8[2][2][4][2];

struct NoHook { DI void operator()() const {} };
template <bool BANDED, class RowF, class MidF = NoHook>
DI void attn_compute(const bf16x8 (&qf)[4], int q0, int key0, char* smem, RowF rowptr, float& m_out, float& l_out, MidF mid = MidF()) {
  const int tid = threadIdx.x, lane = tid & 63, w = tid >> 6, fr = lane & 15, fq = lane >> 4;
  char* sK = smem;
  char* sV = smem + 65536;
  constexpr int NT = BANDED ? 10 : 16;
  const int t0 = BANDED ? (w & ~1) : 0;
  f32x4 s[NT];
#pragma unroll
  for (int j = 0; j < NT; ++j) {
    f32x4 a = f32x4{0.f, 0.f, 0.f, 0.f};
    const int key = (t0 + j) * 16 + fr;
#pragma unroll
    for (int kk = 0; kk < 4; ++kk) {
      const bf16x8 kf = *(const bf16x8*)(sK + key * 256 + (((kk * 4 + fq) ^ fr) << 4));
      a = mfma16(kf, qf[kk], a);
    }
    s[j] = a;
  }
  __syncthreads();
  mid();
  const float L2E = 1.4426950408889634f;
  const float NINF = -__builtin_inff();
  float mx = NINF;
  const int lq = q0 + w * 16 + fr;
#pragma unroll
  for (int j = 0; j < NT; ++j)
#pragma unroll
    for (int i = 0; i < 4; ++i) {
      float v = s[j][i] * L2E;
      if (BANDED) {
        const int lk = key0 + (t0 + j) * 16 + fq * 4 + i;
        const int dist = lq - lk;
        const bool ok = (lk >= 0) && (dist >= 0) && (dist <= 128);
        v = ok ? v : NINF;
      }
      s[j][i] = v;
      mx = fmaxf(mx, v);
    }
  mx = fmaxf(mx, __shfl_xor(mx, 16));
  mx = fmaxf(mx, __shfl_xor(mx, 32));
  float l = 0.f;
#pragma unroll
  for (int j = 0; j < NT; ++j)
#pragma unroll
    for (int i = 0; i < 4; ++i) {
      const float p = __builtin_amdgcn_exp2f(s[j][i] - mx);
      s[j][i] = p;
      l += p;
    }
  l += __shfl_xor(l, 16);
  l += __shfl_xor(l, 32);
  bf16x8 pf[NT / 2];
#pragma unroll
  for (int c = 0; c < NT / 2; ++c) {
    u32x4 t;
    t[0] = pack2(s[2 * c][0], s[2 * c][1]);
    t[1] = pack2(s[2 * c][2], s[2 * c][3]);
    t[2] = pack2(s[2 * c + 1][0], s[2 * c + 1][1]);
    t[3] = pack2(s[2 * c + 1][2], s[2 * c + 1][3]);
    pf[c] = __builtin_bit_cast(bf16x8, t);
  }
  const int q4 = (lane & 15) >> 2, p4 = lane & 3;
  m_out = mx;
  l_out = l;
  char* stage = sK + w * 4224;
  const float il = 1.f / l;
#pragma unroll 2
  for (int dt = 0; dt < 8; ++dt) {
    f32x4 a = f32x4{0.f, 0.f, 0.f, 0.f};
#pragma unroll
    for (int c = 0; c < NT / 2; ++c) {
      const int kb = (t0 + 2 * c) * 16;
      const s16x4 lo = tr_read(sV + (kb + fq * 4 + q4) * 288 + (dt * 16 + p4 * 4) * 2);
      const s16x4 hi = tr_read(sV + (kb + 16 + fq * 4 + q4) * 288 + (dt * 16 + p4 * 4) * 2);
      const bf16x8 vf = __builtin_shufflevector(lo, hi, 0, 1, 2, 3, 4, 5, 6, 7);
      a = mfma16(vf, pf[c], a);
    }
    u32x2 v; v[0] = pack2(a[0] * il, a[1] * il); v[1] = pack2(a[2] * il, a[3] * il);
    *(u32x2*)(stage + fr * 264 + dt * 32 + fq * 8) = v;
  }
  __builtin_amdgcn_wave_barrier();
  asm volatile("" ::: "memory");
#pragma unroll
  for (int j = 0; j < 4; ++j) {
    const int chunk = j * 64 + lane, q = chunk >> 4, c16 = chunk & 15;
    const u32x2 lo = *(const u32x2*)(stage + q * 264 + c16 * 16);
    const u32x2 hi = *(const u32x2*)(stage + q * 264 + c16 * 16 + 8);
    *(u32x4*)(rowptr(q) + c16 * 8) = u32x4{lo[0], lo[1], hi[0], hi[1]};
  }
}

template <bool BANDED, class StoreF>
DI void attn_core(const bfr* __restrict__ Qb, int qstride, int q0, const bfr* __restrict__ Kb, const bfr* __restrict__ Vb,
                  int kvstride, int key0, char* smem, StoreF store, float& m_out, float& l_out) {
  const int tid = threadIdx.x, lane = tid & 63, w = tid >> 6, fr = lane & 15, fq = lane >> 4;
  char* sK = smem;
  char* sV = smem + 65536;
  __syncthreads();
#pragma unroll 1
  for (int rr = 0; rr < 2; ++rr) {
    u32x4 kr[4], vr[4];
#pragma unroll
    for (int i = 0; i < 4; ++i) {
      const int id = tid + (rr * 4 + i) * 512, key = id >> 4, c = id & 15, lk = key0 + key;
      const int lkc = lk < 0 ? 0 : lk;
      const unsigned msk = lk < 0 ? 0u : 0xffffffffu;
      kr[i] = *(const u32x4*)(Kb + (long)lkc * kvstride + c * 8);
      vr[i] = *(const u32x4*)(Vb + (long)lkc * kvstride + c * 8);
      kr[i] &= u32x4{msk, msk, msk, msk};
      vr[i] &= u32x4{msk, msk, msk, msk};
    }
#pragma unroll
    for (int i = 0; i < 4; ++i) {
      const int id = tid + (rr * 4 + i) * 512, key = id >> 4, c = id & 15;
      *(u32x4*)(sK + key * 256 + ((c ^ (key & 15)) << 4)) = kr[i];
      *(u32x4*)(sV + key * 288 + c * 16) = vr[i];
    }
  }
  bf16x8 qf[4];
  {
    const bfr* qrow = Qb + (long)(q0 + w * 16 + fr) * qstride;
#pragma unroll
    for (int kk = 0; kk < 4; ++kk) qf[kk] = *(const bf16x8*)(qrow + kk * 32 + fq * 8);
  }
  __syncthreads();
  attn_compute<BANDED>(qf, q0, key0, smem, store, m_out, l_out);
}

DI int f2sort(float f) { int b = __float_as_int(f); return b ^ ((b >> 31) & 0x7fffffff); }
DI float sort2f(int s) { int b = s ^ ((s >> 31) & 0x7fffffff); return __int_as_float(b); }
DI void topk_insert(int (&lst)[16], int key) {
#pragma unroll
  for (int j = 0; j < 16; ++j) {
    const int hi = max(lst[j], key);
    key = min(lst[j], key);
    lst[j] = hi;
  }
}

template <int O, int N>
DI void bfly(float (&p)[64], int lane) {
  const bool up = (lane & O) != 0;
#pragma unroll
  for (int i = 0; i < N / 2; ++i) {
    const float keep = up ? p[i + N / 2] : p[i];
    const float send = up ? p[i] : p[i + N / 2];
    p[i] = keep + __shfl_xor(send, O);
  }
  if constexpr (O > 1) bfly<O / 2, N / 2>(p, lane);
}

DI void rms_rows2_to_bf16(const float* __restrict__ x0, const float* __restrict__ x1, const float* __restrict__ g,
                          bfr* __restrict__ o0, bfr* __restrict__ o1, int lane) {
  float4 v0[8], v1[8];
#pragma unroll
  for (int j = 0; j < 8; ++j) v0[j] = ldnt4(x0 + j * 256 + lane * 4);
#pragma unroll
  for (int j = 0; j < 8; ++j) v1[j] = ldnt4(x1 + j * 256 + lane * 4);
  float s0 = 0.f, s1 = 0.f;
#pragma unroll
  for (int j = 0; j < 8; ++j) {
    s0 += v0[j].x * v0[j].x + v0[j].y * v0[j].y + v0[j].z * v0[j].z + v0[j].w * v0[j].w;
    s1 += v1[j].x * v1[j].x + v1[j].y * v1[j].y + v1[j].z * v1[j].z + v1[j].w * v1[j].w;
  }
  s0 = wave_sum(s0);
  s1 = wave_sum(s1);
  const float r0 = rsqrtf(s0 * (1.f / 2048.f) + 1e-6f), r1 = rsqrtf(s1 * (1.f / 2048.f) + 1e-6f);
#pragma unroll
  for (int j = 0; j < 8; ++j) {
    const float4 gg = *(const float4*)(g + j * 256 + lane * 4);
    u32x2 a, c;
    a[0] = pack2(v0[j].x * r0 * gg.x, v0[j].y * r0 * gg.y); a[1] = pack2(v0[j].z * r0 * gg.z, v0[j].w * r0 * gg.w);
    c[0] = pack2(v1[j].x * r1 * gg.x, v1[j].y * r1 * gg.y); c[1] = pack2(v1[j].z * r1 * gg.z, v1[j].w * r1 * gg.w);
    *(u32x2*)(o0 + j * 256 + lane * 4) = a;
    *(u32x2*)(o1 + j * 256 + lane * 4) = c;
  }
}

DI void convert_f32_bf16(const float* __restrict__ src, bfr* __restrict__ dst, long n8) {
  for (long i = (long)blockIdx.x * NTHREADS + threadIdx.x; i < n8; i += (long)gridDim.x * NTHREADS) {
    const float4 a = *(const float4*)(src + i * 8);
    const float4 b = *(const float4*)(src + i * 8 + 4);
    u32x4 o;
    o[0] = pack2(a.x, a.y); o[1] = pack2(a.z, a.w); o[2] = pack2(b.x, b.y); o[3] = pack2(b.z, b.w);
    *(u32x4*)(dst + i * 8) = o;
  }
}

DI void transpose_strip(const float* __restrict__ W, int K, int N, int k0, int n0, bfr* __restrict__ Wt, float* tile,
                        const float* colscale, const float* rowscale) {
  const int tid = threadIdx.x;
  __syncthreads();
  {
    const int c4 = tid & 63, r = tid >> 6;
    float4 v[8];
#pragma unroll
    for (int i = 0; i < 8; ++i) v[i] = ldnt4(W + (size_t)(k0 + r + 8 * i) * N + n0 + c4 * 4);
#pragma unroll
    for (int i = 0; i < 8; ++i) {
      float* t = tile + (r + 8 * i) * 257 + c4 * 4;
      t[0] = v[i].x; t[1] = v[i].y; t[2] = v[i].z; t[3] = v[i].w;
    }
  }
  __syncthreads();
#pragma unroll
  for (int j = 0; j < 4; ++j) {
    const int task = tid + 512 * j, n = task >> 3, kc = task & 7;
    const float csv = colscale ? colscale[n0 + n] : 1.0f;
    u32x4 o;
#pragma unroll
    for (int e = 0; e < 4; ++e) {
      const int k = kc * 8 + 2 * e;
      const float r0 = rowscale ? rowscale[k0 + k] : 1.0f, r1 = rowscale ? rowscale[k0 + k + 1] : 1.0f;
      o[e] = pack2(tile[k * 257 + n] * csv * r0, tile[(k + 1) * 257 + n] * csv * r1);
    }
    *(u32x4*)(Wt + (size_t)(n0 + n) * K + k0 + kc * 8) = o;
  }
}

template <bool isv>
DI void quant_rows_fp4(const Params& p, int worker, int nworkers, int lane) {
  const float* tbl = isv ? p.w_v : p.w_u;
  float* scl = isv ? p.sv : p.su;
  unsigned char* out8 = isv ? p.wV8 : p.wU8;
  float4 gg[8];
  if (!isv) {
#pragma unroll
    for (int j = 0; j < 2; ++j)
#pragma unroll
      for (int q = 0; q < 4; ++q) gg[j * 4 + q] = *(const float4*)(p.g_ffn + j * 1024 + lane * 16 + q * 4);
  }
  auto finish = [&](float4 (&v)[8], int rr) {
    float amax = 0.f;
#pragma unroll
    for (int i = 0; i < 8; ++i) {
      if (!isv) { v[i].x *= gg[i].x; v[i].y *= gg[i].y; v[i].z *= gg[i].z; v[i].w *= gg[i].w; }
      amax = fmaxf(amax, fmaxf(fmaxf(fabsf(v[i].x), fabsf(v[i].y)), fmaxf(fabsf(v[i].z), fabsf(v[i].w))));
    }
#pragma unroll
    for (int o = 32; o >= 1; o >>= 1) amax = fmaxf(amax, __shfl_xor(amax, o));
    const float inv = amax > 0.f ? 6.0f / amax : 0.f;
    if (lane == 0) scl[rr] = amax * (1.f / 6.0f);
    u32x4 o4;
#pragma unroll
    for (int c = 0; c < 4; ++c) {
      const float4 t0 = v[2 * c], t1 = v[2 * c + 1];
      unsigned w = 0;
      w = __builtin_amdgcn_cvt_scalef32_pk_fp4_f32(w, t0.x * inv, t0.y * inv, 1.0f, 0);
      w = __builtin_amdgcn_cvt_scalef32_pk_fp4_f32(w, t0.z * inv, t0.w * inv, 1.0f, 1);
      w = __builtin_amdgcn_cvt_scalef32_pk_fp4_f32(w, t1.x * inv, t1.y * inv, 1.0f, 2);
      w = __builtin_amdgcn_cvt_scalef32_pk_fp4_f32(w, t1.z * inv, t1.w * inv, 1.0f, 3);
      o4[c] = w;
    }
    *(u32x4*)(out8 + (size_t)rr * 1024 + lane * 16) = o4;
  };
  for (int rr = worker; rr < 16384; rr += 2 * nworkers) {
    const int rb = rr + nworkers;
    const bool hasb = rb < 16384;
    const float* s0 = tbl + (size_t)rr * 2048;
    const float* s1 = tbl + (size_t)(hasb ? rb : rr) * 2048;
    float4 va[8], vb[8];
#pragma unroll
    for (int j = 0; j < 2; ++j)
#pragma unroll
      for (int q = 0; q < 4; ++q) va[j * 4 + q] = ldnt4(s0 + j * 1024 + lane * 16 + q * 4);
#pragma unroll
    for (int j = 0; j < 2; ++j)
#pragma unroll
      for (int q = 0; q < 4; ++q) vb[j * 4 + q] = ldnt4(s1 + j * 1024 + lane * 16 + q * 4);
    finish(va, rr);
    if (hasb) finish(vb, rb);
  }
}

DI void phase_prep(const Params& p, char* smem) {
  const int lane = threadIdx.x & 63, wid = threadIdx.x >> 6;
  for (int r2 = blockIdx.x * 8 + wid; r2 < (T_TOK + 1024) / 2; r2 += gridDim.x * 8) {
    const int r = 2 * r2;
    if (r < T_TOK) rms_rows2_to_bf16(p.x + (size_t)r * 2048, p.x + (size_t)(r + 1) * 2048, p.g_mix, p.hbuf + (size_t)r * 2048, p.hbuf + (size_t)(r + 1) * 2048, lane);
    else rms_rows2_to_bf16(p.mem + (size_t)(r - T_TOK) * 2048, p.mem + (size_t)(r + 1 - T_TOK) * 2048, p.g_mem, p.memn + (size_t)(r - T_TOK) * 2048, p.memn + (size_t)(r + 1 - T_TOK) * 2048, lane);
  }
  float* tile = (float*)smem;
  for (int id0 = blockIdx.x; id0 < 1296; id0 += gridDim.x) {
    int id = id0;
    const float* W; bfr* Wt; int K, N; const float* cs = nullptr; const float* rsc = nullptr;
    if (id < 512) { W = p.w_in; Wt = p.wInT; K = 2048; N = 4096; }
    else if ((id -= 512) < 256) { W = p.w_out; Wt = p.wOutT; K = 2048; N = 2048; }
    else if ((id -= 256) < 256) { W = p.w_pq; Wt = p.wPqT; K = 2048; N = 2048; rsc = p.g_ffn; }
    else if ((id -= 256) < 64) { W = p.w_cq; Wt = p.wCqT; K = 2048; N = 512; rsc = p.g_cross; }
    else if ((id -= 64) < 64) { W = p.w_ck; Wt = p.wCkT; K = 2048; N = 512; }
    else if ((id -= 64) < 64) { W = p.w_cv; Wt = p.wCvT; K = 2048; N = 512; }
    else if ((id -= 64) < 64) { W = p.w_co; Wt = p.wCoT; K = 512; N = 2048; }
    else { id -= 64; const int g = id >> 2; id &= 3; W = p.w_pool + g * 65536; Wt = p.wPoolT + g * 65536; K = 256; N = 256; cs = p.pool_scale + g * 256; }
    const int ntn = N >> 8;
    const int kt = id / ntn, nt = id % ntn;
    transpose_strip(W, K, N, kt * 64, nt * 256, Wt, tile, cs, rsc);
  }
  for (int i = blockIdx.x * NTHREADS + threadIdx.x; i < T_TOK; i += gridDim.x * NTHREADS) { p.rowss1[i] = 0.f; p.rowss2[i] = 0.f; }
  for (int i = blockIdx.x * NTHREADS + threadIdx.x; i < T_TOK * 16; i += gridDim.x * NTHREADS) {
    const int j = i & 15;
    const float inv = exp2f(-(float)j * (18.931568569324174f / 16.0f));
    float sn, cs;
    sincosf((float)p.pos[i >> 4] * inv, &sn, &cs);
    *(float2*)(p.ropetab + (size_t)i * 2) = make_float2(cs, sn);
  }
  convert_f32_bf16(p.sk1f, p.sk1, 128 * 128 / 8);
  convert_f32_bf16(p.sk2f, p.sk2, 128 * 128 / 8);
  quant_rows_fp4<true>(p, blockIdx.x * 8 + wid, gridDim.x * 8, lane);
}

DI void phase_inproj(const Params& p, char* smem) {
  auto epi = [&](const Acc8& acc0, int pm, int pn, int wr, int wc, int fr, int fq) {
    const int region = pn >> 2;
    if (region == 0) {
      G8_FOREACH8(acc0, pm, pn, wr, wc, fr, fq, ai, bj, m, row, col) {
        *(u32x4*)(p.pbuf + (size_t)row * 1024 + col) = pack8(acc0[ai][bj][m][0], acc0[ai][bj][m][1], 1.0f);
      }
    } else {
      bfr* dst = (region == 1) ? p.qbuf : (region == 2 ? p.kbuf : p.vbuf);
      const float scale = (region == 1) ? 0.08838834764831845f : 1.0f;
      const bool rope = (region != 3) && (wc == 0);
#pragma unroll
      for (int ai = 0; ai < 2; ++ai)
#pragma unroll
        for (int m = 0; m < 4; ++m) {
          const int row = 256 * pm + 128 * ai + 64 * wr + 16 * m + fr;
          const int b = row >> 12, t = row & 4095;
          float sn[8], cs[8];
          if (rope) {
            const float4* tp = (const float4*)(p.ropetab + ((size_t)row * 16 + 8 * (fq & 1)) * 2);
#pragma unroll
            for (int e2 = 0; e2 < 4; ++e2) {
              const float4 t = tp[e2];
              cs[2 * e2] = t.x; sn[2 * e2] = t.y; cs[2 * e2 + 1] = t.z; sn[2 * e2 + 1] = t.w;
            }
          }
#pragma unroll
          for (int bj = 0; bj < 2; ++bj) {
            const int h = (pn & 3) * 2 + bj;
            f32x4 v0 = acc0[ai][bj][m][0], v1 = acc0[ai][bj][m][1];
            if (rope) {
#pragma unroll
              for (int i = 0; i < 4; ++i) {
                const float o0 = __shfl_xor(v0[i], 32), o1 = __shfl_xor(v1[i], 32);
                v0[i] = (fq < 2) ? v0[i] * cs[i] - o0 * sn[i] : v0[i] * cs[i] + o0 * sn[i];
                v1[i] = (fq < 2) ? v1[i] * cs[4 + i] - o1 * sn[4 + i] : v1[i] * cs[4 + i] + o1 * sn[4 + i];
              }
            }
            bfr* drow = dst + ((size_t)((b * 8 + h) * 4096 + t)) * 128 + 32 * wc + 8 * fq;
            *(u32x4*)(drow) = pack8(v0, v1, scale);
          }
        }
    }
  };
  gemm8((LAS unsigned char*)smem, p.hbuf, 2048, p.wInT, T_TOK, 4096, 2048, gridDim.x, blockIdx.x, epi);
}

DI void phase_mix_attn(const Params& p, char* smem) {
  const int tid = threadIdx.x, lane = tid & 63, w = tid >> 6, fr = lane & 15, fq = lane >> 4;
  {
    char* sK = smem;
    char* sV = smem + 65536;
    u32x4 kr[8], vr[8];
    bf16x8 qn[4];
    int pend_key0 = 0;
    auto decode = [&](int id, int& br, int& dl, int& bh, int& r, int& l0) {
      br = id >> 10;
      const int rem = id & 1023;
      dl = (br == 0) ? 1 : (br == 1 ? 4 : 16);
      const int nblk = 32 / dl;
      bh = rem >> 5;
      const int rn = rem & 31;
      r = rn / nblk;
      l0 = (rn % nblk) * 128;
    };
    auto issueK = [&](int id) {
      int br, dl, bh, r, l0;
      decode(id, br, dl, bh, r, l0);
      const size_t base = (size_t)bh * 4096 * 128 + (size_t)r * 128;
      const bfr* Kb = p.kbuf + base;
      const int kvstride = dl * 128, key0 = l0 - 128;
#pragma unroll
      for (int i = 0; i < 8; ++i) {
        const int e = tid + i * 512, key = e >> 4, c = e & 15, lk = key0 + key;
        const int lkc = lk < 0 ? 0 : lk;
        kr[i] = *(const u32x4*)(Kb + (long)lkc * kvstride + c * 8);
      }
      pend_key0 = key0;
    };
    auto issueVQ = [&](int id) {
      int br, dl, bh, r, l0;
      decode(id, br, dl, bh, r, l0);
      const size_t base = (size_t)bh * 4096 * 128 + (size_t)r * 128;
      const bfr* Vb = p.vbuf + base;
      const int kvstride = dl * 128, key0 = l0 - 128;
#pragma unroll
      for (int i = 0; i < 8; ++i) {
        const int e = tid + i * 512, key = e >> 4, c = e & 15, lk = key0 + key;
        const int lkc = lk < 0 ? 0 : lk;
        vr[i] = *(const u32x4*)(Vb + (long)lkc * kvstride + c * 8);
      }
      const bfr* qrow = p.qbuf + base + (long)(l0 + w * 16 + fr) * kvstride;
#pragma unroll
      for (int kk = 0; kk < 4; ++kk) qn[kk] = *(const bf16x8*)(qrow + kk * 32 + fq * 8);
    };
    const bool remap = (gridDim.x == 256);
    const int nround = remap ? 12 : (3072 + (int)gridDim.x - 1) / (int)gridDim.x;
    auto item_of = [&](int k) -> int {
      if (!remap) return k * (int)gridDim.x + (int)blockIdx.x;
      const int xcd = blockIdx.x & 7, slot = blockIdx.x >> 3;
      const int bh = (k / 3) * 8 + xcd, br = k % 3;
      return (br * 32 + bh) * 32 + slot;
    };
    if (item_of(0) < 3072) { issueK(item_of(0)); issueVQ(item_of(0)); }
    for (int k = 0; k < nround; ++k) {
      const int id = item_of(k);
      if (id >= 3072) break;
      __syncthreads();
#pragma unroll
      for (int i = 0; i < 8; ++i) {
        const int e = tid + i * 512, key = e >> 4, c = e & 15;
        const unsigned msk = (pend_key0 + key) < 0 ? 0u : 0xffffffffu;
        const u32x4 m4 = u32x4{msk, msk, msk, msk};
        *(u32x4*)(sK + key * 256 + ((c ^ (key & 15)) << 4)) = kr[i] & m4;
        *(u32x4*)(sV + key * 288 + c * 16) = vr[i] & m4;
      }
      bf16x8 qf[4];
#pragma unroll
      for (int kk = 0; kk < 4; ++kk) qf[kk] = qn[kk];
      __syncthreads();
      const int nid = (k + 1 < nround) ? item_of(k + 1) : 3072;
      if (nid < 3072) issueK(nid);
      int br, dl, bh, r, l0;
      decode(id, br, dl, bh, r, l0);
      float mx, l;
      const int b = bh >> 3, h = bh & 7;
      const int tt = b * 4096 + (l0 + w * 16 + fr) * dl + r;
      bfr* obase = p.ob + (size_t)br * T_TOK * 1024 + h * 128;
      const int tq0 = b * 4096 + r, lw = l0 + w * 16;
      attn_compute<true>(qf, l0, l0 - 128, smem,
                         [&](int q) { return obase + (size_t)(tq0 + (lw + q) * dl) * 1024; }, mx, l,
                         [&]() { if (nid < 3072) issueVQ(nid); });
      if (fq == 0) p.lse[(size_t)br * T_TOK * 8 + (size_t)tt * 8 + h] = mx + __builtin_amdgcn_logf(l);
    }
  }
  for (int id = 3072 + blockIdx.x; id < 3072 + 256; id += gridDim.x) {
    {
      const int ci = id - 3072;
      const int sub = tid >> 7, cgp = tid & 127;
      const int wdw = 2 << (cgp >> 5);
      const int t0 = ci * 64 + sub * 16, tin0 = t0 & 4095;
      const bfr* pb = p.pbuf + cgp * 8;
      float sum[8];
#pragma unroll
      for (int e = 0; e < 8; ++e) sum[e] = 0.f;
      for (int j = 1; j < wdw; ++j) {
        if (tin0 - j >= 0) {
          const u32x4 v = *(const u32x4*)(pb + (size_t)(t0 - j) * 1024);
#pragma unroll
          for (int e = 0; e < 4; ++e) { sum[2 * e] += bflo(v[e]); sum[2 * e + 1] += bfhi(v[e]); }
        }
      }
      for (int s = 0; s < 16; ++s) {
        const int t = t0 + s, tin = tin0 + s;
        const u32x4 v = *(const u32x4*)(pb + (size_t)t * 1024);
        float cur[8];
#pragma unroll
        for (int e = 0; e < 4; ++e) { cur[2 * e] = bflo(v[e]); cur[2 * e + 1] = bfhi(v[e]); }
        const float ic = 1.f / (float)min(tin + 1, wdw);
        u32x4 ov;
#pragma unroll
        for (int e = 0; e < 8; ++e) sum[e] += cur[e];
#pragma unroll
        for (int e = 0; e < 4; ++e) ov[e] = pack2(sum[2 * e] * ic - cur[2 * e], sum[2 * e + 1] * ic - cur[2 * e + 1]);
        *(u32x4*)(p.mixed + (size_t)t * 1024 + cgp * 8) = ov;
        if (tin - wdw + 1 >= 0) {
          const u32x4 u = *(const u32x4*)(pb + (size_t)(t - wdw + 1) * 1024);
#pragma unroll
          for (int e = 0; e < 4; ++e) { sum[2 * e] -= bflo(u[e]); sum[2 * e + 1] -= bfhi(u[e]); }
        }
      }
    }
  }
}

DI void phase_pool_combine(const Params& p, char* smem) {
  const int tid = threadIdx.x;
  {
    auto epi = [&](const Acc8& acc0, int pm, int pn, int wr, int wc, int fr, int fq) {
      G8_FOREACH8(acc0, pm, pn, wr, wc, fr, fq, ai, bj, m, row, col) {
        *(u32x4*)(p.hbuf + (size_t)row * 2048 + col) = pack8(acc0[ai][bj][m][0], acc0[ai][bj][m][1], 1.0f);
      }
    };
    gemm8((LAS unsigned char*)smem, p.mixed, 1024, p.wPoolT, T_TOK, 1024, 256, gridDim.x, blockIdx.x, epi, 512);
  }
  for (long i = (long)blockIdx.x * NTHREADS + tid; i < (long)T_TOK * 8 * 16; i += (long)gridDim.x * NTHREADS) {
    const int dc = (int)(i & 15), h = (int)((i >> 4) & 7);
    const long tt = i >> 7;
    const float l0 = p.lse[tt * 8 + h], l1 = p.lse[(size_t)T_TOK * 8 + tt * 8 + h], l2 = p.lse[(size_t)2 * T_TOK * 8 + tt * 8 + h];
    const float mx = fmaxf(l0, fmaxf(l1, l2));
    float w0 = __builtin_amdgcn_exp2f(l0 - mx), w1 = __builtin_amdgcn_exp2f(l1 - mx), w2 = __builtin_amdgcn_exp2f(l2 - mx);
    const float inv = 1.f / (w0 + w1 + w2);
    w0 *= inv; w1 *= inv; w2 *= inv;
    const size_t off = (size_t)tt * 1024 + h * 128 + dc * 8;
    const u32x4 a = *(const u32x4*)(p.ob + off);
    const u32x4 b = *(const u32x4*)(p.ob + (size_t)T_TOK * 1024 + off);
    const u32x4 c = *(const u32x4*)(p.ob + (size_t)2 * T_TOK * 1024 + off);
    u32x4 o;
#pragma unroll
    for (int e = 0; e < 4; ++e)
      o[e] = pack2(w0 * bflo(a[e]) + w1 * bflo(b[e]) + w2 * bflo(c[e]), w0 * bfhi(a[e]) + w1 * bfhi(b[e]) + w2 * bfhi(c[e]));
    *(u32x4*)(p.hbuf + (size_t)tt * 2048 + 1024 + h * 128 + dc * 8) = o;
  }
}

template <bool RESID_BF16>
DI void phase_gemm_resid(const bfr* A, int lda, const bfr* Bt, int K, const void* resid, bfr* xb, float* rowss, char* smem) {
  auto epi = [&](const Acc8& acc0, int pm, int pn, int wr, int wc, int fr, int fq) {
#pragma unroll
    for (int ai = 0; ai < 2; ++ai)
#pragma unroll
      for (int m = 0; m < 4; ++m) {
        const int row = 256 * pm + 128 * ai + 64 * wr + 16 * m + fr;
        float ss = 0.f;
#pragma unroll
        for (int bj = 0; bj < 2; ++bj) {
          const int col = 256 * pn + 128 * bj + 32 * wc + 8 * fq;
          const f32x4 v0 = acc0[ai][bj][m][0], v1 = acc0[ai][bj][m][1];
          float r[8];
          if (RESID_BF16) {
            const u32x4 t = *(const u32x4*)((const bfr*)resid + (size_t)row * 2048 + col);
#pragma unroll
            for (int e = 0; e < 4; ++e) { r[2 * e] = bflo(t[e]); r[2 * e + 1] = bfhi(t[e]); }
          } else {
            const float4 t0 = *(const float4*)((const float*)resid + (size_t)row * 2048 + col);
            const float4 t1 = *(const float4*)((const float*)resid + (size_t)row * 2048 + col + 4);
            r[0] = t0.x; r[1] = t0.y; r[2] = t0.z; r[3] = t0.w; r[4] = t1.x; r[5] = t1.y; r[6] = t1.z; r[7] = t1.w;
          }
          f32x4 o0, o1;
#pragma unroll
          for (int e = 0; e < 4; ++e) { o0[e] = r[e] + v0[e]; o1[e] = r[4 + e] + v1[e]; ss += o0[e] * o0[e] + o1[e] * o1[e]; }
          *(u32x4*)(xb + (size_t)row * 2048 + col) = pack8(o0, o1, 1.0f);
        }
        ss += __shfl_xor(ss, 16);
        ss += __shfl_xor(ss, 32);
        if (fq == 0) atomicAdd(rowss + row, ss);
      }
  };
  gemm8((LAS unsigned char*)smem, A, lda, Bt, T_TOK, 2048, K, gridDim.x, blockIdx.x, epi);
}

DI void phase_gemm_pq(const Params& p, char* smem) {
  auto epi = [&](const Acc8& acc0, int pm, int pn, int wr, int wc, int fr, int fq) {
    G8_FOREACH8(acc0, pm, pn, wr, wc, fr, fq, ai, bj, m, row, col) {
      const float rs = rsqrtf(p.rowss2[row] * (1.f / 2048.f) + 1e-6f);
      *(u32x4*)(p.pq + (size_t)row * 2048 + col) = pack8(acc0[ai][bj][m][0], acc0[ai][bj][m][1], rs);
    }
  };
  gemm8((LAS unsigned char*)smem, p.hbuf, 2048, p.wPqT, T_TOK, 2048, 2048, gridDim.x, blockIdx.x, epi);
}
DI void phase_cross_proj(const Params& p, char* smem) {
  const int half = gridDim.x >> 1;
  if ((int)blockIdx.x < half) {
    auto epi = [&](const Acc8& acc0, int pm, int pn, int wr, int wc, int fr, int fq) {
      G8_FOREACH8(acc0, pm, pn, wr, wc, fr, fq, ai, bj, m, row, col) {
        const float scale = 0.08838834764831845f * rsqrtf(p.rowss1[row] * (1.f / 2048.f) + 1e-6f);
        *(u32x4*)(p.qc + (size_t)row * 512 + col) = pack8(acc0[ai][bj][m][0], acc0[ai][bj][m][1], scale);
      }
    };
    gemm8((LAS unsigned char*)smem, p.x2b, 2048, p.wCqT, T_TOK, 512, 2048, half, blockIdx.x, epi);
  } else if ((int)blockIdx.x < half + 16) {
    auto epi = [&](const Acc8& acc0, int pm, int pn, int wr, int wc, int fr, int fq) {
      G8_FOREACH8(acc0, pm, pn, wr, wc, fr, fq, ai, bj, m, row, col) {
        bfr* dst = (col < 512) ? p.kc : p.vc;
        const int cc = col & 511, hh = cc >> 7, d = cc & 127, bb = row >> 8, mm = row & 255;
        *(u32x4*)(dst + ((size_t)((bb * 4 + hh) * 256 + mm)) * 128 + d) = pack8(acc0[ai][bj][m][0], acc0[ai][bj][m][1], 1.0f);
      }
    };
    gemm8((LAS unsigned char*)smem, p.memn, 2048, p.wCkT, 1024, 1024, 2048, 16, blockIdx.x - half, epi);
  } else {
    const int nidle = gridDim.x - (half + 16);
    quant_rows_fp4<false>(p, (blockIdx.x - (half + 16)) * 8 + (threadIdx.x >> 6), nidle * 8, threadIdx.x & 63);
  }
}

DI void phase_cross_attn(const Params& p, char* smem) {
  const int tid = threadIdx.x, lane = tid & 63, w = tid >> 6, fr = lane & 15, fq = lane >> 4;
  for (int id = blockIdx.x; id < 512; id += gridDim.x) {
    const int b = id >> 7, h = (id >> 5) & 3, qt = id & 31;
    float mx, l;
    const size_t kvb = (size_t)(b * 4 + h) * 256 * 128;
    bfr* obase = p.oc + (size_t)(b * 4096 + qt * 128 + w * 16) * 512 + h * 128;
    attn_core<false>(p.qc + (size_t)b * 4096 * 512 + h * 128, 512, qt * 128, p.kc + kvb, p.vc + kvb, 128, 0, smem,
                     [&](int q) { return obase + (size_t)q * 512; }, mx, l);
  }
}

DI void bitonic_sort16_desc(int (&mg)[16]);
DI void top16_of_32(int (&a)[16], int (&b)[16]);
template <unsigned AMASK>
DI void route_cands(int (&top)[16], const float (&v1)[16], const float (&v2)[16]) {
  int ca[16], cb[16];
#pragma unroll
  for (int j = 0; j < 16; ++j) { ca[j] = (int)0x80000000; cb[j] = (int)0x80000000; }
  int c = 0;
#pragma unroll
  for (int a = 0; a < 16; ++a)
#pragma unroll
    for (int b = 0; b < 16; ++b)
      if (((AMASK >> a) & 1u) && (a + 1) * (b + 1) <= 16) {
        const int key = (f2sort(v1[a] + v2[b]) & ~0xFF) | (a * 16 + b);
        if (c < 16) ca[c] = key; else cb[c - 16] = key;
        ++c;
      }
  top16_of_32(ca, cb);
#pragma unroll
  for (int j = 0; j < 16; ++j) top[j] = ca[j];
}
DI void bitonic_sort16_desc(int (&mg)[16]) {
#pragma unroll
  for (int st = 8; st >= 1; st >>= 1)
#pragma unroll
    for (int i = 0; i < 16; ++i)
      if ((i & st) == 0) { const int hi = max(mg[i], mg[i + st]), lo = min(mg[i], mg[i + st]); mg[i] = hi; mg[i + st] = lo; }
}

DI void sort16_desc(int (&x)[16]) {
#pragma unroll
  for (int k = 2; k <= 16; k <<= 1)
#pragma unroll
    for (int j = k >> 1; j > 0; j >>= 1)
#pragma unroll
      for (int i = 0; i < 16; ++i) {
        const int l = i ^ j;
        if (l > i) {
          const int hi = max(x[i], x[l]), lo = min(x[i], x[l]);
          const bool desc = ((i & k) == 0);
          x[i] = desc ? hi : lo;
          x[l] = desc ? lo : hi;
        }
      }
}
DI void top16_of_32(int (&a)[16], int (&b)[16]) {
  sort16_desc(a);
  sort16_desc(b);
#pragma unroll
  for (int i = 0; i < 16; ++i) a[i] = max(a[i], b[15 - i]);
  bitonic_sort16_desc(a);
}
DI void phase_peer_route(const Params& p, char* smem) {
  const int tid = threadIdx.x, lane = tid & 63, w = tid >> 6, fr = lane & 15, fq = lane >> 4;
  char* sSK = smem;
  float* scores = (float*)(smem + 65536);
  int* lists = (int*)(smem + 65536 + 67584);
  int* tops = (int*)(smem + 65536);
  constexpr unsigned AM0 = (1u << 0) | (1u << 3) | (1u << 5) | (1u << 8) | (1u << 9) | (1u << 10) | (1u << 11);
  __syncthreads();
#pragma unroll
  for (int i = 0; i < 8; ++i) {
    const int id = tid + i * 512, key = id >> 4, c = id & 15;
    const bfr* src = (key < 128 ? p.sk1 : p.sk2) + (key & 127) * 128 + c * 8;
    *(u32x4*)(sSK + key * 256 + ((c ^ (key & 15)) << 4)) = *(const u32x4*)src;
  }
  for (int id = blockIdx.x; id < 2048; id += gridDim.x) {
    const int tt = id >> 3, h = id & 7;
    const int tok0 = tt * 64;
    __syncthreads();
    {
      const int tg = w & 3, hf = w >> 2;
      const bfr* arow = p.pq + (size_t)(tok0 + tg * 16 + fr) * 2048 + h * 256 + hf * 128;
      bf16x8 af[4];
#pragma unroll
      for (int kk = 0; kk < 4; ++kk) af[kk] = *(const bf16x8*)(arow + kk * 32 + fq * 8);
#pragma unroll
      for (int nt = 0; nt < 8; ++nt) {
        f32x4 a = f32x4{0.f, 0.f, 0.f, 0.f};
        const int key = hf * 128 + nt * 16 + fr;
#pragma unroll
        for (int kk = 0; kk < 4; ++kk) {
          const bf16x8 bfg = *(const bf16x8*)(sSK + key * 256 + (((kk * 4 + fq) ^ fr) << 4));
          a = mfma16(af[kk], bfg, a);
        }
#pragma unroll
        for (int i = 0; i < 4; ++i) scores[(hf * 64 + tg * 16 + fq * 4 + i) * 132 + nt * 16 + fr] = a[i];
      }
    }
    __syncthreads();
    {
      const int row = tid >> 2, part = tid & 3;
      int lst[16], lsb[16];
      const float* srow = scores + row * 132 + part * 32;
#pragma unroll
      for (int k4 = 0; k4 < 4; ++k4) {
        const float4 v = *(const float4*)(srow + k4 * 4);
        const float4 u = *(const float4*)(srow + 16 + k4 * 4);
        const int kb = part * 32 + k4 * 4;
        lst[k4 * 4 + 0] = (f2sort(v.x) & ~0x7F) | (kb + 0);
        lst[k4 * 4 + 1] = (f2sort(v.y) & ~0x7F) | (kb + 1);
        lst[k4 * 4 + 2] = (f2sort(v.z) & ~0x7F) | (kb + 2);
        lst[k4 * 4 + 3] = (f2sort(v.w) & ~0x7F) | (kb + 3);
        lsb[k4 * 4 + 0] = (f2sort(u.x) & ~0x7F) | (kb + 16);
        lsb[k4 * 4 + 1] = (f2sort(u.y) & ~0x7F) | (kb + 17);
        lsb[k4 * 4 + 2] = (f2sort(u.z) & ~0x7F) | (kb + 18);
        lsb[k4 * 4 + 3] = (f2sort(u.w) & ~0x7F) | (kb + 19);
      }
      top16_of_32(lst, lsb);
      int mg[16];
#pragma unroll
      for (int i = 0; i < 16; ++i) mg[i] = max(lst[i], __shfl_xor(lst[15 - i], 1));
      bitonic_sort16_desc(mg);
#pragma unroll
      for (int i = 0; i < 16; ++i) lst[i] = max(mg[i], __shfl_xor(mg[15 - i], 2));
      bitonic_sort16_desc(lst);
      if (part == 0) {
#pragma unroll
        for (int j4 = 0; j4 < 4; ++j4) {
          int4 t; t.x = lst[j4 * 4]; t.y = lst[j4 * 4 + 1]; t.z = lst[j4 * 4 + 2]; t.w = lst[j4 * 4 + 3];
          *(int4*)(lists + row * 16 + j4 * 4) = t;
        }
      }
    }
    __syncthreads();
    int top[16];
#pragma unroll
    for (int j = 0; j < 16; ++j) top[j] = (int)0x80000000;
    const int tokl = tid & 63;
    if (tid < 128) {
      float v1[16], v2[16];
#pragma unroll
      for (int j4 = 0; j4 < 4; ++j4) {
        const int4 t1 = *(const int4*)(lists + tokl * 16 + j4 * 4);
        const int4 t2 = *(const int4*)(lists + (64 + tokl) * 16 + j4 * 4);
        v1[j4 * 4] = sort2f(t1.x & ~0x7F); v1[j4 * 4 + 1] = sort2f(t1.y & ~0x7F); v1[j4 * 4 + 2] = sort2f(t1.z & ~0x7F); v1[j4 * 4 + 3] = sort2f(t1.w & ~0x7F);
        v2[j4 * 4] = sort2f(t2.x & ~0x7F); v2[j4 * 4 + 1] = sort2f(t2.y & ~0x7F); v2[j4 * 4 + 2] = sort2f(t2.z & ~0x7F); v2[j4 * 4 + 3] = sort2f(t2.w & ~0x7F);
      }
      if (tid < 64) {
        route_cands<AM0>(top, v1, v2);
      } else {
        route_cands<(~AM0) & 0xFFFFu>(top, v1, v2);
#pragma unroll
        for (int j4 = 0; j4 < 4; ++j4) {
          int4 t; t.x = top[j4 * 4]; t.y = top[j4 * 4 + 1]; t.z = top[j4 * 4 + 2]; t.w = top[j4 * 4 + 3];
          *(int4*)(tops + tokl * 16 + j4 * 4) = t;
        }
      }
    }
    __syncthreads();
    if (tid < 64) {
      int fin[16];
#pragma unroll
      for (int j4 = 0; j4 < 4; ++j4) {
        const int4 t = *(const int4*)(tops + tid * 16 + (3 - j4) * 4);
        fin[j4 * 4 + 0] = max(top[j4 * 4 + 0], t.w);
        fin[j4 * 4 + 1] = max(top[j4 * 4 + 1], t.z);
        fin[j4 * 4 + 2] = max(top[j4 * 4 + 2], t.y);
        fin[j4 * 4 + 3] = max(top[j4 * 4 + 3], t.x);
      }
      int ex[16];
      float val[16];
      float mxv = -3.0e38f;
#pragma unroll
      for (int j = 0; j < 16; ++j) {
        const int code = fin[j] & 0xFF;
        const int i1 = lists[tid * 16 + (code >> 4)] & 0x7F;
        const int i2 = lists[(64 + tid) * 16 + (code & 15)] & 0x7F;
        ex[j] = i1 * 128 + i2;
        val[j] = sort2f(fin[j] & ~0xFF);
        mxv = fmaxf(mxv, val[j]);
      }
      float sum = 0.f;
      float ev[16];
#pragma unroll
      for (int j = 0; j < 16; ++j) { ev[j] = __expf(val[j] - mxv); sum += ev[j]; }
      const float inv = 1.f / sum;
      const size_t ob = (size_t)(tok0 + tid) * 128 + h * 16;
#pragma unroll
      for (int j4 = 0; j4 < 4; ++j4) {
        int4 iv; iv.x = ex[j4 * 4]; iv.y = ex[j4 * 4 + 1]; iv.z = ex[j4 * 4 + 2]; iv.w = ex[j4 * 4 + 3];
        float4 gv; gv.x = ev[j4 * 4] * inv; gv.y = ev[j4 * 4 + 1] * inv; gv.z = ev[j4 * 4 + 2] * inv; gv.w = ev[j4 * 4 + 3] * inv;
        *(int4*)(p.idx + ob + j4 * 4) = iv;
        *(float4*)(p.gates + ob + j4 * 4) = gv;
      }
    }
  }
}

DI float gelu_tanh(float a) {
  const float u = 0.7978845608028654f * (a + 0.044715f * a * a * a);
  return 0.5f * a * (1.f + tanhf(u));
}

#define SB() __builtin_amdgcn_sched_barrier(0)
DI void peer_load8u(u32x4 (&bufa)[8], const unsigned char* tbl, int idxv, int g, int lane) {
#pragma unroll
  for (int k = 0; k < 8; ++k) {
    const int e = __builtin_amdgcn_readlane(idxv, g * 8 + k);
    bufa[k] = *(const u32x4*)(tbl + (size_t)e * 1024 + lane * 16);
  }
}
DI float peer_dot8(const u32x4 (&bufa)[8], const f32x2 (&hp)[16], int lane) {
  float part[8];
#pragma unroll
  for (int k = 0; k < 8; ++k) {
    const u32x4 u = bufa[k];
    f32x2 a2 = f32x2{0.f, 0.f};
#pragma unroll
    for (int c = 0; c < 4; ++c) {
      const unsigned uu = u[c];
      a2 += __builtin_amdgcn_cvt_scalef32_pk_f32_fp4(uu, 1.0f, 0) * hp[c * 4 + 0];
      a2 += __builtin_amdgcn_cvt_scalef32_pk_f32_fp4(uu, 1.0f, 1) * hp[c * 4 + 1];
      a2 += __builtin_amdgcn_cvt_scalef32_pk_f32_fp4(uu, 1.0f, 2) * hp[c * 4 + 2];
      a2 += __builtin_amdgcn_cvt_scalef32_pk_f32_fp4(uu, 1.0f, 3) * hp[c * 4 + 3];
    }
    part[k] = a2[0] + a2[1];
  }
  const bool up4 = (lane & 4) != 0, up2 = (lane & 2) != 0, up1 = (lane & 1) != 0;
  float q[4];
#pragma unroll
  for (int i = 0; i < 4; ++i) {
    const float keep = up4 ? part[i + 4] : part[i];
    const float send = up4 ? part[i] : part[i + 4];
    q[i] = keep + __shfl_xor(send, 4);
  }
  float r[2];
#pragma unroll
  for (int i = 0; i < 2; ++i) {
    const float keep = up2 ? q[i + 2] : q[i];
    const float send = up2 ? q[i] : q[i + 2];
    r[i] = keep + __shfl_xor(send, 2);
  }
  float v = (up1 ? r[1] : r[0]) + __shfl_xor(up1 ? r[0] : r[1], 1);
  v += __shfl_xor(v, 8);
  v += __shfl_xor(v, 16);
  v += __shfl_xor(v, 32);
  return v;
}
DI void peer_acc8(const u32x4 (&bufa)[8], f32x2 (&ys)[16], float cval, int g) {
#pragma unroll
  for (int k = 0; k < 8; ++k) {
    const float ck = __builtin_bit_cast(float, __builtin_amdgcn_readlane(__builtin_bit_cast(int, cval), g * 8 + k));
    const u32x4 u = bufa[k];
#pragma unroll
    for (int c = 0; c < 4; ++c) {
      const unsigned uu = u[c];
      ys[c * 4 + 0] += __builtin_amdgcn_cvt_scalef32_pk_f32_fp4(uu, 1.0f, 0) * ck;
      ys[c * 4 + 1] += __builtin_amdgcn_cvt_scalef32_pk_f32_fp4(uu, 1.0f, 1) * ck;
      ys[c * 4 + 2] += __builtin_amdgcn_cvt_scalef32_pk_f32_fp4(uu, 1.0f, 2) * ck;
      ys[c * 4 + 3] += __builtin_amdgcn_cvt_scalef32_pk_f32_fp4(uu, 1.0f, 3) * ck;
    }
  }
}

DI void phase_peer_expert(const Params& p) {
  const int lane = threadIdx.x & 63, wid = threadIdx.x >> 6;
  bool flag4;
  {
    float c1 = 1.0f, c2 = 2.0f;
    asm volatile("" : "+v"(c1), "+v"(c2));
    const unsigned w4 = __builtin_amdgcn_cvt_scalef32_pk_fp4_f32(0u, c1, c2, 1.0f, 0);
    const f32x2 r4 = __builtin_amdgcn_cvt_scalef32_pk_f32_fp4(w4, 1.0f, 0);
    flag4 = (r4[0] == 2.0f);
  }
  const int tstride = gridDim.x * 8;
  int myidx[2] = {0, 0};
  float mygate[2] = {0.f, 0.f};
  u32x4 bufAa[8], bufBa[8];
  {
    const int tok0 = blockIdx.x * 8 + wid;
    if (tok0 < T_TOK) {
#pragma unroll
      for (int half = 0; half < 2; ++half) {
        myidx[half] = p.idx[(size_t)tok0 * 128 + half * 64 + lane];
        mygate[half] = p.gates[(size_t)tok0 * 128 + half * 64 + lane];
      }
      peer_load8u(bufAa, p.wU8, myidx[0], 0, lane);
    }
  }
  for (int tok = blockIdx.x * 8 + wid; tok < T_TOK; tok += tstride) {
    const int ntok = (tok + tstride < T_TOK) ? tok + tstride : tok;
    int nxidx[2];
    float nxgate[2];
#pragma unroll
    for (int half = 0; half < 2; ++half) {
      nxidx[half] = p.idx[(size_t)ntok * 128 + half * 64 + lane];
      nxgate[half] = p.gates[(size_t)ntok * 128 + half * 64 + lane];
    }
    const float rs2 = rsqrtf(p.rowss2[tok] * (1.f / 2048.f) + 1e-6f);
    f32x2 hs[16];
    {
      float he[32];
#pragma unroll
      for (int j = 0; j < 2; ++j)
#pragma unroll
        for (int q = 0; q < 2; ++q) {
          const u32x4 t = *(const u32x4*)(p.hbuf + (size_t)tok * 2048 + j * 1024 + lane * 16 + q * 8);
#pragma unroll
          for (int c = 0; c < 4; ++c) { const unsigned tt = t[c]; he[j * 16 + q * 8 + c * 2] = bflo(tt); he[j * 16 + q * 8 + c * 2 + 1] = bfhi(tt); }
        }
#pragma unroll
      for (int i = 0; i < 16; ++i) {
        const float n0 = he[2 * i], n1 = he[2 * i + 1];
        hs[i] = f32x2{flag4 ? n1 : n0, flag4 ? n0 : n1};
      }
    }
    f32x2 ys[16];
#pragma unroll
    for (int e = 0; e < 16; ++e) ys[e] = f32x2{0.f, 0.f};
#pragma unroll 1
    for (int half = 0; half < 2; ++half) {
      const int idxv = half ? myidx[1] : myidx[0];
      const float gate = half ? mygate[1] : mygate[0];
      const float mysu = p.su[idxv], mysv = p.sv[idxv];
      float amine = 0.f;
#pragma unroll 1
      for (int g2 = 0; g2 < 3; ++g2) {
        peer_load8u(bufBa, p.wU8, idxv, 2 * g2 + 1, lane);
        SB();
        { const float v = peer_dot8(bufAa, hs, lane); if ((lane >> 3) == 2 * g2) amine = v; }
        SB();
        peer_load8u(bufAa, p.wU8, idxv, 2 * g2 + 2, lane);
        SB();
        { const float v = peer_dot8(bufBa, hs, lane); if ((lane >> 3) == 2 * g2 + 1) amine = v; }
        SB();
      }
      {
        peer_load8u(bufBa, p.wU8, idxv, 7, lane);
        SB();
        { const float v = peer_dot8(bufAa, hs, lane); if ((lane >> 3) == 6) amine = v; }
        SB();
        peer_load8u(bufAa, p.wV8, idxv, 0, lane);
        SB();
        { const float v = peer_dot8(bufBa, hs, lane); if ((lane >> 3) == 7) amine = v; }
        SB();
      }
      const float cval = gate * gelu_tanh(amine * mysu * rs2) * mysv;
      const int nidx = half ? nxidx[0] : myidx[1];
#pragma unroll 1
      for (int g2 = 0; g2 < 3; ++g2) {
        peer_load8u(bufBa, p.wV8, idxv, 2 * g2 + 1, lane);
        SB();
        peer_acc8(bufAa, ys, cval, 2 * g2);
        SB();
        peer_load8u(bufAa, p.wV8, idxv, 2 * g2 + 2, lane);
        SB();
        peer_acc8(bufBa, ys, cval, 2 * g2 + 1);
        SB();
      }
      {
        peer_load8u(bufBa, p.wV8, idxv, 7, lane);
        SB();
        peer_acc8(bufAa, ys, cval, 6);
        SB();
        peer_load8u(bufAa, p.wU8, nidx, 0, lane);
        SB();
        peer_acc8(bufBa, ys, cval, 7);
        SB();
      }
    }
    float ss = 0.f;
#pragma unroll
    for (int i = 0; i < 16; ++i) { ys[i] += hs[i]; ss += ys[i][0] * ys[i][0] + ys[i][1] * ys[i][1]; }
    float ye[32];
#pragma unroll
    for (int i = 0; i < 16; ++i) {
      ye[2 * i] = flag4 ? ys[i][1] : ys[i][0];
      ye[2 * i + 1] = flag4 ? ys[i][0] : ys[i][1];
    }
    ss = wave_sum(ss);
    const float rs = rsqrtf(ss * (1.f / 2048.f) + 1e-6f);
#pragma unroll
    for (int j = 0; j < 2; ++j)
#pragma unroll
      for (int q = 0; q < 4; ++q) {
        const float4 gq = *(const float4*)(p.g_final + j * 1024 + lane * 16 + q * 4);
        const int b0 = j * 16 + q * 4;
        float4 o;
        o.x = ye[b0] * rs * gq.x; o.y = ye[b0 + 1] * rs * gq.y; o.z = ye[b0 + 2] * rs * gq.z; o.w = ye[b0 + 3] * rs * gq.w;
        *(float4*)(p.out + (size_t)tok * 2048 + j * 1024 + lane * 16 + q * 4) = o;
      }
    myidx[0] = nxidx[0]; myidx[1] = nxidx[1]; mygate[0] = nxgate[0]; mygate[1] = nxgate[1];
  }
}

#define XB_TMO      128
#define XB_XCNT(j)  (256  + 64 * (j))
#define XB_XSUB(j)  (1280 + 64 * (j))
#define XB_XGEN(j)  (2304 + 64 * (j))
#define XB_TOP      3328
#define XB_TOPGEN   3392
#define XCD_BAR_WORDS 3456
#define XB_SPIN_CAP (1u << 20)
DI unsigned xb_ld(unsigned* p)              { return __hip_atomic_load(p, __ATOMIC_RELAXED, __HIP_MEMORY_SCOPE_AGENT); }
DI unsigned xb_add(unsigned* p, unsigned v) { return __hip_atomic_fetch_add(p, v, __ATOMIC_RELAXED, __HIP_MEMORY_SCOPE_AGENT); }
DI unsigned xb_xcc_id() { return (unsigned)__builtin_amdgcn_s_getreg((3 << 11) | 20) & 0xFu; }
#define XB_SPIN(cond, bar) do { unsigned _sp = 0; while (cond) { __builtin_amdgcn_s_sleep(1); \
    if ((++_sp & 255u) == 0u) { if (xb_ld(&(bar)[XB_TMO])) break; if (_sp > XB_SPIN_CAP) { atomicAdd(&(bar)[XB_TMO], 1u); break; } } } } while (0)
struct XcdBarrier { unsigned* bar; unsigned x; volatile LAS unsigned* st; };
DI XcdBarrier xcd_barrier_post(unsigned* bar, volatile LAS unsigned* st) {
  XcdBarrier b; b.bar = bar; b.x = xb_xcc_id(); b.st = st;
  if (threadIdx.x == 0) (void)xb_add(&bar[XB_XCNT(b.x)], 1u);
  return b;
}
DI void xcd_barrier_complete(unsigned* bar, unsigned x, unsigned& nloc, unsigned& nx) {
  const unsigned G = gridDim.x * gridDim.y * gridDim.z;
  unsigned sum, cnt, mine, sp = 0u;
  for (;;) {
    sum = 0u; cnt = 0u; mine = 0u;
#pragma unroll
    for (unsigned j = 0; j < 16; ++j) { const unsigned c = xb_ld(&bar[XB_XCNT(j)]); sum += c; cnt += (c > 0u) ? 1u : 0u; mine = (j == x) ? c : mine; }
    if (sum == G) break;
    __builtin_amdgcn_s_sleep(1);
    if ((++sp & 255u) == 0u) { if (xb_ld(&bar[XB_TMO])) break; if (sp > XB_SPIN_CAP) { atomicAdd(&bar[XB_TMO], 1u); break; } }
  }
  nloc = mine > 0u ? mine : 1u; nx = cnt > 0u ? cnt : 1u;
}
DI void xcd_barrier(const XcdBarrier& b) {
  asm volatile("s_waitcnt vmcnt(0)" ::: "memory");
  __syncthreads();
  if (threadIdx.x == 0) {
    unsigned* bar = b.bar;
    __builtin_amdgcn_s_waitcnt(0);
    unsigned nloc = b.st[0], nx = b.st[1];
    if (nloc == 0u) { xcd_barrier_complete(bar, b.x, nloc, nx); b.st[0] = nloc; b.st[1] = nx; }
    const unsigned old = xb_add(&bar[XB_XSUB(b.x)], 1u);
    const unsigned gen = old / nloc;
    if (old + 1u == (gen + 1u) * nloc) {
      __builtin_amdgcn_fence(__ATOMIC_RELEASE, "agent");
      asm volatile("s_waitcnt vmcnt(0)" ::: "memory");
      const unsigned og = xb_add(&bar[XB_TOP], 1u);
      const unsigned tg = og / nx;
      if (og + 1u == (tg + 1u) * nx) xb_add(&bar[XB_TOPGEN], 1u);
      else XB_SPIN(xb_ld(&bar[XB_TOPGEN]) == tg, bar);
      __builtin_amdgcn_fence(__ATOMIC_ACQUIRE, "agent");
      xb_add(&bar[XB_XGEN(b.x)], 1u);
      asm volatile("s_waitcnt vmcnt(0)" ::: "memory");
    } else {
      XB_SPIN(xb_ld(&bar[XB_XGEN(b.x)]) == gen, bar);
      __builtin_amdgcn_fence(__ATOMIC_ACQUIRE, "agent");
      asm volatile("s_waitcnt vmcnt(0)" ::: "memory");
    }
  }
  __syncthreads();
}

__global__ void __launch_bounds__(NTHREADS) mega(Params p, int phase_lo, int phase_hi) {
  __shared__ __attribute__((aligned(16))) char smem[SMEM_BYTES];
  cg::grid_group grid = cg::this_grid();
  volatile LAS unsigned* xst = (volatile LAS unsigned*)(smem + SMEM_BYTES - 16);
  if (threadIdx.x == 0) { xst[0] = 0u; xst[1] = 0u; }
  __syncthreads();
  const XcdBarrier xbar = xcd_barrier_post(p.bar + 64, xst);
  if (phase_hi > 1000) grid.sync();
#define PHASE(k, call) if (phase_lo <= (k) && (k) < phase_hi) { if ((k) > phase_lo) { xcd_barrier(xbar); } call; if ((DUP_MASK >> (k)) & 1) { xcd_barrier(xbar); call; } }
  PHASE(0, phase_prep(p, smem))
  PHASE(1, phase_inproj(p, smem))
  PHASE(2, phase_mix_attn(p, smem))
  PHASE(3, phase_pool_combine(p, smem))
  PHASE(4, phase_gemm_resid<false>(p.hbuf, 2048, p.wOutT, 2048, p.x, p.x2b, p.rowss1, smem))
  PHASE(6, phase_cross_proj(p, smem))
  PHASE(7, phase_cross_attn(p, smem))
  PHASE(8, phase_gemm_resid<true>(p.oc, 512, p.wCoT, 512, p.x2b, p.hbuf, p.rowss2, smem))
  PHASE(10, phase_gemm_pq(p, smem))
  PHASE(11, phase_peer_route(p, smem))
  PHASE(12, phase_peer_expert(p))
}

extern "C" void kernel_launch(void* const* d_in, const int* in_sizes, int n_in, void* d_out, int out_size, void* d_ws,
                              size_t ws_size, hipStream_t stream) {
  Params p{};
  p.x = (const float*)d_in[0]; p.mem = (const float*)d_in[1]; p.pos = (const int*)d_in[2];
  p.g_mix = (const float*)d_in[3]; p.w_in = (const float*)d_in[4]; p.w_pool = (const float*)d_in[5];
  p.pool_scale = (const float*)d_in[6]; p.w_out = (const float*)d_in[7]; p.g_cross = (const float*)d_in[8];
  p.g_mem = (const float*)d_in[9]; p.w_cq = (const float*)d_in[10]; p.w_ck = (const float*)d_in[11];
  p.w_cv = (const float*)d_in[12]; p.w_co = (const float*)d_in[13]; p.g_ffn = (const float*)d_in[14];
  p.w_pq = (const float*)d_in[15]; p.sk1f = (const float*)d_in[16]; p.sk2f = (const float*)d_in[17];
  p.w_u = (const float*)d_in[18]; p.w_v = (const float*)d_in[19]; p.g_final = (const float*)d_in[20];
  p.out = (float*)d_out;
  char* ws = (char*)d_ws;
  size_t off = 0;
  auto take = [&](size_t bytes) { char* r = ws + off; off += (bytes + 255) & ~(size_t)255; return r; };
  const size_t MB = 1024 * 1024;
  p.wInT = (bfr*)take(16 * MB); p.wPoolT = (bfr*)take(512 * 1024); p.wOutT = (bfr*)take(8 * MB);
  p.wCqT = (bfr*)take(2 * MB); p.wCkT = (bfr*)take(2 * MB); p.wCvT = (bfr*)take(2 * MB); p.wCoT = (bfr*)take(2 * MB);
  p.wPqT = (bfr*)take(8 * MB); p.sk1 = (bfr*)take(32768); p.sk2 = (bfr*)take(32768);
  p.wU8 = (unsigned char*)take(32 * MB); p.wV8 = (unsigned char*)take(32 * MB);
  p.su = (float*)take(65536); p.sv = (float*)take(65536);
  p.memn = (bfr*)take(4 * MB); p.kc = (bfr*)take(1 * MB); p.vc = (bfr*)take(1 * MB);
  p.hbuf = (bfr*)take(64 * MB);
  p.bar = (unsigned*)take(256 + XCD_BAR_WORDS * 4);
  p.rowss1 = (float*)take(65536); p.rowss2 = (float*)take(65536);
  p.ropetab = (float*)take((size_t)T_TOK * 16 * 2 * 4);
  const size_t r2 = off;
  p.qbuf = (bfr*)take(32 * MB); p.kbuf = (bfr*)take(32 * MB); p.vbuf = (bfr*)take(32 * MB);
  p.pbuf = (bfr*)take(32 * MB); p.mixed = (bfr*)take(32 * MB); p.ob = (bfr*)take(96 * MB);
  p.lse = (float*)take((size_t)3 * T_TOK * 8 * 4);
  const size_t end1 = off;
  off = r2;
  p.xres = (float*)take(128 * MB); p.pq = (bfr*)take(64 * MB); p.x2b = p.pq; p.qc = (bfr*)take(16 * MB); p.oc = (bfr*)take(16 * MB);
  p.idx = (int*)take(8 * MB); p.gates = (float*)take(8 * MB);
  const size_t end2 = off;
  const size_t need = end1 > end2 ? end1 : end2;
  if (need > ws_size) { fprintf(stderr, "workspace too small: need %zu have %zu\n", need, ws_size); return; }

  static int grid_blocks = 0;
  if (!grid_blocks) {
    int dev = 0, cus = 0, per_cu = 0;
    hipGetDevice(&dev);
    hipDeviceGetAttribute(&cus, hipDeviceAttributeMultiprocessorCount, dev);
    hipOccupancyMaxActiveBlocksPerMultiprocessor(&per_cu, mega, NTHREADS, 0);
    if (per_cu < 1) per_cu = 1;
    if (per_cu > 1) per_cu = 1;
    grid_blocks = cus * per_cu;
  }
  hipMemsetAsync(p.bar, 0, 256 + XCD_BAR_WORDS * 4, stream);
#if MULTI_LAUNCH
  for (int ph = 0; ph < NPHASE; ++ph) hipLaunchKernelGGL(mega, dim3(grid_blocks), dim3(NTHREADS), 0, stream, p, ph, ph + 1);
#else
  int lo = 0, hi = NPHASE;
  void* args[] = {&p, &lo, &hi};
  hipError_t e = hipLaunchCooperativeKernel((void*)mega, dim3(grid_blocks), dim3(NTHREADS), args, 0, stream);
  if (e != hipSuccess) fprintf(stderr, "cooperative launch failed: %s (grid %d)\n", hipGetErrorString(e), grid_blocks);
#endif
}
```

```cpp
#include <hip/hip_runtime.h>
#include <hip/hip_cooperative_groups.h>
#include <stdint.h>
#include <stdio.h>
namespace cg = cooperative_groups;

#ifndef DUP_MASK
#define DUP_MASK 0
#endif
#ifndef MULTI_LAUNCH
#define MULTI_LAUNCH 0
#endif

#define DI __device__ __forceinline__
typedef unsigned short bfr;
using bf16x8 = __attribute__((ext_vector_type(8))) short;
using s16x4  = __attribute__((ext_vector_type(4))) short;
using f32x4  = __attribute__((ext_vector_type(4))) float;
using u32x4  = __attribute__((ext_vector_type(4))) unsigned;
using u32x2  = __attribute__((ext_vector_type(2))) unsigned;
using bf2    = __attribute__((ext_vector_type(2))) __bf16;
using f32x2  = __attribute__((ext_vector_type(2))) float;
using v6u    = __attribute__((ext_vector_type(6))) unsigned;
using v16f   = __attribute__((ext_vector_type(16))) float;
using v32f   = __attribute__((ext_vector_type(32))) float;

constexpr int T_TOK = 16384;
constexpr int NTHREADS = 512;
constexpr int SMEM_BYTES = 151552;
constexpr int NPHASE = 13;

struct Params {
  const float *x, *mem; const int* pos;
  const float *g_mix, *w_in, *w_pool, *pool_scale, *w_out, *g_cross, *g_mem, *w_cq, *w_ck, *w_cv, *w_co, *g_ffn, *w_pq,
              *sk1f, *sk2f, *w_u, *w_v, *g_final;
  float* out;
  bfr *wInT, *wPoolT, *wOutT, *wCqT, *wCkT, *wCvT, *wCoT, *wPqT, *sk1, *sk2;
  unsigned char *wU8, *wV8; float *su, *sv;
  bfr *hbuf, *memn, *kc, *vc;
  bfr *pbuf, *qbuf, *kbuf, *vbuf, *mixed, *ob; float* lse;
  float* xres; bfr *pq, *qc, *oc; int* idx; float* gates;
  unsigned* bar;
  float *rowss1, *rowss2; bfr* x2b;
  float* ropetab;
};

DI unsigned pack2(float a, float b) { bf2 p; p[0] = (__bf16)a; p[1] = (__bf16)b; return __builtin_bit_cast(unsigned, p); }
DI float bflo(unsigned u) { return __uint_as_float(u << 16); }
DI float bfhi(unsigned u) { return __uint_as_float(u & 0xffff0000u); }
DI float4 ldnt4(const float* p) { const f32x4 v = __builtin_nontemporal_load((const f32x4*)p); return make_float4(v[0], v[1], v[2], v[3]); }
DI float wave_sum(float v) {
#pragma unroll
  for (int o = 32; o >= 1; o >>= 1) v += __shfl_xor(v, o);
  return v;
}
DI f32x4 mfma16(bf16x8 a, bf16x8 b, f32x4 c) { return __builtin_amdgcn_mfma_f32_16x16x32_bf16(a, b, c, 0, 0, 0); }
DI s16x4 tr_read(const char* p) {
  return __builtin_amdgcn_ds_read_tr16_b64_v4i16((s16x4 __attribute__((address_space(3)))*)(p));
}


#define LAS __attribute__((address_space(3)))
namespace g8 {
constexpr int BM = 256, BK = 64, HALF = 128, HTB = HALF * BK * 2, NXCD = 8, WGM = 8;
DI int lds_byte(int r, int c) { const int st = (r >> 4) * 2 + (c >> 5), rr = r & 15, cc = c & 31, ob = rr * 64 + cc * 2; return st * 1024 + (ob ^ (((ob >> 9) & 1) << 5)); }
DI int perm32(int rho) { const int n = rho >> 4, i = rho & 15; return 8 * (i >> 2) + 4 * n + (i & 3); }
DI void stage_rc(int b, int& R, int& C) { const int st = b / 1024, sb = b % 1024, swz = sb ^ (((sb >> 9) & 1) << 5); R = (st >> 1) * 16 + swz / 64; C = (st & 1) * 32 + (swz % 64) / 2; }
struct Order {
  int nM, nN, nwg, G, c;
  DI void init(int M, int N, int G_, int c_) { nM = M / BM; nN = N / BM; nwg = nM * nN; G = G_; c = c_; }
  DI bool next(int i, int& pm, int& pn) const {
    const long L = (long)i * G + c; if (L >= nwg) return false;
    int wgid = (int)L; { const int q = nwg / NXCD, r = nwg % NXCD, xcd = wgid % NXCD, off = wgid / NXCD; wgid = (xcd < r ? xcd * (q + 1) : r * (q + 1) + (xcd - r) * q) + off; }
    const int nig = WGM * nN, gid = wgid / nig, fm = gid * WGM, gsz = (nM - fm) < WGM ? (nM - fm) : WGM;
    pm = fm + ((wgid % nig) % gsz); pn = (wgid % nig) / gsz; return true;
  }
};
}

template <class Epi>
DI void gemm8(LAS unsigned char* lds, const bfr* A, int lda, const bfr* Bt, int M, int N, int K, int G, int c, const Epi& E, int a_pn_bytes = 0) {
  using namespace g8;
  const int tid = threadIdx.x, wid = __builtin_amdgcn_readfirstlane(tid >> 6), lane = tid & 63, wr = wid >> 2, wc = wid & 3, fr = lane & 15, fq = lane >> 4;
  const int nt = K / BK;
  Order S; S.init(M, N, G, c);
  unsigned voffA[2], voffB[2];
#pragma unroll
  for (int i = 0; i < 2; ++i) { int R, C; stage_rc(tid * 16 + i * 8192, R, C); const int Rb = (R & ~31) + perm32(R & 31);
    voffA[i] = (unsigned)(R * lda + C) * 2u; voffB[i] = (unsigned)(Rb * K + C) * 2u; }
  const size_t kstep = (size_t)(BK * 2);
  const size_t hstepA = (size_t)HALF * lda * 2, hstepB = (size_t)HALF * K * 2;
  const size_t tstepA = 2 * hstepA, tstepB = 2 * hstepB;
  const unsigned ldsw = (unsigned)wid * 1024u;
  const int aoff = lds_byte(wr * 64 + fr, fq * 8), boff = lds_byte(wc * 32 + fr, fq * 8);
#define G8_SA(b, h) (((b) * 2 + (h)) * HTB)
#define G8_SB(b, h) ((4 + (b) * 2 + (h)) * HTB)
#define G8_STAGE(bufoff, gbase, voff) do { _Pragma("unroll") for (int _i = 0; _i < 2; ++_i) \
    __builtin_amdgcn_global_load_lds((const unsigned*)((const char*)(gbase) + (voff)[_i]), (LAS unsigned*)(lds + (bufoff) + ldsw + _i * 8192), 16, 0, 0); } while (0)
#define G8_LDA(dst, b, h) do { _Pragma("unroll") for (int m = 0; m < 4; ++m) _Pragma("unroll") for (int k = 0; k < 2; ++k) dst[m][k] = *(const LAS bf16x8*)(lds + G8_SA(b, h) + aoff + m * 2048 + k * 1024); } while (0)
#define G8_LDB(dst, b, h) do { _Pragma("unroll") for (int n = 0; n < 2; ++n) _Pragma("unroll") for (int k = 0; k < 2; ++k) dst[n][k] = *(const LAS bf16x8*)(lds + G8_SB(b, h) + boff + n * 2048 + k * 1024); } while (0)
#define G8_MMA(ai, bj, At, Btf) do { __builtin_amdgcn_s_setprio(1); _Pragma("unroll") for (int m = 0; m < 4; ++m) _Pragma("unroll") for (int n = 0; n < 2; ++n) _Pragma("unroll") for (int k = 0; k < 2; ++k) \
    acc[ai][bj][m][n] = __builtin_amdgcn_mfma_f32_16x16x32_bf16(Btf[n][k], At[m][k], acc[ai][bj][m][n], 0, 0, 0); __builtin_amdgcn_s_setprio(0); } while (0)
#define G8_WAIT_V(n) asm volatile("s_waitcnt vmcnt(" #n ")" ::: "memory")
#define G8_WAIT_L(n) asm volatile("s_waitcnt lgkmcnt(" #n ")" ::: "memory")
#define G8_BAR __builtin_amdgcn_s_barrier()
#define G8_SCHED __builtin_amdgcn_sched_barrier(0)
  int cpm, cpn, npm = 0, npn = 0, ui = 0;
  if (!S.next(0, cpm, cpn)) return;
  f32x4 acc[2][2][4][2];
#pragma unroll
  for (int a = 0; a < 2; ++a)
#pragma unroll
    for (int b = 0; b < 2; ++b)
#pragma unroll
      for (int m = 0; m < 4; ++m)
#pragma unroll
        for (int n = 0; n < 2; ++n) acc[a][b][m][n] = f32x4{0.f, 0.f, 0.f, 0.f};
  bf16x8 At[4][2], B0[2][2], B1[2][2];
  const char* cA = (const char*)A + (size_t)cpm * tstepA + (size_t)cpn * a_pn_bytes; const char* cB = (const char*)Bt + (size_t)cpn * tstepB;
  G8_STAGE(G8_SB(0, 0), cB, voffB); G8_STAGE(G8_SA(0, 0), cA, voffA); G8_STAGE(G8_SB(0, 1), cB + hstepB, voffB); G8_STAGE(G8_SA(0, 1), cA + hstepA, voffA);
  if (wr == 1) G8_BAR;
  G8_WAIT_V(4); G8_BAR;
  G8_STAGE(G8_SB(1, 0), cB + kstep, voffB); G8_STAGE(G8_SA(1, 0), cA + kstep, voffA); G8_STAGE(G8_SB(1, 1), cB + hstepB + kstep, voffB);
  G8_WAIT_V(6); G8_BAR;
  for (;;) {
    const bool has_next = S.next(ui + 1, npm, npn);
    const char* nA = has_next ? (const char*)A + (size_t)npm * tstepA + (size_t)npn * a_pn_bytes : cA; const char* nB = has_next ? (const char*)Bt + (size_t)npn * tstepB : cB;
    for (int t = 0; t < nt; t += 2) {
      const bool last = (t == nt - 2);
      const char* a1 = cA + (size_t)(t + 1) * kstep;
      const char* a2 = last ? nA : cA + (size_t)(t + 2) * kstep; const char* b2 = last ? nB : cB + (size_t)(t + 2) * kstep;
      const char* a3 = a2 + kstep; const char* b3 = b2 + kstep;
      G8_LDB(B0, 0, 0); G8_SCHED; G8_LDA(At, 0, 0); G8_STAGE(G8_SA(1, 1), a1 + hstepA, voffA);
      G8_WAIT_L(8); G8_BAR; G8_WAIT_L(0); G8_MMA(0, 0, At, B0); G8_BAR; G8_SCHED;
      G8_LDB(B1, 0, 1); G8_STAGE(G8_SB(0, 0), b2, voffB);
      G8_BAR; G8_WAIT_L(0); G8_MMA(0, 1, At, B1); G8_BAR;
      G8_LDA(At, 0, 1); G8_STAGE(G8_SA(0, 0), a2, voffA);
      G8_BAR; G8_WAIT_L(0); G8_MMA(1, 0, At, B0); G8_BAR; G8_SCHED;
      G8_STAGE(G8_SB(0, 1), b2 + hstepB, voffB);
      G8_WAIT_V(6); G8_BAR; G8_MMA(1, 1, At, B1); G8_BAR;
      G8_LDB(B0, 1, 0); G8_SCHED; G8_LDA(At, 1, 0); G8_STAGE(G8_SA(0, 1), a2 + hstepA, voffA);
      G8_WAIT_L(8); G8_BAR; G8_WAIT_L(0); G8_MMA(0, 0, At, B0); G8_BAR; G8_SCHED;
      G8_LDB(B1, 1, 1); G8_STAGE(G8_SB(1, 0), b3, voffB);
      G8_BAR; G8_WAIT_L(0); G8_MMA(0, 1, At, B1); G8_BAR;
      G8_LDA(At, 1, 1); G8_STAGE(G8_SA(1, 0), a3, voffA);
      G8_BAR; G8_WAIT_L(0); G8_MMA(1, 0, At, B0); G8_BAR; G8_SCHED;
      G8_STAGE(G8_SB(1, 1), b3 + hstepB, voffB);
      G8_WAIT_V(6); G8_BAR; G8_MMA(1, 1, At, B1); G8_BAR;
    }
    E(acc, cpm, cpn, wr, wc, fr, fq);
    if (!has_next) break;
#pragma unroll
    for (int a = 0; a < 2; ++a)
#pragma unroll
      for (int b = 0; b < 2; ++b)
#pragma unroll
        for (int m = 0; m < 4; ++m)
#pragma unroll
          for (int n = 0; n < 2; ++n) acc[a][b][m][n] = f32x4{0.f, 0.f, 0.f, 0.f};
    cpm = npm; cpn = npn; cA = nA; cB = nB; ++ui;
  }
  G8_WAIT_V(0);
  if (wr == 0) G8_BAR;
  G8_BAR;
#undef G8_SA
#undef G8_SB
#undef G8_STAGE
#undef G8_LDA
#undef G8_LDB
#undef G8_MMA
#undef G8_WAIT_V
#undef G8_WAIT_L
#undef G8_BAR
#undef G8_SCHED
}
#define G8_FOREACH8(acc, pm, pn, wr, wc, fr, fq, ai, bj, m, row, col) \
  _Pragma("unroll") for (int ai = 0; ai < 2; ++ai) _Pragma("unroll") for (int m = 0; m < 4; ++m) \
  _Pragma("unroll") for (int bj = 0; bj < 2; ++bj) \
    if (const int row = 256 * (pm) + 128 * ai + 64 * (wr) + 16 * m + (fr); true) if (const int col = 256 * (pn) + 128 * bj + 32 * (wc) + 8 * (fq); true)
DI u32x4 pack8(const f32x4 a, const f32x4 b, float sc) {
  return u32x4{pack2(a[0] * sc, a[1] * sc), pack2(a[2] * sc, a[3] * sc), pack2(b[0] * sc, b[1] * sc), pack2(b[2] * sc, b[3] * sc)};
}
typedef f32x4 Acc8[2][2][4][2];

struct NoHook { DI void operator()() const {} };
template <bool BANDED, class RowF, class MidF = NoHook>
DI void attn_compute(const bf16x8 (&qf)[4], int q0, int key0, char* smem, RowF rowptr, float& m_out, float& l_out, MidF mid = MidF()) {
  const int tid = threadIdx.x, lane = tid & 63, w = tid >> 6, fr = lane & 15, fq = lane >> 4;
  char* sK = smem;
  char* sV = smem + 65536;
  constexpr int NT = BANDED ? 10 : 16;
  const int t0 = BANDED ? (w & ~1) : 0;
  f32x4 s[NT];
#pragma unroll
  for (int j = 0; j < NT; ++j) {
    f32x4 a = f32x4{0.f, 0.f, 0.f, 0.f};
    const int key = (t0 + j) * 16 + fr;
#pragma unroll
    for (int kk = 0; kk < 4; ++kk) {
      const bf16x8 kf = *(const bf16x8*)(sK + key * 256 + (((kk * 4 + fq) ^ fr) << 4));
      a = mfma16(kf, qf[kk], a);
    }
    s[j] = a;
  }
  mid();
  const float L2E = 1.4426950408889634f;
  const float NINF = -__builtin_inff();
  float mx = NINF;
  const int lq = q0 + w * 16 + fr;
#pragma unroll
  for (int j = 0; j < NT; ++j)
#pragma unroll
    for (int i = 0; i < 4; ++i) {
      float v = s[j][i] * L2E;
      if (BANDED) {
        const int lk = key0 + (t0 + j) * 16 + fq * 4 + i;
        const int dist = lq - lk;
        const bool ok = (lk >= 0) && (dist >= 0) && (dist <= 128);
        v = ok ? v : NINF;
      }
      s[j][i] = v;
      mx = fmaxf(mx, v);
    }
  mx = fmaxf(mx, __shfl_xor(mx, 16));
  mx = fmaxf(mx, __shfl_xor(mx, 32));
  float l = 0.f;
#pragma unroll
  for (int j = 0; j < NT; ++j)
#pragma unroll
    for (int i = 0; i < 4; ++i) {
      const float p = __builtin_amdgcn_exp2f(s[j][i] - mx);
      s[j][i] = p;
      l += p;
    }
  l += __shfl_xor(l, 16);
  l += __shfl_xor(l, 32);
  bf16x8 pf[NT / 2];
#pragma unroll
  for (int c = 0; c < NT / 2; ++c) {
    u32x4 t;
    t[0] = pack2(s[2 * c][0], s[2 * c][1]);
    t[1] = pack2(s[2 * c][2], s[2 * c][3]);
    t[2] = pack2(s[2 * c + 1][0], s[2 * c + 1][1]);
    t[3] = pack2(s[2 * c + 1][2], s[2 * c + 1][3]);
    pf[c] = __builtin_bit_cast(bf16x8, t);
  }
  const int q4 = (lane & 15) >> 2, p4 = lane & 3;
  m_out = mx;
  l_out = l;
  const float il = 1.f / l;
  bfr* dst = rowptr(fr) + fq * 4;
#pragma unroll 2
  for (int dt = 0; dt < 8; ++dt) {
    f32x4 a = f32x4{0.f, 0.f, 0.f, 0.f};
#pragma unroll
    for (int c = 0; c < NT / 2; ++c) {
      const int kb = (t0 + 2 * c) * 16;
      const s16x4 lo = tr_read(sV + (kb + fq * 4 + q4) * 288 + (dt * 16 + p4 * 4) * 2);
      const s16x4 hi = tr_read(sV + (kb + 16 + fq * 4 + q4) * 288 + (dt * 16 + p4 * 4) * 2);
      const bf16x8 vf = __builtin_shufflevector(lo, hi, 0, 1, 2, 3, 4, 5, 6, 7);
      a = mfma16(vf, pf[c], a);
    }
    u32x2 v; v[0] = pack2(a[0] * il, a[1] * il); v[1] = pack2(a[2] * il, a[3] * il);
    *(u32x2*)(dst + dt * 16) = v;
  }
}

template <bool BANDED, class StoreF>
DI void attn_core(const bfr* __restrict__ Qb, int qstride, int q0, const bfr* __restrict__ Kb, const bfr* __restrict__ Vb,
                  int kvstride, int key0, char* smem, StoreF store, float& m_out, float& l_out) {
  const int tid = threadIdx.x, lane = tid & 63, w = tid >> 6, fr = lane & 15, fq = lane >> 4;
  char* sK = smem;
  char* sV = smem + 65536;
  __syncthreads();
#pragma unroll 1
  for (int rr = 0; rr < 2; ++rr) {
    u32x4 kr[4], vr[4];
#pragma unroll
    for (int i = 0; i < 4; ++i) {
      const int id = tid + (rr * 4 + i) * 512, key = id >> 4, c = id & 15, lk = key0 + key;
      const int lkc = lk < 0 ? 0 : lk;
      const unsigned msk = lk < 0 ? 0u : 0xffffffffu;
      kr[i] = *(const u32x4*)(Kb + (long)lkc * kvstride + c * 8);
      vr[i] = *(const u32x4*)(Vb + (long)lkc * kvstride + c * 8);
      kr[i] &= u32x4{msk, msk, msk, msk};
      vr[i] &= u32x4{msk, msk, msk, msk};
    }
#pragma unroll
    for (int i = 0; i < 4; ++i) {
      const int id = tid + (rr * 4 + i) * 512, key = id >> 4, c = id & 15;
      *(u32x4*)(sK + key * 256 + ((c ^ (key & 15)) << 4)) = kr[i];
      *(u32x4*)(sV + key * 288 + c * 16) = vr[i];
    }
  }
  bf16x8 qf[4];
  {
    const bfr* qrow = Qb + (long)(q0 + w * 16 + fr) * qstride;
#pragma unroll
    for (int kk = 0; kk < 4; ++kk) qf[kk] = *(const bf16x8*)(qrow + kk * 32 + fq * 8);
  }
  __syncthreads();
  attn_compute<BANDED>(qf, q0, key0, smem, store, m_out, l_out);
}

DI int f2sort(float f) { int b = __float_as_int(f); return b ^ ((b >> 31) & 0x7fffffff); }
DI float sort2f(int s) { int b = s ^ ((s >> 31) & 0x7fffffff); return __int_as_float(b); }
DI void topk_insert(int (&lst)[16], int key) {
#pragma unroll
  for (int j = 0; j < 16; ++j) {
    const int hi = max(lst[j], key);
    key = min(lst[j], key);
    lst[j] = hi;
  }
}

template <int O, int N>
DI void bfly(float (&p)[64], int lane) {
  const bool up = (lane & O) != 0;
#pragma unroll
  for (int i = 0; i < N / 2; ++i) {
    const float keep = up ? p[i + N / 2] : p[i];
    const float send = up ? p[i] : p[i + N / 2];
    p[i] = keep + __shfl_xor(send, O);
  }
  if constexpr (O > 1) bfly<O / 2, N / 2>(p, lane);
}

DI void rms_rows2_to_bf16(const float* __restrict__ x0, const float* __restrict__ x1, const float* __restrict__ g,
                          bfr* __restrict__ o0, bfr* __restrict__ o1, int lane) {
  float4 v0[8], v1[8];
#pragma unroll
  for (int j = 0; j < 8; ++j) v0[j] = ldnt4(x0 + j * 256 + lane * 4);
#pragma unroll
  for (int j = 0; j < 8; ++j) v1[j] = ldnt4(x1 + j * 256 + lane * 4);
  float s0 = 0.f, s1 = 0.f;
#pragma unroll
  for (int j = 0; j < 8; ++j) {
    s0 += v0[j].x * v0[j].x + v0[j].y * v0[j].y + v0[j].z * v0[j].z + v0[j].w * v0[j].w;
    s1 += v1[j].x * v1[j].x + v1[j].y * v1[j].y + v1[j].z * v1[j].z + v1[j].w * v1[j].w;
  }
  s0 = wave_sum(s0);
  s1 = wave_sum(s1);
  const float r0 = rsqrtf(s0 * (1.f / 2048.f) + 1e-6f), r1 = rsqrtf(s1 * (1.f / 2048.f) + 1e-6f);
#pragma unroll
  for (int j = 0; j < 8; ++j) {
    const float4 gg = *(const float4*)(g + j * 256 + lane * 4);
    u32x2 a, c;
    a[0] = pack2(v0[j].x * r0 * gg.x, v0[j].y * r0 * gg.y); a[1] = pack2(v0[j].z * r0 * gg.z, v0[j].w * r0 * gg.w);
    c[0] = pack2(v1[j].x * r1 * gg.x, v1[j].y * r1 * gg.y); c[1] = pack2(v1[j].z * r1 * gg.z, v1[j].w * r1 * gg.w);
    *(u32x2*)(o0 + j * 256 + lane * 4) = a;
    *(u32x2*)(o1 + j * 256 + lane * 4) = c;
  }
}

DI void convert_f32_bf16(const float* __restrict__ src, bfr* __restrict__ dst, long n8) {
  for (long i = (long)blockIdx.x * NTHREADS + threadIdx.x; i < n8; i += (long)gridDim.x * NTHREADS) {
    const float4 a = *(const float4*)(src + i * 8);
    const float4 b = *(const float4*)(src + i * 8 + 4);
    u32x4 o;
    o[0] = pack2(a.x, a.y); o[1] = pack2(a.z, a.w); o[2] = pack2(b.x, b.y); o[3] = pack2(b.z, b.w);
    *(u32x4*)(dst + i * 8) = o;
  }
}

DI void transpose_strip(const float* __restrict__ W, int K, int N, int k0, int n0, bfr* __restrict__ Wt, float* tile,
                        const float* colscale, const float* rowscale) {
  const int tid = threadIdx.x;
  __syncthreads();
  {
    const int c4 = tid & 63, r = tid >> 6;
    float4 v[8];
#pragma unroll
    for (int i = 0; i < 8; ++i) v[i] = ldnt4(W + (size_t)(k0 + r + 8 * i) * N + n0 + c4 * 4);
#pragma unroll
    for (int i = 0; i < 8; ++i) {
      float* t = tile + (r + 8 * i) * 257 + c4 * 4;
      t[0] = v[i].x; t[1] = v[i].y; t[2] = v[i].z; t[3] = v[i].w;
    }
  }
  __syncthreads();
#pragma unroll
  for (int j = 0; j < 4; ++j) {
    const int task = tid + 512 * j, n = task >> 3, kc = task & 7;
    const float csv = colscale ? colscale[n0 + n] : 1.0f;
    u32x4 o;
#pragma unroll
    for (int e = 0; e < 4; ++e) {
      const int k = kc * 8 + 2 * e;
      const float r0 = rowscale ? rowscale[k0 + k] : 1.0f, r1 = rowscale ? rowscale[k0 + k + 1] : 1.0f;
      o[e] = pack2(tile[k * 257 + n] * csv * r0, tile[(k + 1) * 257 + n] * csv * r1);
    }
    *(u32x4*)(Wt + (size_t)(n0 + n) * K + k0 + kc * 8) = o;
  }
}

template <bool isv>
DI void quant_rows_fp4(const Params& p, int worker, int nworkers, int lane) {
  const float* tbl = isv ? p.w_v : p.w_u;
  float* scl = isv ? p.sv : p.su;
  unsigned char* out8 = isv ? p.wV8 : p.wU8;
  float4 gg[8];
  if (!isv) {
#pragma unroll
    for (int j = 0; j < 2; ++j)
#pragma unroll
      for (int q = 0; q < 4; ++q) gg[j * 4 + q] = *(const float4*)(p.g_ffn + j * 1024 + lane * 16 + q * 4);
  }
  auto finish = [&](float4 (&v)[8], int rr) {
    float amax = 0.f;
#pragma unroll
    for (int i = 0; i < 8; ++i) {
      if (!isv) { v[i].x *= gg[i].x; v[i].y *= gg[i].y; v[i].z *= gg[i].z; v[i].w *= gg[i].w; }
      amax = fmaxf(amax, fmaxf(fmaxf(fabsf(v[i].x), fabsf(v[i].y)), fmaxf(fabsf(v[i].z), fabsf(v[i].w))));
    }
#pragma unroll
    for (int o = 32; o >= 1; o >>= 1) amax = fmaxf(amax, __shfl_xor(amax, o));
    const float inv = amax > 0.f ? 6.0f / amax : 0.f;
    if (lane == 0) scl[rr] = amax * (1.f / 6.0f);
    u32x4 o4;
#pragma unroll
    for (int c = 0; c < 4; ++c) {
      const float4 t0 = v[2 * c], t1 = v[2 * c + 1];
      unsigned w = 0;
      w = __builtin_amdgcn_cvt_scalef32_pk_fp4_f32(w, t0.x * inv, t0.y * inv, 1.0f, 0);
      w = __builtin_amdgcn_cvt_scalef32_pk_fp4_f32(w, t0.z * inv, t0.w * inv, 1.0f, 1);
      w = __builtin_amdgcn_cvt_scalef32_pk_fp4_f32(w, t1.x * inv, t1.y * inv, 1.0f, 2);
      w = __builtin_amdgcn_cvt_scalef32_pk_fp4_f32(w, t1.z * inv, t1.w * inv, 1.0f, 3);
      o4[c] = w;
    }
    *(u32x4*)(out8 + (size_t)rr * 1024 + lane * 16) = o4;
  };
  for (int rr = worker; rr < 16384; rr += 2 * nworkers) {
    const int rb = rr + nworkers;
    const bool hasb = rb < 16384;
    const float* s0 = tbl + (size_t)rr * 2048;
    const float* s1 = tbl + (size_t)(hasb ? rb : rr) * 2048;
    float4 va[8], vb[8];
#pragma unroll
    for (int j = 0; j < 2; ++j)
#pragma unroll
      for (int q = 0; q < 4; ++q) va[j * 4 + q] = ldnt4(s0 + j * 1024 + lane * 16 + q * 4);
#pragma unroll
    for (int j = 0; j < 2; ++j)
#pragma unroll
      for (int q = 0; q < 4; ++q) vb[j * 4 + q] = ldnt4(s1 + j * 1024 + lane * 16 + q * 4);
    finish(va, rr);
    if (hasb) finish(vb, rb);
  }
}

DI void phase_prep(const Params& p, char* smem) {
  const int lane = threadIdx.x & 63, wid = threadIdx.x >> 6;
  for (int r2 = blockIdx.x * 8 + wid; r2 < (T_TOK + 1024) / 2; r2 += gridDim.x * 8) {
    const int r = 2 * r2;
    if (r < T_TOK) rms_rows2_to_bf16(p.x + (size_t)r * 2048, p.x + (size_t)(r + 1) * 2048, p.g_mix, p.hbuf + (size_t)r * 2048, p.hbuf + (size_t)(r + 1) * 2048, lane);
    else rms_rows2_to_bf16(p.mem + (size_t)(r - T_TOK) * 2048, p.mem + (size_t)(r + 1 - T_TOK) * 2048, p.g_mem, p.memn + (size_t)(r - T_TOK) * 2048, p.memn + (size_t)(r + 1 - T_TOK) * 2048, lane);
  }
  float* tile = (float*)smem;
  for (int id0 = blockIdx.x; id0 < 1296; id0 += gridDim.x) {
    int id = id0;
    const float* W; bfr* Wt; int K, N; const float* cs = nullptr; const float* rsc = nullptr;
    if (id < 512) { W = p.w_in; Wt = p.wInT; K = 2048; N = 4096; }
    else if ((id -= 512) < 256) { W = p.w_out; Wt = p.wOutT; K = 2048; N = 2048; }
    else if ((id -= 256) < 256) { W = p.w_pq; Wt = p.wPqT; K = 2048; N = 2048; rsc = p.g_ffn; }
    else if ((id -= 256) < 64) { W = p.w_cq; Wt = p.wCqT; K = 2048; N = 512; rsc = p.g_cross; }
    else if ((id -= 64) < 64) { W = p.w_ck; Wt = p.wCkT; K = 2048; N = 512; }
    else if ((id -= 64) < 64) { W = p.w_cv; Wt = p.wCvT; K = 2048; N = 512; }
    else if ((id -= 64) < 64) { W = p.w_co; Wt = p.wCoT; K = 512; N = 2048; }
    else { id -= 64; const int g = id >> 2; id &= 3; W = p.w_pool + g * 65536; Wt = p.wPoolT + g * 65536; K = 256; N = 256; cs = p.pool_scale + g * 256; }
    const int ntn = N >> 8;
    const int kt = id / ntn, nt = id % ntn;
    transpose_strip(W, K, N, kt * 64, nt * 256, Wt, tile, cs, rsc);
  }
  for (int i = blockIdx.x * NTHREADS + threadIdx.x; i < T_TOK; i += gridDim.x * NTHREADS) { p.rowss1[i] = 0.f; p.rowss2[i] = 0.f; }
  for (int i = blockIdx.x * NTHREADS + threadIdx.x; i < T_TOK * 16; i += gridDim.x * NTHREADS) {
    const int j = i & 15;
    const float inv = exp2f(-(float)j * (18.931568569324174f / 16.0f));
    float sn, cs;
    sincosf((float)p.pos[i >> 4] * inv, &sn, &cs);
    *(float2*)(p.ropetab + (size_t)i * 2) = make_float2(cs, sn);
  }
  convert_f32_bf16(p.sk1f, p.sk1, 128 * 128 / 8);
  convert_f32_bf16(p.sk2f, p.sk2, 128 * 128 / 8);
  quant_rows_fp4<true>(p, blockIdx.x * 8 + wid, gridDim.x * 8, lane);
}

DI void phase_inproj(const Params& p, char* smem) {
  auto epi = [&](const Acc8& acc0, int pm, int pn, int wr, int wc, int fr, int fq) {
    const int region = pn >> 2;
    if (region == 0) {
      G8_FOREACH8(acc0, pm, pn, wr, wc, fr, fq, ai, bj, m, row, col) {
        *(u32x4*)(p.pbuf + (size_t)row * 1024 + col) = pack8(acc0[ai][bj][m][0], acc0[ai][bj][m][1], 1.0f);
      }
    } else {
      bfr* dst = (region == 1) ? p.qbuf : (region == 2 ? p.kbuf : p.vbuf);
      const float scale = (region == 1) ? 0.08838834764831845f : 1.0f;
      const bool rope = (region != 3) && (wc == 0);
#pragma unroll
      for (int ai = 0; ai < 2; ++ai)
#pragma unroll
        for (int m = 0; m < 4; ++m) {
          const int row = 256 * pm + 128 * ai + 64 * wr + 16 * m + fr;
          const int b = row >> 12, t = row & 4095;
          float sn[8], cs[8];
          if (rope) {
            const float4* tp = (const float4*)(p.ropetab + ((size_t)row * 16 + 8 * (fq & 1)) * 2);
#pragma unroll
            for (int e2 = 0; e2 < 4; ++e2) {
              const float4 t = tp[e2];
              cs[2 * e2] = t.x; sn[2 * e2] = t.y; cs[2 * e2 + 1] = t.z; sn[2 * e2 + 1] = t.w;
            }
          }
#pragma unroll
          for (int bj = 0; bj < 2; ++bj) {
            const int h = (pn & 3) * 2 + bj;
            f32x4 v0 = acc0[ai][bj][m][0], v1 = acc0[ai][bj][m][1];
            if (rope) {
#pragma unroll
              for (int i = 0; i < 4; ++i) {
                const float o0 = __shfl_xor(v0[i], 32), o1 = __shfl_xor(v1[i], 32);
                v0[i] = (fq < 2) ? v0[i] * cs[i] - o0 * sn[i] : v0[i] * cs[i] + o0 * sn[i];
                v1[i] = (fq < 2) ? v1[i] * cs[4 + i] - o1 * sn[4 + i] : v1[i] * cs[4 + i] + o1 * sn[4 + i];
              }
            }
            bfr* drow = dst + ((size_t)((b * 8 + h) * 4096 + t)) * 128 + 32 * wc + 8 * fq;
            *(u32x4*)(drow) = pack8(v0, v1, scale);
          }
        }
    }
  };
  gemm8((LAS unsigned char*)smem, p.hbuf, 2048, p.wInT, T_TOK, 4096, 2048, gridDim.x, blockIdx.x, epi);
}

DI void phase_mix_attn(const Params& p, char* smem) {
  const int tid = threadIdx.x, lane = tid & 63, w = tid >> 6, fr = lane & 15, fq = lane >> 4;
  {
    char* sK = smem;
    char* sV = smem + 65536;
    u32x4 kr[8], vr[8];
    bf16x8 qn[4];
    int pend_key0 = 0;
    auto decode = [&](int id, int& br, int& dl, int& bh, int& r, int& l0) {
      br = id >> 10;
      const int rem = id & 1023;
      dl = (br == 0) ? 1 : (br == 1 ? 4 : 16);
      const int nblk = 32 / dl;
      bh = rem >> 5;
      const int rn = rem & 31;
      r = rn / nblk;
      l0 = (rn % nblk) * 128;
    };
    auto issueK = [&](int id) {
      int br, dl, bh, r, l0;
      decode(id, br, dl, bh, r, l0);
      const size_t base = (size_t)bh * 4096 * 128 + (size_t)r * 128;
      const bfr* Kb = p.kbuf + base;
      const int kvstride = dl * 128, key0 = l0 - 128;
#pragma unroll
      for (int i = 0; i < 8; ++i) {
        const int e = tid + i * 512, key = e >> 4, c = e & 15, lk = key0 + key;
        const int lkc = lk < 0 ? 0 : lk;
        kr[i] = *(const u32x4*)(Kb + (long)lkc * kvstride + c * 8);
      }
      pend_key0 = key0;
    };
    auto issueVQ = [&](int id) {
      int br, dl, bh, r, l0;
      decode(id, br, dl, bh, r, l0);
      const size_t base = (size_t)bh * 4096 * 128 + (size_t)r * 128;
      const bfr* Vb = p.vbuf + base;
      const int kvstride = dl * 128, key0 = l0 - 128;
#pragma unroll
      for (int i = 0; i < 8; ++i) {
        const int e = tid + i * 512, key = e >> 4, c = e & 15, lk = key0 + key;
        const int lkc = lk < 0 ? 0 : lk;
        vr[i] = *(const u32x4*)(Vb + (long)lkc * kvstride + c * 8);
      }
      const bfr* qrow = p.qbuf + base + (long)(l0 + w * 16 + fr) * kvstride;
#pragma unroll
      for (int kk = 0; kk < 4; ++kk) qn[kk] = *(const bf16x8*)(qrow + kk * 32 + fq * 8);
    };
    const bool remap = (gridDim.x == 256);
    const int nround = remap ? 12 : (3072 + (int)gridDim.x - 1) / (int)gridDim.x;
    auto item_of = [&](int k) -> int {
      if (!remap) return k * (int)gridDim.x + (int)blockIdx.x;
      const int xcd = blockIdx.x & 7, slot = blockIdx.x >> 3;
      const int bh = (k / 3) * 8 + xcd, br = k % 3;
      return (br * 32 + bh) * 32 + slot;
    };
    if (item_of(0) < 3072) { issueK(item_of(0)); issueVQ(item_of(0)); }
    for (int k = 0; k < nround; ++k) {
      const int id = item_of(k);
      if (id >= 3072) break;
      __syncthreads();
#pragma unroll
      for (int i = 0; i < 8; ++i) {
        const int e = tid + i * 512, key = e >> 4, c = e & 15;
        const unsigned msk = (pend_key0 + key) < 0 ? 0u : 0xffffffffu;
        const u32x4 m4 = u32x4{msk, msk, msk, msk};
        *(u32x4*)(sK + key * 256 + ((c ^ (key & 15)) << 4)) = kr[i] & m4;
        *(u32x4*)(sV + key * 288 + c * 16) = vr[i] & m4;
      }
      bf16x8 qf[4];
#pragma unroll
      for (int kk = 0; kk < 4; ++kk) qf[kk] = qn[kk];
      __syncthreads();
      const int nid = (k + 1 < nround) ? item_of(k + 1) : 3072;
      if (nid < 3072) issueK(nid);
      int br, dl, bh, r, l0;
      decode(id, br, dl, bh, r, l0);
      float mx, l;
      const int b = bh >> 3, h = bh & 7;
      const int tt = b * 4096 + (l0 + w * 16 + fr) * dl + r;
      bfr* obase = p.ob + (size_t)br * T_TOK * 1024 + h * 128;
      const int tq0 = b * 4096 + r, lw = l0 + w * 16;
      attn_compute<true>(qf, l0, l0 - 128, smem,
                         [&](int q) { return obase + (size_t)(tq0 + (lw + q) * dl) * 1024; }, mx, l,
                         [&]() { if (nid < 3072) issueVQ(nid); });
      if (fq == 0) p.lse[(size_t)br * T_TOK * 8 + (size_t)tt * 8 + h] = mx + __builtin_amdgcn_logf(l);
    }
  }
  for (int id = 3072 + blockIdx.x; id < 3072 + 256; id += gridDim.x) {
    {
      const int ci = id - 3072;
      const int sub = tid >> 7, cgp = tid & 127;
      const int wdw = 2 << (cgp >> 5);
      const int t0 = ci * 64 + sub * 16, tin0 = t0 & 4095;
      const bfr* pb = p.pbuf + cgp * 8;
      float sum[8];
#pragma unroll
      for (int e = 0; e < 8; ++e) sum[e] = 0.f;
      for (int j = 1; j < wdw; ++j) {
        if (tin0 - j >= 0) {
          const u32x4 v = *(const u32x4*)(pb + (size_t)(t0 - j) * 1024);
#pragma unroll
          for (int e = 0; e < 4; ++e) { sum[2 * e] += bflo(v[e]); sum[2 * e + 1] += bfhi(v[e]); }
        }
      }
      for (int s = 0; s < 16; ++s) {
        const int t = t0 + s, tin = tin0 + s;
        const u32x4 v = *(const u32x4*)(pb + (size_t)t * 1024);
        float cur[8];
#pragma unroll
        for (int e = 0; e < 4; ++e) { cur[2 * e] = bflo(v[e]); cur[2 * e + 1] = bfhi(v[e]); }
        const float ic = 1.f / (float)min(tin + 1, wdw);
        u32x4 ov;
#pragma unroll
        for (int e = 0; e < 8; ++e) sum[e] += cur[e];
#pragma unroll
        for (int e = 0; e < 4; ++e) ov[e] = pack2(sum[2 * e] * ic - cur[2 * e], sum[2 * e + 1] * ic - cur[2 * e + 1]);
        *(u32x4*)(p.mixed + (size_t)t * 1024 + cgp * 8) = ov;
        if (tin - wdw + 1 >= 0) {
          const u32x4 u = *(const u32x4*)(pb + (size_t)(t - wdw + 1) * 1024);
#pragma unroll
          for (int e = 0; e < 4; ++e) { sum[2 * e] -= bflo(u[e]); sum[2 * e + 1] -= bfhi(u[e]); }
        }
      }
    }
  }
}

DI void phase_pool_combine(const Params& p, char* smem) {
  const int tid = threadIdx.x;
  {
    auto epi = [&](const Acc8& acc0, int pm, int pn, int wr, int wc, int fr, int fq) {
      G8_FOREACH8(acc0, pm, pn, wr, wc, fr, fq, ai, bj, m, row, col) {
        *(u32x4*)(p.hbuf + (size_t)row * 2048 + col) = pack8(acc0[ai][bj][m][0], acc0[ai][bj][m][1], 1.0f);
      }
    };
    gemm8((LAS unsigned char*)smem, p.mixed, 1024, p.wPoolT, T_TOK, 1024, 256, gridDim.x, blockIdx.x, epi, 512);
  }
  for (long i = (long)blockIdx.x * NTHREADS + tid; i < (long)T_TOK * 8 * 16; i += (long)gridDim.x * NTHREADS) {
    const int dc = (int)(i & 15), h = (int)((i >> 4) & 7);
    const long tt = i >> 7;
    const float l0 = p.lse[tt * 8 + h], l1 = p.lse[(size_t)T_TOK * 8 + tt * 8 + h], l2 = p.lse[(size_t)2 * T_TOK * 8 + tt * 8 + h];
    const float mx = fmaxf(l0, fmaxf(l1, l2));
    float w0 = __builtin_amdgcn_exp2f(l0 - mx), w1 = __builtin_amdgcn_exp2f(l1 - mx), w2 = __builtin_amdgcn_exp2f(l2 - mx);
    const float inv = 1.f / (w0 + w1 + w2);
    w0 *= inv; w1 *= inv; w2 *= inv;
    const size_t off = (size_t)tt * 1024 + h * 128 + dc * 8;
    const u32x4 a = *(const u32x4*)(p.ob + off);
    const u32x4 b = *(const u32x4*)(p.ob + (size_t)T_TOK * 1024 + off);
    const u32x4 c = *(const u32x4*)(p.ob + (size_t)2 * T_TOK * 1024 + off);
    u32x4 o;
#pragma unroll
    for (int e = 0; e < 4; ++e)
      o[e] = pack2(w0 * bflo(a[e]) + w1 * bflo(b[e]) + w2 * bflo(c[e]), w0 * bfhi(a[e]) + w1 * bfhi(b[e]) + w2 * bfhi(c[e]));
    *(u32x4*)(p.hbuf + (size_t)tt * 2048 + 1024 + h * 128 + dc * 8) = o;
  }
}

template <bool RESID_BF16>
DI void phase_gemm_resid(const bfr* A, int lda, const bfr* Bt, int K, const void* resid, bfr* xb, float* rowss, char* smem) {
  auto epi = [&](const Acc8& acc0, int pm, int pn, int wr, int wc, int fr, int fq) {
#pragma unroll
    for (int ai = 0; ai < 2; ++ai)
#pragma unroll
      for (int m = 0; m < 4; ++m) {
        const int row = 256 * pm + 128 * ai + 64 * wr + 16 * m + fr;
        float ss = 0.f;
#pragma unroll
        for (int bj = 0; bj < 2; ++bj) {
          const int col = 256 * pn + 128 * bj + 32 * wc + 8 * fq;
          const f32x4 v0 = acc0[ai][bj][m][0], v1 = acc0[ai][bj][m][1];
          float r[8];
          if (RESID_BF16) {
            const u32x4 t = *(const u32x4*)((const bfr*)resid + (size_t)row * 2048 + col);
#pragma unroll
            for (int e = 0; e < 4; ++e) { r[2 * e] = bflo(t[e]); r[2 * e + 1] = bfhi(t[e]); }
          } else {
            const float4 t0 = *(const float4*)((const float*)resid + (size_t)row * 2048 + col);
            const float4 t1 = *(const float4*)((const float*)resid + (size_t)row * 2048 + col + 4);
            r[0] = t0.x; r[1] = t0.y; r[2] = t0.z; r[3] = t0.w; r[4] = t1.x; r[5] = t1.y; r[6] = t1.z; r[7] = t1.w;
          }
          f32x4 o0, o1;
#pragma unroll
          for (int e = 0; e < 4; ++e) { o0[e] = r[e] + v0[e]; o1[e] = r[4 + e] + v1[e]; ss += o0[e] * o0[e] + o1[e] * o1[e]; }
          *(u32x4*)(xb + (size_t)row * 2048 + col) = pack8(o0, o1, 1.0f);
        }
        ss += __shfl_xor(ss, 16);
        ss += __shfl_xor(ss, 32);
        if (fq == 0) atomicAdd(rowss + row, ss);
      }
  };
  gemm8((LAS unsigned char*)smem, A, lda, Bt, T_TOK, 2048, K, gridDim.x, blockIdx.x, epi);
}

DI void phase_gemm_pq(const Params& p, char* smem) {
  auto epi = [&](const Acc8& acc0, int pm, int pn, int wr, int wc, int fr, int fq) {
    G8_FOREACH8(acc0, pm, pn, wr, wc, fr, fq, ai, bj, m, row, col) {
      const float rs = rsqrtf(p.rowss2[row] * (1.f / 2048.f) + 1e-6f);
      *(u32x4*)(p.pq + (size_t)row * 2048 + col) = pack8(acc0[ai][bj][m][0], acc0[ai][bj][m][1], rs);
    }
  };
  gemm8((LAS unsigned char*)smem, p.hbuf, 2048, p.wPqT, T_TOK, 2048, 2048, gridDim.x, blockIdx.x, epi);
}
DI void phase_cross_proj(const Params& p, char* smem) {
  const int half = gridDim.x >> 1;
  if ((int)blockIdx.x < half) {
    auto epi = [&](const Acc8& acc0, int pm, int pn, int wr, int wc, int fr, int fq) {
      G8_FOREACH8(acc0, pm, pn, wr, wc, fr, fq, ai, bj, m, row, col) {
        const float scale = 0.08838834764831845f * rsqrtf(p.rowss1[row] * (1.f / 2048.f) + 1e-6f);
        *(u32x4*)(p.qc + (size_t)row * 512 + col) = pack8(acc0[ai][bj][m][0], acc0[ai][bj][m][1], scale);
      }
    };
    gemm8((LAS unsigned char*)smem, p.x2b, 2048, p.wCqT, T_TOK, 512, 2048, half, blockIdx.x, epi);
  } else if ((int)blockIdx.x < half + 16) {
    auto epi = [&](const Acc8& acc0, int pm, int pn, int wr, int wc, int fr, int fq) {
      G8_FOREACH8(acc0, pm, pn, wr, wc, fr, fq, ai, bj, m, row, col) {
        bfr* dst = (col < 512) ? p.kc : p.vc;
        const int cc = col & 511, hh = cc >> 7, d = cc & 127, bb = row >> 8, mm = row & 255;
        *(u32x4*)(dst + ((size_t)((bb * 4 + hh) * 256 + mm)) * 128 + d) = pack8(acc0[ai][bj][m][0], acc0[ai][bj][m][1], 1.0f);
      }
    };
    gemm8((LAS unsigned char*)smem, p.memn, 2048, p.wCkT, 1024, 1024, 2048, 16, blockIdx.x - half, epi);
  } else {
    const int nidle = gridDim.x - (half + 16);
    quant_rows_fp4<false>(p, (blockIdx.x - (half + 16)) * 8 + (threadIdx.x >> 6), nidle * 8, threadIdx.x & 63);
  }
}

DI void phase_cross_attn(const Params& p, char* smem) {
  const int tid = threadIdx.x, lane = tid & 63, w = tid >> 6, fr = lane & 15, fq = lane >> 4;
  for (int id = blockIdx.x; id < 512; id += gridDim.x) {
    const int b = id >> 7, h = (id >> 5) & 3, qt = id & 31;
    float mx, l;
    const size_t kvb = (size_t)(b * 4 + h) * 256 * 128;
    bfr* obase = p.oc + (size_t)(b * 4096 + qt * 128 + w * 16) * 512 + h * 128;
    attn_core<false>(p.qc + (size_t)b * 4096 * 512 + h * 128, 512, qt * 128, p.kc + kvb, p.vc + kvb, 128, 0, smem,
                     [&](int q) { return obase + (size_t)q * 512; }, mx, l);
  }
}

DI void bitonic_sort16_desc(int (&mg)[16]);
DI void top16_of_32(int (&a)[16], int (&b)[16]);
template <unsigned AMASK>
DI void route_cands(int (&top)[16], const float (&v1)[16], const float (&v2)[16]) {
  int ca[16], cb[16];
#pragma unroll
  for (int j = 0; j < 16; ++j) { ca[j] = (int)0x80000000; cb[j] = (int)0x80000000; }
  int c = 0;
#pragma unroll
  for (int a = 0; a < 16; ++a)
#pragma unroll
    for (int b = 0; b < 16; ++b)
      if (((AMASK >> a) & 1u) && (a + 1) * (b + 1) <= 16) {
        const int key = (f2sort(v1[a] + v2[b]) & ~0xFF) | (a * 16 + b);
        if (c < 16) ca[c] = key; else cb[c - 16] = key;
        ++c;
      }
  top16_of_32(ca, cb);
#pragma unroll
  for (int j = 0; j < 16; ++j) top[j] = ca[j];
}
DI void bitonic_sort16_desc(int (&mg)[16]) {
#pragma unroll
  for (int st = 8; st >= 1; st >>= 1)
#pragma unroll
    for (int i = 0; i < 16; ++i)
      if ((i & st) == 0) { const int hi = max(mg[i], mg[i + st]), lo = min(mg[i], mg[i + st]); mg[i] = hi; mg[i + st] = lo; }
}

DI void sort16_desc(int (&x)[16]) {
#pragma unroll
  for (int k = 2; k <= 16; k <<= 1)
#pragma unroll
    for (int j = k >> 1; j > 0; j >>= 1)
#pragma unroll
      for (int i = 0; i < 16; ++i) {
        const int l = i ^ j;
        if (l > i) {
          const int hi = max(x[i], x[l]), lo = min(x[i], x[l]);
          const bool desc = ((i & k) == 0);
          x[i] = desc ? hi : lo;
          x[l] = desc ? lo : hi;
        }
      }
}
DI void top16_of_32(int (&a)[16], int (&b)[16]) {
  sort16_desc(a);
  sort16_desc(b);
#pragma unroll
  for (int i = 0; i < 16; ++i) a[i] = max(a[i], b[15 - i]);
  bitonic_sort16_desc(a);
}
DI void phase_peer_route(const Params& p, char* smem) {
  const int tid = threadIdx.x, lane = tid & 63, w = tid >> 6, fr = lane & 15, fq = lane >> 4;
  char* sSK = smem;
  float* scores = (float*)(smem + 65536);
  int* lists = (int*)(smem + 65536 + 67584);
  int* tops = (int*)(smem + 65536);
  constexpr unsigned AM0 = (1u << 0) | (1u << 3) | (1u << 5) | (1u << 8) | (1u << 9) | (1u << 10) | (1u << 11);
  __syncthreads();
#pragma unroll
  for (int i = 0; i < 8; ++i) {
    const int id = tid + i * 512, key = id >> 4, c = id & 15;
    const bfr* src = (key < 128 ? p.sk1 : p.sk2) + (key & 127) * 128 + c * 8;
    *(u32x4*)(sSK + key * 256 + ((c ^ (key & 15)) << 4)) = *(const u32x4*)src;
  }
  for (int id = blockIdx.x; id < 2048; id += gridDim.x) {
    const int tt = id >> 3, h = id & 7;
    const int tok0 = tt * 64;
    __syncthreads();
    {
      const int tg = w & 3, hf = w >> 2;
      const bfr* arow = p.pq + (size_t)(tok0 + tg * 16 + fr) * 2048 + h * 256 + hf * 128;
      bf16x8 af[4];
#pragma unroll
      for (int kk = 0; kk < 4; ++kk) af[kk] = *(const bf16x8*)(arow + kk * 32 + fq * 8);
#pragma unroll
      for (int nt = 0; nt < 8; ++nt) {
        f32x4 a = f32x4{0.f, 0.f, 0.f, 0.f};
        const int key = hf * 128 + nt * 16 + fr;
#pragma unroll
        for (int kk = 0; kk < 4; ++kk) {
          const bf16x8 bfg = *(const bf16x8*)(sSK + key * 256 + (((kk * 4 + fq) ^ fr) << 4));
          a = mfma16(af[kk], bfg, a);
        }
#pragma unroll
        for (int i = 0; i < 4; ++i) scores[(hf * 64 + tg * 16 + fq * 4 + i) * 132 + nt * 16 + fr] = a[i];
      }
    }
    __syncthreads();
    {
      const int row = tid >> 2, part = tid & 3;
      int lst[16], lsb[16];
      const float* srow = scores + row * 132 + part * 32;
#pragma unroll
      for (int k4 = 0; k4 < 4; ++k4) {
        const float4 v = *(const float4*)(srow + k4 * 4);
        const float4 u = *(const float4*)(srow + 16 + k4 * 4);
        const int kb = part * 32 + k4 * 4;
        lst[k4 * 4 + 0] = (f2sort(v.x) & ~0x7F) | (kb + 0);
        lst[k4 * 4 + 1] = (f2sort(v.y) & ~0x7F) | (kb + 1);
        lst[k4 * 4 + 2] = (f2sort(v.z) & ~0x7F) | (kb + 2);
        lst[k4 * 4 + 3] = (f2sort(v.w) & ~0x7F) | (kb + 3);
        lsb[k4 * 4 + 0] = (f2sort(u.x) & ~0x7F) | (kb + 16);
        lsb[k4 * 4 + 1] = (f2sort(u.y) & ~0x7F) | (kb + 17);
        lsb[k4 * 4 + 2] = (f2sort(u.z) & ~0x7F) | (kb + 18);
        lsb[k4 * 4 + 3] = (f2sort(u.w) & ~0x7F) | (kb + 19);
      }
      top16_of_32(lst, lsb);
      int mg[16];
#pragma unroll
      for (int i = 0; i < 16; ++i) mg[i] = max(lst[i], __shfl_xor(lst[15 - i], 1));
      bitonic_sort16_desc(mg);
#pragma unroll
      for (int i = 0; i < 16; ++i) lst[i] = max(mg[i], __shfl_xor(mg[15 - i], 2));
      bitonic_sort16_desc(lst);
      if (part == 0) {
#pragma unroll
        for (int j4 = 0; j4 < 4; ++j4) {
          int4 t; t.x = lst[j4 * 4]; t.y = lst[j4 * 4 + 1]; t.z = lst[j4 * 4 + 2]; t.w = lst[j4 * 4 + 3];
          *(int4*)(lists + row * 16 + j4 * 4) = t;
        }
      }
    }
    __syncthreads();
    int top[16];
#pragma unroll
    for (int j = 0; j < 16; ++j) top[j] = (int)0x80000000;
    const int tokl = tid & 63;
    if (tid < 128) {
      float v1[16], v2[16];
#pragma unroll
      for (int j4 = 0; j4 < 4; ++j4) {
        const int4 t1 = *(const int4*)(lists + tokl * 16 + j4 * 4);
        const int4 t2 = *(const int4*)(lists + (64 + tokl) * 16 + j4 * 4);
        v1[j4 * 4] = sort2f(t1.x & ~0x7F); v1[j4 * 4 + 1] = sort2f(t1.y & ~0x7F); v1[j4 * 4 + 2] = sort2f(t1.z & ~0x7F); v1[j4 * 4 + 3] = sort2f(t1.w & ~0x7F);
        v2[j4 * 4] = sort2f(t2.x & ~0x7F); v2[j4 * 4 + 1] = sort2f(t2.y & ~0x7F); v2[j4 * 4 + 2] = sort2f(t2.z & ~0x7F); v2[j4 * 4 + 3] = sort2f(t2.w & ~0x7F);
      }
      if (tid < 64) {
        route_cands<AM0>(top, v1, v2);
      } else {
        route_cands<(~AM0) & 0xFFFFu>(top, v1, v2);
#pragma unroll
        for (int j4 = 0; j4 < 4; ++j4) {
          int4 t; t.x = top[j4 * 4]; t.y = top[j4 * 4 + 1]; t.z = top[j4 * 4 + 2]; t.w = top[j4 * 4 + 3];
          *(int4*)(tops + tokl * 16 + j4 * 4) = t;
        }
      }
    }
    __syncthreads();
    if (tid < 64) {
      int fin[16];
#pragma unroll
      for (int j4 = 0; j4 < 4; ++j4) {
        const int4 t = *(const int4*)(tops + tid * 16 + (3 - j4) * 4);
        fin[j4 * 4 + 0] = max(top[j4 * 4 + 0], t.w);
        fin[j4 * 4 + 1] = max(top[j4 * 4 + 1], t.z);
        fin[j4 * 4 + 2] = max(top[j4 * 4 + 2], t.y);
        fin[j4 * 4 + 3] = max(top[j4 * 4 + 3], t.x);
      }
      int ex[16];
      float val[16];
      float mxv = -3.0e38f;
#pragma unroll
      for (int j = 0; j < 16; ++j) {
        const int code = fin[j] & 0xFF;
        const int i1 = lists[tid * 16 + (code >> 4)] & 0x7F;
        const int i2 = lists[(64 + tid) * 16 + (code & 15)] & 0x7F;
        ex[j] = i1 * 128 + i2;
        val[j] = sort2f(fin[j] & ~0xFF);
        mxv = fmaxf(mxv, val[j]);
      }
      float sum = 0.f;
      float ev[16];
#pragma unroll
      for (int j = 0; j < 16; ++j) { ev[j] = __expf(val[j] - mxv); sum += ev[j]; }
      const float inv = 1.f / sum;
      const size_t ob = (size_t)(tok0 + tid) * 128 + h * 16;
#pragma unroll
      for (int j4 = 0; j4 < 4; ++j4) {
        int4 iv; iv.x = ex[j4 * 4]; iv.y = ex[j4 * 4 + 1]; iv.z = ex[j4 * 4 + 2]; iv.w = ex[j4 * 4 + 3];
        float4 gv; gv.x = ev[j4 * 4] * inv; gv.y = ev[j4 * 4 + 1] * inv; gv.z = ev[j4 * 4 + 2] * inv; gv.w = ev[j4 * 4 + 3] * inv;
        *(int4*)(p.idx + ob + j4 * 4) = iv;
        *(float4*)(p.gates + ob + j4 * 4) = gv;
      }
    }
  }
}

DI float gelu_tanh(float a) {
  const float u = 0.7978845608028654f * (a + 0.044715f * a * a * a);
  return 0.5f * a * (1.f + tanhf(u));
}

#define SB() __builtin_amdgcn_sched_barrier(0)
DI void peer_load8u(u32x4 (&bufa)[8], const unsigned char* tbl, int idxv, int g, int lane) {
#pragma unroll
  for (int k = 0; k < 8; ++k) {
    const int e = __builtin_amdgcn_readlane(idxv, g * 8 + k);
    bufa[k] = *(const u32x4*)(tbl + (size_t)e * 1024 + lane * 16);
  }
}
DI float peer_dot8(const u32x4 (&bufa)[8], const f32x2 (&hp)[16], int lane) {
  float part[8];
#pragma unroll
  for (int k = 0; k < 8; ++k) {
    const u32x4 u = bufa[k];
    f32x2 a2 = f32x2{0.f, 0.f};
#pragma unroll
    for (int c = 0; c < 4; ++c) {
      const unsigned uu = u[c];
      a2 += __builtin_amdgcn_cvt_scalef32_pk_f32_fp4(uu, 1.0f, 0) * hp[c * 4 + 0];
      a2 += __builtin_amdgcn_cvt_scalef32_pk_f32_fp4(uu, 1.0f, 1) * hp[c * 4 + 1];
      a2 += __builtin_amdgcn_cvt_scalef32_pk_f32_fp4(uu, 1.0f, 2) * hp[c * 4 + 2];
      a2 += __builtin_amdgcn_cvt_scalef32_pk_f32_fp4(uu, 1.0f, 3) * hp[c * 4 + 3];
    }
    part[k] = a2[0] + a2[1];
  }
  const bool up4 = (lane & 4) != 0, up2 = (lane & 2) != 0, up1 = (lane & 1) != 0;
  float q[4];
#pragma unroll
  for (int i = 0; i < 4; ++i) {
    const float keep = up4 ? part[i + 4] : part[i];
    const float send = up4 ? part[i] : part[i + 4];
    q[i] = keep + __shfl_xor(send, 4);
  }
  float r[2];
#pragma unroll
  for (int i = 0; i < 2; ++i) {
    const float keep = up2 ? q[i + 2] : q[i];
    const float send = up2 ? q[i] : q[i + 2];
    r[i] = keep + __shfl_xor(send, 2);
  }
  float v = (up1 ? r[1] : r[0]) + __shfl_xor(up1 ? r[0] : r[1], 1);
  v += __shfl_xor(v, 8);
  v += __shfl_xor(v, 16);
  v += __shfl_xor(v, 32);
  return v;
}
DI void peer_acc8(const u32x4 (&bufa)[8], f32x2 (&ys)[16], float cval, int g) {
#pragma unroll
  for (int k = 0; k < 8; ++k) {
    const float ck = __builtin_bit_cast(float, __builtin_amdgcn_readlane(__builtin_bit_cast(int, cval), g * 8 + k));
    const u32x4 u = bufa[k];
#pragma unroll
    for (int c = 0; c < 4; ++c) {
      const unsigned uu = u[c];
      ys[c * 4 + 0] += __builtin_amdgcn_cvt_scalef32_pk_f32_fp4(uu, 1.0f, 0) * ck;
      ys[c * 4 + 1] += __builtin_amdgcn_cvt_scalef32_pk_f32_fp4(uu, 1.0f, 1) * ck;
      ys[c * 4 + 2] += __builtin_amdgcn_cvt_scalef32_pk_f32_fp4(uu, 1.0f, 2) * ck;
      ys[c * 4 + 3] += __builtin_amdgcn_cvt_scalef32_pk_f32_fp4(uu, 1.0f, 3) * ck;
    }
  }
}

DI void phase_peer_expert(const Params& p) {
  const int lane = threadIdx.x & 63, wid = threadIdx.x >> 6;
  bool flag4;
  {
    float c1 = 1.0f, c2 = 2.0f;
    asm volatile("" : "+v"(c1), "+v"(c2));
    const unsigned w4 = __builtin_amdgcn_cvt_scalef32_pk_fp4_f32(0u, c1, c2, 1.0f, 0);
    const f32x2 r4 = __builtin_amdgcn_cvt_scalef32_pk_f32_fp4(w4, 1.0f, 0);
    flag4 = (r4[0] == 2.0f);
  }
  const int tstride = gridDim.x * 8;
  int myidx[2] = {0, 0};
  float mygate[2] = {0.f, 0.f};
  u32x4 bufAa[8], bufBa[8];
  {
    const int tok0 = blockIdx.x * 8 + wid;
    if (tok0 < T_TOK) {
#pragma unroll
      for (int half = 0; half < 2; ++half) {
        myidx[half] = p.idx[(size_t)tok0 * 128 + half * 64 + lane];
        mygate[half] = p.gates[(size_t)tok0 * 128 + half * 64 + lane];
      }
      peer_load8u(bufAa, p.wU8, myidx[0], 0, lane);
    }
  }
  for (int tok = blockIdx.x * 8 + wid; tok < T_TOK; tok += tstride) {
    const int ntok = (tok + tstride < T_TOK) ? tok + tstride : tok;
    int nxidx[2];
    float nxgate[2];
#pragma unroll
    for (int half = 0; half < 2; ++half) {
      nxidx[half] = p.idx[(size_t)ntok * 128 + half * 64 + lane];
      nxgate[half] = p.gates[(size_t)ntok * 128 + half * 64 + lane];
    }
    const float rs2 = rsqrtf(p.rowss2[tok] * (1.f / 2048.f) + 1e-6f);
    f32x2 hs[16];
    {
      float he[32];
#pragma unroll
      for (int j = 0; j < 2; ++j)
#pragma unroll
        for (int q = 0; q < 2; ++q) {
          const u32x4 t = *(const u32x4*)(p.hbuf + (size_t)tok * 2048 + j * 1024 + lane * 16 + q * 8);
#pragma unroll
          for (int c = 0; c < 4; ++c) { const unsigned tt = t[c]; he[j * 16 + q * 8 + c * 2] = bflo(tt); he[j * 16 + q * 8 + c * 2 + 1] = bfhi(tt); }
        }
#pragma unroll
      for (int i = 0; i < 16; ++i) {
        const float n0 = he[2 * i], n1 = he[2 * i + 1];
        hs[i] = f32x2{flag4 ? n1 : n0, flag4 ? n0 : n1};
      }
    }
    f32x2 ys[16];
#pragma unroll
    for (int e = 0; e < 16; ++e) ys[e] = f32x2{0.f, 0.f};
#pragma unroll 1
    for (int half = 0; half < 2; ++half) {
      const int idxv = half ? myidx[1] : myidx[0];
      const float gate = half ? mygate[1] : mygate[0];
      const float mysu = p.su[idxv], mysv = p.sv[idxv];
      float amine = 0.f;
#pragma unroll 1
      for (int g2 = 0; g2 < 3; ++g2) {
        peer_load8u(bufBa, p.wU8, idxv, 2 * g2 + 1, lane);
        SB();
        { const float v = peer_dot8(bufAa, hs, lane); if ((lane >> 3) == 2 * g2) amine = v; }
        SB();
        peer_load8u(bufAa, p.wU8, idxv, 2 * g2 + 2, lane);
        SB();
        { const float v = peer_dot8(bufBa, hs, lane); if ((lane >> 3) == 2 * g2 + 1) amine = v; }
        SB();
      }
      {
        peer_load8u(bufBa, p.wU8, idxv, 7, lane);
        SB();
        { const float v = peer_dot8(bufAa, hs, lane); if ((lane >> 3) == 6) amine = v; }
        SB();
        peer_load8u(bufAa, p.wV8, idxv, 0, lane);
        SB();
        { const float v = peer_dot8(bufBa, hs, lane); if ((lane >> 3) == 7) amine = v; }
        SB();
      }
      const float cval = gate * gelu_tanh(amine * mysu * rs2) * mysv;
      const int nidx = half ? nxidx[0] : myidx[1];
#pragma unroll 1
      for (int g2 = 0; g2 < 3; ++g2) {
        peer_load8u(bufBa, p.wV8, idxv, 2 * g2 + 1, lane);
        SB();
        peer_acc8(bufAa, ys, cval, 2 * g2);
        SB();
        peer_load8u(bufAa, p.wV8, idxv, 2 * g2 + 2, lane);
        SB();
        peer_acc8(bufBa, ys, cval, 2 * g2 + 1);
        SB();
      }
      {
        peer_load8u(bufBa, p.wV8, idxv, 7, lane);
        SB();
        peer_acc8(bufAa, ys, cval, 6);
        SB();
        peer_load8u(bufAa, p.wU8, nidx, 0, lane);
        SB();
        peer_acc8(bufBa, ys, cval, 7);
        SB();
      }
    }
    float ss = 0.f;
#pragma unroll
    for (int i = 0; i < 16; ++i) { ys[i] += hs[i]; ss += ys[i][0] * ys[i][0] + ys[i][1] * ys[i][1]; }
    float ye[32];
#pragma unroll
    for (int i = 0; i < 16; ++i) {
      ye[2 * i] = flag4 ? ys[i][1] : ys[i][0];
      ye[2 * i + 1] = flag4 ? ys[i][0] : ys[i][1];
    }
    ss = wave_sum(ss);
    const float rs = rsqrtf(ss * (1.f / 2048.f) + 1e-6f);
#pragma unroll
    for (int j = 0; j < 2; ++j)
#pragma unroll
      for (int q = 0; q < 4; ++q) {
        const float4 gq = *(const float4*)(p.g_final + j * 1024 + lane * 16 + q * 4);
        const int b0 = j * 16 + q * 4;
        float4 o;
        o.x = ye[b0] * rs * gq.x; o.y = ye[b0 + 1] * rs * gq.y; o.z = ye[b0 + 2] * rs * gq.z; o.w = ye[b0 + 3] * rs * gq.w;
        *(float4*)(p.out + (size_t)tok * 2048 + j * 1024 + lane * 16 + q * 4) = o;
      }
    myidx[0] = nxidx[0]; myidx[1] = nxidx[1]; mygate[0] = nxgate[0]; mygate[1] = nxgate[1];
  }
}

#define XB_TMO      128
#define XB_XCNT(j)  (256  + 64 * (j))
#define XB_XSUB(j)  (1280 + 64 * (j))
#define XB_XGEN(j)  (2304 + 64 * (j))
#define XB_TOP      3328
#define XB_TOPGEN   3392
#define XCD_BAR_WORDS 3456
#define XB_SPIN_CAP (1u << 20)
DI unsigned xb_ld(unsigned* p)              { return __hip_atomic_load(p, __ATOMIC_RELAXED, __HIP_MEMORY_SCOPE_AGENT); }
DI unsigned xb_add(unsigned* p, unsigned v) { return __hip_atomic_fetch_add(p, v, __ATOMIC_RELAXED, __HIP_MEMORY_SCOPE_AGENT); }
DI unsigned xb_xcc_id() { return (unsigned)__builtin_amdgcn_s_getreg((3 << 11) | 20) & 0xFu; }
#define XB_SPIN(cond, bar) do { unsigned _sp = 0; while (cond) { __builtin_amdgcn_s_sleep(1); \
    if ((++_sp & 255u) == 0u) { if (xb_ld(&(bar)[XB_TMO])) break; if (_sp > XB_SPIN_CAP) { atomicAdd(&(bar)[XB_TMO], 1u); break; } } } } while (0)
struct XcdBarrier { unsigned* bar; unsigned x; volatile LAS unsigned* st; };
DI XcdBarrier xcd_barrier_post(unsigned* bar, volatile LAS unsigned* st) {
  XcdBarrier b; b.bar = bar; b.x = xb_xcc_id(); b.st = st;
  if (threadIdx.x == 0) (void)xb_add(&bar[XB_XCNT(b.x)], 1u);
  return b;
}
DI void xcd_barrier_complete(unsigned* bar, unsigned x, unsigned& nloc, unsigned& nx) {
  const unsigned G = gridDim.x * gridDim.y * gridDim.z;
  unsigned sum, cnt, mine, sp = 0u;
  for (;;) {
    sum = 0u; cnt = 0u; mine = 0u;
#pragma unroll
    for (unsigned j = 0; j < 16; ++j) { const unsigned c = xb_ld(&bar[XB_XCNT(j)]); sum += c; cnt += (c > 0u) ? 1u : 0u; mine = (j == x) ? c : mine; }
    if (sum == G) break;
    __builtin_amdgcn_s_sleep(1);
    if ((++sp & 255u) == 0u) { if (xb_ld(&bar[XB_TMO])) break; if (sp > XB_SPIN_CAP) { atomicAdd(&bar[XB_TMO], 1u); break; } }
  }
  nloc = mine > 0u ? mine : 1u; nx = cnt > 0u ? cnt : 1u;
}
DI void xcd_barrier(const XcdBarrier& b) {
  asm volatile("s_waitcnt vmcnt(0)" ::: "memory");
  __syncthreads();
  if (threadIdx.x == 0) {
    unsigned* bar = b.bar;
    __builtin_amdgcn_s_waitcnt(0);
    unsigned nloc = b.st[0], nx = b.st[1];
    if (nloc == 0u) { xcd_barrier_complete(bar, b.x, nloc, nx); b.st[0] = nloc; b.st[1] = nx; }
    const unsigned old = xb_add(&bar[XB_XSUB(b.x)], 1u);
    const unsigned gen = old / nloc;
    if (old + 1u == (gen + 1u) * nloc) {
      __builtin_amdgcn_fence(__ATOMIC_RELEASE, "agent");
      asm volatile("s_waitcnt vmcnt(0)" ::: "memory");
      const unsigned og = xb_add(&bar[XB_TOP], 1u);
      const unsigned tg = og / nx;
      if (og + 1u == (tg + 1u) * nx) xb_add(&bar[XB_TOPGEN], 1u);
      else XB_SPIN(xb_ld(&bar[XB_TOPGEN]) == tg, bar);
      __builtin_amdgcn_fence(__ATOMIC_ACQUIRE, "agent");
      xb_add(&bar[XB_XGEN(b.x)], 1u);
      asm volatile("s_waitcnt vmcnt(0)" ::: "memory");
    } else {
      XB_SPIN(xb_ld(&bar[XB_XGEN(b.x)]) == gen, bar);
      __builtin_amdgcn_fence(__ATOMIC_ACQUIRE, "agent");
      asm volatile("s_waitcnt vmcnt(0)" ::: "memory");
    }
  }
  __syncthreads();
}

__global__ void __launch_bounds__(NTHREADS) mega(Params p, int phase_lo, int phase_hi) {
  __shared__ __attribute__((aligned(16))) char smem[SMEM_BYTES];
  cg::grid_group grid = cg::this_grid();
  volatile LAS unsigned* xst = (volatile LAS unsigned*)(smem + SMEM_BYTES - 16);
  if (threadIdx.x == 0) { xst[0] = 0u; xst[1] = 0u; }
  __syncthreads();
  const XcdBarrier xbar = xcd_barrier_post(p.bar + 64, xst);
  if (phase_hi > 1000) grid.sync();
#define PHASE(k, call) if (phase_lo <= (k) && (k) < phase_hi) { if ((k) > phase_lo) { xcd_barrier(xbar); } call; if ((DUP_MASK >> (k)) & 1) { xcd_barrier(xbar); call; } }
  PHASE(0, phase_prep(p, smem))
  PHASE(1, phase_inproj(p, smem))
  PHASE(2, phase_mix_attn(p, smem))
  PHASE(3, phase_pool_combine(p, smem))
  PHASE(4, phase_gemm_resid<false>(p.hbuf, 2048, p.wOutT, 2048, p.x, p.x2b, p.rowss1, smem))
  PHASE(6, phase_cross_proj(p, smem))
  PHASE(7, phase_cross_attn(p, smem))
  PHASE(8, phase_gemm_resid<true>(p.oc, 512, p.wCoT, 512, p.x2b, p.hbuf, p.rowss2, smem))
  PHASE(10, phase_gemm_pq(p, smem))
  PHASE(11, phase_peer_route(p, smem))
  PHASE(12, phase_peer_expert(p))
}

extern "C" void kernel_launch(void* const* d_in, const int* in_sizes, int n_in, void* d_out, int out_size, void* d_ws,
                              size_t ws_size, hipStream_t stream) {
  Params p{};
  p.x = (const float*)d_in[0]; p.mem = (const float*)d_in[1]; p.pos = (const int*)d_in[2];
  p.g_mix = (const float*)d_in[3]; p.w_in = (const float*)d_in[4]; p.w_pool = (const float*)d_in[5];
  p.pool_scale = (const float*)d_in[6]; p.w_out = (const float*)d_in[7]; p.g_cross = (const float*)d_in[8];
  p.g_mem = (const float*)d_in[9]; p.w_cq = (const float*)d_in[10]; p.w_ck = (const float*)d_in[11];
  p.w_cv = (const float*)d_in[12]; p.w_co = (const float*)d_in[13]; p.g_ffn = (const float*)d_in[14];
  p.w_pq = (const float*)d_in[15]; p.sk1f = (const float*)d_in[16]; p.sk2f = (const float*)d_in[17];
  p.w_u = (const float*)d_in[18]; p.w_v = (const float*)d_in[19]; p.g_final = (const float*)d_in[20];
  p.out = (float*)d_out;
  char* ws = (char*)d_ws;
  size_t off = 0;
  auto take = [&](size_t bytes) { char* r = ws + off; off += (bytes + 255) & ~(size_t)255; return r; };
  const size_t MB = 1024 * 1024;
  p.wInT = (bfr*)take(16 * MB); p.wPoolT = (bfr*)take(512 * 1024); p.wOutT = (bfr*)take(8 * MB);
  p.wCqT = (bfr*)take(2 * MB); p.wCkT = (bfr*)take(2 * MB); p.wCvT = (bfr*)take(2 * MB); p.wCoT = (bfr*)take(2 * MB);
  p.wPqT = (bfr*)take(8 * MB); p.sk1 = (bfr*)take(32768); p.sk2 = (bfr*)take(32768);
  p.wU8 = (unsigned char*)take(32 * MB); p.wV8 = (unsigned char*)take(32 * MB);
  p.su = (float*)take(65536); p.sv = (float*)take(65536);
  p.memn = (bfr*)take(4 * MB); p.kc = (bfr*)take(1 * MB); p.vc = (bfr*)take(1 * MB);
  p.hbuf = (bfr*)take(64 * MB);
  p.bar = (unsigned*)take(256 + XCD_BAR_WORDS * 4);
  p.rowss1 = (float*)take(65536); p.rowss2 = (float*)take(65536);
  p.ropetab = (float*)take((size_t)T_TOK * 16 * 2 * 4);
  const size_t r2 = off;
  p.qbuf = (bfr*)take(32 * MB); p.kbuf = (bfr*)take(32 * MB); p.vbuf = (bfr*)take(32 * MB);
  p.pbuf = (bfr*)take(32 * MB); p.mixed = (bfr*)take(32 * MB); p.ob = (bfr*)take(96 * MB);
  p.lse = (float*)take((size_t)3 * T_TOK * 8 * 4);
  const size_t end1 = off;
  off = r2;
  p.xres = (float*)take(128 * MB); p.pq = (bfr*)take(64 * MB); p.x2b = p.pq; p.qc = (bfr*)take(16 * MB); p.oc = (bfr*)take(16 * MB);
  p.idx = (int*)take(8 * MB); p.gates = (float*)take(8 * MB);
  const size_t end2 = off;
  const size_t need = end1 > end2 ? end1 : end2;
  if (need > ws_size) { fprintf(stderr, "workspace too small: need %zu have %zu\n", need, ws_size); return; }

  static int grid_blocks = 0;
  if (!grid_blocks) {
    int dev = 0, cus = 0, per_cu = 0;
    hipGetDevice(&dev);
    hipDeviceGetAttribute(&cus, hipDeviceAttributeMultiprocessorCount, dev);
    hipOccupancyMaxActiveBlocksPerMultiprocessor(&per_cu, mega, NTHREADS, 0);
    if (per_cu < 1) per_cu = 1;
    if (per_cu > 1) per_cu = 1;
    grid_blocks = cus * per_cu;
  }
  hipMemsetAsync(p.bar, 0, 256 + XCD_BAR_WORDS * 4, stream);
#if MULTI_LAUNCH
  for (int ph = 0; ph < NPHASE; ++ph) hipLaunchKernelGGL(mega, dim3(grid_blocks), dim3(NTHREADS), 0, stream, p, ph, ph + 1);
#else
  int lo = 0, hi = NPHASE;
  void* args[] = {&p, &lo, &hi};
  hipError_t e = hipLaunchCooperativeKernel((void*)mega, dim3(grid_blocks), dim3(NTHREADS), args, 0, stream);
  if (e != hipSuccess) fprintf(stderr, "cooperative launch failed: %s (grid %d)\n", hipGetErrorString(e), grid_blocks);
#endif
}
```

```cpp
#include <hip/hip_runtime.h>
#include <hip/hip_cooperative_groups.h>
#include <stdint.h>
#include <stdio.h>
namespace cg = cooperative_groups;

#ifndef DUP_MASK
#define DUP_MASK 0
#endif
#ifndef MULTI_LAUNCH
#define MULTI_LAUNCH 0
#endif

#define DI __device__ __forceinline__
typedef unsigned short bfr;
using bf16x8 = __attribute__((ext_vector_type(8))) short;
using s16x4  = __attribute__((ext_vector_type(4))) short;
using f32x4  = __attribute__((ext_vector_type(4))) float;
using u32x4  = __attribute__((ext_vector_type(4))) unsigned;
using u32x2  = __attribute__((ext_vector_type(2))) unsigned;
using bf2    = __attribute__((ext_vector_type(2))) __bf16;
using f32x2  = __attribute__((ext_vector_type(2))) float;
using v6u    = __attribute__((ext_vector_type(6))) unsigned;
using v16f   = __attribute__((ext_vector_type(16))) float;
using v32f   = __attribute__((ext_vector_type(32))) float;

constexpr int T_TOK = 16384;
constexpr int NTHREADS = 512;
constexpr int SMEM_BYTES = 151552;
constexpr int NPHASE = 13;

struct Params {
  const float *x, *mem; const int* pos;
  const float *g_mix, *w_in, *w_pool, *pool_scale, *w_out, *g_cross, *g_mem, *w_cq, *w_ck, *w_cv, *w_co, *g_ffn, *w_pq,
              *sk1f, *sk2f, *w_u, *w_v, *g_final;
  float* out;
  bfr *wInT, *wPoolT, *wOutT, *wCqT, *wCkT, *wCvT, *wCoT, *wPqT, *sk1, *sk2;
  unsigned char *wU8, *wV8; float *su, *sv;
  bfr *hbuf, *memn, *kc, *vc;
  bfr *pbuf, *qbuf, *kbuf, *vbuf, *mixed, *ob; float* lse;
  float* xres; bfr *pq, *qc, *oc; int* idx; float* gates;
  unsigned* bar;
  float *rowss1, *rowss2; bfr* x2b;
  float* ropetab;
};

DI unsigned pack2(float a, float b) { bf2 p; p[0] = (__bf16)a; p[1] = (__bf16)b; return __builtin_bit_cast(unsigned, p); }
DI float bflo(unsigned u) { return __uint_as_float(u << 16); }
DI float bfhi(unsigned u) { return __uint_as_float(u & 0xffff0000u); }
DI float4 ldnt4(const float* p) { const f32x4 v = __builtin_nontemporal_load((const f32x4*)p); return make_float4(v[0], v[1], v[2], v[3]); }
DI float wave_sum(float v) {
#pragma unroll
  for (int o = 32; o >= 1; o >>= 1) v += __shfl_xor(v, o);
  return v;
}
DI f32x4 mfma16(bf16x8 a, bf16x8 b, f32x4 c) { return __builtin_amdgcn_mfma_f32_16x16x32_bf16(a, b, c, 0, 0, 0); }
DI s16x4 tr_read(const char* p) {
  return __builtin_amdgcn_ds_read_tr16_b64_v4i16((s16x4 __attribute__((address_space(3)))*)(p));
}


#define LAS __attribute__((address_space(3)))
namespace g8 {
constexpr int BM = 256, BK = 64, HALF = 128, HTB = HALF * BK * 2, NXCD = 8, WGM = 8;
DI int lds_byte(int r, int c) { const int st = (r >> 4) * 2 + (c >> 5), rr = r & 15, cc = c & 31, ob = rr * 64 + cc * 2; return st * 1024 + (ob ^ (((ob >> 9) & 1) << 5)); }
DI int perm32(int rho) { const int n = rho >> 4, i = rho & 15; return 8 * (i >> 2) + 4 * n + (i & 3); }
DI void stage_rc(int b, int& R, int& C) { const int st = b / 1024, sb = b % 1024, swz = sb ^ (((sb >> 9) & 1) << 5); R = (st >> 1) * 16 + swz / 64; C = (st & 1) * 32 + (swz % 64) / 2; }
struct Order {
  int nM, nN, nwg, G, c;
  DI void init(int M, int N, int G_, int c_) { nM = M / BM; nN = N / BM; nwg = nM * nN; G = G_; c = c_; }
  DI bool next(int i, int& pm, int& pn) const {
    const long L = (long)i * G + c; if (L >= nwg) return false;
    int wgid = (int)L; { const int q = nwg / NXCD, r = nwg % NXCD, xcd = wgid % NXCD, off = wgid / NXCD; wgid = (xcd < r ? xcd * (q + 1) : r * (q + 1) + (xcd - r) * q) + off; }
    const int nig = WGM * nN, gid = wgid / nig, fm = gid * WGM, gsz = (nM - fm) < WGM ? (nM - fm) : WGM;
    pm = fm + ((wgid % nig) % gsz); pn = (wgid % nig) / gsz; return true;
  }
};
}

template <class Epi>
DI void gemm8(LAS unsigned char* lds, const bfr* A, int lda, const bfr* Bt, int M, int N, int K, int G, int c, const Epi& E, int a_pn_bytes = 0) {
  using namespace g8;
  const int tid = threadIdx.x, wid = __builtin_amdgcn_readfirstlane(tid >> 6), lane = tid & 63, wr = wid >> 2, wc = wid & 3, fr = lane & 15, fq = lane >> 4;
  const int nt = K / BK;
  Order S; S.init(M, N, G, c);
  unsigned voffA[2], voffB[2];
#pragma unroll
  for (int i = 0; i < 2; ++i) { int R, C; stage_rc(tid * 16 + i * 8192, R, C); const int Rb = (R & ~31) + perm32(R & 31);
    voffA[i] = (unsigned)(R * lda + C) * 2u; voffB[i] = (unsigned)(Rb * K + C) * 2u; }
  const size_t kstep = (size_t)(BK * 2);
  const size_t hstepA = (size_t)HALF * lda * 2, hstepB = (size_t)HALF * K * 2;
  const size_t tstepA = 2 * hstepA, tstepB = 2 * hstepB;
  const unsigned ldsw = (unsigned)wid * 1024u;
  const int aoff = lds_byte(wr * 64 + fr, fq * 8), boff = lds_byte(wc * 32 + fr, fq * 8);
#define G8_SA(b, h) (((b) * 2 + (h)) * HTB)
#define G8_SB(b, h) ((4 + (b) * 2 + (h)) * HTB)
#define G8_STAGE(bufoff, gbase, voff) do { _Pragma("unroll") for (int _i = 0; _i < 2; ++_i) \
    __builtin_amdgcn_global_load_lds((const unsigned*)((const char*)(gbase) + (voff)[_i]), (LAS unsigned*)(lds + (bufoff) + ldsw + _i * 8192), 16, 0, 0); } while (0)
#define G8_LDA(dst, b, h) do { _Pragma("unroll") for (int m = 0; m < 4; ++m) _Pragma("unroll") for (int k = 0; k < 2; ++k) dst[m][k] = *(const LAS bf16x8*)(lds + G8_SA(b, h) + aoff + m * 2048 + k * 1024); } while (0)
#define G8_LDB(dst, b, h) do { _Pragma("unroll") for (int n = 0; n < 2; ++n) _Pragma("unroll") for (int k = 0; k < 2; ++k) dst[n][k] = *(const LAS bf16x8*)(lds + G8_SB(b, h) + boff + n * 2048 + k * 1024); } while (0)
#define G8_MMA(ai, bj, At, Btf) do { __builtin_amdgcn_s_setprio(1); _Pragma("unroll") for (int m = 0; m < 4; ++m) _Pragma("unroll") for (int n = 0; n < 2; ++n) _Pragma("unroll") for (int k = 0; k < 2; ++k) \
    acc[ai][bj][m][n] = __builtin_amdgcn_mfma_f32_16x16x32_bf16(Btf[n][k], At[m][k], acc[ai][bj][m][n], 0, 0, 0); __builtin_amdgcn_s_setprio(0); } while (0)
#define G8_WAIT_V(n) asm volatile("s_waitcnt vmcnt(" #n ")" ::: "memory")
#define G8_WAIT_L(n) asm volatile("s_waitcnt lgkmcnt(" #n ")" ::: "memory")
#define G8_BAR __builtin_amdgcn_s_barrier()
#define G8_SCHED __builtin_amdgcn_sched_barrier(0)
  int cpm, cpn, npm = 0, npn = 0, ui = 0;
  if (!S.next(0, cpm, cpn)) return;
  f32x4 acc[2][2][4][2];
#pragma unroll
  for (int a = 0; a < 2; ++a)
#pragma unroll
    for (int b = 0; b < 2; ++b)
#pragma unroll
      for (int m = 0; m < 4; ++m)
#pragma unroll
        for (int n = 0; n < 2; ++n) acc[a][b][m][n] = f32x4{0.f, 0.f, 0.f, 0.f};
  bf16x8 At[4][2], B0[2][2], B1[2][2];
  const char* cA = (const char*)A + (size_t)cpm * tstepA + (size_t)cpn * a_pn_bytes; const char* cB = (const char*)Bt + (size_t)cpn * tstepB;
  G8_STAGE(G8_SB(0, 0), cB, voffB); G8_STAGE(G8_SA(0, 0), cA, voffA); G8_STAGE(G8_SB(0, 1), cB + hstepB, voffB); G8_STAGE(G8_SA(0, 1), cA + hstepA, voffA);
  if (wr == 1) G8_BAR;
  G8_WAIT_V(4); G8_BAR;
  G8_STAGE(G8_SB(1, 0), cB + kstep, voffB); G8_STAGE(G8_SA(1, 0), cA + kstep, voffA); G8_STAGE(G8_SB(1, 1), cB + hstepB + kstep, voffB);
  G8_WAIT_V(6); G8_BAR;
  for (;;) {
    const bool has_next = S.next(ui + 1, npm, npn);
    const char* nA = has_next ? (const char*)A + (size_t)npm * tstepA + (size_t)npn * a_pn_bytes : cA; const char* nB = has_next ? (const char*)Bt + (size_t)npn * tstepB : cB;
    for (int t = 0; t < nt; t += 2) {
      const bool last = (t == nt - 2);
      const char* a1 = cA + (size_t)(t + 1) * kstep;
      const char* a2 = last ? nA : cA + (size_t)(t + 2) * kstep; const char* b2 = last ? nB : cB + (size_t)(t + 2) * kstep;
      const char* a3 = a2 + kstep; const char* b3 = b2 + kstep;
      G8_LDB(B0, 0, 0); G8_SCHED; G8_LDA(At, 0, 0); G8_STAGE(G8_SA(1, 1), a1 + hstepA, voffA);
      G8_WAIT_L(8); G8_BAR; G8_WAIT_L(0); G8_MMA(0, 0, At, B0); G8_BAR; G8_SCHED;
      G8_LDB(B1, 0, 1); G8_STAGE(G8_SB(0, 0), b2, voffB);
      G8_BAR; G8_WAIT_L(0); G8_MMA(0, 1, At, B1); G8_BAR;
      G8_LDA(At, 0, 1); G8_STAGE(G8_SA(0, 0), a2, voffA);
      G8_BAR; G8_WAIT_L(0); G8_MMA(1, 0, At, B0); G8_BAR; G8_SCHED;
      G8_STAGE(G8_SB(0, 1), b2 + hstepB, voffB);
      G8_WAIT_V(6); G8_BAR; G8_MMA(1, 1, At, B1); G8_BAR;
      G8_LDB(B0, 1, 0); G8_SCHED; G8_LDA(At, 1, 0); G8_STAGE(G8_SA(0, 1), a2 + hstepA, voffA);
      G8_WAIT_L(8); G8_BAR; G8_WAIT_L(0); G8_MMA(0, 0, At, B0); G8_BAR; G8_SCHED;
      G8_LDB(B1, 1, 1); G8_STAGE(G8_SB(1, 0), b3, voffB);
      G8_BAR; G8_WAIT_L(0); G8_MMA(0, 1, At, B1); G8_BAR;
      G8_LDA(At, 1, 1); G8_STAGE(G8_SA(1, 0), a3, voffA);
      G8_BAR; G8_WAIT_L(0); G8_MMA(1, 0, At, B0); G8_BAR; G8_SCHED;
      G8_STAGE(G8_SB(1, 1), b3 + hstepB, voffB);
      G8_WAIT_V(6); G8_BAR; G8_MMA(1, 1, At, B1); G8_BAR;
    }
    E(acc, cpm, cpn, wr, wc, fr, fq);
    if (!has_next) break;
#pragma unroll
    for (int a = 0; a < 2; ++a)
#pragma unroll
      for (int b = 0; b < 2; ++b)
#pragma unroll
        for (int m = 0; m < 4; ++m)
#pragma unroll
          for (int n = 0; n < 2; ++n) acc[a][b][m][n] = f32x4{0.f, 0.f, 0.f, 0.f};
    cpm = npm; cpn = npn; cA = nA; cB = nB; ++ui;
  }
  G8_WAIT_V(0);
  if (wr == 0) G8_BAR;
  G8_BAR;
#undef G8_SA
#undef G8_SB
#undef G8_STAGE
#undef G8_LDA
#undef G8_LDB
#undef G8_MMA
#undef G8_WAIT_V
#undef G8_WAIT_L
#undef G8_BAR
#undef G8_SCHED
}
#define G8_FOREACH8(acc, pm, pn, wr, wc, fr, fq, ai, bj, m, row, col) \
  _Pragma("unroll") for (int ai = 0; ai < 2; ++ai) _Pragma("unroll") for (int m = 0; m < 4; ++m) \
  _Pragma("unroll") for (int bj = 0; bj < 2; ++bj) \
    if (const int row = 256 * (pm) + 128 * ai + 64 * (wr) + 16 * m + (fr); true) if (const int col = 256 * (pn) + 128 * bj + 32 * (wc) + 8 * (fq); true)
DI u32x4 pack8(const f32x4 a, const f32x4 b, float sc) {
  return u32x4{pack2(a[0] * sc, a[1] * sc), pack2(a[2] * sc, a[3] * sc), pack2(b[0] * sc, b[1] * sc), pack2(b[2] * sc, b[3] * sc)};
}
typedef f32x4 Acc8[2][2][4][2];

struct NoHook { DI void operator()() const {} };
template <bool BANDED, class RowF, class MidF = NoHook>
DI void attn_compute(const bf16x8 (&qf)[4], int q0, int key0, char* smem, RowF rowptr, float& m_out, float& l_out, MidF mid = MidF()) {
  const int tid = threadIdx.x, lane = tid & 63, w = tid >> 6, fr = lane & 15, fq = lane >> 4;
  char* sK = smem;
  char* sV = smem + 65536;
  constexpr int NT = BANDED ? 10 : 16;
  const int t0 = BANDED ? (w & ~1) : 0;
  f32x4 s[NT];
#pragma unroll
  for (int j = 0; j < NT; ++j) {
    f32x4 a = f32x4{0.f, 0.f, 0.f, 0.f};
    const int key = (t0 + j) * 16 + fr;
#pragma unroll
    for (int kk = 0; kk < 4; ++kk) {
      const bf16x8 kf = *(const bf16x8*)(sK + key * 256 + (((kk * 4 + fq) ^ fr) << 4));
      a = mfma16(kf, qf[kk], a);
    }
    s[j] = a;
  }
  mid();
  const float L2E = 1.4426950408889634f;
  const float NINF = -__builtin_inff();
  float mx = NINF;
  const int lq = q0 + w * 16 + fr;
#pragma unroll
  for (int j = 0; j < NT; ++j)
#pragma unroll
    for (int i = 0; i < 4; ++i) {
      float v = s[j][i] * L2E;
      if (BANDED) {
        const int lk = key0 + (t0 + j) * 16 + fq * 4 + i;
        const int dist = lq - lk;
        const bool ok = (lk >= 0) && (dist >= 0) && (dist <= 128);
        v = ok ? v : NINF;
      }
      s[j][i] = v;
      mx = fmaxf(mx, v);
    }
  mx = fmaxf(mx, __shfl_xor(mx, 16));
  mx = fmaxf(mx, __shfl_xor(mx, 32));
  float l = 0.f;
#pragma unroll
  for (int j = 0; j < NT; ++j)
#pragma unroll
    for (int i = 0; i < 4; ++i) {
      const float p = __builtin_amdgcn_exp2f(s[j][i] - mx);
      s[j][i] = p;
      l += p;
    }
  l += __shfl_xor(l, 16);
  l += __shfl_xor(l, 32);
  bf16x8 pf[NT / 2];
#pragma unroll
  for (int c = 0; c < NT / 2; ++c) {
    u32x4 t;
    t[0] = pack2(s[2 * c][0], s[2 * c][1]);
    t[1] = pack2(s[2 * c][2], s[2 * c][3]);
    t[2] = pack2(s[2 * c + 1][0], s[2 * c + 1][1]);
    t[3] = pack2(s[2 * c + 1][2], s[2 * c + 1][3]);
    pf[c] = __builtin_bit_cast(bf16x8, t);
  }
  const int q4 = (lane & 15) >> 2, p4 = lane & 3;
  m_out = mx;
  l_out = l;
  const float il = 1.f / l;
  bfr* dst = rowptr(fr) + fq * 4;
#pragma unroll 2
  for (int dt = 0; dt < 8; ++dt) {
    f32x4 a = f32x4{0.f, 0.f, 0.f, 0.f};
#pragma unroll
    for (int c = 0; c < NT / 2; ++c) {
      const int kb = (t0 + 2 * c) * 16;
      const s16x4 lo = tr_read(sV + (kb + fq * 4 + q4) * 288 + (dt * 16 + p4 * 4) * 2);
      const s16x4 hi = tr_read(sV + (kb + 16 + fq * 4 + q4) * 288 + (dt * 16 + p4 * 4) * 2);
      const bf16x8 vf = __builtin_shufflevector(lo, hi, 0, 1, 2, 3, 4, 5, 6, 7);
      a = mfma16(vf, pf[c], a);
    }
    u32x2 v; v[0] = pack2(a[0] * il, a[1] * il); v[1] = pack2(a[2] * il, a[3] * il);
    *(u32x2*)(dst + dt * 16) = v;
  }
}

template <bool BANDED, class StoreF>
DI void attn_core(const bfr* __restrict__ Qb, int qstride, int q0, const bfr* __restrict__ Kb, const bfr* __restrict__ Vb,
                  int kvstride, int key0, char* smem, StoreF store, float& m_out, float& l_out) {
  const int tid = threadIdx.x, lane = tid & 63, w = tid >> 6, fr = lane & 15, fq = lane >> 4;
  char* sK = smem;
  char* sV = smem + 65536;
  __syncthreads();
#pragma unroll 1
  for (int rr = 0; rr < 2; ++rr) {
    u32x4 kr[4], vr[4];
#pragma unroll
    for (int i = 0; i < 4; ++i) {
      const int id = tid + (rr * 4 + i) * 512, key = id >> 4, c = id & 15, lk = key0 + key;
      const int lkc = lk < 0 ? 0 : lk;
      const unsigned msk = lk < 0 ? 0u : 0xffffffffu;
      kr[i] = *(const u32x4*)(Kb + (long)lkc * kvstride + c * 8);
      vr[i] = *(const u32x4*)(Vb + (long)lkc * kvstride + c * 8);
      kr[i] &= u32x4{msk, msk, msk, msk};
      vr[i] &= u32x4{msk, msk, msk, msk};
    }
#pragma unroll
    for (int i = 0; i < 4; ++i) {
      const int id = tid + (rr * 4 + i) * 512, key = id >> 4, c = id & 15;
      *(u32x4*)(sK + key * 256 + ((c ^ (key & 15)) << 4)) = kr[i];
      *(u32x4*)(sV + key * 288 + c * 16) = vr[i];
    }
  }
  bf16x8 qf[4];
  {
    const bfr* qrow = Qb + (long)(q0 + w * 16 + fr) * qstride;
#pragma unroll
    for (int kk = 0; kk < 4; ++kk) qf[kk] = *(const bf16x8*)(qrow + kk * 32 + fq * 8);
  }
  __syncthreads();
  attn_compute<BANDED>(qf, q0, key0, smem, store, m_out, l_out);
}

DI int f2sort(float f) { int b = __float_as_int(f); return b ^ ((b >> 31) & 0x7fffffff); }
DI float sort2f(int s) { int b = s ^ ((s >> 31) & 0x7fffffff); return __int_as_float(b); }
DI void topk_insert(int (&lst)[16], int key) {
#pragma unroll
  for (int j = 0; j < 16; ++j) {
    const int hi = max(lst[j], key);
    key = min(lst[j], key);
    lst[j] = hi;
  }
}

template <int O, int N>
DI void bfly(float (&p)[64], int lane) {
  const bool up = (lane & O) != 0;
#pragma unroll
  for (int i = 0; i < N / 2; ++i) {
    const float keep = up ? p[i + N / 2] : p[i];
    const float send = up ? p[i] : p[i + N / 2];
    p[i] = keep + __shfl_xor(send, O);
  }
  if constexpr (O > 1) bfly<O / 2, N / 2>(p, lane);
}

DI void rms_rows2_to_bf16(const float* __restrict__ x0, const float* __restrict__ x1, const float* __restrict__ g,
                          bfr* __restrict__ o0, bfr* __restrict__ o1, int lane) {
  float4 v0[8], v1[8];
#pragma unroll
  for (int j = 0; j < 8; ++j) v0[j] = ldnt4(x0 + j * 256 + lane * 4);
#pragma unroll
  for (int j = 0; j < 8; ++j) v1[j] = ldnt4(x1 + j * 256 + lane * 4);
  float s0 = 0.f, s1 = 0.f;
#pragma unroll
  for (int j = 0; j < 8; ++j) {
    s0 += v0[j].x * v0[j].x + v0[j].y * v0[j].y + v0[j].z * v0[j].z + v0[j].w * v0[j].w;
    s1 += v1[j].x * v1[j].x + v1[j].y * v1[j].y + v1[j].z * v1[j].z + v1[j].w * v1[j].w;
  }
  s0 = wave_sum(s0);
  s1 = wave_sum(s1);
  const float r0 = rsqrtf(s0 * (1.f / 2048.f) + 1e-6f), r1 = rsqrtf(s1 * (1.f / 2048.f) + 1e-6f);
#pragma unroll
  for (int j = 0; j < 8; ++j) {
    const float4 gg = *(const float4*)(g + j * 256 + lane * 4);
    u32x2 a, c;
    a[0] = pack2(v0[j].x * r0 * gg.x, v0[j].y * r0 * gg.y); a[1] = pack2(v0[j].z * r0 * gg.z, v0[j].w * r0 * gg.w);
    c[0] = pack2(v1[j].x * r1 * gg.x, v1[j].y * r1 * gg.y); c[1] = pack2(v1[j].z * r1 * gg.z, v1[j].w * r1 * gg.w);
    *(u32x2*)(o0 + j * 256 + lane * 4) = a;
    *(u32x2*)(o1 + j * 256 + lane * 4) = c;
  }
}

DI void convert_f32_bf16(const float* __restrict__ src, bfr* __restrict__ dst, long n8) {
  for (long i = (long)blockIdx.x * NTHREADS + threadIdx.x; i < n8; i += (long)gridDim.x * NTHREADS) {
    const float4 a = *(const float4*)(src + i * 8);
    const float4 b = *(const float4*)(src + i * 8 + 4);
    u32x4 o;
    o[0] = pack2(a.x, a.y); o[1] = pack2(a.z, a.w); o[2] = pack2(b.x, b.y); o[3] = pack2(b.z, b.w);
    *(u32x4*)(dst + i * 8) = o;
  }
}

DI void transpose_strip(const float* __restrict__ W, int K, int N, int k0, int n0, bfr* __restrict__ Wt, float* tile,
                        const float* colscale, const float* rowscale) {
  const int tid = threadIdx.x;
  __syncthreads();
  {
    const int c4 = tid & 63, r = tid >> 6;
    float4 v[8];
#pragma unroll
    for (int i = 0; i < 8; ++i) v[i] = ldnt4(W + (size_t)(k0 + r + 8 * i) * N + n0 + c4 * 4);
#pragma unroll
    for (int i = 0; i < 8; ++i) {
      float* t = tile + (r + 8 * i) * 257 + c4 * 4;
      t[0] = v[i].x; t[1] = v[i].y; t[2] = v[i].z; t[3] = v[i].w;
    }
  }
  __syncthreads();
#pragma unroll
  for (int j = 0; j < 4; ++j) {
    const int task = tid + 512 * j, n = task >> 3, kc = task & 7;
    const float csv = colscale ? colscale[n0 + n] : 1.0f;
    u32x4 o;
#pragma unroll
    for (int e = 0; e < 4; ++e) {
      const int k = kc * 8 + 2 * e;
      const float r0 = rowscale ? rowscale[k0 + k] : 1.0f, r1 = rowscale ? rowscale[k0 + k + 1] : 1.0f;
      o[e] = pack2(tile[k * 257 + n] * csv * r0, tile[(k + 1) * 257 + n] * csv * r1);
    }
    *(u32x4*)(Wt + (size_t)(n0 + n) * K + k0 + kc * 8) = o;
  }
}

template <bool isv>
DI void quant_rows_fp4(const Params& p, int worker, int nworkers, int lane) {
  const float* tbl = isv ? p.w_v : p.w_u;
  float* scl = isv ? p.sv : p.su;
  unsigned char* out8 = isv ? p.wV8 : p.wU8;
  float4 gg[8];
  if (!isv) {
#pragma unroll
    for (int j = 0; j < 2; ++j)
#pragma unroll
      for (int q = 0; q < 4; ++q) gg[j * 4 + q] = *(const float4*)(p.g_ffn + j * 1024 + lane * 16 + q * 4);
  }
  auto finish = [&](float4 (&v)[8], int rr) {
    float amax = 0.f;
#pragma unroll
    for (int i = 0; i < 8; ++i) {
      if (!isv) { v[i].x *= gg[i].x; v[i].y *= gg[i].y; v[i].z *= gg[i].z; v[i].w *= gg[i].w; }
      amax = fmaxf(amax, fmaxf(fmaxf(fabsf(v[i].x), fabsf(v[i].y)), fmaxf(fabsf(v[i].z), fabsf(v[i].w))));
    }
#pragma unroll
    for (int o = 32; o >= 1; o >>= 1) amax = fmaxf(amax, __shfl_xor(amax, o));
    const float inv = amax > 0.f ? 6.0f / amax : 0.f;
    if (lane == 0) scl[rr] = amax * (1.f / 6.0f);
    u32x4 o4;
#pragma unroll
    for (int c = 0; c < 4; ++c) {
      const float4 t0 = v[2 * c], t1 = v[2 * c + 1];
      unsigned w = 0;
      w = __builtin_amdgcn_cvt_scalef32_pk_fp4_f32(w, t0.x * inv, t0.y * inv, 1.0f, 0);
      w = __builtin_amdgcn_cvt_scalef32_pk_fp4_f32(w, t0.z * inv, t0.w * inv, 1.0f, 1);
      w = __builtin_amdgcn_cvt_scalef32_pk_fp4_f32(w, t1.x * inv, t1.y * inv, 1.0f, 2);
      w = __builtin_amdgcn_cvt_scalef32_pk_fp4_f32(w, t1.z * inv, t1.w * inv, 1.0f, 3);
      o4[c] = w;
    }
    *(u32x4*)(out8 + (size_t)rr * 1024 + lane * 16) = o4;
  };
  for (int rr = worker; rr < 16384; rr += 2 * nworkers) {
    const int rb = rr + nworkers;
    const bool hasb = rb < 16384;
    const float* s0 = tbl + (size_t)rr * 2048;
    const float* s1 = tbl + (size_t)(hasb ? rb : rr) * 2048;
    float4 va[8], vb[8];
#pragma unroll
    for (int j = 0; j < 2; ++j)
#pragma unroll
      for (int q = 0; q < 4; ++q) va[j * 4 + q] = ldnt4(s0 + j * 1024 + lane * 16 + q * 4);
#pragma unroll
    for (int j = 0; j < 2; ++j)
#pragma unroll
      for (int q = 0; q < 4; ++q) vb[j * 4 + q] = ldnt4(s1 + j * 1024 + lane * 16 + q * 4);
    finish(va, rr);
    if (hasb) finish(vb, rb);
  }
}

DI void phase_prep(const Params& p, char* smem) {
  const int lane = threadIdx.x & 63, wid = threadIdx.x >> 6;
  for (int r2 = blockIdx.x * 8 + wid; r2 < (T_TOK + 1024) / 2; r2 += gridDim.x * 8) {
    const int r = 2 * r2;
    if (r < T_TOK) rms_rows2_to_bf16(p.x + (size_t)r * 2048, p.x + (size_t)(r + 1) * 2048, p.g_mix, p.hbuf + (size_t)r * 2048, p.hbuf + (size_t)(r + 1) * 2048, lane);
    else rms_rows2_to_bf16(p.mem + (size_t)(r - T_TOK) * 2048, p.mem + (size_t)(r + 1 - T_TOK) * 2048, p.g_mem, p.memn + (size_t)(r - T_TOK) * 2048, p.memn + (size_t)(r + 1 - T_TOK) * 2048, lane);
  }
  float* tile = (float*)smem;
  for (int id0 = blockIdx.x; id0 < 1296; id0 += gridDim.x) {
    int id = id0;
    const float* W; bfr* Wt; int K, N; const float* cs = nullptr; const float* rsc = nullptr;
    if (id < 512) { W = p.w_in; Wt = p.wInT; K = 2048; N = 4096; }
    else if ((id -= 512) < 256) { W = p.w_out; Wt = p.wOutT; K = 2048; N = 2048; }
    else if ((id -= 256) < 256) { W = p.w_pq; Wt = p.wPqT; K = 2048; N = 2048; rsc = p.g_ffn; }
    else if ((id -= 256) < 64) { W = p.w_cq; Wt = p.wCqT; K = 2048; N = 512; rsc = p.g_cross; }
    else if ((id -= 64) < 64) { W = p.w_ck; Wt = p.wCkT; K = 2048; N = 512; }
    else if ((id -= 64) < 64) { W = p.w_cv; Wt = p.wCvT; K = 2048; N = 512; }
    else if ((id -= 64) < 64) { W = p.w_co; Wt = p.wCoT; K = 512; N = 2048; }
    else { id -= 64; const int g = id >> 2; id &= 3; W = p.w_pool + g * 65536; Wt = p.wPoolT + g * 65536; K = 256; N = 256; cs = p.pool_scale + g * 256; }
    const int ntn = N >> 8;
    const int kt = id / ntn, nt = id % ntn;
    transpose_strip(W, K, N, kt * 64, nt * 256, Wt, tile, cs, rsc);
  }
  for (int i = blockIdx.x * NTHREADS + threadIdx.x; i < T_TOK; i += gridDim.x * NTHREADS) { p.rowss1[i] = 0.f; p.rowss2[i] = 0.f; }
  for (int i = blockIdx.x * NTHREADS + threadIdx.x; i < T_TOK * 16; i += gridDim.x * NTHREADS) {
    const int j = i & 15;
    const float inv = exp2f(-(float)j * (18.931568569324174f / 16.0f));
    float sn, cs;
    sincosf((float)p.pos[i >> 4] * inv, &sn, &cs);
    *(float2*)(p.ropetab + (size_t)i * 2) = make_float2(cs, sn);
  }
  convert_f32_bf16(p.sk1f, p.sk1, 128 * 128 / 8);
  convert_f32_bf16(p.sk2f, p.sk2, 128 * 128 / 8);
  quant_rows_fp4<true>(p, blockIdx.x * 8 + wid, gridDim.x * 8, lane);
}

DI void phase_inproj(const Params& p, char* smem) {
  auto epi = [&](const Acc8& acc0, int pm, int pn, int wr, int wc, int fr, int fq) {
    const int region = pn >> 2;
    if (region == 0) {
      G8_FOREACH8(acc0, pm, pn, wr, wc, fr, fq, ai, bj, m, row, col) {
        *(u32x4*)(p.pbuf + (size_t)row * 1024 + col) = pack8(acc0[ai][bj][m][0], acc0[ai][bj][m][1], 1.0f);
      }
    } else {
      bfr* dst = (region == 1) ? p.qbuf : (region == 2 ? p.kbuf : p.vbuf);
      const float scale = (region == 1) ? 0.08838834764831845f : 1.0f;
      const bool rope = (region != 3) && (wc == 0);
#pragma unroll
      for (int ai = 0; ai < 2; ++ai)
#pragma unroll
        for (int m = 0; m < 4; ++m) {
          const int row = 256 * pm + 128 * ai + 64 * wr + 16 * m + fr;
          const int b = row >> 12, t = row & 4095;
          float sn[8], cs[8];
          if (rope) {
            const float4* tp = (const float4*)(p.ropetab + ((size_t)row * 16 + 8 * (fq & 1)) * 2);
#pragma unroll
            for (int e2 = 0; e2 < 4; ++e2) {
              const float4 t = tp[e2];
              cs[2 * e2] = t.x; sn[2 * e2] = t.y; cs[2 * e2 + 1] = t.z; sn[2 * e2 + 1] = t.w;
            }
          }
#pragma unroll
          for (int bj = 0; bj < 2; ++bj) {
            const int h = (pn & 3) * 2 + bj;
            f32x4 v0 = acc0[ai][bj][m][0], v1 = acc0[ai][bj][m][1];
            if (rope) {
#pragma unroll
              for (int i = 0; i < 4; ++i) {
                const float o0 = __shfl_xor(v0[i], 32), o1 = __shfl_xor(v1[i], 32);
                v0[i] = (fq < 2) ? v0[i] * cs[i] - o0 * sn[i] : v0[i] * cs[i] + o0 * sn[i];
                v1[i] = (fq < 2) ? v1[i] * cs[4 + i] - o1 * sn[4 + i] : v1[i] * cs[4 + i] + o1 * sn[4 + i];
              }
            }
            bfr* drow = dst + ((size_t)((b * 8 + h) * 4096 + t)) * 128 + 32 * wc + 8 * fq;
            *(u32x4*)(drow) = pack8(v0, v1, scale);
          }
        }
    }
  };
  gemm8((LAS unsigned char*)smem, p.hbuf, 2048, p.wInT, T_TOK, 4096, 2048, gridDim.x, blockIdx.x, epi);
}

DI void phase_mix_attn(const Params& p, char* smem) {
  const int tid = threadIdx.x, lane = tid & 63, w = tid >> 6, fr = lane & 15, fq = lane >> 4;
  {
    char* sK = smem;
    char* sV = smem + 65536;
    u32x4 kr[8], vr[8];
    bf16x8 qn[4];
    int pend_key0 = 0;
    auto decode = [&](int id, int& br, int& dl, int& bh, int& r, int& l0) {
      br = id >> 10;
      const int rem = id & 1023;
      dl = (br == 0) ? 1 : (br == 1 ? 4 : 16);
      const int nblk = 32 / dl;
      bh = rem >> 5;
      const int rn = rem & 31;
      r = rn / nblk;
      l0 = (rn % nblk) * 128;
    };
    auto issueK = [&](int id) {
      int br, dl, bh, r, l0;
      decode(id, br, dl, bh, r, l0);
      const size_t base = (size_t)bh * 4096 * 128 + (size_t)r * 128;
      const bfr* Kb = p.kbuf + base;
      const int kvstride = dl * 128, key0 = l0 - 128;
#pragma unroll
      for (int i = 0; i < 8; ++i) {
        const int e = tid + i * 512, key = e >> 4, c = e & 15, lk = key0 + key;
        const int lkc = lk < 0 ? 0 : lk;
        kr[i] = *(const u32x4*)(Kb + (long)lkc * kvstride + c * 8);
      }
      pend_key0 = key0;
    };
    auto issueVQ = [&](int id) {
      int br, dl, bh, r, l0;
      decode(id, br, dl, bh, r, l0);
      const size_t base = (size_t)bh * 4096 * 128 + (size_t)r * 128;
      const bfr* Vb = p.vbuf + base;
      const int kvstride = dl * 128, key0 = l0 - 128;
#pragma unroll
      for (int i = 0; i < 8; ++i) {
        const int e = tid + i * 512, key = e >> 4, c = e & 15, lk = key0 + key;
        const int lkc = lk < 0 ? 0 : lk;
        vr[i] = *(const u32x4*)(Vb + (long)lkc * kvstride + c * 8);
      }
      const bfr* qrow = p.qbuf + base + (long)(l0 + w * 16 + fr) * kvstride;
#pragma unroll
      for (int kk = 0; kk < 4; ++kk) qn[kk] = *(const bf16x8*)(qrow + kk * 32 + fq * 8);
    };
    const bool remap = (gridDim.x == 256);
    const int nround = remap ? 12 : (3072 + (int)gridDim.x - 1) / (int)gridDim.x;
    auto item_of = [&](int k) -> int {
      if (!remap) return k * (int)gridDim.x + (int)blockIdx.x;
      const int xcd = blockIdx.x & 7, slot = blockIdx.x >> 3;
      const int bh = (k / 3) * 8 + xcd, br = k % 3;
      return (br * 32 + bh) * 32 + slot;
    };
    if (item_of(0) < 3072) { issueK(item_of(0)); issueVQ(item_of(0)); }
    for (int k = 0; k < nround; ++k) {
      const int id = item_of(k);
      if (id >= 3072) break;
      __syncthreads();
#pragma unroll
      for (int i = 0; i < 8; ++i) {
        const int e = tid + i * 512, key = e >> 4, c = e & 15;
        const unsigned msk = (pend_key0 + key) < 0 ? 0u : 0xffffffffu;
        const u32x4 m4 = u32x4{msk, msk, msk, msk};
        *(u32x4*)(sK + key * 256 + ((c ^ (key & 15)) << 4)) = kr[i] & m4;
        *(u32x4*)(sV + key * 288 + c * 16) = vr[i] & m4;
      }
      bf16x8 qf[4];
#pragma unroll
      for (int kk = 0; kk < 4; ++kk) qf[kk] = qn[kk];
      __syncthreads();
      const int nid = (k + 1 < nround) ? item_of(k + 1) : 3072;
      if (nid < 3072) issueK(nid);
      int br, dl, bh, r, l0;
      decode(id, br, dl, bh, r, l0);
      float mx, l;
      const int b = bh >> 3, h = bh & 7;
      const int tt = b * 4096 + (l0 + w * 16 + fr) * dl + r;
      bfr* obase = p.ob + (size_t)br * T_TOK * 1024 + h * 128;
      const int tq0 = b * 4096 + r, lw = l0 + w * 16;
      attn_compute<true>(qf, l0, l0 - 128, smem,
                         [&](int q) { return obase + (size_t)(tq0 + (lw + q) * dl) * 1024; }, mx, l,
                         [&]() { if (nid < 3072) issueVQ(nid); });
      if (fq == 0) p.lse[(size_t)br * T_TOK * 8 + (size_t)tt * 8 + h] = mx + __builtin_amdgcn_logf(l);
    }
  }
  for (int id = 3072 + blockIdx.x; id < 3072 + 256; id += gridDim.x) {
    {
      const int ci = id - 3072;
      const int sub = tid >> 7, cgp = tid & 127;
      const int wdw = 2 << (cgp >> 5);
      const int t0 = ci * 64 + sub * 16, tin0 = t0 & 4095;
      const bfr* pb = p.pbuf + cgp * 8;
      float sum[8];
#pragma unroll
      for (int e = 0; e < 8; ++e) sum[e] = 0.f;
      u32x4 hv[15];
#pragma unroll
      for (int j = 1; j < 16; ++j) {
        const bool ok = (j < wdw) && (tin0 - j >= 0);
        const unsigned msk = ok ? 0xffffffffu : 0u;
        hv[j - 1] = *(const u32x4*)(pb + (size_t)(ok ? t0 - j : t0) * 1024) & u32x4{msk, msk, msk, msk};
      }
#pragma unroll
      for (int hb = 0; hb < 2; ++hb) {
        u32x4 cv[8], sv[8];
#pragma unroll
        for (int s2 = 0; s2 < 8; ++s2) {
          const int so = hb * 8 + s2;
          cv[s2] = *(const u32x4*)(pb + (size_t)(t0 + so) * 1024);
          const bool ok = (tin0 + so - wdw + 1 >= 0);
          const unsigned msk = ok ? 0xffffffffu : 0u;
          sv[s2] = *(const u32x4*)(pb + (size_t)(ok ? t0 + so - wdw + 1 : t0) * 1024) & u32x4{msk, msk, msk, msk};
        }
        if (hb == 0) {
#pragma unroll
          for (int j = 0; j < 15; ++j)
#pragma unroll
            for (int e = 0; e < 4; ++e) { sum[2 * e] += bflo(hv[j][e]); sum[2 * e + 1] += bfhi(hv[j][e]); }
        }
#pragma unroll
        for (int s2 = 0; s2 < 8; ++s2) {
          const int so = hb * 8 + s2, t = t0 + so, tin = tin0 + so;
          float cur[8];
#pragma unroll
          for (int e = 0; e < 4; ++e) { cur[2 * e] = bflo(cv[s2][e]); cur[2 * e + 1] = bfhi(cv[s2][e]); }
          const float ic = 1.f / (float)min(tin + 1, wdw);
          u32x4 ov;
#pragma unroll
          for (int e = 0; e < 8; ++e) sum[e] += cur[e];
#pragma unroll
          for (int e = 0; e < 4; ++e) ov[e] = pack2(sum[2 * e] * ic - cur[2 * e], sum[2 * e + 1] * ic - cur[2 * e + 1]);
          *(u32x4*)(p.mixed + (size_t)t * 1024 + cgp * 8) = ov;
#pragma unroll
          for (int e = 0; e < 4; ++e) { sum[2 * e] -= bflo(sv[s2][e]); sum[2 * e + 1] -= bfhi(sv[s2][e]); }
        }
      }
    }
  }
}

DI void phase_pool_combine(const Params& p, char* smem) {
  const int tid = threadIdx.x;
  {
    auto epi = [&](const Acc8& acc0, int pm, int pn, int wr, int wc, int fr, int fq) {
      G8_FOREACH8(acc0, pm, pn, wr, wc, fr, fq, ai, bj, m, row, col) {
        *(u32x4*)(p.hbuf + (size_t)row * 2048 + col) = pack8(acc0[ai][bj][m][0], acc0[ai][bj][m][1], 1.0f);
      }
    };
    gemm8((LAS unsigned char*)smem, p.mixed, 1024, p.wPoolT, T_TOK, 1024, 256, gridDim.x, blockIdx.x, epi, 512);
  }
  for (long i = (long)blockIdx.x * NTHREADS + tid; i < (long)T_TOK * 8 * 16; i += (long)gridDim.x * NTHREADS) {
    const int dc = (int)(i & 15), h = (int)((i >> 4) & 7);
    const long tt = i >> 7;
    const float l0 = p.lse[tt * 8 + h], l1 = p.lse[(size_t)T_TOK * 8 + tt * 8 + h], l2 = p.lse[(size_t)2 * T_TOK * 8 + tt * 8 + h];
    const float mx = fmaxf(l0, fmaxf(l1, l2));
    float w0 = __builtin_amdgcn_exp2f(l0 - mx), w1 = __builtin_amdgcn_exp2f(l1 - mx), w2 = __builtin_amdgcn_exp2f(l2 - mx);
    const float inv = 1.f / (w0 + w1 + w2);
    w0 *= inv; w1 *= inv; w2 *= inv;
    const size_t off = (size_t)tt * 1024 + h * 128 + dc * 8;
    const u32x4 a = *(const u32x4*)(p.ob + off);
    const u32x4 b = *(const u32x4*)(p.ob + (size_t)T_TOK * 1024 + off);
    const u32x4 c = *(const u32x4*)(p.ob + (size_t)2 * T_TOK * 1024 + off);
    u32x4 o;
#pragma unroll
    for (int e = 0; e < 4; ++e)
      o[e] = pack2(w0 * bflo(a[e]) + w1 * bflo(b[e]) + w2 * bflo(c[e]), w0 * bfhi(a[e]) + w1 * bfhi(b[e]) + w2 * bfhi(c[e]));
    *(u32x4*)(p.hbuf + (size_t)tt * 2048 + 1024 + h * 128 + dc * 8) = o;
  }
}

template <bool RESID_BF16>
DI void phase_gemm_resid(const bfr* A, int lda, const bfr* Bt, int K, const void* resid, bfr* xb, float* rowss, char* smem) {
  auto epi = [&](const Acc8& acc0, int pm, int pn, int wr, int wc, int fr, int fq) {
#pragma unroll
    for (int ai = 0; ai < 2; ++ai)
#pragma unroll
      for (int m = 0; m < 4; ++m) {
        const int row = 256 * pm + 128 * ai + 64 * wr + 16 * m + fr;
        float ss = 0.f;
#pragma unroll
        for (int bj = 0; bj < 2; ++bj) {
          const int col = 256 * pn + 128 * bj + 32 * wc + 8 * fq;
          const f32x4 v0 = acc0[ai][bj][m][0], v1 = acc0[ai][bj][m][1];
          float r[8];
          if (RESID_BF16) {
            const u32x4 t = *(const u32x4*)((const bfr*)resid + (size_t)row * 2048 + col);
#pragma unroll
            for (int e = 0; e < 4; ++e) { r[2 * e] = bflo(t[e]); r[2 * e + 1] = bfhi(t[e]); }
          } else {
            const float4 t0 = *(const float4*)((const float*)resid + (size_t)row * 2048 + col);
            const float4 t1 = *(const float4*)((const float*)resid + (size_t)row * 2048 + col + 4);
            r[0] = t0.x; r[1] = t0.y; r[2] = t0.z; r[3] = t0.w; r[4] = t1.x; r[5] = t1.y; r[6] = t1.z; r[7] = t1.w;
          }
          f32x4 o0, o1;
#pragma unroll
          for (int e = 0; e < 4; ++e) { o0[e] = r[e] + v0[e]; o1[e] = r[4 + e] + v1[e]; ss += o0[e] * o0[e] + o1[e] * o1[e]; }
          *(u32x4*)(xb + (size_t)row * 2048 + col) = pack8(o0, o1, 1.0f);
        }
        ss += __shfl_xor(ss, 16);
        ss += __shfl_xor(ss, 32);
        if (fq == 0) atomicAdd(rowss + row, ss);
      }
  };
  gemm8((LAS unsigned char*)smem, A, lda, Bt, T_TOK, 2048, K, gridDim.x, blockIdx.x, epi);
}

DI void phase_gemm_pq(const Params& p, char* smem) {
  auto epi = [&](const Acc8& acc0, int pm, int pn, int wr, int wc, int fr, int fq) {
    G8_FOREACH8(acc0, pm, pn, wr, wc, fr, fq, ai, bj, m, row, col) {
      const float rs = rsqrtf(p.rowss2[row] * (1.f / 2048.f) + 1e-6f);
      *(u32x4*)(p.pq + (size_t)row * 2048 + col) = pack8(acc0[ai][bj][m][0], acc0[ai][bj][m][1], rs);
    }
  };
  gemm8((LAS unsigned char*)smem, p.hbuf, 2048, p.wPqT, T_TOK, 2048, 2048, gridDim.x, blockIdx.x, epi);
}
DI void phase_cross_proj(const Params& p, char* smem) {
  const int half = gridDim.x >> 1;
  if ((int)blockIdx.x < half) {
    auto epi = [&](const Acc8& acc0, int pm, int pn, int wr, int wc, int fr, int fq) {
      G8_FOREACH8(acc0, pm, pn, wr, wc, fr, fq, ai, bj, m, row, col) {
        const float scale = 0.08838834764831845f * rsqrtf(p.rowss1[row] * (1.f / 2048.f) + 1e-6f);
        *(u32x4*)(p.qc + (size_t)row * 512 + col) = pack8(acc0[ai][bj][m][0], acc0[ai][bj][m][1], scale);
      }
    };
    gemm8((LAS unsigned char*)smem, p.x2b, 2048, p.wCqT, T_TOK, 512, 2048, half, blockIdx.x, epi);
  } else if ((int)blockIdx.x < half + 16) {
    auto epi = [&](const Acc8& acc0, int pm, int pn, int wr, int wc, int fr, int fq) {
      G8_FOREACH8(acc0, pm, pn, wr, wc, fr, fq, ai, bj, m, row, col) {
        bfr* dst = (col < 512) ? p.kc : p.vc;
        const int cc = col & 511, hh = cc >> 7, d = cc & 127, bb = row >> 8, mm = row & 255;
        *(u32x4*)(dst + ((size_t)((bb * 4 + hh) * 256 + mm)) * 128 + d) = pack8(acc0[ai][bj][m][0], acc0[ai][bj][m][1], 1.0f);
      }
    };
    gemm8((LAS unsigned char*)smem, p.memn, 2048, p.wCkT, 1024, 1024, 2048, 16, blockIdx.x - half, epi);
  } else {
    const int nidle = gridDim.x - (half + 16);
    quant_rows_fp4<false>(p, (blockIdx.x - (half + 16)) * 8 + (threadIdx.x >> 6), nidle * 8, threadIdx.x & 63);
  }
}

DI void phase_cross_attn(const Params& p, char* smem) {
  const int tid = threadIdx.x, lane = tid & 63, w = tid >> 6, fr = lane & 15, fq = lane >> 4;
  for (int id = blockIdx.x; id < 512; id += gridDim.x) {
    const int b = id >> 7, h = (id >> 5) & 3, qt = id & 31;
    float mx, l;
    const size_t kvb = (size_t)(b * 4 + h) * 256 * 128;
    bfr* obase = p.oc + (size_t)(b * 4096 + qt * 128 + w * 16) * 512 + h * 128;
    attn_core<false>(p.qc + (size_t)b * 4096 * 512 + h * 128, 512, qt * 128, p.kc + kvb, p.vc + kvb, 128, 0, smem,
                     [&](int q) { return obase + (size_t)q * 512; }, mx, l);
  }
}

DI void bitonic_sort16_desc(int (&mg)[16]);
DI void top16_of_32(int (&a)[16], int (&b)[16]);
template <unsigned AMASK>
DI void route_cands(int (&top)[16], const float (&v1)[16], const float (&v2)[16]) {
  int ca[16], cb[16];
#pragma unroll
  for (int j = 0; j < 16; ++j) { ca[j] = (int)0x80000000; cb[j] = (int)0x80000000; }
  int c = 0;
#pragma unroll
  for (int a = 0; a < 16; ++a)
#pragma unroll
    for (int b = 0; b < 16; ++b)
      if (((AMASK >> a) & 1u) && (a + 1) * (b + 1) <= 16) {
        const int key = (f2sort(v1[a] + v2[b]) & ~0xFF) | (a * 16 + b);
        if (c < 16) ca[c] = key; else cb[c - 16] = key;
        ++c;
      }
  top16_of_32(ca, cb);
#pragma unroll
  for (int j = 0; j < 16; ++j) top[j] = ca[j];
}
DI void bitonic_sort16_desc(int (&mg)[16]) {
#pragma unroll
  for (int st = 8; st >= 1; st >>= 1)
#pragma unroll
    for (int i = 0; i < 16; ++i)
      if ((i & st) == 0) { const int hi = max(mg[i], mg[i + st]), lo = min(mg[i], mg[i + st]); mg[i] = hi; mg[i + st] = lo; }
}

DI void sort16_desc(int (&x)[16]) {
#pragma unroll
  for (int k = 2; k <= 16; k <<= 1)
#pragma unroll
    for (int j = k >> 1; j > 0; j >>= 1)
#pragma unroll
      for (int i = 0; i < 16; ++i) {
        const int l = i ^ j;
        if (l > i) {
          const int hi = max(x[i], x[l]), lo = min(x[i], x[l]);
          const bool desc = ((i & k) == 0);
          x[i] = desc ? hi : lo;
          x[l] = desc ? lo : hi;
        }
      }
}
DI void top16_of_32(int (&a)[16], int (&b)[16]) {
  sort16_desc(a);
  sort16_desc(b);
#pragma unroll
  for (int i = 0; i < 16; ++i) a[i] = max(a[i], b[15 - i]);
  bitonic_sort16_desc(a);
}
DI void phase_peer_route(const Params& p, char* smem) {
  const int tid = threadIdx.x, lane = tid & 63, w = tid >> 6, fr = lane & 15, fq = lane >> 4;
  char* sSK = smem;
  float* scores = (float*)(smem + 65536);
  int* lists = (int*)(smem + 65536 + 67584);
  int* tops = (int*)(smem + 65536);
  constexpr unsigned AM0 = (1u << 0) | (1u << 3) | (1u << 5) | (1u << 8) | (1u << 9) | (1u << 10) | (1u << 11);
  __syncthreads();
#pragma unroll
  for (int i = 0; i < 8; ++i) {
    const int id = tid + i * 512, key = id >> 4, c = id & 15;
    const bfr* src = (key < 128 ? p.sk1 : p.sk2) + (key & 127) * 128 + c * 8;
    *(u32x4*)(sSK + key * 256 + ((c ^ (key & 15)) << 4)) = *(const u32x4*)src;
  }
  for (int id = blockIdx.x; id < 2048; id += gridDim.x) {
    const int tt = id >> 3, h = id & 7;
    const int tok0 = tt * 64;
    __syncthreads();
    {
      const int tg = w & 3, hf = w >> 2;
      const bfr* arow = p.pq + (size_t)(tok0 + tg * 16 + fr) * 2048 + h * 256 + hf * 128;
      bf16x8 af[4];
#pragma unroll
      for (int kk = 0; kk < 4; ++kk) af[kk] = *(const bf16x8*)(arow + kk * 32 + fq * 8);
#pragma unroll
      for (int nt = 0; nt < 8; ++nt) {
        f32x4 a = f32x4{0.f, 0.f, 0.f, 0.f};
        const int key = hf * 128 + nt * 16 + fr;
#pragma unroll
        for (int kk = 0; kk < 4; ++kk) {
          const bf16x8 bfg = *(const bf16x8*)(sSK + key * 256 + (((kk * 4 + fq) ^ fr) << 4));
          a = mfma16(af[kk], bfg, a);
        }
#pragma unroll
        for (int i = 0; i < 4; ++i) scores[(hf * 64 + tg * 16 + fq * 4 + i) * 132 + nt * 16 + fr] = a[i];
      }
    }
    __syncthreads();
    {
      const int row = tid >> 2, part = tid & 3;
      int lst[16], lsb[16];
      const float* srow = scores + row * 132 + part * 32;
#pragma unroll
      for (int k4 = 0; k4 < 4; ++k4) {
        const float4 v = *(const float4*)(srow + k4 * 4);
        const float4 u = *(const float4*)(srow + 16 + k4 * 4);
        const int kb = part * 32 + k4 * 4;
        lst[k4 * 4 + 0] = (f2sort(v.x) & ~0x7F) | (kb + 0);
        lst[k4 * 4 + 1] = (f2sort(v.y) & ~0x7F) | (kb + 1);
        lst[k4 * 4 + 2] = (f2sort(v.z) & ~0x7F) | (kb + 2);
        lst[k4 * 4 + 3] = (f2sort(v.w) & ~0x7F) | (kb + 3);
        lsb[k4 * 4 + 0] = (f2sort(u.x) & ~0x7F) | (kb + 16);
        lsb[k4 * 4 + 1] = (f2sort(u.y) & ~0x7F) | (kb + 17);
        lsb[k4 * 4 + 2] = (f2sort(u.z) & ~0x7F) | (kb + 18);
        lsb[k4 * 4 + 3] = (f2sort(u.w) & ~0x7F) | (kb + 19);
      }
      top16_of_32(lst, lsb);
      int mg[16];
#pragma unroll
      for (int i = 0; i < 16; ++i) mg[i] = max(lst[i], __shfl_xor(lst[15 - i], 1));
      bitonic_sort16_desc(mg);
#pragma unroll
      for (int i = 0; i < 16; ++i) lst[i] = max(mg[i], __shfl_xor(mg[15 - i], 2));
      bitonic_sort16_desc(lst);
      if (part == 0) {
#pragma unroll
        for (int j4 = 0; j4 < 4; ++j4) {
          int4 t; t.x = lst[j4 * 4]; t.y = lst[j4 * 4 + 1]; t.z = lst[j4 * 4 + 2]; t.w = lst[j4 * 4 + 3];
          *(int4*)(lists + row * 16 + j4 * 4) = t;
        }
      }
    }
    __syncthreads();
    int top[16];
#pragma unroll
    for (int j = 0; j < 16; ++j) top[j] = (int)0x80000000;
    const int tokl = tid & 63;
    if (tid < 128) {
      float v1[16], v2[16];
#pragma unroll
      for (int j4 = 0; j4 < 4; ++j4) {
        const int4 t1 = *(const int4*)(lists + tokl * 16 + j4 * 4);
        const int4 t2 = *(const int4*)(lists + (64 + tokl) * 16 + j4 * 4);
        v1[j4 * 4] = sort2f(t1.x & ~0x7F); v1[j4 * 4 + 1] = sort2f(t1.y & ~0x7F); v1[j4 * 4 + 2] = sort2f(t1.z & ~0x7F); v1[j4 * 4 + 3] = sort2f(t1.w & ~0x7F);
        v2[j4 * 4] = sort2f(t2.x & ~0x7F); v2[j4 * 4 + 1] = sort2f(t2.y & ~0x7F); v2[j4 * 4 + 2] = sort2f(t2.z & ~0x7F); v2[j4 * 4 + 3] = sort2f(t2.w & ~0x7F);
      }
      if (tid < 64) {
        route_cands<AM0>(top, v1, v2);
      } else {
        route_cands<(~AM0) & 0xFFFFu>(top, v1, v2);
#pragma unroll
        for (int j4 = 0; j4 < 4; ++j4) {
          int4 t; t.x = top[j4 * 4]; t.y = top[j4 * 4 + 1]; t.z = top[j4 * 4 + 2]; t.w = top[j4 * 4 + 3];
          *(int4*)(tops + tokl * 16 + j4 * 4) = t;
        }
      }
    }
    __syncthreads();
    if (tid < 64) {
      int fin[16];
#pragma unroll
      for (int j4 = 0; j4 < 4; ++j4) {
        const int4 t = *(const int4*)(tops + tid * 16 + (3 - j4) * 4);
        fin[j4 * 4 + 0] = max(top[j4 * 4 + 0], t.w);
        fin[j4 * 4 + 1] = max(top[j4 * 4 + 1], t.z);
        fin[j4 * 4 + 2] = max(top[j4 * 4 + 2], t.y);
        fin[j4 * 4 + 3] = max(top[j4 * 4 + 3], t.x);
      }
      int ex[16];
      float val[16];
      float mxv = -3.0e38f;
#pragma unroll
      for (int j = 0; j < 16; ++j) {
        const int code = fin[j] & 0xFF;
        const int i1 = lists[tid * 16 + (code >> 4)] & 0x7F;
        const int i2 = lists[(64 + tid) * 16 + (code & 15)] & 0x7F;
        ex[j] = i1 * 128 + i2;
        val[j] = sort2f(fin[j] & ~0xFF);
        mxv = fmaxf(mxv, val[j]);
      }
      float sum = 0.f;
      float ev[16];
#pragma unroll
      for (int j = 0; j < 16; ++j) { ev[j] = __expf(val[j] - mxv); sum += ev[j]; }
      const float inv = 1.f / sum;
      const size_t ob = (size_t)(tok0 + tid) * 128 + h * 16;
#pragma unroll
      for (int j4 = 0; j4 < 4; ++j4) {
        int4 iv; iv.x = ex[j4 * 4]; iv.y = ex[j4 * 4 + 1]; iv.z = ex[j4 * 4 + 2]; iv.w = ex[j4 * 4 + 3];
        float4 gv; gv.x = ev[j4 * 4] * inv; gv.y = ev[j4 * 4 + 1] * inv; gv.z = ev[j4 * 4 + 2] * inv; gv.w = ev[j4 * 4 + 3] * inv;
        *(int4*)(p.idx + ob + j4 * 4) = iv;
        *(float4*)(p.gates + ob + j4 * 4) = gv;
      }
    }
  }
}

DI float gelu_tanh(float a) {
  const float u = 0.7978845608028654f * (a + 0.044715f * a * a * a);
  return 0.5f * a * (1.f + tanhf(u));
}

#define SB() __builtin_amdgcn_sched_barrier(0)
DI void peer_load8u(u32x4 (&bufa)[8], const unsigned char* tbl, int idxv, int g, int lane) {
#pragma unroll
  for (int k = 0; k < 8; ++k) {
    const int e = __builtin_amdgcn_readlane(idxv, g * 8 + k);
    bufa[k] = *(const u32x4*)(tbl + (size_t)e * 1024 + lane * 16);
  }
}
DI float peer_dot8(const u32x4 (&bufa)[8], const f32x2 (&hp)[16], int lane) {
  float part[8];
#pragma unroll
  for (int k = 0; k < 8; ++k) {
    const u32x4 u = bufa[k];
    f32x2 a2 = f32x2{0.f, 0.f};
#pragma unroll
    for (int c = 0; c < 4; ++c) {
      const unsigned uu = u[c];
      a2 += __builtin_amdgcn_cvt_scalef32_pk_f32_fp4(uu, 1.0f, 0) * hp[c * 4 + 0];
      a2 += __builtin_amdgcn_cvt_scalef32_pk_f32_fp4(uu, 1.0f, 1) * hp[c * 4 + 1];
      a2 += __builtin_amdgcn_cvt_scalef32_pk_f32_fp4(uu, 1.0f, 2) * hp[c * 4 + 2];
      a2 += __builtin_amdgcn_cvt_scalef32_pk_f32_fp4(uu, 1.0f, 3) * hp[c * 4 + 3];
    }
    part[k] = a2[0] + a2[1];
  }
  const bool up4 = (lane & 4) != 0, up2 = (lane & 2) != 0, up1 = (lane & 1) != 0;
  float q[4];
#pragma unroll
  for (int i = 0; i < 4; ++i) {
    const float keep = up4 ? part[i + 4] : part[i];
    const float send = up4 ? part[i] : part[i + 4];
    q[i] = keep + __shfl_xor(send, 4);
  }
  float r[2];
#pragma unroll
  for (int i = 0; i < 2; ++i) {
    const float keep = up2 ? q[i + 2] : q[i];
    const float send = up2 ? q[i] : q[i + 2];
    r[i] = keep + __shfl_xor(send, 2);
  }
  float v = (up1 ? r[1] : r[0]) + __shfl_xor(up1 ? r[0] : r[1], 1);
  v += __shfl_xor(v, 8);
  v += __shfl_xor(v, 16);
  v += __shfl_xor(v, 32);
  return v;
}
DI void peer_acc8(const u32x4 (&bufa)[8], f32x2 (&ys)[16], float cval, int g) {
#pragma unroll
  for (int k = 0; k < 8; ++k) {
    const float ck = __builtin_bit_cast(float, __builtin_amdgcn_readlane(__builtin_bit_cast(int, cval), g * 8 + k));
    const u32x4 u = bufa[k];
#pragma unroll
    for (int c = 0; c < 4; ++c) {
      const unsigned uu = u[c];
      ys[c * 4 + 0] += __builtin_amdgcn_cvt_scalef32_pk_f32_fp4(uu, 1.0f, 0) * ck;
      ys[c * 4 + 1] += __builtin_amdgcn_cvt_scalef32_pk_f32_fp4(uu, 1.0f, 1) * ck;
      ys[c * 4 + 2] += __builtin_amdgcn_cvt_scalef32_pk_f32_fp4(uu, 1.0f, 2) * ck;
      ys[c * 4 + 3] += __builtin_amdgcn_cvt_scalef32_pk_f32_fp4(uu, 1.0f, 3) * ck;
    }
  }
}

DI void phase_peer_expert(const Params& p) {
  const int lane = threadIdx.x & 63, wid = threadIdx.x >> 6;
  bool flag4;
  {
    float c1 = 1.0f, c2 = 2.0f;
    asm volatile("" : "+v"(c1), "+v"(c2));
    const unsigned w4 = __builtin_amdgcn_cvt_scalef32_pk_fp4_f32(0u, c1, c2, 1.0f, 0);
    const f32x2 r4 = __builtin_amdgcn_cvt_scalef32_pk_f32_fp4(w4, 1.0f, 0);
    flag4 = (r4[0] == 2.0f);
  }
  const int tstride = gridDim.x * 8;
  int myidx[2] = {0, 0};
  float mygate[2] = {0.f, 0.f};
  u32x4 bufAa[8], bufBa[8];
  {
    const int tok0 = blockIdx.x * 8 + wid;
    if (tok0 < T_TOK) {
#pragma unroll
      for (int half = 0; half < 2; ++half) {
        myidx[half] = p.idx[(size_t)tok0 * 128 + half * 64 + lane];
        mygate[half] = p.gates[(size_t)tok0 * 128 + half * 64 + lane];
      }
      peer_load8u(bufAa, p.wU8, myidx[0], 0, lane);
    }
  }
  for (int tok = blockIdx.x * 8 + wid; tok < T_TOK; tok += tstride) {
    const int ntok = (tok + tstride < T_TOK) ? tok + tstride : tok;
    int nxidx[2];
    float nxgate[2];
#pragma unroll
    for (int half = 0; half < 2; ++half) {
      nxidx[half] = p.idx[(size_t)ntok * 128 + half * 64 + lane];
      nxgate[half] = p.gates[(size_t)ntok * 128 + half * 64 + lane];
    }
    const float rs2 = rsqrtf(p.rowss2[tok] * (1.f / 2048.f) + 1e-6f);
    f32x2 hs[16];
    {
      float he[32];
#pragma unroll
      for (int j = 0; j < 2; ++j)
#pragma unroll
        for (int q = 0; q < 2; ++q) {
          const u32x4 t = *(const u32x4*)(p.hbuf + (size_t)tok * 2048 + j * 1024 + lane * 16 + q * 8);
#pragma unroll
          for (int c = 0; c < 4; ++c) { const unsigned tt = t[c]; he[j * 16 + q * 8 + c * 2] = bflo(tt); he[j * 16 + q * 8 + c * 2 + 1] = bfhi(tt); }
        }
#pragma unroll
      for (int i = 0; i < 16; ++i) {
        const float n0 = he[2 * i], n1 = he[2 * i + 1];
        hs[i] = f32x2{flag4 ? n1 : n0, flag4 ? n0 : n1};
      }
    }
    f32x2 ys[16];
#pragma unroll
    for (int e = 0; e < 16; ++e) ys[e] = f32x2{0.f, 0.f};
#pragma unroll 1
    for (int half = 0; half < 2; ++half) {
      const int idxv = half ? myidx[1] : myidx[0];
      const float gate = half ? mygate[1] : mygate[0];
      const float mysu = p.su[idxv], mysv = p.sv[idxv];
      float amine = 0.f;
#pragma unroll 1
      for (int g2 = 0; g2 < 3; ++g2) {
        peer_load8u(bufBa, p.wU8, idxv, 2 * g2 + 1, lane);
        SB();
        { const float v = peer_dot8(bufAa, hs, lane); if ((lane >> 3) == 2 * g2) amine = v; }
        SB();
        peer_load8u(bufAa, p.wU8, idxv, 2 * g2 + 2, lane);
        SB();
        { const float v = peer_dot8(bufBa, hs, lane); if ((lane >> 3) == 2 * g2 + 1) amine = v; }
        SB();
      }
      {
        peer_load8u(bufBa, p.wU8, idxv, 7, lane);
        SB();
        { const float v = peer_dot8(bufAa, hs, lane); if ((lane >> 3) == 6) amine = v; }
        SB();
        peer_load8u(bufAa, p.wV8, idxv, 0, lane);
        SB();
        { const float v = peer_dot8(bufBa, hs, lane); if ((lane >> 3) == 7) amine = v; }
        SB();
      }
      const float cval = gate * gelu_tanh(amine * mysu * rs2) * mysv;
      const int nidx = half ? nxidx[0] : myidx[1];
#pragma unroll 1
      for (int g2 = 0; g2 < 3; ++g2) {
        peer_load8u(bufBa, p.wV8, idxv, 2 * g2 + 1, lane);
        SB();
        peer_acc8(bufAa, ys, cval, 2 * g2);
        SB();
        peer_load8u(bufAa, p.wV8, idxv, 2 * g2 + 2, lane);
        SB();
        peer_acc8(bufBa, ys, cval, 2 * g2 + 1);
        SB();
      }
      {
        peer_load8u(bufBa, p.wV8, idxv, 7, lane);
        SB();
        peer_acc8(bufAa, ys, cval, 6);
        SB();
        peer_load8u(bufAa, p.wU8, nidx, 0, lane);
        SB();
        peer_acc8(bufBa, ys, cval, 7);
        SB();
      }
    }
    float ss = 0.f;
#pragma unroll
    for (int i = 0; i < 16; ++i) { ys[i] += hs[i]; ss += ys[i][0] * ys[i][0] + ys[i][1] * ys[i][1]; }
    float ye[32];
#pragma unroll
    for (int i = 0; i < 16; ++i) {
      ye[2 * i] = flag4 ? ys[i][1] : ys[i][0];
      ye[2 * i + 1] = flag4 ? ys[i][0] : ys[i][1];
    }
    ss = wave_sum(ss);
    const float rs = rsqrtf(ss * (1.f / 2048.f) + 1e-6f);
#pragma unroll
    for (int j = 0; j < 2; ++j)
#pragma unroll
      for (int q = 0; q < 4; ++q) {
        const float4 gq = *(const float4*)(p.g_final + j * 1024 + lane * 16 + q * 4);
        const int b0 = j * 16 + q * 4;
        float4 o;
        o.x = ye[b0] * rs * gq.x; o.y = ye[b0 + 1] * rs * gq.y; o.z = ye[b0 + 2] * rs * gq.z; o.w = ye[b0 + 3] * rs * gq.w;
        *(float4*)(p.out + (size_t)tok * 2048 + j * 1024 + lane * 16 + q * 4) = o;
      }
    myidx[0] = nxidx[0]; myidx[1] = nxidx[1]; mygate[0] = nxgate[0]; mygate[1] = nxgate[1];
  }
}

#define XB_TMO      128
#define XB_XCNT(j)  (256  + 64 * (j))
#define XB_XSUB(j)  (1280 + 64 * (j))
#define XB_XGEN(j)  (2304 + 64 * (j))
#define XB_TOP      3328
#define XB_TOPGEN   3392
#define XCD_BAR_WORDS 3456
#define XB_SPIN_CAP (1u << 20)
DI unsigned xb_ld(unsigned* p)              { return __hip_atomic_load(p, __ATOMIC_RELAXED, __HIP_MEMORY_SCOPE_AGENT); }
DI unsigned xb_add(unsigned* p, unsigned v) { return __hip_atomic_fetch_add(p, v, __ATOMIC_RELAXED, __HIP_MEMORY_SCOPE_AGENT); }
DI unsigned xb_xcc_id() { return (unsigned)__builtin_amdgcn_s_getreg((3 << 11) | 20) & 0xFu; }
#define XB_SPIN(cond, bar) do { unsigned _sp = 0; while (cond) { __builtin_amdgcn_s_sleep(1); \
    if ((++_sp & 255u) == 0u) { if (xb_ld(&(bar)[XB_TMO])) break; if (_sp > XB_SPIN_CAP) { atomicAdd(&(bar)[XB_TMO], 1u); break; } } } } while (0)
struct XcdBarrier { unsigned* bar; unsigned x; volatile LAS unsigned* st; };
DI XcdBarrier xcd_barrier_post(unsigned* bar, volatile LAS unsigned* st) {
  XcdBarrier b; b.bar = bar; b.x = xb_xcc_id(); b.st = st;
  if (threadIdx.x == 0) (void)xb_add(&bar[XB_XCNT(b.x)], 1u);
  return b;
}
DI void xcd_barrier_complete(unsigned* bar, unsigned x, unsigned& nloc, unsigned& nx) {
  const unsigned G = gridDim.x * gridDim.y * gridDim.z;
  unsigned sum, cnt, mine, sp = 0u;
  for (;;) {
    sum = 0u; cnt = 0u; mine = 0u;
#pragma unroll
    for (unsigned j = 0; j < 16; ++j) { const unsigned c = xb_ld(&bar[XB_XCNT(j)]); sum += c; cnt += (c > 0u) ? 1u : 0u; mine = (j == x) ? c : mine; }
    if (sum == G) break;
    __builtin_amdgcn_s_sleep(1);
    if ((++sp & 255u) == 0u) { if (xb_ld(&bar[XB_TMO])) break; if (sp > XB_SPIN_CAP) { atomicAdd(&bar[XB_TMO], 1u); break; } }
  }
  nloc = mine > 0u ? mine : 1u; nx = cnt > 0u ? cnt : 1u;
}
DI void xcd_barrier(const XcdBarrier& b) {
  asm volatile("s_waitcnt vmcnt(0)" ::: "memory");
  __syncthreads();
  if (threadIdx.x == 0) {
    unsigned* bar = b.bar;
    __builtin_amdgcn_s_waitcnt(0);
    unsigned nloc = b.st[0], nx = b.st[1];
    if (nloc == 0u) { xcd_barrier_complete(bar, b.x, nloc, nx); b.st[0] = nloc; b.st[1] = nx; }
    const unsigned old = xb_add(&bar[XB_XSUB(b.x)], 1u);
    const unsigned gen = old / nloc;
    if (old + 1u == (gen + 1u) * nloc) {
      __builtin_amdgcn_fence(__ATOMIC_RELEASE, "agent");
      asm volatile("s_waitcnt vmcnt(0)" ::: "memory");
      const unsigned og = xb_add(&bar[XB_TOP], 1u);
      const unsigned tg = og / nx;
      if (og + 1u == (tg + 1u) * nx) xb_add(&bar[XB_TOPGEN], 1u);
      else XB_SPIN(xb_ld(&bar[XB_TOPGEN]) == tg, bar);
      __builtin_amdgcn_fence(__ATOMIC_ACQUIRE, "agent");
      xb_add(&bar[XB_XGEN(b.x)], 1u);
      asm volatile("s_waitcnt vmcnt(0)" ::: "memory");
    } else {
      XB_SPIN(xb_ld(&bar[XB_XGEN(b.x)]) == gen, bar);
      __builtin_amdgcn_fence(__ATOMIC_ACQUIRE, "agent");
      asm volatile("s_waitcnt vmcnt(0)" ::: "memory");
    }
  }
  __syncthreads();
}

__global__ void __launch_bounds__(NTHREADS) mega(Params p, int phase_lo, int phase_hi) {
  __shared__ __attribute__((aligned(16))) char smem[SMEM_BYTES];
  cg::grid_group grid = cg::this_grid();
  volatile LAS unsigned* xst = (volatile LAS unsigned*)(smem + SMEM_BYTES - 16);
  if (threadIdx.x == 0) { xst[0] = 0u; xst[1] = 0u; }
  __syncthreads();
  const XcdBarrier xbar = xcd_barrier_post(p.bar + 64, xst);
  if (phase_hi > 1000) grid.sync();
#define PHASE(k, call) if (phase_lo <= (k) && (k) < phase_hi) { if ((k) > phase_lo) { xcd_barrier(xbar); } call; if ((DUP_MASK >> (k)) & 1) { xcd_barrier(xbar); call; } }
  PHASE(0, phase_prep(p, smem))
  PHASE(1, phase_inproj(p, smem))
  PHASE(2, phase_mix_attn(p, smem))
  PHASE(3, phase_pool_combine(p, smem))
  PHASE(4, phase_gemm_resid<false>(p.hbuf, 2048, p.wOutT, 2048, p.x, p.x2b, p.rowss1, smem))
  PHASE(6, phase_cross_proj(p, smem))
  PHASE(7, phase_cross_attn(p, smem))
  PHASE(8, phase_gemm_resid<true>(p.oc, 512, p.wCoT, 512, p.x2b, p.hbuf, p.rowss2, smem))
  PHASE(10, phase_gemm_pq(p, smem))
  PHASE(11, phase_peer_route(p, smem))
  PHASE(12, phase_peer_expert(p))
}

extern "C" void kernel_launch(void* const* d_in, const int* in_sizes, int n_in, void* d_out, int out_size, void* d_ws,
                              size_t ws_size, hipStream_t stream) {
  Params p{};
  p.x = (const float*)d_in[0]; p.mem = (const float*)d_in[1]; p.pos = (const int*)d_in[2];
  p.g_mix = (const float*)d_in[3]; p.w_in = (const float*)d_in[4]; p.w_pool = (const float*)d_in[5];
  p.pool_scale = (const float*)d_in[6]; p.w_out = (const float*)d_in[7]; p.g_cross = (const float*)d_in[8];
  p.g_mem = (const float*)d_in[9]; p.w_cq = (const float*)d_in[10]; p.w_ck = (const float*)d_in[11];
  p.w_cv = (const float*)d_in[12]; p.w_co = (const float*)d_in[13]; p.g_ffn = (const float*)d_in[14];
  p.w_pq = (const float*)d_in[15]; p.sk1f = (const float*)d_in[16]; p.sk2f = (const float*)d_in[17];
  p.w_u = (const float*)d_in[18]; p.w_v = (const float*)d_in[19]; p.g_final = (const float*)d_in[20];
  p.out = (float*)d_out;
  char* ws = (char*)d_ws;
  size_t off = 0;
  auto take = [&](size_t bytes) { char* r = ws + off; off += (bytes + 255) & ~(size_t)255; return r; };
  const size_t MB = 1024 * 1024;
  p.wInT = (bfr*)take(16 * MB); p.wPoolT = (bfr*)take(512 * 1024); p.wOutT = (bfr*)take(8 * MB);
  p.wCqT = (bfr*)take(2 * MB); p.wCkT = (bfr*)take(2 * MB); p.wCvT = (bfr*)take(2 * MB); p.wCoT = (bfr*)take(2 * MB);
  p.wPqT = (bfr*)take(8 * MB); p.sk1 = (bfr*)take(32768); p.sk2 = (bfr*)take(32768);
  p.wU8 = (unsigned char*)take(32 * MB); p.wV8 = (unsigned char*)take(32 * MB);
  p.su = (float*)take(65536); p.sv = (float*)take(65536);
  p.memn = (bfr*)take(4 * MB); p.kc = (bfr*)take(1 * MB); p.vc = (bfr*)take(1 * MB);
  p.hbuf = (bfr*)take(64 * MB);
  p.bar = (unsigned*)take(256 + XCD_BAR_WORDS * 4);
  p.rowss1 = (float*)take(65536); p.rowss2 = (float*)take(65536);
  p.ropetab = (float*)take((size_t)T_TOK * 16 * 2 * 4);
  const size_t r2 = off;
  p.qbuf = (bfr*)take(32 * MB); p.kbuf = (bfr*)take(32 * MB); p.vbuf = (bfr*)take(32 * MB);
  p.pbuf = (bfr*)take(32 * MB); p.mixed = (bfr*)take(32 * MB); p.ob = (bfr*)take(96 * MB);
  p.lse = (float*)take((size_t)3 * T_TOK * 8 * 4);
  const size_t end1 = off;
  off = r2;
  p.xres = (float*)take(128 * MB); p.pq = (bfr*)take(64 * MB); p.x2b = p.pq; p.qc = (bfr*)take(16 * MB); p.oc = (bfr*)take(16 * MB);
  p.idx = (int*)take(8 * MB); p.gates = (float*)take(8 * MB);
  const size_t end2 = off;
  const size_t need = end1 > end2 ? end1 : end2;
  if (need > ws_size) { fprintf(stderr, "workspace too small: need %zu have %zu\n", need, ws_size); return; }

  static int grid_blocks = 0;
  if (!grid_blocks) {
    int dev = 0, cus = 0, per_cu = 0;
    hipGetDevice(&dev);
    hipDeviceGetAttribute(&cus, hipDeviceAttributeMultiprocessorCount, dev);
    hipOccupancyMaxActiveBlocksPerMultiprocessor(&per_cu, mega, NTHREADS, 0);
    if (per_cu < 1) per_cu = 1;
    if (per_cu > 1) per_cu = 1;
    grid_blocks = cus * per_cu;
  }
  hipMemsetAsync(p.bar, 0, 256 + XCD_BAR_WORDS * 4, stream);
#if MULTI_LAUNCH
  for (int ph = 0; ph < NPHASE; ++ph) hipLaunchKernelGGL(mega, dim3(grid_blocks), dim3(NTHREADS), 0, stream, p, ph, ph + 1);
#else
  int lo = 0, hi = NPHASE;
  void* args[] = {&p, &lo, &hi};
  hipError_t e = hipLaunchCooperativeKernel((void*)mega, dim3(grid_blocks), dim3(NTHREADS), args, 0, stream);
  if (e != hipSuccess) fprintf(stderr, "cooperative launch failed: %s (grid %d)\n", hipGetErrorString(e), grid_blocks);
#endif
}
```

```cpp
#include <hip/hip_runtime.h>
#include <hip/hip_cooperative_groups.h>
#include <stdint.h>
#include <stdio.h>
namespace cg = cooperative_groups;

#ifndef DUP_MASK
#define DUP_MASK 0
#endif
#ifndef MULTI_LAUNCH
#define MULTI_LAUNCH 0
#endif

#define DI __device__ __forceinline__
typedef unsigned short bfr;
using bf16x8 = __attribute__((ext_vector_type(8))) short;
using s16x4  = __attribute__((ext_vector_type(4))) short;
using f32x4  = __attribute__((ext_vector_type(4))) float;
using u32x4  = __attribute__((ext_vector_type(4))) unsigned;
using u32x2  = __attribute__((ext_vector_type(2))) unsigned;
using bf2    = __attribute__((ext_vector_type(2))) __bf16;
using f32x2  = __attribute__((ext_vector_type(2))) float;
using v6u    = __attribute__((ext_vector_type(6))) unsigned;
using v16f   = __attribute__((ext_vector_type(16))) float;
using v32f   = __attribute__((ext_vector_type(32))) float;

constexpr int T_TOK = 16384;
constexpr int NTHREADS = 512;
constexpr int SMEM_BYTES = 151552;
constexpr int NPHASE = 13;

struct Params {
  const float *x, *mem; const int* pos;
  const float *g_mix, *w_in, *w_pool, *pool_scale, *w_out, *g_cross, *g_mem, *w_cq, *w_ck, *w_cv, *w_co, *g_ffn, *w_pq,
              *sk1f, *sk2f, *w_u, *w_v, *g_final;
  float* out;
  bfr *wInT, *wPoolT, *wOutT, *wCqT, *wCkT, *wCvT, *wCoT, *wPqT, *sk1, *sk2;
  unsigned char *wU8, *wV8; float *su, *sv;
  bfr *hbuf, *memn, *kc, *vc;
  bfr *pbuf, *qbuf, *kbuf, *vbuf, *mixed, *ob; float* lse;
  float* xres; bfr *pq, *qc, *oc; int* idx; float* gates;
  unsigned* bar;
  float *rowss1, *rowss2; bfr* x2b;
  float* ropetab;
};

DI unsigned pack2(float a, float b) { bf2 p; p[0] = (__bf16)a; p[1] = (__bf16)b; return __builtin_bit_cast(unsigned, p); }
DI float bflo(unsigned u) { return __uint_as_float(u << 16); }
DI float bfhi(unsigned u) { return __uint_as_float(u & 0xffff0000u); }
DI float4 ldnt4(const float* p) { const f32x4 v = __builtin_nontemporal_load((const f32x4*)p); return make_float4(v[0], v[1], v[2], v[3]); }
DI float wave_sum(float v) {
#pragma unroll
  for (int o = 32; o >= 1; o >>= 1) v += __shfl_xor(v, o);
  return v;
}
DI f32x4 mfma16(bf16x8 a, bf16x8 b, f32x4 c) { return __builtin_amdgcn_mfma_f32_16x16x32_bf16(a, b, c, 0, 0, 0); }
DI s16x4 tr_read(const char* p) {
  return __builtin_amdgcn_ds_read_tr16_b64_v4i16((s16x4 __attribute__((address_space(3)))*)(p));
}


#define LAS __attribute__((address_space(3)))
namespace g8 {
constexpr int BM = 256, BK = 64, HALF = 128, HTB = HALF * BK * 2, NXCD = 8, WGM = 8;
DI int lds_byte(int r, int c) { const int st = (r >> 4) * 2 + (c >> 5), rr = r & 15, cc = c & 31, ob = rr * 64 + cc * 2; return st * 1024 + (ob ^ (((ob >> 9) & 1) << 5)); }
DI int perm32(int rho) { const int n = rho >> 4, i = rho & 15; return 8 * (i >> 2) + 4 * n + (i & 3); }
DI void stage_rc(int b, int& R, int& C) { const int st = b / 1024, sb = b % 1024, swz = sb ^ (((sb >> 9) & 1) << 5); R = (st >> 1) * 16 + swz / 64; C = (st & 1) * 32 + (swz % 64) / 2; }
struct Order {
  int nM, nN, nwg, G, c;
  DI void init(int M, int N, int G_, int c_) { nM = M / BM; nN = N / BM; nwg = nM * nN; G = G_; c = c_; }
  DI bool next(int i, int& pm, int& pn) const {
    const long L = (long)i * G + c; if (L >= nwg) return false;
    int wgid = (int)L; { const int q = nwg / NXCD, r = nwg % NXCD, xcd = wgid % NXCD, off = wgid / NXCD; wgid = (xcd < r ? xcd * (q + 1) : r * (q + 1) + (xcd - r) * q) + off; }
    const int nig = WGM * nN, gid = wgid / nig, fm = gid * WGM, gsz = (nM - fm) < WGM ? (nM - fm) : WGM;
    pm = fm + ((wgid % nig) % gsz); pn = (wgid % nig) / gsz; return true;
  }
};
}

template <class Epi>
DI void gemm8(LAS unsigned char* lds, const bfr* A, int lda, const bfr* Bt, int M, int N, int K, int G, int c, const Epi& E, int a_pn_bytes = 0) {
  using namespace g8;
  const int tid = threadIdx.x, wid = __builtin_amdgcn_readfirstlane(tid >> 6), lane = tid & 63, wr = wid >> 2, wc = wid & 3, fr = lane & 15, fq = lane >> 4;
  const int nt = K / BK;
  Order S; S.init(M, N, G, c);
  unsigned voffA[2], voffB[2];
#pragma unroll
  for (int i = 0; i < 2; ++i) { int R, C; stage_rc(tid * 16 + i * 8192, R, C); const int Rb = (R & ~31) + perm32(R & 31);
    voffA[i] = (unsigned)(R * lda + C) * 2u; voffB[i] = (unsigned)(Rb * K + C) * 2u; }
  const size_t kstep = (size_t)(BK * 2);
  const size_t hstepA = (size_t)HALF * lda * 2, hstepB = (size_t)HALF * K * 2;
  const size_t tstepA = 2 * hstepA, tstepB = 2 * hstepB;
  const unsigned ldsw = (unsigned)wid * 1024u;
  const int aoff = lds_byte(wr * 64 + fr, fq * 8), boff = lds_byte(wc * 32 + fr, fq * 8);
#define G8_SA(b, h) (((b) * 2 + (h)) * HTB)
#define G8_SB(b, h) ((4 + (b) * 2 + (h)) * HTB)
#define G8_STAGE(bufoff, gbase, voff) do { _Pragma("unroll") for (int _i = 0; _i < 2; ++_i) \
    __builtin_amdgcn_global_load_lds((const unsigned*)((const char*)(gbase) + (voff)[_i]), (LAS unsigned*)(lds + (bufoff) + ldsw + _i * 8192), 16, 0, 0); } while (0)
#define G8_LDA(dst, b, h) do { _Pragma("unroll") for (int m = 0; m < 4; ++m) _Pragma("unroll") for (int k = 0; k < 2; ++k) dst[m][k] = *(const LAS bf16x8*)(lds + G8_SA(b, h) + aoff + m * 2048 + k * 1024); } while (0)
#define G8_LDB(dst, b, h) do { _Pragma("unroll") for (int n = 0; n < 2; ++n) _Pragma("unroll") for (int k = 0; k < 2; ++k) dst[n][k] = *(const LAS bf16x8*)(lds + G8_SB(b, h) + boff + n * 2048 + k * 1024); } while (0)
#define G8_MMA(ai, bj, At, Btf) do { __builtin_amdgcn_s_setprio(1); _Pragma("unroll") for (int m = 0; m < 4; ++m) _Pragma("unroll") for (int n = 0; n < 2; ++n) _Pragma("unroll") for (int k = 0; k < 2; ++k) \
    acc[ai][bj][m][n] = __builtin_amdgcn_mfma_f32_16x16x32_bf16(Btf[n][k], At[m][k], acc[ai][bj][m][n], 0, 0, 0); __builtin_amdgcn_s_setprio(0); } while (0)
#define G8_WAIT_V(n) asm volatile("s_waitcnt vmcnt(" #n ")" ::: "memory")
#define G8_WAIT_L(n) asm volatile("s_waitcnt lgkmcnt(" #n ")" ::: "memory")
#define G8_BAR __builtin_amdgcn_s_barrier()
#define G8_SCHED __builtin_amdgcn_sched_barrier(0)
  int cpm, cpn, npm = 0, npn = 0, ui = 0;
  if (!S.next(0, cpm, cpn)) return;
  f32x4 acc[2][2][4][2];
#pragma unroll
  for (int a = 0; a < 2; ++a)
#pragma unroll
    for (int b = 0; b < 2; ++b)
#pragma unroll
      for (int m = 0; m < 4; ++m)
#pragma unroll
        for (int n = 0; n < 2; ++n) acc[a][b][m][n] = f32x4{0.f, 0.f, 0.f, 0.f};
  bf16x8 At[4][2], B0[2][2], B1[2][2];
  const char* cA = (const char*)A + (size_t)cpm * tstepA + (size_t)cpn * a_pn_bytes; const char* cB = (const char*)Bt + (size_t)cpn * tstepB;
  G8_STAGE(G8_SB(0, 0), cB, voffB); G8_STAGE(G8_SA(0, 0), cA, voffA); G8_STAGE(G8_SB(0, 1), cB + hstepB, voffB); G8_STAGE(G8_SA(0, 1), cA + hstepA, voffA);
  if (wr == 1) G8_BAR;
  G8_WAIT_V(4); G8_BAR;
  G8_STAGE(G8_SB(1, 0), cB + kstep, voffB); G8_STAGE(G8_SA(1, 0), cA + kstep, voffA); G8_STAGE(G8_SB(1, 1), cB + hstepB + kstep, voffB);
  G8_WAIT_V(6); G8_BAR;
  for (;;) {
    const bool has_next = S.next(ui + 1, npm, npn);
    const char* nA = has_next ? (const char*)A + (size_t)npm * tstepA + (size_t)npn * a_pn_bytes : cA; const char* nB = has_next ? (const char*)Bt + (size_t)npn * tstepB : cB;
    for (int t = 0; t < nt; t += 2) {
      const bool last = (t == nt - 2);
      const char* a1 = cA + (size_t)(t + 1) * kstep;
      const char* a2 = last ? nA : cA + (size_t)(t + 2) * kstep; const char* b2 = last ? nB : cB + (size_t)(t + 2) * kstep;
      const char* a3 = a2 + kstep; const char* b3 = b2 + kstep;
      G8_LDB(B0, 0, 0); G8_SCHED; G8_LDA(At, 0, 0); G8_STAGE(G8_SA(1, 1), a1 + hstepA, voffA);
      G8_WAIT_L(8); G8_BAR; G8_WAIT_L(0); G8_MMA(0, 0, At, B0); G8_BAR; G8_SCHED;
      G8_LDB(B1, 0, 1); G8_STAGE(G8_SB(0, 0), b2, voffB);
      G8_BAR; G8_WAIT_L(0); G8_MMA(0, 1, At, B1); G8_BAR;
      G8_LDA(At, 0, 1); G8_STAGE(G8_SA(0, 0), a2, voffA);
      G8_BAR; G8_WAIT_L(0); G8_MMA(1, 0, At, B0); G8_BAR; G8_SCHED;
      G8_STAGE(G8_SB(0, 1), b2 + hstepB, voffB);
      G8_WAIT_V(6); G8_BAR; G8_MMA(1, 1, At, B1); G8_BAR;
      G8_LDB(B0, 1, 0); G8_SCHED; G8_LDA(At, 1, 0); G8_STAGE(G8_SA(0, 1), a2 + hstepA, voffA);
      G8_WAIT_L(8); G8_BAR; G8_WAIT_L(0); G8_MMA(0, 0, At, B0); G8_BAR; G8_SCHED;
      G8_LDB(B1, 1, 1); G8_STAGE(G8_SB(1, 0), b3, voffB);
      G8_BAR; G8_WAIT_L(0); G8_MMA(0, 1, At, B1); G8_BAR;
      G8_LDA(At, 1, 1); G8_STAGE(G8_SA(1, 0), a3, voffA);
      G8_BAR; G8_WAIT_L(0); G8_MMA(1, 0, At, B0); G8_BAR; G8_SCHED;
      G8_STAGE(G8_SB(1, 1), b3 + hstepB, voffB);
      G8_WAIT_V(6); G8_BAR; G8_MMA(1, 1, At, B1); G8_BAR;
    }
    E(acc, cpm, cpn, wr, wc, fr, fq);
    if (!has_next) break;
#pragma unroll
    for (int a = 0; a < 2; ++a)
#pragma unroll
      for (int b = 0; b < 2; ++b)
#pragma unroll
        for (int m = 0; m < 4; ++m)
#pragma unroll
          for (int n = 0; n < 2; ++n) acc[a][b][m][n] = f32x4{0.f, 0.f, 0.f, 0.f};
    cpm = npm; cpn = npn; cA = nA; cB = nB; ++ui;
  }
  G8_WAIT_V(0);
  if (wr == 0) G8_BAR;
  G8_BAR;
#undef G8_SA
#undef G8_SB
#undef G8_STAGE
#undef G8_LDA
#undef G8_LDB
#undef G8_MMA
#undef G8_WAIT_V
#undef G8_WAIT_L
#undef G8_BAR
#undef G8_SCHED
}
#define G8_FOREACH8(acc, pm, pn, wr, wc, fr, fq, ai, bj, m, row, col) \
  _Pragma("unroll") for (int ai = 0; ai < 2; ++ai) _Pragma("unroll") for (int m = 0; m < 4; ++m) \
  _Pragma("unroll") for (int bj = 0; bj < 2; ++bj) \
    if (const int row = 256 * (pm) + 128 * ai + 64 * (wr) + 16 * m + (fr); true) if (const int col = 256 * (pn) + 128 * bj + 32 * (wc) + 8 * (fq); true)
DI u32x4 pack8(const f32x4 a, const f32x4 b, float sc) {
  return u32x4{pack2(a[0] * sc, a[1] * sc), pack2(a[2] * sc, a[3] * sc), pack2(b[0] * sc, b[1] * sc), pack2(b[2] * sc, b[3] * sc)};
}
typedef f32x4 Acc8[2][2][4][2];

struct NoHook { DI void operator()() const {} };
template <bool BANDED, class RowF, class MidF = NoHook>
DI void attn_compute(const bf16x8 (&qf)[4], int q0, int key0, char* smem, RowF rowptr, float& m_out, float& l_out, MidF mid = MidF()) {
  const int tid = threadIdx.x, lane = tid & 63, w = tid >> 6, fr = lane & 15, fq = lane >> 4;
  char* sK = smem;
  char* sV = smem + 65536;
  constexpr int NT = BANDED ? 10 : 16;
  const int t0 = BANDED ? (w & ~1) : 0;
  f32x4 s[NT];
#pragma unroll
  for (int j = 0; j < NT; ++j) {
    f32x4 a = f32x4{0.f, 0.f, 0.f, 0.f};
    const int key = (t0 + j) * 16 + fr;
#pragma unroll
    for (int kk = 0; kk < 4; ++kk) {
      const bf16x8 kf = *(const bf16x8*)(sK + key * 256 + (((kk * 4 + fq) ^ fr) << 4));
      a = mfma16(kf, qf[kk], a);
    }
    s[j] = a;
  }
  mid();
  const float L2E = 1.4426950408889634f;
  const float NINF = -__builtin_inff();
  float mx = NINF;
  const int lq = q0 + w * 16 + fr;
#pragma unroll
  for (int j = 0; j < NT; ++j)
#pragma unroll
    for (int i = 0; i < 4; ++i) {
      float v = s[j][i] * L2E;
      if (BANDED) {
        const int lk = key0 + (t0 + j) * 16 + fq * 4 + i;
        const int dist = lq - lk;
        const bool ok = (lk >= 0) && (dist >= 0) && (dist <= 128);
        v = ok ? v : NINF;
      }
      s[j][i] = v;
      mx = fmaxf(mx, v);
    }
  mx = fmaxf(mx, __shfl_xor(mx, 16));
  mx = fmaxf(mx, __shfl_xor(mx, 32));
  float l = 0.f;
#pragma unroll
  for (int j = 0; j < NT; ++j)
#pragma unroll
    for (int i = 0; i < 4; ++i) {
      const float p = __builtin_amdgcn_exp2f(s[j][i] - mx);
      s[j][i] = p;
      l += p;
    }
  l += __shfl_xor(l, 16);
  l += __shfl_xor(l, 32);
  bf16x8 pf[NT / 2];
#pragma unroll
  for (int c = 0; c < NT / 2; ++c) {
    u32x4 t;
    t[0] = pack2(s[2 * c][0], s[2 * c][1]);
    t[1] = pack2(s[2 * c][2], s[2 * c][3]);
    t[2] = pack2(s[2 * c + 1][0], s[2 * c + 1][1]);
    t[3] = pack2(s[2 * c + 1][2], s[2 * c + 1][3]);
    pf[c] = __builtin_bit_cast(bf16x8, t);
  }
  const int q4 = (lane & 15) >> 2, p4 = lane & 3;
  m_out = mx;
  l_out = l;
  const float il = 1.f / l;
  bfr* dst = rowptr(fr) + fq * 4;
#pragma unroll 2
  for (int dt = 0; dt < 8; ++dt) {
    f32x4 a = f32x4{0.f, 0.f, 0.f, 0.f};
#pragma unroll
    for (int c = 0; c < NT / 2; ++c) {
      const int kb = (t0 + 2 * c) * 16;
      const s16x4 lo = tr_read(sV + (kb + fq * 4 + q4) * 288 + (dt * 16 + p4 * 4) * 2);
      const s16x4 hi = tr_read(sV + (kb + 16 + fq * 4 + q4) * 288 + (dt * 16 + p4 * 4) * 2);
      const bf16x8 vf = __builtin_shufflevector(lo, hi, 0, 1, 2, 3, 4, 5, 6, 7);
      a = mfma16(vf, pf[c], a);
    }
    u32x2 v; v[0] = pack2(a[0] * il, a[1] * il); v[1] = pack2(a[2] * il, a[3] * il);
    *(u32x2*)(dst + dt * 16) = v;
  }
}

template <bool BANDED, class StoreF>
DI void attn_core(const bfr* __restrict__ Qb, int qstride, int q0, const bfr* __restrict__ Kb, const bfr* __restrict__ Vb,
                  int kvstride, int key0, char* smem, StoreF store, float& m_out, float& l_out) {
  const int tid = threadIdx.x, lane = tid & 63, w = tid >> 6, fr = lane & 15, fq = lane >> 4;
  char* sK = smem;
  char* sV = smem + 65536;
  __syncthreads();
#pragma unroll 1
  for (int rr = 0; rr < 2; ++rr) {
    u32x4 kr[4], vr[4];
#pragma unroll
    for (int i = 0; i < 4; ++i) {
      const int id = tid + (rr * 4 + i) * 512, key = id >> 4, c = id & 15, lk = key0 + key;
      const int lkc = lk < 0 ? 0 : lk;
      const unsigned msk = lk < 0 ? 0u : 0xffffffffu;
      kr[i] = *(const u32x4*)(Kb + (long)lkc * kvstride + c * 8);
      vr[i] = *(const u32x4*)(Vb + (long)lkc * kvstride + c * 8);
      kr[i] &= u32x4{msk, msk, msk, msk};
      vr[i] &= u32x4{msk, msk, msk, msk};
    }
#pragma unroll
    for (int i = 0; i < 4; ++i) {
      const int id = tid + (rr * 4 + i) * 512, key = id >> 4, c = id & 15;
      *(u32x4*)(sK + key * 256 + ((c ^ (key & 15)) << 4)) = kr[i];
      *(u32x4*)(sV + key * 288 + c * 16) = vr[i];
    }
  }
  bf16x8 qf[4];
  {
    const bfr* qrow = Qb + (long)(q0 + w * 16 + fr) * qstride;
#pragma unroll
    for (int kk = 0; kk < 4; ++kk) qf[kk] = *(const bf16x8*)(qrow + kk * 32 + fq * 8);
  }
  __syncthreads();
  attn_compute<BANDED>(qf, q0, key0, smem, store, m_out, l_out);
}

DI int f2sort(float f) { int b = __float_as_int(f); return b ^ ((b >> 31) & 0x7fffffff); }
DI float sort2f(int s) { int b = s ^ ((s >> 31) & 0x7fffffff); return __int_as_float(b); }
DI void topk_insert(int (&lst)[16], int key) {
#pragma unroll
  for (int j = 0; j < 16; ++j) {
    const int hi = max(lst[j], key);
    key = min(lst[j], key);
    lst[j] = hi;
  }
}

template <int O, int N>
DI void bfly(float (&p)[64], int lane) {
  const bool up = (lane & O) != 0;
#pragma unroll
  for (int i = 0; i < N / 2; ++i) {
    const float keep = up ? p[i + N / 2] : p[i];
    const float send = up ? p[i] : p[i + N / 2];
    p[i] = keep + __shfl_xor(send, O);
  }
  if constexpr (O > 1) bfly<O / 2, N / 2>(p, lane);
}

DI void rms_rows2_to_bf16(const float* __restrict__ x0, const float* __restrict__ x1, const float* __restrict__ g,
                          bfr* __restrict__ o0, bfr* __restrict__ o1, int lane) {
  float4 v0[8], v1[8];
#pragma unroll
  for (int j = 0; j < 8; ++j) v0[j] = ldnt4(x0 + j * 256 + lane * 4);
#pragma unroll
  for (int j = 0; j < 8; ++j) v1[j] = ldnt4(x1 + j * 256 + lane * 4);
  float s0 = 0.f, s1 = 0.f;
#pragma unroll
  for (int j = 0; j < 8; ++j) {
    s0 += v0[j].x * v0[j].x + v0[j].y * v0[j].y + v0[j].z * v0[j].z + v0[j].w * v0[j].w;
    s1 += v1[j].x * v1[j].x + v1[j].y * v1[j].y + v1[j].z * v1[j].z + v1[j].w * v1[j].w;
  }
  s0 = wave_sum(s0);
  s1 = wave_sum(s1);
  const float r0 = rsqrtf(s0 * (1.f / 2048.f) + 1e-6f), r1 = rsqrtf(s1 * (1.f / 2048.f) + 1e-6f);
#pragma unroll
  for (int j = 0; j < 8; ++j) {
    const float4 gg = *(const float4*)(g + j * 256 + lane * 4);
    u32x2 a, c;
    a[0] = pack2(v0[j].x * r0 * gg.x, v0[j].y * r0 * gg.y); a[1] = pack2(v0[j].z * r0 * gg.z, v0[j].w * r0 * gg.w);
    c[0] = pack2(v1[j].x * r1 * gg.x, v1[j].y * r1 * gg.y); c[1] = pack2(v1[j].z * r1 * gg.z, v1[j].w * r1 * gg.w);
    *(u32x2*)(o0 + j * 256 + lane * 4) = a;
    *(u32x2*)(o1 + j * 256 + lane * 4) = c;
  }
}

DI void convert_f32_bf16(const float* __restrict__ src, bfr* __restrict__ dst, long n8) {
  for (long i = (long)blockIdx.x * NTHREADS + threadIdx.x; i < n8; i += (long)gridDim.x * NTHREADS) {
    const float4 a = *(const float4*)(src + i * 8);
    const float4 b = *(const float4*)(src + i * 8 + 4);
    u32x4 o;
    o[0] = pack2(a.x, a.y); o[1] = pack2(a.z, a.w); o[2] = pack2(b.x, b.y); o[3] = pack2(b.z, b.w);
    *(u32x4*)(dst + i * 8) = o;
  }
}

DI void transpose_strip(const float* __restrict__ W, int K, int N, int k0, int n0, bfr* __restrict__ Wt, float* tile,
                        const float* colscale, const float* rowscale) {
  const int tid = threadIdx.x;
  __syncthreads();
  {
    const int c4 = tid & 63, r = tid >> 6;
    float4 v[8];
#pragma unroll
    for (int i = 0; i < 8; ++i) v[i] = ldnt4(W + (size_t)(k0 + r + 8 * i) * N + n0 + c4 * 4);
#pragma unroll
    for (int i = 0; i < 8; ++i) {
      float* t = tile + (r + 8 * i) * 257 + c4 * 4;
      t[0] = v[i].x; t[1] = v[i].y; t[2] = v[i].z; t[3] = v[i].w;
    }
  }
  __syncthreads();
#pragma unroll
  for (int j = 0; j < 4; ++j) {
    const int task = tid + 512 * j, n = task >> 3, kc = task & 7;
    const float csv = colscale ? colscale[n0 + n] : 1.0f;
    u32x4 o;
#pragma unroll
    for (int e = 0; e < 4; ++e) {
      const int k = kc * 8 + 2 * e;
      const float r0 = rowscale ? rowscale[k0 + k] : 1.0f, r1 = rowscale ? rowscale[k0 + k + 1] : 1.0f;
      o[e] = pack2(tile[k * 257 + n] * csv * r0, tile[(k + 1) * 257 + n] * csv * r1);
    }
    *(u32x4*)(Wt + (size_t)(n0 + n) * K + k0 + kc * 8) = o;
  }
}

template <bool isv>
DI void quant_rows_fp4(const Params& p, int worker, int nworkers, int lane) {
  const float* tbl = isv ? p.w_v : p.w_u;
  float* scl = isv ? p.sv : p.su;
  unsigned char* out8 = isv ? p.wV8 : p.wU8;
  float4 gg[8];
  if (!isv) {
#pragma unroll
    for (int j = 0; j < 2; ++j)
#pragma unroll
      for (int q = 0; q < 4; ++q) gg[j * 4 + q] = *(const float4*)(p.g_ffn + j * 1024 + lane * 16 + q * 4);
  }
  auto finish = [&](float4 (&v)[8], int rr) {
    float amax = 0.f;
#pragma unroll
    for (int i = 0; i < 8; ++i) {
      if (!isv) { v[i].x *= gg[i].x; v[i].y *= gg[i].y; v[i].z *= gg[i].z; v[i].w *= gg[i].w; }
      amax = fmaxf(amax, fmaxf(fmaxf(fabsf(v[i].x), fabsf(v[i].y)), fmaxf(fabsf(v[i].z), fabsf(v[i].w))));
    }
#pragma unroll
    for (int o = 32; o >= 1; o >>= 1) amax = fmaxf(amax, __shfl_xor(amax, o));
    const float inv = amax > 0.f ? 6.0f / amax : 0.f;
    if (lane == 0) scl[rr] = amax * (1.f / 6.0f);
    u32x4 o4;
#pragma unroll
    for (int c = 0; c < 4; ++c) {
      const float4 t0 = v[2 * c], t1 = v[2 * c + 1];
      unsigned w = 0;
      w = __builtin_amdgcn_cvt_scalef32_pk_fp4_f32(w, t0.x * inv, t0.y * inv, 1.0f, 0);
      w = __builtin_amdgcn_cvt_scalef32_pk_fp4_f32(w, t0.z * inv, t0.w * inv, 1.0f, 1);
      w = __builtin_amdgcn_cvt_scalef32_pk_fp4_f32(w, t1.x * inv, t1.y * inv, 1.0f, 2);
      w = __builtin_amdgcn_cvt_scalef32_pk_fp4_f32(w, t1.z * inv, t1.w * inv, 1.0f, 3);
      o4[c] = w;
    }
    *(u32x4*)(out8 + (size_t)rr * 1024 + lane * 16) = o4;
  };
  for (int rr = worker; rr < 16384; rr += 2 * nworkers) {
    const int rb = rr + nworkers;
    const bool hasb = rb < 16384;
    const float* s0 = tbl + (size_t)rr * 2048;
    const float* s1 = tbl + (size_t)(hasb ? rb : rr) * 2048;
    float4 va[8], vb[8];
#pragma unroll
    for (int j = 0; j < 2; ++j)
#pragma unroll
      for (int q = 0; q < 4; ++q) va[j * 4 + q] = ldnt4(s0 + j * 1024 + lane * 16 + q * 4);
#pragma unroll
    for (int j = 0; j < 2; ++j)
#pragma unroll
      for (int q = 0; q < 4; ++q) vb[j * 4 + q] = ldnt4(s1 + j * 1024 + lane * 16 + q * 4);
    finish(va, rr);
    if (hasb) finish(vb, rb);
  }
}

DI void phase_prep(const Params& p, char* smem) {
  const int lane = threadIdx.x & 63, wid = threadIdx.x >> 6;
  for (int r2 = blockIdx.x * 8 + wid; r2 < (T_TOK + 1024) / 2; r2 += gridDim.x * 8) {
    const int r = 2 * r2;
    if (r < T_TOK) rms_rows2_to_bf16(p.x + (size_t)r * 2048, p.x + (size_t)(r + 1) * 2048, p.g_mix, p.hbuf + (size_t)r * 2048, p.hbuf + (size_t)(r + 1) * 2048, lane);
    else rms_rows2_to_bf16(p.mem + (size_t)(r - T_TOK) * 2048, p.mem + (size_t)(r + 1 - T_TOK) * 2048, p.g_mem, p.memn + (size_t)(r - T_TOK) * 2048, p.memn + (size_t)(r + 1 - T_TOK) * 2048, lane);
  }
  float* tile = (float*)smem;
  for (int id0 = blockIdx.x; id0 < 1296; id0 += gridDim.x) {
    int id = id0;
    const float* W; bfr* Wt; int K, N; const float* cs = nullptr; const float* rsc = nullptr;
    if (id < 512) { W = p.w_in; Wt = p.wInT; K = 2048; N = 4096; }
    else if ((id -= 512) < 256) { W = p.w_out; Wt = p.wOutT; K = 2048; N = 2048; }
    else if ((id -= 256) < 256) { W = p.w_pq; Wt = p.wPqT; K = 2048; N = 2048; rsc = p.g_ffn; }
    else if ((id -= 256) < 64) { W = p.w_cq; Wt = p.wCqT; K = 2048; N = 512; rsc = p.g_cross; }
    else if ((id -= 64) < 64) { W = p.w_ck; Wt = p.wCkT; K = 2048; N = 512; }
    else if ((id -= 64) < 64) { W = p.w_cv; Wt = p.wCvT; K = 2048; N = 512; }
    else if ((id -= 64) < 64) { W = p.w_co; Wt = p.wCoT; K = 512; N = 2048; }
    else { id -= 64; const int g = id >> 2; id &= 3; W = p.w_pool + g * 65536; Wt = p.wPoolT + g * 65536; K = 256; N = 256; cs = p.pool_scale + g * 256; }
    const int ntn = N >> 8;
    const int kt = id / ntn, nt = id % ntn;
    transpose_strip(W, K, N, kt * 64, nt * 256, Wt, tile, cs, rsc);
  }
  for (int i = blockIdx.x * NTHREADS + threadIdx.x; i < T_TOK; i += gridDim.x * NTHREADS) { p.rowss1[i] = 0.f; p.rowss2[i] = 0.f; }
  for (int i = blockIdx.x * NTHREADS + threadIdx.x; i < T_TOK * 16; i += gridDim.x * NTHREADS) {
    const int j = i & 15;
    const float inv = exp2f(-(float)j * (18.931568569324174f / 16.0f));
    float sn, cs;
    sincosf((float)p.pos[i >> 4] * inv, &sn, &cs);
    *(float2*)(p.ropetab + (size_t)i * 2) = make_float2(cs, sn);
  }
  convert_f32_bf16(p.sk1f, p.sk1, 128 * 128 / 8);
  convert_f32_bf16(p.sk2f, p.sk2, 128 * 128 / 8);
  quant_rows_fp4<true>(p, blockIdx.x * 8 + wid, gridDim.x * 8, lane);
}

DI void phase_inproj(const Params& p, char* smem) {
  auto epi = [&](const Acc8& acc0, int pm, int pn, int wr, int wc, int fr, int fq) {
    const int region = pn >> 2;
    if (region == 0) {
      G8_FOREACH8(acc0, pm, pn, wr, wc, fr, fq, ai, bj, m, row, col) {
        *(u32x4*)(p.pbuf + (size_t)row * 1024 + col) = pack8(acc0[ai][bj][m][0], acc0[ai][bj][m][1], 1.0f);
      }
    } else {
      bfr* dst = (region == 1) ? p.qbuf : (region == 2 ? p.kbuf : p.vbuf);
      const float scale = (region == 1) ? 0.08838834764831845f : 1.0f;
      const bool rope = (region != 3) && (wc == 0);
#pragma unroll
      for (int ai = 0; ai < 2; ++ai)
#pragma unroll
        for (int m = 0; m < 4; ++m) {
          const int row = 256 * pm + 128 * ai + 64 * wr + 16 * m + fr;
          const int b = row >> 12, t = row & 4095;
          float sn[8], cs[8];
          if (rope) {
            const float4* tp = (const float4*)(p.ropetab + ((size_t)row * 16 + 8 * (fq & 1)) * 2);
#pragma unroll
            for (int e2 = 0; e2 < 4; ++e2) {
              const float4 t = tp[e2];
              cs[2 * e2] = t.x; sn[2 * e2] = t.y; cs[2 * e2 + 1] = t.z; sn[2 * e2 + 1] = t.w;
            }
          }
#pragma unroll
          for (int bj = 0; bj < 2; ++bj) {
            const int h = (pn & 3) * 2 + bj;
            f32x4 v0 = acc0[ai][bj][m][0], v1 = acc0[ai][bj][m][1];
            if (rope) {
#pragma unroll
              for (int i = 0; i < 4; ++i) {
                const float o0 = __shfl_xor(v0[i], 32), o1 = __shfl_xor(v1[i], 32);
                v0[i] = (fq < 2) ? v0[i] * cs[i] - o0 * sn[i] : v0[i] * cs[i] + o0 * sn[i];
                v1[i] = (fq < 2) ? v1[i] * cs[4 + i] - o1 * sn[4 + i] : v1[i] * cs[4 + i] + o1 * sn[4 + i];
              }
            }
            bfr* drow = dst + ((size_t)((b * 8 + h) * 4096 + t)) * 128 + 32 * wc + 8 * fq;
            *(u32x4*)(drow) = pack8(v0, v1, scale);
          }
        }
    }
  };
  gemm8((LAS unsigned char*)smem, p.hbuf, 2048, p.wInT, T_TOK, 4096, 2048, gridDim.x, blockIdx.x, epi);
}

DI void phase_mix_attn(const Params& p, char* smem) {
  const int tid = threadIdx.x, lane = tid & 63, w = tid >> 6, fr = lane & 15, fq = lane >> 4;
  {
    char* sK = smem;
    char* sV = smem + 65536;
    u32x4 kr[8], vr[8];
    bf16x8 qn[4];
    int pend_key0 = 0;
    auto decode = [&](int id, int& br, int& dl, int& bh, int& r, int& l0) {
      br = id >> 10;
      const int rem = id & 1023;
      dl = (br == 0) ? 1 : (br == 1 ? 4 : 16);
      const int nblk = 32 / dl;
      bh = rem >> 5;
      const int rn = rem & 31;
      r = rn / nblk;
      l0 = (rn % nblk) * 128;
    };
    auto issueK = [&](int id) {
      int br, dl, bh, r, l0;
      decode(id, br, dl, bh, r, l0);
      const size_t base = (size_t)bh * 4096 * 128 + (size_t)r * 128;
      const bfr* Kb = p.kbuf + base;
      const int kvstride = dl * 128, key0 = l0 - 128;
#pragma unroll
      for (int i = 0; i < 8; ++i) {
        const int e = tid + i * 512, key = e >> 4, c = e & 15, lk = key0 + key;
        const int lkc = lk < 0 ? 0 : lk;
        kr[i] = *(const u32x4*)(Kb + (long)lkc * kvstride + c * 8);
      }
      pend_key0 = key0;
    };
    auto issueVQ = [&](int id) {
      int br, dl, bh, r, l0;
      decode(id, br, dl, bh, r, l0);
      const size_t base = (size_t)bh * 4096 * 128 + (size_t)r * 128;
      const bfr* Vb = p.vbuf + base;
      const int kvstride = dl * 128, key0 = l0 - 128;
#pragma unroll
      for (int i = 0; i < 8; ++i) {
        const int e = tid + i * 512, key = e >> 4, c = e & 15, lk = key0 + key;
        const int lkc = lk < 0 ? 0 : lk;
        vr[i] = *(const u32x4*)(Vb + (long)lkc * kvstride + c * 8);
      }
      const bfr* qrow = p.qbuf + base + (long)(l0 + w * 16 + fr) * kvstride;
#pragma unroll
      for (int kk = 0; kk < 4; ++kk) qn[kk] = *(const bf16x8*)(qrow + kk * 32 + fq * 8);
    };
    const bool remap = (gridDim.x == 256);
    const int nround = remap ? 12 : (3072 + (int)gridDim.x - 1) / (int)gridDim.x;
    auto item_of = [&](int k) -> int {
      if (!remap) return k * (int)gridDim.x + (int)blockIdx.x;
      const int xcd = blockIdx.x & 7, slot = blockIdx.x >> 3;
      const int bh = (k / 3) * 8 + xcd, br = k % 3;
      return (br * 32 + bh) * 32 + slot;
    };
    if (item_of(0) < 3072) { issueK(item_of(0)); issueVQ(item_of(0)); }
    for (int k = 0; k < nround; ++k) {
      const int id = item_of(k);
      if (id >= 3072) break;
      __syncthreads();
#pragma unroll
      for (int i = 0; i < 8; ++i) {
        const int e = tid + i * 512, key = e >> 4, c = e & 15;
        const unsigned msk = (pend_key0 + key) < 0 ? 0u : 0xffffffffu;
        const u32x4 m4 = u32x4{msk, msk, msk, msk};
        *(u32x4*)(sK + key * 256 + ((c ^ (key & 15)) << 4)) = kr[i] & m4;
        *(u32x4*)(sV + key * 288 + c * 16) = vr[i] & m4;
      }
      bf16x8 qf[4];
#pragma unroll
      for (int kk = 0; kk < 4; ++kk) qf[kk] = qn[kk];
      __syncthreads();
      const int nid = (k + 1 < nround) ? item_of(k + 1) : 3072;
      if (nid < 3072) issueK(nid);
      int br, dl, bh, r, l0;
      decode(id, br, dl, bh, r, l0);
      float mx, l;
      const int b = bh >> 3, h = bh & 7;
      const int tt = b * 4096 + (l0 + w * 16 + fr) * dl + r;
      bfr* obase = p.ob + (size_t)br * T_TOK * 1024 + h * 128;
      const int tq0 = b * 4096 + r, lw = l0 + w * 16;
      attn_compute<true>(qf, l0, l0 - 128, smem,
                         [&](int q) { return obase + (size_t)(tq0 + (lw + q) * dl) * 1024; }, mx, l,
                         [&]() { if (nid < 3072) issueVQ(nid); });
      if (fq == 0) p.lse[(size_t)br * T_TOK * 8 + (size_t)tt * 8 + h] = mx + __builtin_amdgcn_logf(l);
    }
  }
  for (int id = 3072 + blockIdx.x; id < 3072 + 256; id += gridDim.x) {
    {
      const int ci = id - 3072;
      const int sub = tid >> 7, cgp = tid & 127;
      const int wdw = 2 << (cgp >> 5);
      const int t0 = ci * 64 + sub * 16, tin0 = t0 & 4095;
      const bfr* pb = p.pbuf + cgp * 8;
      float sum[8];
#pragma unroll
      for (int e = 0; e < 8; ++e) sum[e] = 0.f;
      u32x4 hv[15];
#pragma unroll
      for (int j = 1; j < 16; ++j) {
        const bool ok = (j < wdw) && (tin0 - j >= 0);
        const unsigned msk = ok ? 0xffffffffu : 0u;
        hv[j - 1] = *(const u32x4*)(pb + (size_t)(ok ? t0 - j : t0) * 1024) & u32x4{msk, msk, msk, msk};
      }
#pragma unroll
      for (int hb = 0; hb < 2; ++hb) {
        u32x4 cv[8], sv[8];
#pragma unroll
        for (int s2 = 0; s2 < 8; ++s2) {
          const int so = hb * 8 + s2;
          cv[s2] = *(const u32x4*)(pb + (size_t)(t0 + so) * 1024);
          const bool ok = (tin0 + so - wdw + 1 >= 0);
          const unsigned msk = ok ? 0xffffffffu : 0u;
          sv[s2] = *(const u32x4*)(pb + (size_t)(ok ? t0 + so - wdw + 1 : t0) * 1024) & u32x4{msk, msk, msk, msk};
        }
        if (hb == 0) {
#pragma unroll
          for (int j = 0; j < 15; ++j)
#pragma unroll
            for (int e = 0; e < 4; ++e) { sum[2 * e] += bflo(hv[j][e]); sum[2 * e + 1] += bfhi(hv[j][e]); }
        }
#pragma unroll
        for (int s2 = 0; s2 < 8; ++s2) {
          const int so = hb * 8 + s2, t = t0 + so, tin = tin0 + so;
          float cur[8];
#pragma unroll
          for (int e = 0; e < 4; ++e) { cur[2 * e] = bflo(cv[s2][e]); cur[2 * e + 1] = bfhi(cv[s2][e]); }
          const float ic = 1.f / (float)min(tin + 1, wdw);
          u32x4 ov;
#pragma unroll
          for (int e = 0; e < 8; ++e) sum[e] += cur[e];
#pragma unroll
          for (int e = 0; e < 4; ++e) ov[e] = pack2(sum[2 * e] * ic - cur[2 * e], sum[2 * e + 1] * ic - cur[2 * e + 1]);
          *(u32x4*)(p.mixed + (size_t)t * 1024 + cgp * 8) = ov;
#pragma unroll
          for (int e = 0; e < 4; ++e) { sum[2 * e] -= bflo(sv[s2][e]); sum[2 * e + 1] -= bfhi(sv[s2][e]); }
        }
      }
    }
  }
}

DI void phase_pool_combine(const Params& p, char* smem) {
  const int tid = threadIdx.x;
  {
    auto epi = [&](const Acc8& acc0, int pm, int pn, int wr, int wc, int fr, int fq) {
      G8_FOREACH8(acc0, pm, pn, wr, wc, fr, fq, ai, bj, m, row, col) {
        *(u32x4*)(p.hbuf + (size_t)row * 2048 + col) = pack8(acc0[ai][bj][m][0], acc0[ai][bj][m][1], 1.0f);
      }
    };
    gemm8((LAS unsigned char*)smem, p.mixed, 1024, p.wPoolT, T_TOK, 1024, 256, gridDim.x, blockIdx.x, epi, 512);
  }
  {
    const long total = (long)T_TOK * 8 * 16, stride = (long)gridDim.x * NTHREADS;
    for (long i0 = (long)blockIdx.x * NTHREADS + tid; i0 < total; i0 += 4 * stride) {
      float l0[4], l1[4], l2[4];
      u32x4 a[4], b[4], c[4];
      size_t dsto[4];
      bool ok[4];
#pragma unroll
      for (int u = 0; u < 4; ++u) {
        const long i = i0 + u * stride;
        ok[u] = i < total;
        const long ic = ok[u] ? i : i0;
        const int dc = (int)(ic & 15), h = (int)((ic >> 4) & 7);
        const long tt = ic >> 7;
        l0[u] = p.lse[tt * 8 + h]; l1[u] = p.lse[(size_t)T_TOK * 8 + tt * 8 + h]; l2[u] = p.lse[(size_t)2 * T_TOK * 8 + tt * 8 + h];
        const size_t off = (size_t)tt * 1024 + h * 128 + dc * 8;
        a[u] = *(const u32x4*)(p.ob + off);
        b[u] = *(const u32x4*)(p.ob + (size_t)T_TOK * 1024 + off);
        c[u] = *(const u32x4*)(p.ob + (size_t)2 * T_TOK * 1024 + off);
        dsto[u] = (size_t)tt * 2048 + 1024 + h * 128 + dc * 8;
      }
#pragma unroll
      for (int u = 0; u < 4; ++u) {
        const float mx = fmaxf(l0[u], fmaxf(l1[u], l2[u]));
        float w0 = __builtin_amdgcn_exp2f(l0[u] - mx), w1 = __builtin_amdgcn_exp2f(l1[u] - mx), w2 = __builtin_amdgcn_exp2f(l2[u] - mx);
        const float inv = 1.f / (w0 + w1 + w2);
        w0 *= inv; w1 *= inv; w2 *= inv;
        u32x4 o;
#pragma unroll
        for (int e = 0; e < 4; ++e)
          o[e] = pack2(w0 * bflo(a[u][e]) + w1 * bflo(b[u][e]) + w2 * bflo(c[u][e]), w0 * bfhi(a[u][e]) + w1 * bfhi(b[u][e]) + w2 * bfhi(c[u][e]));
        if (ok[u]) *(u32x4*)(p.hbuf + dsto[u]) = o;
      }
    }
  }
}

template <bool RESID_BF16>
DI void phase_gemm_resid(const bfr* A, int lda, const bfr* Bt, int K, const void* resid, bfr* xb, float* rowss, char* smem) {
  auto epi = [&](const Acc8& acc0, int pm, int pn, int wr, int wc, int fr, int fq) {
#pragma unroll
    for (int ai = 0; ai < 2; ++ai)
#pragma unroll
      for (int m = 0; m < 4; ++m) {
        const int row = 256 * pm + 128 * ai + 64 * wr + 16 * m + fr;
        float ss = 0.f;
#pragma unroll
        for (int bj = 0; bj < 2; ++bj) {
          const int col = 256 * pn + 128 * bj + 32 * wc + 8 * fq;
          const f32x4 v0 = acc0[ai][bj][m][0], v1 = acc0[ai][bj][m][1];
          float r[8];
          if (RESID_BF16) {
            const u32x4 t = *(const u32x4*)((const bfr*)resid + (size_t)row * 2048 + col);
#pragma unroll
            for (int e = 0; e < 4; ++e) { r[2 * e] = bflo(t[e]); r[2 * e + 1] = bfhi(t[e]); }
          } else {
            const float4 t0 = *(const float4*)((const float*)resid + (size_t)row * 2048 + col);
            const float4 t1 = *(const float4*)((const float*)resid + (size_t)row * 2048 + col + 4);
            r[0] = t0.x; r[1] = t0.y; r[2] = t0.z; r[3] = t0.w; r[4] = t1.x; r[5] = t1.y; r[6] = t1.z; r[7] = t1.w;
          }
          f32x4 o0, o1;
#pragma unroll
          for (int e = 0; e < 4; ++e) { o0[e] = r[e] + v0[e]; o1[e] = r[4 + e] + v1[e]; ss += o0[e] * o0[e] + o1[e] * o1[e]; }
          *(u32x4*)(xb + (size_t)row * 2048 + col) = pack8(o0, o1, 1.0f);
        }
        ss += __shfl_xor(ss, 16);
        ss += __shfl_xor(ss, 32);
        if (fq == 0) atomicAdd(rowss + row, ss);
      }
  };
  gemm8((LAS unsigned char*)smem, A, lda, Bt, T_TOK, 2048, K, gridDim.x, blockIdx.x, epi);
}

DI void phase_gemm_pq(const Params& p, char* smem) {
  auto epi = [&](const Acc8& acc0, int pm, int pn, int wr, int wc, int fr, int fq) {
    G8_FOREACH8(acc0, pm, pn, wr, wc, fr, fq, ai, bj, m, row, col) {
      const float rs = rsqrtf(p.rowss2[row] * (1.f / 2048.f) + 1e-6f);
      *(u32x4*)(p.pq + (size_t)row * 2048 + col) = pack8(acc0[ai][bj][m][0], acc0[ai][bj][m][1], rs);
    }
  };
  gemm8((LAS unsigned char*)smem, p.hbuf, 2048, p.wPqT, T_TOK, 2048, 2048, gridDim.x, blockIdx.x, epi);
}
DI void phase_cross_proj(const Params& p, char* smem) {
  const int half = gridDim.x >> 1;
  if ((int)blockIdx.x < half) {
    auto epi = [&](const Acc8& acc0, int pm, int pn, int wr, int wc, int fr, int fq) {
      G8_FOREACH8(acc0, pm, pn, wr, wc, fr, fq, ai, bj, m, row, col) {
        const float scale = 0.08838834764831845f * rsqrtf(p.rowss1[row] * (1.f / 2048.f) + 1e-6f);
        *(u32x4*)(p.qc + (size_t)row * 512 + col) = pack8(acc0[ai][bj][m][0], acc0[ai][bj][m][1], scale);
      }
    };
    gemm8((LAS unsigned char*)smem, p.x2b, 2048, p.wCqT, T_TOK, 512, 2048, half, blockIdx.x, epi);
  } else if ((int)blockIdx.x < half + 16) {
    auto epi = [&](const Acc8& acc0, int pm, int pn, int wr, int wc, int fr, int fq) {
      G8_FOREACH8(acc0, pm, pn, wr, wc, fr, fq, ai, bj, m, row, col) {
        bfr* dst = (col < 512) ? p.kc : p.vc;
        const int cc = col & 511, hh = cc >> 7, d = cc & 127, bb = row >> 8, mm = row & 255;
        *(u32x4*)(dst + ((size_t)((bb * 4 + hh) * 256 + mm)) * 128 + d) = pack8(acc0[ai][bj][m][0], acc0[ai][bj][m][1], 1.0f);
      }
    };
    gemm8((LAS unsigned char*)smem, p.memn, 2048, p.wCkT, 1024, 1024, 2048, 16, blockIdx.x - half, epi);
  } else {
    const int nidle = gridDim.x - (half + 16);
    quant_rows_fp4<false>(p, (blockIdx.x - (half + 16)) * 8 + (threadIdx.x >> 6), nidle * 8, threadIdx.x & 63);
  }
}

DI void phase_cross_attn(const Params& p, char* smem) {
  const int tid = threadIdx.x, lane = tid & 63, w = tid >> 6, fr = lane & 15, fq = lane >> 4;
  for (int id = blockIdx.x; id < 512; id += gridDim.x) {
    const int b = id >> 7, h = (id >> 5) & 3, qt = id & 31;
    float mx, l;
    const size_t kvb = (size_t)(b * 4 + h) * 256 * 128;
    bfr* obase = p.oc + (size_t)(b * 4096 + qt * 128 + w * 16) * 512 + h * 128;
    attn_core<false>(p.qc + (size_t)b * 4096 * 512 + h * 128, 512, qt * 128, p.kc + kvb, p.vc + kvb, 128, 0, smem,
                     [&](int q) { return obase + (size_t)q * 512; }, mx, l);
  }
}

DI void bitonic_sort16_desc(int (&mg)[16]);
DI void top16_of_32(int (&a)[16], int (&b)[16]);
template <unsigned AMASK>
DI void route_cands(int (&top)[16], const float (&v1)[16], const float (&v2)[16]) {
  int ca[16], cb[16];
#pragma unroll
  for (int j = 0; j < 16; ++j) { ca[j] = (int)0x80000000; cb[j] = (int)0x80000000; }
  int c = 0;
#pragma unroll
  for (int a = 0; a < 16; ++a)
#pragma unroll
    for (int b = 0; b < 16; ++b)
      if (((AMASK >> a) & 1u) && (a + 1) * (b + 1) <= 16) {
        const int key = (f2sort(v1[a] + v2[b]) & ~0xFF) | (a * 16 + b);
        if (c < 16) ca[c] = key; else cb[c - 16] = key;
        ++c;
      }
  top16_of_32(ca, cb);
#pragma unroll
  for (int j = 0; j < 16; ++j) top[j] = ca[j];
}
DI void bitonic_sort16_desc(int (&mg)[16]) {
#pragma unroll
  for (int st = 8; st >= 1; st >>= 1)
#pragma unroll
    for (int i = 0; i < 16; ++i)
      if ((i & st) == 0) { const int hi = max(mg[i], mg[i + st]), lo = min(mg[i], mg[i + st]); mg[i] = hi; mg[i + st] = lo; }
}

DI void sort16_desc(int (&x)[16]) {
#pragma unroll
  for (int k = 2; k <= 16; k <<= 1)
#pragma unroll
    for (int j = k >> 1; j > 0; j >>= 1)
#pragma unroll
      for (int i = 0; i < 16; ++i) {
        const int l = i ^ j;
        if (l > i) {
          const int hi = max(x[i], x[l]), lo = min(x[i], x[l]);
          const bool desc = ((i & k) == 0);
          x[i] = desc ? hi : lo;
          x[l] = desc ? lo : hi;
        }
      }
}
DI void top16_of_32(int (&a)[16], int (&b)[16]) {
  sort16_desc(a);
  sort16_desc(b);
#pragma unroll
  for (int i = 0; i < 16; ++i) a[i] = max(a[i], b[15 - i]);
  bitonic_sort16_desc(a);
}
DI void phase_peer_route(const Params& p, char* smem) {
  const int tid = threadIdx.x, lane = tid & 63, w = tid >> 6, fr = lane & 15, fq = lane >> 4;
  char* sSK = smem;
  float* scores = (float*)(smem + 65536);
  int* lists = (int*)(smem + 65536 + 67584);
  int* tops = (int*)(smem + 65536);
  constexpr unsigned AM0 = (1u << 0) | (1u << 3) | (1u << 5) | (1u << 8) | (1u << 9) | (1u << 10) | (1u << 11);
  __syncthreads();
#pragma unroll
  for (int i = 0; i < 8; ++i) {
    const int id = tid + i * 512, key = id >> 4, c = id & 15;
    const bfr* src = (key < 128 ? p.sk1 : p.sk2) + (key & 127) * 128 + c * 8;
    *(u32x4*)(sSK + key * 256 + ((c ^ (key & 15)) << 4)) = *(const u32x4*)src;
  }
  for (int id = blockIdx.x; id < 2048; id += gridDim.x) {
    const int tt = id >> 3, h = id & 7;
    const int tok0 = tt * 64;
    __syncthreads();
    {
      const int tg = w & 3, hf = w >> 2;
      const bfr* arow = p.pq + (size_t)(tok0 + tg * 16 + fr) * 2048 + h * 256 + hf * 128;
      bf16x8 af[4];
#pragma unroll
      for (int kk = 0; kk < 4; ++kk) af[kk] = *(const bf16x8*)(arow + kk * 32 + fq * 8);
#pragma unroll
      for (int nt = 0; nt < 8; ++nt) {
        f32x4 a = f32x4{0.f, 0.f, 0.f, 0.f};
        const int key = hf * 128 + nt * 16 + fr;
#pragma unroll
        for (int kk = 0; kk < 4; ++kk) {
          const bf16x8 bfg = *(const bf16x8*)(sSK + key * 256 + (((kk * 4 + fq) ^ fr) << 4));
          a = mfma16(af[kk], bfg, a);
        }
#pragma unroll
        for (int i = 0; i < 4; ++i) scores[(hf * 64 + tg * 16 + fq * 4 + i) * 132 + nt * 16 + fr] = a[i];
      }
    }
    __syncthreads();
    {
      const int row = tid >> 2, part = tid & 3;
      int lst[16], lsb[16];
      const float* srow = scores + row * 132 + part * 32;
#pragma unroll
      for (int k4 = 0; k4 < 4; ++k4) {
        const float4 v = *(const float4*)(srow + k4 * 4);
        const float4 u = *(const float4*)(srow + 16 + k4 * 4);
        const int kb = part * 32 + k4 * 4;
        lst[k4 * 4 + 0] = (f2sort(v.x) & ~0x7F) | (kb + 0);
        lst[k4 * 4 + 1] = (f2sort(v.y) & ~0x7F) | (kb + 1);
        lst[k4 * 4 + 2] = (f2sort(v.z) & ~0x7F) | (kb + 2);
        lst[k4 * 4 + 3] = (f2sort(v.w) & ~0x7F) | (kb + 3);
        lsb[k4 * 4 + 0] = (f2sort(u.x) & ~0x7F) | (kb + 16);
        lsb[k4 * 4 + 1] = (f2sort(u.y) & ~0x7F) | (kb + 17);
        lsb[k4 * 4 + 2] = (f2sort(u.z) & ~0x7F) | (kb + 18);
        lsb[k4 * 4 + 3] = (f2sort(u.w) & ~0x7F) | (kb + 19);
      }
      top16_of_32(lst, lsb);
      int mg[16];
#pragma unroll
      for (int i = 0; i < 16; ++i) mg[i] = max(lst[i], __shfl_xor(lst[15 - i], 1));
      bitonic_sort16_desc(mg);
#pragma unroll
      for (int i = 0; i < 16; ++i) lst[i] = max(mg[i], __shfl_xor(mg[15 - i], 2));
      bitonic_sort16_desc(lst);
      if (part == 0) {
#pragma unroll
        for (int j4 = 0; j4 < 4; ++j4) {
          int4 t; t.x = lst[j4 * 4]; t.y = lst[j4 * 4 + 1]; t.z = lst[j4 * 4 + 2]; t.w = lst[j4 * 4 + 3];
          *(int4*)(lists + row * 16 + j4 * 4) = t;
        }
      }
    }
    __syncthreads();
    int top[16];
#pragma unroll
    for (int j = 0; j < 16; ++j) top[j] = (int)0x80000000;
    const int tokl = tid & 63;
    if (tid < 128) {
      float v1[16], v2[16];
#pragma unroll
      for (int j4 = 0; j4 < 4; ++j4) {
        const int4 t1 = *(const int4*)(lists + tokl * 16 + j4 * 4);
        const int4 t2 = *(const int4*)(lists + (64 + tokl) * 16 + j4 * 4);
        v1[j4 * 4] = sort2f(t1.x & ~0x7F); v1[j4 * 4 + 1] = sort2f(t1.y & ~0x7F); v1[j4 * 4 + 2] = sort2f(t1.z & ~0x7F); v1[j4 * 4 + 3] = sort2f(t1.w & ~0x7F);
        v2[j4 * 4] = sort2f(t2.x & ~0x7F); v2[j4 * 4 + 1] = sort2f(t2.y & ~0x7F); v2[j4 * 4 + 2] = sort2f(t2.z & ~0x7F); v2[j4 * 4 + 3] = sort2f(t2.w & ~0x7F);
      }
      if (tid < 64) {
        route_cands<AM0>(top, v1, v2);
      } else {
        route_cands<(~AM0) & 0xFFFFu>(top, v1, v2);
#pragma unroll
        for (int j4 = 0; j4 < 4; ++j4) {
          int4 t; t.x = top[j4 * 4]; t.y = top[j4 * 4 + 1]; t.z = top[j4 * 4 + 2]; t.w = top[j4 * 4 + 3];
          *(int4*)(tops + tokl * 16 + j4 * 4) = t;
        }
      }
    }
    __syncthreads();
    if (tid < 64) {
      int fin[16];
#pragma unroll
      for (int j4 = 0; j4 < 4; ++j4) {
        const int4 t = *(const int4*)(tops + tid * 16 + (3 - j4) * 4);
        fin[j4 * 4 + 0] = max(top[j4 * 4 + 0], t.w);
        fin[j4 * 4 + 1] = max(top[j4 * 4 + 1], t.z);
        fin[j4 * 4 + 2] = max(top[j4 * 4 + 2], t.y);
        fin[j4 * 4 + 3] = max(top[j4 * 4 + 3], t.x);
      }
      int ex[16];
      float val[16];
      float mxv = -3.0e38f;
#pragma unroll
      for (int j = 0; j < 16; ++j) {
        const int code = fin[j] & 0xFF;
        const int i1 = lists[tid * 16 + (code >> 4)] & 0x7F;
        const int i2 = lists[(64 + tid) * 16 + (code & 15)] & 0x7F;
        ex[j] = i1 * 128 + i2;
        val[j] = sort2f(fin[j] & ~0xFF);
        mxv = fmaxf(mxv, val[j]);
      }
      float sum = 0.f;
      float ev[16];
#pragma unroll
      for (int j = 0; j < 16; ++j) { ev[j] = __expf(val[j] - mxv); sum += ev[j]; }
      const float inv = 1.f / sum;
      const size_t ob = (size_t)(tok0 + tid) * 128 + h * 16;
#pragma unroll
      for (int j4 = 0; j4 < 4; ++j4) {
        int4 iv; iv.x = ex[j4 * 4]; iv.y = ex[j4 * 4 + 1]; iv.z = ex[j4 * 4 + 2]; iv.w = ex[j4 * 4 + 3];
        float4 gv; gv.x = ev[j4 * 4] * inv; gv.y = ev[j4 * 4 + 1] * inv; gv.z = ev[j4 * 4 + 2] * inv; gv.w = ev[j4 * 4 + 3] * inv;
        *(int4*)(p.idx + ob + j4 * 4) = iv;
        *(float4*)(p.gates + ob + j4 * 4) = gv;
      }
    }
  }
}

DI float gelu_tanh(float a) {
  const float u = 0.7978845608028654f * (a + 0.044715f * a * a * a);
  return 0.5f * a * (1.f + tanhf(u));
}

#define SB() __builtin_amdgcn_sched_barrier(0)
DI void peer_load8u(u32x4 (&bufa)[8], const unsigned char* tbl, int idxv, int g, int lane) {
#pragma unroll
  for (int k = 0; k < 8; ++k) {
    const int e = __builtin_amdgcn_readlane(idxv, g * 8 + k);
    bufa[k] = *(const u32x4*)(tbl + (size_t)e * 1024 + lane * 16);
  }
}
DI float peer_dot8(const u32x4 (&bufa)[8], const f32x2 (&hp)[16], int lane) {
  float part[8];
#pragma unroll
  for (int k = 0; k < 8; ++k) {
    const u32x4 u = bufa[k];
    f32x2 a2 = f32x2{0.f, 0.f};
#pragma unroll
    for (int c = 0; c < 4; ++c) {
      const unsigned uu = u[c];
      a2 += __builtin_amdgcn_cvt_scalef32_pk_f32_fp4(uu, 1.0f, 0) * hp[c * 4 + 0];
      a2 += __builtin_amdgcn_cvt_scalef32_pk_f32_fp4(uu, 1.0f, 1) * hp[c * 4 + 1];
      a2 += __builtin_amdgcn_cvt_scalef32_pk_f32_fp4(uu, 1.0f, 2) * hp[c * 4 + 2];
      a2 += __builtin_amdgcn_cvt_scalef32_pk_f32_fp4(uu, 1.0f, 3) * hp[c * 4 + 3];
    }
    part[k] = a2[0] + a2[1];
  }
  const bool up4 = (lane & 4) != 0, up2 = (lane & 2) != 0, up1 = (lane & 1) != 0;
  float q[4];
#pragma unroll
  for (int i = 0; i < 4; ++i) {
    const float keep = up4 ? part[i + 4] : part[i];
    const float send = up4 ? part[i] : part[i + 4];
    q[i] = keep + __shfl_xor(send, 4);
  }
  float r[2];
#pragma unroll
  for (int i = 0; i < 2; ++i) {
    const float keep = up2 ? q[i + 2] : q[i];
    const float send = up2 ? q[i] : q[i + 2];
    r[i] = keep + __shfl_xor(send, 2);
  }
  float v = (up1 ? r[1] : r[0]) + __shfl_xor(up1 ? r[0] : r[1], 1);
  v += __shfl_xor(v, 8);
  v += __shfl_xor(v, 16);
  v += __shfl_xor(v, 32);
  return v;
}
DI void peer_acc8(const u32x4 (&bufa)[8], f32x2 (&ys)[16], float cval, int g) {
#pragma unroll
  for (int k = 0; k < 8; ++k) {
    const float ck = __builtin_bit_cast(float, __builtin_amdgcn_readlane(__builtin_bit_cast(int, cval), g * 8 + k));
    const u32x4 u = bufa[k];
#pragma unroll
    for (int c = 0; c < 4; ++c) {
      const unsigned uu = u[c];
      ys[c * 4 + 0] += __builtin_amdgcn_cvt_scalef32_pk_f32_fp4(uu, 1.0f, 0) * ck;
      ys[c * 4 + 1] += __builtin_amdgcn_cvt_scalef32_pk_f32_fp4(uu, 1.0f, 1) * ck;
      ys[c * 4 + 2] += __builtin_amdgcn_cvt_scalef32_pk_f32_fp4(uu, 1.0f, 2) * ck;
      ys[c * 4 + 3] += __builtin_amdgcn_cvt_scalef32_pk_f32_fp4(uu, 1.0f, 3) * ck;
    }
  }
}

DI void phase_peer_expert(const Params& p) {
  const int lane = threadIdx.x & 63, wid = threadIdx.x >> 6;
  bool flag4;
  {
    float c1 = 1.0f, c2 = 2.0f;
    asm volatile("" : "+v"(c1), "+v"(c2));
    const unsigned w4 = __builtin_amdgcn_cvt_scalef32_pk_fp4_f32(0u, c1, c2, 1.0f, 0);
    const f32x2 r4 = __builtin_amdgcn_cvt_scalef32_pk_f32_fp4(w4, 1.0f, 0);
    flag4 = (r4[0] == 2.0f);
  }
  const int tstride = gridDim.x * 8;
  int myidx[2] = {0, 0};
  float mygate[2] = {0.f, 0.f};
  u32x4 bufAa[8], bufBa[8];
  {
    const int tok0 = blockIdx.x * 8 + wid;
    if (tok0 < T_TOK) {
#pragma unroll
      for (int half = 0; half < 2; ++half) {
        myidx[half] = p.idx[(size_t)tok0 * 128 + half * 64 + lane];
        mygate[half] = p.gates[(size_t)tok0 * 128 + half * 64 + lane];
      }
      peer_load8u(bufAa, p.wU8, myidx[0], 0, lane);
    }
  }
  for (int tok = blockIdx.x * 8 + wid; tok < T_TOK; tok += tstride) {
    const int ntok = (tok + tstride < T_TOK) ? tok + tstride : tok;
    int nxidx[2];
    float nxgate[2];
#pragma unroll
    for (int half = 0; half < 2; ++half) {
      nxidx[half] = p.idx[(size_t)ntok * 128 + half * 64 + lane];
      nxgate[half] = p.gates[(size_t)ntok * 128 + half * 64 + lane];
    }
    const float rs2 = rsqrtf(p.rowss2[tok] * (1.f / 2048.f) + 1e-6f);
    f32x2 hs[16];
    {
      float he[32];
#pragma unroll
      for (int j = 0; j < 2; ++j)
#pragma unroll
        for (int q = 0; q < 2; ++q) {
          const u32x4 t = *(const u32x4*)(p.hbuf + (size_t)tok * 2048 + j * 1024 + lane * 16 + q * 8);
#pragma unroll
          for (int c = 0; c < 4; ++c) { const unsigned tt = t[c]; he[j * 16 + q * 8 + c * 2] = bflo(tt); he[j * 16 + q * 8 + c * 2 + 1] = bfhi(tt); }
        }
#pragma unroll
      for (int i = 0; i < 16; ++i) {
        const float n0 = he[2 * i], n1 = he[2 * i + 1];
        hs[i] = f32x2{flag4 ? n1 : n0, flag4 ? n0 : n1};
      }
    }
    f32x2 ys[16];
#pragma unroll
    for (int e = 0; e < 16; ++e) ys[e] = f32x2{0.f, 0.f};
#pragma unroll 1
    for (int half = 0; half < 2; ++half) {
      const int idxv = half ? myidx[1] : myidx[0];
      const float gate = half ? mygate[1] : mygate[0];
      const float mysu = p.su[idxv], mysv = p.sv[idxv];
      float amine = 0.f;
#pragma unroll 1
      for (int g2 = 0; g2 < 3; ++g2) {
        peer_load8u(bufBa, p.wU8, idxv, 2 * g2 + 1, lane);
        SB();
        { const float v = peer_dot8(bufAa, hs, lane); if ((lane >> 3) == 2 * g2) amine = v; }
        SB();
        peer_load8u(bufAa, p.wU8, idxv, 2 * g2 + 2, lane);
        SB();
        { const float v = peer_dot8(bufBa, hs, lane); if ((lane >> 3) == 2 * g2 + 1) amine = v; }
        SB();
      }
      {
        peer_load8u(bufBa, p.wU8, idxv, 7, lane);
        SB();
        { const float v = peer_dot8(bufAa, hs, lane); if ((lane >> 3) == 6) amine = v; }
        SB();
        peer_load8u(bufAa, p.wV8, idxv, 0, lane);
        SB();
        { const float v = peer_dot8(bufBa, hs, lane); if ((lane >> 3) == 7) amine = v; }
        SB();
      }
      const float cval = gate * gelu_tanh(amine * mysu * rs2) * mysv;
      const int nidx = half ? nxidx[0] : myidx[1];
#pragma unroll 1
      for (int g2 = 0; g2 < 3; ++g2) {
        peer_load8u(bufBa, p.wV8, idxv, 2 * g2 + 1, lane);
        SB();
        peer_acc8(bufAa, ys, cval, 2 * g2);
        SB();
        peer_load8u(bufAa, p.wV8, idxv, 2 * g2 + 2, lane);
        SB();
        peer_acc8(bufBa, ys, cval, 2 * g2 + 1);
        SB();
      }
      {
        peer_load8u(bufBa, p.wV8, idxv, 7, lane);
        SB();
        peer_acc8(bufAa, ys, cval, 6);
        SB();
        peer_load8u(bufAa, p.wU8, nidx, 0, lane);
        SB();
        peer_acc8(bufBa, ys, cval, 7);
        SB();
      }
    }
    float ss = 0.f;
#pragma unroll
    for (int i = 0; i < 16; ++i) { ys[i] += hs[i]; ss += ys[i][0] * ys[i][0] + ys[i][1] * ys[i][1]; }
    float ye[32];
#pragma unroll
    for (int i = 0; i < 16; ++i) {
      ye[2 * i] = flag4 ? ys[i][1] : ys[i][0];
      ye[2 * i + 1] = flag4 ? ys[i][0] : ys[i][1];
    }
    ss = wave_sum(ss);
    const float rs = rsqrtf(ss * (1.f / 2048.f) + 1e-6f);
#pragma unroll
    for (int j = 0; j < 2; ++j)
#pragma unroll
      for (int q = 0; q < 4; ++q) {
        const float4 gq = *(const float4*)(p.g_final + j * 1024 + lane * 16 + q * 4);
        const int b0 = j * 16 + q * 4;
        float4 o;
        o.x = ye[b0] * rs * gq.x; o.y = ye[b0 + 1] * rs * gq.y; o.z = ye[b0 + 2] * rs * gq.z; o.w = ye[b0 + 3] * rs * gq.w;
        *(float4*)(p.out + (size_t)tok * 2048 + j * 1024 + lane * 16 + q * 4) = o;
      }
    myidx[0] = nxidx[0]; myidx[1] = nxidx[1]; mygate[0] = nxgate[0]; mygate[1] = nxgate[1];
  }
}

#define XB_TMO      128
#define XB_XCNT(j)  (256  + 64 * (j))
#define XB_XSUB(j)  (1280 + 64 * (j))
#define XB_XGEN(j)  (2304 + 64 * (j))
#define XB_TOP      3328
#define XB_TOPGEN   3392
#define XCD_BAR_WORDS 3456
#define XB_SPIN_CAP (1u << 20)
DI unsigned xb_ld(unsigned* p)              { return __hip_atomic_load(p, __ATOMIC_RELAXED, __HIP_MEMORY_SCOPE_AGENT); }
DI unsigned xb_add(unsigned* p, unsigned v) { return __hip_atomic_fetch_add(p, v, __ATOMIC_RELAXED, __HIP_MEMORY_SCOPE_AGENT); }
DI unsigned xb_xcc_id() { return (unsigned)__builtin_amdgcn_s_getreg((3 << 11) | 20) & 0xFu; }
#define XB_SPIN(cond, bar) do { unsigned _sp = 0; while (cond) { __builtin_amdgcn_s_sleep(1); \
    if ((++_sp & 255u) == 0u) { if (xb_ld(&(bar)[XB_TMO])) break; if (_sp > XB_SPIN_CAP) { atomicAdd(&(bar)[XB_TMO], 1u); break; } } } } while (0)
struct XcdBarrier { unsigned* bar; unsigned x; volatile LAS unsigned* st; };
DI XcdBarrier xcd_barrier_post(unsigned* bar, volatile LAS unsigned* st) {
  XcdBarrier b; b.bar = bar; b.x = xb_xcc_id(); b.st = st;
  if (threadIdx.x == 0) (void)xb_add(&bar[XB_XCNT(b.x)], 1u);
  return b;
}
DI void xcd_barrier_complete(unsigned* bar, unsigned x, unsigned& nloc, unsigned& nx) {
  const unsigned G = gridDim.x * gridDim.y * gridDim.z;
  unsigned sum, cnt, mine, sp = 0u;
  for (;;) {
    sum = 0u; cnt = 0u; mine = 0u;
#pragma unroll
    for (unsigned j = 0; j < 16; ++j) { const unsigned c = xb_ld(&bar[XB_XCNT(j)]); sum += c; cnt += (c > 0u) ? 1u : 0u; mine = (j == x) ? c : mine; }
    if (sum == G) break;
    __builtin_amdgcn_s_sleep(1);
    if ((++sp & 255u) == 0u) { if (xb_ld(&bar[XB_TMO])) break; if (sp > XB_SPIN_CAP) { atomicAdd(&bar[XB_TMO], 1u); break; } }
  }
  nloc = mine > 0u ? mine : 1u; nx = cnt > 0u ? cnt : 1u;
}
DI void xcd_barrier(const XcdBarrier& b) {
  asm volatile("s_waitcnt vmcnt(0)" ::: "memory");
  __syncthreads();
  if (threadIdx.x == 0) {
    unsigned* bar = b.bar;
    __builtin_amdgcn_s_waitcnt(0);
    unsigned nloc = b.st[0], nx = b.st[1];
    if (nloc == 0u) { xcd_barrier_complete(bar, b.x, nloc, nx); b.st[0] = nloc; b.st[1] = nx; }
    const unsigned old = xb_add(&bar[XB_XSUB(b.x)], 1u);
    const unsigned gen = old / nloc;
    if (old + 1u == (gen + 1u) * nloc) {
      __builtin_amdgcn_fence(__ATOMIC_RELEASE, "agent");
      asm volatile("s_waitcnt vmcnt(0)" ::: "memory");
      const unsigned og = xb_add(&bar[XB_TOP], 1u);
      const unsigned tg = og / nx;
      if (og + 1u == (tg + 1u) * nx) xb_add(&bar[XB_TOPGEN], 1u);
      else XB_SPIN(xb_ld(&bar[XB_TOPGEN]) == tg, bar);
      __builtin_amdgcn_fence(__ATOMIC_ACQUIRE, "agent");
      xb_add(&bar[XB_XGEN(b.x)], 1u);
      asm volatile("s_waitcnt vmcnt(0)" ::: "memory");
    } else {
      XB_SPIN(xb_ld(&bar[XB_XGEN(b.x)]) == gen, bar);
      __builtin_amdgcn_fence(__ATOMIC_ACQUIRE, "agent");
      asm volatile("s_waitcnt vmcnt(0)" ::: "memory");
    }
  }
  __syncthreads();
}

__global__ void __launch_bounds__(NTHREADS) mega(Params p, int phase_lo, int phase_hi) {
  __shared__ __attribute__((aligned(16))) char smem[SMEM_BYTES];
  cg::grid_group grid = cg::this_grid();
  volatile LAS unsigned* xst = (volatile LAS unsigned*)(smem + SMEM_BYTES - 16);
  if (threadIdx.x == 0) { xst[0] = 0u; xst[1] = 0u; }
  __syncthreads();
  const XcdBarrier xbar = xcd_barrier_post(p.bar + 64, xst);
  if (phase_hi > 1000) grid.sync();
#define PHASE(k, call) if (phase_lo <= (k) && (k) < phase_hi) { if ((k) > phase_lo) { xcd_barrier(xbar); } call; if ((DUP_MASK >> (k)) & 1) { xcd_barrier(xbar); call; } }
  PHASE(0, phase_prep(p, smem))
  PHASE(1, phase_inproj(p, smem))
  PHASE(2, phase_mix_attn(p, smem))
  PHASE(3, phase_pool_combine(p, smem))
  PHASE(4, phase_gemm_resid<false>(p.hbuf, 2048, p.wOutT, 2048, p.x, p.x2b, p.rowss1, smem))
  PHASE(6, phase_cross_proj(p, smem))
  PHASE(7, phase_cross_attn(p, smem))
  PHASE(8, phase_gemm_resid<true>(p.oc, 512, p.wCoT, 512, p.x2b, p.hbuf, p.rowss2, smem))
  PHASE(10, phase_gemm_pq(p, smem))
  PHASE(11, phase_peer_route(p, smem))
  PHASE(12, phase_peer_expert(p))
}

extern "C" void kernel_launch(void* const* d_in, const int* in_sizes, int n_in, void* d_out, int out_size, void* d_ws,
                              size_t ws_size, hipStream_t stream) {
  Params p{};
  p.x = (const float*)d_in[0]; p.mem = (const float*)d_in[1]; p.pos = (const int*)d_in[2];
  p.g_mix = (const float*)d_in[3]; p.w_in = (const float*)d_in[4]; p.w_pool = (const float*)d_in[5];
  p.pool_scale = (const float*)d_in[6]; p.w_out = (const float*)d_in[7]; p.g_cross = (const float*)d_in[8];
  p.g_mem = (const float*)d_in[9]; p.w_cq = (const float*)d_in[10]; p.w_ck = (const float*)d_in[11];
  p.w_cv = (const float*)d_in[12]; p.w_co = (const float*)d_in[13]; p.g_ffn = (const float*)d_in[14];
  p.w_pq = (const float*)d_in[15]; p.sk1f = (const float*)d_in[16]; p.sk2f = (const float*)d_in[17];
  p.w_u = (const float*)d_in[18]; p.w_v = (const float*)d_in[19]; p.g_final = (const float*)d_in[20];
  p.out = (float*)d_out;
  char* ws = (char*)d_ws;
  size_t off = 0;
  auto take = [&](size_t bytes) { char* r = ws + off; off += (bytes + 255) & ~(size_t)255; return r; };
  const size_t MB = 1024 * 1024;
  p.wInT = (bfr*)take(16 * MB); p.wPoolT = (bfr*)take(512 * 1024); p.wOutT = (bfr*)take(8 * MB);
  p.wCqT = (bfr*)take(2 * MB); p.wCkT = (bfr*)take(2 * MB); p.wCvT = (bfr*)take(2 * MB); p.wCoT = (bfr*)take(2 * MB);
  p.wPqT = (bfr*)take(8 * MB); p.sk1 = (bfr*)take(32768); p.sk2 = (bfr*)take(32768);
  p.wU8 = (unsigned char*)take(32 * MB); p.wV8 = (unsigned char*)take(32 * MB);
  p.su = (float*)take(65536); p.sv = (float*)take(65536);
  p.memn = (bfr*)take(4 * MB); p.kc = (bfr*)take(1 * MB); p.vc = (bfr*)take(1 * MB);
  p.hbuf = (bfr*)take(64 * MB);
  p.bar = (unsigned*)take(256 + XCD_BAR_WORDS * 4);
  p.rowss1 = (float*)take(65536); p.rowss2 = (float*)take(65536);
  p.ropetab = (float*)take((size_t)T_TOK * 16 * 2 * 4);
  const size_t r2 = off;
  p.qbuf = (bfr*)take(32 * MB); p.kbuf = (bfr*)take(32 * MB); p.vbuf = (bfr*)take(32 * MB);
  p.pbuf = (bfr*)take(32 * MB); p.mixed = (bfr*)take(32 * MB); p.ob = (bfr*)take(96 * MB);
  p.lse = (float*)take((size_t)3 * T_TOK * 8 * 4);
  const size_t end1 = off;
  off = r2;
  p.xres = (float*)take(128 * MB); p.pq = (bfr*)take(64 * MB); p.x2b = p.pq; p.qc = (bfr*)take(16 * MB); p.oc = (bfr*)take(16 * MB);
  p.idx = (int*)take(8 * MB); p.gates = (float*)take(8 * MB);
  const size_t end2 = off;
  const size_t need = end1 > end2 ? end1 : end2;
  if (need > ws_size) { fprintf(stderr, "workspace too small: need %zu have %zu\n", need, ws_size); return; }

  static int grid_blocks = 0;
  if (!grid_blocks) {
    int dev = 0, cus = 0, per_cu = 0;
    hipGetDevice(&dev);
    hipDeviceGetAttribute(&cus, hipDeviceAttributeMultiprocessorCount, dev);
    hipOccupancyMaxActiveBlocksPerMultiprocessor(&per_cu, mega, NTHREADS, 0);
    if (per_cu < 1) per_cu = 1;
    if (per_cu > 1) per_cu = 1;
    grid_blocks = cus * per_cu;
  }
  hipMemsetAsync(p.bar, 0, 256 + XCD_BAR_WORDS * 4, stream);
#if MULTI_LAUNCH
  for (int ph = 0; ph < NPHASE; ++ph) hipLaunchKernelGGL(mega, dim3(grid_blocks), dim3(NTHREADS), 0, stream, p, ph, ph + 1);
#else
  int lo = 0, hi = NPHASE;
  void* args[] = {&p, &lo, &hi};
  hipError_t e = hipLaunchCooperativeKernel((void*)mega, dim3(grid_blocks), dim3(NTHREADS), args, 0, stream);
  if (e != hipSuccess) fprintf(stderr, "cooperative launch failed: %s (grid %d)\n", hipGetErrorString(e), grid_blocks);
#endif
}
```

```cpp
#include <hip/hip_runtime.h>
#include <hip/hip_cooperative_groups.h>
#include <stdint.h>
#include <stdio.h>
namespace cg = cooperative_groups;

#ifndef DUP_MASK
#define DUP_MASK 0
#endif
#ifndef MULTI_LAUNCH
#define MULTI_LAUNCH 0
#endif

#define DI __device__ __forceinline__
typedef unsigned short bfr;
using bf16x8 = __attribute__((ext_vector_type(8))) short;
using s16x4  = __attribute__((ext_vector_type(4))) short;
using f32x4  = __attribute__((ext_vector_type(4))) float;
using u32x4  = __attribute__((ext_vector_type(4))) unsigned;
using u32x2  = __attribute__((ext_vector_type(2))) unsigned;
using bf2    = __attribute__((ext_vector_type(2))) __bf16;
using f32x2  = __attribute__((ext_vector_type(2))) float;
using v6u    = __attribute__((ext_vector_type(6))) unsigned;
using v16f   = __attribute__((ext_vector_type(16))) float;
using v32f   = __attribute__((ext_vector_type(32))) float;

constexpr int T_TOK = 16384;
constexpr int NTHREADS = 512;
constexpr int SMEM_BYTES = 151552;
constexpr int NPHASE = 13;

struct Params {
  const float *x, *mem; const int* pos;
  const float *g_mix, *w_in, *w_pool, *pool_scale, *w_out, *g_cross, *g_mem, *w_cq, *w_ck, *w_cv, *w_co, *g_ffn, *w_pq,
              *sk1f, *sk2f, *w_u, *w_v, *g_final;
  float* out;
  bfr *wInT, *wPoolT, *wOutT, *wCqT, *wCkT, *wCvT, *wCoT, *wPqT, *sk1, *sk2;
  unsigned char *wU8, *wV8; float *su, *sv;
  bfr *hbuf, *memn, *kc, *vc;
  bfr *pbuf, *qbuf, *kbuf, *vbuf, *mixed, *ob; float* lse;
  float* xres; bfr *pq, *qc, *oc; int* idx; float* gates;
  unsigned* bar;
  float *rowss1, *rowss2; bfr* x2b;
  float* ropetab;
};

DI unsigned pack2(float a, float b) { bf2 p; p[0] = (__bf16)a; p[1] = (__bf16)b; return __builtin_bit_cast(unsigned, p); }
DI float bflo(unsigned u) { return __uint_as_float(u << 16); }
DI float bfhi(unsigned u) { return __uint_as_float(u & 0xffff0000u); }
DI float4 ldnt4(const float* p) { const f32x4 v = __builtin_nontemporal_load((const f32x4*)p); return make_float4(v[0], v[1], v[2], v[3]); }
DI float wave_sum(float v) {
#pragma unroll
  for (int o = 32; o >= 1; o >>= 1) v += __shfl_xor(v, o);
  return v;
}
DI f32x4 mfma16(bf16x8 a, bf16x8 b, f32x4 c) { return __builtin_amdgcn_mfma_f32_16x16x32_bf16(a, b, c, 0, 0, 0); }
DI s16x4 tr_read(const char* p) {
  return __builtin_amdgcn_ds_read_tr16_b64_v4i16((s16x4 __attribute__((address_space(3)))*)(p));
}


#define LAS __attribute__((address_space(3)))
namespace g8 {
constexpr int BM = 256, BK = 64, HALF = 128, HTB = HALF * BK * 2, NXCD = 8, WGM = 8;
DI int lds_byte(int r, int c) { const int st = (r >> 4) * 2 + (c >> 5), rr = r & 15, cc = c & 31, ob = rr * 64 + cc * 2; return st * 1024 + (ob ^ (((ob >> 9) & 1) << 5)); }
DI int perm32(int rho) { const int n = rho >> 4, i = rho & 15; return 8 * (i >> 2) + 4 * n + (i & 3); }
DI void stage_rc(int b, int& R, int& C) { const int st = b / 1024, sb = b % 1024, swz = sb ^ (((sb >> 9) & 1) << 5); R = (st >> 1) * 16 + swz / 64; C = (st & 1) * 32 + (swz % 64) / 2; }
struct Order {
  int nM, nN, nwg, G, c;
  DI void init(int M, int N, int G_, int c_) { nM = M / BM; nN = N / BM; nwg = nM * nN; G = G_; c = c_; }
  DI bool next(int i, int& pm, int& pn) const {
    const long L = (long)i * G + c; if (L >= nwg) return false;
    int wgid = (int)L; { const int q = nwg / NXCD, r = nwg % NXCD, xcd = wgid % NXCD, off = wgid / NXCD; wgid = (xcd < r ? xcd * (q + 1) : r * (q + 1) + (xcd - r) * q) + off; }
    const int nig = WGM * nN, gid = wgid / nig, fm = gid * WGM, gsz = (nM - fm) < WGM ? (nM - fm) : WGM;
    pm = fm + ((wgid % nig) % gsz); pn = (wgid % nig) / gsz; return true;
  }
};
}

template <class Epi>
DI void gemm8(LAS unsigned char* lds, const bfr* A, int lda, const bfr* Bt, int M, int N, int K, int G, int c, const Epi& E, int a_pn_bytes = 0) {
  using namespace g8;
  const int tid = threadIdx.x, wid = __builtin_amdgcn_readfirstlane(tid >> 6), lane = tid & 63, wr = wid >> 2, wc = wid & 3, fr = lane & 15, fq = lane >> 4;
  const int nt = K / BK;
  Order S; S.init(M, N, G, c);
  unsigned voffA[2], voffB[2];
#pragma unroll
  for (int i = 0; i < 2; ++i) { int R, C; stage_rc(tid * 16 + i * 8192, R, C); const int Rb = (R & ~31) + perm32(R & 31);
    voffA[i] = (unsigned)(R * lda + C) * 2u; voffB[i] = (unsigned)(Rb * K + C) * 2u; }
  const size_t kstep = (size_t)(BK * 2);
  const size_t hstepA = (size_t)HALF * lda * 2, hstepB = (size_t)HALF * K * 2;
  const size_t tstepA = 2 * hstepA, tstepB = 2 * hstepB;
  const unsigned ldsw = (unsigned)wid * 1024u;
  const int aoff = lds_byte(wr * 64 + fr, fq * 8), boff = lds_byte(wc * 32 + fr, fq * 8);
#define G8_SA(b, h) (((b) * 2 + (h)) * HTB)
#define G8_SB(b, h) ((4 + (b) * 2 + (h)) * HTB)
#define G8_STAGE(bufoff, gbase, voff) do { _Pragma("unroll") for (int _i = 0; _i < 2; ++_i) \
    __builtin_amdgcn_global_load_lds((const unsigned*)((const char*)(gbase) + (voff)[_i]), (LAS unsigned*)(lds + (bufoff) + ldsw + _i * 8192), 16, 0, 0); } while (0)
#define G8_LDA(dst, b, h) do { _Pragma("unroll") for (int m = 0; m < 4; ++m) _Pragma("unroll") for (int k = 0; k < 2; ++k) dst[m][k] = *(const LAS bf16x8*)(lds + G8_SA(b, h) + aoff + m * 2048 + k * 1024); } while (0)
#define G8_LDB(dst, b, h) do { _Pragma("unroll") for (int n = 0; n < 2; ++n) _Pragma("unroll") for (int k = 0; k < 2; ++k) dst[n][k] = *(const LAS bf16x8*)(lds + G8_SB(b, h) + boff + n * 2048 + k * 1024); } while (0)
#define G8_MMA(ai, bj, At, Btf) do { __builtin_amdgcn_s_setprio(1); _Pragma("unroll") for (int m = 0; m < 4; ++m) _Pragma("unroll") for (int n = 0; n < 2; ++n) _Pragma("unroll") for (int k = 0; k < 2; ++k) \
    acc[ai][bj][m][n] = __builtin_amdgcn_mfma_f32_16x16x32_bf16(Btf[n][k], At[m][k], acc[ai][bj][m][n], 0, 0, 0); __builtin_amdgcn_s_setprio(0); } while (0)
#define G8_WAIT_V(n) asm volatile("s_waitcnt vmcnt(" #n ")" ::: "memory")
#define G8_WAIT_L(n) asm volatile("s_waitcnt lgkmcnt(" #n ")" ::: "memory")
#define G8_BAR __builtin_amdgcn_s_barrier()
#define G8_SCHED __builtin_amdgcn_sched_barrier(0)
  int cpm, cpn, npm = 0, npn = 0, ui = 0;
  if (!S.next(0, cpm, cpn)) return;
  f32x4 acc[2][2][4][2];
#pragma unroll
  for (int a = 0; a < 2; ++a)
#pragma unroll
    for (int b = 0; b < 2; ++b)
#pragma unroll
      for (int m = 0; m < 4; ++m)
#pragma unroll
        for (int n = 0; n < 2; ++n) acc[a][b][m][n] = f32x4{0.f, 0.f, 0.f, 0.f};
  bf16x8 At[4][2], B0[2][2], B1[2][2];
  const char* cA = (const char*)A + (size_t)cpm * tstepA + (size_t)cpn * a_pn_bytes; const char* cB = (const char*)Bt + (size_t)cpn * tstepB;
  G8_STAGE(G8_SB(0, 0), cB, voffB); G8_STAGE(G8_SA(0, 0), cA, voffA); G8_STAGE(G8_SB(0, 1), cB + hstepB, voffB); G8_STAGE(G8_SA(0, 1), cA + hstepA, voffA);
  if (wr == 1) G8_BAR;
  G8_WAIT_V(4); G8_BAR;
  G8_STAGE(G8_SB(1, 0), cB + kstep, voffB); G8_STAGE(G8_SA(1, 0), cA + kstep, voffA); G8_STAGE(G8_SB(1, 1), cB + hstepB + kstep, voffB);
  G8_WAIT_V(6); G8_BAR;
  for (;;) {
    const bool has_next = S.next(ui + 1, npm, npn);
    const char* nA = has_next ? (const char*)A + (size_t)npm * tstepA + (size_t)npn * a_pn_bytes : cA; const char* nB = has_next ? (const char*)Bt + (size_t)npn * tstepB : cB;
    for (int t = 0; t < nt; t += 2) {
      const bool last = (t == nt - 2);
      const char* a1 = cA + (size_t)(t + 1) * kstep;
      const char* a2 = last ? nA : cA + (size_t)(t + 2) * kstep; const char* b2 = last ? nB : cB + (size_t)(t + 2) * kstep;
      const char* a3 = a2 + kstep; const char* b3 = b2 + kstep;
      G8_LDB(B0, 0, 0); G8_SCHED; G8_LDA(At, 0, 0); G8_STAGE(G8_SA(1, 1), a1 + hstepA, voffA);
      G8_WAIT_L(8); G8_BAR; G8_WAIT_L(0); G8_MMA(0, 0, At, B0); G8_BAR; G8_SCHED;
      G8_LDB(B1, 0, 1); G8_STAGE(G8_SB(0, 0), b2, voffB);
      G8_BAR; G8_WAIT_L(0); G8_MMA(0, 1, At, B1); G8_BAR;
      G8_LDA(At, 0, 1); G8_STAGE(G8_SA(0, 0), a2, voffA);
      G8_BAR; G8_WAIT_L(0); G8_MMA(1, 0, At, B0); G8_BAR; G8_SCHED;
      G8_STAGE(G8_SB(0, 1), b2 + hstepB, voffB);
      G8_WAIT_V(6); G8_BAR; G8_MMA(1, 1, At, B1); G8_BAR;
      G8_LDB(B0, 1, 0); G8_SCHED; G8_LDA(At, 1, 0); G8_STAGE(G8_SA(0, 1), a2 + hstepA, voffA);
      G8_WAIT_L(8); G8_BAR; G8_WAIT_L(0); G8_MMA(0, 0, At, B0); G8_BAR; G8_SCHED;
      G8_LDB(B1, 1, 1); G8_STAGE(G8_SB(1, 0), b3, voffB);
      G8_BAR; G8_WAIT_L(0); G8_MMA(0, 1, At, B1); G8_BAR;
      G8_LDA(At, 1, 1); G8_STAGE(G8_SA(1, 0), a3, voffA);
      G8_BAR; G8_WAIT_L(0); G8_MMA(1, 0, At, B0); G8_BAR; G8_SCHED;
      G8_STAGE(G8_SB(1, 1), b3 + hstepB, voffB);
      G8_WAIT_V(6); G8_BAR; G8_MMA(1, 1, At, B1); G8_BAR;
    }
    E(acc, cpm, cpn, wr, wc, fr, fq);
    if (!has_next) break;
#pragma unroll
    for (int a = 0; a < 2; ++a)
#pragma unroll
      for (int b = 0; b < 2; ++b)
#pragma unroll
        for (int m = 0; m < 4; ++m)
#pragma unroll
          for (int n = 0; n < 2; ++n) acc[a][b][m][n] = f32x4{0.f, 0.f, 0.f, 0.f};
    cpm = npm; cpn = npn; cA = nA; cB = nB; ++ui;
  }
  G8_WAIT_V(0);
  if (wr == 0) G8_BAR;
  G8_BAR;
#undef G8_SA
#undef G8_SB
#undef G8_STAGE
#undef G8_LDA
#undef G8_LDB
#undef G8_MMA
#undef G8_WAIT_V
#undef G8_WAIT_L
#undef G8_BAR
#undef G8_SCHED
}
#define G8_FOREACH8(acc, pm, pn, wr, wc, fr, fq, ai, bj, m, row, col) \
  _Pragma("unroll") for (int ai = 0; ai < 2; ++ai) _Pragma("unroll") for (int m = 0; m < 4; ++m) \
  _Pragma("unroll") for (int bj = 0; bj < 2; ++bj) \
    if (const int row = 256 * (pm) + 128 * ai + 64 * (wr) + 16 * m + (fr); true) if (const int col = 256 * (pn) + 128 * bj + 32 * (wc) + 8 * (fq); true)
DI u32x4 pack8(const f32x4 a, const f32x4 b, float sc) {
  return u32x4{pack2(a[0] * sc, a[1] * sc), pack2(a[2] * sc, a[3] * sc), pack2(b[0] * sc, b[1] * sc), pack2(b[2] * sc, b[3] * sc)};
}
typedef f32x4 Acc8[2][2][4][2];

struct NoHook { DI void operator()() const {} };
template <bool BANDED, class RowF, class MidF = NoHook>
DI void attn_compute(const bf16x8 (&qf)[4], int q0, int key0, char* smem, RowF rowptr, float& m_out, float& l_out, MidF mid = MidF()) {
  const int tid = threadIdx.x, lane = tid & 63, w = tid >> 6, fr = lane & 15, fq = lane >> 4;
  char* sK = smem;
  char* sV = smem + 65536;
  constexpr int NT = BANDED ? 10 : 16;
  const int t0 = BANDED ? (w & ~1) : 0;
  f32x4 s[NT];
#pragma unroll
  for (int j = 0; j < NT; ++j) {
    f32x4 a = f32x4{0.f, 0.f, 0.f, 0.f};
    const int key = (t0 + j) * 16 + fr;
#pragma unroll
    for (int kk = 0; kk < 4; ++kk) {
      const bf16x8 kf = *(const bf16x8*)(sK + key * 256 + (((kk * 4 + fq) ^ fr) << 4));
      a = mfma16(kf, qf[kk], a);
    }
    s[j] = a;
  }
  mid();
  const float L2E = 1.4426950408889634f;
  const float NINF = -__builtin_inff();
  float mx = NINF;
  const int lq = q0 + w * 16 + fr;
#pragma unroll
  for (int j = 0; j < NT; ++j)
#pragma unroll
    for (int i = 0; i < 4; ++i) {
      float v = s[j][i] * L2E;
      if (BANDED) {
        const int lk = key0 + (t0 + j) * 16 + fq * 4 + i;
        const int dist = lq - lk;
        const bool ok = (lk >= 0) && (dist >= 0) && (dist <= 128);
        v = ok ? v : NINF;
      }
      s[j][i] = v;
      mx = fmaxf(mx, v);
    }
  mx = fmaxf(mx, __shfl_xor(mx, 16));
  mx = fmaxf(mx, __shfl_xor(mx, 32));
  float l = 0.f;
#pragma unroll
  for (int j = 0; j < NT; ++j)
#pragma unroll
    for (int i = 0; i < 4; ++i) {
      const float p = __builtin_amdgcn_exp2f(s[j][i] - mx);
      s[j][i] = p;
      l += p;
    }
  l += __shfl_xor(l, 16);
  l += __shfl_xor(l, 32);
  bf16x8 pf[NT / 2];
#pragma unroll
  for (int c = 0; c < NT / 2; ++c) {
    u32x4 t;
    t[0] = pack2(s[2 * c][0], s[2 * c][1]);
    t[1] = pack2(s[2 * c][2], s[2 * c][3]);
    t[2] = pack2(s[2 * c + 1][0], s[2 * c + 1][1]);
    t[3] = pack2(s[2 * c + 1][2], s[2 * c + 1][3]);
    pf[c] = __builtin_bit_cast(bf16x8, t);
  }
  const int q4 = (lane & 15) >> 2, p4 = lane & 3;
  m_out = mx;
  l_out = l;
  const float il = 1.f / l;
  bfr* dst = rowptr(fr) + fq * 4;
#pragma unroll 2
  for (int dt = 0; dt < 8; ++dt) {
    f32x4 a = f32x4{0.f, 0.f, 0.f, 0.f};
#pragma unroll
    for (int c = 0; c < NT / 2; ++c) {
      const int kb = (t0 + 2 * c) * 16;
      const s16x4 lo = tr_read(sV + (kb + fq * 4 + q4) * 288 + (dt * 16 + p4 * 4) * 2);
      const s16x4 hi = tr_read(sV + (kb + 16 + fq * 4 + q4) * 288 + (dt * 16 + p4 * 4) * 2);
      const bf16x8 vf = __builtin_shufflevector(lo, hi, 0, 1, 2, 3, 4, 5, 6, 7);
      a = mfma16(vf, pf[c], a);
    }
    u32x2 v; v[0] = pack2(a[0] * il, a[1] * il); v[1] = pack2(a[2] * il, a[3] * il);
    *(u32x2*)(dst + dt * 16) = v;
  }
}

template <bool BANDED, class StoreF>
DI void attn_core(const bfr* __restrict__ Qb, int qstride, int q0, const bfr* __restrict__ Kb, const bfr* __restrict__ Vb,
                  int kvstride, int key0, char* smem, StoreF store, float& m_out, float& l_out) {
  const int tid = threadIdx.x, lane = tid & 63, w = tid >> 6, fr = lane & 15, fq = lane >> 4;
  char* sK = smem;
  char* sV = smem + 65536;
  __syncthreads();
#pragma unroll 1
  for (int rr = 0; rr < 2; ++rr) {
    u32x4 kr[4], vr[4];
#pragma unroll
    for (int i = 0; i < 4; ++i) {
      const int id = tid + (rr * 4 + i) * 512, key = id >> 4, c = id & 15, lk = key0 + key;
      const int lkc = lk < 0 ? 0 : lk;
      const unsigned msk = lk < 0 ? 0u : 0xffffffffu;
      kr[i] = *(const u32x4*)(Kb + (long)lkc * kvstride + c * 8);
      vr[i] = *(const u32x4*)(Vb + (long)lkc * kvstride + c * 8);
      kr[i] &= u32x4{msk, msk, msk, msk};
      vr[i] &= u32x4{msk, msk, msk, msk};
    }
#pragma unroll
    for (int i = 0; i < 4; ++i) {
      const int id = tid + (rr * 4 + i) * 512, key = id >> 4, c = id & 15;
      *(u32x4*)(sK + key * 256 + ((c ^ (key & 15)) << 4)) = kr[i];
      *(u32x4*)(sV + key * 288 + c * 16) = vr[i];
    }
  }
  bf16x8 qf[4];
  {
    const bfr* qrow = Qb + (long)(q0 + w * 16 + fr) * qstride;
#pragma unroll
    for (int kk = 0; kk < 4; ++kk) qf[kk] = *(const bf16x8*)(qrow + kk * 32 + fq * 8);
  }
  __syncthreads();
  attn_compute<BANDED>(qf, q0, key0, smem, store, m_out, l_out);
}

DI int f2sort(float f) { int b = __float_as_int(f); return b ^ ((b >> 31) & 0x7fffffff); }
DI float sort2f(int s) { int b = s ^ ((s >> 31) & 0x7fffffff); return __int_as_float(b); }
DI void topk_insert(int (&lst)[16], int key) {
#pragma unroll
  for (int j = 0; j < 16; ++j) {
    const int hi = max(lst[j], key);
    key = min(lst[j], key);
    lst[j] = hi;
  }
}

template <int O, int N>
DI void bfly(float (&p)[64], int lane) {
  const bool up = (lane & O) != 0;
#pragma unroll
  for (int i = 0; i < N / 2; ++i) {
    const float keep = up ? p[i + N / 2] : p[i];
    const float send = up ? p[i] : p[i + N / 2];
    p[i] = keep + __shfl_xor(send, O);
  }
  if constexpr (O > 1) bfly<O / 2, N / 2>(p, lane);
}

DI void rms_rows2_to_bf16(const float* __restrict__ x0, const float* __restrict__ x1, const float* __restrict__ g,
                          bfr* __restrict__ o0, bfr* __restrict__ o1, int lane) {
  float4 v0[8], v1[8];
#pragma unroll
  for (int j = 0; j < 8; ++j) v0[j] = ldnt4(x0 + j * 256 + lane * 4);
#pragma unroll
  for (int j = 0; j < 8; ++j) v1[j] = ldnt4(x1 + j * 256 + lane * 4);
  float s0 = 0.f, s1 = 0.f;
#pragma unroll
  for (int j = 0; j < 8; ++j) {
    s0 += v0[j].x * v0[j].x + v0[j].y * v0[j].y + v0[j].z * v0[j].z + v0[j].w * v0[j].w;
    s1 += v1[j].x * v1[j].x + v1[j].y * v1[j].y + v1[j].z * v1[j].z + v1[j].w * v1[j].w;
  }
  s0 = wave_sum(s0);
  s1 = wave_sum(s1);
  const float r0 = rsqrtf(s0 * (1.f / 2048.f) + 1e-6f), r1 = rsqrtf(s1 * (1.f / 2048.f) + 1e-6f);
#pragma unroll
  for (int j = 0; j < 8; ++j) {
    const float4 gg = *(const float4*)(g + j * 256 + lane * 4);
    u32x2 a, c;
    a[0] = pack2(v0[j].x * r0 * gg.x, v0[j].y * r0 * gg.y); a[1] = pack2(v0[j].z * r0 * gg.z, v0[j].w * r0 * gg.w);
    c[0] = pack2(v1[j].x * r1 * gg.x, v1[j].y * r1 * gg.y); c[1] = pack2(v1[j].z * r1 * gg.z, v1[j].w * r1 * gg.w);
    *(u32x2*)(o0 + j * 256 + lane * 4) = a;
    *(u32x2*)(o1 + j * 256 + lane * 4) = c;
  }
}

DI void convert_f32_bf16(const float* __restrict__ src, bfr* __restrict__ dst, long n8) {
  for (long i = (long)blockIdx.x * NTHREADS + threadIdx.x; i < n8; i += (long)gridDim.x * NTHREADS) {
    const float4 a = *(const float4*)(src + i * 8);
    const float4 b = *(const float4*)(src + i * 8 + 4);
    u32x4 o;
    o[0] = pack2(a.x, a.y); o[1] = pack2(a.z, a.w); o[2] = pack2(b.x, b.y); o[3] = pack2(b.z, b.w);
    *(u32x4*)(dst + i * 8) = o;
  }
}

DI void transpose_strip(const float* __restrict__ W, int K, int N, int k0, int n0, bfr* __restrict__ Wt, float* tile,
                        const float* colscale, const float* rowscale) {
  const int tid = threadIdx.x;
  __syncthreads();
  {
    const int c4 = tid & 63, r = tid >> 6;
    float4 v[8];
#pragma unroll
    for (int i = 0; i < 8; ++i) v[i] = ldnt4(W + (size_t)(k0 + r + 8 * i) * N + n0 + c4 * 4);
#pragma unroll
    for (int i = 0; i < 8; ++i) {
      float* t = tile + (r + 8 * i) * 257 + c4 * 4;
      t[0] = v[i].x; t[1] = v[i].y; t[2] = v[i].z; t[3] = v[i].w;
    }
  }
  __syncthreads();
#pragma unroll
  for (int j = 0; j < 4; ++j) {
    const int task = tid + 512 * j, n = task >> 3, kc = task & 7;
    const float csv = colscale ? colscale[n0 + n] : 1.0f;
    u32x4 o;
#pragma unroll
    for (int e = 0; e < 4; ++e) {
      const int k = kc * 8 + 2 * e;
      const float r0 = rowscale ? rowscale[k0 + k] : 1.0f, r1 = rowscale ? rowscale[k0 + k + 1] : 1.0f;
      o[e] = pack2(tile[k * 257 + n] * csv * r0, tile[(k + 1) * 257 + n] * csv * r1);
    }
    *(u32x4*)(Wt + (size_t)(n0 + n) * K + k0 + kc * 8) = o;
  }
}

template <bool isv>
DI void quant_rows_fp4(const Params& p, int worker, int nworkers, int lane) {
  const float* tbl = isv ? p.w_v : p.w_u;
  float* scl = isv ? p.sv : p.su;
  unsigned char* out8 = isv ? p.wV8 : p.wU8;
  float4 gg[8];
  if (!isv) {
#pragma unroll
    for (int j = 0; j < 2; ++j)
#pragma unroll
      for (int q = 0; q < 4; ++q) gg[j * 4 + q] = *(const float4*)(p.g_ffn + j * 1024 + lane * 16 + q * 4);
  }
  auto finish = [&](float4 (&v)[8], int rr) {
    float amax = 0.f;
#pragma unroll
    for (int i = 0; i < 8; ++i) {
      if (!isv) { v[i].x *= gg[i].x; v[i].y *= gg[i].y; v[i].z *= gg[i].z; v[i].w *= gg[i].w; }
      amax = fmaxf(amax, fmaxf(fmaxf(fabsf(v[i].x), fabsf(v[i].y)), fmaxf(fabsf(v[i].z), fabsf(v[i].w))));
    }
#pragma unroll
    for (int o = 32; o >= 1; o >>= 1) amax = fmaxf(amax, __shfl_xor(amax, o));
    const float inv = amax > 0.f ? 6.0f / amax : 0.f;
    if (lane == 0) scl[rr] = amax * (1.f / 6.0f);
    u32x4 o4;
#pragma unroll
    for (int c = 0; c < 4; ++c) {
      const float4 t0 = v[2 * c], t1 = v[2 * c + 1];
      unsigned w = 0;
      w = __builtin_amdgcn_cvt_scalef32_pk_fp4_f32(w, t0.x * inv, t0.y * inv, 1.0f, 0);
      w = __builtin_amdgcn_cvt_scalef32_pk_fp4_f32(w, t0.z * inv, t0.w * inv, 1.0f, 1);
      w = __builtin_amdgcn_cvt_scalef32_pk_fp4_f32(w, t1.x * inv, t1.y * inv, 1.0f, 2);
      w = __builtin_amdgcn_cvt_scalef32_pk_fp4_f32(w, t1.z * inv, t1.w * inv, 1.0f, 3);
      o4[c] = w;
    }
    *(u32x4*)(out8 + (size_t)rr * 1024 + lane * 16) = o4;
  };
  for (int rr = worker; rr < 16384; rr += 2 * nworkers) {
    const int rb = rr + nworkers;
    const bool hasb = rb < 16384;
    const float* s0 = tbl + (size_t)rr * 2048;
    const float* s1 = tbl + (size_t)(hasb ? rb : rr) * 2048;
    float4 va[8], vb[8];
#pragma unroll
    for (int j = 0; j < 2; ++j)
#pragma unroll
      for (int q = 0; q < 4; ++q) va[j * 4 + q] = ldnt4(s0 + j * 1024 + lane * 16 + q * 4);
#pragma unroll
    for (int j = 0; j < 2; ++j)
#pragma unroll
      for (int q = 0; q < 4; ++q) vb[j * 4 + q] = ldnt4(s1 + j * 1024 + lane * 16 + q * 4);
    finish(va, rr);
    if (hasb) finish(vb, rb);
  }
}

DI void phase_prep(const Params& p, char* smem) {
  const int lane = threadIdx.x & 63, wid = threadIdx.x >> 6;
  for (int r2 = blockIdx.x * 8 + wid; r2 < (T_TOK + 1024) / 2; r2 += gridDim.x * 8) {
    const int r = 2 * r2;
    if (r < T_TOK) rms_rows2_to_bf16(p.x + (size_t)r * 2048, p.x + (size_t)(r + 1) * 2048, p.g_mix, p.hbuf + (size_t)r * 2048, p.hbuf + (size_t)(r + 1) * 2048, lane);
    else rms_rows2_to_bf16(p.mem + (size_t)(r - T_TOK) * 2048, p.mem + (size_t)(r + 1 - T_TOK) * 2048, p.g_mem, p.memn + (size_t)(r - T_TOK) * 2048, p.memn + (size_t)(r + 1 - T_TOK) * 2048, lane);
  }
  {
    float* tile = (float*)smem;
    struct Strip { const float* W; bfr* Wt; int K, N, k0, n0; const float* cs; const float* rsc; };
    auto strip_of = [&](int id0) {
      Strip d; d.cs = nullptr; d.rsc = nullptr;
      int id = id0;
      if (id < 512) { d.W = p.w_in; d.Wt = p.wInT; d.K = 2048; d.N = 4096; }
      else if ((id -= 512) < 256) { d.W = p.w_out; d.Wt = p.wOutT; d.K = 2048; d.N = 2048; }
      else if ((id -= 256) < 256) { d.W = p.w_pq; d.Wt = p.wPqT; d.K = 2048; d.N = 2048; d.rsc = p.g_ffn; }
      else if ((id -= 256) < 64) { d.W = p.w_cq; d.Wt = p.wCqT; d.K = 2048; d.N = 512; d.rsc = p.g_cross; }
      else if ((id -= 64) < 64) { d.W = p.w_ck; d.Wt = p.wCkT; d.K = 2048; d.N = 512; }
      else if ((id -= 64) < 64) { d.W = p.w_cv; d.Wt = p.wCvT; d.K = 2048; d.N = 512; }
      else if ((id -= 64) < 64) { d.W = p.w_co; d.Wt = p.wCoT; d.K = 512; d.N = 2048; }
      else { id -= 64; const int g = id >> 2; id &= 3; d.W = p.w_pool + g * 65536; d.Wt = p.wPoolT + g * 65536; d.K = 256; d.N = 256; d.cs = p.pool_scale + g * 256; }
      const int ntn = d.N >> 8;
      d.k0 = (id / ntn) * 64; d.n0 = (id % ntn) * 256;
      return d;
    };
    const int tid = threadIdx.x, c4 = tid & 63, r = tid >> 6;
    float4 v[8];
    auto load_strip = [&](const Strip& d) {
#pragma unroll
      for (int i = 0; i < 8; ++i) v[i] = ldnt4(d.W + (size_t)(d.k0 + r + 8 * i) * d.N + d.n0 + c4 * 4);
    };
    int id0 = blockIdx.x;
    Strip cur = strip_of(id0 < 1296 ? id0 : 0);
    if (id0 < 1296) load_strip(cur);
    for (; id0 < 1296; id0 += gridDim.x) {
      __syncthreads();
#pragma unroll
      for (int i = 0; i < 8; ++i) {
        float* t = tile + (r + 8 * i) * 257 + c4 * 4;
        t[0] = v[i].x; t[1] = v[i].y; t[2] = v[i].z; t[3] = v[i].w;
      }
      const int nid = id0 + gridDim.x;
      Strip nxt = strip_of(nid < 1296 ? nid : 0);
      if (nid < 1296) load_strip(nxt);
      __syncthreads();
#pragma unroll
      for (int j = 0; j < 4; ++j) {
        const int task = tid + 512 * j, n = task >> 3, kc = task & 7;
        const float csv = cur.cs ? cur.cs[cur.n0 + n] : 1.0f;
        u32x4 o;
#pragma unroll
        for (int e = 0; e < 4; ++e) {
          const int k = kc * 8 + 2 * e;
          const float r0 = cur.rsc ? cur.rsc[cur.k0 + k] : 1.0f, r1 = cur.rsc ? cur.rsc[cur.k0 + k + 1] : 1.0f;
          o[e] = pack2(tile[k * 257 + n] * csv * r0, tile[(k + 1) * 257 + n] * csv * r1);
        }
        *(u32x4*)(cur.Wt + (size_t)(cur.n0 + n) * cur.K + cur.k0 + kc * 8) = o;
      }
      cur = nxt;
    }
  }
  for (int i = blockIdx.x * NTHREADS + threadIdx.x; i < T_TOK; i += gridDim.x * NTHREADS) { p.rowss1[i] = 0.f; p.rowss2[i] = 0.f; }
  for (int i = blockIdx.x * NTHREADS + threadIdx.x; i < T_TOK * 16; i += gridDim.x * NTHREADS) {
    const int j = i & 15;
    const float inv = exp2f(-(float)j * (18.931568569324174f / 16.0f));
    float sn, cs;
    sincosf((float)p.pos[i >> 4] * inv, &sn, &cs);
    *(float2*)(p.ropetab + (size_t)i * 2) = make_float2(cs, sn);
  }
  convert_f32_bf16(p.sk1f, p.sk1, 128 * 128 / 8);
  convert_f32_bf16(p.sk2f, p.sk2, 128 * 128 / 8);
  quant_rows_fp4<true>(p, blockIdx.x * 8 + wid, gridDim.x * 8, lane);
}

DI void phase_inproj(const Params& p, char* smem) {
  auto epi = [&](const Acc8& acc0, int pm, int pn, int wr, int wc, int fr, int fq) {
    const int region = pn >> 2;
    if (region == 0) {
      G8_FOREACH8(acc0, pm, pn, wr, wc, fr, fq, ai, bj, m, row, col) {
        *(u32x4*)(p.pbuf + (size_t)row * 1024 + col) = pack8(acc0[ai][bj][m][0], acc0[ai][bj][m][1], 1.0f);
      }
    } else {
      bfr* dst = (region == 1) ? p.qbuf : (region == 2 ? p.kbuf : p.vbuf);
      const float scale = (region == 1) ? 0.08838834764831845f : 1.0f;
      const bool rope = (region != 3) && (wc == 0);
#pragma unroll
      for (int ai = 0; ai < 2; ++ai)
#pragma unroll
        for (int m = 0; m < 4; ++m) {
          const int row = 256 * pm + 128 * ai + 64 * wr + 16 * m + fr;
          const int b = row >> 12, t = row & 4095;
          float sn[8], cs[8];
          if (rope) {
            const float4* tp = (const float4*)(p.ropetab + ((size_t)row * 16 + 8 * (fq & 1)) * 2);
#pragma unroll
            for (int e2 = 0; e2 < 4; ++e2) {
              const float4 t = tp[e2];
              cs[2 * e2] = t.x; sn[2 * e2] = t.y; cs[2 * e2 + 1] = t.z; sn[2 * e2 + 1] = t.w;
            }
          }
#pragma unroll
          for (int bj = 0; bj < 2; ++bj) {
            const int h = (pn & 3) * 2 + bj;
            f32x4 v0 = acc0[ai][bj][m][0], v1 = acc0[ai][bj][m][1];
            if (rope) {
#pragma unroll
              for (int i = 0; i < 4; ++i) {
                const float o0 = __shfl_xor(v0[i], 32), o1 = __shfl_xor(v1[i], 32);
                v0[i] = (fq < 2) ? v0[i] * cs[i] - o0 * sn[i] : v0[i] * cs[i] + o0 * sn[i];
                v1[i] = (fq < 2) ? v1[i] * cs[4 + i] - o1 * sn[4 + i] : v1[i] * cs[4 + i] + o1 * sn[4 + i];
              }
            }
            bfr* drow = dst + ((size_t)((b * 8 + h) * 4096 + t)) * 128 + 32 * wc + 8 * fq;
            *(u32x4*)(drow) = pack8(v0, v1, scale);
          }
        }
    }
  };
  gemm8((LAS unsigned char*)smem, p.hbuf, 2048, p.wInT, T_TOK, 4096, 2048, gridDim.x, blockIdx.x, epi);
}

DI void phase_mix_attn(const Params& p, char* smem) {
  const int tid = threadIdx.x, lane = tid & 63, w = tid >> 6, fr = lane & 15, fq = lane >> 4;
  {
    char* sK = smem;
    char* sV = smem + 65536;
    u32x4 kr[8], vr[8];
    bf16x8 qn[4];
    int pend_key0 = 0;
    auto decode = [&](int id, int& br, int& dl, int& bh, int& r, int& l0) {
      br = id >> 10;
      const int rem = id & 1023;
      dl = (br == 0) ? 1 : (br == 1 ? 4 : 16);
      const int nblk = 32 / dl;
      bh = rem >> 5;
      const int rn = rem & 31;
      r = rn / nblk;
      l0 = (rn % nblk) * 128;
    };
    auto issueK = [&](int id) {
      int br, dl, bh, r, l0;
      decode(id, br, dl, bh, r, l0);
      const size_t base = (size_t)bh * 4096 * 128 + (size_t)r * 128;
      const bfr* Kb = p.kbuf + base;
      const int kvstride = dl * 128, key0 = l0 - 128;
#pragma unroll
      for (int i = 0; i < 8; ++i) {
        const int e = tid + i * 512, key = e >> 4, c = e & 15, lk = key0 + key;
        const int lkc = lk < 0 ? 0 : lk;
        kr[i] = *(const u32x4*)(Kb + (long)lkc * kvstride + c * 8);
      }
      pend_key0 = key0;
    };
    auto issueVQ = [&](int id) {
      int br, dl, bh, r, l0;
      decode(id, br, dl, bh, r, l0);
      const size_t base = (size_t)bh * 4096 * 128 + (size_t)r * 128;
      const bfr* Vb = p.vbuf + base;
      const int kvstride = dl * 128, key0 = l0 - 128;
#pragma unroll
      for (int i = 0; i < 8; ++i) {
        const int e = tid + i * 512, key = e >> 4, c = e & 15, lk = key0 + key;
        const int lkc = lk < 0 ? 0 : lk;
        vr[i] = *(const u32x4*)(Vb + (long)lkc * kvstride + c * 8);
      }
      const bfr* qrow = p.qbuf + base + (long)(l0 + w * 16 + fr) * kvstride;
#pragma unroll
      for (int kk = 0; kk < 4; ++kk) qn[kk] = *(const bf16x8*)(qrow + kk * 32 + fq * 8);
    };
    const bool remap = (gridDim.x == 256);
    const int nround = remap ? 12 : (3072 + (int)gridDim.x - 1) / (int)gridDim.x;
    auto item_of = [&](int k) -> int {
      if (!remap) return k * (int)gridDim.x + (int)blockIdx.x;
      const int xcd = blockIdx.x & 7, slot = blockIdx.x >> 3;
      const int bh = (k / 3) * 8 + xcd, br = k % 3;
      return (br * 32 + bh) * 32 + slot;
    };
    if (item_of(0) < 3072) { issueK(item_of(0)); issueVQ(item_of(0)); }
    for (int k = 0; k < nround; ++k) {
      const int id = item_of(k);
      if (id >= 3072) break;
      __syncthreads();
#pragma unroll
      for (int i = 0; i < 8; ++i) {
        const int e = tid + i * 512, key = e >> 4, c = e & 15;
        const unsigned msk = (pend_key0 + key) < 0 ? 0u : 0xffffffffu;
        const u32x4 m4 = u32x4{msk, msk, msk, msk};
        *(u32x4*)(sK + key * 256 + ((c ^ (key & 15)) << 4)) = kr[i] & m4;
        *(u32x4*)(sV + key * 288 + c * 16) = vr[i] & m4;
      }
      bf16x8 qf[4];
#pragma unroll
      for (int kk = 0; kk < 4; ++kk) qf[kk] = qn[kk];
      __syncthreads();
      const int nid = (k + 1 < nround) ? item_of(k + 1) : 3072;
      if (nid < 3072) issueK(nid);
      int br, dl, bh, r, l0;
      decode(id, br, dl, bh, r, l0);
      float mx, l;
      const int b = bh >> 3, h = bh & 7;
      const int tt = b * 4096 + (l0 + w * 16 + fr) * dl + r;
      bfr* obase = p.ob + (size_t)br * T_TOK * 1024 + h * 128;
      const int tq0 = b * 4096 + r, lw = l0 + w * 16;
      attn_compute<true>(qf, l0, l0 - 128, smem,
                         [&](int q) { return obase + (size_t)(tq0 + (lw + q) * dl) * 1024; }, mx, l,
                         [&]() { if (nid < 3072) issueVQ(nid); });
      if (fq == 0) p.lse[(size_t)br * T_TOK * 8 + (size_t)tt * 8 + h] = mx + __builtin_amdgcn_logf(l);
    }
  }
  for (int id = 3072 + blockIdx.x; id < 3072 + 256; id += gridDim.x) {
    {
      const int ci = id - 3072;
      const int sub = tid >> 7, cgp = tid & 127;
      const int wdw = 2 << (cgp >> 5);
      const int t0 = ci * 64 + sub * 16, tin0 = t0 & 4095;
      const bfr* pb = p.pbuf + cgp * 8;
      float sum[8];
#pragma unroll
      for (int e = 0; e < 8; ++e) sum[e] = 0.f;
      u32x4 hv[15];
#pragma unroll
      for (int j = 1; j < 16; ++j) {
        const bool ok = (j < wdw) && (tin0 - j >= 0);
        const unsigned msk = ok ? 0xffffffffu : 0u;
        hv[j - 1] = *(const u32x4*)(pb + (size_t)(ok ? t0 - j : t0) * 1024) & u32x4{msk, msk, msk, msk};
      }
#pragma unroll
      for (int hb = 0; hb < 2; ++hb) {
        u32x4 cv[8], sv[8];
#pragma unroll
        for (int s2 = 0; s2 < 8; ++s2) {
          const int so = hb * 8 + s2;
          cv[s2] = *(const u32x4*)(pb + (size_t)(t0 + so) * 1024);
          const bool ok = (tin0 + so - wdw + 1 >= 0);
          const unsigned msk = ok ? 0xffffffffu : 0u;
          sv[s2] = *(const u32x4*)(pb + (size_t)(ok ? t0 + so - wdw + 1 : t0) * 1024) & u32x4{msk, msk, msk, msk};
        }
        if (hb == 0) {
#pragma unroll
          for (int j = 0; j < 15; ++j)
#pragma unroll
            for (int e = 0; e < 4; ++e) { sum[2 * e] += bflo(hv[j][e]); sum[2 * e + 1] += bfhi(hv[j][e]); }
        }
#pragma unroll
        for (int s2 = 0; s2 < 8; ++s2) {
          const int so = hb * 8 + s2, t = t0 + so, tin = tin0 + so;
          float cur[8];
#pragma unroll
          for (int e = 0; e < 4; ++e) { cur[2 * e] = bflo(cv[s2][e]); cur[2 * e + 1] = bfhi(cv[s2][e]); }
          const float ic = 1.f / (float)min(tin + 1, wdw);
          u32x4 ov;
#pragma unroll
          for (int e = 0; e < 8; ++e) sum[e] += cur[e];
#pragma unroll
          for (int e = 0; e < 4; ++e) ov[e] = pack2(sum[2 * e] * ic - cur[2 * e], sum[2 * e + 1] * ic - cur[2 * e + 1]);
          *(u32x4*)(p.mixed + (size_t)t * 1024 + cgp * 8) = ov;
#pragma unroll
          for (int e = 0; e < 4; ++e) { sum[2 * e] -= bflo(sv[s2][e]); sum[2 * e + 1] -= bfhi(sv[s2][e]); }
        }
      }
    }
  }
}

DI void phase_pool_combine(const Params& p, char* smem) {
  const int tid = threadIdx.x;
  {
    auto epi = [&](const Acc8& acc0, int pm, int pn, int wr, int wc, int fr, int fq) {
      G8_FOREACH8(acc0, pm, pn, wr, wc, fr, fq, ai, bj, m, row, col) {
        *(u32x4*)(p.hbuf + (size_t)row * 2048 + col) = pack8(acc0[ai][bj][m][0], acc0[ai][bj][m][1], 1.0f);
      }
    };
    gemm8((LAS unsigned char*)smem, p.mixed, 1024, p.wPoolT, T_TOK, 1024, 256, gridDim.x, blockIdx.x, epi, 512);
  }
  {
    const long total = (long)T_TOK * 8 * 16, stride = (long)gridDim.x * NTHREADS;
    for (long i0 = (long)blockIdx.x * NTHREADS + tid; i0 < total; i0 += 4 * stride) {
      float l0[4], l1[4], l2[4];
      u32x4 a[4], b[4], c[4];
      size_t dsto[4];
      bool ok[4];
#pragma unroll
      for (int u = 0; u < 4; ++u) {
        const long i = i0 + u * stride;
        ok[u] = i < total;
        const long ic = ok[u] ? i : i0;
        const int dc = (int)(ic & 15), h = (int)((ic >> 4) & 7);
        const long tt = ic >> 7;
        l0[u] = p.lse[tt * 8 + h]; l1[u] = p.lse[(size_t)T_TOK * 8 + tt * 8 + h]; l2[u] = p.lse[(size_t)2 * T_TOK * 8 + tt * 8 + h];
        const size_t off = (size_t)tt * 1024 + h * 128 + dc * 8;
        a[u] = *(const u32x4*)(p.ob + off);
        b[u] = *(const u32x4*)(p.ob + (size_t)T_TOK * 1024 + off);
        c[u] = *(const u32x4*)(p.ob + (size_t)2 * T_TOK * 1024 + off);
        dsto[u] = (size_t)tt * 2048 + 1024 + h * 128 + dc * 8;
      }
#pragma unroll
      for (int u = 0; u < 4; ++u) {
        const float mx = fmaxf(l0[u], fmaxf(l1[u], l2[u]));
        float w0 = __builtin_amdgcn_exp2f(l0[u] - mx), w1 = __builtin_amdgcn_exp2f(l1[u] - mx), w2 = __builtin_amdgcn_exp2f(l2[u] - mx);
        const float inv = 1.f / (w0 + w1 + w2);
        w0 *= inv; w1 *= inv; w2 *= inv;
        u32x4 o;
#pragma unroll
        for (int e = 0; e < 4; ++e)
          o[e] = pack2(w0 * bflo(a[u][e]) + w1 * bflo(b[u][e]) + w2 * bflo(c[u][e]), w0 * bfhi(a[u][e]) + w1 * bfhi(b[u][e]) + w2 * bfhi(c[u][e]));
        if (ok[u]) *(u32x4*)(p.hbuf + dsto[u]) = o;
      }
    }
  }
}

template <bool RESID_BF16>
DI void phase_gemm_resid(const bfr* A, int lda, const bfr* Bt, int K, const void* resid, bfr* xb, float* rowss, char* smem) {
  auto epi = [&](const Acc8& acc0, int pm, int pn, int wr, int wc, int fr, int fq) {
#pragma unroll
    for (int ai = 0; ai < 2; ++ai)
#pragma unroll
      for (int m = 0; m < 4; ++m) {
        const int row = 256 * pm + 128 * ai + 64 * wr + 16 * m + fr;
        float ss = 0.f;
#pragma unroll
        for (int bj = 0; bj < 2; ++bj) {
          const int col = 256 * pn + 128 * bj + 32 * wc + 8 * fq;
          const f32x4 v0 = acc0[ai][bj][m][0], v1 = acc0[ai][bj][m][1];
          float r[8];
          if (RESID_BF16) {
            const u32x4 t = *(const u32x4*)((const bfr*)resid + (size_t)row * 2048 + col);
#pragma unroll
            for (int e = 0; e < 4; ++e) { r[2 * e] = bflo(t[e]); r[2 * e + 1] = bfhi(t[e]); }
          } else {
            const float4 t0 = *(const float4*)((const float*)resid + (size_t)row * 2048 + col);
            const float4 t1 = *(const float4*)((const float*)resid + (size_t)row * 2048 + col + 4);
            r[0] = t0.x; r[1] = t0.y; r[2] = t0.z; r[3] = t0.w; r[4] = t1.x; r[5] = t1.y; r[6] = t1.z; r[7] = t1.w;
          }
          f32x4 o0, o1;
#pragma unroll
          for (int e = 0; e < 4; ++e) { o0[e] = r[e] + v0[e]; o1[e] = r[4 + e] + v1[e]; ss += o0[e] * o0[e] + o1[e] * o1[e]; }
          *(u32x4*)(xb + (size_t)row * 2048 + col) = pack8(o0, o1, 1.0f);
        }
        ss += __shfl_xor(ss, 16);
        ss += __shfl_xor(ss, 32);
        if (fq == 0) atomicAdd(rowss + row, ss);
      }
  };
  gemm8((LAS unsigned char*)smem, A, lda, Bt, T_TOK, 2048, K, gridDim.x, blockIdx.x, epi);
}

DI void phase_gemm_pq(const Params& p, char* smem) {
  auto epi = [&](const Acc8& acc0, int pm, int pn, int wr, int wc, int fr, int fq) {
    G8_FOREACH8(acc0, pm, pn, wr, wc, fr, fq, ai, bj, m, row, col) {
      const float rs = rsqrtf(p.rowss2[row] * (1.f / 2048.f) + 1e-6f);
      *(u32x4*)(p.pq + (size_t)row * 2048 + col) = pack8(acc0[ai][bj][m][0], acc0[ai][bj][m][1], rs);
    }
  };
  gemm8((LAS unsigned char*)smem, p.hbuf, 2048, p.wPqT, T_TOK, 2048, 2048, gridDim.x, blockIdx.x, epi);
}
DI void phase_cross_proj(const Params& p, char* smem) {
  const int half = gridDim.x >> 1;
  if ((int)blockIdx.x < half) {
    auto epi = [&](const Acc8& acc0, int pm, int pn, int wr, int wc, int fr, int fq) {
      G8_FOREACH8(acc0, pm, pn, wr, wc, fr, fq, ai, bj, m, row, col) {
        const float scale = 0.08838834764831845f * rsqrtf(p.rowss1[row] * (1.f / 2048.f) + 1e-6f);
        *(u32x4*)(p.qc + (size_t)row * 512 + col) = pack8(acc0[ai][bj][m][0], acc0[ai][bj][m][1], scale);
      }
    };
    gemm8((LAS unsigned char*)smem, p.x2b, 2048, p.wCqT, T_TOK, 512, 2048, half, blockIdx.x, epi);
  } else if ((int)blockIdx.x < half + 16) {
    auto epi = [&](const Acc8& acc0, int pm, int pn, int wr, int wc, int fr, int fq) {
      G8_FOREACH8(acc0, pm, pn, wr, wc, fr, fq, ai, bj, m, row, col) {
        bfr* dst = (col < 512) ? p.kc : p.vc;
        const int cc = col & 511, hh = cc >> 7, d = cc & 127, bb = row >> 8, mm = row & 255;
        *(u32x4*)(dst + ((size_t)((bb * 4 + hh) * 256 + mm)) * 128 + d) = pack8(acc0[ai][bj][m][0], acc0[ai][bj][m][1], 1.0f);
      }
    };
    gemm8((LAS unsigned char*)smem, p.memn, 2048, p.wCkT, 1024, 1024, 2048, 16, blockIdx.x - half, epi);
  } else {
    const int nidle = gridDim.x - (half + 16);
    quant_rows_fp4<false>(p, (blockIdx.x - (half + 16)) * 8 + (threadIdx.x >> 6), nidle * 8, threadIdx.x & 63);
  }
}

DI void phase_cross_attn(const Params& p, char* smem) {
  const int tid = threadIdx.x, lane = tid & 63, w = tid >> 6, fr = lane & 15, fq = lane >> 4;
  for (int id = blockIdx.x; id < 512; id += gridDim.x) {
    const int b = id >> 7, h = (id >> 5) & 3, qt = id & 31;
    float mx, l;
    const size_t kvb = (size_t)(b * 4 + h) * 256 * 128;
    bfr* obase = p.oc + (size_t)(b * 4096 + qt * 128 + w * 16) * 512 + h * 128;
    attn_core<false>(p.qc + (size_t)b * 4096 * 512 + h * 128, 512, qt * 128, p.kc + kvb, p.vc + kvb, 128, 0, smem,
                     [&](int q) { return obase + (size_t)q * 512; }, mx, l);
  }
}

DI void bitonic_sort16_desc(int (&mg)[16]);
DI void top16_of_32(int (&a)[16], int (&b)[16]);
template <unsigned AMASK>
DI void route_cands(int (&top)[16], const float (&v1)[16], const float (&v2)[16]) {
  int ca[16], cb[16];
#pragma unroll
  for (int j = 0; j < 16; ++j) { ca[j] = (int)0x80000000; cb[j] = (int)0x80000000; }
  int c = 0;
#pragma unroll
  for (int a = 0; a < 16; ++a)
#pragma unroll
    for (int b = 0; b < 16; ++b)
      if (((AMASK >> a) & 1u) && (a + 1) * (b + 1) <= 16) {
        const int key = (f2sort(v1[a] + v2[b]) & ~0xFF) | (a * 16 + b);
        if (c < 16) ca[c] = key; else cb[c - 16] = key;
        ++c;
      }
  top16_of_32(ca, cb);
#pragma unroll
  for (int j = 0; j < 16; ++j) top[j] = ca[j];
}
DI void bitonic_sort16_desc(int (&mg)[16]) {
#pragma unroll
  for (int st = 8; st >= 1; st >>= 1)
#pragma unroll
    for (int i = 0; i < 16; ++i)
      if ((i & st) == 0) { const int hi = max(mg[i], mg[i + st]), lo = min(mg[i], mg[i + st]); mg[i] = hi; mg[i + st] = lo; }
}

DI void sort16_desc(int (&x)[16]) {
#pragma unroll
  for (int k = 2; k <= 16; k <<= 1)
#pragma unroll
    for (int j = k >> 1; j > 0; j >>= 1)
#pragma unroll
      for (int i = 0; i < 16; ++i) {
        const int l = i ^ j;
        if (l > i) {
          const int hi = max(x[i], x[l]), lo = min(x[i], x[l]);
          const bool desc = ((i & k) == 0);
          x[i] = desc ? hi : lo;
          x[l] = desc ? lo : hi;
        }
      }
}
DI void top16_of_32(int (&a)[16], int (&b)[16]) {
  sort16_desc(a);
  sort16_desc(b);
#pragma unroll
  for (int i = 0; i < 16; ++i) a[i] = max(a[i], b[15 - i]);
  bitonic_sort16_desc(a);
}
DI void phase_peer_route(const Params& p, char* smem) {
  const int tid = threadIdx.x, lane = tid & 63, w = tid >> 6, fr = lane & 15, fq = lane >> 4;
  char* sSK = smem;
  float* scores = (float*)(smem + 65536);
  int* lists = (int*)(smem + 65536 + 67584);
  int* tops = (int*)(smem + 65536);
  constexpr unsigned AM0 = (1u << 0) | (1u << 3) | (1u << 5) | (1u << 8) | (1u << 9) | (1u << 10) | (1u << 11);
  __syncthreads();
#pragma unroll
  for (int i = 0; i < 8; ++i) {
    const int id = tid + i * 512, key = id >> 4, c = id & 15;
    const bfr* src = (key < 128 ? p.sk1 : p.sk2) + (key & 127) * 128 + c * 8;
    *(u32x4*)(sSK + key * 256 + ((c ^ (key & 15)) << 4)) = *(const u32x4*)src;
  }
  for (int id = blockIdx.x; id < 2048; id += gridDim.x) {
    const int tt = id >> 3, h = id & 7;
    const int tok0 = tt * 64;
    __syncthreads();
    {
      const int tg = w & 3, hf = w >> 2;
      const bfr* arow = p.pq + (size_t)(tok0 + tg * 16 + fr) * 2048 + h * 256 + hf * 128;
      bf16x8 af[4];
#pragma unroll
      for (int kk = 0; kk < 4; ++kk) af[kk] = *(const bf16x8*)(arow + kk * 32 + fq * 8);
#pragma unroll
      for (int nt = 0; nt < 8; ++nt) {
        f32x4 a = f32x4{0.f, 0.f, 0.f, 0.f};
        const int key = hf * 128 + nt * 16 + fr;
#pragma unroll
        for (int kk = 0; kk < 4; ++kk) {
          const bf16x8 bfg = *(const bf16x8*)(sSK + key * 256 + (((kk * 4 + fq) ^ fr) << 4));
          a = mfma16(af[kk], bfg, a);
        }
#pragma unroll
        for (int i = 0; i < 4; ++i) scores[(hf * 64 + tg * 16 + fq * 4 + i) * 132 + nt * 16 + fr] = a[i];
      }
    }
    __syncthreads();
    {
      const int row = tid >> 2, part = tid & 3;
      int lst[16], lsb[16];
      const float* srow = scores + row * 132 + part * 32;
#pragma unroll
      for (int k4 = 0; k4 < 4; ++k4) {
        const float4 v = *(const float4*)(srow + k4 * 4);
        const float4 u = *(const float4*)(srow + 16 + k4 * 4);
        const int kb = part * 32 + k4 * 4;
        lst[k4 * 4 + 0] = (f2sort(v.x) & ~0x7F) | (kb + 0);
        lst[k4 * 4 + 1] = (f2sort(v.y) & ~0x7F) | (kb + 1);
        lst[k4 * 4 + 2] = (f2sort(v.z) & ~0x7F) | (kb + 2);
        lst[k4 * 4 + 3] = (f2sort(v.w) & ~0x7F) | (kb + 3);
        lsb[k4 * 4 + 0] = (f2sort(u.x) & ~0x7F) | (kb + 16);
        lsb[k4 * 4 + 1] = (f2sort(u.y) & ~0x7F) | (kb + 17);
        lsb[k4 * 4 + 2] = (f2sort(u.z) & ~0x7F) | (kb + 18);
        lsb[k4 * 4 + 3] = (f2sort(u.w) & ~0x7F) | (kb + 19);
      }
      top16_of_32(lst, lsb);
      int mg[16];
#pragma unroll
      for (int i = 0; i < 16; ++i) mg[i] = max(lst[i], __shfl_xor(lst[15 - i], 1));
      bitonic_sort16_desc(mg);
#pragma unroll
      for (int i = 0; i < 16; ++i) lst[i] = max(mg[i], __shfl_xor(mg[15 - i], 2));
      bitonic_sort16_desc(lst);
      if (part == 0) {
#pragma unroll
        for (int j4 = 0; j4 < 4; ++j4) {
          int4 t; t.x = lst[j4 * 4]; t.y = lst[j4 * 4 + 1]; t.z = lst[j4 * 4 + 2]; t.w = lst[j4 * 4 + 3];
          *(int4*)(lists + row * 16 + j4 * 4) = t;
        }
      }
    }
    __syncthreads();
    int top[16];
#pragma unroll
    for (int j = 0; j < 16; ++j) top[j] = (int)0x80000000;
    const int tokl = tid & 63;
    if (tid < 128) {
      float v1[16], v2[16];
#pragma unroll
      for (int j4 = 0; j4 < 4; ++j4) {
        const int4 t1 = *(const int4*)(lists + tokl * 16 + j4 * 4);
        const int4 t2 = *(const int4*)(lists + (64 + tokl) * 16 + j4 * 4);
        v1[j4 * 4] = sort2f(t1.x & ~0x7F); v1[j4 * 4 + 1] = sort2f(t1.y & ~0x7F); v1[j4 * 4 + 2] = sort2f(t1.z & ~0x7F); v1[j4 * 4 + 3] = sort2f(t1.w & ~0x7F);
        v2[j4 * 4] = sort2f(t2.x & ~0x7F); v2[j4 * 4 + 1] = sort2f(t2.y & ~0x7F); v2[j4 * 4 + 2] = sort2f(t2.z & ~0x7F); v2[j4 * 4 + 3] = sort2f(t2.w & ~0x7F);
      }
      if (tid < 64) {
        route_cands<AM0>(top, v1, v2);
      } else {
        route_cands<(~AM0) & 0xFFFFu>(top, v1, v2);
#pragma unroll
        for (int j4 = 0; j4 < 4; ++j4) {
          int4 t; t.x = top[j4 * 4]; t.y = top[j4 * 4 + 1]; t.z = top[j4 * 4 + 2]; t.w = top[j4 * 4 + 3];
          *(int4*)(tops + tokl * 16 + j4 * 4) = t;
        }
      }
    }
    __syncthreads();
    if (tid < 64) {
      int fin[16];
#pragma unroll
      for (int j4 = 0; j4 < 4; ++j4) {
        const int4 t = *(const int4*)(tops + tid * 16 + (3 - j4) * 4);
        fin[j4 * 4 + 0] = max(top[j4 * 4 + 0], t.w);
        fin[j4 * 4 + 1] = max(top[j4 * 4 + 1], t.z);
        fin[j4 * 4 + 2] = max(top[j4 * 4 + 2], t.y);
        fin[j4 * 4 + 3] = max(top[j4 * 4 + 3], t.x);
      }
      int ex[16];
      float val[16];
      float mxv = -3.0e38f;
#pragma unroll
      for (int j = 0; j < 16; ++j) {
        const int code = fin[j] & 0xFF;
        const int i1 = lists[tid * 16 + (code >> 4)] & 0x7F;
        const int i2 = lists[(64 + tid) * 16 + (code & 15)] & 0x7F;
        ex[j] = i1 * 128 + i2;
        val[j] = sort2f(fin[j] & ~0xFF);
        mxv = fmaxf(mxv, val[j]);
      }
      float sum = 0.f;
      float ev[16];
#pragma unroll
      for (int j = 0; j < 16; ++j) { ev[j] = __expf(val[j] - mxv); sum += ev[j]; }
      const float inv = 1.f / sum;
      const size_t ob = (size_t)(tok0 + tid) * 128 + h * 16;
#pragma unroll
      for (int j4 = 0; j4 < 4; ++j4) {
        int4 iv; iv.x = ex[j4 * 4]; iv.y = ex[j4 * 4 + 1]; iv.z = ex[j4 * 4 + 2]; iv.w = ex[j4 * 4 + 3];
        float4 gv; gv.x = ev[j4 * 4] * inv; gv.y = ev[j4 * 4 + 1] * inv; gv.z = ev[j4 * 4 + 2] * inv; gv.w = ev[j4 * 4 + 3] * inv;
        *(int4*)(p.idx + ob + j4 * 4) = iv;
        *(float4*)(p.gates + ob + j4 * 4) = gv;
      }
    }
  }
}

DI float gelu_tanh(float a) {
  const float u = 0.7978845608028654f * (a + 0.044715f * a * a * a);
  return 0.5f * a * (1.f + tanhf(u));
}

#define SB() __builtin_amdgcn_sched_barrier(0)
DI void peer_load8u(u32x4 (&bufa)[8], const unsigned char* tbl, int idxv, int g, int lane) {
#pragma unroll
  for (int k = 0; k < 8; ++k) {
    const int e = __builtin_amdgcn_readlane(idxv, g * 8 + k);
    bufa[k] = *(const u32x4*)(tbl + (size_t)e * 1024 + lane * 16);
  }
}
DI float peer_dot8(const u32x4 (&bufa)[8], const f32x2 (&hp)[16], int lane) {
  float part[8];
#pragma unroll
  for (int k = 0; k < 8; ++k) {
    const u32x4 u = bufa[k];
    f32x2 a2 = f32x2{0.f, 0.f};
#pragma unroll
    for (int c = 0; c < 4; ++c) {
      const unsigned uu = u[c];
      a2 += __builtin_amdgcn_cvt_scalef32_pk_f32_fp4(uu, 1.0f, 0) * hp[c * 4 + 0];
      a2 += __builtin_amdgcn_cvt_scalef32_pk_f32_fp4(uu, 1.0f, 1) * hp[c * 4 + 1];
      a2 += __builtin_amdgcn_cvt_scalef32_pk_f32_fp4(uu, 1.0f, 2) * hp[c * 4 + 2];
      a2 += __builtin_amdgcn_cvt_scalef32_pk_f32_fp4(uu, 1.0f, 3) * hp[c * 4 + 3];
    }
    part[k] = a2[0] + a2[1];
  }
  const bool up4 = (lane & 4) != 0, up2 = (lane & 2) != 0, up1 = (lane & 1) != 0;
  float q[4];
#pragma unroll
  for (int i = 0; i < 4; ++i) {
    const float keep = up4 ? part[i + 4] : part[i];
    const float send = up4 ? part[i] : part[i + 4];
    q[i] = keep + __shfl_xor(send, 4);
  }
  float r[2];
#pragma unroll
  for (int i = 0; i < 2; ++i) {
    const float keep = up2 ? q[i + 2] : q[i];
    const float send = up2 ? q[i] : q[i + 2];
    r[i] = keep + __shfl_xor(send, 2);
  }
  float v = (up1 ? r[1] : r[0]) + __shfl_xor(up1 ? r[0] : r[1], 1);
  v += __shfl_xor(v, 8);
  v += __shfl_xor(v, 16);
  v += __shfl_xor(v, 32);
  return v;
}
DI void peer_acc8(const u32x4 (&bufa)[8], f32x2 (&ys)[16], float cval, int g) {
#pragma unroll
  for (int k = 0; k < 8; ++k) {
    const float ck = __builtin_bit_cast(float, __builtin_amdgcn_readlane(__builtin_bit_cast(int, cval), g * 8 + k));
    const u32x4 u = bufa[k];
#pragma unroll
    for (int c = 0; c < 4; ++c) {
      const unsigned uu = u[c];
      ys[c * 4 + 0] += __builtin_amdgcn_cvt_scalef32_pk_f32_fp4(uu, 1.0f, 0) * ck;
      ys[c * 4 + 1] += __builtin_amdgcn_cvt_scalef32_pk_f32_fp4(uu, 1.0f, 1) * ck;
      ys[c * 4 + 2] += __builtin_amdgcn_cvt_scalef32_pk_f32_fp4(uu, 1.0f, 2) * ck;
      ys[c * 4 + 3] += __builtin_amdgcn_cvt_scalef32_pk_f32_fp4(uu, 1.0f, 3) * ck;
    }
  }
}

DI void phase_peer_expert(const Params& p) {
  const int lane = threadIdx.x & 63, wid = threadIdx.x >> 6;
  bool flag4;
  {
    float c1 = 1.0f, c2 = 2.0f;
    asm volatile("" : "+v"(c1), "+v"(c2));
    const unsigned w4 = __builtin_amdgcn_cvt_scalef32_pk_fp4_f32(0u, c1, c2, 1.0f, 0);
    const f32x2 r4 = __builtin_amdgcn_cvt_scalef32_pk_f32_fp4(w4, 1.0f, 0);
    flag4 = (r4[0] == 2.0f);
  }
  const int tstride = gridDim.x * 8;
  int myidx[2] = {0, 0};
  float mygate[2] = {0.f, 0.f};
  u32x4 bufAa[8], bufBa[8];
  {
    const int tok0 = blockIdx.x * 8 + wid;
    if (tok0 < T_TOK) {
#pragma unroll
      for (int half = 0; half < 2; ++half) {
        myidx[half] = p.idx[(size_t)tok0 * 128 + half * 64 + lane];
        mygate[half] = p.gates[(size_t)tok0 * 128 + half * 64 + lane];
      }
      peer_load8u(bufAa, p.wU8, myidx[0], 0, lane);
    }
  }
  for (int tok = blockIdx.x * 8 + wid; tok < T_TOK; tok += tstride) {
    const int ntok = (tok + tstride < T_TOK) ? tok + tstride : tok;
    int nxidx[2];
    float nxgate[2];
#pragma unroll
    for (int half = 0; half < 2; ++half) {
      nxidx[half] = p.idx[(size_t)ntok * 128 + half * 64 + lane];
      nxgate[half] = p.gates[(size_t)ntok * 128 + half * 64 + lane];
    }
    const float rs2 = rsqrtf(p.rowss2[tok] * (1.f / 2048.f) + 1e-6f);
    f32x2 hs[16];
    {
      float he[32];
#pragma unroll
      for (int j = 0; j < 2; ++j)
#pragma unroll
        for (int q = 0; q < 2; ++q) {
          const u32x4 t = *(const u32x4*)(p.hbuf + (size_t)tok * 2048 + j * 1024 + lane * 16 + q * 8);
#pragma unroll
          for (int c = 0; c < 4; ++c) { const unsigned tt = t[c]; he[j * 16 + q * 8 + c * 2] = bflo(tt); he[j * 16 + q * 8 + c * 2 + 1] = bfhi(tt); }
        }
#pragma unroll
      for (int i = 0; i < 16; ++i) {
        const float n0 = he[2 * i], n1 = he[2 * i + 1];
        hs[i] = f32x2{flag4 ? n1 : n0, flag4 ? n0 : n1};
      }
    }
    f32x2 ys[16];
#pragma unroll
    for (int e = 0; e < 16; ++e) ys[e] = f32x2{0.f, 0.f};
#pragma unroll 1
    for (int half = 0; half < 2; ++half) {
      const int idxv = half ? myidx[1] : myidx[0];
      const float gate = half ? mygate[1] : mygate[0];
      const float mysu = p.su[idxv], mysv = p.sv[idxv];
      float amine = 0.f;
#pragma unroll 1
      for (int g2 = 0; g2 < 3; ++g2) {
        peer_load8u(bufBa, p.wU8, idxv, 2 * g2 + 1, lane);
        SB();
        { const float v = peer_dot8(bufAa, hs, lane); if ((lane >> 3) == 2 * g2) amine = v; }
        SB();
        peer_load8u(bufAa, p.wU8, idxv, 2 * g2 + 2, lane);
        SB();
        { const float v = peer_dot8(bufBa, hs, lane); if ((lane >> 3) == 2 * g2 + 1) amine = v; }
        SB();
      }
      {
        peer_load8u(bufBa, p.wU8, idxv, 7, lane);
        SB();
        { const float v = peer_dot8(bufAa, hs, lane); if ((lane >> 3) == 6) amine = v; }
        SB();
        peer_load8u(bufAa, p.wV8, idxv, 0, lane);
        SB();
        { const float v = peer_dot8(bufBa, hs, lane); if ((lane >> 3) == 7) amine = v; }
        SB();
      }
      const float cval = gate * gelu_tanh(amine * mysu * rs2) * mysv;
      const int nidx = half ? nxidx[0] : myidx[1];
#pragma unroll 1
      for (int g2 = 0; g2 < 3; ++g2) {
        peer_load8u(bufBa, p.wV8, idxv, 2 * g2 + 1, lane);
        SB();
        peer_acc8(bufAa, ys, cval, 2 * g2);
        SB();
        peer_load8u(bufAa, p.wV8, idxv, 2 * g2 + 2, lane);
        SB();
        peer_acc8(bufBa, ys, cval, 2 * g2 + 1);
        SB();
      }
      {
        peer_load8u(bufBa, p.wV8, idxv, 7, lane);
        SB();
        peer_acc8(bufAa, ys, cval, 6);
        SB();
        peer_load8u(bufAa, p.wU8, nidx, 0, lane);
        SB();
        peer_acc8(bufBa, ys, cval, 7);
        SB();
      }
    }
    float ss = 0.f;
#pragma unroll
    for (int i = 0; i < 16; ++i) { ys[i] += hs[i]; ss += ys[i][0] * ys[i][0] + ys[i][1] * ys[i][1]; }
    float ye[32];
#pragma unroll
    for (int i = 0; i < 16; ++i) {
      ye[2 * i] = flag4 ? ys[i][1] : ys[i][0];
      ye[2 * i + 1] = flag4 ? ys[i][0] : ys[i][1];
    }
    ss = wave_sum(ss);
    const float rs = rsqrtf(ss * (1.f / 2048.f) + 1e-6f);
#pragma unroll
    for (int j = 0; j < 2; ++j)
#pragma unroll
      for (int q = 0; q < 4; ++q) {
        const float4 gq = *(const float4*)(p.g_final + j * 1024 + lane * 16 + q * 4);
        const int b0 = j * 16 + q * 4;
        float4 o;
        o.x = ye[b0] * rs * gq.x; o.y = ye[b0 + 1] * rs * gq.y; o.z = ye[b0 + 2] * rs * gq.z; o.w = ye[b0 + 3] * rs * gq.w;
        *(float4*)(p.out + (size_t)tok * 2048 + j * 1024 + lane * 16 + q * 4) = o;
      }
    myidx[0] = nxidx[0]; myidx[1] = nxidx[1]; mygate[0] = nxgate[0]; mygate[1] = nxgate[1];
  }
}

#define XB_TMO      128
#define XB_XCNT(j)  (256  + 64 * (j))
#define XB_XSUB(j)  (1280 + 64 * (j))
#define XB_XGEN(j)  (2304 + 64 * (j))
#define XB_TOP      3328
#define XB_TOPGEN   3392
#define XCD_BAR_WORDS 3456
#define XB_SPIN_CAP (1u << 20)
DI unsigned xb_ld(unsigned* p)              { return __hip_atomic_load(p, __ATOMIC_RELAXED, __HIP_MEMORY_SCOPE_AGENT); }
DI unsigned xb_add(unsigned* p, unsigned v) { return __hip_atomic_fetch_add(p, v, __ATOMIC_RELAXED, __HIP_MEMORY_SCOPE_AGENT); }
DI unsigned xb_xcc_id() { return (unsigned)__builtin_amdgcn_s_getreg((3 << 11) | 20) & 0xFu; }
#define XB_SPIN(cond, bar) do { unsigned _sp = 0; while (cond) { __builtin_amdgcn_s_sleep(1); \
    if ((++_sp & 255u) == 0u) { if (xb_ld(&(bar)[XB_TMO])) break; if (_sp > XB_SPIN_CAP) { atomicAdd(&(bar)[XB_TMO], 1u); break; } } } } while (0)
struct XcdBarrier { unsigned* bar; unsigned x; volatile LAS unsigned* st; };
DI XcdBarrier xcd_barrier_post(unsigned* bar, volatile LAS unsigned* st) {
  XcdBarrier b; b.bar = bar; b.x = xb_xcc_id(); b.st = st;
  if (threadIdx.x == 0) (void)xb_add(&bar[XB_XCNT(b.x)], 1u);
  return b;
}
DI void xcd_barrier_complete(unsigned* bar, unsigned x, unsigned& nloc, unsigned& nx) {
  const unsigned G = gridDim.x * gridDim.y * gridDim.z;
  unsigned sum, cnt, mine, sp = 0u;
  for (;;) {
    sum = 0u; cnt = 0u; mine = 0u;
#pragma unroll
    for (unsigned j = 0; j < 16; ++j) { const unsigned c = xb_ld(&bar[XB_XCNT(j)]); sum += c; cnt += (c > 0u) ? 1u : 0u; mine = (j == x) ? c : mine; }
    if (sum == G) break;
    __builtin_amdgcn_s_sleep(1);
    if ((++sp & 255u) == 0u) { if (xb_ld(&bar[XB_TMO])) break; if (sp > XB_SPIN_CAP) { atomicAdd(&bar[XB_TMO], 1u); break; } }
  }
  nloc = mine > 0u ? mine : 1u; nx = cnt > 0u ? cnt : 1u;
}
DI void xcd_barrier(const XcdBarrier& b) {
  asm volatile("s_waitcnt vmcnt(0)" ::: "memory");
  __syncthreads();
  if (threadIdx.x == 0) {
    unsigned* bar = b.bar;
    __builtin_amdgcn_s_waitcnt(0);
    unsigned nloc = b.st[0], nx = b.st[1];
    if (nloc == 0u) { xcd_barrier_complete(bar, b.x, nloc, nx); b.st[0] = nloc; b.st[1] = nx; }
    const unsigned old = xb_add(&bar[XB_XSUB(b.x)], 1u);
    const unsigned gen = old / nloc;
    if (old + 1u == (gen + 1u) * nloc) {
      __builtin_amdgcn_fence(__ATOMIC_RELEASE, "agent");
      asm volatile("s_waitcnt vmcnt(0)" ::: "memory");
      const unsigned og = xb_add(&bar[XB_TOP], 1u);
      const unsigned tg = og / nx;
      if (og + 1u == (tg + 1u) * nx) xb_add(&bar[XB_TOPGEN], 1u);
      else XB_SPIN(xb_ld(&bar[XB_TOPGEN]) == tg, bar);
      __builtin_amdgcn_fence(__ATOMIC_ACQUIRE, "agent");
      xb_add(&bar[XB_XGEN(b.x)], 1u);
      asm volatile("s_waitcnt vmcnt(0)" ::: "memory");
    } else {
      XB_SPIN(xb_ld(&bar[XB_XGEN(b.x)]) == gen, bar);
      __builtin_amdgcn_fence(__ATOMIC_ACQUIRE, "agent");
      asm volatile("s_waitcnt vmcnt(0)" ::: "memory");
    }
  }
  __syncthreads();
}

__global__ void __launch_bounds__(NTHREADS) mega(Params p, int phase_lo, int phase_hi) {
  __shared__ __attribute__((aligned(16))) char smem[SMEM_BYTES];
  cg::grid_group grid = cg::this_grid();
  volatile LAS unsigned* xst = (volatile LAS unsigned*)(smem + SMEM_BYTES - 16);
  if (threadIdx.x == 0) { xst[0] = 0u; xst[1] = 0u; }
  __syncthreads();
  const XcdBarrier xbar = xcd_barrier_post(p.bar + 64, xst);
  if (phase_hi > 1000) grid.sync();
#define PHASE(k, call) if (phase_lo <= (k) && (k) < phase_hi) { if ((k) > phase_lo) { xcd_barrier(xbar); } call; if ((DUP_MASK >> (k)) & 1) { xcd_barrier(xbar); call; } }
  PHASE(0, phase_prep(p, smem))
  PHASE(1, phase_inproj(p, smem))
  PHASE(2, phase_mix_attn(p, smem))
  PHASE(3, phase_pool_combine(p, smem))
  PHASE(4, phase_gemm_resid<false>(p.hbuf, 2048, p.wOutT, 2048, p.x, p.x2b, p.rowss1, smem))
  PHASE(6, phase_cross_proj(p, smem))
  PHASE(7, phase_cross_attn(p, smem))
  PHASE(8, phase_gemm_resid<true>(p.oc, 512, p.wCoT, 512, p.x2b, p.hbuf, p.rowss2, smem))
  PHASE(10, phase_gemm_pq(p, smem))
  PHASE(11, phase_peer_route(p, smem))
  PHASE(12, phase_peer_expert(p))
}

extern "C" void kernel_launch(void* const* d_in, const int* in_sizes, int n_in, void* d_out, int out_size, void* d_ws,
                              size_t ws_size, hipStream_t stream) {
  Params p{};
  p.x = (const float*)d_in[0]; p.mem = (const float*)d_in[1]; p.pos = (const int*)d_in[2];
  p.g_mix = (const float*)d_in[3]; p.w_in = (const float*)d_in[4]; p.w_pool = (const float*)d_in[5];
  p.pool_scale = (const float*)d_in[6]; p.w_out = (const float*)d_in[7]; p.g_cross = (const float*)d_in[8];
  p.g_mem = (const float*)d_in[9]; p.w_cq = (const float*)d_in[10]; p.w_ck = (const float*)d_in[11];
  p.w_cv = (const float*)d_in[12]; p.w_co = (const float*)d_in[13]; p.g_ffn = (const float*)d_in[14];
  p.w_pq = (const float*)d_in[15]; p.sk1f = (const float*)d_in[16]; p.sk2f = (const float*)d_in[17];
  p.w_u = (const float*)d_in[18]; p.w_v = (const float*)d_in[19]; p.g_final = (const float*)d_in[20];
  p.out = (float*)d_out;
  char* ws = (char*)d_ws;
  size_t off = 0;
  auto take = [&](size_t bytes) { char* r = ws + off; off += (bytes + 255) & ~(size_t)255; return r; };
  const size_t MB = 1024 * 1024;
  p.wInT = (bfr*)take(16 * MB); p.wPoolT = (bfr*)take(512 * 1024); p.wOutT = (bfr*)take(8 * MB);
  p.wCqT = (bfr*)take(2 * MB); p.wCkT = (bfr*)take(2 * MB); p.wCvT = (bfr*)take(2 * MB); p.wCoT = (bfr*)take(2 * MB);
  p.wPqT = (bfr*)take(8 * MB); p.sk1 = (bfr*)take(32768); p.sk2 = (bfr*)take(32768);
  p.wU8 = (unsigned char*)take(32 * MB); p.wV8 = (unsigned char*)take(32 * MB);
  p.su = (float*)take(65536); p.sv = (float*)take(65536);
  p.memn = (bfr*)take(4 * MB); p.kc = (bfr*)take(1 * MB); p.vc = (bfr*)take(1 * MB);
  p.hbuf = (bfr*)take(64 * MB);
  p.bar = (unsigned*)take(256 + XCD_BAR_WORDS * 4);
  p.rowss1 = (float*)take(65536); p.rowss2 = (float*)take(65536);
  p.ropetab = (float*)take((size_t)T_TOK * 16 * 2 * 4);
  const size_t r2 = off;
  p.qbuf = (bfr*)take(32 * MB); p.kbuf = (bfr*)take(32 * MB); p.vbuf = (bfr*)take(32 * MB);
  p.pbuf = (bfr*)take(32 * MB); p.mixed = (bfr*)take(32 * MB); p.ob = (bfr*)take(96 * MB);
  p.lse = (float*)take((size_t)3 * T_TOK * 8 * 4);
  const size_t end1 = off;
  off = r2;
  p.xres = (float*)take(128 * MB); p.pq = (bfr*)take(64 * MB); p.x2b = p.pq; p.qc = (bfr*)take(16 * MB); p.oc = (bfr*)take(16 * MB);
  p.idx = (int*)take(8 * MB); p.gates = (float*)take(8 * MB);
  const size_t end2 = off;
  const size_t need = end1 > end2 ? end1 : end2;
  if (need > ws_size) { fprintf(stderr, "workspace too small: need %zu have %zu\n", need, ws_size); return; }

  static int grid_blocks = 0;
  if (!grid_blocks) {
    int dev = 0, cus = 0, per_cu = 0;
    hipGetDevice(&dev);
    hipDeviceGetAttribute(&cus, hipDeviceAttributeMultiprocessorCount, dev);
    hipOccupancyMaxActiveBlocksPerMultiprocessor(&per_cu, mega, NTHREADS, 0);
    if (per_cu < 1) per_cu = 1;
    if (per_cu > 1) per_cu = 1;
    grid_blocks = cus * per_cu;
  }
  hipMemsetAsync(p.bar, 0, 256 + XCD_BAR_WORDS * 4, stream);
#if MULTI_LAUNCH
  for (int ph = 0; ph < NPHASE; ++ph) hipLaunchKernelGGL(mega, dim3(grid_blocks), dim3(NTHREADS), 0, stream, p, ph, ph + 1);
#else
  int lo = 0, hi = NPHASE;
  void* args[] = {&p, &lo, &hi};
  hipError_t e = hipLaunchCooperativeKernel((void*)mega, dim3(grid_blocks), dim3(NTHREADS), args, 0, stream);
  if (e != hipSuccess) fprintf(stderr, "cooperative launch failed: %s (grid %d)\n", hipGetErrorString(e), grid_blocks);
#endif
}
```
